# Optimizing an MI355X kernel written in HIP

```python
import jax, jax.numpy as jnp
from jax import lax
import numpy as np

D_MODEL = 4096
BATCH = 1
SEQ = 16384
DEPTH = 1

CHUNK = 64
N_META = 16
Q_BLOCK = 128
MAX_TOPK = 256
NORM_EPS = 1e-6

A_HEAD_DIM = 64
A_WIDTH = D_MODEL // 2
A_HEADS = A_WIDTH // A_HEAD_DIM
A_DECAY_LORA = 96
A_ICLR_LORA = 96
A_GATE_LORA = 256
A_GN_EPS = 64e-5
A_SIZES = (A_WIDTH, A_WIDTH, A_WIDTH, A_DECAY_LORA, A_ICLR_LORA, A_GATE_LORA)
A_COLS = sum(A_SIZES)

B_HEAD_DIM = 128
B_WIDTH = D_MODEL // 2
B_HEADS = B_WIDTH // B_HEAD_DIM
B_KV_RANK = 512
IDX_HEADS = 32
IDX_DIM = 64
IDX_EPS = 1e-6
B_SIZES = (B_WIDTH, B_KV_RANK, IDX_HEADS * IDX_DIM, IDX_DIM, IDX_HEADS)
B_COLS = sum(B_SIZES)
IN_COLS = A_COLS + B_COLS

D_FF = 11008
CONV_W = 3

kernel_name = "hybrid_rwkv7_dsa_convffn_block"


def rmsnorm(x, w, eps=NORM_EPS):
    xf = x.astype(jnp.float32)
    y = xf * lax.rsqrt(jnp.mean(xf * xf, axis=-1, keepdims=True) + eps)
    return (y * w.astype(jnp.float32)).astype(x.dtype)


def layernorm(x, w, b, eps):
    xf = x.astype(jnp.float32)
    mu = jnp.mean(xf, axis=-1, keepdims=True)
    var = jnp.mean(jnp.square(xf - mu), axis=-1, keepdims=True)
    y = (xf - mu) * lax.rsqrt(var + eps)
    return (y * w.astype(jnp.float32) + b.astype(jnp.float32)).astype(x.dtype)


def split_cols(z, sizes):
    return jnp.split(z, [int(c) for c in np.cumsum(sizes)[:-1]], axis=-1)


def chunk_ids(n):
    p = jnp.arange(n)
    return jnp.where(p < N_META, 0, 1 + (p - N_META) // CHUNK)


def causal_dwconv(x, w, b):
    k_w = w.shape[0]
    L = x.shape[1]
    xp = jnp.pad(x, ((0, 0), (k_w - 1, 0), (0, 0)))
    return sum(xp[:, i:i + L] * w[i] for i in range(k_w)) + b


def rwkv7_mix(za, mu, w0, w2, a0, a2, g2, k_k, k_a, r_k, ln_w, ln_b):
    f32 = jnp.float32
    B, L, _ = za.shape
    prev = jnp.pad(za, ((0, 0), (1, 0), (0, 0)))[:, :-1]
    zs = za + (prev - za) * mu
    r, k, v, w_lo, a_lo, g_lo = split_cols(zs, A_SIZES)
    w = -jax.nn.softplus(-(w0 + jnp.tanh(w_lo) @ w2)) - 0.5
    decay = jnp.exp(-jnp.exp(w.astype(f32)))
    a = jax.nn.sigmoid(a0 + a_lo @ a2)
    g = jax.nn.sigmoid(g_lo) @ g2

    def heads(t):
        return t.reshape(B, L, A_HEADS, A_HEAD_DIM)

    kk = heads(k * k_k).astype(f32)
    kk = kk * lax.rsqrt(jnp.sum(kk * kk, axis=-1, keepdims=True) + 1e-12)
    k = k * (1.0 + (a - 1.0) * k_a)
    rh, kh, vh, ah = heads(r).astype(f32), heads(k).astype(f32), heads(v).astype(f32), heads(a).astype(f32)
    bb = kk * ah

    def step(S, inp):
        r_t, d_t, k_t, v_t, kk_t, b_t = inp
        S = (S * d_t[:, :, None, :]
             - jnp.einsum('bhvk,bhk->bhv', S, kk_t)[..., None] * b_t[:, :, None, :]
             + v_t[..., None] * k_t[:, :, None, :])
        return S, jnp.einsum('bhvk,bhk->bhv', S, r_t)

    xs = tuple(jnp.moveaxis(t, 1, 0) for t in (rh, heads(decay), kh, vh, kk, bb))
    S0 = jnp.zeros((B, A_HEADS, A_HEAD_DIM, A_HEAD_DIM), f32)
    _, y = lax.scan(step, S0, xs)
    y = jnp.moveaxis(y, 0, 1)
    mu_y = jnp.mean(y, axis=-1, keepdims=True)
    var_y = jnp.mean(jnp.square(y - mu_y), axis=-1, keepdims=True)
    y = ((y - mu_y) * lax.rsqrt(var_y + A_GN_EPS)).reshape(B, L, A_WIDTH)
    y = y * ln_w.astype(f32) + ln_b.astype(f32)
    bonus = jnp.sum(rh * kh * r_k.astype(f32), axis=-1, keepdims=True) * vh
    y = (y + bonus.reshape(B, L, A_WIDTH)) * g.astype(f32)
    return y.astype(za.dtype)


def dsa_mix(zb, kv_norm_w, w_uk, w_uv, idx_ln_w, idx_ln_b, topk):
    f32 = jnp.float32
    B, L, _ = zb.shape
    q, c_kv, q_idx, k_idx, w_idx = split_cols(zb, B_SIZES)
    c_kv = rmsnorm(c_kv, kv_norm_w)
    k_idx = layernorm(k_idx, idx_ln_w, idx_ln_b, IDX_EPS)
    w_idx = w_idx * (IDX_HEADS ** -0.5 * IDX_DIM ** -0.5)
    n_blk = -(-L // Q_BLOCK)
    Lp = n_blk * Q_BLOCK

    def blocks(t):
        pad = [(0, 0), (0, Lp - L)] + [(0, 0)] * (t.ndim - 2)
        t = jnp.pad(t, pad)
        return jnp.moveaxis(t.reshape((B, n_blk, Q_BLOCK) + t.shape[2:]), 1, 0)

    q_blk = blocks(q.reshape(B, L, B_HEADS, B_HEAD_DIM))
    qi_blk = blocks(q_idx.reshape(B, L, IDX_HEADS, IDX_DIM))
    wi_blk = blocks(w_idx)
    cid = chunk_ids(Lp)
    cid_q = cid.reshape(n_blk, Q_BLOCK)
    cid_k = cid[:L]
    scale = B_HEAD_DIM ** -0.5
    k_idx_f = k_idx.astype(f32)

    def one_block(args):
        qb, qib, wib, cq = args
        rel = jax.nn.relu(jnp.einsum('bqhd,bsd->bqhs', qib.astype(f32), k_idx_f))
        score = jnp.einsum('bqhs,bqh->bqs', rel, wib.astype(f32))
        admissible = cid_k[None, None, :] <= cq[None, :, None]
        score = jnp.where(admissible, score, -jnp.inf)
        sel_score, sel_idx = lax.top_k(score, topk)
        valid = sel_score > -jnp.inf
        c_sel = jax.vmap(lambda c, i: c[i])(c_kv, sel_idx)
        q_lat = jnp.einsum('bqhd,hrd->bqhr', qb, w_uk)
        logits = jnp.einsum('bqhr,bqkr->bqhk', q_lat, c_sel).astype(f32) * scale
        logits = jnp.where(valid[:, :, None, :], logits, -jnp.inf)
        p = jax.nn.softmax(logits, axis=-1).astype(c_sel.dtype)
        o_lat = jnp.einsum('bqhk,bqkr->bqhr', p, c_sel)
        return jnp.einsum('bqhr,hrd->bqhd', o_lat, w_uv)

    o = lax.map(one_block, (q_blk, qi_blk, wi_blk, cid_q))
    o = jnp.moveaxis(o, 0, 1).reshape(B, Lp, B_WIDTH)[:, :L]
    return o


def setup_inputs(seed: int = 0) -> dict:
    key = jax.random.key(seed)
    ks = iter(jax.random.split(key, 40))

    def nrm(shape, scale=1.0):
        return jax.random.normal(next(ks), shape, jnp.float32) * scale

    def gain(shape):
        return 1.0 + nrm(shape, 0.05)

    ramp = (jnp.arange(A_WIDTH, dtype=jnp.float32) / (A_WIDTH - 1)) ** 1.5
    conv_base = jnp.array([0.2, 0.3, 1.0], jnp.float32)[None, :, None]
    return {
        "x": nrm((BATCH, SEQ, D_MODEL)),
        "meta_tokens": nrm((N_META, D_MODEL)),
        "norm_mix_w": gain((DEPTH, D_MODEL)),
        "w_in": nrm((DEPTH, D_MODEL, IN_COLS), D_MODEL ** -0.5),
        "mu_shift": jax.random.uniform(next(ks), (DEPTH, A_COLS), jnp.float32),
        "rwkv_w0": -6.0 + 5.0 * ramp[None, :] + nrm((DEPTH, A_WIDTH), 0.1),
        "rwkv_w2": nrm((DEPTH, A_DECAY_LORA, A_WIDTH), 0.1 * A_DECAY_LORA ** -0.5),
        "rwkv_a0": nrm((DEPTH, A_WIDTH), 0.1),
        "rwkv_a2": nrm((DEPTH, A_ICLR_LORA, A_WIDTH), 0.1 * A_ICLR_LORA ** -0.5),
        "rwkv_g2": nrm((DEPTH, A_GATE_LORA, A_WIDTH), A_GATE_LORA ** -0.5),
        "rwkv_k_k": 0.85 + nrm((DEPTH, A_WIDTH), 0.05),
        "rwkv_k_a": 1.0 + nrm((DEPTH, A_WIDTH), 0.05),
        "rwkv_r_k": nrm((DEPTH, A_HEADS, A_HEAD_DIM), 0.1),
        "rwkv_ln_w": gain((DEPTH, A_WIDTH)),
        "rwkv_ln_b": nrm((DEPTH, A_WIDTH), 0.02),
        "kv_norm_w": gain((DEPTH, B_KV_RANK)),
        "w_uk": nrm((DEPTH, B_HEADS, B_KV_RANK, B_HEAD_DIM), B_KV_RANK ** -0.5),
        "w_uv": nrm((DEPTH, B_HEADS, B_KV_RANK, B_HEAD_DIM), B_KV_RANK ** -0.5),
        "idx_ln_w": gain((DEPTH, IDX_DIM)),
        "idx_ln_b": nrm((DEPTH, IDX_DIM), 0.02),
        "w_proj_a": nrm((DEPTH, A_WIDTH, D_MODEL), A_WIDTH ** -0.5),
        "w_proj_b": nrm((DEPTH, B_WIDTH, D_MODEL), B_WIDTH ** -0.5),
        "w_gate": nrm((DEPTH, D_MODEL, 2 * D_MODEL), D_MODEL ** -0.5),
        "w_out": nrm((DEPTH, D_MODEL, D_MODEL), D_MODEL ** -0.5),
        "norm_ffn_w": gain((DEPTH, D_MODEL)),
        "w_ffn_in": nrm((DEPTH, D_MODEL, 2 * D_FF), D_MODEL ** -0.5),
        "ffn_conv_w": conv_base + nrm((DEPTH, CONV_W, 2 * D_FF), 0.1),
        "ffn_conv_b": nrm((DEPTH, 2 * D_FF), 0.02),
        "w_ffn_out": nrm((DEPTH, D_FF, D_MODEL), D_FF ** -0.5),
        "norm_final_w": gain((D_MODEL,)),
    }


def reference(x, meta_tokens, norm_mix_w, w_in, mu_shift, rwkv_w0, rwkv_w2, rwkv_a0, rwkv_a2,
              rwkv_g2, rwkv_k_k, rwkv_k_a, rwkv_r_k, rwkv_ln_w, rwkv_ln_b, kv_norm_w, w_uk, w_uv,
              idx_ln_w, idx_ln_b, w_proj_a, w_proj_b, w_gate, w_out, norm_ffn_w, w_ffn_in,
              ffn_conv_w, ffn_conv_b, w_ffn_out, norm_final_w):
    B = x.shape[0]
    topk = min(MAX_TOPK, SEQ // 4)
    meta = jnp.broadcast_to(meta_tokens[None].astype(x.dtype), (B, N_META, D_MODEL))
    h = jnp.concatenate([meta, x], axis=1)
    for l in range(DEPTH):
        u = rmsnorm(h, norm_mix_w[l])
        z = u @ w_in[l]
        za, zb = z[..., :A_COLS], z[..., A_COLS:]
        ya = rwkv7_mix(za, mu_shift[l], rwkv_w0[l], rwkv_w2[l], rwkv_a0[l], rwkv_a2[l], rwkv_g2[l],
                       rwkv_k_k[l], rwkv_k_a[l], rwkv_r_k[l], rwkv_ln_w[l], rwkv_ln_b[l])
        yb = dsa_mix(zb, kv_norm_w[l], w_uk[l], w_uv[l], idx_ln_w[l], idx_ln_b[l], topk)
        gates = jax.nn.sigmoid(u @ w_gate[l])
        g_a, g_b = gates[..., :D_MODEL], gates[..., D_MODEL:]
        merged = g_a * (ya @ w_proj_a[l]) + g_b * (yb @ w_proj_b[l])
        h = h + merged @ w_out[l]
        u = rmsnorm(h, norm_ffn_w[l])
        zf = causal_dwconv(u @ w_ffn_in[l], ffn_conv_w[l], ffn_conv_b[l])
        zg, zu = zf[..., :D_FF], zf[..., D_FF:]
        h = h + (jax.nn.silu(zg) * zu) @ w_ffn_out[l]
    y = rmsnorm(h, norm_final_w)
    return y[:, N_META:]
```

```cpp
#include <hip/hip_runtime.h>
#include <cstdio>
#include <cstdint>
#define MK_ONE_LAUNCH 1
namespace pg8 {
#define PG8_LAS __attribute__((address_space(3)))
typedef unsigned short bf16_t;
typedef short bf16x8 __attribute__((ext_vector_type(8)));
typedef float f32x4 __attribute__((ext_vector_type(4)));
typedef unsigned u32x4 __attribute__((ext_vector_type(4)));
constexpr int BM = 256, BK = 64, HALF = 128, HTB = HALF * BK * 2  , STAGE_BYTES = 8 * HTB, NXCD = 8, WGM = 8;

__host__ __device__ __forceinline__ int lds_byte(int r, int c) { const int st = (r >> 4) * 2 + (c >> 5), rr = r & 15, cc = c & 31, ob = rr * 64 + cc * 2; return st * 1024 + (ob ^ (((ob >> 9) & 1) << 5)); }
__host__ __device__ __forceinline__ void stage_rc(int b, int& R, int& C) { const int st = b / 1024, sb = b % 1024, swz = sb ^ (((sb >> 9) & 1) << 5); R = (st >> 1) * 16 + swz / 64; C = (st & 1) * 32 + (swz % 64) / 2; }
__host__ __device__ __forceinline__ int perm32(int rho) { const int n = rho >> 4, i = rho & 15; return 8 * (i >> 2) + 4 * n + (i & 3); }

struct Unit { int pm, pn; };
struct Gemm { const bf16_t* A; const bf16_t* Bt; int M, N, K; };

struct StaticOrder {
    int nM, nN, nwg, G, c;
    __host__ __device__ void init(int M, int N, int G_, int c_) { nM = M / BM; nN = N / BM; nwg = nM * nN; G = G_; c = c_; }
    __host__ __device__ bool next(int i, Unit& u) const {
        const long L = (long)i * G + c; if (L >= nwg) return false;
        int wgid = (int)L; { const int q = nwg / NXCD, r = nwg % NXCD, xcd = wgid % NXCD, off = wgid / NXCD; wgid = (xcd < r ? xcd * (q + 1) : r * (q + 1) + (xcd - r) * q) + off; }
        const int nig = WGM * nN, gid = wgid / nig, fm = gid * WGM, gsz = (nM - fm) < WGM ? (nM - fm) : WGM;
        u.pm = fm + ((wgid % nig) % gsz); u.pn = (wgid % nig) / gsz; return true;
    }
    __device__ __forceinline__ void a_ready(const Unit&) const {}
    __device__ __forceinline__ void done(const Unit&) const {}
};

__device__ __forceinline__ unsigned cvt_pk_bf16(float lo, float hi) { unsigned r; asm volatile("v_cvt_pk_bf16_f32 %0, %1, %2" : "=v"(r) : "v"(lo), "v"(hi)); return r; }
typedef float f32x2 __attribute__((ext_vector_type(2)));

typedef unsigned u32x2 __attribute__((ext_vector_type(2)));
__device__ __forceinline__ float bf_lo(unsigned w) { return __uint_as_float(w << 16); }
__device__ __forceinline__ float bf_hi(unsigned w) { return __uint_as_float(w & 0xffff0000u); }
__device__ __forceinline__ float sigmoidf_(float x) { return 1.f / (1.f + __expf(-x)); }

template <int ACT> struct EpiBf16 {
    static constexpr bool PERM = true, AFTER_DRAIN = false;
    bf16_t* O; int ldc;
    __device__ __forceinline__ void operator()(const f32x4 (&acc)[2][2][4][2], const Unit& u, int wr, int wc, int fr, int fq) const {
        const int row0 = u.pm * BM + wr * 64 + fr; const int col0 = u.pn * BM + wc * 32 + 8 * fq;
#pragma unroll
        for (int ai = 0; ai < 2; ++ai)
#pragma unroll
            for (int m = 0; m < 4; ++m) { bf16_t* rowp = O + (size_t)(row0 + ai * HALF + m * 16) * ldc + col0;
#pragma unroll
                for (int bj = 0; bj < 2; ++bj) { f32x4 v0 = acc[ai][bj][m][0], v1 = acc[ai][bj][m][1];
                    if (ACT == 1) {
#pragma unroll
                        for (int e = 0; e < 4; ++e) { v0[e] = sigmoidf_(v0[e]); v1[e] = sigmoidf_(v1[e]); } }
                    u32x4 w; w.x = cvt_pk_bf16(v0[0], v0[1]); w.y = cvt_pk_bf16(v0[2], v0[3]); w.z = cvt_pk_bf16(v1[0], v1[1]); w.w = cvt_pk_bf16(v1[2], v1[3]);
                    *(u32x4*)(rowp + bj * HALF) = w; } }
    }
};
struct EpiGateMulF32 {
    static constexpr bool PERM = false, AFTER_DRAIN = false;
    float* MF; int ldc; const bf16_t* G; int ldg; int gcol0;
    __device__ __forceinline__ void operator()(const f32x4 (&acc)[2][2][4][2], const Unit& u, int wr, int wc, int fr, int fq) const {
        const int row0 = u.pm * BM + wr * 64 + fr, col0 = u.pn * BM + wc * 32 + 4 * fq;
#pragma unroll
        for (int ai = 0; ai < 2; ++ai)
#pragma unroll
            for (int m = 0; m < 4; ++m) { const size_t r = (size_t)(row0 + ai * HALF + m * 16); float* rowp = MF + r * ldc + col0; const bf16_t* gp = G + r * ldg + gcol0 + col0;
#pragma unroll
                for (int bj = 0; bj < 2; ++bj)
#pragma unroll
                    for (int n = 0; n < 2; ++n) { const u32x2 g = *(const u32x2*)(gp + bj * HALF + n * 16); const f32x4 a = acc[ai][bj][m][n];
                        f32x4 o; o[0] = a[0] * bf_lo(g.x); o[1] = a[1] * bf_hi(g.x); o[2] = a[2] * bf_lo(g.y); o[3] = a[3] * bf_hi(g.y);
                        *(f32x4*)(rowp + bj * HALF + n * 16) = o; } }
    }
};
struct EpiGateMulAddBf16 {
    static constexpr bool PERM = true, AFTER_DRAIN = false;
    bf16_t* MB; int ldc; const float* MF; const bf16_t* G; int ldg; int gcol0;
    __device__ __forceinline__ void operator()(const f32x4 (&acc)[2][2][4][2], const Unit& u, int wr, int wc, int fr, int fq) const {
        const int row0 = u.pm * BM + wr * 64 + fr, col0 = u.pn * BM + wc * 32 + 8 * fq;
#pragma unroll
        for (int ai = 0; ai < 2; ++ai)
#pragma unroll
            for (int m = 0; m < 4; ++m) { const size_t r = (size_t)(row0 + ai * HALF + m * 16); bf16_t* rowp = MB + r * ldc + col0; const float* mp = MF + r * ldc + col0; const bf16_t* gp = G + r * ldg + gcol0 + col0;
#pragma unroll
                for (int bj = 0; bj < 2; ++bj) { const u32x4 g = *(const u32x4*)(gp + bj * HALF); const f32x4 m0 = *(const f32x4*)(mp + bj * HALF), m1 = *(const f32x4*)(mp + bj * HALF + 4);
                    const f32x4 a0 = acc[ai][bj][m][0], a1 = acc[ai][bj][m][1];
                    u32x4 w; w.x = cvt_pk_bf16(m0[0] + a0[0] * bf_lo(g.x), m0[1] + a0[1] * bf_hi(g.x)); w.y = cvt_pk_bf16(m0[2] + a0[2] * bf_lo(g.y), m0[3] + a0[3] * bf_hi(g.y));
                    w.z = cvt_pk_bf16(m1[0] + a1[0] * bf_lo(g.z), m1[1] + a1[1] * bf_hi(g.z)); w.w = cvt_pk_bf16(m1[2] + a1[2] * bf_lo(g.w), m1[3] + a1[3] * bf_hi(g.w));
                    *(u32x4*)(rowp + bj * HALF) = w; } }
    }
};
struct EpiResid {
    static constexpr bool PERM = false, AFTER_DRAIN = false;
    const float* smeta; const float* sreal; float* dmeta; float* dreal; int ld; int nmeta; int nrows;
    __device__ __forceinline__ void operator()(const f32x4 (&acc)[2][2][4][2], const Unit& u, int wr, int wc, int fr, int fq) const {
        const int row0 = u.pm * BM + wr * 64 + fr, col0 = u.pn * BM + wc * 32 + 4 * fq;
#pragma unroll
        for (int ai = 0; ai < 2; ++ai)
#pragma unroll
            for (int m = 0; m < 4; ++m) { const int r = row0 + ai * HALF + m * 16;
                if (r < nrows) {
                    const float* sp = (r < nmeta ? smeta + (size_t)r * ld : sreal + (size_t)(r - nmeta) * ld) + col0;
                    float* dp = (r < nmeta ? dmeta + (size_t)r * ld : dreal + (size_t)(r - nmeta) * ld) + col0;
#pragma unroll
                    for (int bj = 0; bj < 2; ++bj)
#pragma unroll
                        for (int n = 0; n < 2; ++n) *(f32x4*)(dp + bj * HALF + n * 16) = *(const f32x4*)(sp + bj * HALF + n * 16) + acc[ai][bj][m][n];
                } }
    }
};
template <class Epi, class Sched, bool ALIGN_EPI = false, bool SP2 = false>
__device__ __forceinline__ void gemm_phase(PG8_LAS unsigned char* lds, const Gemm g, const Sched& S, const Epi& E) {
    const int tid = threadIdx.x, wid = __builtin_amdgcn_readfirstlane(tid >> 6), lane = tid & 63, wr = wid >> 2, wc = wid & 3, fr = lane & 15, fq = lane >> 4;
    const int K = g.K, nt = K / BK;
    unsigned voffA[2], voffB[2];
#pragma unroll
    for (int i = 0; i < 2; ++i) { int R, C; stage_rc(tid * 16 + i * 8192, R, C); const int Rb = Epi::PERM ? ((R & ~31) + perm32(R & 31)) : R;
        voffA[i] = (unsigned)(R * K + C) * 2u; voffB[i] = (unsigned)(Rb * K + C) * 2u; }
    const size_t kstep = (size_t)(BK * 2);
    const size_t hstep = (size_t)HALF * K * 2;
    const size_t tstep = 2 * hstep;
    const unsigned ldsw = (unsigned)wid * 1024u;
    const int aoff = lds_byte(wr * 64 + fr, fq * 8), boff = lds_byte(wc * 32 + fr, fq * 8);
#define PG8_SA(b, h) (((b) * 2 + (h)) * HTB)
#define PG8_SB(b, h) ((4 + (b) * 2 + (h)) * HTB)
#define PG8_STAGE(bufoff, gbase, voff) do { _Pragma("unroll") for (int _i = 0; _i < 2; ++_i) \
        __builtin_amdgcn_global_load_lds((const unsigned*)((const char*)(gbase) + (voff)[_i]), (PG8_LAS unsigned*)(lds + (bufoff) + ldsw + _i * 8192), 16, 0, 0); } while (0)
#define PG8_LDA(dst, b, h) do { _Pragma("unroll") for (int m = 0; m < 4; ++m) _Pragma("unroll") for (int k = 0; k < 2; ++k) dst[m][k] = *(const PG8_LAS bf16x8*)(lds + PG8_SA(b, h) + aoff + m * 2048 + k * 1024); } while (0)
#define PG8_LDB(dst, b, h) do { _Pragma("unroll") for (int n = 0; n < 2; ++n) _Pragma("unroll") for (int k = 0; k < 2; ++k) dst[n][k] = *(const PG8_LAS bf16x8*)(lds + PG8_SB(b, h) + boff + n * 2048 + k * 1024); } while (0)
#define PG8_MMA(ai, bj, At, Bt) do { __builtin_amdgcn_s_setprio(1); _Pragma("unroll") for (int m = 0; m < 4; ++m) _Pragma("unroll") for (int n = 0; n < 2; ++n) _Pragma("unroll") for (int k = 0; k < 2; ++k) \
        acc[ai][bj][m][n] = __builtin_amdgcn_mfma_f32_16x16x32_bf16(Bt[n][k], At[m][k], acc[ai][bj][m][n], 0, 0, 0); __builtin_amdgcn_s_setprio(0); } while (0)
#define PG8_WAIT_V(n) asm volatile("s_waitcnt vmcnt(" #n ")" ::: "memory")
#define PG8_WAIT_L(n) asm volatile("s_waitcnt lgkmcnt(" #n ")" ::: "memory")
#define PG8_BAR __builtin_amdgcn_s_barrier()
#define PG8_SCHED __builtin_amdgcn_sched_barrier(0)
    Unit cur, nxt; int ui = 0;
    if (!S.next(0, cur)) return;
    f32x4 acc[2][2][4][2];
#pragma unroll
    for (int a = 0; a < 2; ++a)
#pragma unroll
        for (int b = 0; b < 2; ++b)
#pragma unroll
            for (int m = 0; m < 4; ++m)
#pragma unroll
                for (int n = 0; n < 2; ++n) acc[a][b][m][n] = (f32x4){0.f, 0.f, 0.f, 0.f};
    bf16x8 At[4][2], B0[2][2], B1[2][2];
    const char* cA = (const char*)g.A + (size_t)cur.pm * tstep; const char* cB = (const char*)g.Bt + (size_t)cur.pn * tstep;
    S.a_ready(cur);
    if constexpr (SP2) {
        PG8_STAGE(PG8_SB(0, 0), cB, voffB); PG8_STAGE(PG8_SB(0, 1), cB + hstep, voffB); PG8_STAGE(PG8_SA(0, 0), cA, voffA); PG8_STAGE(PG8_SA(0, 1), cA + hstep, voffA);
        if (wr == 1) PG8_BAR;
        PG8_WAIT_V(2); PG8_BAR;
        PG8_STAGE(PG8_SB(1, 0), cB + kstep, voffB); PG8_STAGE(PG8_SA(1, 0), cA + kstep, voffA); PG8_STAGE(PG8_SB(1, 1), cB + hstep + kstep, voffB);
        PG8_WAIT_V(6); PG8_BAR;
    } else {
        PG8_STAGE(PG8_SB(0, 0), cB, voffB); PG8_STAGE(PG8_SA(0, 0), cA, voffA); PG8_STAGE(PG8_SB(0, 1), cB + hstep, voffB); PG8_STAGE(PG8_SA(0, 1), cA + hstep, voffA);
        if (wr == 1) PG8_BAR;
        PG8_WAIT_V(4); PG8_BAR;
        PG8_STAGE(PG8_SB(1, 0), cB + kstep, voffB); PG8_STAGE(PG8_SA(1, 0), cA + kstep, voffA); PG8_STAGE(PG8_SB(1, 1), cB + hstep + kstep, voffB);
        PG8_WAIT_V(6); PG8_BAR;
    }
    for (;;) {
        const bool has_next = S.next(ui + 1, nxt);
        const char* nA = has_next ? (const char*)g.A + (size_t)nxt.pm * tstep : cA; const char* nB = has_next ? (const char*)g.Bt + (size_t)nxt.pn * tstep : cB;
        for (int t = 0; t < nt; t += 2) {
            const bool last = (t == nt - 2);
            const char* a1 = cA + (size_t)(t + 1) * kstep;
            const char* a2 = last ? nA : cA + (size_t)(t + 2) * kstep; const char* b2 = last ? nB : cB + (size_t)(t + 2) * kstep;
            const char* a3 = a2 + kstep; const char* b3 = b2 + kstep;
            if (last && has_next) S.a_ready(nxt);
            if constexpr (SP2) {
            PG8_LDB(B0, 0, 0); PG8_LDB(B1, 0, 1); PG8_SCHED; PG8_LDA(At, 0, 0); PG8_STAGE(PG8_SA(1, 1), a1 + hstep, voffA);
            PG8_WAIT_V(8); PG8_WAIT_L(0); PG8_BAR; PG8_MMA(0, 0, At, B0); PG8_MMA(0, 1, At, B1); PG8_BAR; PG8_SCHED;
            PG8_LDA(At, 0, 1); PG8_STAGE(PG8_SB(0, 0), b2, voffB); PG8_STAGE(PG8_SB(0, 1), b2 + hstep, voffB); PG8_STAGE(PG8_SA(0, 0), a2, voffA);
            PG8_WAIT_V(8); PG8_WAIT_L(0); PG8_BAR; PG8_MMA(1, 0, At, B0); PG8_MMA(1, 1, At, B1); PG8_BAR; PG8_SCHED;
            PG8_LDB(B0, 1, 0); PG8_LDB(B1, 1, 1); PG8_SCHED; PG8_LDA(At, 1, 0); PG8_STAGE(PG8_SA(0, 1), a2 + hstep, voffA);
            PG8_WAIT_V(8); PG8_WAIT_L(0); PG8_BAR; PG8_MMA(0, 0, At, B0); PG8_MMA(0, 1, At, B1); PG8_BAR; PG8_SCHED;
            PG8_LDA(At, 1, 1); PG8_STAGE(PG8_SB(1, 0), b3, voffB); PG8_STAGE(PG8_SB(1, 1), b3 + hstep, voffB); PG8_STAGE(PG8_SA(1, 0), a3, voffA);
            PG8_WAIT_V(8); PG8_WAIT_L(0); PG8_BAR; PG8_MMA(1, 0, At, B0); PG8_MMA(1, 1, At, B1); PG8_BAR; PG8_SCHED;
            } else {
            PG8_LDB(B0, 0, 0); PG8_SCHED; PG8_LDA(At, 0, 0); PG8_STAGE(PG8_SA(1, 1), a1 + hstep, voffA);
            PG8_WAIT_L(8); PG8_BAR; PG8_WAIT_L(0); PG8_MMA(0, 0, At, B0); PG8_BAR; PG8_SCHED;
            PG8_LDB(B1, 0, 1); PG8_STAGE(PG8_SB(0, 0), b2, voffB);
            PG8_BAR; PG8_WAIT_L(0); PG8_MMA(0, 1, At, B1); PG8_BAR;
            PG8_LDA(At, 0, 1); PG8_STAGE(PG8_SA(0, 0), a2, voffA);
            PG8_BAR; PG8_WAIT_L(0); PG8_MMA(1, 0, At, B0); PG8_BAR; PG8_SCHED;
            PG8_STAGE(PG8_SB(0, 1), b2 + hstep, voffB);
            PG8_WAIT_V(6); PG8_BAR; PG8_MMA(1, 1, At, B1); PG8_BAR;
            PG8_LDB(B0, 1, 0); PG8_SCHED; PG8_LDA(At, 1, 0); PG8_STAGE(PG8_SA(0, 1), a2 + hstep, voffA);
            PG8_WAIT_L(8); PG8_BAR; PG8_WAIT_L(0); PG8_MMA(0, 0, At, B0); PG8_BAR; PG8_SCHED;
            PG8_LDB(B1, 1, 1); PG8_STAGE(PG8_SB(1, 0), b3, voffB);
            PG8_BAR; PG8_WAIT_L(0); PG8_MMA(0, 1, At, B1); PG8_BAR;
            PG8_LDA(At, 1, 1); PG8_STAGE(PG8_SA(1, 0), a3, voffA);
            PG8_BAR; PG8_WAIT_L(0); PG8_MMA(1, 0, At, B0); PG8_BAR; PG8_SCHED;
            PG8_STAGE(PG8_SB(1, 1), b3 + hstep, voffB);
            PG8_WAIT_V(6); PG8_BAR; PG8_MMA(1, 1, At, B1); PG8_BAR;
            }
        }
        if constexpr (ALIGN_EPI) { if (wr == 0) PG8_BAR; }
        if constexpr (!Epi::AFTER_DRAIN) { E(acc, cur, wr, wc, fr, fq); S.done(cur); }
        if (!has_next) break;
#pragma unroll
        for (int a = 0; a < 2; ++a)
#pragma unroll
            for (int b = 0; b < 2; ++b)
#pragma unroll
                for (int m = 0; m < 4; ++m)
#pragma unroll
                    for (int n = 0; n < 2; ++n) acc[a][b][m][n] = (f32x4){0.f, 0.f, 0.f, 0.f};
        cur = nxt; cA = nA; cB = nB; ++ui;
        if constexpr (ALIGN_EPI) { if (wr == 1) PG8_BAR; }
    }
    PG8_WAIT_V(0);
    if constexpr (!ALIGN_EPI) { if (wr == 0) PG8_BAR; }
    PG8_BAR;
    if constexpr (Epi::AFTER_DRAIN) { E.fused(acc, cur, wr, wc, fr, fq, lds, wid, lane); S.done(cur); }
#undef PG8_SA
#undef PG8_SB
#undef PG8_STAGE
#undef PG8_LDA
#undef PG8_LDB
#undef PG8_MMA
#undef PG8_WAIT_V
#undef PG8_WAIT_L
#undef PG8_BAR
#undef PG8_SCHED
}
}
#define XB_TMO      128
#define XB_XCNT(j)  (256  + 64 * (j))
#define XB_XSUB(j)  (1280 + 64 * (j))
#define XB_XGEN(j)  (2304 + 64 * (j))
#define XB_TOP      3328
#define XB_TOPGEN   3392
#define XCD_BAR_WORDS 3456
#define XB_SPIN_CAP (1u << 18)
#define LAS __attribute__((address_space(3)))

__device__ __forceinline__ unsigned xb_ld(unsigned* p)              { return __hip_atomic_load(p, __ATOMIC_RELAXED, __HIP_MEMORY_SCOPE_AGENT); }
__device__ __forceinline__ unsigned xb_add(unsigned* p, unsigned v) { return __hip_atomic_fetch_add(p, v, __ATOMIC_RELAXED, __HIP_MEMORY_SCOPE_AGENT); }
__device__ __forceinline__ unsigned xb_xcc_id() { return (unsigned)__builtin_amdgcn_s_getreg((3 << 11) | 20) & 0xFu; }
#define XB_SPIN(cond, bar) do { unsigned _sp = 0; while (cond) { __builtin_amdgcn_s_sleep(1); \
    if ((++_sp & 255u) == 0u) { if (xb_ld(&(bar)[XB_TMO])) break; if (_sp > XB_SPIN_CAP) { atomicAdd(&(bar)[XB_TMO], 1u); break; } } } } while (0)

struct XcdBarrier {
    unsigned* bar; unsigned x;
    volatile LAS unsigned* st;
};

__device__ __forceinline__ XcdBarrier xcd_barrier_post(unsigned* bar, volatile LAS unsigned* st) {
    XcdBarrier b; b.bar = bar; b.x = xb_xcc_id(); b.st = st;
    if (threadIdx.x == 0) (void)xb_add(&bar[XB_XCNT(b.x)], 1u);
    return b;
}
__device__ __forceinline__ void xcd_barrier_complete(unsigned* bar, unsigned x, unsigned& nloc, unsigned& nx) {
    const unsigned G = gridDim.x * gridDim.y * gridDim.z;
    unsigned sum, cnt, mine, sp = 0u;
    for (;;) {
        sum = 0u; cnt = 0u; mine = 0u;
#pragma unroll
        for (unsigned j = 0; j < 16; ++j) { const unsigned c = xb_ld(&bar[XB_XCNT(j)]); sum += c; cnt += (c > 0u) ? 1u : 0u; mine = (j == x) ? c : mine; }
        if (sum == G) break;
        __builtin_amdgcn_s_sleep(1);
        if ((++sp & 255u) == 0u) { if (xb_ld(&bar[XB_TMO])) break; if (sp > XB_SPIN_CAP) { atomicAdd(&bar[XB_TMO], 1u); break; } }
    }
    nloc = mine > 0u ? mine : 1u; nx = cnt > 0u ? cnt : 1u;
}

__device__ __forceinline__ void xcd_barrier(const XcdBarrier& b) {
    asm volatile("s_waitcnt vmcnt(0)" ::: "memory");
    __syncthreads();
    if (threadIdx.x == 0) {
        unsigned* bar = b.bar;
        __builtin_amdgcn_s_waitcnt(0);
        unsigned nloc = b.st[0], nx = b.st[1];
        if (nloc == 0u) { xcd_barrier_complete(bar, b.x, nloc, nx); b.st[0] = nloc; b.st[1] = nx; }
        const unsigned old = xb_add(&bar[XB_XSUB(b.x)], 1u);
        const unsigned gen = old / nloc;
        if (old + 1u == (gen + 1u) * nloc) {
            __builtin_amdgcn_fence(__ATOMIC_RELEASE, "agent");
            asm volatile("s_waitcnt vmcnt(0)" ::: "memory");
            const unsigned og = xb_add(&bar[XB_TOP], 1u);
            const unsigned tg = og / nx;
            if (og + 1u == (tg + 1u) * nx) xb_add(&bar[XB_TOPGEN], 1u);
            else XB_SPIN(xb_ld(&bar[XB_TOPGEN]) == tg, bar);
            __builtin_amdgcn_fence(__ATOMIC_ACQUIRE, "agent");
            xb_add(&bar[XB_XGEN(b.x)], 1u);
            asm volatile("s_waitcnt vmcnt(0)" ::: "memory");
        } else {
            XB_SPIN(xb_ld(&bar[XB_XGEN(b.x)]) == gen, bar);
            __builtin_amdgcn_fence(__ATOMIC_ACQUIRE, "agent");
            asm volatile("s_waitcnt vmcnt(0)" ::: "memory");
        }
    }
    __syncthreads();
}

#define LAS __attribute__((address_space(3)))
typedef unsigned short bf16_t;
typedef float f32x4 __attribute__((ext_vector_type(4)));
typedef unsigned u32x4 __attribute__((ext_vector_type(4)));
typedef unsigned u32x2 __attribute__((ext_vector_type(2)));

#ifndef MK_ONE_LAUNCH
#define MK_ONE_LAUNCH 0
#endif

constexpr int NWAVES = 8, NT = NWAVES * 64;
constexpr int D = 4096, SEQ = 16384, NMETA = 16, L = SEQ + NMETA, MP = 16640;
constexpr int A_W = 2048, A_COLS = 6592, B_COLS = 4704, IN_COLS = A_COLS + B_COLS, NZ = 11520;
constexpr int ZQ = A_COLS, ZCKV = A_COLS + 2048, ZQI = A_COLS + 2560, ZKI = A_COLS + 4608, ZWI = A_COLS + 4672;
constexpr int DFF = 11008, NFI = 2 * DFF;
constexpr int KVR = 512, NH_B = 16, HD_B = 128, IDXH = 32, IDXD = 64, TOPK = 256;
constexpr int LDS_BYTES = 147456, MISC_OFF = 147200;

constexpr size_t al256(size_t x) { return (x + 255) & ~(size_t)255; }
constexpr size_t WS_CTL = 0, CTL_BYTES = 1u << 20;
constexpr size_t WS_WGT = WS_CTL + CTL_BYTES;
constexpr size_t WS_WPAT = WS_WGT + (size_t)8192 * 4096 * 2;
constexpr size_t WS_WPBT = WS_WPAT + (size_t)4096 * 2048 * 2;
constexpr size_t WS_WOUTT = WS_WPBT + (size_t)4096 * 2048 * 2;
constexpr size_t WS_WFIT = WS_WOUTT + (size_t)4096 * 4096 * 2;
constexpr size_t WS_WFOT = WS_WFIT + (size_t)NFI * 4096 * 2;
constexpr size_t WS_WINT = WS_WFOT + (size_t)4096 * DFF * 2;
constexpr size_t WS_U = WS_WINT + (size_t)NZ * 4096 * 2;
constexpr size_t WS_BIG = WS_U + (size_t)MP * D * 2;
constexpr size_t WS_Z = WS_BIG;
constexpr size_t WS_R1 = WS_Z + (size_t)MP * NZ * 2;
constexpr size_t R1_BYTES = (size_t)MP * D * 4;
constexpr size_t WS_LD = WS_R1;
constexpr size_t WS_AA = WS_LD + (size_t)L * A_W * 4;
constexpr size_t WS_GG = WS_AA + (size_t)L * A_W * 2;
constexpr size_t WS_QLAT = WS_R1;
constexpr size_t WS_MF = WS_R1;
constexpr size_t WS_YA = WS_R1 + R1_BYTES;
constexpr size_t WS_YB = WS_YA + (size_t)MP * A_W * 2;
constexpr size_t WS_END = WS_YB + (size_t)MP * A_W * 2;
constexpr size_t WS_GATES = WS_Z;
constexpr size_t WS_ZF = WS_BIG;
constexpr size_t WS_ACT = WS_BIG + (size_t)MP * DFF * 2;
constexpr size_t WS_CKV = WS_WINT;
constexpr size_t WS_KIDX = WS_CKV + al256((size_t)L * KVR * 2);
constexpr size_t WS_SEL = WS_KIDX + al256((size_t)L * IDXD * 4);
constexpr size_t WS_HMETA = WS_SEL + al256((size_t)L * TOPK * 4);
static_assert(WS_HMETA + (size_t)NMETA * D * 4 <= WS_U, "DSA overlays exceed WINT");
constexpr size_t WS_KIDXB = WS_HMETA + al256((size_t)NMETA * D * 4);
static_assert(WS_KIDXB + (size_t)L * IDXD * 2 <= WS_U, "KIDXB");
constexpr size_t WS_WUKB = WS_END;
constexpr size_t WS_WUVT = WS_WUKB + (size_t)16 * 512 * 128 * 2;
constexpr size_t WS_END2 = WS_WUVT + (size_t)16 * 512 * 128 * 2;
static_assert(WS_END2 <= (size_t)4 * 4096 * 22016 * 4, "workspace");
constexpr size_t WS_ST = WS_WINT;
constexpr size_t WS_BS = WS_ST + al256((size_t)257 * 32 * 4096 * 2);
static_assert(WS_BS + (size_t)L * 32 * 4 <= WS_U, "RWKV overlays exceed WINT");
static_assert((size_t)L * A_W * 4 + 2 * (size_t)L * A_W * 2 <= R1_BYTES && (size_t)L * 8192 * 2 <= R1_BYTES, "R1");
static_assert(WS_ACT + (size_t)MP * DFF * 2 <= WS_END, "ACT");
static_assert((size_t)MP * 8192 * 2 <= (size_t)MP * NZ * 2, "GATES");
static_assert(WS_END <= (size_t)4 * 4096 * 22016 * 4, "workspace");

__device__ __forceinline__ float bf2f(bf16_t b) { return __uint_as_float(((unsigned)b) << 16); }
__device__ __forceinline__ bf16_t f2bf(float f) { unsigned u = __float_as_uint(f); u += 0x7FFFu + ((u >> 16) & 1u); return (bf16_t)(u >> 16); }
__device__ __forceinline__ unsigned pk2(float lo, float hi) { return (unsigned)f2bf(lo) | ((unsigned)f2bf(hi) << 16); }
__device__ __forceinline__ float blo(unsigned w) { return __uint_as_float(w << 16); }
__device__ __forceinline__ float bhi(unsigned w) { return __uint_as_float(w & 0xffff0000u); }
__device__ __forceinline__ float sigm(float x) { return 1.f / (1.f + __expf(-x)); }
template <int CTRL> __device__ __forceinline__ float dpp_f(float v) { return __builtin_bit_cast(float, __builtin_amdgcn_update_dpp(0, __builtin_bit_cast(int, v), CTRL, 0xf, 0xf, false)); }
__device__ __forceinline__ float wave_sum(float v) {
    v += dpp_f<0xB1>(v);
    v += dpp_f<0x4E>(v);
    v += dpp_f<0x141>(v);
    v += dpp_f<0x140>(v);
    const float a = __builtin_bit_cast(float, __builtin_amdgcn_readlane(__builtin_bit_cast(int, v), 0));
    const float b = __builtin_bit_cast(float, __builtin_amdgcn_readlane(__builtin_bit_cast(int, v), 16));
    const float c = __builtin_bit_cast(float, __builtin_amdgcn_readlane(__builtin_bit_cast(int, v), 32));
    const float d = __builtin_bit_cast(float, __builtin_amdgcn_readlane(__builtin_bit_cast(int, v), 48));
    return (a + b) + (c + d);
}
__device__ __forceinline__ float wave_max(float v) {
    v = fmaxf(v, dpp_f<0xB1>(v)); v = fmaxf(v, dpp_f<0x4E>(v)); v = fmaxf(v, dpp_f<0x141>(v)); v = fmaxf(v, dpp_f<0x140>(v));
    const float a = __builtin_bit_cast(float, __builtin_amdgcn_readlane(__builtin_bit_cast(int, v), 0));
    const float b = __builtin_bit_cast(float, __builtin_amdgcn_readlane(__builtin_bit_cast(int, v), 16));
    const float c = __builtin_bit_cast(float, __builtin_amdgcn_readlane(__builtin_bit_cast(int, v), 32));
    const float d = __builtin_bit_cast(float, __builtin_amdgcn_readlane(__builtin_bit_cast(int, v), 48));
    return fmaxf(fmaxf(a, b), fmaxf(c, d));
}
#define LDS_WAIT() asm volatile("s_waitcnt lgkmcnt(0)" ::: "memory")

struct P {
    const float* in[30]; float* out; unsigned char* ws; int ph_lo, ph_hi;
};
enum { I_X = 0, I_META, I_NMW, I_WIN, I_MU, I_W0, I_W2, I_A0, I_A2, I_G2, I_KK, I_KA, I_RK, I_LNW, I_LNB, I_KVNW, I_WUK, I_WUV, I_ILNW, I_ILNB,
       I_WPA, I_WPB, I_WGATE, I_WOUT, I_NFW, I_WFI, I_CW, I_CB, I_WFO, I_NFIN };

template <int MODE>
__device__ __forceinline__ void tr_item(const float* W, int K, int N, int Npad, bf16_t* WT, LAS float* scr, int item, int lane) {
    const int nblk = Npad / 32, kb = item / nblk, nb = item % nblk, k0 = 64 * kb, n0 = 32 * nb;
    int s0 = n0; bool valid = n0 < N;
    if (MODE == 1) { const int T = n0 >> 8, w = n0 & 255; s0 = (w < 128) ? T * 128 + w : DFF + T * 128 + (w - 128); valid = true; }
    if (valid) {
#pragma unroll 8
        for (int i = 0; i < 32; ++i) { const int kk = 2 * i + (lane >> 5); scr[kk * 33 + (lane & 31)] = W[(size_t)(k0 + kk) * N + s0 + (lane & 31)]; }
    } else {
#pragma unroll 8
        for (int i = 0; i < 32; ++i) { const int kk = 2 * i + (lane >> 5); scr[kk * 33 + (lane & 31)] = 0.f; }
    }
    LDS_WAIT(); __builtin_amdgcn_wave_barrier();
    const int c = lane & 7;
#pragma unroll
    for (int j = 0; j < 4; ++j) { const int n = (lane >> 3) + 8 * j; const LAS float* s = scr + (8 * c) * 33 + n;
        u32x4 o; o.x = pk2(s[0 * 33], s[1 * 33]); o.y = pk2(s[2 * 33], s[3 * 33]); o.z = pk2(s[4 * 33], s[5 * 33]); o.w = pk2(s[6 * 33], s[7 * 33]);
        *(u32x4*)(WT + (size_t)(n0 + n) * K + k0 + 8 * c) = o; }
    LDS_WAIT(); __builtin_amdgcn_wave_barrier();
}
__device__ __forceinline__ void rms_row_bf16(const float* src, const float* w, bf16_t* dst, int lane, float eps) {
    if (src == nullptr) {
#pragma unroll
        for (int j = 0; j < 8; ++j) *(u32x4*)(dst + (j * 64 + lane) * 8) = (u32x4){0u, 0u, 0u, 0u};
        return;
    }
    f32x4 v[16]; float s = 0.f;
#pragma unroll
    for (int j = 0; j < 16; ++j) { v[j] = *(const f32x4*)(src + (j * 64 + lane) * 4); s += (v[j].x * v[j].x + v[j].y * v[j].y) + (v[j].z * v[j].z + v[j].w * v[j].w); }
    const float r = rsqrtf(wave_sum(s) * (1.f / D) + eps);
#pragma unroll
    for (int j = 0; j < 16; ++j) { const f32x4 g = *(const f32x4*)(w + (j * 64 + lane) * 4);
        u32x2 o; o.x = pk2(v[j].x * r * g.x, v[j].y * r * g.y); o.y = pk2(v[j].z * r * g.z, v[j].w * r * g.w);
        *(u32x2*)(dst + (j * 64 + lane) * 4) = o; }
}
__device__ __forceinline__ void p0_prologue(const P& p, LAS unsigned char* lds, int G) {
    const int tid = threadIdx.x, lane = tid & 63, wave = tid >> 6;
    LAS float* scr = (LAS float*)(lds + wave * 16384);
    const int gw = blockIdx.x * NWAVES + wave, NGW = G * NWAVES;
    unsigned char* ws = p.ws;
    constexpr int I0 = (4096 / 64) * (NZ / 32), I1 = (4096 / 64) * (8192 / 32), I2 = (2048 / 64) * (4096 / 32), I3 = I2, I4 = (4096 / 64) * (4096 / 32),
                  I5 = (4096 / 64) * (NFI / 32), I6 = (DFF / 64) * (4096 / 32);
    constexpr int NITEMS = I0 + I1 + I2 + I3 + I4 + I5 + I6;
    for (int it = gw; it < NITEMS; it += NGW) {
        int r = it;
        if (r < I0) { tr_item<0>(p.in[I_WIN], 4096, IN_COLS, NZ, (bf16_t*)(ws + WS_WINT), scr, r, lane); continue; } r -= I0;
        if (r < I1) { tr_item<0>(p.in[I_WGATE], 4096, 8192, 8192, (bf16_t*)(ws + WS_WGT), scr, r, lane); continue; } r -= I1;
        if (r < I2) { tr_item<0>(p.in[I_WPA], 2048, 4096, 4096, (bf16_t*)(ws + WS_WPAT), scr, r, lane); continue; } r -= I2;
        if (r < I3) { tr_item<0>(p.in[I_WPB], 2048, 4096, 4096, (bf16_t*)(ws + WS_WPBT), scr, r, lane); continue; } r -= I3;
        if (r < I4) { tr_item<0>(p.in[I_WOUT], 4096, 4096, 4096, (bf16_t*)(ws + WS_WOUTT), scr, r, lane); continue; } r -= I4;
        if (r < I5) { tr_item<1>(p.in[I_WFI], 4096, NFI, NFI, (bf16_t*)(ws + WS_WFIT), scr, r, lane); continue; } r -= I5;
        tr_item<0>(p.in[I_WFO], DFF, 4096, 4096, (bf16_t*)(ws + WS_WFOT), scr, r, lane);
    }
    for (int it = gw; it < 16 * 32; it += NGW) { const int hh = it >> 5;
        tr_item<0>(p.in[I_WUV] + (size_t)hh * KVR * HD_B, KVR, HD_B, HD_B, (bf16_t*)(ws + WS_WUVT) + (size_t)hh * HD_B * KVR, scr, it & 31, lane); }
    for (size_t i = (size_t)blockIdx.x * NT + threadIdx.x; i < (size_t)16 * 512 * 128 / 4; i += (size_t)G * NT) {
        const f32x4 v = *(const f32x4*)(p.in[I_WUK] + i * 4); u32x2 o; o.x = pk2(v.x, v.y); o.y = pk2(v.z, v.w); *(u32x2*)((bf16_t*)(ws + WS_WUKB) + i * 4) = o; }
    bf16_t* U = (bf16_t*)(ws + WS_U);
    for (int m = gw; m < MP; m += NGW) {
        const float* src = m < NMETA ? p.in[I_META] + (size_t)m * D : (m < L ? p.in[I_X] + (size_t)(m - NMETA) * D : nullptr);
        rms_row_bf16(src, p.in[I_NMW], U + (size_t)m * D, lane, 1e-6f);
    }
}

__device__ __forceinline__ void p2_rwkv_prep(const P& p, LAS unsigned char* lds, int G) {
    const int tid = threadIdx.x;
    const bf16_t* Z = (const bf16_t*)(p.ws + WS_Z);
    float* LDo = (float*)(p.ws + WS_LD); bf16_t* AAo = (bf16_t*)(p.ws + WS_AA); bf16_t* GGo = (bf16_t*)(p.ws + WS_GG);
    LAS float* sv = (LAS float*)lds;
    const float* mu = p.in[I_MU];
    for (int tile = blockIdx.x; tile < L / 16; tile += G) {
        const int t0 = tile * 16;
        __syncthreads();
        for (int idx = tid; idx < 16 * 448; idx += NT) {
            const int tok = idx / 448, j = idx % 448, col = 6144 + j, pp = t0 + tok;
            const float za = bf2f(Z[(size_t)pp * NZ + col]); const float pv = pp > 0 ? bf2f(Z[(size_t)(pp - 1) * NZ + col]) : 0.f;
            const float zs = za + (pv - za) * mu[col];
            const float val = j < 96 ? tanhf(zs) : (j < 192 ? zs : sigm(zs));
            sv[j * 16 + tok] = val;
        }
        __syncthreads();
        for (int ci = 0; ci < 4; ++ci) {
            const int c = tid + NT * ci;
            float aw[16], aa[16], ag[16];
#pragma unroll
            for (int k = 0; k < 16; ++k) { aw[k] = 0.f; aa[k] = 0.f; ag[k] = 0.f; }
            for (int j = 0; j < 96; ++j) {
                const float w2v = p.in[I_W2][(size_t)j * A_W + c], a2v = p.in[I_A2][(size_t)j * A_W + c];
#pragma unroll
                for (int q = 0; q < 4; ++q) { const f32x4 x = *(const LAS f32x4*)(sv + j * 16 + q * 4), y = *(const LAS f32x4*)(sv + (96 + j) * 16 + q * 4);
#pragma unroll
                    for (int e = 0; e < 4; ++e) { aw[q * 4 + e] += x[e] * w2v; aa[q * 4 + e] += y[e] * a2v; } }
            }
            for (int j = 0; j < 256; ++j) {
                const float g2v = p.in[I_G2][(size_t)j * A_W + c];
#pragma unroll
                for (int q = 0; q < 4; ++q) { const f32x4 x = *(const LAS f32x4*)(sv + (192 + j) * 16 + q * 4);
#pragma unroll
                    for (int e = 0; e < 4; ++e) ag[q * 4 + e] += x[e] * g2v; }
            }
            const float w0 = p.in[I_W0][c], a0 = p.in[I_A0][c];
            float cs = 0.f;
#pragma unroll
            for (int k = 0; k < 16; ++k) {
                const float xx = -(w0 + aw[k]);
                const float sp = xx > 20.f ? xx : log1pf(__expf(xx));
                const float w = -sp - 0.5f;
                const size_t o = (size_t)(t0 + k) * A_W + c;
                cs -= __expf(w);
                LDo[o] = cs;
                AAo[o] = f2bf(sigm(a0 + aa[k]));
                GGo[o] = f2bf(ag[k]);
            }
        }
    }
}


typedef short bf16x8_t __attribute__((ext_vector_type(8)));
constexpr int NCHUNK = 257, NITEM = NCHUNK * 32, RS = 72, SLOT = 64 * RS * 2;
constexpr int GAM_OFF = 15 * SLOT;
constexpr size_t GTP_OFF = 0, HT_OFF = (size_t)8192 * 8192;
typedef __bf16 bf16x2v_t __attribute__((ext_vector_type(2)));
typedef float f32x2v_t __attribute__((ext_vector_type(2)));
__device__ __forceinline__ unsigned cvtpk(float lo, float hi) { const f32x2v_t v = {lo, hi}; const bf16x2v_t b = __builtin_convertvector(v, bf16x2v_t); return __builtin_bit_cast(unsigned, b); }
__device__ __forceinline__ void mm2(const LAS bf16_t* X, const LAS bf16_t* Y, int tm, int tn0, int r, int q, f32x4& c0, f32x4& c1) {
#pragma unroll
    for (int s = 0; s < 2; ++s) {
        const bf16x8_t a = *(const LAS bf16x8_t*)(X + (tm * 16 + r) * RS + s * 32 + q * 8);
        const bf16x8_t b0 = *(const LAS bf16x8_t*)(Y + (tn0 * 16 + r) * RS + s * 32 + q * 8);
        const bf16x8_t b1 = *(const LAS bf16x8_t*)(Y + ((tn0 + 1) * 16 + r) * RS + s * 32 + q * 8);
        c0 = __builtin_amdgcn_mfma_f32_16x16x32_bf16(a, b0, c0, 0, 0, 0);
        c1 = __builtin_amdgcn_mfma_f32_16x16x32_bf16(a, b1, c1, 0, 0, 0);
    }
}
__device__ __forceinline__ void st_cheap(LAS bf16_t* B, int m0, int n, const f32x4& c) {
    u32x2 w; w.x = cvtpk(c[0], c[1]); w.y = cvtpk(c[2], c[3]); *(LAS u32x2*)(B + n * RS + m0) = w;
}
__device__ __forceinline__ void st_scat(LAS bf16_t* B, int m0, int n, const f32x4& c) {
#pragma unroll
    for (int e = 0; e < 4; ++e) B[(m0 + e) * RS + n] = f2bf(c[e]);
}
__device__ __forceinline__ void tr2(const LAS bf16_t* X, LAS bf16_t* Xt, int tm, int tn0, int r16, int q) {
#pragma unroll
    for (int j2 = 0; j2 < 2; ++j2) {
        const int tn = tn0 + j2, s = tn >> 1, n = tn * 16 + r16;
        bf16x8_t idf;
#pragma unroll
        for (int j = 0; j < 8; ++j) idf[j] = (n == s * 32 + q * 8 + j) ? (short)0x3F80 : (short)0;
        const bf16x8_t a = *(const LAS bf16x8_t*)(X + (tm * 16 + r16) * RS + s * 32 + q * 8);
        f32x4 c = {0.f, 0.f, 0.f, 0.f};
        c = __builtin_amdgcn_mfma_f32_16x16x32_bf16(a, idf, c, 0, 0, 0);
        st_cheap(Xt, tm * 16 + q * 4, n, c);
    }
}
template <int CTRL> __device__ __forceinline__ float dpp_add(float v) { return v + dpp_f<CTRL>(v); }
__device__ __forceinline__ float sum8(float v) { v = dpp_add<0xB1>(v); v = dpp_add<0x4E>(v); v = dpp_add<0x141>(v); return v; }

__device__ __forceinline__ void ra_items(const P& p, LAS unsigned char* lds, int G) {
    const int tid = threadIdx.x, lane = tid & 63, wave = __builtin_amdgcn_readfirstlane(tid >> 6), r16 = lane & 15, q = lane >> 4;
    const int tm = wave >> 1, tn0 = (wave & 1) * 2;
    const bf16_t* Z = (const bf16_t*)(p.ws + WS_Z); const float* CS = (const float*)(p.ws + WS_LD); const bf16_t* AAi = (const bf16_t*)(p.ws + WS_AA);
    bf16_t* GTP = (bf16_t*)((unsigned char*)p.out + GTP_OFF); float* HT = (float*)((unsigned char*)p.out + HT_OFF);
    bf16_t* PPo = (bf16_t*)(p.ws + WS_YB); bf16_t* Y0o = (bf16_t*)(p.ws + WS_YA); float* BS = (float*)(p.ws + WS_BS);
    LAS bf16_t* sl[15];
#pragma unroll
    for (int i = 0; i < 15; ++i) sl[i] = (LAS bf16_t*)(lds + i * SLOT);
    LAS float* gam = (LAS float*)(lds + GAM_OFF);
    LAS bf16_t *Al_r = sl[0], *Be_r = sl[1], *Ka_r = sl[2], *Al_t = sl[3], *Be_t = sl[4], *Ka_t = sl[5], *Rh_r = sl[6], *V_t = sl[7];
    LAS bf16_t *N_r = sl[8], *N_t = sl[9], *LAK = sl[10], *MRK = sl[11], *MRB = sl[12], *Q_t = sl[13], *T_a = sl[14], *T_b = sl[0], *Q_r = sl[1];
    LAS bf16_t *W_t = sl[8], *X1_t = sl[9], *U0_t = sl[1];
    for (int item = blockIdx.x; item < NITEM; item += G) {
        const int ch = item >> 5, h = item & 31;
        __syncthreads();
        {
            const int t = tid >> 3, k8 = (tid & 7) * 8, tg = ch * 64 + t, c0 = h * 64 + k8;
            float Av[8], Bv[8], Kv[8], Rv[8], Vv[8];
            if (tg < L) {
                const bf16_t* zr = Z + (size_t)tg * NZ + c0;
                const u32x4 r0 = *(const u32x4*)zr, k0 = *(const u32x4*)(zr + 2048), v0 = *(const u32x4*)(zr + 4096);
                u32x4 r1 = (u32x4){0u, 0u, 0u, 0u}, k1 = r1, v1 = r1;
                if (tg > 0) { r1 = *(const u32x4*)(zr - NZ); k1 = *(const u32x4*)(zr - NZ + 2048); v1 = *(const u32x4*)(zr - NZ + 4096); }
                const u32x4 a0 = *(const u32x4*)(AAi + (size_t)tg * A_W + c0);
                float lc[8], lx[8];
                {
                    const float* cs = CS + (size_t)tg * A_W + c0;
                    const f32x4 c0v = *(const f32x4*)cs, c1v = *(const f32x4*)(cs + 4);
                    float base[8];
#pragma unroll
                    for (int e = 0; e < 8; ++e) base[e] = 0.f;
                    for (int b = 0; b < (t >> 4); ++b) { const float* ce = CS + (size_t)(ch * 64 + b * 16 + 15) * A_W + c0; const f32x4 x0 = *(const f32x4*)ce, x1 = *(const f32x4*)(ce + 4);
#pragma unroll
                        for (int e = 0; e < 4; ++e) { base[e] += x0[e]; base[4 + e] += x1[e]; } }
                    f32x4 p0 = (f32x4){0.f, 0.f, 0.f, 0.f}, p1 = p0;
                    if ((t & 15) != 0) { p0 = *(const f32x4*)(cs - A_W); p1 = *(const f32x4*)(cs - A_W + 4); }
#pragma unroll
                    for (int e = 0; e < 4; ++e) { lc[e] = base[e] + c0v[e]; lc[4 + e] = base[4 + e] + c1v[e]; lx[e] = base[e] + p0[e]; lx[4 + e] = base[4 + e] + p1[e]; }
                }
                const unsigned rw[4] = {r0.x, r0.y, r0.z, r0.w}, kw[4] = {k0.x, k0.y, k0.z, k0.w}, vw[4] = {v0.x, v0.y, v0.z, v0.w};
                const unsigned rp[4] = {r1.x, r1.y, r1.z, r1.w}, kq[4] = {k1.x, k1.y, k1.z, k1.w}, vq[4] = {v1.x, v1.y, v1.z, v1.w}, aw[4] = {a0.x, a0.y, a0.z, a0.w};
                float rr[8], kk[8], kp[8], aa[8]; float ss = 0.f, bs = 0.f;
#pragma unroll
                for (int e = 0; e < 8; ++e) {
                    const int c = c0 + e; const int wi = e >> 1; const bool hi = e & 1;
                    const float zr_ = hi ? bhi(rw[wi]) : blo(rw[wi]), zk_ = hi ? bhi(kw[wi]) : blo(kw[wi]), zv_ = hi ? bhi(vw[wi]) : blo(vw[wi]);
                    const float pr_ = hi ? bhi(rp[wi]) : blo(rp[wi]), pk_ = hi ? bhi(kq[wi]) : blo(kq[wi]), pv_ = hi ? bhi(vq[wi]) : blo(vq[wi]);
                    aa[e] = hi ? bhi(aw[wi]) : blo(aw[wi]);
                    rr[e] = zr_ + (pr_ - zr_) * p.in[I_MU][c]; const float k_ = zk_ + (pk_ - zk_) * p.in[I_MU][2048 + c]; Vv[e] = zv_ + (pv_ - zv_) * p.in[I_MU][4096 + c];
                    kk[e] = k_ * p.in[I_KK][c]; ss += kk[e] * kk[e];
                    kp[e] = k_ * (1.f + (aa[e] - 1.f) * p.in[I_KA][c]);
                    bs += rr[e] * kp[e] * p.in[I_RK][c];
                }
                ss = sum8(ss); bs = sum8(bs);
                const float rn = rsqrtf(ss + 1e-12f);
                if ((tid & 7) == 0) BS[(size_t)tg * 32 + h] = bs;
#pragma unroll
                for (int e = 0; e < 8; ++e) {
                    const float kn = kk[e] * rn; const float ex = __expf(lx[e]), em = __expf(-lc[e]), ep = __expf(lc[e]);
                    Av[e] = kn * ex; Bv[e] = kn * aa[e] * em; Kv[e] = kp[e] * em; Rv[e] = rr[e] * ep;
                }
                if (t == 63) {
#pragma unroll
                    for (int e = 0; e < 8; ++e) gam[k8 + e] = __expf(lc[e]);
                }
            } else {
#pragma unroll
                for (int e = 0; e < 8; ++e) { Av[e] = 0.f; Bv[e] = 0.f; Kv[e] = 0.f; Rv[e] = 0.f; Vv[e] = 0.f; }
                if (t == 63) {
                    const float* ce = CS + (size_t)(L - 1) * A_W + c0;
#pragma unroll
                    for (int e = 0; e < 8; ++e) gam[k8 + e] = __expf(ce[e]);
                }
            }
            u32x4 w;
            w.x = cvtpk(Av[0], Av[1]); w.y = cvtpk(Av[2], Av[3]); w.z = cvtpk(Av[4], Av[5]); w.w = cvtpk(Av[6], Av[7]); *(LAS u32x4*)(Al_r + t * RS + k8) = w;
            w.x = cvtpk(Bv[0], Bv[1]); w.y = cvtpk(Bv[2], Bv[3]); w.z = cvtpk(Bv[4], Bv[5]); w.w = cvtpk(Bv[6], Bv[7]); *(LAS u32x4*)(Be_r + t * RS + k8) = w;
            w.x = cvtpk(Kv[0], Kv[1]); w.y = cvtpk(Kv[2], Kv[3]); w.z = cvtpk(Kv[4], Kv[5]); w.w = cvtpk(Kv[6], Kv[7]); *(LAS u32x4*)(Ka_r + t * RS + k8) = w;
            w.x = cvtpk(Rv[0], Rv[1]); w.y = cvtpk(Rv[2], Rv[3]); w.z = cvtpk(Rv[4], Rv[5]); w.w = cvtpk(Rv[6], Rv[7]); *(LAS u32x4*)(Rh_r + t * RS + k8) = w;
            w.x = cvtpk(Vv[0], Vv[1]); w.y = cvtpk(Vv[2], Vv[3]); w.z = cvtpk(Vv[4], Vv[5]); w.w = cvtpk(Vv[6], Vv[7]); *(LAS u32x4*)(T_a + t * RS + k8) = w;
        }
        __syncthreads();
        tr2(Al_r, Al_t, tm, tn0, r16, q); tr2(Be_r, Be_t, tm, tn0, r16, q); tr2(Ka_r, Ka_t, tm, tn0, r16, q); tr2(T_a, V_t, tm, tn0, r16, q);
        __syncthreads();
        {
            f32x4 cab0 = {0.f, 0.f, 0.f, 0.f}, cab1 = cab0, cak0 = cab0, cak1 = cab0, crk0 = cab0, crk1 = cab0, crb0 = cab0, crb1 = cab0;
            f32x4 cba0 = cab0, cba1 = cab0;
            mm2(Al_r, Be_r, tm, tn0, r16, q, cba0, cba1);
            mm2(Be_r, Al_r, tm, tn0, r16, q, cab0, cab1); mm2(Ka_r, Al_r, tm, tn0, r16, q, cak0, cak1);
            mm2(Ka_r, Rh_r, tm, tn0, r16, q, crk0, crk1); mm2(Be_r, Rh_r, tm, tn0, r16, q, crb0, crb1);
            const int s0 = tm * 16 + q * 4;
#pragma unroll
            for (int j = 0; j < 2; ++j) {
                const int t = (tn0 + j) * 16 + r16;
                f32x4 ab = j ? cab1 : cab0, ak = j ? cak1 : cak0, rk = j ? crk1 : crk0, rb = j ? crb1 : crb0, nn, t0;
#pragma unroll
                for (int e = 0; e < 4; ++e) { const int s = s0 + e; nn[e] = s < t ? -ab[e] : 0.f; t0[e] = nn[e] + (s == t ? 1.f : 0.f); ak[e] = s < t ? ak[e] : 0.f; rk[e] = s <= t ? rk[e] : 0.f; rb[e] = s <= t ? rb[e] : 0.f; }
                {   const int sT = (tn0 + j) * 16 + r16; f32x4 ba = j ? cba1 : cba0, nt;
#pragma unroll
                    for (int e = 0; e < 4; ++e) nt[e] = sT < s0 + e ? -ba[e] : 0.f;
                    st_cheap(N_t, s0, sT, nt); }
                st_cheap(N_r, s0, t, nn); st_cheap(T_a, s0, t, t0); st_cheap(LAK, s0, t, ak); st_cheap(MRK, s0, t, rk); st_cheap(MRB, s0, t, rb);
            }
        }
        __syncthreads();
        {
            LAS bf16_t* Pr = N_r; LAS bf16_t* Pt = N_t; LAS bf16_t* Qr = Q_r; LAS bf16_t* Qt = Q_t; LAS bf16_t* Tc = T_a; LAS bf16_t* Tn = T_b;
#pragma unroll 1
            for (int it = 0; it < 5; ++it) {
                {   f32x4 c0 = {0.f, 0.f, 0.f, 0.f}, c1 = c0;
                    mm2(Pr, Pt, tm, tn0, r16, q, c0, c1);
                    const int m0 = tm * 16 + q * 4;
                    st_cheap(Qt, m0, tn0 * 16 + r16, c0); st_cheap(Qt, m0, (tn0 + 1) * 16 + r16, c1);
                    f32x4 d0 = {0.f, 0.f, 0.f, 0.f}, d1 = d0;
                    mm2(Pt, Pr, tm, tn0, r16, q, d0, d1);
                    st_cheap(Qr, m0, tn0 * 16 + r16, d0); st_cheap(Qr, m0, (tn0 + 1) * 16 + r16, d1); }
                __syncthreads();
                {   f32x4 c0 = {0.f, 0.f, 0.f, 0.f}, c1 = c0;
                    mm2(Qt, Tc, tm, tn0, r16, q, c0, c1);
                    const int b0 = tm * 16 + q * 4;
#pragma unroll
                    for (int j = 0; j < 2; ++j) { const int a = (tn0 + j) * 16 + r16; const u32x2 o = *(const LAS u32x2*)(Tc + a * RS + b0); f32x4 c = j ? c1 : c0;
                        c[0] += blo(o.x); c[1] += bhi(o.x); c[2] += blo(o.y); c[3] += bhi(o.y); st_cheap(Tn, b0, a, c); } }
                __syncthreads();
                LAS bf16_t* x = Pr; Pr = Qr; Qr = x; x = Pt; Pt = Qt; Qt = x; x = Tc; Tc = Tn; Tn = x;
            }
        }
        {
            f32x4 c0 = {0.f, 0.f, 0.f, 0.f}, c1 = c0, d0 = c0, d1 = c0;
            mm2(T_b, Al_t, tm, tn0, r16, q, c0, c1);
            mm2(LAK, V_t, tm, tn0, r16, q, d0, d1);
            const int t0 = tm * 16 + q * 4;
            st_cheap(W_t, t0, tn0 * 16 + r16, c0); st_cheap(W_t, t0, (tn0 + 1) * 16 + r16, c1);
            st_cheap(X1_t, t0, tn0 * 16 + r16, d0); st_cheap(X1_t, t0, (tn0 + 1) * 16 + r16, d1);
        }
        __syncthreads();
        {
            f32x4 c0 = {0.f, 0.f, 0.f, 0.f}, c1 = c0;
            mm2(T_b, X1_t, tm, tn0, r16, q, c0, c1);
            const int t0 = tm * 16 + q * 4;
            st_cheap(U0_t, t0, tn0 * 16 + r16, c0); st_cheap(U0_t, t0, (tn0 + 1) * 16 + r16, c1);
        }
        __syncthreads();
        {
            const int m0 = tm * 16 + q * 4;
            if (ch < 256) {
                f32x4 g0 = {0.f, 0.f, 0.f, 0.f}, g1 = g0, h0 = g0, h1 = g0, u0 = g0, u1 = g0;
                mm2(W_t, Be_t, tm, tn0, r16, q, g0, g1);
                mm2(Ka_t, V_t, tm, tn0, r16, q, h0, h1);
                mm2(Be_t, U0_t, tm, tn0, r16, q, u0, u1);
                const size_t it8 = (size_t)item;
#pragma unroll
                for (int j = 0; j < 2; ++j) {
                    const int n = (tn0 + j) * 16 + r16; const f32x4 g = j ? g1 : g0; const float gc = gam[n];
                    f32x4 o;
#pragma unroll
                    for (int e = 0; e < 4; ++e) o[e] = ((m0 + e == n ? 1.f : 0.f) - g[e]) * gc;
                    u32x2 w; w.x = cvtpk(o[0], o[1]); w.y = cvtpk(o[2], o[3]);
                    *(u32x2*)(GTP + it8 * 4096 + (size_t)n * 64 + 32 * (tm >> 1) + 8 * q + 4 * (tm & 1)) = w;
                    const f32x4 hh = (j ? h1 : h0) - (j ? u1 : u0);
                    const f32x4 gk = *(const LAS f32x4*)(gam + m0);
                    *(f32x4*)(HT + (it8 * 16 + tm * 4 + (tn0 + j)) * 256 + lane * 4) = hh * gk;
                }
            }
            f32x4 p0 = {0.f, 0.f, 0.f, 0.f}, p1 = p0, y0 = p0, y1 = p0, z0 = p0, z1 = p0;
            mm2(W_t, MRB, tm, tn0, r16, q, p0, p1);
            mm2(V_t, MRK, tm, tn0, r16, q, y0, y1);
            mm2(U0_t, MRB, tm, tn0, r16, q, z0, z1);
#pragma unroll
            for (int j = 0; j < 2; ++j) {
                const int t = (tn0 + j) * 16 + r16, tg = ch * 64 + t;
                const u32x2 o = *(const LAS u32x2*)(Rh_r + t * RS + m0); const f32x4 pm = j ? p1 : p0;
                u32x2 w; w.x = cvtpk(blo(o.x) - pm[0], bhi(o.x) - pm[1]); w.y = cvtpk(blo(o.y) - pm[2], bhi(o.y) - pm[3]);
                *(u32x2*)(PPo + (size_t)item * 4096 + t * 64 + m0) = w;
                if (tg < L) { const f32x4 yy = (j ? y1 : y0) - (j ? z1 : z0); u32x2 wy; wy.x = cvtpk(yy[0], yy[1]); wy.y = cvtpk(yy[2], yy[3]);
                    *(u32x2*)(Y0o + (size_t)tg * A_W + h * 64 + m0) = wy; }
            }
        }
    }
}

__device__ __forceinline__ void rb_chain(const P& p, int G) {
    const int tid = threadIdx.x, lane = tid & 63, wave = __builtin_amdgcn_readfirstlane(tid >> 6), r16 = lane & 15, q = lane >> 4;
    const int cw = blockIdx.x;
    if (cw < 128 && wave == 0) {
        const int h = cw >> 2, vg = cw & 3;
        const bf16_t* GTP = (const bf16_t*)((const unsigned char*)p.out + GTP_OFF); const float* HT = (const float*)((const unsigned char*)p.out + HT_OFF);
        bf16_t* ST = (bf16_t*)(p.ws + WS_ST);
        f32x4 acc[4];
#pragma unroll
        for (int i = 0; i < 4; ++i) acc[i] = (f32x4){0.f, 0.f, 0.f, 0.f};
        bf16x8_t ga[4][2]; f32x4 hv[4];
        {   const size_t it8 = (size_t)h;
#pragma unroll
            for (int i = 0; i < 4; ++i) { hv[i] = *(const f32x4*)(HT + (it8 * 16 + i * 4 + vg) * 256 + lane * 4);
#pragma unroll
                for (int s = 0; s < 2; ++s) ga[i][s] = *(const bf16x8_t*)(GTP + it8 * 4096 + (size_t)(i * 16 + r16) * 64 + s * 32 + q * 8); } }
#pragma unroll 1
        for (int c = 0; c < NCHUNK; ++c) {
            const size_t item = (size_t)c * 32 + h;
            bf16x8_t bfr[2];
            {   unsigned w[8];
#pragma unroll
                for (int i = 0; i < 4; ++i) { w[2 * i] = cvtpk(acc[i][0], acc[i][1]); w[2 * i + 1] = cvtpk(acc[i][2], acc[i][3]);
                    u32x2 o; o.x = w[2 * i]; o.y = w[2 * i + 1]; *(u32x2*)(ST + item * 4096 + (size_t)(vg * 16 + r16) * 64 + i * 16 + q * 4) = o; }
                u32x4 b0 = (u32x4){w[0], w[1], w[2], w[3]}, b1 = (u32x4){w[4], w[5], w[6], w[7]};
                bfr[0] = __builtin_bit_cast(bf16x8_t, b0); bfr[1] = __builtin_bit_cast(bf16x8_t, b1); }
            if (c == NCHUNK - 1) break;
            bf16x8_t gn[4][2]; f32x4 hn[4];
            if (c + 1 < 256) { const size_t it8 = (size_t)(c + 1) * 32 + h;
#pragma unroll
                for (int i = 0; i < 4; ++i) { hn[i] = *(const f32x4*)(HT + (it8 * 16 + i * 4 + vg) * 256 + lane * 4);
#pragma unroll
                    for (int s = 0; s < 2; ++s) gn[i][s] = *(const bf16x8_t*)(GTP + it8 * 4096 + (size_t)(i * 16 + r16) * 64 + s * 32 + q * 8); } }
            else {
#pragma unroll
                for (int i = 0; i < 4; ++i) { hn[i] = hv[i]; gn[i][0] = ga[i][0]; gn[i][1] = ga[i][1]; } }
#pragma unroll
            for (int i = 0; i < 4; ++i) { f32x4 a = hv[i];
                a = __builtin_amdgcn_mfma_f32_16x16x32_bf16(ga[i][0], bfr[0], a, 0, 0, 0);
                a = __builtin_amdgcn_mfma_f32_16x16x32_bf16(ga[i][1], bfr[1], a, 0, 0, 0);
                acc[i] = a; }
#pragma unroll
            for (int i = 0; i < 4; ++i) { hv[i] = hn[i]; ga[i][0] = gn[i][0]; ga[i][1] = gn[i][1]; }
        }
    }
}

__device__ __forceinline__ void rc_out(const P& p, int G) {
    const int tid = threadIdx.x, lane = tid & 63, wave = __builtin_amdgcn_readfirstlane(tid >> 6), r16 = lane & 15, q = lane >> 4;
    const bf16_t* Z = (const bf16_t*)(p.ws + WS_Z); const bf16_t* GGi = (const bf16_t*)(p.ws + WS_GG); const float* BS = (const float*)(p.ws + WS_BS);
    const bf16_t* ST = (const bf16_t*)(p.ws + WS_ST); const bf16_t* PPi = (const bf16_t*)(p.ws + WS_YB); bf16_t* YA = (bf16_t*)(p.ws + WS_YA);
    for (size_t i = (size_t)blockIdx.x * NT + tid; i < (size_t)(MP - L) * A_W / 8; i += (size_t)G * NT) *(u32x4*)(YA + (size_t)L * A_W + i * 8) = (u32x4){0u, 0u, 0u, 0u};
    const int tt = wave & 3;
    for (int item = blockIdx.x * 2 + (wave >> 2); item < NITEM; item += 2 * G) {
        const int ch = item >> 5, h = item & 31;
        const int t = tt * 16 + r16, tg = ch * 64 + t;
        f32x4 acc[4];
#pragma unroll
        for (int i = 0; i < 4; ++i) acc[i] = (f32x4){0.f, 0.f, 0.f, 0.f};
        const bf16_t* sp = ST + (size_t)item * 4096; const bf16_t* pp = PPi + (size_t)item * 4096 + (size_t)t * 64;
#pragma unroll
        for (int s = 0; s < 2; ++s) {
            const bf16x8_t b = *(const bf16x8_t*)(pp + s * 32 + q * 8);
#pragma unroll
            for (int i = 0; i < 4; ++i) { const bf16x8_t a = *(const bf16x8_t*)(sp + (size_t)(i * 16 + r16) * 64 + s * 32 + q * 8);
                acc[i] = __builtin_amdgcn_mfma_f32_16x16x32_bf16(a, b, acc[i], 0, 0, 0); }
        }
        if (tg < L) {
            float s1 = 0.f;
#pragma unroll
            for (int i = 0; i < 4; ++i) { const u32x2 y0 = *(const u32x2*)(YA + (size_t)tg * A_W + h * 64 + i * 16 + q * 4);
                acc[i][0] += blo(y0.x); acc[i][1] += bhi(y0.x); acc[i][2] += blo(y0.y); acc[i][3] += bhi(y0.y);
                s1 += (acc[i][0] + acc[i][1]) + (acc[i][2] + acc[i][3]); }
            s1 += __shfl_xor(s1, 16); s1 += __shfl_xor(s1, 32);
            const float mean = s1 * (1.f / 64.f);
            float s2 = 0.f;
#pragma unroll
            for (int i = 0; i < 4; ++i)
#pragma unroll
                for (int e = 0; e < 4; ++e) { const float d = acc[i][e] - mean; s2 += d * d; }
            s2 += __shfl_xor(s2, 16); s2 += __shfl_xor(s2, 32);
            const float rstd = rsqrtf(s2 * (1.f / 64.f) + 64e-5f);
            const float bs = BS[(size_t)tg * 32 + h];
#pragma unroll
            for (int i = 0; i < 4; ++i) {
                const int c = h * 64 + i * 16 + q * 4;
                const u32x2 zv = *(const u32x2*)(Z + (size_t)tg * NZ + 4096 + c);
                u32x2 pv = (u32x2){0u, 0u}; if (tg > 0) pv = *(const u32x2*)(Z + (size_t)(tg - 1) * NZ + 4096 + c);
                const u32x2 gg = *(const u32x2*)(GGi + (size_t)tg * A_W + c);
                const f32x4 lw = *(const f32x4*)(p.in[I_LNW] + c), lb = *(const f32x4*)(p.in[I_LNB] + c), mv = *(const f32x4*)(p.in[I_MU] + 4096 + c);
                const float zz[4] = {blo(zv.x), bhi(zv.x), blo(zv.y), bhi(zv.y)}, pz[4] = {blo(pv.x), bhi(pv.x), blo(pv.y), bhi(pv.y)}, gv[4] = {blo(gg.x), bhi(gg.x), blo(gg.y), bhi(gg.y)};
                float o[4];
#pragma unroll
                for (int e = 0; e < 4; ++e) { const float vv = zz[e] + (pz[e] - zz[e]) * mv[e]; const float yn = (acc[i][e] - mean) * rstd * lw[e] + lb[e]; o[e] = (yn + bs * vv) * gv[e]; }
                u32x2 w; w.x = cvtpk(o[0], o[1]); w.y = cvtpk(o[2], o[3]);
                *(u32x2*)(YA + (size_t)tg * A_W + c) = w;
            }
        }
    }
}


__device__ __forceinline__ void p4_dsa_prep(const P& p, int G) {
    const int tid = threadIdx.x, lane = tid & 63, wave = tid >> 6;
    const bf16_t* Z = (const bf16_t*)(p.ws + WS_Z);
    bf16_t* CKV = (bf16_t*)(p.ws + WS_CKV); float* KIDX = (float*)(p.ws + WS_KIDX);
    for (int t = blockIdx.x * NWAVES + wave; t < L; t += G * NWAVES) {
        const u32x4 raw = *(const u32x4*)(Z + (size_t)t * NZ + ZCKV + lane * 8);
        float x[8] = {blo(raw.x), bhi(raw.x), blo(raw.y), bhi(raw.y), blo(raw.z), bhi(raw.z), blo(raw.w), bhi(raw.w)};
        float s = 0.f;
#pragma unroll
        for (int e = 0; e < 8; ++e) s += x[e] * x[e];
        const float r = rsqrtf(wave_sum(s) * (1.f / KVR) + 1e-6f);
        const f32x4 w0 = *(const f32x4*)(p.in[I_KVNW] + lane * 8), w1 = *(const f32x4*)(p.in[I_KVNW] + lane * 8 + 4);
        u32x4 o; o.x = pk2(x[0] * r * w0.x, x[1] * r * w0.y); o.y = pk2(x[2] * r * w0.z, x[3] * r * w0.w); o.z = pk2(x[4] * r * w1.x, x[5] * r * w1.y); o.w = pk2(x[6] * r * w1.z, x[7] * r * w1.w);
        *(u32x4*)(CKV + (size_t)t * KVR + lane * 8) = o;
        const float ki = bf2f(Z[(size_t)t * NZ + ZKI + lane]);
        const float mean = wave_sum(ki) * (1.f / 64.f), dk = ki - mean, var = wave_sum(dk * dk) * (1.f / 64.f);
        const float kn_ = dk * rsqrtf(var + 1e-6f) * p.in[I_ILNW][lane] + p.in[I_ILNB][lane];
        KIDX[(size_t)t * IDXD + lane] = kn_;
        ((bf16_t*)(p.ws + WS_KIDXB))[(size_t)t * IDXD + lane] = f2bf(kn_);
    }
}

__device__ __forceinline__ unsigned fkey(float f) { const unsigned u = __float_as_uint(f); return (u & 0x80000000u) ? ~u : (u | 0x80000000u); }

typedef float f32x16 __attribute__((ext_vector_type(16)));
constexpr int SCR_N = 16416;
__device__ __forceinline__ unsigned lds_add(LAS unsigned* p, unsigned v) { return __hip_atomic_fetch_add(p, v, __ATOMIC_RELAXED, __HIP_MEMORY_SCOPE_WORKGROUP); }
constexpr int KST = 72;
template <int NBL> __device__ __forceinline__ void wfind(const LAS unsigned* hist, unsigned target, int lane, unsigned& b, unsigned& ab) {
    unsigned loc[NBL]; unsigned s = 0;
#pragma unroll
    for (int j = 0; j < NBL; j += 4) { const u32x4 v4 = *(const LAS u32x4*)(hist + lane * NBL + j); loc[j] = v4.x; loc[j + 1] = v4.y; loc[j + 2] = v4.z; loc[j + 3] = v4.w; s += (v4.x + v4.y) + (v4.z + v4.w); }
    unsigned v = s;
#pragma unroll
    for (int d = 1; d < 64; d <<= 1) { const unsigned o = (unsigned)__shfl_down((int)v, d); if (lane + d < 64) v += o; }
    const unsigned above = v - s;
    const bool found = above < target && above + s >= target;
    unsigned bb = 0u, aa = 0u;
    if (found) { unsigned a = above;
#pragma unroll
        for (int j = NBL - 1; j >= 0; --j) { if (a < target && a + loc[j] >= target) { bb = (unsigned)(lane * NBL + j); aa = a; } a += loc[j]; } }
    const unsigned long long m = __ballot(found);
    const int src = m ? (int)__builtin_ctzll(m) : 0;
    b = (unsigned)__shfl((int)bb, src); ab = (unsigned)__shfl((int)aa, src);
}
__device__ __forceinline__ void d2_topk(const P& p, LAS unsigned char* lds, int G) {
    const int tid = threadIdx.x, lane = tid & 63, wave = __builtin_amdgcn_readfirstlane(tid >> 6);
    const bf16_t* Z = (const bf16_t*)(p.ws + WS_Z); const bf16_t* KB = (const bf16_t*)(p.ws + WS_KIDXB); int* SEL = (int*)(p.ws + WS_SEL);
    float* scr = (float*)(p.ws + WS_R1) + ((size_t)blockIdx.x * NWAVES + wave) * 2 * SCR_N;
    LAS bf16_t* ksb = (LAS bf16_t*)lds;
    LAS unsigned* hw = (LAS unsigned*)(lds + 73728) + wave * 2048;
    const int key_l = lane & 31, hh = lane >> 5;
    for (int t = blockIdx.x; t < NMETA + 192; t += G) { const int n = t < NMETA ? NMETA : NMETA + 64 * (1 + (t - NMETA) / 64);
        if (tid < TOPK) SEL[(size_t)t * TOPK + tid] = tid < n ? tid : -1; }
    const int nui = (G == 256) ? 4 : (1012 + G - 1) / G;
    for (int ui = 0; ui < nui; ++ui) {
        int i = (int)blockIdx.x + ui * G;
        if (G == 256) i = ui == 0 ? (int)blockIdx.x : (ui == 1 ? 511 - (int)blockIdx.x : (ui == 2 ? 512 + (int)blockIdx.x : 1023 - (int)blockIdx.x));
        if (i >= 1012) continue;
        const int c = 256 - (i >> 2), r = i & 3, n = NMETA + 64 * c;
        const int tA = NMETA + 64 * (c - 1) + 16 * r + 2 * wave;
        bf16x8_t af[2][4]; float wv[2][16];
#pragma unroll
        for (int qq = 0; qq < 2; ++qq) {
            const bf16_t* zr = Z + (size_t)(tA + qq) * NZ;
#pragma unroll
            for (int ks = 0; ks < 4; ++ks) af[qq][ks] = *(const bf16x8_t*)(zr + ZQI + key_l * 64 + ks * 16 + hh * 8);
#pragma unroll
            for (int g = 0; g < 4; ++g) { const u32x2 w2 = *(const u32x2*)(zr + ZWI + 8 * g + 4 * hh);
                wv[qq][g * 4 + 0] = blo(w2.x) * 0.02209708691207961f; wv[qq][g * 4 + 1] = bhi(w2.x) * 0.02209708691207961f;
                wv[qq][g * 4 + 2] = blo(w2.y) * 0.02209708691207961f; wv[qq][g * 4 + 3] = bhi(w2.y) * 0.02209708691207961f; }
        }
#pragma unroll
        for (int j = 0; j < 8; ++j) *(LAS u32x4*)(hw + (j * 64 + lane) * 4) = (u32x4){0u, 0u, 0u, 0u};
        const int nblk = (n + 255) >> 8;
        __syncthreads();
        {
            const int kk = tid >> 1, hf = tid & 1; const int src = kk < n ? kk : n - 1;
            const u32x4* gp = (const u32x4*)(KB + (size_t)src * IDXD + hf * 32);
#pragma unroll
            for (int j = 0; j < 4; ++j) *(LAS u32x4*)(ksb + kk * KST + hf * 32 + j * 8) = gp[j];
        }
        __syncthreads();
        for (int b = 0; b < nblk; ++b) {
            u32x4 pre[4];
            const bool more = b + 1 < nblk;
            if (more) { const int kk = (b + 1) * 256 + (tid >> 1); const int src = kk < n ? kk : n - 1; const u32x4* gp = (const u32x4*)(KB + (size_t)src * IDXD + (tid & 1) * 32);
#pragma unroll
                for (int j = 0; j < 4; ++j) pre[j] = gp[j]; }
            const LAS bf16_t* kb = ksb + (b & 1) * 256 * KST;
#pragma unroll 2
            for (int tt = 0; tt < 8; ++tt) {
                const int s0 = b * 256 + tt * 32;
                if (s0 < n) {
                    bf16x8_t bfr[4];
#pragma unroll
                    for (int ks = 0; ks < 4; ++ks) bfr[ks] = *(const LAS bf16x8_t*)(kb + (tt * 32 + key_l) * KST + ks * 16 + hh * 8);
                    float part[2];
#pragma unroll
                    for (int qq = 0; qq < 2; ++qq) {
                        f32x16 acc;
#pragma unroll
                        for (int e = 0; e < 16; ++e) acc[e] = 0.f;
#pragma unroll
                        for (int ks = 0; ks < 4; ++ks) acc = __builtin_amdgcn_mfma_f32_32x32x16_bf16(af[qq][ks], bfr[ks], acc, 0, 0, 0);
                        float s = 0.f;
#pragma unroll
                        for (int e = 0; e < 16; ++e) s += wv[qq][e] * fmaxf(acc[e], 0.f);
                        part[qq] = s;
                    }
                    const float mine = hh ? part[1] : part[0], give = hh ? part[0] : part[1];
                    const float score = mine + __shfl_xor(give, 32);
                    const int key = s0 + key_l;
                    if (key < n) { scr[hh * SCR_N + key] = score; lds_add(hw + hh * 1024 + (fkey(score) >> 22), 1u); }
                }
            }
            if (more) { const int kk = tid >> 1, hf = tid & 1;
#pragma unroll
                for (int j = 0; j < 4; ++j) *(LAS u32x4*)(ksb + ((b + 1) & 1) * 256 * KST + kk * KST + hf * 32 + j * 8) = pre[j]; }
            __syncthreads();
        }
        unsigned b1[2], ab1[2];
        wfind<16>(hw, TOPK, lane, b1[0], ab1[0]); wfind<16>(hw + 1024, TOPK, lane, b1[1], ab1[1]);
        const int nv4 = (n + 3) >> 2;
#pragma unroll 1
        for (int qq = 0; qq < 2; ++qq) {
            const float* sq = scr + qq * SCR_N;
#pragma unroll
            for (int j = 0; j < 8; ++j) *(LAS u32x4*)(hw + (j * 64 + lane) * 4) = (u32x4){0u, 0u, 0u, 0u};
            for (int s4 = lane; s4 < nv4; s4 += 64) { const f32x4 v = *(const f32x4*)(sq + s4 * 4);
#pragma unroll
                for (int e = 0; e < 4; ++e) { const unsigned k = fkey(v[e]); if ((k >> 22) == b1[qq]) lds_add(hw + ((k >> 11) & 2047u), 1u); } }
            unsigned b2, ab2; wfind<32>(hw, TOPK - ab1[qq], lane, b2, ab2);
#pragma unroll
            for (int j = 0; j < 8; ++j) *(LAS u32x4*)(hw + (j * 64 + lane) * 4) = (u32x4){0u, 0u, 0u, 0u};
            const unsigned pfx = (b1[qq] << 11) | b2;
            for (int s4 = lane; s4 < nv4; s4 += 64) { const f32x4 v = *(const f32x4*)(sq + s4 * 4);
#pragma unroll
                for (int e = 0; e < 4; ++e) { const unsigned k = fkey(v[e]); if ((k >> 11) == pfx) lds_add(hw + (k & 2047u), 1u); } }
            unsigned b3, ab3; wfind<32>(hw, TOPK - ab1[qq] - ab2, lane, b3, ab3);
            const unsigned T = (pfx << 11) | b3; const unsigned need = (unsigned)TOPK - ab1[qq] - ab2 - ab3;
            unsigned cnt = 0u, cntT = 0u; int* sel = SEL + (size_t)(tA + qq) * TOPK;
            const unsigned long long lt = (1ull << lane) - 1ull;
            for (int s4b = 0; s4b < nv4; s4b += 64) { const int s4 = s4b + lane; f32x4 v = {0.f, 0.f, 0.f, 0.f}; const bool inr = s4 < nv4; if (inr) v = *(const f32x4*)(sq + s4 * 4);
#pragma unroll
                for (int e = 0; e < 4; ++e) { const unsigned k = fkey(v[e]); const bool gt = inr && k > T, eq = inr && k == T;
                    const unsigned long long mg = __ballot(gt), me = __ballot(eq);
                    const unsigned rk_e = cntT + (unsigned)__builtin_popcountll(me & lt);
                    const bool take_e = eq && rk_e < need;
                    const unsigned long long mt = __ballot(take_e);
                    const unsigned long long mall = mg | mt;
                    if (gt || take_e) { const unsigned pos = cnt + (unsigned)__builtin_popcountll(mall & lt); if (pos < (unsigned)TOPK) sel[pos] = s4 * 4 + e; }
                    cnt += (unsigned)__builtin_popcountll(mall); cntT += (unsigned)__builtin_popcountll(me); } }
        }
    }
}

__device__ __forceinline__ void d3_qlat(const P& p, int G) {
    const int tid = threadIdx.x, lane = tid & 63, wave = __builtin_amdgcn_readfirstlane(tid >> 6), r16 = lane & 15, q = lane >> 4;
    const bf16_t* Z = (const bf16_t*)(p.ws + WS_Z); const bf16_t* WK = (const bf16_t*)(p.ws + WS_WUKB); bf16_t* QL = (bf16_t*)(p.ws + WS_QLAT);
    for (int item = blockIdx.x * NWAVES + wave; item < (L / 16) * NH_B; item += G * NWAVES) {
        const int qb = item >> 4, h = item & 15, t0 = qb * 16;
        bf16x8_t bq[4];
#pragma unroll
        for (int ks = 0; ks < 4; ++ks) bq[ks] = *(const bf16x8_t*)(Z + (size_t)(t0 + r16) * NZ + ZQ + h * 128 + ks * 32 + q * 8);
        const bf16_t* wk = WK + (size_t)h * KVR * HD_B;
        for (int mt = 0; mt < 32; ++mt) {
            f32x4 acc = {0.f, 0.f, 0.f, 0.f};
#pragma unroll
            for (int ks = 0; ks < 4; ++ks) { const bf16x8_t a = *(const bf16x8_t*)(wk + (size_t)(mt * 16 + r16) * HD_B + ks * 32 + q * 8);
                acc = __builtin_amdgcn_mfma_f32_16x16x32_bf16(a, bq[ks], acc, 0, 0, 0); }
            u32x2 w; w.x = cvtpk(acc[0], acc[1]); w.y = cvtpk(acc[2], acc[3]);
            *(u32x2*)(QL + (size_t)(t0 + r16) * 8192 + h * 512 + mt * 16 + q * 4) = w;
        }
    }
}
__device__ __forceinline__ void d5_oproj(const P& p, int G) {
    const int tid = threadIdx.x, lane = tid & 63, wave = __builtin_amdgcn_readfirstlane(tid >> 6), r16 = lane & 15, q = lane >> 4;
    const bf16_t* OL = (const bf16_t*)(p.ws + WS_QLAT); const bf16_t* WV = (const bf16_t*)(p.ws + WS_WUVT); bf16_t* YB = (bf16_t*)(p.ws + WS_YB);
    for (size_t i = (size_t)blockIdx.x * NT + tid; i < (size_t)(MP - L) * A_W / 8; i += (size_t)G * NT) *(u32x4*)(YB + (size_t)L * A_W + i * 8) = (u32x4){0u, 0u, 0u, 0u};
    for (int item = blockIdx.x * NWAVES + wave; item < (L / 16) * NH_B; item += G * NWAVES) {
        const int qb = item >> 4, h = item & 15, t0 = qb * 16;
        f32x4 acc[8];
#pragma unroll
        for (int mt = 0; mt < 8; ++mt) acc[mt] = (f32x4){0.f, 0.f, 0.f, 0.f};
        const bf16_t* wv = WV + (size_t)h * HD_B * KVR; const bf16_t* ol = OL + (size_t)(t0 + r16) * 8192 + h * 512;
#pragma unroll 4
        for (int ks = 0; ks < 16; ++ks) {
            const bf16x8_t b = *(const bf16x8_t*)(ol + ks * 32 + q * 8);
#pragma unroll
            for (int mt = 0; mt < 8; ++mt) { const bf16x8_t a = *(const bf16x8_t*)(wv + (size_t)(mt * 16 + r16) * KVR + ks * 32 + q * 8);
                acc[mt] = __builtin_amdgcn_mfma_f32_16x16x32_bf16(a, b, acc[mt], 0, 0, 0); }
        }
#pragma unroll
        for (int mt = 0; mt < 8; ++mt) { u32x2 w; w.x = cvtpk(acc[mt][0], acc[mt][1]); w.y = cvtpk(acc[mt][2], acc[mt][3]);
            *(u32x2*)(YB + (size_t)(t0 + r16) * A_W + h * HD_B + mt * 16 + q * 4) = w; }
    }
}

constexpr int QLS = 520, PLS = 264, CTS = 520;
__device__ __forceinline__ void d4_attn(const P& p, LAS unsigned char* lds, int G) {
    const int tid = threadIdx.x, lane = tid & 63, wave = __builtin_amdgcn_readfirstlane(tid >> 6), r16 = lane & 15, q = lane >> 4;
    bf16_t* QO = (bf16_t*)(p.ws + WS_QLAT); const bf16_t* CKV = (const bf16_t*)(p.ws + WS_CKV); const int* SEL = (const int*)(p.ws + WS_SEL);
    LAS bf16_t* ql = (LAS bf16_t*)lds;
    LAS float* lg = (LAS float*)(lds + 16640);
    LAS bf16_t* pl = (LAS bf16_t*)(lds + 33024);
    LAS int* sl = (LAS int*)(lds + 41472);
    LAS bf16_t* ct = (LAS bf16_t*)(lds + 42496);
    const float scale = 0.08838834764831845f;
    for (int t = blockIdx.x; t < L; t += G) {
        __syncthreads();
        for (int i = tid; i < 1024; i += NT) { const int hd = i >> 6, c = i & 63; *(LAS u32x4*)(ql + hd * QLS + c * 8) = *(const u32x4*)(QO + (size_t)t * 8192 + hd * 512 + c * 8); }
        if (tid < TOPK) sl[tid] = SEL[(size_t)t * TOPK + tid];
        __syncthreads();
        {
            const int i0 = sl[wave * 32 + r16], i1 = sl[wave * 32 + 16 + r16];
            const bf16_t* row0 = CKV + (size_t)(i0 < 0 ? 0 : i0) * KVR; const bf16_t* row1 = CKV + (size_t)(i1 < 0 ? 0 : i1) * KVR;
            f32x4 c0 = {0.f, 0.f, 0.f, 0.f}, c1 = c0;
#pragma unroll 4
            for (int ks = 0; ks < 16; ++ks) {
                const bf16x8_t a = *(const LAS bf16x8_t*)(ql + r16 * QLS + ks * 32 + q * 8);
                const bf16x8_t b0 = *(const bf16x8_t*)(row0 + ks * 32 + q * 8), b1 = *(const bf16x8_t*)(row1 + ks * 32 + q * 8);
                c0 = __builtin_amdgcn_mfma_f32_16x16x32_bf16(a, b0, c0, 0, 0, 0); c1 = __builtin_amdgcn_mfma_f32_16x16x32_bf16(a, b1, c1, 0, 0, 0);
            }
#pragma unroll
            for (int e = 0; e < 4; ++e) { lg[(4 * q + e) * 256 + wave * 32 + r16] = i0 < 0 ? -INFINITY : c0[e] * scale; lg[(4 * q + e) * 256 + wave * 32 + 16 + r16] = i1 < 0 ? -INFINITY : c1[e] * scale; }
        }
        __syncthreads();
        for (int hd = wave * 2; hd < wave * 2 + 2; ++hd) {
            float v[4]; float mx = -INFINITY;
#pragma unroll
            for (int k = 0; k < 4; ++k) { v[k] = lg[hd * 256 + k * 64 + lane]; mx = fmaxf(mx, v[k]); }
            mx = wave_max(mx);
            float s = 0.f;
#pragma unroll
            for (int k = 0; k < 4; ++k) { v[k] = __expf(v[k] - mx); s += v[k]; }
            s = 1.f / wave_sum(s);
#pragma unroll
            for (int k = 0; k < 4; ++k) pl[hd * PLS + k * 64 + lane] = f2bf(v[k] * s);
        }
        f32x4 acc[4];
#pragma unroll
        for (int m = 0; m < 4; ++m) acc[m] = (f32x4){0.f, 0.f, 0.f, 0.f};
        for (int kt = 0; kt < 4; ++kt) {
            u32x4 st[8];
#pragma unroll
            for (int i = 0; i < 8; ++i) { const int idx = sl[kt * 64 + wave + 8 * i]; st[i] = *(const u32x4*)(CKV + (size_t)(idx < 0 ? 0 : idx) * KVR + lane * 8); }
            __syncthreads();
#pragma unroll
            for (int i = 0; i < 8; ++i) *(LAS u32x4*)(ct + (wave + 8 * i) * CTS + lane * 8) = st[i];
            __syncthreads();
#pragma unroll
            for (int ks = 0; ks < 2; ++ks) {
                const bf16x8_t b = *(const LAS bf16x8_t*)(pl + r16 * PLS + kt * 64 + ks * 32 + q * 8);
#pragma unroll
                for (int m = 0; m < 4; ++m) {
                    const LAS bf16_t* cp = ct + (ks * 32 + q * 8) * CTS + wave * 64 + m * 16 + r16;
                    bf16x8_t a;
#pragma unroll
                    for (int j = 0; j < 8; ++j) a[j] = (short)cp[j * CTS];
                    acc[m] = __builtin_amdgcn_mfma_f32_16x16x32_bf16(a, b, acc[m], 0, 0, 0);
                }
            }
        }
#pragma unroll
        for (int m = 0; m < 4; ++m) { u32x2 w; w.x = cvtpk(acc[m][0], acc[m][1]); w.y = cvtpk(acc[m][2], acc[m][3]);
            *(u32x2*)(QO + (size_t)t * 8192 + r16 * 512 + wave * 64 + m * 16 + q * 4) = w; }
    }
}

__device__ __forceinline__ void p12_norm_u2(const P& p, int G) {
    const int tid = threadIdx.x, lane = tid & 63, wave = tid >> 6;
    bf16_t* U = (bf16_t*)(p.ws + WS_U); const float* hmeta = (const float*)(p.ws + WS_HMETA);
    for (int m = blockIdx.x * NWAVES + wave; m < MP; m += G * NWAVES) {
        const float* src = m < NMETA ? hmeta + (size_t)m * D : (m < L ? p.out + (size_t)(m - NMETA) * D : nullptr);
        rms_row_bf16(src, p.in[I_NFW], U + (size_t)m * D, lane, 1e-6f);
    }
}
__device__ __forceinline__ void p18_final_norm(const P& p, int G) {
    const int tid = threadIdx.x, lane = tid & 63, wave = tid >> 6;
    const float* w = p.in[I_NFIN];
    for (int m = blockIdx.x * NWAVES + wave; m < SEQ; m += G * NWAVES) {
        float* row = p.out + (size_t)m * D;
        f32x4 v[16]; float s = 0.f;
#pragma unroll
        for (int j = 0; j < 16; ++j) { v[j] = *(const f32x4*)(row + (j * 64 + lane) * 4); s += (v[j].x * v[j].x + v[j].y * v[j].y) + (v[j].z * v[j].z + v[j].w * v[j].w); }
        const float r = rsqrtf(wave_sum(s) * (1.f / D) + 1e-6f);
#pragma unroll
        for (int j = 0; j < 16; ++j) { const f32x4 g = *(const f32x4*)(w + (j * 64 + lane) * 4); *(f32x4*)(row + (j * 64 + lane) * 4) = v[j] * r * g; }
    }
}

__device__ __forceinline__ void p14_conv_act(const P& p, int G, int pass) {
    const int tid = threadIdx.x;
    const bf16_t* ZF = (const bf16_t*)(p.ws + WS_ZF); bf16_t* ACT = (bf16_t*)(p.ws + WS_ACT);
    const float* cw = p.in[I_CW]; const float* cb = p.in[I_CB];
    const size_t nitems = (size_t)MP * 43 * 16;
    for (size_t it = (size_t)blockIdx.x * NT + tid; it < nitems; it += (size_t)G * NT) {
        const int g8 = (int)(it % 16), tl = (int)((it / 16) % 43), t = (int)(it / (16 * 43));
        const int ch = (pass * 43 + tl) * 128 + g8 * 8;
        u32x4 o = (u32x4){0u, 0u, 0u, 0u};
        if (t < L) {
            float zg[8], zu[8];
#pragma unroll
            for (int e = 0; e < 8; ++e) { zg[e] = cb[ch + e]; zu[e] = cb[DFF + ch + e]; }
#pragma unroll
            for (int i = 0; i < 3; ++i) { const int tt = t - 2 + i;
                if (tt >= 0) {
                    const u32x4 a = *(const u32x4*)(ZF + (size_t)tt * DFF + tl * 256 + g8 * 8), b = *(const u32x4*)(ZF + (size_t)tt * DFF + tl * 256 + 128 + g8 * 8);
                    const float xa[8] = {blo(a.x), bhi(a.x), blo(a.y), bhi(a.y), blo(a.z), bhi(a.z), blo(a.w), bhi(a.w)};
                    const float xb[8] = {blo(b.x), bhi(b.x), blo(b.y), bhi(b.y), blo(b.z), bhi(b.z), blo(b.w), bhi(b.w)};
#pragma unroll
                    for (int e = 0; e < 8; ++e) { zg[e] += cw[(size_t)i * NFI + ch + e] * xa[e]; zu[e] += cw[(size_t)i * NFI + DFF + ch + e] * xb[e]; }
                } }
            float r[8];
#pragma unroll
            for (int e = 0; e < 8; ++e) r[e] = zg[e] * sigm(zg[e]) * zu[e];
            o.x = pk2(r[0], r[1]); o.y = pk2(r[2], r[3]); o.z = pk2(r[4], r[5]); o.w = pk2(r[6], r[7]);
        }
        *(u32x4*)(ACT + (size_t)t * DFF + ch) = o;
    }
}

constexpr int NPHASE = 22;
__global__ void __launch_bounds__(NT, 2) fwd_kernel(P p) {
    extern __shared__ __attribute__((aligned(16))) unsigned char lds_raw[];
    LAS unsigned char* lds = (LAS unsigned char*)lds_raw;
    const int G = gridDim.x;
    unsigned char* ws = p.ws;
    volatile LAS unsigned* MISC = (volatile LAS unsigned*)(lds + MISC_OFF);
    if (threadIdx.x < 16) MISC[threadIdx.x] = 0u;
    __syncthreads();
#if MK_ONE_LAUNCH
    XcdBarrier bar = xcd_barrier_post((unsigned*)(ws + WS_CTL), MISC + 8);
#define GRID_BAR() xcd_barrier(bar)
#else
#define GRID_BAR() do {} while (0)
#endif
    const int lo = p.ph_lo, hi = p.ph_hi;
#ifndef PHASE_MASK
#define PHASE_MASK 0xFFFFFFFu
#endif
#define IN(k) ((((PHASE_MASK) >> (k)) & 1u) && lo <= (k) && (k) < hi)
#define SEAM(k) do { if (IN((k) + 1)) GRID_BAR(); } while (0)
#ifndef PROBE_REP_MASK
#define PROBE_REP_MASK 0u
#endif
#define NREP(k) ((((PROBE_REP_MASK) >> (k)) & 1u) ? 2 : 1)
    bf16_t* U = (bf16_t*)(ws + WS_U);
    if (IN(0)) _Pragma("unroll") for (int rep_ = 0; rep_ < NREP(0); ++rep_) { p0_prologue(p, lds, G); if (rep_ == NREP(0) - 1) SEAM(0); }
    if (IN(1)) _Pragma("unroll") for (int rep_ = 0; rep_ < NREP(1); ++rep_) {
        pg8::Gemm g{U, (const bf16_t*)(ws + WS_WINT), MP, NZ, D}; pg8::StaticOrder S; S.init(MP, NZ, G, (int)blockIdx.x);
        pg8::EpiBf16<0> E{(bf16_t*)(ws + WS_Z), NZ};
        pg8::gemm_phase<pg8::EpiBf16<0>, pg8::StaticOrder, true, true>(lds, g, S, E);
        if (rep_ == NREP(1) - 1) SEAM(1);
    }
    if (IN(2)) _Pragma("unroll") for (int rep_ = 0; rep_ < NREP(2); ++rep_) { p2_rwkv_prep(p, lds, G); if (rep_ == NREP(2) - 1) SEAM(2); }
    if (IN(3)) _Pragma("unroll") for (int rep_ = 0; rep_ < NREP(3); ++rep_) { ra_items(p, lds, G); if (rep_ == NREP(3) - 1) SEAM(3); }
    if (IN(4)) _Pragma("unroll") for (int rep_ = 0; rep_ < NREP(4); ++rep_) { rb_chain(p, G); if (rep_ == NREP(4) - 1) SEAM(4); }
    if (IN(5)) _Pragma("unroll") for (int rep_ = 0; rep_ < NREP(5); ++rep_) { rc_out(p, G); if (rep_ == NREP(5) - 1) SEAM(5); }
    if (IN(6)) _Pragma("unroll") for (int rep_ = 0; rep_ < NREP(6); ++rep_) { p4_dsa_prep(p, G); if (rep_ == NREP(6) - 1) SEAM(6); }
    if (IN(7)) _Pragma("unroll") for (int rep_ = 0; rep_ < NREP(7); ++rep_) { d2_topk(p, lds, G); if (rep_ == NREP(7) - 1) SEAM(7); }
    if (IN(8)) _Pragma("unroll") for (int rep_ = 0; rep_ < NREP(8); ++rep_) { d3_qlat(p, G); if (rep_ == NREP(8) - 1) SEAM(8); }
    if (IN(9)) _Pragma("unroll") for (int rep_ = 0; rep_ < NREP(9); ++rep_) { d4_attn(p, lds, G); if (rep_ == NREP(9) - 1) SEAM(9); }
    if (IN(10)) _Pragma("unroll") for (int rep_ = 0; rep_ < NREP(10); ++rep_) { d5_oproj(p, G); if (rep_ == NREP(10) - 1) SEAM(10); }
    if (IN(11)) _Pragma("unroll") for (int rep_ = 0; rep_ < NREP(11); ++rep_) {
        pg8::Gemm g{U, (const bf16_t*)(ws + WS_WGT), MP, 8192, D}; pg8::StaticOrder S; S.init(MP, 8192, G, (int)blockIdx.x);
        pg8::EpiBf16<1> E{(bf16_t*)(ws + WS_GATES), 8192};
        pg8::gemm_phase<pg8::EpiBf16<1>, pg8::StaticOrder, true, true>(lds, g, S, E);
        if (rep_ == NREP(11) - 1) SEAM(11);
    }
    if (IN(12)) _Pragma("unroll") for (int rep_ = 0; rep_ < NREP(12); ++rep_) {
        pg8::Gemm g{(const bf16_t*)(ws + WS_YA), (const bf16_t*)(ws + WS_WPAT), MP, D, A_W}; pg8::StaticOrder S; S.init(MP, D, G, (int)blockIdx.x);
        pg8::EpiGateMulF32 E{(float*)(ws + WS_MF), D, (const bf16_t*)(ws + WS_GATES), 8192, 0};
        pg8::gemm_phase<pg8::EpiGateMulF32, pg8::StaticOrder, true, true>(lds, g, S, E);
        if (rep_ == NREP(12) - 1) SEAM(12);
    }
    if (IN(13)) _Pragma("unroll") for (int rep_ = 0; rep_ < NREP(13); ++rep_) {
        pg8::Gemm g{(const bf16_t*)(ws + WS_YB), (const bf16_t*)(ws + WS_WPBT), MP, D, A_W}; pg8::StaticOrder S; S.init(MP, D, G, (int)blockIdx.x);
        pg8::EpiGateMulAddBf16 E{U, D, (const float*)(ws + WS_MF), (const bf16_t*)(ws + WS_GATES), 8192, D};
        pg8::gemm_phase<pg8::EpiGateMulAddBf16, pg8::StaticOrder, true, true>(lds, g, S, E);
        if (rep_ == NREP(13) - 1) SEAM(13);
    }
    if (IN(14)) _Pragma("unroll") for (int rep_ = 0; rep_ < NREP(14); ++rep_) {
        pg8::Gemm g{U, (const bf16_t*)(ws + WS_WOUTT), MP, D, D}; pg8::StaticOrder S; S.init(MP, D, G, (int)blockIdx.x);
        pg8::EpiResid E{p.in[I_META], p.in[I_X], (float*)(ws + WS_HMETA), p.out, D, NMETA, L};
        pg8::gemm_phase<pg8::EpiResid, pg8::StaticOrder, true, true>(lds, g, S, E);
        if (rep_ == NREP(14) - 1) SEAM(14);
    }
    if (IN(15)) _Pragma("unroll") for (int rep_ = 0; rep_ < NREP(15); ++rep_) { p12_norm_u2(p, G); if (rep_ == NREP(15) - 1) SEAM(15); }
    if (IN(16)) _Pragma("unroll") for (int rep_ = 0; rep_ < NREP(16); ++rep_) {
        pg8::Gemm g{U, (const bf16_t*)(ws + WS_WFIT), MP, DFF, D}; pg8::StaticOrder S; S.init(MP, DFF, G, (int)blockIdx.x);
        pg8::EpiBf16<0> E{(bf16_t*)(ws + WS_ZF), DFF};
        pg8::gemm_phase<pg8::EpiBf16<0>, pg8::StaticOrder, true, true>(lds, g, S, E);
        if (rep_ == NREP(16) - 1) SEAM(16);
    }
    if (IN(17)) _Pragma("unroll") for (int rep_ = 0; rep_ < NREP(17); ++rep_) { p14_conv_act(p, G, 0); if (rep_ == NREP(17) - 1) SEAM(17); }
    if (IN(18)) _Pragma("unroll") for (int rep_ = 0; rep_ < NREP(18); ++rep_) {
        pg8::Gemm g{U, (const bf16_t*)(ws + WS_WFIT) + (size_t)DFF * D, MP, DFF, D}; pg8::StaticOrder S; S.init(MP, DFF, G, (int)blockIdx.x);
        pg8::EpiBf16<0> E{(bf16_t*)(ws + WS_ZF), DFF};
        pg8::gemm_phase<pg8::EpiBf16<0>, pg8::StaticOrder, true, true>(lds, g, S, E);
        if (rep_ == NREP(18) - 1) SEAM(18);
    }
    if (IN(19)) _Pragma("unroll") for (int rep_ = 0; rep_ < NREP(19); ++rep_) { p14_conv_act(p, G, 1); if (rep_ == NREP(19) - 1) SEAM(19); }
    if (IN(20)) _Pragma("unroll") for (int rep_ = 0; rep_ < NREP(20); ++rep_) {
        pg8::Gemm g{(const bf16_t*)(ws + WS_ACT), (const bf16_t*)(ws + WS_WFOT), MP, D, DFF}; pg8::StaticOrder S; S.init(MP, D, G, (int)blockIdx.x);
        pg8::EpiResid E{(const float*)(ws + WS_HMETA), p.out, (float*)(ws + WS_HMETA), p.out, D, NMETA, L};
        pg8::gemm_phase<pg8::EpiResid, pg8::StaticOrder, true, true>(lds, g, S, E);
        if (rep_ == NREP(20) - 1) SEAM(20);
    }
    if (IN(21)) _Pragma("unroll") for (int rep_ = 0; rep_ < NREP(21); ++rep_) { p18_final_norm(p, G); }
#undef IN
#undef SEAM
}

extern "C" void kernel_launch(void* const* d_in, const int* in_sizes, int n_in, void* d_out, int out_size, void* d_ws, size_t ws_size, hipStream_t stream) {
    static int grid = 0;
    if (grid == 0) {
        if (n_in != 30 || out_size != SEQ * D || ws_size < WS_END2) { fprintf(stderr, "kernel_launch: unexpected shapes (n_in %d out %d ws %zu need %zu)\n", n_in, out_size, ws_size, (size_t)WS_END); grid = -1; return; }
        int dev = 0, cus = 0, per_cu = 0;
        if (hipGetDevice(&dev) != hipSuccess || hipDeviceGetAttribute(&cus, hipDeviceAttributeMultiprocessorCount, dev) != hipSuccess) { grid = -1; return; }
        if (hipFuncSetAttribute((const void*)fwd_kernel, hipFuncAttributeMaxDynamicSharedMemorySize, LDS_BYTES) != hipSuccess) { fprintf(stderr, "kernel_launch: hipFuncSetAttribute failed\n"); grid = -1; return; }
        if (hipOccupancyMaxActiveBlocksPerMultiprocessor(&per_cu, (const void*)fwd_kernel, NT, LDS_BYTES) != hipSuccess || per_cu < 1) fprintf(stderr, "kernel_launch: occupancy query says %d\n", per_cu);
        (void)hipGetLastError();
        grid = cus;
    }
    if (grid < 0) return;
    (void)hipMemsetAsync((char*)d_ws + WS_CTL, 0, CTL_BYTES, stream);
    P a{};
    for (int i = 0; i < 30; ++i) a.in[i] = (const float*)d_in[i];
    a.out = (float*)d_out; a.ws = (unsigned char*)d_ws;
#if MK_ONE_LAUNCH
    a.ph_lo = 0; a.ph_hi = NPHASE;
    hipLaunchKernelGGL(fwd_kernel, dim3(grid), dim3(NT), LDS_BYTES, stream, a);
#else
    for (int k = 0; k < NPHASE; ++k) { a.ph_lo = k; a.ph_hi = k + 1; hipLaunchKernelGGL(fwd_kernel, dim3(grid), dim3(NT), LDS_BYTES, stream, a); }
#endif
}
```

```cpp
#include <hip/hip_runtime.h>
#include <cstdio>
#include <cstdint>
#define MK_ONE_LAUNCH 1
namespace pg8 {
#define PG8_LAS __attribute__((address_space(3)))
typedef unsigned short bf16_t;
typedef short bf16x8 __attribute__((ext_vector_type(8)));
typedef float f32x4 __attribute__((ext_vector_type(4)));
typedef unsigned u32x4 __attribute__((ext_vector_type(4)));
typedef int i32x4 __attribute__((ext_vector_type(4)));
constexpr int BM = 256, BK = 64, HALF = 128, HTB = HALF * BK * 2  , STAGE_BYTES = 8 * HTB, NXCD = 8, WGM = 4;

__host__ __device__ __forceinline__ int lds_byte(int r, int c) { const int st = (r >> 4) * 2 + (c >> 5), rr = r & 15, cc = c & 31, ob = rr * 64 + cc * 2; return st * 1024 + (ob ^ (((ob >> 9) & 1) << 5)); }
__host__ __device__ __forceinline__ void stage_rc(int b, int& R, int& C) { const int st = b / 1024, sb = b % 1024, swz = sb ^ (((sb >> 9) & 1) << 5); R = (st >> 1) * 16 + swz / 64; C = (st & 1) * 32 + (swz % 64) / 2; }
__host__ __device__ __forceinline__ int perm32(int rho) { const int n = rho >> 4, i = rho & 15; return 8 * (i >> 2) + 4 * n + (i & 3); }

struct Unit { int pm, pn; };
struct Gemm { const bf16_t* A; const bf16_t* Bt; int M, N, K; const float* sa; const float* sb; };

struct StaticOrder {
    int nM, nN, nwg, G, c;
    __host__ __device__ void init(int M, int N, int G_, int c_) { nM = M / BM; nN = N / BM; nwg = nM * nN; G = G_; c = c_; }
    __host__ __device__ bool next(int i, Unit& u) const {
        const long L = (long)i * G + c; if (L >= nwg) return false;
        int wgid = (int)L; { const int q = nwg / NXCD, r = nwg % NXCD, xcd = wgid % NXCD, off = wgid / NXCD; wgid = (xcd < r ? xcd * (q + 1) : r * (q + 1) + (xcd - r) * q) + off; }
        const int nig = WGM * nN, gid = wgid / nig, fm = gid * WGM, gsz = (nM - fm) < WGM ? (nM - fm) : WGM;
        u.pm = fm + ((wgid % nig) % gsz); u.pn = (wgid % nig) / gsz; return true;
    }
    __device__ __forceinline__ void a_ready(const Unit&) const {}
    __device__ __forceinline__ void done(const Unit&) const {}
};

__device__ __forceinline__ unsigned cvt_pk_bf16(float lo, float hi) { unsigned r; asm volatile("v_cvt_pk_bf16_f32 %0, %1, %2" : "=v"(r) : "v"(lo), "v"(hi)); return r; }
typedef float f32x2 __attribute__((ext_vector_type(2)));

typedef unsigned u32x2 __attribute__((ext_vector_type(2)));
__device__ __forceinline__ float bf_lo(unsigned w) { return __uint_as_float(w << 16); }
__device__ __forceinline__ float bf_hi(unsigned w) { return __uint_as_float(w & 0xffff0000u); }
__device__ __forceinline__ float sigmoidf_(float x) { return 1.f / (1.f + __expf(-x)); }

template <int ACT> struct EpiBf16 {
    static constexpr bool PERM = true, AFTER_DRAIN = false, SELF_SCALE = false;
    bf16_t* O; int ldc;
    __device__ __forceinline__ void operator()(const f32x4 (&acc)[2][2][4][2], const Unit& u, int wr, int wc, int fr, int fq) const {
        const int row0 = u.pm * BM + wr * 64 + fr; const int col0 = u.pn * BM + wc * 32 + 8 * fq;
#pragma unroll
        for (int ai = 0; ai < 2; ++ai)
#pragma unroll
            for (int m = 0; m < 4; ++m) { bf16_t* rowp = O + (size_t)(row0 + ai * HALF + m * 16) * ldc + col0;
#pragma unroll
                for (int bj = 0; bj < 2; ++bj) { f32x4 v0 = acc[ai][bj][m][0], v1 = acc[ai][bj][m][1];
                    if (ACT == 1) {
#pragma unroll
                        for (int e = 0; e < 4; ++e) { v0[e] = sigmoidf_(v0[e]); v1[e] = sigmoidf_(v1[e]); } }
                    u32x4 w; w.x = cvt_pk_bf16(v0[0], v0[1]); w.y = cvt_pk_bf16(v0[2], v0[3]); w.z = cvt_pk_bf16(v1[0], v1[1]); w.w = cvt_pk_bf16(v1[2], v1[3]);
                    *(u32x4*)(rowp + bj * HALF) = w; } }
    }
};
struct EpiGateMulF32 {
    static constexpr bool PERM = true, AFTER_DRAIN = false, SELF_SCALE = false;
    bf16_t* MA; int ldc; const bf16_t* G; int ldg; int gcol0;
    __device__ __forceinline__ void operator()(const f32x4 (&acc)[2][2][4][2], const Unit& u, int wr, int wc, int fr, int fq) const {
        const int row0 = u.pm * BM + wr * 64 + fr, col0 = u.pn * BM + wc * 32 + 8 * fq;
#pragma unroll
        for (int ai = 0; ai < 2; ++ai)
#pragma unroll
            for (int m = 0; m < 4; ++m) { const size_t r = (size_t)(row0 + ai * HALF + m * 16); bf16_t* rowp = MA + r * ldc + col0; const bf16_t* gp = G + r * ldg + gcol0 + col0;
#pragma unroll
                for (int bj = 0; bj < 2; ++bj) { const u32x4 g = *(const u32x4*)(gp + bj * HALF); const f32x4 a0 = acc[ai][bj][m][0], a1 = acc[ai][bj][m][1];
                    u32x4 w; w.x = cvt_pk_bf16(a0[0] * bf_lo(g.x), a0[1] * bf_hi(g.x)); w.y = cvt_pk_bf16(a0[2] * bf_lo(g.y), a0[3] * bf_hi(g.y));
                    w.z = cvt_pk_bf16(a1[0] * bf_lo(g.z), a1[1] * bf_hi(g.z)); w.w = cvt_pk_bf16(a1[2] * bf_lo(g.w), a1[3] * bf_hi(g.w));
                    *(u32x4*)(rowp + bj * HALF) = w; } }
    }
};
struct EpiGateMulAddBf16 {
    static constexpr bool PERM = true, AFTER_DRAIN = false, SELF_SCALE = false;
    bf16_t* MB; int ldc; const bf16_t* MA; const bf16_t* G; int ldg; int gcol0;
    __device__ __forceinline__ void operator()(const f32x4 (&acc)[2][2][4][2], const Unit& u, int wr, int wc, int fr, int fq) const {
        const int row0 = u.pm * BM + wr * 64 + fr, col0 = u.pn * BM + wc * 32 + 8 * fq;
#pragma unroll
        for (int ai = 0; ai < 2; ++ai)
#pragma unroll
            for (int m = 0; m < 4; ++m) { const size_t r = (size_t)(row0 + ai * HALF + m * 16); bf16_t* rowp = MB + r * ldc + col0; const bf16_t* mp = MA + r * ldc + col0; const bf16_t* gp = G + r * ldg + gcol0 + col0;
#pragma unroll
                for (int bj = 0; bj < 2; ++bj) { const u32x4 g = *(const u32x4*)(gp + bj * HALF); const u32x4 mm = *(const u32x4*)(mp + bj * HALF);
                    const f32x4 a0 = acc[ai][bj][m][0], a1 = acc[ai][bj][m][1];
                    u32x4 w; w.x = cvt_pk_bf16(bf_lo(mm.x) + a0[0] * bf_lo(g.x), bf_hi(mm.x) + a0[1] * bf_hi(g.x)); w.y = cvt_pk_bf16(bf_lo(mm.y) + a0[2] * bf_lo(g.y), bf_hi(mm.y) + a0[3] * bf_hi(g.y));
                    w.z = cvt_pk_bf16(bf_lo(mm.z) + a1[0] * bf_lo(g.z), bf_hi(mm.z) + a1[1] * bf_hi(g.z)); w.w = cvt_pk_bf16(bf_lo(mm.w) + a1[2] * bf_lo(g.w), bf_hi(mm.w) + a1[3] * bf_hi(g.w));
                    *(u32x4*)(rowp + bj * HALF) = w; } }
    }
};
struct EpiResid {
    static constexpr bool PERM = false, AFTER_DRAIN = false, SELF_SCALE = false;
    const float* smeta; const float* sreal; float* dmeta; float* dreal; int ld; int nmeta; int nrows;
    __device__ __forceinline__ void operator()(const f32x4 (&acc)[2][2][4][2], const Unit& u, int wr, int wc, int fr, int fq) const {
        const int row0 = u.pm * BM + wr * 64 + fr, col0 = u.pn * BM + wc * 32 + 4 * fq;
#pragma unroll
        for (int ai = 0; ai < 2; ++ai)
#pragma unroll
            for (int m = 0; m < 4; ++m) { const int r = row0 + ai * HALF + m * 16;
                if (r < nrows) {
                    const float* sp = (r < nmeta ? smeta + (size_t)r * ld : sreal + (size_t)(r - nmeta) * ld) + col0;
                    float* dp = (r < nmeta ? dmeta + (size_t)r * ld : dreal + (size_t)(r - nmeta) * ld) + col0;
#pragma unroll
                    for (int bj = 0; bj < 2; ++bj)
#pragma unroll
                        for (int n = 0; n < 2; ++n) *(f32x4*)(dp + bj * HALF + n * 16) = *(const f32x4*)(sp + bj * HALF + n * 16) + acc[ai][bj][m][n];
                } }
    }
};

template <int CTRL> __device__ __forceinline__ float dpp_mov(float v) { return __builtin_bit_cast(float, __builtin_amdgcn_update_dpp(0, __builtin_bit_cast(int, v), CTRL, 0xf, 0xf, false)); }
struct EpiConvAct {
    static constexpr bool PERM = true, AFTER_DRAIN = false, SELF_SCALE = true;
    bf16_t* ACT; int ldact; float* HALO; int ldh; const float* cw; const float* cb; int dff; PG8_LAS float* hx; const float* sag; const float* sb;
    __device__ __forceinline__ void operator()(const f32x4 (&acc)[2][2][4][2], const Unit& u, int wr, int wc, int fr, int fq) const {
        const int cl = wc * 32 + 8 * fq;
        const int ch = u.pn * 128 + cl;
        if (fr >= 14) {
#pragma unroll
            for (int ai = 0; ai < 2; ++ai)
#pragma unroll
                for (int bj = 0; bj < 2; ++bj)
#pragma unroll
                    for (int n = 0; n < 2; ++n) *(PG8_LAS f32x4*)(hx + (((ai * 2 + wr) * 2 + (fr - 14)) * 256 + bj * 128 + cl + 4 * n)) = acc[ai][bj][3][n];
        }
        if (wr == 0 && fr < 2) {
            float* hp = HALO + ((size_t)u.pm * 4 + fr) * ldh + u.pn * 256 + cl;
#pragma unroll
            for (int bj = 0; bj < 2; ++bj)
#pragma unroll
                for (int n = 0; n < 2; ++n) *(f32x4*)(hp + bj * 128 + 4 * n) = acc[0][bj][0][n] * (*(const f32x4*)(sb + u.pn * 256 + bj * 128 + cl + 4 * n) * sag[0]);
        }
        if (wr == 1 && fr >= 14) {
            float* hp = HALO + ((size_t)u.pm * 4 + (fr - 12)) * ldh + u.pn * 256 + cl;
#pragma unroll
            for (int bj = 0; bj < 2; ++bj)
#pragma unroll
                for (int n = 0; n < 2; ++n) *(f32x4*)(hp + bj * 128 + 4 * n) = acc[1][bj][3][n] * (*(const f32x4*)(sb + u.pn * 256 + bj * 128 + cl + 4 * n) * sag[0]);
        }
        asm volatile("s_waitcnt lgkmcnt(0)" ::: "memory"); __builtin_amdgcn_s_barrier(); asm volatile("" ::: "memory");
#pragma unroll
        for (int n = 0; n < 2; ++n) {
            f32x4 wt[2][3], bb[2];
#pragma unroll
            for (int bj = 0; bj < 2; ++bj) { bb[bj] = *(const f32x4*)(cb + bj * dff + ch + 4 * n);
#pragma unroll
                for (int i = 0; i < 3; ++i) wt[bj][i] = *(const f32x4*)(cw + (size_t)i * 2 * dff + bj * dff + ch + 4 * n) * (*(const f32x4*)(sb + u.pn * 256 + bj * 128 + cl + 4 * n) * sag[0]); }
#pragma unroll
            for (int ai = 0; ai < 2; ++ai) {
                const bool hasprev = (ai | wr) != 0; const int pb = ai * 2 + wr - 1;
                f32x4 xp[2];
#pragma unroll
                for (int bj = 0; bj < 2; ++bj) { xp[bj] = (f32x4){0.f, 0.f, 0.f, 0.f};
                    if (hasprev && fr >= 14) xp[bj] = *(const PG8_LAS f32x4*)(hx + ((pb * 2 + (fr - 14)) * 256 + bj * 128 + cl + 4 * n)); }
#pragma unroll
                for (int m = 0; m < 4; ++m) {
                    f32x4 z[2];
#pragma unroll
                    for (int bj = 0; bj < 2; ++bj) {
                        const f32x4 x = acc[ai][bj][m][n];
#pragma unroll
                        for (int j = 0; j < 4; ++j) {
                            const float a1 = dpp_mov<0x121>(x[j]), p1 = dpp_mov<0x121>(xp[bj][j]), a2 = dpp_mov<0x122>(x[j]), p2 = dpp_mov<0x122>(xp[bj][j]);
                            const float s1 = fr == 0 ? p1 : a1, s2 = fr < 2 ? p2 : a2;
                            z[bj][j] = bb[bj][j] + wt[bj][2][j] * x[j] + wt[bj][1][j] * s1 + wt[bj][0][j] * s2;
                        }
                        xp[bj] = x;
                    }
                    const int r = u.pm * BM + ai * HALF + wr * 64 + m * 16 + fr;
                    float o[4];
#pragma unroll
                    for (int j = 0; j < 4; ++j) { const float g = z[0][j]; o[j] = g * __builtin_amdgcn_rcpf(1.f + __expf(-g)) * z[1][j]; }
                    u32x2 w; w.x = cvt_pk_bf16(o[0], o[1]); w.y = cvt_pk_bf16(o[2], o[3]);
                    *(u32x2*)(ACT + (size_t)r * ldact + ch + 4 * n) = w;
                }
                asm volatile("" ::: "memory");
            }
        }
    }
};
template <class Epi, class Sched, bool ALIGN_EPI = false, bool SP2 = false, bool I8 = false>
__device__ __forceinline__ void gemm_phase(PG8_LAS unsigned char* lds, const Gemm g, const Sched& S, const Epi& E) {
    const int tid = threadIdx.x, wid = __builtin_amdgcn_readfirstlane(tid >> 6), lane = tid & 63, wr = wid >> 2, wc = wid & 3, fr = lane & 15, fq = lane >> 4;
    const int K = g.K, nt = K / BK;
    unsigned voffA[2], voffB[2];
#pragma unroll
    for (int i = 0; i < 2; ++i) { int R, C; stage_rc(tid * 16 + i * 8192, R, C); const int Rb = Epi::PERM ? ((R & ~31) + perm32(R & 31)) : R;
        voffA[i] = (unsigned)(R * K + C) * 2u; voffB[i] = (unsigned)(Rb * K + C) * 2u; }
    const size_t kstep = (size_t)(BK * 2);
    const size_t hstep = (size_t)HALF * K * 2;
    const size_t tstep = 2 * hstep;
    const unsigned ldsw = (unsigned)wid * 1024u;
    const int aoff = lds_byte(wr * 64 + fr, fq * 8), boff = lds_byte(wc * 32 + fr, fq * 8);
#define PG8_SA(b, h) (((b) * 2 + (h)) * HTB)
#define PG8_SB(b, h) ((4 + (b) * 2 + (h)) * HTB)
#define PG8_STAGE(bufoff, gbase, voff) do { _Pragma("unroll") for (int _i = 0; _i < 2; ++_i) \
        __builtin_amdgcn_global_load_lds((const unsigned*)((const char*)(gbase) + (voff)[_i]), (PG8_LAS unsigned*)(lds + (bufoff) + ldsw + _i * 8192), 16, 0, 0); } while (0)
#define PG8_LDA(dst, b, h) do { _Pragma("unroll") for (int m = 0; m < 4; ++m) _Pragma("unroll") for (int k = 0; k < 2; ++k) dst[m][k] = *(const PG8_LAS bf16x8*)(lds + PG8_SA(b, h) + aoff + m * 2048 + k * 1024); } while (0)
#define PG8_LDB(dst, b, h) do { _Pragma("unroll") for (int n = 0; n < 2; ++n) _Pragma("unroll") for (int k = 0; k < 2; ++k) dst[n][k] = *(const PG8_LAS bf16x8*)(lds + PG8_SB(b, h) + boff + n * 2048 + k * 1024); } while (0)
#define PG8_MMA(ai, bj, At, Bt) do { __builtin_amdgcn_s_setprio(1); _Pragma("unroll") for (int m = 0; m < 4; ++m) _Pragma("unroll") for (int n = 0; n < 2; ++n) _Pragma("unroll") for (int k = 0; k < 2; ++k) { \
        if constexpr (I8) acc[ai][bj][m][n] = __builtin_bit_cast(f32x4, __builtin_amdgcn_mfma_i32_16x16x64_i8(__builtin_bit_cast(i32x4, Bt[n][k]), __builtin_bit_cast(i32x4, At[m][k]), __builtin_bit_cast(i32x4, acc[ai][bj][m][n]), 0, 0, 0)); \
        else acc[ai][bj][m][n] = __builtin_amdgcn_mfma_f32_16x16x32_bf16(Bt[n][k], At[m][k], acc[ai][bj][m][n], 0, 0, 0); } __builtin_amdgcn_s_setprio(0); } while (0)
#define PG8_WAIT_V(n) asm volatile("s_waitcnt vmcnt(" #n ")" ::: "memory")
#define PG8_WAIT_L(n) asm volatile("s_waitcnt lgkmcnt(" #n ")" ::: "memory")
#define PG8_BAR __builtin_amdgcn_s_barrier()
#define PG8_SCHED __builtin_amdgcn_sched_barrier(0)
    Unit cur, nxt; int ui = 0;
    if (!S.next(0, cur)) return;
    f32x4 acc[2][2][4][2];
#pragma unroll
    for (int a = 0; a < 2; ++a)
#pragma unroll
        for (int b = 0; b < 2; ++b)
#pragma unroll
            for (int m = 0; m < 4; ++m)
#pragma unroll
                for (int n = 0; n < 2; ++n) acc[a][b][m][n] = (f32x4){0.f, 0.f, 0.f, 0.f};
    bf16x8 At[4][2], B0[2][2], B1[2][2];
    const char* cA = (const char*)g.A + (size_t)cur.pm * tstep; const char* cB = (const char*)g.Bt + (size_t)cur.pn * tstep;
    S.a_ready(cur);
    if constexpr (SP2) {
        PG8_STAGE(PG8_SB(0, 0), cB, voffB); PG8_STAGE(PG8_SB(0, 1), cB + hstep, voffB); PG8_STAGE(PG8_SA(0, 0), cA, voffA); PG8_STAGE(PG8_SA(0, 1), cA + hstep, voffA);
        if (wr == 1) PG8_BAR;
        PG8_WAIT_V(2); PG8_BAR;
        PG8_STAGE(PG8_SB(1, 0), cB + kstep, voffB); PG8_STAGE(PG8_SA(1, 0), cA + kstep, voffA); PG8_STAGE(PG8_SB(1, 1), cB + hstep + kstep, voffB);
        PG8_WAIT_V(6); PG8_BAR;
    } else {
        PG8_STAGE(PG8_SB(0, 0), cB, voffB); PG8_STAGE(PG8_SA(0, 0), cA, voffA); PG8_STAGE(PG8_SB(0, 1), cB + hstep, voffB); PG8_STAGE(PG8_SA(0, 1), cA + hstep, voffA);
        if (wr == 1) PG8_BAR;
        PG8_WAIT_V(4); PG8_BAR;
        PG8_STAGE(PG8_SB(1, 0), cB + kstep, voffB); PG8_STAGE(PG8_SA(1, 0), cA + kstep, voffA); PG8_STAGE(PG8_SB(1, 1), cB + hstep + kstep, voffB);
        PG8_WAIT_V(6); PG8_BAR;
    }
    for (;;) {
        const bool has_next = S.next(ui + 1, nxt);
        const char* nA = has_next ? (const char*)g.A + (size_t)nxt.pm * tstep : cA; const char* nB = has_next ? (const char*)g.Bt + (size_t)nxt.pn * tstep : cB;
        for (int t = 0; t < nt; t += 2) {
            const bool last = (t == nt - 2);
            const char* a1 = cA + (size_t)(t + 1) * kstep;
            const char* a2 = last ? nA : cA + (size_t)(t + 2) * kstep; const char* b2 = last ? nB : cB + (size_t)(t + 2) * kstep;
            const char* a3 = a2 + kstep; const char* b3 = b2 + kstep;
            if (last && has_next) S.a_ready(nxt);
            if constexpr (SP2) {
            PG8_LDB(B0, 0, 0); PG8_LDB(B1, 0, 1); PG8_SCHED; PG8_LDA(At, 0, 0); PG8_STAGE(PG8_SA(1, 1), a1 + hstep, voffA);
            PG8_WAIT_V(8); PG8_WAIT_L(0); PG8_BAR; PG8_MMA(0, 0, At, B0); PG8_MMA(0, 1, At, B1); PG8_BAR; PG8_SCHED;
            PG8_LDA(At, 0, 1); PG8_STAGE(PG8_SB(0, 0), b2, voffB); PG8_STAGE(PG8_SB(0, 1), b2 + hstep, voffB); PG8_STAGE(PG8_SA(0, 0), a2, voffA);
            PG8_WAIT_V(8); PG8_WAIT_L(0); PG8_BAR; PG8_MMA(1, 0, At, B0); PG8_MMA(1, 1, At, B1); PG8_BAR; PG8_SCHED;
            PG8_LDB(B0, 1, 0); PG8_LDB(B1, 1, 1); PG8_SCHED; PG8_LDA(At, 1, 0); PG8_STAGE(PG8_SA(0, 1), a2 + hstep, voffA);
            PG8_WAIT_V(8); PG8_WAIT_L(0); PG8_BAR; PG8_MMA(0, 0, At, B0); PG8_MMA(0, 1, At, B1); PG8_BAR; PG8_SCHED;
            PG8_LDA(At, 1, 1); PG8_STAGE(PG8_SB(1, 0), b3, voffB); PG8_STAGE(PG8_SB(1, 1), b3 + hstep, voffB); PG8_STAGE(PG8_SA(1, 0), a3, voffA);
            PG8_WAIT_V(8); PG8_WAIT_L(0); PG8_BAR; PG8_MMA(1, 0, At, B0); PG8_MMA(1, 1, At, B1); PG8_BAR; PG8_SCHED;
            } else {
            PG8_LDB(B0, 0, 0); PG8_SCHED; PG8_LDA(At, 0, 0); PG8_STAGE(PG8_SA(1, 1), a1 + hstep, voffA);
            PG8_WAIT_L(8); PG8_BAR; PG8_WAIT_L(0); PG8_MMA(0, 0, At, B0); PG8_BAR; PG8_SCHED;
            PG8_LDB(B1, 0, 1); PG8_STAGE(PG8_SB(0, 0), b2, voffB);
            PG8_BAR; PG8_WAIT_L(0); PG8_MMA(0, 1, At, B1); PG8_BAR;
            PG8_LDA(At, 0, 1); PG8_STAGE(PG8_SA(0, 0), a2, voffA);
            PG8_BAR; PG8_WAIT_L(0); PG8_MMA(1, 0, At, B0); PG8_BAR; PG8_SCHED;
            PG8_STAGE(PG8_SB(0, 1), b2 + hstep, voffB);
            PG8_WAIT_V(6); PG8_BAR; PG8_MMA(1, 1, At, B1); PG8_BAR;
            PG8_LDB(B0, 1, 0); PG8_SCHED; PG8_LDA(At, 1, 0); PG8_STAGE(PG8_SA(0, 1), a2 + hstep, voffA);
            PG8_WAIT_L(8); PG8_BAR; PG8_WAIT_L(0); PG8_MMA(0, 0, At, B0); PG8_BAR; PG8_SCHED;
            PG8_LDB(B1, 1, 1); PG8_STAGE(PG8_SB(1, 0), b3, voffB);
            PG8_BAR; PG8_WAIT_L(0); PG8_MMA(0, 1, At, B1); PG8_BAR;
            PG8_LDA(At, 1, 1); PG8_STAGE(PG8_SA(1, 0), a3, voffA);
            PG8_BAR; PG8_WAIT_L(0); PG8_MMA(1, 0, At, B0); PG8_BAR; PG8_SCHED;
            PG8_STAGE(PG8_SB(1, 1), b3 + hstep, voffB);
            PG8_WAIT_V(6); PG8_BAR; PG8_MMA(1, 1, At, B1); PG8_BAR;
            }
        }
        if constexpr (ALIGN_EPI) { if (wr == 0) PG8_BAR; }
        if constexpr (I8) {
            asm volatile("s_nop 15\n\ts_nop 15" ::: "memory");
#pragma unroll
            for (int ai = 0; ai < 2; ++ai)
#pragma unroll
                for (int bj = 0; bj < 2; ++bj)
#pragma unroll
                    for (int m = 0; m < 4; ++m)
#pragma unroll
                        for (int n = 0; n < 2; ++n)
#pragma unroll
                            for (int j = 0; j < 4; ++j) { float x = acc[ai][bj][m][n][j]; asm volatile("v_cvt_f32_i32 %0, %0" : "+v"(x)); acc[ai][bj][m][n][j] = x; }
            if constexpr (!Epi::SELF_SCALE) {
                const int row0 = cur.pm * BM + wr * 64 + fr, col0 = cur.pn * BM + wc * 32 + (Epi::PERM ? 8 * fq : 4 * fq);
#pragma unroll
                for (int bj = 0; bj < 2; ++bj)
#pragma unroll
                    for (int n = 0; n < 2; ++n) { const f32x4 sc = *(const f32x4*)(g.sb + col0 + bj * HALF + (Epi::PERM ? 4 * n : 16 * n));
#pragma unroll
                        for (int ai = 0; ai < 2; ++ai)
#pragma unroll
                            for (int m = 0; m < 4; ++m) { const float sr = g.sa[row0 + ai * HALF + m * 16]; acc[ai][bj][m][n] = acc[ai][bj][m][n] * (sc * sr); } }
            }
        }
        if constexpr (!Epi::AFTER_DRAIN) { E(acc, cur, wr, wc, fr, fq); S.done(cur); }
        if (!has_next) break;
#pragma unroll
        for (int a = 0; a < 2; ++a)
#pragma unroll
            for (int b = 0; b < 2; ++b)
#pragma unroll
                for (int m = 0; m < 4; ++m)
#pragma unroll
                    for (int n = 0; n < 2; ++n) acc[a][b][m][n] = (f32x4){0.f, 0.f, 0.f, 0.f};
        cur = nxt; cA = nA; cB = nB; ++ui;
        if constexpr (ALIGN_EPI) { if (wr == 1) PG8_BAR; }
    }
    PG8_WAIT_V(0);
    if constexpr (!ALIGN_EPI) { if (wr == 0) PG8_BAR; }
    PG8_BAR;
    if constexpr (Epi::AFTER_DRAIN) { E.fused(acc, cur, wr, wc, fr, fq, lds, wid, lane); S.done(cur); }
#undef PG8_SA
#undef PG8_SB
#undef PG8_STAGE
#undef PG8_LDA
#undef PG8_LDB
#undef PG8_MMA
#undef PG8_WAIT_V
#undef PG8_WAIT_L
#undef PG8_BAR
#undef PG8_SCHED
}
}
#define XB_TMO      128
#define XB_XCNT(j)  (256  + 64 * (j))
#define XB_XSUB(j)  (1280 + 64 * (j))
#define XB_XGEN(j)  (2304 + 64 * (j))
#define XB_TOP      3328
#define XB_TOPGEN   3392
#define XCD_BAR_WORDS 3456
#define XB_SPIN_CAP (1u << 18)
#define LAS __attribute__((address_space(3)))

__device__ __forceinline__ unsigned xb_ld(unsigned* p)              { return __hip_atomic_load(p, __ATOMIC_RELAXED, __HIP_MEMORY_SCOPE_AGENT); }
__device__ __forceinline__ unsigned xb_add(unsigned* p, unsigned v) { return __hip_atomic_fetch_add(p, v, __ATOMIC_RELAXED, __HIP_MEMORY_SCOPE_AGENT); }
__device__ __forceinline__ unsigned xb_xcc_id() { return (unsigned)__builtin_amdgcn_s_getreg((3 << 11) | 20) & 0xFu; }
#define XB_SPIN(cond, bar) do { unsigned _sp = 0; while (cond) { __builtin_amdgcn_s_sleep(1); \
    if ((++_sp & 255u) == 0u) { if (xb_ld(&(bar)[XB_TMO])) break; if (_sp > XB_SPIN_CAP) { atomicAdd(&(bar)[XB_TMO], 1u); break; } } } } while (0)

struct XcdBarrier {
    unsigned* bar; unsigned x;
    volatile LAS unsigned* st;
};

__device__ __forceinline__ XcdBarrier xcd_barrier_post(unsigned* bar, volatile LAS unsigned* st) {
    XcdBarrier b; b.bar = bar; b.x = xb_xcc_id(); b.st = st;
    if (threadIdx.x == 0) (void)xb_add(&bar[XB_XCNT(b.x)], 1u);
    return b;
}
__device__ __forceinline__ void xcd_barrier_complete(unsigned* bar, unsigned x, unsigned& nloc, unsigned& nx) {
    const unsigned G = gridDim.x * gridDim.y * gridDim.z;
    unsigned sum, cnt, mine, sp = 0u;
    for (;;) {
        sum = 0u; cnt = 0u; mine = 0u;
#pragma unroll
        for (unsigned j = 0; j < 16; ++j) { const unsigned c = xb_ld(&bar[XB_XCNT(j)]); sum += c; cnt += (c > 0u) ? 1u : 0u; mine = (j == x) ? c : mine; }
        if (sum == G) break;
        __builtin_amdgcn_s_sleep(1);
        if ((++sp & 255u) == 0u) { if (xb_ld(&bar[XB_TMO])) break; if (sp > XB_SPIN_CAP) { atomicAdd(&bar[XB_TMO], 1u); break; } }
    }
    nloc = mine > 0u ? mine : 1u; nx = cnt > 0u ? cnt : 1u;
}

__device__ __forceinline__ void xcd_barrier(const XcdBarrier& b) {
    asm volatile("s_waitcnt vmcnt(0)" ::: "memory");
    __syncthreads();
    if (threadIdx.x == 0) {
        unsigned* bar = b.bar;
        __builtin_amdgcn_s_waitcnt(0);
        unsigned nloc = b.st[0], nx = b.st[1];
        if (nloc == 0u) { xcd_barrier_complete(bar, b.x, nloc, nx); b.st[0] = nloc; b.st[1] = nx; }
        const unsigned old = xb_add(&bar[XB_XSUB(b.x)], 1u);
        const unsigned gen = old / nloc;
        if (old + 1u == (gen + 1u) * nloc) {
            __builtin_amdgcn_fence(__ATOMIC_RELEASE, "agent");
            asm volatile("s_waitcnt vmcnt(0)" ::: "memory");
            const unsigned og = xb_add(&bar[XB_TOP], 1u);
            const unsigned tg = og / nx;
            if (og + 1u == (tg + 1u) * nx) xb_add(&bar[XB_TOPGEN], 1u);
            else XB_SPIN(xb_ld(&bar[XB_TOPGEN]) == tg, bar);
            __builtin_amdgcn_fence(__ATOMIC_ACQUIRE, "agent");
            xb_add(&bar[XB_XGEN(b.x)], 1u);
            asm volatile("s_waitcnt vmcnt(0)" ::: "memory");
        } else {
            XB_SPIN(xb_ld(&bar[XB_XGEN(b.x)]) == gen, bar);
            __builtin_amdgcn_fence(__ATOMIC_ACQUIRE, "agent");
            asm volatile("s_waitcnt vmcnt(0)" ::: "memory");
        }
    }
    __syncthreads();
}

#define LAS __attribute__((address_space(3)))
typedef unsigned short bf16_t;
typedef float f32x4 __attribute__((ext_vector_type(4)));
typedef unsigned u32x4 __attribute__((ext_vector_type(4)));
typedef unsigned u32x2 __attribute__((ext_vector_type(2)));

#ifndef MK_ONE_LAUNCH
#define MK_ONE_LAUNCH 0
#endif

constexpr int NWAVES = 8, NT = NWAVES * 64;
constexpr int D = 4096, SEQ = 16384, NMETA = 16, L = SEQ + NMETA, MP = 16640;
constexpr int A_W = 2048, A_COLS = 6592, B_COLS = 4704, IN_COLS = A_COLS + B_COLS, NZ = 11520;
constexpr int ZQ = A_COLS, ZCKV = A_COLS + 2048, ZQI = A_COLS + 2560, ZKI = A_COLS + 4608, ZWI = A_COLS + 4672;
constexpr int DFF = 11008, NFI = 2 * DFF;
constexpr int KVR = 512, NH_B = 16, HD_B = 128, IDXH = 32, IDXD = 64, TOPK = 256;
constexpr int LDS_BYTES = 163840, MISC_OFF = 163584;
constexpr int NZ8 = 8960;
constexpr size_t WINT_BF_OFF = (size_t)40 << 20;

constexpr size_t al256(size_t x) { return (x + 255) & ~(size_t)255; }
constexpr size_t WS_CTL = 0, CTL_BYTES = 1u << 20;
constexpr size_t WS_WGT = WS_CTL + CTL_BYTES;
constexpr size_t WS_WPAT = WS_WGT + (size_t)8192 * 4096 * 2;
constexpr size_t WS_WPBT = WS_WPAT + (size_t)4096 * 2048 * 2;
constexpr size_t WS_WOUTT = WS_WPBT + (size_t)4096 * 2048 * 2;
constexpr size_t WS_WFIT = WS_WOUTT + (size_t)4096 * 4096 * 2;
constexpr size_t WS_WFOT = WS_WFIT + (size_t)NFI * 4096 * 2;
constexpr size_t WS_WINT = WS_WFOT + (size_t)4096 * DFF * 2;
constexpr size_t WS_U = WS_WINT + (size_t)NZ * 4096 * 2;
constexpr size_t WS_BIG = WS_U + (size_t)MP * D * 2;
constexpr size_t WS_Z = WS_BIG;
constexpr size_t WS_R1 = WS_Z + (size_t)MP * NZ * 2;
constexpr size_t R1_BYTES = (size_t)MP * D * 4;
constexpr size_t WS_LD = WS_R1;
constexpr size_t WS_AA = WS_LD + (size_t)L * A_W * 4;
constexpr size_t WS_GG = WS_AA + (size_t)L * A_W * 2;
constexpr size_t WS_QLAT = WS_R1;
constexpr size_t WS_MF = WS_R1;
constexpr size_t WS_YA = WS_R1 + R1_BYTES;
constexpr size_t WS_YB = WS_YA + (size_t)MP * A_W * 2;
constexpr size_t WS_END = WS_YB + (size_t)MP * A_W * 2;
constexpr size_t WS_GATES = WS_Z;
constexpr size_t WS_ZF = WS_BIG;
constexpr size_t WS_ACT = WS_BIG + (size_t)MP * DFF * 2;
constexpr size_t WS_CKV = WS_WINT;
constexpr size_t WS_KIDX = WS_CKV + al256((size_t)L * KVR * 2);
constexpr size_t WS_SEL = WS_KIDX + al256((size_t)L * IDXD * 4);
constexpr size_t WS_HMETA = WS_SEL + al256((size_t)L * TOPK * 4);
static_assert(WS_HMETA + (size_t)NMETA * D * 4 <= WS_U, "DSA overlays exceed WINT");
constexpr size_t WS_KIDXB = WS_HMETA + al256((size_t)NMETA * D * 4);
static_assert(WS_KIDXB + (size_t)L * IDXD * 2 <= WS_U, "KIDXB");
constexpr size_t WS_WUKB = WS_END;
constexpr size_t WS_WUVT = WS_WUKB + (size_t)16 * 512 * 128 * 2;
constexpr size_t WS_WLT = WS_WUVT + (size_t)16 * 512 * 128 * 2;
constexpr size_t WS_END2 = WS_WLT + (size_t)2048 * 448 * 2;
static_assert(WS_END2 <= (size_t)4 * 4096 * 22016 * 4, "workspace");
constexpr size_t CT_CMX_IN = 524288, CT_CMX_G = CT_CMX_IN + (size_t)NZ * 4, CT_CMX_F = CT_CMX_G + 8192 * 4, CT_SB_IN = CT_CMX_F + (size_t)NFI * 4, CT_SB_G = CT_SB_IN + (size_t)NZ * 4,
                 CT_SB_F = CT_SB_G + 8192 * 4, CT_SA = CT_SB_F + (size_t)NFI * 4, CT_AMAX = CT_SA + (size_t)MP * 4, CT_SAG = CT_AMAX + 256, CT_END = CT_SAG + 256;
static_assert(CT_END <= CTL_BYTES, "control region");
constexpr size_t WS_ST = WS_WINT;
constexpr size_t WS_BS = WS_ST + al256((size_t)257 * 32 * 4096 * 2);
static_assert(WS_BS + (size_t)L * 32 * 4 <= WS_U, "RWKV overlays exceed WINT");
static_assert((size_t)L * A_W * 4 + 2 * (size_t)L * A_W * 2 <= R1_BYTES && (size_t)L * 8192 * 2 <= R1_BYTES, "R1");
static_assert(WS_ACT + (size_t)MP * DFF * 2 <= WS_END, "ACT");
static_assert((size_t)MP * 8192 * 2 <= (size_t)MP * NZ * 2, "GATES");
static_assert(WS_END <= (size_t)4 * 4096 * 22016 * 4, "workspace");

__device__ __forceinline__ float bf2f(bf16_t b) { return __uint_as_float(((unsigned)b) << 16); }
__device__ __forceinline__ bf16_t f2bf(float f) { unsigned u = __float_as_uint(f); u += 0x7FFFu + ((u >> 16) & 1u); return (bf16_t)(u >> 16); }
__device__ __forceinline__ unsigned pk2(float lo, float hi) { return (unsigned)f2bf(lo) | ((unsigned)f2bf(hi) << 16); }
__device__ __forceinline__ float blo(unsigned w) { return __uint_as_float(w << 16); }
__device__ __forceinline__ float bhi(unsigned w) { return __uint_as_float(w & 0xffff0000u); }
__device__ __forceinline__ float sigm(float x) { return 1.f / (1.f + __expf(-x)); }
template <int CTRL> __device__ __forceinline__ float dpp_f(float v) { return __builtin_bit_cast(float, __builtin_amdgcn_update_dpp(0, __builtin_bit_cast(int, v), CTRL, 0xf, 0xf, false)); }
__device__ __forceinline__ float wave_sum(float v) {
    v += dpp_f<0xB1>(v);
    v += dpp_f<0x4E>(v);
    v += dpp_f<0x141>(v);
    v += dpp_f<0x140>(v);
    const float a = __builtin_bit_cast(float, __builtin_amdgcn_readlane(__builtin_bit_cast(int, v), 0));
    const float b = __builtin_bit_cast(float, __builtin_amdgcn_readlane(__builtin_bit_cast(int, v), 16));
    const float c = __builtin_bit_cast(float, __builtin_amdgcn_readlane(__builtin_bit_cast(int, v), 32));
    const float d = __builtin_bit_cast(float, __builtin_amdgcn_readlane(__builtin_bit_cast(int, v), 48));
    return (a + b) + (c + d);
}
__device__ __forceinline__ float wave_max(float v) {
    v = fmaxf(v, dpp_f<0xB1>(v)); v = fmaxf(v, dpp_f<0x4E>(v)); v = fmaxf(v, dpp_f<0x141>(v)); v = fmaxf(v, dpp_f<0x140>(v));
    const float a = __builtin_bit_cast(float, __builtin_amdgcn_readlane(__builtin_bit_cast(int, v), 0));
    const float b = __builtin_bit_cast(float, __builtin_amdgcn_readlane(__builtin_bit_cast(int, v), 16));
    const float c = __builtin_bit_cast(float, __builtin_amdgcn_readlane(__builtin_bit_cast(int, v), 32));
    const float d = __builtin_bit_cast(float, __builtin_amdgcn_readlane(__builtin_bit_cast(int, v), 48));
    return fmaxf(fmaxf(a, b), fmaxf(c, d));
}
#define LDS_WAIT() asm volatile("s_waitcnt lgkmcnt(0)" ::: "memory")

struct P {
    const float* in[30]; float* out; unsigned char* ws; int ph_lo, ph_hi;
};
enum { I_X = 0, I_META, I_NMW, I_WIN, I_MU, I_W0, I_W2, I_A0, I_A2, I_G2, I_KK, I_KA, I_RK, I_LNW, I_LNB, I_KVNW, I_WUK, I_WUV, I_ILNW, I_ILNB,
       I_WPA, I_WPB, I_WGATE, I_WOUT, I_NFW, I_WFI, I_CW, I_CB, I_WFO, I_NFIN };

template <int MODE>
__device__ __forceinline__ void tr_item(const float* W, int K, int N, int Npad, bf16_t* WT, LAS float* scr, int item, int lane) {
    const int nblk = Npad / 32, kb = item / nblk, nb = item % nblk, k0 = 64 * kb, n0 = 32 * nb;
    int s0 = n0; bool valid = n0 < N;
    if (MODE == 1) { const int T = n0 >> 8, w = n0 & 255; s0 = (w < 128) ? T * 128 + w : DFF + T * 128 + (w - 128); valid = true; }
    if (valid) {
#pragma unroll 8
        for (int i = 0; i < 32; ++i) { const int kk = 2 * i + (lane >> 5); scr[kk * 33 + (lane & 31)] = W[(size_t)(k0 + kk) * N + s0 + (lane & 31)]; }
    } else {
#pragma unroll 8
        for (int i = 0; i < 32; ++i) { const int kk = 2 * i + (lane >> 5); scr[kk * 33 + (lane & 31)] = 0.f; }
    }
    LDS_WAIT(); __builtin_amdgcn_wave_barrier();
    const int c = lane & 7;
#pragma unroll
    for (int j = 0; j < 4; ++j) { const int n = (lane >> 3) + 8 * j; const LAS float* s = scr + (8 * c) * 33 + n;
        u32x4 o; o.x = pk2(s[0 * 33], s[1 * 33]); o.y = pk2(s[2 * 33], s[3 * 33]); o.z = pk2(s[4 * 33], s[5 * 33]); o.w = pk2(s[6 * 33], s[7 * 33]);
        *(u32x4*)(WT + (size_t)(n0 + n) * K + k0 + 8 * c) = o; }
    LDS_WAIT(); __builtin_amdgcn_wave_barrier();
}
__device__ __forceinline__ void colmax_item(const float* W, int N, unsigned* cmx, int it) {
    const int nb = (N + 511) / 512, kc = it / nb, n = (it % nb) * 512 + threadIdx.x;
    if (n < N) { float m = 0.f; const float* wp = W + (size_t)kc * 64 * N + n;
#pragma unroll 8
        for (int k = 0; k < 64; ++k) m = fmaxf(m, fabsf(wp[(size_t)k * N]));
        atomicMax(cmx + n, __float_as_uint(m)); }
}
template <int MODE>
__device__ __forceinline__ void tr_item_i8(const float* W, int K, int N, int Npad, signed char* WT, const unsigned* cmx, float* sbdst, LAS float* scr, int item, int lane) {
    const int nblk = Npad / 32, kb = item / nblk, nb = item % nblk, k0 = 64 * kb, n0 = 32 * nb;
    int s0 = n0; bool valid = n0 < N;
    if (MODE == 1) { const int T = n0 >> 8, w = n0 & 255; s0 = (w < 128) ? T * 128 + w : DFF + T * 128 + (w - 128); valid = true; }
    if (valid) {
#pragma unroll 8
        for (int i = 0; i < 32; ++i) { const int kk = 2 * i + (lane >> 5); scr[kk * 33 + (lane & 31)] = W[(size_t)(k0 + kk) * N + s0 + (lane & 31)]; }
    } else {
#pragma unroll 8
        for (int i = 0; i < 32; ++i) { const int kk = 2 * i + (lane >> 5); scr[kk * 33 + (lane & 31)] = 0.f; }
    }
    LDS_WAIT(); __builtin_amdgcn_wave_barrier();
    const int n = lane >> 1, half = lane & 1;
    const float mx = valid ? __uint_as_float(cmx[s0 + n]) : 0.f; const float inv = mx > 0.f ? 127.f / mx : 0.f;
    unsigned o[8];
#pragma unroll
    for (int c = 0; c < 8; ++c) { unsigned w = 0u;
#pragma unroll
        for (int e = 0; e < 4; ++e) { const int qv = (int)rintf(scr[(half * 32 + c * 4 + e) * 33 + n] * inv); w |= ((unsigned)qv & 0xffu) << (8 * e); }
        o[c] = w; }
    *(u32x4*)(WT + (size_t)(n0 + n) * K + k0 + half * 32) = (u32x4){o[0], o[1], o[2], o[3]};
    *(u32x4*)(WT + (size_t)(n0 + n) * K + k0 + half * 32 + 16) = (u32x4){o[4], o[5], o[6], o[7]};
    if (kb == 0 && half == 0) sbdst[n0 + n] = mx * (1.f / 127.f);
    LDS_WAIT(); __builtin_amdgcn_wave_barrier();
}
template <bool DUAL = false> __device__ __forceinline__ void rms_row_i8(const float* src, const float* w, signed char* dst, float* sa, int lane, float eps, bf16_t* dstb = nullptr) {
    if (src == nullptr) {
        if (DUAL) {
#pragma unroll
            for (int j = 0; j < 8; ++j) *(u32x4*)(dstb + (j * 64 + lane) * 8) = (u32x4){0u, 0u, 0u, 0u}; }
#pragma unroll
        for (int j = 0; j < 4; ++j) *(u32x4*)(dst + (j * 64 + lane) * 16) = (u32x4){0u, 0u, 0u, 0u};
        if (lane == 0) *sa = 1.f;
        return;
    }
    f32x4 v[16]; float s = 0.f;
#pragma unroll
    for (int j = 0; j < 16; ++j) { v[j] = *(const f32x4*)(src + (j * 64 + lane) * 4); s += (v[j].x * v[j].x + v[j].y * v[j].y) + (v[j].z * v[j].z + v[j].w * v[j].w); }
    const float r = rsqrtf(wave_sum(s) * (1.f / D) + eps);
    float mx = 0.f;
#pragma unroll
    for (int j = 0; j < 16; ++j) { const f32x4 g = *(const f32x4*)(w + (j * 64 + lane) * 4); v[j] = v[j] * r * g; mx = fmaxf(mx, fmaxf(fmaxf(fabsf(v[j].x), fabsf(v[j].y)), fmaxf(fabsf(v[j].z), fabsf(v[j].w))));
        if (DUAL) { u32x2 o; o.x = pk2(v[j].x, v[j].y); o.y = pk2(v[j].z, v[j].w); *(u32x2*)(dstb + (j * 64 + lane) * 4) = o; } }
    mx = wave_max(mx);
    const float inv = mx > 0.f ? 127.f / mx : 0.f;
#pragma unroll
    for (int j = 0; j < 16; ++j) { const unsigned q = ((unsigned)(int)rintf(v[j].x * inv) & 0xffu) | (((unsigned)(int)rintf(v[j].y * inv) & 0xffu) << 8) | (((unsigned)(int)rintf(v[j].z * inv) & 0xffu) << 16) | (((unsigned)(int)rintf(v[j].w * inv) & 0xffu) << 24);
        *(unsigned*)(dst + (j * 64 + lane) * 4) = q; }
    if (lane == 0) *sa = mx > 0.f ? mx * (1.f / 127.f) : 1.f;
}
__device__ __forceinline__ void rms_row_bf16(const float* src, const float* w, bf16_t* dst, int lane, float eps) {
    if (src == nullptr) {
#pragma unroll
        for (int j = 0; j < 8; ++j) *(u32x4*)(dst + (j * 64 + lane) * 8) = (u32x4){0u, 0u, 0u, 0u};
        return;
    }
    f32x4 v[16]; float s = 0.f;
#pragma unroll
    for (int j = 0; j < 16; ++j) { v[j] = *(const f32x4*)(src + (j * 64 + lane) * 4); s += (v[j].x * v[j].x + v[j].y * v[j].y) + (v[j].z * v[j].z + v[j].w * v[j].w); }
    const float r = rsqrtf(wave_sum(s) * (1.f / D) + eps);
#pragma unroll
    for (int j = 0; j < 16; ++j) { const f32x4 g = *(const f32x4*)(w + (j * 64 + lane) * 4);
        u32x2 o; o.x = pk2(v[j].x * r * g.x, v[j].y * r * g.y); o.y = pk2(v[j].z * r * g.z, v[j].w * r * g.w);
        *(u32x2*)(dst + (j * 64 + lane) * 4) = o; }
}
__device__ __forceinline__ void p0_prologue_a(const P& p, LAS unsigned char* lds, int G) {
    const int tid = threadIdx.x, lane = tid & 63, wave = tid >> 6;
    LAS float* scr = (LAS float*)(lds + wave * 16384);
    const int gw = blockIdx.x * NWAVES + wave, NGW = G * NWAVES;
    unsigned char* ws = p.ws;
    {
        constexpr int C0 = 64 * ((IN_COLS + 511) / 512), C1 = 64 * (8192 / 512), C2 = 64 * (NFI / 512);
        for (int it = blockIdx.x; it < C0 + C1 + C2; it += G) {
            if (it < C0) colmax_item(p.in[I_WIN], IN_COLS, (unsigned*)(ws + WS_CTL + CT_CMX_IN), it);
            else if (it < C0 + C1) colmax_item(p.in[I_WGATE], 8192, (unsigned*)(ws + WS_CTL + CT_CMX_G), it - C0);
            else colmax_item(p.in[I_WFI], NFI, (unsigned*)(ws + WS_CTL + CT_CMX_F), it - C0 - C1);
        } }
    for (int it = gw; it < 16 * 32; it += NGW) { const int hh = it >> 5;
        tr_item<0>(p.in[I_WUV] + (size_t)hh * KVR * HD_B, KVR, HD_B, HD_B, (bf16_t*)(ws + WS_WUVT) + (size_t)hh * HD_B * KVR, scr, it & 31, lane); }
    for (size_t i = (size_t)blockIdx.x * NT + threadIdx.x; i < (size_t)16 * 512 * 128 / 4; i += (size_t)G * NT) {
        const f32x4 v = *(const f32x4*)(p.in[I_WUK] + i * 4); u32x2 o; o.x = pk2(v.x, v.y); o.y = pk2(v.z, v.w); *(u32x2*)((bf16_t*)(ws + WS_WUKB) + i * 4) = o; }
    for (int i = blockIdx.x * NT + threadIdx.x; i < 448 * 2048; i += G * NT) { const int j = i >> 11, c = i & 2047;
        const float v = j < 96 ? p.in[I_W2][(size_t)j * 2048 + c] : (j < 192 ? p.in[I_A2][(size_t)(j - 96) * 2048 + c] : p.in[I_G2][(size_t)(j - 192) * 2048 + c]);
        ((bf16_t*)(ws + WS_WLT))[(size_t)c * 448 + j] = f2bf(v); }
    signed char* U8 = (signed char*)(ws + WS_U); float* SA = (float*)(ws + WS_CTL + CT_SA);
    for (int m = gw; m < MP; m += NGW) {
        const float* src = m < NMETA ? p.in[I_META] + (size_t)m * D : (m < L ? p.in[I_X] + (size_t)(m - NMETA) * D : nullptr);
        rms_row_i8<true>(src, p.in[I_NMW], U8 + (size_t)m * D, SA + m, lane, 1e-6f, (bf16_t*)(ws + WS_R1) + (size_t)m * D);
    }
}
__device__ __forceinline__ void p0_prologue_b(const P& p, LAS unsigned char* lds, int G) {
    const int lane = threadIdx.x & 63, wave = threadIdx.x >> 6;
    LAS float* scr = (LAS float*)(lds + wave * 16384);
    const int gw = blockIdx.x * NWAVES + wave, NGW = G * NWAVES;
    constexpr int I0 = (4096 / 64) * (NZ / 32);
    for (int it = gw; it < I0; it += NGW) {
        const int nb = it % (NZ / 32);
        if (nb * 32 < NZ8) tr_item_i8<0>(p.in[I_WIN], 4096, IN_COLS, NZ, (signed char*)(p.ws + WS_WINT), (const unsigned*)(p.ws + WS_CTL + CT_CMX_IN), (float*)(p.ws + WS_CTL + CT_SB_IN), scr, it, lane);
        else tr_item<0>(p.in[I_WIN], 4096, IN_COLS, NZ, (bf16_t*)(p.ws + WS_WINT + WINT_BF_OFF) - (size_t)NZ8 * 4096, scr, it, lane);
    }
}
__device__ __forceinline__ void p0b_weights(const P& p, LAS unsigned char* lds, int vw, int nvw) {
    const int lane = threadIdx.x & 63, wave = threadIdx.x >> 6;
    LAS float* scr = (LAS float*)(lds + wave * 16384);
    unsigned char* ws = p.ws;
    constexpr int I1 = (4096 / 64) * (8192 / 32), I2 = (2048 / 64) * (4096 / 32), I3 = I2, I4 = (4096 / 64) * (4096 / 32), I5 = (4096 / 64) * (NFI / 32), I6 = (DFF / 64) * (4096 / 32);
    constexpr int NITEMS = I1 + I2 + I3 + I4 + I5 + I6;
    for (int it = vw; it < NITEMS; it += nvw) {
        int r = it;
        if (r < I1) { tr_item_i8<0>(p.in[I_WGATE], 4096, 8192, 8192, (signed char*)(ws + WS_WGT), (const unsigned*)(ws + WS_CTL + CT_CMX_G), (float*)(ws + WS_CTL + CT_SB_G), scr, r, lane); continue; } r -= I1;
        if (r < I2) { tr_item<0>(p.in[I_WPA], 2048, 4096, 4096, (bf16_t*)(ws + WS_WPAT), scr, r, lane); continue; } r -= I2;
        if (r < I3) { tr_item<0>(p.in[I_WPB], 2048, 4096, 4096, (bf16_t*)(ws + WS_WPBT), scr, r, lane); continue; } r -= I3;
        if (r < I4) { tr_item<0>(p.in[I_WOUT], 4096, 4096, 4096, (bf16_t*)(ws + WS_WOUTT), scr, r, lane); continue; } r -= I4;
        if (r < I5) { tr_item_i8<1>(p.in[I_WFI], 4096, NFI, NFI, (signed char*)(ws + WS_WFIT), (const unsigned*)(ws + WS_CTL + CT_CMX_F), (float*)(ws + WS_CTL + CT_SB_F), scr, r, lane); continue; } r -= I5;
        tr_item<0>(p.in[I_WFO], DFF, 4096, 4096, (bf16_t*)(ws + WS_WFOT), scr, r, lane);
    }
}

typedef short bf16x8p_t __attribute__((ext_vector_type(8)));
template <int CTRL> __device__ __forceinline__ float dpp_shr0(float v) { return __builtin_bit_cast(float, __builtin_amdgcn_update_dpp(0, __builtin_bit_cast(int, v), CTRL, 0xf, 0xf, true)); }
__device__ __forceinline__ void p2_rwkv_prep(const P& p, LAS unsigned char* lds, int G) {
    const int tid = threadIdx.x, lane = tid & 63, wave = __builtin_amdgcn_readfirstlane(tid >> 6), r16 = lane & 15, q = lane >> 4;
    const bf16_t* Z = (const bf16_t*)(p.ws + WS_Z); const bf16_t* WLT = (const bf16_t*)(p.ws + WS_WLT);
    float* CSo = (float*)(p.ws + WS_LD); bf16_t* AAo = (bf16_t*)(p.ws + WS_AA); bf16_t* GGo = (bf16_t*)(p.ws + WS_GG);
    constexpr int AST = 456;
    LAS bf16_t* act = (LAS bf16_t*)lds;
    const float* mu = p.in[I_MU] + 6144;
    for (int item = blockIdx.x; item < 256; item += G) {
        const int ct = item & 15, tr = item >> 4;
        const int ch = ct * 128 + wave * 16 + r16;
        bf16x8p_t af[14];
#pragma unroll
        for (int ks = 0; ks < 14; ++ks) af[ks] = *(const bf16x8p_t*)(WLT + (size_t)ch * 448 + ks * 32 + q * 8);
        const int c4 = ct * 128 + wave * 16 + q * 4;
        const f32x4 w0v = *(const f32x4*)(p.in[I_W0] + c4), a0v = *(const f32x4*)(p.in[I_A0] + c4);
        const int st0 = tr * 16, st1 = tr == 15 ? 257 : st0 + 16;
        for (int st = st0; st < st1; ++st) {
            const int t0 = st * 64;
            __syncthreads();
            {
                u32x4 za[7], zp[7];
#pragma unroll
                for (int k = 0; k < 7; ++k) { const int cidx = tid + k * NT, t = cidx / 56, j8 = (cidx % 56) * 8; int tg = t0 + t; if (tg > L - 1) tg = L - 1; const int tp = tg > 0 ? tg - 1 : 0;
                    za[k] = *(const u32x4*)(Z + (size_t)tg * NZ + 6144 + j8); zp[k] = *(const u32x4*)(Z + (size_t)tp * NZ + 6144 + j8); }
#pragma unroll
                for (int k = 0; k < 7; ++k) { const int cidx = tid + k * NT, t = cidx / 56, j8 = (cidx % 56) * 8, tg = t0 + t;
                    u32x4 o = (u32x4){0u, 0u, 0u, 0u};
                    if (tg < L) {
                        const f32x4 m0 = *(const f32x4*)(mu + j8), m1 = *(const f32x4*)(mu + j8 + 4);
                        const float a[8] = {blo(za[k].x), bhi(za[k].x), blo(za[k].y), bhi(za[k].y), blo(za[k].z), bhi(za[k].z), blo(za[k].w), bhi(za[k].w)};
                        float b[8] = {blo(zp[k].x), bhi(zp[k].x), blo(zp[k].y), bhi(zp[k].y), blo(zp[k].z), bhi(zp[k].z), blo(zp[k].w), bhi(zp[k].w)};
                        if (tg == 0) {
#pragma unroll
                            for (int e = 0; e < 8; ++e) b[e] = 0.f; }
                        const float m[8] = {m0.x, m0.y, m0.z, m0.w, m1.x, m1.y, m1.z, m1.w};
                        float v[8];
#pragma unroll
                        for (int e = 0; e < 8; ++e) { const float zs = a[e] + (b[e] - a[e]) * m[e]; const bool ist = j8 < 96, isi = j8 < 192;
                            const float r = __builtin_amdgcn_rcpf(1.f + __expf(ist ? 2.f * zs : -zs)); v[e] = ist ? 1.f - 2.f * r : (isi ? zs : r); }
                        o.x = pk2(v[0], v[1]); o.y = pk2(v[2], v[3]); o.z = pk2(v[4], v[5]); o.w = pk2(v[6], v[7]);
                    }
                    *(LAS u32x4*)(act + t * AST + j8) = o; }
            }
            __syncthreads();
#pragma unroll 1
            for (int nt = 0; nt < 4; ++nt) {
                f32x4 cw = {0.f, 0.f, 0.f, 0.f}, ca = cw, cg = cw;
                const LAS bf16_t* ar = act + (nt * 16 + r16) * AST + q * 8;
#pragma unroll
                for (int ks = 0; ks < 3; ++ks) cw = __builtin_amdgcn_mfma_f32_16x16x32_bf16(af[ks], *(const LAS bf16x8p_t*)(ar + ks * 32), cw, 0, 0, 0);
#pragma unroll
                for (int ks = 3; ks < 6; ++ks) ca = __builtin_amdgcn_mfma_f32_16x16x32_bf16(af[ks], *(const LAS bf16x8p_t*)(ar + ks * 32), ca, 0, 0, 0);
#pragma unroll
                for (int ks = 6; ks < 14; ++ks) cg = __builtin_amdgcn_mfma_f32_16x16x32_bf16(af[ks], *(const LAS bf16x8p_t*)(ar + ks * 32), cg, 0, 0, 0);
                f32x4 ld;
#pragma unroll
                for (int e = 0; e < 4; ++e) { const float xx = -(w0v[e] + cw[e]); const float sp = xx > 20.f ? xx : __logf(1.f + __expf(xx)); ld[e] = -__expf(-sp - 0.5f); }
#pragma unroll
                for (int e = 0; e < 4; ++e) { float x = ld[e]; x += dpp_shr0<0x111>(x); x += dpp_shr0<0x112>(x); x += dpp_shr0<0x114>(x); x += dpp_shr0<0x118>(x); ld[e] = x; }
                const int tg = t0 + nt * 16 + r16;
                if (tg < L) {
                    *(f32x4*)(CSo + (size_t)tg * A_W + c4) = ld;
                    u32x2 oa, og; oa.x = pk2(sigm(a0v[0] + ca[0]), sigm(a0v[1] + ca[1])); oa.y = pk2(sigm(a0v[2] + ca[2]), sigm(a0v[3] + ca[3]));
                    og.x = pk2(cg[0], cg[1]); og.y = pk2(cg[2], cg[3]);
                    *(u32x2*)(AAo + (size_t)tg * A_W + c4) = oa; *(u32x2*)(GGo + (size_t)tg * A_W + c4) = og;
                }
            }
        }
    }
}


typedef short bf16x8_t __attribute__((ext_vector_type(8)));
constexpr int NCHUNK = 257, NITEM = NCHUNK * 32, RS = 72, SLOT = 64 * RS * 2;
constexpr int GAM_OFF = 15 * SLOT;
constexpr size_t GTP_OFF = 0, HT_OFF = (size_t)8192 * 8192;
typedef __bf16 bf16x2v_t __attribute__((ext_vector_type(2)));
typedef float f32x2v_t __attribute__((ext_vector_type(2)));
__device__ __forceinline__ unsigned cvtpk(float lo, float hi) { const f32x2v_t v = {lo, hi}; const bf16x2v_t b = __builtin_convertvector(v, bf16x2v_t); return __builtin_bit_cast(unsigned, b); }
__device__ __forceinline__ void mm2(const LAS bf16_t* X, const LAS bf16_t* Y, int tm, int tn0, int r, int q, f32x4& c0, f32x4& c1) {
#pragma unroll
    for (int s = 0; s < 2; ++s) {
        const bf16x8_t a = *(const LAS bf16x8_t*)(X + (tm * 16 + r) * RS + s * 32 + q * 8);
        const bf16x8_t b0 = *(const LAS bf16x8_t*)(Y + (tn0 * 16 + r) * RS + s * 32 + q * 8);
        const bf16x8_t b1 = *(const LAS bf16x8_t*)(Y + ((tn0 + 1) * 16 + r) * RS + s * 32 + q * 8);
        c0 = __builtin_amdgcn_mfma_f32_16x16x32_bf16(a, b0, c0, 0, 0, 0);
        c1 = __builtin_amdgcn_mfma_f32_16x16x32_bf16(a, b1, c1, 0, 0, 0);
    }
}
__device__ __forceinline__ void st_cheap(LAS bf16_t* B, int m0, int n, const f32x4& c) {
    u32x2 w; w.x = cvtpk(c[0], c[1]); w.y = cvtpk(c[2], c[3]); *(LAS u32x2*)(B + n * RS + m0) = w;
}
__device__ __forceinline__ void st_scat(LAS bf16_t* B, int m0, int n, const f32x4& c) {
#pragma unroll
    for (int e = 0; e < 4; ++e) B[(m0 + e) * RS + n] = f2bf(c[e]);
}
template <int CTRL> __device__ __forceinline__ float dpp_add(float v) { return v + dpp_f<CTRL>(v); }
__device__ __forceinline__ float sum8(float v) { v = dpp_add<0xB1>(v); v = dpp_add<0x4E>(v); v = dpp_add<0x141>(v); return v; }

struct RaIn { u32x4 r0, k0, v0, r1, k1, v1, a0; f32x4 c0v, c1v, p0, p1, ba[3], bb[3]; };
__device__ __forceinline__ void ra_load(RaIn& I, const bf16_t* Z, const float* CS, const bf16_t* AAi, int ch, int h, int tid) {
    const int t = tid >> 3, k8 = (tid & 7) * 8, c0 = h * 64 + k8; int tg = ch * 64 + t; if (tg > L - 1) tg = L - 1; const int tp = tg > 0 ? tg - 1 : 0;
    const bf16_t* zr = Z + (size_t)tg * NZ + c0; const bf16_t* zp = Z + (size_t)tp * NZ + c0;
    I.r0 = *(const u32x4*)zr; I.k0 = *(const u32x4*)(zr + 2048); I.v0 = *(const u32x4*)(zr + 4096);
    I.r1 = *(const u32x4*)zp; I.k1 = *(const u32x4*)(zp + 2048); I.v1 = *(const u32x4*)(zp + 4096);
    I.a0 = *(const u32x4*)(AAi + (size_t)tg * A_W + c0);
    const float* cs = CS + (size_t)tg * A_W + c0; const float* cp = CS + (size_t)tp * A_W + c0;
    I.c0v = *(const f32x4*)cs; I.c1v = *(const f32x4*)(cs + 4); I.p0 = *(const f32x4*)cp; I.p1 = *(const f32x4*)(cp + 4);
#pragma unroll
    for (int b = 0; b < 3; ++b) { int rb = ch * 64 + b * 16 + 15; if (rb > L - 1) rb = L - 1; const float* ce = CS + (size_t)rb * A_W + c0; I.ba[b] = *(const f32x4*)ce; I.bb[b] = *(const f32x4*)(ce + 4); }
}
#define LDS_BARRIER() do { asm volatile("s_waitcnt lgkmcnt(0)" ::: "memory"); __builtin_amdgcn_s_barrier(); asm volatile("" ::: "memory"); } while (0)
__device__ __forceinline__ void ra_items(const P& p, LAS unsigned char* lds, int G) {
    const int tid = threadIdx.x, lane = tid & 63, wave = __builtin_amdgcn_readfirstlane(tid >> 6), r16 = lane & 15, q = lane >> 4;
    const int tm = wave >> 1, tn0 = (wave & 1) * 2;
    const bf16_t* Z = (const bf16_t*)(p.ws + WS_Z); const float* CS = (const float*)(p.ws + WS_LD); const bf16_t* AAi = (const bf16_t*)(p.ws + WS_AA);
    bf16_t* GTP = (bf16_t*)((unsigned char*)p.out + GTP_OFF); float* HT = (float*)((unsigned char*)p.out + HT_OFF);
    bf16_t* PPo = (bf16_t*)(p.ws + WS_YB); bf16_t* Y0o = (bf16_t*)(p.ws + WS_YA); float* BS = (float*)(p.ws + WS_BS);
    LAS bf16_t* sl[15];
#pragma unroll
    for (int i = 0; i < 15; ++i) sl[i] = (LAS bf16_t*)(lds + i * SLOT);
    LAS float* gam = (LAS float*)(lds + GAM_OFF);
    LAS bf16_t *Al_r = sl[0], *Be_r = sl[1], *Ka_r = sl[2], *Al_t = sl[3], *Be_t = sl[4], *Ka_t = sl[5], *Rh_r = sl[6], *V_t = sl[7];
    LAS bf16_t *N_r = sl[8], *N_t = sl[9], *LAK = sl[10], *MRK = sl[11], *MRB = sl[12], *Q_t = sl[13], *T_a = sl[14], *T_b = sl[0], *Q_r = sl[1];
    LAS bf16_t *W_t = sl[8], *X1_t = sl[9], *U0_t = sl[1];
    const bool fixed_h = (G & 31) == 0;
    const int nit = fixed_h ? (NCHUNK - (int)(blockIdx.x >> 5) + (G >> 5) - 1) / (G >> 5) : (NITEM - (int)blockIdx.x + G - 1) / G;
    auto item_of = [&](int i, int& ch, int& h) { if (fixed_h) { h = blockIdx.x & 31; ch = (int)(blockIdx.x >> 5) + i * (G >> 5); } else { const int it = (int)blockIdx.x + i * G; ch = it >> 5; h = it & 31; } };
    float pmr[8], pmk[8], pmv[8], pkk[8], pka[8], prk[8]; int h_par = -1;
    RaIn I; { int ch0, h0; item_of(0, ch0, h0); if (nit > 0) ra_load(I, Z, CS, AAi, ch0, h0, tid); }
    for (int ii = 0; ii < nit; ++ii) {
        int ch, h; item_of(ii, ch, h); const int item = ch * 32 + h;
        if (h != h_par) { const int c0 = h * 64 + (tid & 7) * 8;
#pragma unroll
            for (int e = 0; e < 8; ++e) { pmr[e] = p.in[I_MU][c0 + e]; pmk[e] = p.in[I_MU][2048 + c0 + e]; pmv[e] = p.in[I_MU][4096 + c0 + e]; pkk[e] = p.in[I_KK][c0 + e]; pka[e] = p.in[I_KA][c0 + e]; prk[e] = p.in[I_RK][c0 + e]; }
            h_par = h; }
        LDS_BARRIER();
        {
            const int t = tid >> 3, k8 = (tid & 7) * 8, tg = ch * 64 + t;
            float Av[8], Bv[8], Kv[8], Rv[8], Vv[8];
            const bool valid = tg < L, hasp = tg > 0;
            {
                float lc[8], lx[8];
                {   float base[8];
#pragma unroll
                    for (int e = 0; e < 8; ++e) base[e] = 0.f;
#pragma unroll
                    for (int b = 0; b < 3; ++b) if (b < (t >> 4)) {
#pragma unroll
                        for (int e = 0; e < 4; ++e) { base[e] += I.ba[b][e]; base[4 + e] += I.bb[b][e]; } }
                    const bool pin = (t & 15) != 0;
#pragma unroll
                    for (int e = 0; e < 4; ++e) { lc[e] = base[e] + I.c0v[e]; lc[4 + e] = base[4 + e] + I.c1v[e]; lx[e] = base[e] + (pin ? I.p0[e] : 0.f); lx[4 + e] = base[4 + e] + (pin ? I.p1[e] : 0.f); }
                }
                const unsigned rw[4] = {I.r0.x, I.r0.y, I.r0.z, I.r0.w}, kw[4] = {I.k0.x, I.k0.y, I.k0.z, I.k0.w}, vw[4] = {I.v0.x, I.v0.y, I.v0.z, I.v0.w};
                const unsigned rp[4] = {I.r1.x, I.r1.y, I.r1.z, I.r1.w}, kq[4] = {I.k1.x, I.k1.y, I.k1.z, I.k1.w}, vq[4] = {I.v1.x, I.v1.y, I.v1.z, I.v1.w}, aw[4] = {I.a0.x, I.a0.y, I.a0.z, I.a0.w};
                float rr[8], kk[8], kp[8], aa[8]; float ss = 0.f, bs = 0.f;
#pragma unroll
                for (int e = 0; e < 8; ++e) {
                    const int wi = e >> 1; const bool hi = e & 1;
                    const float zr_ = hi ? bhi(rw[wi]) : blo(rw[wi]), zk_ = hi ? bhi(kw[wi]) : blo(kw[wi]), zv_ = hi ? bhi(vw[wi]) : blo(vw[wi]);
                    float pr_ = hi ? bhi(rp[wi]) : blo(rp[wi]), pk_ = hi ? bhi(kq[wi]) : blo(kq[wi]), pv_ = hi ? bhi(vq[wi]) : blo(vq[wi]);
                    if (!hasp) { pr_ = 0.f; pk_ = 0.f; pv_ = 0.f; }
                    aa[e] = hi ? bhi(aw[wi]) : blo(aw[wi]);
                    rr[e] = zr_ + (pr_ - zr_) * pmr[e]; const float k_ = zk_ + (pk_ - zk_) * pmk[e]; Vv[e] = zv_ + (pv_ - zv_) * pmv[e];
                    kk[e] = k_ * pkk[e]; ss += kk[e] * kk[e];
                    kp[e] = k_ * (1.f + (aa[e] - 1.f) * pka[e]);
                    bs += rr[e] * kp[e] * prk[e];
                }
                ss = sum8(ss); bs = sum8(bs);
                const float rn = rsqrtf(ss + 1e-12f);
                if (valid && (tid & 7) == 0) BS[(size_t)tg * 32 + h] = bs;
#pragma unroll
                for (int e = 0; e < 8; ++e) {
                    const float kn = kk[e] * rn; const float ex = __expf(lx[e]), em = __expf(-lc[e]), ep = __expf(lc[e]);
                    Av[e] = kn * ex; Bv[e] = kn * aa[e] * em; Kv[e] = kp[e] * em; Rv[e] = rr[e] * ep;
                }
                if (t == 63) {
#pragma unroll
                    for (int e = 0; e < 8; ++e) gam[k8 + e] = __expf(valid ? lc[e] : (e < 4 ? I.c0v[e] : I.c1v[e - 4]));
                }
                if (!valid) {
#pragma unroll
                    for (int e = 0; e < 8; ++e) { Av[e] = 0.f; Bv[e] = 0.f; Kv[e] = 0.f; Rv[e] = 0.f; Vv[e] = 0.f; }
                }
            }
            u32x4 w;
            w.x = cvtpk(Av[0], Av[1]); w.y = cvtpk(Av[2], Av[3]); w.z = cvtpk(Av[4], Av[5]); w.w = cvtpk(Av[6], Av[7]); *(LAS u32x4*)(Al_r + t * RS + k8) = w;
            w.x = cvtpk(Bv[0], Bv[1]); w.y = cvtpk(Bv[2], Bv[3]); w.z = cvtpk(Bv[4], Bv[5]); w.w = cvtpk(Bv[6], Bv[7]); *(LAS u32x4*)(Be_r + t * RS + k8) = w;
            w.x = cvtpk(Kv[0], Kv[1]); w.y = cvtpk(Kv[2], Kv[3]); w.z = cvtpk(Kv[4], Kv[5]); w.w = cvtpk(Kv[6], Kv[7]); *(LAS u32x4*)(Ka_r + t * RS + k8) = w;
            w.x = cvtpk(Rv[0], Rv[1]); w.y = cvtpk(Rv[2], Rv[3]); w.z = cvtpk(Rv[4], Rv[5]); w.w = cvtpk(Rv[6], Rv[7]); *(LAS u32x4*)(Rh_r + t * RS + k8) = w;
#pragma unroll
            for (int e = 0; e < 8; ++e) { Al_t[(k8 + e) * RS + t] = f2bf(Av[e]); Be_t[(k8 + e) * RS + t] = f2bf(Bv[e]); Ka_t[(k8 + e) * RS + t] = f2bf(Kv[e]); V_t[(k8 + e) * RS + t] = f2bf(Vv[e]); }
        }
        if (ii + 1 < nit) { int ch1, h1; item_of(ii + 1, ch1, h1); ra_load(I, Z, CS, AAi, ch1, h1, tid); }
        LDS_BARRIER();
        {
            f32x4 cab0 = {0.f, 0.f, 0.f, 0.f}, cab1 = cab0, cak0 = cab0, cak1 = cab0, crk0 = cab0, crk1 = cab0, crb0 = cab0, crb1 = cab0;
            mm2(Be_r, Al_r, tm, tn0, r16, q, cab0, cab1); mm2(Ka_r, Al_r, tm, tn0, r16, q, cak0, cak1);
            mm2(Ka_r, Rh_r, tm, tn0, r16, q, crk0, crk1); mm2(Be_r, Rh_r, tm, tn0, r16, q, crb0, crb1);
            const int s0 = tm * 16 + q * 4;
#pragma unroll
            for (int j = 0; j < 2; ++j) {
                const int t = (tn0 + j) * 16 + r16;
                f32x4 ab = j ? cab1 : cab0, ak = j ? cak1 : cak0, rk = j ? crk1 : crk0, rb = j ? crb1 : crb0, nn, t0;
#pragma unroll
                for (int e = 0; e < 4; ++e) { const int s = s0 + e; nn[e] = s < t ? -ab[e] : 0.f; t0[e] = nn[e] + (s == t ? 1.f : 0.f); ak[e] = s < t ? ak[e] : 0.f; rk[e] = s <= t ? rk[e] : 0.f; rb[e] = s <= t ? rb[e] : 0.f; }
                st_cheap(N_r, s0, t, nn); st_scat(N_t, s0, t, nn); st_cheap(T_a, s0, t, t0); st_cheap(LAK, s0, t, ak); st_cheap(MRK, s0, t, rk); st_cheap(MRB, s0, t, rb);
            }
        }
        LDS_BARRIER();
        {
            LAS bf16_t* Pr = N_r; LAS bf16_t* Pt = N_t; LAS bf16_t* Qr = Q_r; LAS bf16_t* Qt = Q_t; LAS bf16_t* Tc = T_a; LAS bf16_t* Tn = T_b;
#pragma unroll 1
            for (int it = 0; it < 5; ++it) {
                {   f32x4 c0 = {0.f, 0.f, 0.f, 0.f}, c1 = c0;
                    mm2(Pr, Pt, tm, tn0, r16, q, c0, c1);
                    const int m0 = tm * 16 + q * 4;
                    st_cheap(Qt, m0, tn0 * 16 + r16, c0); st_cheap(Qt, m0, (tn0 + 1) * 16 + r16, c1);
                    st_scat(Qr, m0, tn0 * 16 + r16, c0); st_scat(Qr, m0, (tn0 + 1) * 16 + r16, c1); }
                LDS_BARRIER();
                {   f32x4 c0 = {0.f, 0.f, 0.f, 0.f}, c1 = c0;
                    mm2(Qt, Tc, tm, tn0, r16, q, c0, c1);
                    const int b0 = tm * 16 + q * 4;
#pragma unroll
                    for (int j = 0; j < 2; ++j) { const int a = (tn0 + j) * 16 + r16; const u32x2 o = *(const LAS u32x2*)(Tc + a * RS + b0); f32x4 c = j ? c1 : c0;
                        c[0] += blo(o.x); c[1] += bhi(o.x); c[2] += blo(o.y); c[3] += bhi(o.y); st_cheap(Tn, b0, a, c); } }
                LDS_BARRIER();
                LAS bf16_t* x = Pr; Pr = Qr; Qr = x; x = Pt; Pt = Qt; Qt = x; x = Tc; Tc = Tn; Tn = x;
            }
        }
        {
            f32x4 c0 = {0.f, 0.f, 0.f, 0.f}, c1 = c0, d0 = c0, d1 = c0;
            mm2(T_b, Al_t, tm, tn0, r16, q, c0, c1);
            mm2(LAK, V_t, tm, tn0, r16, q, d0, d1);
            const int t0 = tm * 16 + q * 4;
            st_cheap(W_t, t0, tn0 * 16 + r16, c0); st_cheap(W_t, t0, (tn0 + 1) * 16 + r16, c1);
            st_cheap(X1_t, t0, tn0 * 16 + r16, d0); st_cheap(X1_t, t0, (tn0 + 1) * 16 + r16, d1);
        }
        LDS_BARRIER();
        {
            f32x4 c0 = {0.f, 0.f, 0.f, 0.f}, c1 = c0;
            mm2(T_b, X1_t, tm, tn0, r16, q, c0, c1);
            const int t0 = tm * 16 + q * 4;
            st_cheap(U0_t, t0, tn0 * 16 + r16, c0); st_cheap(U0_t, t0, (tn0 + 1) * 16 + r16, c1);
        }
        LDS_BARRIER();
        {
            const int m0 = tm * 16 + q * 4;
            if (ch < 256) {
                f32x4 g0 = {0.f, 0.f, 0.f, 0.f}, g1 = g0, h0 = g0, h1 = g0, u0 = g0, u1 = g0;
                mm2(W_t, Be_t, tm, tn0, r16, q, g0, g1);
                mm2(Ka_t, V_t, tm, tn0, r16, q, h0, h1);
                mm2(Be_t, U0_t, tm, tn0, r16, q, u0, u1);
                const size_t it8 = (size_t)item;
#pragma unroll
                for (int j = 0; j < 2; ++j) {
                    const int n = (tn0 + j) * 16 + r16; const f32x4 g = j ? g1 : g0; const float gc = gam[n];
                    f32x4 o;
#pragma unroll
                    for (int e = 0; e < 4; ++e) o[e] = ((m0 + e == n ? 1.f : 0.f) - g[e]) * gc;
                    u32x2 w; w.x = cvtpk(o[0], o[1]); w.y = cvtpk(o[2], o[3]);
                    *(u32x2*)(GTP + it8 * 4096 + (size_t)n * 64 + 32 * (tm >> 1) + 8 * q + 4 * (tm & 1)) = w;
                    const f32x4 hh = (j ? h1 : h0) - (j ? u1 : u0);
                    const f32x4 gk = *(const LAS f32x4*)(gam + m0);
                    *(f32x4*)(HT + (it8 * 16 + tm * 4 + (tn0 + j)) * 256 + lane * 4) = hh * gk;
                }
            }
            f32x4 p0 = {0.f, 0.f, 0.f, 0.f}, p1 = p0, y0 = p0, y1 = p0, z0 = p0, z1 = p0;
            mm2(W_t, MRB, tm, tn0, r16, q, p0, p1);
            mm2(V_t, MRK, tm, tn0, r16, q, y0, y1);
            mm2(U0_t, MRB, tm, tn0, r16, q, z0, z1);
#pragma unroll
            for (int j = 0; j < 2; ++j) {
                const int t = (tn0 + j) * 16 + r16, tg = ch * 64 + t;
                const u32x2 o = *(const LAS u32x2*)(Rh_r + t * RS + m0); const f32x4 pm = j ? p1 : p0;
                u32x2 w; w.x = cvtpk(blo(o.x) - pm[0], bhi(o.x) - pm[1]); w.y = cvtpk(blo(o.y) - pm[2], bhi(o.y) - pm[3]);
                *(u32x2*)(PPo + (size_t)item * 4096 + t * 64 + m0) = w;
                if (tg < L) { const f32x4 yy = (j ? y1 : y0) - (j ? z1 : z0); u32x2 wy; wy.x = cvtpk(yy[0], yy[1]); wy.y = cvtpk(yy[2], yy[3]);
                    *(u32x2*)(Y0o + (size_t)tg * A_W + h * 64 + m0) = wy; }
            }
        }
    }
}

struct RbSet { bf16x8_t ga[4][2]; f32x4 hv[4]; };
__device__ __forceinline__ void rb_load(RbSet& S, const bf16_t* GTP, const float* HT, int c, int h, int vg, int lane, int r16, int q) {
    const size_t it8 = (size_t)(c < 256 ? c : 255) * 32 + h;
#pragma unroll
    for (int i = 0; i < 4; ++i) { S.hv[i] = *(const f32x4*)(HT + (it8 * 16 + i * 4 + vg) * 256 + lane * 4);
#pragma unroll
        for (int s = 0; s < 2; ++s) S.ga[i][s] = *(const bf16x8_t*)(GTP + it8 * 4096 + (size_t)(i * 16 + r16) * 64 + s * 32 + q * 8); }
}
__device__ __forceinline__ void rb_step(f32x4 (&acc)[4], const RbSet& S, bf16_t* ST, int c, int h, int vg, int r16, int q) {
    const size_t item = (size_t)c * 32 + h;
    unsigned w[8];
#pragma unroll
    for (int i = 0; i < 4; ++i) { w[2 * i] = cvtpk(acc[i][0], acc[i][1]); w[2 * i + 1] = cvtpk(acc[i][2], acc[i][3]);
        u32x2 o; o.x = w[2 * i]; o.y = w[2 * i + 1]; *(u32x2*)(ST + item * 4096 + (size_t)(vg * 16 + r16) * 64 + i * 16 + q * 4) = o; }
    const u32x4 b0 = (u32x4){w[0], w[1], w[2], w[3]}, b1 = (u32x4){w[4], w[5], w[6], w[7]};
    const bf16x8_t f0 = __builtin_bit_cast(bf16x8_t, b0), f1 = __builtin_bit_cast(bf16x8_t, b1);
#pragma unroll
    for (int i = 0; i < 4; ++i) { f32x4 a = S.hv[i];
        a = __builtin_amdgcn_mfma_f32_16x16x32_bf16(S.ga[i][0], f0, a, 0, 0, 0);
        a = __builtin_amdgcn_mfma_f32_16x16x32_bf16(S.ga[i][1], f1, a, 0, 0, 0);
        acc[i] = a; }
}
__device__ __forceinline__ void rb_chain(const P& p, int G) {
    const int tid = threadIdx.x, lane = tid & 63, wave = __builtin_amdgcn_readfirstlane(tid >> 6), r16 = lane & 15, q = lane >> 4;
    if (wave == 0) for (int cw = blockIdx.x; cw < 128; cw += G) {
        const int h = cw >> 2, vg = cw & 3;
        const bf16_t* GTP = (const bf16_t*)((const unsigned char*)p.out + GTP_OFF); const float* HT = (const float*)((const unsigned char*)p.out + HT_OFF);
        bf16_t* ST = (bf16_t*)(p.ws + WS_ST);
        f32x4 acc[4];
#pragma unroll
        for (int i = 0; i < 4; ++i) acc[i] = (f32x4){0.f, 0.f, 0.f, 0.f};
        RbSet S0, S1, S2, S3;
        rb_load(S0, GTP, HT, 0, h, vg, lane, r16, q); rb_load(S1, GTP, HT, 1, h, vg, lane, r16, q); rb_load(S2, GTP, HT, 2, h, vg, lane, r16, q); rb_load(S3, GTP, HT, 3, h, vg, lane, r16, q);
#pragma unroll 1
        for (int c = 0; c < 256; c += 4) {
            rb_step(acc, S0, ST, c, h, vg, r16, q);     rb_load(S0, GTP, HT, c + 4, h, vg, lane, r16, q);
            rb_step(acc, S1, ST, c + 1, h, vg, r16, q); rb_load(S1, GTP, HT, c + 5, h, vg, lane, r16, q);
            rb_step(acc, S2, ST, c + 2, h, vg, r16, q); rb_load(S2, GTP, HT, c + 6, h, vg, lane, r16, q);
            rb_step(acc, S3, ST, c + 3, h, vg, r16, q); rb_load(S3, GTP, HT, c + 7, h, vg, lane, r16, q);
        }
        {
            const size_t item = (size_t)256 * 32 + h;
#pragma unroll
            for (int i = 0; i < 4; ++i) { u32x2 o; o.x = cvtpk(acc[i][0], acc[i][1]); o.y = cvtpk(acc[i][2], acc[i][3]); *(u32x2*)(ST + item * 4096 + (size_t)(vg * 16 + r16) * 64 + i * 16 + q * 4) = o; }
        }
    }
}

__device__ __forceinline__ void rc_out(const P& p, int G) {
    const int tid = threadIdx.x, lane = tid & 63, wave = __builtin_amdgcn_readfirstlane(tid >> 6), r16 = lane & 15, q = lane >> 4;
    const bf16_t* Z = (const bf16_t*)(p.ws + WS_Z); const bf16_t* GGi = (const bf16_t*)(p.ws + WS_GG); const float* BS = (const float*)(p.ws + WS_BS);
    const bf16_t* ST = (const bf16_t*)(p.ws + WS_ST); const bf16_t* PPi = (const bf16_t*)(p.ws + WS_YB); bf16_t* YA = (bf16_t*)(p.ws + WS_YA);
    for (size_t i = (size_t)blockIdx.x * NT + tid; i < (size_t)(MP - L) * A_W / 8; i += (size_t)G * NT) *(u32x4*)(YA + (size_t)L * A_W + i * 8) = (u32x4){0u, 0u, 0u, 0u};
    const int tt = wave & 3;
    for (int item = blockIdx.x * 2 + (wave >> 2); item < NITEM; item += 2 * G) {
        const int ch = item >> 5, h = item & 31;
        const int t = tt * 16 + r16, tg = ch * 64 + t;
        f32x4 acc[4];
#pragma unroll
        for (int i = 0; i < 4; ++i) acc[i] = (f32x4){0.f, 0.f, 0.f, 0.f};
        const bf16_t* sp = ST + (size_t)item * 4096; const bf16_t* pp = PPi + (size_t)item * 4096 + (size_t)t * 64;
#pragma unroll
        for (int s = 0; s < 2; ++s) {
            const bf16x8_t b = *(const bf16x8_t*)(pp + s * 32 + q * 8);
#pragma unroll
            for (int i = 0; i < 4; ++i) { const bf16x8_t a = *(const bf16x8_t*)(sp + (size_t)(i * 16 + r16) * 64 + s * 32 + q * 8);
                acc[i] = __builtin_amdgcn_mfma_f32_16x16x32_bf16(a, b, acc[i], 0, 0, 0); }
        }
        if (tg < L) {
            float s1 = 0.f;
#pragma unroll
            for (int i = 0; i < 4; ++i) { const u32x2 y0 = *(const u32x2*)(YA + (size_t)tg * A_W + h * 64 + i * 16 + q * 4);
                acc[i][0] += blo(y0.x); acc[i][1] += bhi(y0.x); acc[i][2] += blo(y0.y); acc[i][3] += bhi(y0.y);
                s1 += (acc[i][0] + acc[i][1]) + (acc[i][2] + acc[i][3]); }
            s1 += __shfl_xor(s1, 16); s1 += __shfl_xor(s1, 32);
            const float mean = s1 * (1.f / 64.f);
            float s2 = 0.f;
#pragma unroll
            for (int i = 0; i < 4; ++i)
#pragma unroll
                for (int e = 0; e < 4; ++e) { const float d = acc[i][e] - mean; s2 += d * d; }
            s2 += __shfl_xor(s2, 16); s2 += __shfl_xor(s2, 32);
            const float rstd = rsqrtf(s2 * (1.f / 64.f) + 64e-5f);
            const float bs = BS[(size_t)tg * 32 + h];
#pragma unroll
            for (int i = 0; i < 4; ++i) {
                const int c = h * 64 + i * 16 + q * 4;
                const u32x2 zv = *(const u32x2*)(Z + (size_t)tg * NZ + 4096 + c);
                u32x2 pv = (u32x2){0u, 0u}; if (tg > 0) pv = *(const u32x2*)(Z + (size_t)(tg - 1) * NZ + 4096 + c);
                const u32x2 gg = *(const u32x2*)(GGi + (size_t)tg * A_W + c);
                const f32x4 lw = *(const f32x4*)(p.in[I_LNW] + c), lb = *(const f32x4*)(p.in[I_LNB] + c), mv = *(const f32x4*)(p.in[I_MU] + 4096 + c);
                const float zz[4] = {blo(zv.x), bhi(zv.x), blo(zv.y), bhi(zv.y)}, pz[4] = {blo(pv.x), bhi(pv.x), blo(pv.y), bhi(pv.y)}, gv[4] = {blo(gg.x), bhi(gg.x), blo(gg.y), bhi(gg.y)};
                float o[4];
#pragma unroll
                for (int e = 0; e < 4; ++e) { const float vv = zz[e] + (pz[e] - zz[e]) * mv[e]; const float yn = (acc[i][e] - mean) * rstd * lw[e] + lb[e]; o[e] = (yn + bs * vv) * gv[e]; }
                u32x2 w; w.x = cvtpk(o[0], o[1]); w.y = cvtpk(o[2], o[3]);
                *(u32x2*)(YA + (size_t)tg * A_W + c) = w;
            }
        }
    }
}


__device__ __forceinline__ void p4_dsa_prep(const P& p, int G) {
    const int tid = threadIdx.x, lane = tid & 63, wave = tid >> 6;
    const bf16_t* Z = (const bf16_t*)(p.ws + WS_Z);
    bf16_t* CKV = (bf16_t*)(p.ws + WS_CKV); float* KIDX = (float*)(p.ws + WS_KIDX);
    for (int t = blockIdx.x * NWAVES + wave; t < L; t += G * NWAVES) {
        const u32x4 raw = *(const u32x4*)(Z + (size_t)t * NZ + ZCKV + lane * 8);
        float x[8] = {blo(raw.x), bhi(raw.x), blo(raw.y), bhi(raw.y), blo(raw.z), bhi(raw.z), blo(raw.w), bhi(raw.w)};
        float s = 0.f;
#pragma unroll
        for (int e = 0; e < 8; ++e) s += x[e] * x[e];
        const float r = rsqrtf(wave_sum(s) * (1.f / KVR) + 1e-6f);
        const f32x4 w0 = *(const f32x4*)(p.in[I_KVNW] + lane * 8), w1 = *(const f32x4*)(p.in[I_KVNW] + lane * 8 + 4);
        u32x4 o; o.x = pk2(x[0] * r * w0.x, x[1] * r * w0.y); o.y = pk2(x[2] * r * w0.z, x[3] * r * w0.w); o.z = pk2(x[4] * r * w1.x, x[5] * r * w1.y); o.w = pk2(x[6] * r * w1.z, x[7] * r * w1.w);
        *(u32x4*)(CKV + (size_t)t * KVR + lane * 8) = o;
        const float ki = bf2f(Z[(size_t)t * NZ + ZKI + lane]);
        const float mean = wave_sum(ki) * (1.f / 64.f), dk = ki - mean, var = wave_sum(dk * dk) * (1.f / 64.f);
        const float kn_ = dk * rsqrtf(var + 1e-6f) * p.in[I_ILNW][lane] + p.in[I_ILNB][lane];
        KIDX[(size_t)t * IDXD + lane] = kn_;
        ((bf16_t*)(p.ws + WS_KIDXB))[(size_t)t * IDXD + lane] = f2bf(kn_);
    }
}

__device__ __forceinline__ unsigned fkey(float f) { const unsigned u = __float_as_uint(f); return (u & 0x80000000u) ? ~u : (u | 0x80000000u); }


typedef float f32x16 __attribute__((ext_vector_type(16)));
constexpr int SCR_N = 16416;
__device__ __forceinline__ unsigned lds_add(LAS unsigned* p, unsigned v) { return __hip_atomic_fetch_add(p, v, __ATOMIC_RELAXED, __HIP_MEMORY_SCOPE_WORKGROUP); }
constexpr int KST = 72, SELB = 8;
template <int NBL> __device__ __forceinline__ void wfind(const LAS unsigned* hist, unsigned target, int lane, unsigned& b, unsigned& ab) {
    unsigned loc[NBL]; unsigned s = 0;
#pragma unroll
    for (int j = 0; j < NBL; j += 4) { const u32x4 v4 = *(const LAS u32x4*)(hist + lane * NBL + j); loc[j] = v4.x; loc[j + 1] = v4.y; loc[j + 2] = v4.z; loc[j + 3] = v4.w; s += (v4.x + v4.y) + (v4.z + v4.w); }
    unsigned v = s;
#pragma unroll
    for (int d = 1; d < 64; d <<= 1) { const unsigned o = (unsigned)__shfl_down((int)v, d); if (lane + d < 64) v += o; }
    const unsigned above = v - s;
    const bool found = above < target && above + s >= target;
    unsigned bb = 0u, aa = 0u;
    if (found) { unsigned a = above;
#pragma unroll
        for (int j = NBL - 1; j >= 0; --j) { if (a < target && a + loc[j] >= target) { bb = (unsigned)(lane * NBL + j); aa = a; } a += loc[j]; } }
    const unsigned long long m = __ballot(found);
    const int src = m ? (int)__builtin_ctzll(m) : 0;
    b = (unsigned)__shfl((int)bb, src); ab = (unsigned)__shfl((int)aa, src);
}
__device__ __forceinline__ void d2_topk(const P& p, LAS unsigned char* lds, int G) {
    const int tid = threadIdx.x, lane = tid & 63, wave = __builtin_amdgcn_readfirstlane(tid >> 6);
    const bf16_t* Z = (const bf16_t*)(p.ws + WS_Z); const bf16_t* KB = (const bf16_t*)(p.ws + WS_KIDXB); int* SEL = (int*)(p.ws + WS_SEL);
    float* scr = (float*)(p.ws + WS_R1) + ((size_t)blockIdx.x * NWAVES + wave) * 2 * SCR_N;
    LAS bf16_t* ksb = (LAS bf16_t*)lds;
    LAS unsigned* hw = (LAS unsigned*)(lds + 73728) + wave * 2048;
    const int key_l = lane & 31, hh = lane >> 5;
    for (int t = blockIdx.x; t < NMETA + 192; t += G) { const int n = t < NMETA ? NMETA : NMETA + 64 * (1 + (t - NMETA) / 64);
        if (tid < TOPK) SEL[(size_t)t * TOPK + tid] = tid < n ? tid : -1; }
    const int nui = (G == 256) ? 4 : (1012 + G - 1) / G;
    for (int ui = 0; ui < nui; ++ui) {
        int i = (int)blockIdx.x + ui * G;
        if (G == 256) i = ui == 0 ? (int)blockIdx.x : (ui == 1 ? 511 - (int)blockIdx.x : (ui == 2 ? 512 + (int)blockIdx.x : 1023 - (int)blockIdx.x));
        if (i >= 1012) continue;
        const int c = 256 - (i >> 2), r = i & 3, n = NMETA + 64 * c;
        const int tA = NMETA + 64 * (c - 1) + 16 * r + 2 * wave;
        bf16x8_t af[2][4]; float wv[2][16];
#pragma unroll
        for (int qq = 0; qq < 2; ++qq) {
            const bf16_t* zr = Z + (size_t)(tA + qq) * NZ;
#pragma unroll
            for (int ks = 0; ks < 4; ++ks) af[qq][ks] = *(const bf16x8_t*)(zr + ZQI + key_l * 64 + ks * 16 + hh * 8);
#pragma unroll
            for (int g = 0; g < 4; ++g) { const u32x2 w2 = *(const u32x2*)(zr + ZWI + 8 * g + 4 * hh);
                wv[qq][g * 4 + 0] = blo(w2.x) * 0.02209708691207961f; wv[qq][g * 4 + 1] = bhi(w2.x) * 0.02209708691207961f;
                wv[qq][g * 4 + 2] = blo(w2.y) * 0.02209708691207961f; wv[qq][g * 4 + 3] = bhi(w2.y) * 0.02209708691207961f; }
        }
#pragma unroll
        for (int j = 0; j < 8; ++j) *(LAS u32x4*)(hw + (j * 64 + lane) * 4) = (u32x4){0u, 0u, 0u, 0u};
        const int nblk = (n + 255) >> 8;
        __syncthreads();
        {
            const int kk = tid >> 1, hf = tid & 1; const int src = kk < n ? kk : n - 1;
            const u32x4* gp = (const u32x4*)(KB + (size_t)src * IDXD + hf * 32);
#pragma unroll
            for (int j = 0; j < 4; ++j) *(LAS u32x4*)(ksb + kk * KST + hf * 32 + j * 8) = gp[j];
        }
        __syncthreads();
        for (int b = 0; b < nblk; ++b) {
            u32x4 pre[4];
            const bool more = b + 1 < nblk;
            if (more) { const int kk = (b + 1) * 256 + (tid >> 1); const int src = kk < n ? kk : n - 1; const u32x4* gp = (const u32x4*)(KB + (size_t)src * IDXD + (tid & 1) * 32);
#pragma unroll
                for (int j = 0; j < 4; ++j) pre[j] = gp[j]; }
            const LAS bf16_t* kb = ksb + (b & 1) * 256 * KST;
#pragma unroll 2
            for (int tt = 0; tt < 8; ++tt) {
                const int s0 = b * 256 + tt * 32;
                if (s0 < n) {
                    bf16x8_t bfr[4];
#pragma unroll
                    for (int ks = 0; ks < 4; ++ks) bfr[ks] = *(const LAS bf16x8_t*)(kb + (tt * 32 + key_l) * KST + ks * 16 + hh * 8);
                    float part[2];
#pragma unroll
                    for (int qq = 0; qq < 2; ++qq) {
                        f32x16 acc;
#pragma unroll
                        for (int e = 0; e < 16; ++e) acc[e] = 0.f;
#pragma unroll
                        for (int ks = 0; ks < 4; ++ks) acc = __builtin_amdgcn_mfma_f32_32x32x16_bf16(af[qq][ks], bfr[ks], acc, 0, 0, 0);
                        float s = 0.f;
                        float s0_ = 0.f, s1_ = 0.f;
#pragma unroll
                        for (int e = 0; e < 16; e += 2) { s0_ += wv[qq][e] * __builtin_amdgcn_fmed3f(acc[e], 0.f, 3.0e38f); s1_ += wv[qq][e + 1] * __builtin_amdgcn_fmed3f(acc[e + 1], 0.f, 3.0e38f); }
                        part[qq] = s0_ + s1_; (void)s;
                    }
                    const float mine = hh ? part[1] : part[0], give = hh ? part[0] : part[1];
                    const float score = mine + __shfl_xor(give, 32);
                    const int key = s0 + key_l;
                    if (key < n) { scr[hh * SCR_N + key] = score; lds_add(hw + hh * 1024 + (fkey(score) >> 22), 1u); }
                }
            }
            if (more) { const int kk = tid >> 1, hf = tid & 1;
#pragma unroll
                for (int j = 0; j < 4; ++j) *(LAS u32x4*)(ksb + ((b + 1) & 1) * 256 * KST + kk * KST + hf * 32 + j * 8) = pre[j]; }
            __syncthreads();
        }
        unsigned b1[2], ab1[2];
        wfind<16>(hw, TOPK, lane, b1[0], ab1[0]); wfind<16>(hw + 1024, TOPK, lane, b1[1], ab1[1]);
        const int nv4 = (n + 3) >> 2;
#pragma unroll
        for (int j = 0; j < 8; ++j) *(LAS u32x4*)(hw + (j * 64 + lane) * 4) = (u32x4){0u, 0u, 0u, 0u};
        for (int sb = 0; sb < nv4; sb += 64 * SELB) {
            f32x4 va[SELB], vb[SELB];
#pragma unroll
            for (int u = 0; u < SELB; ++u) { const int s4 = sb + u * 64 + lane; const int sc = s4 < nv4 ? s4 : nv4 - 1; va[u] = *(const f32x4*)(scr + sc * 4); vb[u] = *(const f32x4*)(scr + SCR_N + sc * 4); }
#pragma unroll
            for (int u = 0; u < SELB; ++u) if (sb + u * 64 + lane < nv4) {
#pragma unroll
                for (int e = 0; e < 4; ++e) { const unsigned ka = fkey(va[u][e]), kb = fkey(vb[u][e]);
                    if ((ka >> 22) == b1[0]) lds_add(hw + ((ka >> 12) & 1023u), 1u);
                    if ((kb >> 22) == b1[1]) lds_add(hw + 1024 + ((kb >> 12) & 1023u), 1u); } } }
        unsigned b2[2], ab2[2];
        wfind<16>(hw, TOPK - ab1[0], lane, b2[0], ab2[0]); wfind<16>(hw + 1024, TOPK - ab1[1], lane, b2[1], ab2[1]);
        const unsigned pfx0 = (b1[0] << 10) | b2[0], pfx1 = (b1[1] << 10) | b2[1];
        const unsigned need0 = (unsigned)TOPK - ab1[0] - ab2[0], need1 = (unsigned)TOPK - ab1[1] - ab2[1];
        LAS unsigned* cl0 = hw; LAS unsigned* cl1 = hw + 1024;
        unsigned cnt0 = 0u, cnt1 = 0u, cc0 = 0u, cc1 = 0u; int* sel0 = SEL + (size_t)tA * TOPK; int* sel1 = sel0 + TOPK;
        const unsigned long long lt = (1ull << lane) - 1ull;
        for (int sb = 0; sb < nv4; sb += 64 * SELB) {
            f32x4 va[SELB], vb[SELB];
#pragma unroll
            for (int u = 0; u < SELB; ++u) { const int s4 = sb + u * 64 + lane; const int sc = s4 < nv4 ? s4 : nv4 - 1; va[u] = *(const f32x4*)(scr + sc * 4); vb[u] = *(const f32x4*)(scr + SCR_N + sc * 4); }
#pragma unroll
            for (int u = 0; u < SELB; ++u) { const int s4 = sb + u * 64 + lane; const bool inr = s4 < nv4;
                if (sb + u * 64 < nv4) {
#pragma unroll
                    for (int e = 0; e < 4; ++e) {
                        {   const unsigned k = fkey(va[u][e]); const bool gt = inr && (k >> 12) > pfx0, eq = inr && (k >> 12) == pfx0;
                            const unsigned long long mg = __ballot(gt), me = __ballot(eq);
                            if (gt) { const unsigned pos = cnt0 + (unsigned)__builtin_popcountll(mg & lt); if (pos < (unsigned)TOPK) sel0[pos] = s4 * 4 + e; }
                            if (eq) { const unsigned ci = cc0 + (unsigned)__builtin_popcountll(me & lt); if (ci < 512u) { cl0[2 * ci] = k; cl0[2 * ci + 1] = (unsigned)(s4 * 4 + e); } }
                            cnt0 += (unsigned)__builtin_popcountll(mg); cc0 += (unsigned)__builtin_popcountll(me); }
                        {   const unsigned k = fkey(vb[u][e]); const bool gt = inr && (k >> 12) > pfx1, eq = inr && (k >> 12) == pfx1;
                            const unsigned long long mg = __ballot(gt), me = __ballot(eq);
                            if (gt) { const unsigned pos = cnt1 + (unsigned)__builtin_popcountll(mg & lt); if (pos < (unsigned)TOPK) sel1[pos] = s4 * 4 + e; }
                            if (eq) { const unsigned ci = cc1 + (unsigned)__builtin_popcountll(me & lt); if (ci < 512u) { cl1[2 * ci] = k; cl1[2 * ci + 1] = (unsigned)(s4 * 4 + e); } }
                            cnt1 += (unsigned)__builtin_popcountll(mg); cc1 += (unsigned)__builtin_popcountll(me); }
                    } } } }
#pragma unroll 1
        for (int qq = 0; qq < 2; ++qq) {
            const LAS unsigned* cl = qq ? cl1 : cl0; const unsigned c = min(qq ? cc1 : cc0, 512u), need = qq ? need1 : need0, base = qq ? cnt1 : cnt0; int* sel = qq ? sel1 : sel0;
            for (unsigned i = lane; i < c; i += 64) { const unsigned k = cl[2 * i], ix = cl[2 * i + 1]; unsigned rank = 0;
                for (unsigned j = 0; j < c; ++j) { const unsigned kj = cl[2 * j], ij = cl[2 * j + 1]; rank += (kj > k || (kj == k && ij < ix)) ? 1u : 0u; }
                if (rank < need && base + rank < (unsigned)TOPK) sel[base + rank] = (int)ix; }
        }
    }
}

__device__ __forceinline__ void d3_qlat(const P& p, int G) {
    const int tid = threadIdx.x, lane = tid & 63, wave = __builtin_amdgcn_readfirstlane(tid >> 6), r16 = lane & 15, q = lane >> 4;
    const bf16_t* Z = (const bf16_t*)(p.ws + WS_Z); const bf16_t* WK = (const bf16_t*)(p.ws + WS_WUKB); bf16_t* QL = (bf16_t*)(p.ws + WS_QLAT);
    constexpr int NB = L / 16;
    for (int item = blockIdx.x; item < 256; item += G) {
        const int h = item & 15, qr = item >> 4; const int b0 = qr * 64, b1 = qr == 15 ? NB : b0 + 64;
        bf16x8_t af[4][4];
#pragma unroll
        for (int mt = 0; mt < 4; ++mt)
#pragma unroll
            for (int ks = 0; ks < 4; ++ks) af[mt][ks] = *(const bf16x8_t*)(WK + ((size_t)h * KVR + wave * 64 + mt * 16 + r16) * HD_B + ks * 32 + q * 8);
        bf16x8_t bq[4];
#pragma unroll
        for (int ks = 0; ks < 4; ++ks) bq[ks] = *(const bf16x8_t*)(Z + (size_t)(b0 * 16 + r16) * NZ + ZQ + h * 128 + ks * 32 + q * 8);
        for (int b = b0; b < b1; ++b) {
            bf16x8_t bn[4];
            const int bnx = b + 1 < b1 ? b + 1 : b;
#pragma unroll
            for (int ks = 0; ks < 4; ++ks) bn[ks] = *(const bf16x8_t*)(Z + (size_t)(bnx * 16 + r16) * NZ + ZQ + h * 128 + ks * 32 + q * 8);
#pragma unroll
            for (int mt = 0; mt < 4; ++mt) {
                f32x4 acc = {0.f, 0.f, 0.f, 0.f};
#pragma unroll
                for (int ks = 0; ks < 4; ++ks) acc = __builtin_amdgcn_mfma_f32_16x16x32_bf16(af[mt][ks], bq[ks], acc, 0, 0, 0);
                u32x2 w; w.x = cvtpk(acc[0], acc[1]); w.y = cvtpk(acc[2], acc[3]);
                *(u32x2*)(QL + (size_t)(b * 16 + r16) * 8192 + h * 512 + wave * 64 + mt * 16 + q * 4) = w;
            }
#pragma unroll
            for (int ks = 0; ks < 4; ++ks) bq[ks] = bn[ks];
        }
    }
}
__device__ __forceinline__ void d5_oproj(const P& p, int G) {
    const int tid = threadIdx.x, lane = tid & 63, wave = __builtin_amdgcn_readfirstlane(tid >> 6), r16 = lane & 15, q = lane >> 4;
    const bf16_t* OL = (const bf16_t*)(p.ws + WS_QLAT); const bf16_t* WV = (const bf16_t*)(p.ws + WS_WUVT); bf16_t* YB = (bf16_t*)(p.ws + WS_YB);
    for (size_t i = (size_t)blockIdx.x * NT + tid; i < (size_t)(MP - L) * A_W / 8; i += (size_t)G * NT) *(u32x4*)(YB + (size_t)L * A_W + i * 8) = (u32x4){0u, 0u, 0u, 0u};
    constexpr int NB = L / 16;
    for (int item = blockIdx.x; item < 256; item += G) {
        const int h = item & 15, qr = item >> 4; const int b0 = qr * 64, b1 = qr == 15 ? NB : b0 + 64;
        bf16x8_t af[16];
#pragma unroll
        for (int ks = 0; ks < 16; ++ks) af[ks] = *(const bf16x8_t*)(WV + ((size_t)h * HD_B + wave * 16 + r16) * KVR + ks * 32 + q * 8);
        bf16x8_t bo[16];
#pragma unroll
        for (int ks = 0; ks < 16; ++ks) bo[ks] = *(const bf16x8_t*)(OL + (size_t)(b0 * 16 + r16) * 8192 + h * 512 + ks * 32 + q * 8);
        for (int b = b0; b < b1; ++b) {
            f32x4 acc0 = {0.f, 0.f, 0.f, 0.f}, acc1 = acc0;
#pragma unroll
            for (int ks = 0; ks < 16; ks += 2) { acc0 = __builtin_amdgcn_mfma_f32_16x16x32_bf16(af[ks], bo[ks], acc0, 0, 0, 0); acc1 = __builtin_amdgcn_mfma_f32_16x16x32_bf16(af[ks + 1], bo[ks + 1], acc1, 0, 0, 0); }
            const int bnx = b + 1 < b1 ? b + 1 : b;
#pragma unroll
            for (int ks = 0; ks < 16; ++ks) bo[ks] = *(const bf16x8_t*)(OL + (size_t)(bnx * 16 + r16) * 8192 + h * 512 + ks * 32 + q * 8);
            const f32x4 acc = acc0 + acc1;
            u32x2 w; w.x = cvtpk(acc[0], acc[1]); w.y = cvtpk(acc[2], acc[3]);
            *(u32x2*)(YB + (size_t)(b * 16 + r16) * A_W + h * HD_B + wave * 16 + q * 4) = w;
        }
    }
}

typedef short s16x4_t __attribute__((ext_vector_type(4)));
constexpr int QLS = 520, PLS = 264, CTS = 528;
#ifndef ATT_REG
#define ATT_REG 0
#endif
#if ATT_REG > 0
#define AREG_T() const unsigned long long tt_ = __builtin_amdgcn_s_memrealtime()
#ifndef ATT_BLK
#define ATT_BLK 0
#endif
#define AREG(k) do { if (ATT_REG == (k) && blockIdx.x == ATT_BLK && threadIdx.x == 0) { const unsigned long long t1_ = __builtin_amdgcn_s_memrealtime(); areg_acc += t1_ - areg_t0; } if (ATT_REG != 9 && blockIdx.x == ATT_BLK && threadIdx.x == 0) areg_t0 = __builtin_amdgcn_s_memrealtime(); } while (0)
#else
#define AREG(k) do {} while (0)
#endif
__device__ __forceinline__ void d4_attn(const P& p, LAS unsigned char* lds, int G) {
    unsigned long long areg_acc = 0, areg_t0 = 0; (void)areg_acc; (void)areg_t0;
    const int tid = threadIdx.x, lane = tid & 63, wave = __builtin_amdgcn_readfirstlane(tid >> 6), r16 = lane & 15, q = lane >> 4;
    bf16_t* QO = (bf16_t*)(p.ws + WS_QLAT); const bf16_t* CKV = (const bf16_t*)(p.ws + WS_CKV); const int* SEL = (const int*)(p.ws + WS_SEL);
    LAS bf16_t* ql = (LAS bf16_t*)lds;
    LAS float* lg = (LAS float*)(lds + 16640);
    LAS bf16_t* pl = (LAS bf16_t*)(lds + 49408);
    LAS int* sl = (LAS int*)(lds + 57856);
    LAS bf16_t* ct = (LAS bf16_t*)(lds + 58880);
    LAS bf16_t* cx = (LAS bf16_t*)(lds + 126464);
    const float scale = 0.08838834764831845f;
    u32x4 qn0 = (u32x4){0u, 0u, 0u, 0u}, qn1 = qn0; int seln = -1;
    const bool xdeal = (G == 256);
    const int tq0 = xdeal ? ((int)(blockIdx.x & 7) * (L / 8) + (int)(blockIdx.x >> 3)) : (int)blockIdx.x, tqs = xdeal ? 32 : G, tq1 = xdeal ? ((int)(blockIdx.x & 7) + 1) * (L / 8) : L;
    {   const int t = tq0;
        if (t < tq1) { qn0 = *(const u32x4*)(QO + (size_t)t * 8192 + tid * 8); qn1 = *(const u32x4*)(QO + (size_t)t * 8192 + 4096 + tid * 8); if (tid < TOPK) seln = SEL[(size_t)t * TOPK + tid]; } }
#if ATT_REG == 9
    if (blockIdx.x == ATT_BLK && threadIdx.x == 0) areg_t0 = __builtin_amdgcn_s_memrealtime();
#endif
    for (int t = tq0; t < tq1; t += tqs) {
        AREG(5);
        LDS_BARRIER();
        {   const int i0_ = tid, i1_ = tid + 512;
            *(LAS u32x4*)(ql + (i0_ >> 6) * QLS + (i0_ & 63) * 8) = qn0; *(LAS u32x4*)(ql + (i1_ >> 6) * QLS + (i1_ & 63) * 8) = qn1;
            if (tid < TOPK) sl[tid] = seln; }
        LDS_BARRIER();
        AREG(1);
        u32x4 st[8];
#pragma unroll
        for (int i = 0; i < 8; ++i) { const int idx = sl[wave + 8 * i]; st[i] = *(const u32x4*)(CKV + (size_t)(idx < 0 ? 0 : idx) * KVR + lane * 8); }
        int nidx[8];
#define D4_RDIDX(base_) do { _Pragma("unroll") for (int i = 0; i < 8; ++i) nidx[i] = sl[(base_) + wave + 8 * i]; } while (0)
#define D4_GATHER(i_) st[i_] = *(const u32x4*)(CKV + (size_t)(nidx[i_] < 0 ? 0 : nidx[i_]) * KVR + lane * 8)
        D4_RDIDX(64);
        const int kk = wave & 3, kh = wave >> 2;
        bf16x8_t af[8];
#pragma unroll
        for (int ks = 0; ks < 8; ++ks) af[ks] = *(const LAS bf16x8_t*)(ql + r16 * QLS + kh * 256 + ks * 32 + q * 8);
        for (int kt = 0; kt < 4; ++kt) {
            LDS_BARRIER();
#pragma unroll
            for (int i = 0; i < 8; ++i) { LAS bf16_t* dst = (kt == 2 && i >= 4) ? cx + (wave + 8 * i - 32) * CTS : ct + (wave + 8 * i) * CTS; *(LAS u32x4*)(dst + lane * 8) = st[i]; }
            if (kt < 3) {
#pragma unroll
                for (int i = 0; i < 8; ++i) D4_GATHER(i);
            } else {
#pragma unroll
                for (int i = 0; i < 4; ++i) D4_GATHER(i);
            }
            LDS_BARRIER();
            const LAS bf16_t* kb = (kt == 2 && kk >= 2) ? cx + ((kk - 2) * 16 + r16) * CTS : ct + (kk * 16 + r16) * CTS;
            f32x4 c0 = {0.f, 0.f, 0.f, 0.f};
#pragma unroll
            for (int ks = 0; ks < 8; ++ks) {
                const bf16x8_t b = *(const LAS bf16x8_t*)(kb + kh * 256 + ks * 32 + q * 8);
                c0 = __builtin_amdgcn_mfma_f32_16x16x32_bf16(af[ks], b, c0, 0, 0, 0);
            }
            const int key = kt * 64 + kk * 16 + r16; const bool inval = sl[key] < 0;
#pragma unroll
            for (int e = 0; e < 4; ++e) lg[kh * 4096 + (4 * q + e) * 256 + key] = inval ? (kh ? 0.f : -INFINITY) : c0[e] * scale;
            { const int nb_ = kt == 0 ? 128 : (kt == 1 ? 192 : (kt == 2 ? 128 : 64)); D4_RDIDX(nb_); }
        }
        LDS_BARRIER();
        AREG(2);
        for (int hd = wave * 2; hd < wave * 2 + 2; ++hd) {
            float v[4]; float mx = -INFINITY;
#pragma unroll
            for (int k = 0; k < 4; ++k) { v[k] = lg[hd * 256 + k * 64 + lane] + lg[4096 + hd * 256 + k * 64 + lane]; mx = fmaxf(mx, v[k]); }
            mx = wave_max(mx);
            float s = 0.f;
#pragma unroll
            for (int k = 0; k < 4; ++k) { v[k] = __expf(v[k] - mx); s += v[k]; }
            s = 1.f / wave_sum(s);
#pragma unroll
            for (int k = 0; k < 4; ++k) pl[hd * PLS + k * 64 + lane] = f2bf(v[k] * s);
        }
        f32x4 acc[4];
#pragma unroll
        for (int m = 0; m < 4; ++m) acc[m] = (f32x4){0.f, 0.f, 0.f, 0.f};
        {   const int tn = t + tqs;
            if (tn < tq1) { qn0 = *(const u32x4*)(QO + (size_t)tn * 8192 + tid * 8); qn1 = *(const u32x4*)(QO + (size_t)tn * 8192 + 4096 + tid * 8); if (tid < TOPK) seln = SEL[(size_t)tn * TOPK + tid]; } }
        AREG(3);
        for (int j2 = 0; j2 < 4; ++j2) {
            const int kt = 3 - j2;
            LDS_BARRIER();
            if (j2 > 0) {
                if (j2 == 1) {
#pragma unroll
                    for (int i = 0; i < 4; ++i) *(LAS u32x4*)(ct + (wave + 8 * i) * CTS + lane * 8) = st[i];
                } else {
#pragma unroll
                    for (int i = 0; i < 8; ++i) *(LAS u32x4*)(ct + (wave + 8 * i) * CTS + lane * 8) = st[i];
                }
                if (j2 < 3) {
#pragma unroll
                    for (int i = 0; i < 8; ++i) D4_GATHER(i); }
                LDS_BARRIER();
            }
            const int kq = 16 * (q >> 1) + 4 * (q & 1);
#pragma unroll
            for (int s = 0; s < 2; ++s) {
                const u32x2 pa = *(const LAS u32x2*)(pl + r16 * PLS + kt * 64 + s * 32 + kq), pb = *(const LAS u32x2*)(pl + r16 * PLS + kt * 64 + s * 32 + kq + 8);
                const u32x4 pw = (u32x4){pa.x, pa.y, pb.x, pb.y}; const bf16x8_t b = __builtin_bit_cast(bf16x8_t, pw);
                const LAS bf16_t* cb = (kt == 2 && s == 1) ? cx : ct + s * 32 * CTS;
                const LAS bf16_t* tp = cb + (kq + (r16 >> 2)) * CTS + wave * 64 + (r16 & 3) * 4;
#pragma unroll
                for (int m = 0; m < 4; ++m) {
                    const s16x4_t lo = __builtin_amdgcn_ds_read_tr16_b64_v4i16((LAS s16x4_t*)(tp + m * 16)), hi = __builtin_amdgcn_ds_read_tr16_b64_v4i16((LAS s16x4_t*)(tp + 8 * CTS + m * 16));
                    const bf16x8_t a = (bf16x8_t){lo[0], lo[1], lo[2], lo[3], hi[0], hi[1], hi[2], hi[3]};
                    acc[m] = __builtin_amdgcn_mfma_f32_16x16x32_bf16(a, b, acc[m], 0, 0, 0);
                }
            }
            if (j2 == 1) D4_RDIDX(0);
        }
#undef D4_RDIDX
#undef D4_GATHER
        AREG(4);
#pragma unroll
        for (int m = 0; m < 4; ++m) { u32x2 w; w.x = cvtpk(acc[m][0], acc[m][1]); w.y = cvtpk(acc[m][2], acc[m][3]);
            *(u32x2*)(QO + (size_t)t * 8192 + r16 * 512 + wave * 64 + m * 16 + q * 4) = w; }
    }
#if ATT_REG == 9
    if (blockIdx.x == ATT_BLK && threadIdx.x == 0) areg_acc = __builtin_amdgcn_s_memrealtime() - areg_t0;
#endif
#if ATT_REG > 0
    if (blockIdx.x == ATT_BLK && threadIdx.x == 0) __hip_atomic_store((unsigned*)(p.ws + WS_CTL) + 65540, (unsigned)areg_acc, __ATOMIC_RELAXED, __HIP_MEMORY_SCOPE_AGENT);
#endif
}


__device__ __forceinline__ const float* h1_row(const P& p, int m) { const float* hmeta = (const float*)(p.ws + WS_HMETA); return m < NMETA ? hmeta + (size_t)m * D : p.out + (size_t)(m - NMETA) * D; }
__device__ __forceinline__ void p12_norm_a(const P& p, int G) {
    const int lane = threadIdx.x & 63, wave = threadIdx.x >> 6;
    float* SA = (float*)(p.ws + WS_CTL + CT_SA); const float* w = p.in[I_NFW];
    float gmx = 0.f;
    for (int m = blockIdx.x * NWAVES + wave; m < L; m += G * NWAVES) {
        const float* src = h1_row(p, m);
        f32x4 v[16]; float s = 0.f;
#pragma unroll
        for (int j = 0; j < 16; ++j) { v[j] = *(const f32x4*)(src + (j * 64 + lane) * 4); s += (v[j].x * v[j].x + v[j].y * v[j].y) + (v[j].z * v[j].z + v[j].w * v[j].w); }
        const float r = rsqrtf(wave_sum(s) * (1.f / D) + 1e-6f);
        float mx = 0.f;
#pragma unroll
        for (int j = 0; j < 16; ++j) { const f32x4 g = *(const f32x4*)(w + (j * 64 + lane) * 4); const f32x4 y = v[j] * g; mx = fmaxf(mx, fmaxf(fmaxf(fabsf(y.x), fabsf(y.y)), fmaxf(fabsf(y.z), fabsf(y.w)))); }
        gmx = fmaxf(gmx, mx * r);
        if (lane == 0) SA[m] = r;
    }
    gmx = wave_max(gmx);
    if (lane == 0) atomicMax((unsigned*)(p.ws + WS_CTL + CT_AMAX), __float_as_uint(gmx));
}
__device__ __forceinline__ void p12_norm_b(const P& p, int G) {
    const int lane = threadIdx.x & 63, wave = threadIdx.x >> 6;
    signed char* U8 = (signed char*)(p.ws + WS_U); const float* SA = (const float*)(p.ws + WS_CTL + CT_SA); const float* w = p.in[I_NFW];
    const float amax = __uint_as_float(__hip_atomic_load((const unsigned*)(p.ws + WS_CTL + CT_AMAX), __ATOMIC_RELAXED, __HIP_MEMORY_SCOPE_AGENT));
    const float amc = fminf(amax, 4.0f);
    const float inv = amc > 0.f ? 127.f / amc : 0.f;
    if (blockIdx.x == 0 && threadIdx.x == 0) *(float*)(p.ws + WS_CTL + CT_SAG) = amc > 0.f ? amc * (1.f / 127.f) : 1.f;
    for (int m = blockIdx.x * NWAVES + wave; m < MP; m += G * NWAVES) {
        signed char* dst = U8 + (size_t)m * D;
        if (m >= L) {
#pragma unroll
            for (int j = 0; j < 4; ++j) *(u32x4*)(dst + (j * 64 + lane) * 16) = (u32x4){0u, 0u, 0u, 0u};
            continue; }
        const float* src = h1_row(p, m); const float ri = SA[m] * inv;
#pragma unroll
        for (int j = 0; j < 16; ++j) { const f32x4 x = *(const f32x4*)(src + (j * 64 + lane) * 4) * ri; const f32x4 g = *(const f32x4*)(w + (j * 64 + lane) * 4);
            const unsigned q = ((unsigned)(int)rintf(fminf(fmaxf(x.x * g.x, -127.f), 127.f)) & 0xffu) | (((unsigned)(int)rintf(fminf(fmaxf(x.y * g.y, -127.f), 127.f)) & 0xffu) << 8) | (((unsigned)(int)rintf(fminf(fmaxf(x.z * g.z, -127.f), 127.f)) & 0xffu) << 16) | (((unsigned)(int)rintf(fminf(fmaxf(x.w * g.w, -127.f), 127.f)) & 0xffu) << 24);
            *(unsigned*)(dst + (j * 64 + lane) * 4) = q; }
    }
}
__device__ __forceinline__ void p18_final_norm(const P& p, int G) {
    const int tid = threadIdx.x, lane = tid & 63, wave = tid >> 6;
    const float* w = p.in[I_NFIN];
    for (int m = blockIdx.x * NWAVES + wave; m < SEQ; m += G * NWAVES) {
        float* row = p.out + (size_t)m * D;
        f32x4 v[16]; float s = 0.f;
#pragma unroll
        for (int j = 0; j < 16; ++j) { v[j] = *(const f32x4*)(row + (j * 64 + lane) * 4); s += (v[j].x * v[j].x + v[j].y * v[j].y) + (v[j].z * v[j].z + v[j].w * v[j].w); }
        float r = rsqrtf(wave_sum(s) * (1.f / D) + 1e-6f);
#if STAMP_A0 >= 0
        r *= 1.f + 1e-7f * (float)__hip_atomic_load((const unsigned*)(p.ws + WS_CTL) + 65536, __ATOMIC_RELAXED, __HIP_MEMORY_SCOPE_AGENT);
#endif
#pragma unroll
        for (int j = 0; j < 16; ++j) { const f32x4 g = *(const f32x4*)(w + (j * 64 + lane) * 4); *(f32x4*)(row + (j * 64 + lane) * 4) = v[j] * r * g; }
    }
}

__device__ __forceinline__ void p14_conv_act(const P& p, int G, int pass) {
    const int tid = threadIdx.x;
    const bf16_t* ZF = (const bf16_t*)(p.ws + WS_ZF); bf16_t* ACT = (bf16_t*)(p.ws + WS_ACT);
    const float* cw = p.in[I_CW]; const float* cb = p.in[I_CB];
    const size_t nitems = (size_t)MP * 43 * 16;
    for (size_t it = (size_t)blockIdx.x * NT + tid; it < nitems; it += (size_t)G * NT) {
        const int g8 = (int)(it % 16), tl = (int)((it / 16) % 43), t = (int)(it / (16 * 43));
        const int ch = (pass * 43 + tl) * 128 + g8 * 8;
        u32x4 o = (u32x4){0u, 0u, 0u, 0u};
        if (t < L) {
            float zg[8], zu[8];
#pragma unroll
            for (int e = 0; e < 8; ++e) { zg[e] = cb[ch + e]; zu[e] = cb[DFF + ch + e]; }
#pragma unroll
            for (int i = 0; i < 3; ++i) { const int tt = t - 2 + i;
                if (tt >= 0) {
                    const u32x4 a = *(const u32x4*)(ZF + (size_t)tt * DFF + tl * 256 + g8 * 8), b = *(const u32x4*)(ZF + (size_t)tt * DFF + tl * 256 + 128 + g8 * 8);
                    const float xa[8] = {blo(a.x), bhi(a.x), blo(a.y), bhi(a.y), blo(a.z), bhi(a.z), blo(a.w), bhi(a.w)};
                    const float xb[8] = {blo(b.x), bhi(b.x), blo(b.y), bhi(b.y), blo(b.z), bhi(b.z), blo(b.w), bhi(b.w)};
#pragma unroll
                    for (int e = 0; e < 8; ++e) { zg[e] += cw[(size_t)i * NFI + ch + e] * xa[e]; zu[e] += cw[(size_t)i * NFI + DFF + ch + e] * xb[e]; }
                } }
            float r[8];
#pragma unroll
            for (int e = 0; e < 8; ++e) r[e] = zg[e] * sigm(zg[e]) * zu[e];
            o.x = pk2(r[0], r[1]); o.y = pk2(r[2], r[3]); o.z = pk2(r[4], r[5]); o.w = pk2(r[6], r[7]);
        }
        *(u32x4*)(ACT + (size_t)t * DFF + ch) = o;
    }
}

template <int K, class F> __device__ __forceinline__ void side2(const bf16_t* A14, int lda, const bf16_t* Bt, int N, int G, F f) {
    const int lane = threadIdx.x & 63, gw = blockIdx.x * NWAVES + (threadIdx.x >> 6);
    constexpr int NC = K / 512;
    u32x4 a0[NC], a1[NC];
#pragma unroll
    for (int i = 0; i < NC; ++i) { a0[i] = *(const u32x4*)(A14 + i * 512 + lane * 8); a1[i] = *(const u32x4*)(A14 + lda + i * 512 + lane * 8); }
    for (int n = gw; n < N; n += G * NWAVES) {
        float s0 = 0.f, s1 = 0.f;
#pragma unroll
        for (int i = 0; i < NC; ++i) { const u32x4 b = *(const u32x4*)(Bt + (size_t)n * K + i * 512 + lane * 8);
            const unsigned bw[4] = {b.x, b.y, b.z, b.w}, x0[4] = {a0[i].x, a0[i].y, a0[i].z, a0[i].w}, x1[4] = {a1[i].x, a1[i].y, a1[i].z, a1[i].w};
#pragma unroll
            for (int e = 0; e < 4; ++e) { s0 += blo(x0[e]) * blo(bw[e]) + bhi(x0[e]) * bhi(bw[e]); s1 += blo(x1[e]) * blo(bw[e]) + bhi(x1[e]) * bhi(bw[e]); } }
        s0 = wave_sum(s0); s1 = wave_sum(s1);
        if (lane == 0) f(n, s0, s1);
    }
}

template <class F> __device__ __forceinline__ void side2_i8(const signed char* A14, const signed char* Bt, int N, int G, F f) {
    const int lane = threadIdx.x & 63, gw = blockIdx.x * NWAVES + (threadIdx.x >> 6);
    u32x4 a0[4], a1[4];
#pragma unroll
    for (int i = 0; i < 4; ++i) { a0[i] = *(const u32x4*)(A14 + i * 1024 + lane * 16); a1[i] = *(const u32x4*)(A14 + 4096 + i * 1024 + lane * 16); }
    for (int n = gw; n < N; n += G * NWAVES) {
        int s0 = 0, s1 = 0;
#pragma unroll
        for (int i = 0; i < 4; ++i) { const u32x4 b = *(const u32x4*)(Bt + (size_t)n * 4096 + i * 1024 + lane * 16);
            s0 = __builtin_amdgcn_sdot4((int)a0[i].x, (int)b.x, s0, false); s0 = __builtin_amdgcn_sdot4((int)a0[i].y, (int)b.y, s0, false); s0 = __builtin_amdgcn_sdot4((int)a0[i].z, (int)b.z, s0, false); s0 = __builtin_amdgcn_sdot4((int)a0[i].w, (int)b.w, s0, false);
            s1 = __builtin_amdgcn_sdot4((int)a1[i].x, (int)b.x, s1, false); s1 = __builtin_amdgcn_sdot4((int)a1[i].y, (int)b.y, s1, false); s1 = __builtin_amdgcn_sdot4((int)a1[i].z, (int)b.z, s1, false); s1 = __builtin_amdgcn_sdot4((int)a1[i].w, (int)b.w, s1, false); }
#pragma unroll
        for (int d = 32; d >= 1; d >>= 1) { s0 += __shfl_xor(s0, d); s1 += __shfl_xor(s1, d); }
        if (lane == 0) f(n, s0, s1);
    }
}

__device__ __forceinline__ void p_conv_fix(const P& p, int G) {
    const int tid = threadIdx.x;
    const float* HALO = (const float*)(p.ws + WS_ZF); bf16_t* ACT = (bf16_t*)(p.ws + WS_ACT);
    const float* cw = p.in[I_CW]; const float* cb = p.in[I_CB];
    const int nitems = 64 * 2 * DFF;
    for (int it = blockIdx.x * NT + tid; it < nitems; it += G * NT) {
        const int c = it % DFF, d = (it / DFF) & 1, pm = 1 + it / (2 * DFF);
        const int r = pm * 256 + d; if (r >= L) continue;
        const int T = c >> 7, cl = c & 127; const int colg = T * 256 + cl, colu = colg + 128;
        const float* h0 = HALO + ((size_t)(pm - 1) * 4 + 2 + d) * NFI; const float* h1 = d == 0 ? HALO + ((size_t)(pm - 1) * 4 + 3) * NFI : HALO + ((size_t)pm * 4 + 0) * NFI; const float* h2 = HALO + ((size_t)pm * 4 + d) * NFI;
        const float zg = cb[c] + cw[c] * h0[colg] + cw[(size_t)NFI + c] * h1[colg] + cw[(size_t)2 * NFI + c] * h2[colg];
        const float zu = cb[DFF + c] + cw[DFF + c] * h0[colu] + cw[(size_t)NFI + DFF + c] * h1[colu] + cw[(size_t)2 * NFI + DFF + c] * h2[colu];
        ACT[(size_t)r * DFF + c] = f2bf(zg * sigm(zg) * zu);
    }
}

constexpr int NPHASE = 20;
__global__ void __launch_bounds__(NT, 2) fwd_kernel(P p) {
    extern __shared__ __attribute__((aligned(16))) unsigned char lds_raw[];
    LAS unsigned char* lds = (LAS unsigned char*)lds_raw;
    const int G = gridDim.x;
    unsigned char* ws = p.ws;
    volatile LAS unsigned* MISC = (volatile LAS unsigned*)(lds + MISC_OFF);
    if (threadIdx.x < 16) MISC[threadIdx.x] = 0u;
    __syncthreads();
#if MK_ONE_LAUNCH
    XcdBarrier bar = xcd_barrier_post((unsigned*)(ws + WS_CTL), MISC + 8);
#define GRID_BAR() xcd_barrier(bar)
#else
#define GRID_BAR() do {} while (0)
#endif
    unsigned long long tsA0 = 0, tsA1 = 0, tsB0 = 0, tsB1 = 0; (void)tsA0; (void)tsA1; (void)tsB0; (void)tsB1;
    const int lo = p.ph_lo, hi = p.ph_hi;
#ifndef PHASE_MASK
#define PHASE_MASK 0xFFFFFFFu
#endif
#define IN(k) ((((PHASE_MASK) >> (k)) & 1u) && lo <= (k) && (k) < hi)
#ifndef STAMP_A0
#define STAMP_A0 -1
#endif
#if STAMP_A0 >= 0
#define STAMP(k) do { if (blockIdx.x == 0 && threadIdx.x == 0) { const unsigned long long t_ = __builtin_amdgcn_s_memrealtime(); if ((k) == STAMP_A0) tsA0 = t_; if ((k) == STAMP_A1) tsA1 = t_; if ((k) == STAMP_B0) tsB0 = t_; if ((k) == STAMP_B1) { tsB1 = t_; \
    __hip_atomic_store((unsigned*)(ws + WS_CTL) + 65536, (unsigned)(tsB1 - tsB0), __ATOMIC_RELAXED, __HIP_MEMORY_SCOPE_AGENT); } } } while (0)
#else
#define STAMP(k) do {} while (0)
#endif
#define SEAM(k) do { if (IN((k) + 1)) GRID_BAR(); STAMP((k) + 1); } while (0)
    STAMP(0);
#ifndef PROBE_REP_MASK
#define PROBE_REP_MASK 0u
#endif
#define NREP(k) ((((PROBE_REP_MASK) >> (k)) & 1u) ? 2 : 1)
    bf16_t* U = (bf16_t*)(ws + WS_U);
    if (IN(0)) _Pragma("unroll") for (int rep_ = 0; rep_ < NREP(0); ++rep_) { p0_prologue_a(p, lds, G); GRID_BAR(); p0_prologue_b(p, lds, G); if (rep_ == NREP(0) - 1) SEAM(0); }
    if (IN(1)) _Pragma("unroll") for (int rep_ = 0; rep_ < NREP(1); ++rep_) {
        {   pg8::Gemm g{U, (const bf16_t*)(ws + WS_WINT), MP, NZ8, D / 2, (const float*)(ws + WS_CTL + CT_SA), (const float*)(ws + WS_CTL + CT_SB_IN)}; pg8::StaticOrder S; S.init(MP, NZ8, G, (int)blockIdx.x);
            pg8::EpiBf16<0> E{(bf16_t*)(ws + WS_Z), NZ};
            pg8::gemm_phase<pg8::EpiBf16<0>, pg8::StaticOrder, true, true, true>(lds, g, S, E); }
        {   pg8::Gemm g{(const bf16_t*)(ws + WS_R1), (const bf16_t*)(ws + WS_WINT + WINT_BF_OFF), MP, NZ - NZ8, D}; pg8::StaticOrder S; S.init(MP, NZ - NZ8, G, (int)blockIdx.x);
            pg8::EpiBf16<0> E{(bf16_t*)(ws + WS_Z) + NZ8, NZ};
            pg8::gemm_phase<pg8::EpiBf16<0>, pg8::StaticOrder, true, true, false>(lds, g, S, E); }
        if (rep_ == NREP(1) - 1) SEAM(1);
    }
    if (IN(2)) _Pragma("unroll") for (int rep_ = 0; rep_ < NREP(2); ++rep_) { p2_rwkv_prep(p, lds, G); if (rep_ == NREP(2) - 1) SEAM(2); }
    if (IN(3)) _Pragma("unroll") for (int rep_ = 0; rep_ < NREP(3); ++rep_) { ra_items(p, lds, G); if (rep_ == NREP(3) - 1) SEAM(3); }
    if (IN(4)) _Pragma("unroll") for (int rep_ = 0; rep_ < NREP(4); ++rep_) { rb_chain(p, G);
        {
            const int wv_ = threadIdx.x >> 6, nch_ = G < 128 ? G : 128; const int nvw_ = nch_ * 7 + (G - nch_) * 8;
            const int vw_ = (int)blockIdx.x < nch_ ? ((int)blockIdx.x * 7 + wv_ - 1) : (nch_ * 7 + ((int)blockIdx.x - nch_) * 8 + wv_);
            if (!((int)blockIdx.x < nch_ && wv_ == 0)) p0b_weights(p, lds, vw_, nvw_); }
        if (rep_ == NREP(4) - 1) SEAM(4); }
    if (IN(5)) _Pragma("unroll") for (int rep_ = 0; rep_ < NREP(5); ++rep_) { rc_out(p, G); if (rep_ == NREP(5) - 1) SEAM(5); }
    if (IN(6)) _Pragma("unroll") for (int rep_ = 0; rep_ < NREP(6); ++rep_) { p4_dsa_prep(p, G); if (rep_ == NREP(6) - 1) SEAM(6); }
    if (IN(7)) _Pragma("unroll") for (int rep_ = 0; rep_ < NREP(7); ++rep_) { d2_topk(p, lds, G); if (rep_ == NREP(7) - 1) SEAM(7); }
    if (IN(8)) _Pragma("unroll") for (int rep_ = 0; rep_ < NREP(8); ++rep_) { d3_qlat(p, G); if (rep_ == NREP(8) - 1) SEAM(8); }
    if (IN(9)) _Pragma("unroll") for (int rep_ = 0; rep_ < NREP(9); ++rep_) { d4_attn(p, lds, G); if (rep_ == NREP(9) - 1) SEAM(9); }
    if (IN(11)) _Pragma("unroll") for (int rep_ = 0; rep_ < NREP(11); ++rep_) {
        d5_oproj(p, G);
        pg8::Gemm g{U + (size_t)NMETA * (D / 2), (const bf16_t*)(ws + WS_WGT), SEQ, 8192, D / 2, (const float*)(ws + WS_CTL + CT_SA) + NMETA, (const float*)(ws + WS_CTL + CT_SB_G)}; pg8::StaticOrder S; S.init(SEQ, 8192, G, (int)blockIdx.x);
        pg8::EpiBf16<1> E{(bf16_t*)(ws + WS_GATES) + (size_t)NMETA * 8192, 8192};
        pg8::gemm_phase<pg8::EpiBf16<1>, pg8::StaticOrder, true, true, true>(lds, g, S, E);
        {   const float* SA_ = (const float*)(ws + WS_CTL + CT_SA); const float* SB_ = (const float*)(ws + WS_CTL + CT_SB_G); bf16_t* GT = (bf16_t*)(ws + WS_GATES);
            side2_i8((const signed char*)(ws + WS_U) + (size_t)14 * D, (const signed char*)(ws + WS_WGT), 8192, G, [&](int n, int i0, int i1) {
                GT[(size_t)14 * 8192 + n] = f2bf(1.f / (1.f + __expf(-(float)i0 * SA_[14] * SB_[n]))); GT[(size_t)15 * 8192 + n] = f2bf(1.f / (1.f + __expf(-(float)i1 * SA_[15] * SB_[n]))); }); }
        if (rep_ == NREP(11) - 1) SEAM(11);
    }
    if (IN(12)) _Pragma("unroll") for (int rep_ = 0; rep_ < NREP(12); ++rep_) {
        pg8::Gemm g{(const bf16_t*)(ws + WS_YA) + (size_t)NMETA * A_W, (const bf16_t*)(ws + WS_WPAT), SEQ, D, A_W}; pg8::StaticOrder S; S.init(SEQ, D, G, (int)blockIdx.x);
        pg8::EpiGateMulF32 E{(bf16_t*)(ws + WS_MF) + (size_t)NMETA * D, D, (const bf16_t*)(ws + WS_GATES) + (size_t)NMETA * 8192, 8192, 0};
        pg8::gemm_phase<pg8::EpiGateMulF32, pg8::StaticOrder, true, true>(lds, g, S, E);
        {   bf16_t* MA = (bf16_t*)(ws + WS_MF); const bf16_t* GT = (const bf16_t*)(ws + WS_GATES);
            side2<2048>((const bf16_t*)(ws + WS_YA) + (size_t)14 * A_W, A_W, (const bf16_t*)(ws + WS_WPAT), D, G, [&](int n, float s0, float s1) {
                MA[(size_t)14 * D + n] = f2bf(bf2f(GT[(size_t)14 * 8192 + n]) * s0); MA[(size_t)15 * D + n] = f2bf(bf2f(GT[(size_t)15 * 8192 + n]) * s1); }); }
        if (rep_ == NREP(12) - 1) SEAM(12);
    }
    if (IN(13)) _Pragma("unroll") for (int rep_ = 0; rep_ < NREP(13); ++rep_) {
        pg8::Gemm g{(const bf16_t*)(ws + WS_YB) + (size_t)NMETA * A_W, (const bf16_t*)(ws + WS_WPBT), SEQ, D, A_W}; pg8::StaticOrder S; S.init(SEQ, D, G, (int)blockIdx.x);
        pg8::EpiGateMulAddBf16 E{U + (size_t)NMETA * D, D, (const bf16_t*)(ws + WS_MF) + (size_t)NMETA * D, (const bf16_t*)(ws + WS_GATES) + (size_t)NMETA * 8192, 8192, D};
        pg8::gemm_phase<pg8::EpiGateMulAddBf16, pg8::StaticOrder, true, true>(lds, g, S, E);
        {   const bf16_t* MA = (const bf16_t*)(ws + WS_MF); const bf16_t* GT = (const bf16_t*)(ws + WS_GATES);
            side2<2048>((const bf16_t*)(ws + WS_YB) + (size_t)14 * A_W, A_W, (const bf16_t*)(ws + WS_WPBT), D, G, [&](int n, float s0, float s1) {
                U[(size_t)14 * D + n] = f2bf(bf2f(MA[(size_t)14 * D + n]) + bf2f(GT[(size_t)14 * 8192 + D + n]) * s0); U[(size_t)15 * D + n] = f2bf(bf2f(MA[(size_t)15 * D + n]) + bf2f(GT[(size_t)15 * 8192 + D + n]) * s1); }); }
        if (rep_ == NREP(13) - 1) SEAM(13);
    }
    if (IN(14)) _Pragma("unroll") for (int rep_ = 0; rep_ < NREP(14); ++rep_) {
        pg8::Gemm g{U + (size_t)NMETA * D, (const bf16_t*)(ws + WS_WOUTT), SEQ, D, D}; pg8::StaticOrder S; S.init(SEQ, D, G, (int)blockIdx.x);
        pg8::EpiResid E{p.in[I_X], p.in[I_X], p.out, p.out, D, 0, SEQ};
        pg8::gemm_phase<pg8::EpiResid, pg8::StaticOrder, true, true>(lds, g, S, E);
        {   float* HM = (float*)(ws + WS_HMETA); const float* mt = p.in[I_META];
            for (int i2 = blockIdx.x * NT + threadIdx.x; i2 < 14 * D; i2 += G * NT) HM[i2] = mt[i2];
            side2<4096>(U + (size_t)14 * D, D, (const bf16_t*)(ws + WS_WOUTT), D, G, [&](int n, float s0, float s1) { HM[(size_t)14 * D + n] = mt[(size_t)14 * D + n] + s0; HM[(size_t)15 * D + n] = mt[(size_t)15 * D + n] + s1; }); }
        if (rep_ == NREP(14) - 1) SEAM(14);
    }
    if (IN(15)) _Pragma("unroll") for (int rep_ = 0; rep_ < NREP(15); ++rep_) { p12_norm_a(p, G); GRID_BAR(); p12_norm_b(p, G); if (rep_ == NREP(15) - 1) SEAM(15); }
    if (IN(16)) _Pragma("unroll") for (int rep_ = 0; rep_ < NREP(16); ++rep_) {
        pg8::Gemm g{U, (const bf16_t*)(ws + WS_WFIT), MP, NFI, D / 2, (const float*)(ws + WS_CTL + CT_SA), (const float*)(ws + WS_CTL + CT_SB_F)}; pg8::StaticOrder S; S.init(MP, NFI, G, (int)blockIdx.x);
        pg8::EpiConvAct E{(bf16_t*)(ws + WS_ACT), DFF, (float*)(ws + WS_ZF), NFI, p.in[I_CW], p.in[I_CB], DFF, (PG8_LAS float*)(lds + 131072), (const float*)(ws + WS_CTL + CT_SAG), (const float*)(ws + WS_CTL + CT_SB_F)};
        pg8::gemm_phase<pg8::EpiConvAct, pg8::StaticOrder, true, true, true>(lds, g, S, E);
        if (rep_ == NREP(16) - 1) SEAM(16);
    }
    if (IN(17)) _Pragma("unroll") for (int rep_ = 0; rep_ < NREP(17); ++rep_) { p_conv_fix(p, G); if (rep_ == NREP(17) - 1) SEAM(17); }
    if (IN(18)) _Pragma("unroll") for (int rep_ = 0; rep_ < NREP(18); ++rep_) {
        pg8::Gemm g{(const bf16_t*)(ws + WS_ACT) + (size_t)NMETA * DFF, (const bf16_t*)(ws + WS_WFOT), SEQ, D, DFF}; pg8::StaticOrder S; S.init(SEQ, D, G, (int)blockIdx.x);
        pg8::EpiResid E{p.out, p.out, p.out, p.out, D, 0, SEQ};
        pg8::gemm_phase<pg8::EpiResid, pg8::StaticOrder, true, true>(lds, g, S, E);
        if (rep_ == NREP(18) - 1) SEAM(18);
    }
    if (IN(19)) _Pragma("unroll") for (int rep_ = 0; rep_ < NREP(19); ++rep_) { p18_final_norm(p, G); }
#if STAMP_A0 >= 0
    if (blockIdx.x == 0 && threadIdx.x == 0) { const unsigned long long t_end = __builtin_amdgcn_s_memrealtime(); unsigned long long dA = (tsA1 - tsA0) * 64ull;
#if defined(ATT_REG) && ATT_REG > 0
        dA = (unsigned long long)__hip_atomic_load((const unsigned*)(ws + WS_CTL) + 65540, __ATOMIC_RELAXED, __HIP_MEMORY_SCOPE_AGENT) * 64ull;
#endif
        while (__builtin_amdgcn_s_memrealtime() - t_end < dA) __builtin_amdgcn_s_sleep(8); }
#endif
#undef IN
#undef SEAM
}

extern "C" void kernel_launch(void* const* d_in, const int* in_sizes, int n_in, void* d_out, int out_size, void* d_ws, size_t ws_size, hipStream_t stream) {
    static int grid = 0;
    if (grid == 0) {
        if (n_in != 30 || out_size != SEQ * D || ws_size < WS_END2) { fprintf(stderr, "kernel_launch: unexpected shapes (n_in %d out %d ws %zu need %zu)\n", n_in, out_size, ws_size, (size_t)WS_END); grid = -1; return; }
        int dev = 0, cus = 0, per_cu = 0;
        if (hipGetDevice(&dev) != hipSuccess || hipDeviceGetAttribute(&cus, hipDeviceAttributeMultiprocessorCount, dev) != hipSuccess) { grid = -1; return; }
        if (hipFuncSetAttribute((const void*)fwd_kernel, hipFuncAttributeMaxDynamicSharedMemorySize, LDS_BYTES) != hipSuccess) { fprintf(stderr, "kernel_launch: hipFuncSetAttribute failed\n"); grid = -1; return; }
        if (hipOccupancyMaxActiveBlocksPerMultiprocessor(&per_cu, (const void*)fwd_kernel, NT, LDS_BYTES) != hipSuccess || per_cu < 1) fprintf(stderr, "kernel_launch: occupancy query says %d\n", per_cu);
        (void)hipGetLastError();
        grid = cus;
    }
    if (grid < 0) return;
    (void)hipMemsetAsync((char*)d_ws + WS_CTL, 0, CTL_BYTES, stream);
    P a{};
    for (int i = 0; i < 30; ++i) a.in[i] = (const float*)d_in[i];
    a.out = (float*)d_out; a.ws = (unsigned char*)d_ws;
#if MK_ONE_LAUNCH
    a.ph_lo = 0; a.ph_hi = NPHASE;
    hipLaunchKernelGGL(fwd_kernel, dim3(grid), dim3(NT), LDS_BYTES, stream, a);
#else
    for (int k = 0; k < NPHASE; ++k) { a.ph_lo = k; a.ph_hi = k + 1; hipLaunchKernelGGL(fwd_kernel, dim3(grid), dim3(NT), LDS_BYTES, stream, a); }
#endif
}
```

```cpp
#include <hip/hip_runtime.h>
#include <cstdio>
#include <cstdint>
#define MK_ONE_LAUNCH 1
namespace pg8 {
#define PG8_LAS __attribute__((address_space(3)))
typedef unsigned short bf16_t;
typedef short bf16x8 __attribute__((ext_vector_type(8)));
typedef float f32x4 __attribute__((ext_vector_type(4)));
typedef unsigned u32x4 __attribute__((ext_vector_type(4)));
typedef int i32x4 __attribute__((ext_vector_type(4)));
constexpr int BM = 256, BK = 64, HALF = 128, HTB = HALF * BK * 2  , STAGE_BYTES = 8 * HTB, NXCD = 8, WGM = 4;

__host__ __device__ __forceinline__ int lds_byte(int r, int c) { const int st = (r >> 4) * 2 + (c >> 5), rr = r & 15, cc = c & 31, ob = rr * 64 + cc * 2; return st * 1024 + (ob ^ (((ob >> 9) & 1) << 5)); }
__host__ __device__ __forceinline__ void stage_rc(int b, int& R, int& C) { const int st = b / 1024, sb = b % 1024, swz = sb ^ (((sb >> 9) & 1) << 5); R = (st >> 1) * 16 + swz / 64; C = (st & 1) * 32 + (swz % 64) / 2; }
__host__ __device__ __forceinline__ int perm32(int rho) { const int n = rho >> 4, i = rho & 15; return 8 * (i >> 2) + 4 * n + (i & 3); }

struct Unit { int pm, pn; };
struct Gemm { const bf16_t* A; const bf16_t* Bt; int M, N, K; const float* sa; const float* sb; };

struct StaticOrder {
    int nM, nN, nwg, G, c;
    __host__ __device__ void init(int M, int N, int G_, int c_) { nM = M / BM; nN = N / BM; nwg = nM * nN; G = G_; c = c_; }
    __host__ __device__ bool next(int i, Unit& u) const {
        const long L = (long)i * G + c; if (L >= nwg) return false;
        int wgid = (int)L; { const int q = nwg / NXCD, r = nwg % NXCD, xcd = wgid % NXCD, off = wgid / NXCD; wgid = (xcd < r ? xcd * (q + 1) : r * (q + 1) + (xcd - r) * q) + off; }
        const int nig = WGM * nN, gid = wgid / nig, fm = gid * WGM, gsz = (nM - fm) < WGM ? (nM - fm) : WGM;
        u.pm = fm + ((wgid % nig) % gsz); u.pn = (wgid % nig) / gsz; return true;
    }
    __device__ __forceinline__ void a_ready(const Unit&) const {}
    __device__ __forceinline__ void done(const Unit&) const {}
};

__device__ __forceinline__ unsigned cvt_pk_bf16(float lo, float hi) { unsigned r; asm volatile("v_cvt_pk_bf16_f32 %0, %1, %2" : "=v"(r) : "v"(lo), "v"(hi)); return r; }
typedef float f32x2 __attribute__((ext_vector_type(2)));

typedef unsigned u32x2 __attribute__((ext_vector_type(2)));
__device__ __forceinline__ float bf_lo(unsigned w) { return __uint_as_float(w << 16); }
__device__ __forceinline__ float bf_hi(unsigned w) { return __uint_as_float(w & 0xffff0000u); }
__device__ __forceinline__ float sigmoidf_(float x) { return 1.f / (1.f + __expf(-x)); }

template <int ACT> struct EpiBf16 {
    static constexpr bool PERM = true, AFTER_DRAIN = false, SELF_SCALE = false;
    bf16_t* O; int ldc;
    __device__ __forceinline__ void operator()(const f32x4 (&acc)[2][2][4][2], const Unit& u, int wr, int wc, int fr, int fq) const {
        const int row0 = u.pm * BM + wr * 64 + fr; const int col0 = u.pn * BM + wc * 32 + 8 * fq;
#pragma unroll
        for (int ai = 0; ai < 2; ++ai)
#pragma unroll
            for (int m = 0; m < 4; ++m) { bf16_t* rowp = O + (size_t)(row0 + ai * HALF + m * 16) * ldc + col0;
#pragma unroll
                for (int bj = 0; bj < 2; ++bj) { f32x4 v0 = acc[ai][bj][m][0], v1 = acc[ai][bj][m][1];
                    if (ACT == 1) {
#pragma unroll
                        for (int e = 0; e < 4; ++e) { v0[e] = sigmoidf_(v0[e]); v1[e] = sigmoidf_(v1[e]); } }
                    u32x4 w; w.x = cvt_pk_bf16(v0[0], v0[1]); w.y = cvt_pk_bf16(v0[2], v0[3]); w.z = cvt_pk_bf16(v1[0], v1[1]); w.w = cvt_pk_bf16(v1[2], v1[3]);
                    *(u32x4*)(rowp + bj * HALF) = w; } }
    }
};
struct EpiGateMulF32 {
    static constexpr bool PERM = true, AFTER_DRAIN = false, SELF_SCALE = false;
    bf16_t* MA; int ldc; const bf16_t* G; int ldg; int gcol0;
    __device__ __forceinline__ void operator()(const f32x4 (&acc)[2][2][4][2], const Unit& u, int wr, int wc, int fr, int fq) const {
        const int row0 = u.pm * BM + wr * 64 + fr, col0 = u.pn * BM + wc * 32 + 8 * fq;
#pragma unroll
        for (int ai = 0; ai < 2; ++ai)
#pragma unroll
            for (int m = 0; m < 4; ++m) { const size_t r = (size_t)(row0 + ai * HALF + m * 16); bf16_t* rowp = MA + r * ldc + col0; const bf16_t* gp = G + r * ldg + gcol0 + col0;
#pragma unroll
                for (int bj = 0; bj < 2; ++bj) { const u32x4 g = *(const u32x4*)(gp + bj * HALF); const f32x4 a0 = acc[ai][bj][m][0], a1 = acc[ai][bj][m][1];
                    u32x4 w; w.x = cvt_pk_bf16(a0[0] * bf_lo(g.x), a0[1] * bf_hi(g.x)); w.y = cvt_pk_bf16(a0[2] * bf_lo(g.y), a0[3] * bf_hi(g.y));
                    w.z = cvt_pk_bf16(a1[0] * bf_lo(g.z), a1[1] * bf_hi(g.z)); w.w = cvt_pk_bf16(a1[2] * bf_lo(g.w), a1[3] * bf_hi(g.w));
                    *(u32x4*)(rowp + bj * HALF) = w; } }
    }
};
struct EpiGateMulAddBf16 {
    static constexpr bool PERM = true, AFTER_DRAIN = false, SELF_SCALE = false;
    bf16_t* MB; int ldc; const bf16_t* MA; const bf16_t* G; int ldg; int gcol0;
    __device__ __forceinline__ void operator()(const f32x4 (&acc)[2][2][4][2], const Unit& u, int wr, int wc, int fr, int fq) const {
        const int row0 = u.pm * BM + wr * 64 + fr, col0 = u.pn * BM + wc * 32 + 8 * fq;
#pragma unroll
        for (int ai = 0; ai < 2; ++ai)
#pragma unroll
            for (int m = 0; m < 4; ++m) { const size_t r = (size_t)(row0 + ai * HALF + m * 16); bf16_t* rowp = MB + r * ldc + col0; const bf16_t* mp = MA + r * ldc + col0; const bf16_t* gp = G + r * ldg + gcol0 + col0;
#pragma unroll
                for (int bj = 0; bj < 2; ++bj) { const u32x4 g = *(const u32x4*)(gp + bj * HALF); const u32x4 mm = *(const u32x4*)(mp + bj * HALF);
                    const f32x4 a0 = acc[ai][bj][m][0], a1 = acc[ai][bj][m][1];
                    u32x4 w; w.x = cvt_pk_bf16(bf_lo(mm.x) + a0[0] * bf_lo(g.x), bf_hi(mm.x) + a0[1] * bf_hi(g.x)); w.y = cvt_pk_bf16(bf_lo(mm.y) + a0[2] * bf_lo(g.y), bf_hi(mm.y) + a0[3] * bf_hi(g.y));
                    w.z = cvt_pk_bf16(bf_lo(mm.z) + a1[0] * bf_lo(g.z), bf_hi(mm.z) + a1[1] * bf_hi(g.z)); w.w = cvt_pk_bf16(bf_lo(mm.w) + a1[2] * bf_lo(g.w), bf_hi(mm.w) + a1[3] * bf_hi(g.w));
                    *(u32x4*)(rowp + bj * HALF) = w; } }
    }
};
struct EpiResid {
    static constexpr bool PERM = false, AFTER_DRAIN = false, SELF_SCALE = false;
    const float* smeta; const float* sreal; float* dmeta; float* dreal; int ld; int nmeta; int nrows;
    __device__ __forceinline__ void operator()(const f32x4 (&acc)[2][2][4][2], const Unit& u, int wr, int wc, int fr, int fq) const {
        const int row0 = u.pm * BM + wr * 64 + fr, col0 = u.pn * BM + wc * 32 + 4 * fq;
#pragma unroll
        for (int ai = 0; ai < 2; ++ai)
#pragma unroll
            for (int m = 0; m < 4; ++m) { const int r = row0 + ai * HALF + m * 16;
                if (r < nrows) {
                    const float* sp = (r < nmeta ? smeta + (size_t)r * ld : sreal + (size_t)(r - nmeta) * ld) + col0;
                    float* dp = (r < nmeta ? dmeta + (size_t)r * ld : dreal + (size_t)(r - nmeta) * ld) + col0;
#pragma unroll
                    for (int bj = 0; bj < 2; ++bj)
#pragma unroll
                        for (int n = 0; n < 2; ++n) *(f32x4*)(dp + bj * HALF + n * 16) = *(const f32x4*)(sp + bj * HALF + n * 16) + acc[ai][bj][m][n];
                } }
    }
};

template <int CTRL> __device__ __forceinline__ float dpp_mov(float v) { return __builtin_bit_cast(float, __builtin_amdgcn_update_dpp(0, __builtin_bit_cast(int, v), CTRL, 0xf, 0xf, false)); }
struct EpiConvAct {
    static constexpr bool PERM = true, AFTER_DRAIN = false, SELF_SCALE = true;
    bf16_t* ACT; int ldact; float* HALO; int ldh; const float* cw; const float* cb; int dff; PG8_LAS float* hx; const float* sag; const float* sb;
    __device__ __forceinline__ void operator()(const f32x4 (&acc)[2][2][4][2], const Unit& u, int wr, int wc, int fr, int fq) const {
        const int cl = wc * 32 + 8 * fq;
        const int ch = u.pn * 128 + cl;
        if (fr >= 14) {
#pragma unroll
            for (int ai = 0; ai < 2; ++ai)
#pragma unroll
                for (int bj = 0; bj < 2; ++bj)
#pragma unroll
                    for (int n = 0; n < 2; ++n) *(PG8_LAS f32x4*)(hx + (((ai * 2 + wr) * 2 + (fr - 14)) * 256 + bj * 128 + cl + 4 * n)) = acc[ai][bj][3][n];
        }
        if (wr == 0 && fr < 2) {
            float* hp = HALO + ((size_t)u.pm * 4 + fr) * ldh + u.pn * 256 + cl;
#pragma unroll
            for (int bj = 0; bj < 2; ++bj)
#pragma unroll
                for (int n = 0; n < 2; ++n) *(f32x4*)(hp + bj * 128 + 4 * n) = acc[0][bj][0][n] * (*(const f32x4*)(sb + u.pn * 256 + bj * 128 + cl + 4 * n) * sag[0]);
        }
        if (wr == 1 && fr >= 14) {
            float* hp = HALO + ((size_t)u.pm * 4 + (fr - 12)) * ldh + u.pn * 256 + cl;
#pragma unroll
            for (int bj = 0; bj < 2; ++bj)
#pragma unroll
                for (int n = 0; n < 2; ++n) *(f32x4*)(hp + bj * 128 + 4 * n) = acc[1][bj][3][n] * (*(const f32x4*)(sb + u.pn * 256 + bj * 128 + cl + 4 * n) * sag[0]);
        }
        asm volatile("s_waitcnt lgkmcnt(0)" ::: "memory"); __builtin_amdgcn_s_barrier(); asm volatile("" ::: "memory");
#pragma unroll
        for (int n = 0; n < 2; ++n) {
            f32x4 wt[2][3], bb[2];
#pragma unroll
            for (int bj = 0; bj < 2; ++bj) { bb[bj] = *(const f32x4*)(cb + bj * dff + ch + 4 * n);
#pragma unroll
                for (int i = 0; i < 3; ++i) wt[bj][i] = *(const f32x4*)(cw + (size_t)i * 2 * dff + bj * dff + ch + 4 * n) * (*(const f32x4*)(sb + u.pn * 256 + bj * 128 + cl + 4 * n) * sag[0]); }
#pragma unroll
            for (int ai = 0; ai < 2; ++ai) {
                const bool hasprev = (ai | wr) != 0; const int pb = ai * 2 + wr - 1;
                f32x4 xp[2];
#pragma unroll
                for (int bj = 0; bj < 2; ++bj) { xp[bj] = (f32x4){0.f, 0.f, 0.f, 0.f};
                    if (hasprev && fr >= 14) xp[bj] = *(const PG8_LAS f32x4*)(hx + ((pb * 2 + (fr - 14)) * 256 + bj * 128 + cl + 4 * n)); }
#pragma unroll
                for (int m = 0; m < 4; ++m) {
                    f32x4 z[2];
#pragma unroll
                    for (int bj = 0; bj < 2; ++bj) {
                        const f32x4 x = acc[ai][bj][m][n];
#pragma unroll
                        for (int j = 0; j < 4; ++j) {
                            const float a1 = dpp_mov<0x121>(x[j]), p1 = dpp_mov<0x121>(xp[bj][j]), a2 = dpp_mov<0x122>(x[j]), p2 = dpp_mov<0x122>(xp[bj][j]);
                            const float s1 = fr == 0 ? p1 : a1, s2 = fr < 2 ? p2 : a2;
                            z[bj][j] = bb[bj][j] + wt[bj][2][j] * x[j] + wt[bj][1][j] * s1 + wt[bj][0][j] * s2;
                        }
                        xp[bj] = x;
                    }
                    const int r = u.pm * BM + ai * HALF + wr * 64 + m * 16 + fr;
                    float o[4];
#pragma unroll
                    for (int j = 0; j < 4; ++j) { const float g = z[0][j]; o[j] = g * __builtin_amdgcn_rcpf(1.f + __expf(-g)) * z[1][j]; }
                    u32x2 w; w.x = cvt_pk_bf16(o[0], o[1]); w.y = cvt_pk_bf16(o[2], o[3]);
                    *(u32x2*)(ACT + (size_t)r * ldact + ch + 4 * n) = w;
                }
                asm volatile("" ::: "memory");
            }
        }
    }
};
template <class Epi, class Sched, bool ALIGN_EPI = false, bool SP2 = false, bool I8 = false>
__device__ __forceinline__ void gemm_phase(PG8_LAS unsigned char* lds, const Gemm g, const Sched& S, const Epi& E) {
    const int tid = threadIdx.x, wid = __builtin_amdgcn_readfirstlane(tid >> 6), lane = tid & 63, wr = wid >> 2, wc = wid & 3, fr = lane & 15, fq = lane >> 4;
    const int K = g.K, nt = K / BK;
    unsigned voffA[2], voffB[2];
#pragma unroll
    for (int i = 0; i < 2; ++i) { int R, C; stage_rc(tid * 16 + i * 8192, R, C); const int Rb = Epi::PERM ? ((R & ~31) + perm32(R & 31)) : R;
        voffA[i] = (unsigned)(R * K + C) * 2u; voffB[i] = (unsigned)(Rb * K + C) * 2u; }
    const size_t kstep = (size_t)(BK * 2);
    const size_t hstep = (size_t)HALF * K * 2;
    const size_t tstep = 2 * hstep;
    const unsigned ldsw = (unsigned)wid * 1024u;
    const int aoff = lds_byte(wr * 64 + fr, fq * 8), boff = lds_byte(wc * 32 + fr, fq * 8);
#define PG8_SA(b, h) (((b) * 2 + (h)) * HTB)
#define PG8_SB(b, h) ((4 + (b) * 2 + (h)) * HTB)
#define PG8_STAGE(bufoff, gbase, voff) do { _Pragma("unroll") for (int _i = 0; _i < 2; ++_i) \
        __builtin_amdgcn_global_load_lds((const unsigned*)((const char*)(gbase) + (voff)[_i]), (PG8_LAS unsigned*)(lds + (bufoff) + ldsw + _i * 8192), 16, 0, 0); } while (0)
#define PG8_LDA(dst, b, h) do { _Pragma("unroll") for (int m = 0; m < 4; ++m) _Pragma("unroll") for (int k = 0; k < 2; ++k) dst[m][k] = *(const PG8_LAS bf16x8*)(lds + PG8_SA(b, h) + aoff + m * 2048 + k * 1024); } while (0)
#define PG8_LDB(dst, b, h) do { _Pragma("unroll") for (int n = 0; n < 2; ++n) _Pragma("unroll") for (int k = 0; k < 2; ++k) dst[n][k] = *(const PG8_LAS bf16x8*)(lds + PG8_SB(b, h) + boff + n * 2048 + k * 1024); } while (0)
#define PG8_MMA(ai, bj, At, Bt) do { __builtin_amdgcn_s_setprio(1); _Pragma("unroll") for (int m = 0; m < 4; ++m) _Pragma("unroll") for (int n = 0; n < 2; ++n) _Pragma("unroll") for (int k = 0; k < 2; ++k) { \
        if constexpr (I8) acc[ai][bj][m][n] = __builtin_bit_cast(f32x4, __builtin_amdgcn_mfma_i32_16x16x64_i8(__builtin_bit_cast(i32x4, Bt[n][k]), __builtin_bit_cast(i32x4, At[m][k]), __builtin_bit_cast(i32x4, acc[ai][bj][m][n]), 0, 0, 0)); \
        else acc[ai][bj][m][n] = __builtin_amdgcn_mfma_f32_16x16x32_bf16(Bt[n][k], At[m][k], acc[ai][bj][m][n], 0, 0, 0); } __builtin_amdgcn_s_setprio(0); } while (0)
#define PG8_WAIT_V(n) asm volatile("s_waitcnt vmcnt(" #n ")" ::: "memory")
#define PG8_WAIT_L(n) asm volatile("s_waitcnt lgkmcnt(" #n ")" ::: "memory")
#define PG8_BAR __builtin_amdgcn_s_barrier()
#define PG8_SCHED __builtin_amdgcn_sched_barrier(0)
    Unit cur, nxt; int ui = 0;
    if (!S.next(0, cur)) return;
    f32x4 acc[2][2][4][2];
#pragma unroll
    for (int a = 0; a < 2; ++a)
#pragma unroll
        for (int b = 0; b < 2; ++b)
#pragma unroll
            for (int m = 0; m < 4; ++m)
#pragma unroll
                for (int n = 0; n < 2; ++n) acc[a][b][m][n] = (f32x4){0.f, 0.f, 0.f, 0.f};
    bf16x8 At[4][2], B0[2][2], B1[2][2];
    const char* cA = (const char*)g.A + (size_t)cur.pm * tstep; const char* cB = (const char*)g.Bt + (size_t)cur.pn * tstep;
    S.a_ready(cur);
    if constexpr (SP2) {
        PG8_STAGE(PG8_SB(0, 0), cB, voffB); PG8_STAGE(PG8_SB(0, 1), cB + hstep, voffB); PG8_STAGE(PG8_SA(0, 0), cA, voffA); PG8_STAGE(PG8_SA(0, 1), cA + hstep, voffA);
        if (wr == 1) PG8_BAR;
        PG8_WAIT_V(2); PG8_BAR;
        PG8_STAGE(PG8_SB(1, 0), cB + kstep, voffB); PG8_STAGE(PG8_SA(1, 0), cA + kstep, voffA); PG8_STAGE(PG8_SB(1, 1), cB + hstep + kstep, voffB);
        PG8_WAIT_V(6); PG8_BAR;
    } else {
        PG8_STAGE(PG8_SB(0, 0), cB, voffB); PG8_STAGE(PG8_SA(0, 0), cA, voffA); PG8_STAGE(PG8_SB(0, 1), cB + hstep, voffB); PG8_STAGE(PG8_SA(0, 1), cA + hstep, voffA);
        if (wr == 1) PG8_BAR;
        PG8_WAIT_V(4); PG8_BAR;
        PG8_STAGE(PG8_SB(1, 0), cB + kstep, voffB); PG8_STAGE(PG8_SA(1, 0), cA + kstep, voffA); PG8_STAGE(PG8_SB(1, 1), cB + hstep + kstep, voffB);
        PG8_WAIT_V(6); PG8_BAR;
    }
    for (;;) {
        const bool has_next = S.next(ui + 1, nxt);
        const char* nA = has_next ? (const char*)g.A + (size_t)nxt.pm * tstep : cA; const char* nB = has_next ? (const char*)g.Bt + (size_t)nxt.pn * tstep : cB;
        for (int t = 0; t < nt; t += 2) {
            const bool last = (t == nt - 2);
            const char* a1 = cA + (size_t)(t + 1) * kstep;
            const char* a2 = last ? nA : cA + (size_t)(t + 2) * kstep; const char* b2 = last ? nB : cB + (size_t)(t + 2) * kstep;
            const char* a3 = a2 + kstep; const char* b3 = b2 + kstep;
            if (last && has_next) S.a_ready(nxt);
            if constexpr (SP2) {
            PG8_LDB(B0, 0, 0); PG8_LDB(B1, 0, 1); PG8_SCHED; PG8_LDA(At, 0, 0); PG8_STAGE(PG8_SA(1, 1), a1 + hstep, voffA);
            PG8_WAIT_V(8); PG8_WAIT_L(0); PG8_BAR; PG8_MMA(0, 0, At, B0); PG8_MMA(0, 1, At, B1); PG8_BAR; PG8_SCHED;
            PG8_LDA(At, 0, 1); PG8_STAGE(PG8_SB(0, 0), b2, voffB); PG8_STAGE(PG8_SB(0, 1), b2 + hstep, voffB); PG8_STAGE(PG8_SA(0, 0), a2, voffA);
            PG8_WAIT_V(8); PG8_WAIT_L(0); PG8_BAR; PG8_MMA(1, 0, At, B0); PG8_MMA(1, 1, At, B1); PG8_BAR; PG8_SCHED;
            PG8_LDB(B0, 1, 0); PG8_LDB(B1, 1, 1); PG8_SCHED; PG8_LDA(At, 1, 0); PG8_STAGE(PG8_SA(0, 1), a2 + hstep, voffA);
            PG8_WAIT_V(8); PG8_WAIT_L(0); PG8_BAR; PG8_MMA(0, 0, At, B0); PG8_MMA(0, 1, At, B1); PG8_BAR; PG8_SCHED;
            PG8_LDA(At, 1, 1); PG8_STAGE(PG8_SB(1, 0), b3, voffB); PG8_STAGE(PG8_SB(1, 1), b3 + hstep, voffB); PG8_STAGE(PG8_SA(1, 0), a3, voffA);
            PG8_WAIT_V(8); PG8_WAIT_L(0); PG8_BAR; PG8_MMA(1, 0, At, B0); PG8_MMA(1, 1, At, B1); PG8_BAR; PG8_SCHED;
            } else {
            PG8_LDB(B0, 0, 0); PG8_SCHED; PG8_LDA(At, 0, 0); PG8_STAGE(PG8_SA(1, 1), a1 + hstep, voffA);
            PG8_WAIT_L(8); PG8_BAR; PG8_WAIT_L(0); PG8_MMA(0, 0, At, B0); PG8_BAR; PG8_SCHED;
            PG8_LDB(B1, 0, 1); PG8_STAGE(PG8_SB(0, 0), b2, voffB);
            PG8_BAR; PG8_WAIT_L(0); PG8_MMA(0, 1, At, B1); PG8_BAR;
            PG8_LDA(At, 0, 1); PG8_STAGE(PG8_SA(0, 0), a2, voffA);
            PG8_BAR; PG8_WAIT_L(0); PG8_MMA(1, 0, At, B0); PG8_BAR; PG8_SCHED;
            PG8_STAGE(PG8_SB(0, 1), b2 + hstep, voffB);
            PG8_WAIT_V(6); PG8_BAR; PG8_MMA(1, 1, At, B1); PG8_BAR;
            PG8_LDB(B0, 1, 0); PG8_SCHED; PG8_LDA(At, 1, 0); PG8_STAGE(PG8_SA(0, 1), a2 + hstep, voffA);
            PG8_WAIT_L(8); PG8_BAR; PG8_WAIT_L(0); PG8_MMA(0, 0, At, B0); PG8_BAR; PG8_SCHED;
            PG8_LDB(B1, 1, 1); PG8_STAGE(PG8_SB(1, 0), b3, voffB);
            PG8_BAR; PG8_WAIT_L(0); PG8_MMA(0, 1, At, B1); PG8_BAR;
            PG8_LDA(At, 1, 1); PG8_STAGE(PG8_SA(1, 0), a3, voffA);
            PG8_BAR; PG8_WAIT_L(0); PG8_MMA(1, 0, At, B0); PG8_BAR; PG8_SCHED;
            PG8_STAGE(PG8_SB(1, 1), b3 + hstep, voffB);
            PG8_WAIT_V(6); PG8_BAR; PG8_MMA(1, 1, At, B1); PG8_BAR;
            }
        }
        if constexpr (ALIGN_EPI) { if (wr == 0) PG8_BAR; }
        if constexpr (I8) {
            asm volatile("s_nop 15\n\ts_nop 15" ::: "memory");
#pragma unroll
            for (int ai = 0; ai < 2; ++ai)
#pragma unroll
                for (int bj = 0; bj < 2; ++bj)
#pragma unroll
                    for (int m = 0; m < 4; ++m)
#pragma unroll
                        for (int n = 0; n < 2; ++n)
#pragma unroll
                            for (int j = 0; j < 4; ++j) { float x = acc[ai][bj][m][n][j]; asm volatile("v_cvt_f32_i32 %0, %0" : "+v"(x)); acc[ai][bj][m][n][j] = x; }
            if constexpr (!Epi::SELF_SCALE) {
                const int row0 = cur.pm * BM + wr * 64 + fr, col0 = cur.pn * BM + wc * 32 + (Epi::PERM ? 8 * fq : 4 * fq);
#pragma unroll
                for (int bj = 0; bj < 2; ++bj)
#pragma unroll
                    for (int n = 0; n < 2; ++n) { const f32x4 sc = *(const f32x4*)(g.sb + col0 + bj * HALF + (Epi::PERM ? 4 * n : 16 * n));
#pragma unroll
                        for (int ai = 0; ai < 2; ++ai)
#pragma unroll
                            for (int m = 0; m < 4; ++m) { const float sr = g.sa[row0 + ai * HALF + m * 16]; acc[ai][bj][m][n] = acc[ai][bj][m][n] * (sc * sr); } }
            }
        }
        if constexpr (!Epi::AFTER_DRAIN) { E(acc, cur, wr, wc, fr, fq); S.done(cur); }
        if (!has_next) break;
#pragma unroll
        for (int a = 0; a < 2; ++a)
#pragma unroll
            for (int b = 0; b < 2; ++b)
#pragma unroll
                for (int m = 0; m < 4; ++m)
#pragma unroll
                    for (int n = 0; n < 2; ++n) acc[a][b][m][n] = (f32x4){0.f, 0.f, 0.f, 0.f};
        cur = nxt; cA = nA; cB = nB; ++ui;
        if constexpr (ALIGN_EPI) { if (wr == 1) PG8_BAR; }
    }
    PG8_WAIT_V(0);
    if constexpr (!ALIGN_EPI) { if (wr == 0) PG8_BAR; }
    PG8_BAR;
    if constexpr (Epi::AFTER_DRAIN) { E.fused(acc, cur, wr, wc, fr, fq, lds, wid, lane); S.done(cur); }
#undef PG8_SA
#undef PG8_SB
#undef PG8_STAGE
#undef PG8_LDA
#undef PG8_LDB
#undef PG8_MMA
#undef PG8_WAIT_V
#undef PG8_WAIT_L
#undef PG8_BAR
#undef PG8_SCHED
}
}
#define XB_TMO      128
#define XB_XCNT(j)  (256  + 64 * (j))
#define XB_XSUB(j)  (1280 + 64 * (j))
#define XB_XGEN(j)  (2304 + 64 * (j))
#define XB_TOP      3328
#define XB_TOPGEN   3392
#define XCD_BAR_WORDS 3456
#define XB_SPIN_CAP (1u << 18)
#define LAS __attribute__((address_space(3)))

__device__ __forceinline__ unsigned xb_ld(unsigned* p)              { return __hip_atomic_load(p, __ATOMIC_RELAXED, __HIP_MEMORY_SCOPE_AGENT); }
__device__ __forceinline__ unsigned xb_add(unsigned* p, unsigned v) { return __hip_atomic_fetch_add(p, v, __ATOMIC_RELAXED, __HIP_MEMORY_SCOPE_AGENT); }
__device__ __forceinline__ unsigned xb_xcc_id() { return (unsigned)__builtin_amdgcn_s_getreg((3 << 11) | 20) & 0xFu; }
#define XB_SPIN(cond, bar) do { unsigned _sp = 0; while (cond) { __builtin_amdgcn_s_sleep(1); \
    if ((++_sp & 255u) == 0u) { if (xb_ld(&(bar)[XB_TMO])) break; if (_sp > XB_SPIN_CAP) { atomicAdd(&(bar)[XB_TMO], 1u); break; } } } } while (0)

struct XcdBarrier {
    unsigned* bar; unsigned x;
    volatile LAS unsigned* st;
};

__device__ __forceinline__ XcdBarrier xcd_barrier_post(unsigned* bar, volatile LAS unsigned* st) {
    XcdBarrier b; b.bar = bar; b.x = xb_xcc_id(); b.st = st;
    if (threadIdx.x == 0) (void)xb_add(&bar[XB_XCNT(b.x)], 1u);
    return b;
}
__device__ __forceinline__ void xcd_barrier_complete(unsigned* bar, unsigned x, unsigned& nloc, unsigned& nx) {
    const unsigned G = gridDim.x * gridDim.y * gridDim.z;
    unsigned sum, cnt, mine, sp = 0u;
    for (;;) {
        sum = 0u; cnt = 0u; mine = 0u;
#pragma unroll
        for (unsigned j = 0; j < 16; ++j) { const unsigned c = xb_ld(&bar[XB_XCNT(j)]); sum += c; cnt += (c > 0u) ? 1u : 0u; mine = (j == x) ? c : mine; }
        if (sum == G) break;
        __builtin_amdgcn_s_sleep(1);
        if ((++sp & 255u) == 0u) { if (xb_ld(&bar[XB_TMO])) break; if (sp > XB_SPIN_CAP) { atomicAdd(&bar[XB_TMO], 1u); break; } }
    }
    nloc = mine > 0u ? mine : 1u; nx = cnt > 0u ? cnt : 1u;
}

__device__ __forceinline__ void xcd_barrier(const XcdBarrier& b) {
    asm volatile("s_waitcnt vmcnt(0)" ::: "memory");
    __syncthreads();
    if (threadIdx.x == 0) {
        unsigned* bar = b.bar;
        __builtin_amdgcn_s_waitcnt(0);
        unsigned nloc = b.st[0], nx = b.st[1];
        if (nloc == 0u) { xcd_barrier_complete(bar, b.x, nloc, nx); b.st[0] = nloc; b.st[1] = nx; }
        const unsigned old = xb_add(&bar[XB_XSUB(b.x)], 1u);
        const unsigned gen = old / nloc;
        if (old + 1u == (gen + 1u) * nloc) {
            __builtin_amdgcn_fence(__ATOMIC_RELEASE, "agent");
            asm volatile("s_waitcnt vmcnt(0)" ::: "memory");
            const unsigned og = xb_add(&bar[XB_TOP], 1u);
            const unsigned tg = og / nx;
            if (og + 1u == (tg + 1u) * nx) xb_add(&bar[XB_TOPGEN], 1u);
            else XB_SPIN(xb_ld(&bar[XB_TOPGEN]) == tg, bar);
            __builtin_amdgcn_fence(__ATOMIC_ACQUIRE, "agent");
            xb_add(&bar[XB_XGEN(b.x)], 1u);
            asm volatile("s_waitcnt vmcnt(0)" ::: "memory");
        } else {
            XB_SPIN(xb_ld(&bar[XB_XGEN(b.x)]) == gen, bar);
            __builtin_amdgcn_fence(__ATOMIC_ACQUIRE, "agent");
            asm volatile("s_waitcnt vmcnt(0)" ::: "memory");
        }
    }
    __syncthreads();
}

#define LAS __attribute__((address_space(3)))
typedef unsigned short bf16_t;
typedef float f32x4 __attribute__((ext_vector_type(4)));
typedef unsigned u32x4 __attribute__((ext_vector_type(4)));
typedef unsigned u32x2 __attribute__((ext_vector_type(2)));

#ifndef MK_ONE_LAUNCH
#define MK_ONE_LAUNCH 0
#endif

constexpr int NWAVES = 8, NT = NWAVES * 64;
constexpr int D = 4096, SEQ = 16384, NMETA = 16, L = SEQ + NMETA, MP = 16640;
constexpr int A_W = 2048, A_COLS = 6592, B_COLS = 4704, IN_COLS = A_COLS + B_COLS, NZ = 11520;
constexpr int ZQ = A_COLS, ZCKV = A_COLS + 2048, ZQI = A_COLS + 2560, ZKI = A_COLS + 4608, ZWI = A_COLS + 4672;
constexpr int DFF = 11008, NFI = 2 * DFF;
constexpr int KVR = 512, NH_B = 16, HD_B = 128, IDXH = 32, IDXD = 64, TOPK = 256;
constexpr int LDS_BYTES = 163840, MISC_OFF = 163584;
constexpr int NZ8 = 8960;
constexpr size_t WINT_BF_OFF = (size_t)40 << 20;

constexpr size_t al256(size_t x) { return (x + 255) & ~(size_t)255; }
constexpr size_t WS_CTL = 0, CTL_BYTES = 1u << 20;
constexpr size_t WS_WGT = WS_CTL + CTL_BYTES;
constexpr size_t WS_WPAT = WS_WGT + (size_t)8192 * 4096 * 2;
constexpr size_t WS_WPBT = WS_WPAT + (size_t)4096 * 2048 * 2;
constexpr size_t WS_WOUTT = WS_WPBT + (size_t)4096 * 2048 * 2;
constexpr size_t WS_WFIT = WS_WOUTT + (size_t)4096 * 4096 * 2;
constexpr size_t WS_WFOT = WS_WFIT + (size_t)NFI * 4096 * 2;
constexpr size_t WS_WINT = WS_WFOT + (size_t)4096 * DFF * 2;
constexpr size_t WS_U = WS_WINT + (size_t)NZ * 4096 * 2;
constexpr size_t WS_BIG = WS_U + (size_t)MP * D * 2;
constexpr size_t WS_Z = WS_BIG;
constexpr size_t WS_R1 = WS_Z + (size_t)MP * NZ * 2;
constexpr size_t R1_BYTES = (size_t)MP * D * 4;
constexpr size_t WS_LD = WS_R1;
constexpr size_t WS_AA = WS_LD + (size_t)L * A_W * 4;
constexpr size_t WS_GG = WS_AA + (size_t)L * A_W * 2;
constexpr size_t WS_QLAT = WS_R1;
constexpr size_t WS_MF = WS_R1;
constexpr size_t WS_YA = WS_R1 + R1_BYTES;
constexpr size_t WS_YB = WS_YA + (size_t)MP * A_W * 2;
constexpr size_t WS_END = WS_YB + (size_t)MP * A_W * 2;
constexpr size_t WS_GATES = WS_Z;
constexpr size_t WS_ZF = WS_BIG;
constexpr size_t WS_ACT = WS_BIG + (size_t)MP * DFF * 2;
constexpr size_t WS_CKV = WS_WINT;
constexpr size_t WS_KIDX = WS_CKV + al256((size_t)L * KVR * 2);
constexpr size_t WS_SEL = WS_KIDX + al256((size_t)L * IDXD * 4);
constexpr size_t WS_HMETA = WS_SEL + al256((size_t)L * TOPK * 4);
static_assert(WS_HMETA + (size_t)NMETA * D * 4 <= WS_U, "DSA overlays exceed WINT");
constexpr size_t WS_KIDXB = WS_HMETA + al256((size_t)NMETA * D * 4);
static_assert(WS_KIDXB + (size_t)L * IDXD * 2 <= WS_U, "KIDXB");
constexpr size_t WS_WUKB = WS_END;
constexpr size_t WS_WUVT = WS_WUKB + (size_t)16 * 512 * 128 * 2;
constexpr size_t WS_WLT = WS_WUVT + (size_t)16 * 512 * 128 * 2;
constexpr size_t WS_END2 = WS_WLT + (size_t)2048 * 448 * 2;
static_assert(WS_END2 <= (size_t)4 * 4096 * 22016 * 4, "workspace");
constexpr size_t CT_CMX_IN = 524288, CT_CMX_G = CT_CMX_IN + (size_t)NZ * 4, CT_CMX_F = CT_CMX_G + 8192 * 4, CT_SB_IN = CT_CMX_F + (size_t)NFI * 4, CT_SB_G = CT_SB_IN + (size_t)NZ * 4,
                 CT_SB_F = CT_SB_G + 8192 * 4, CT_SA = CT_SB_F + (size_t)NFI * 4, CT_AMAX = CT_SA + (size_t)MP * 4, CT_SAG = CT_AMAX + 256, CT_END = CT_SAG + 256;
static_assert(CT_END <= CTL_BYTES, "control region");
constexpr size_t WS_ST = WS_WINT;
constexpr size_t WS_BS = WS_ST + al256((size_t)257 * 32 * 4096 * 2);
static_assert(WS_BS + (size_t)L * 32 * 4 <= WS_U, "RWKV overlays exceed WINT");
static_assert((size_t)L * A_W * 4 + 2 * (size_t)L * A_W * 2 <= R1_BYTES && (size_t)L * 8192 * 2 <= R1_BYTES, "R1");
static_assert(WS_ACT + (size_t)MP * DFF * 2 <= WS_END, "ACT");
static_assert((size_t)MP * 8192 * 2 <= (size_t)MP * NZ * 2, "GATES");
static_assert(WS_END <= (size_t)4 * 4096 * 22016 * 4, "workspace");

__device__ __forceinline__ float bf2f(bf16_t b) { return __uint_as_float(((unsigned)b) << 16); }
__device__ __forceinline__ bf16_t f2bf(float f) { unsigned u = __float_as_uint(f); u += 0x7FFFu + ((u >> 16) & 1u); return (bf16_t)(u >> 16); }
__device__ __forceinline__ unsigned pk2(float lo, float hi) { return (unsigned)f2bf(lo) | ((unsigned)f2bf(hi) << 16); }
__device__ __forceinline__ float blo(unsigned w) { return __uint_as_float(w << 16); }
__device__ __forceinline__ float bhi(unsigned w) { return __uint_as_float(w & 0xffff0000u); }
__device__ __forceinline__ float sigm(float x) { return 1.f / (1.f + __expf(-x)); }
template <int CTRL> __device__ __forceinline__ float dpp_f(float v) { return __builtin_bit_cast(float, __builtin_amdgcn_update_dpp(0, __builtin_bit_cast(int, v), CTRL, 0xf, 0xf, false)); }
__device__ __forceinline__ float wave_sum(float v) {
    v += dpp_f<0xB1>(v);
    v += dpp_f<0x4E>(v);
    v += dpp_f<0x141>(v);
    v += dpp_f<0x140>(v);
    const float a = __builtin_bit_cast(float, __builtin_amdgcn_readlane(__builtin_bit_cast(int, v), 0));
    const float b = __builtin_bit_cast(float, __builtin_amdgcn_readlane(__builtin_bit_cast(int, v), 16));
    const float c = __builtin_bit_cast(float, __builtin_amdgcn_readlane(__builtin_bit_cast(int, v), 32));
    const float d = __builtin_bit_cast(float, __builtin_amdgcn_readlane(__builtin_bit_cast(int, v), 48));
    return (a + b) + (c + d);
}
__device__ __forceinline__ float wave_max(float v) {
    v = fmaxf(v, dpp_f<0xB1>(v)); v = fmaxf(v, dpp_f<0x4E>(v)); v = fmaxf(v, dpp_f<0x141>(v)); v = fmaxf(v, dpp_f<0x140>(v));
    const float a = __builtin_bit_cast(float, __builtin_amdgcn_readlane(__builtin_bit_cast(int, v), 0));
    const float b = __builtin_bit_cast(float, __builtin_amdgcn_readlane(__builtin_bit_cast(int, v), 16));
    const float c = __builtin_bit_cast(float, __builtin_amdgcn_readlane(__builtin_bit_cast(int, v), 32));
    const float d = __builtin_bit_cast(float, __builtin_amdgcn_readlane(__builtin_bit_cast(int, v), 48));
    return fmaxf(fmaxf(a, b), fmaxf(c, d));
}
#define LDS_WAIT() asm volatile("s_waitcnt lgkmcnt(0)" ::: "memory")

struct P {
    const float* in[30]; float* out; unsigned char* ws; int ph_lo, ph_hi;
};
enum { I_X = 0, I_META, I_NMW, I_WIN, I_MU, I_W0, I_W2, I_A0, I_A2, I_G2, I_KK, I_KA, I_RK, I_LNW, I_LNB, I_KVNW, I_WUK, I_WUV, I_ILNW, I_ILNB,
       I_WPA, I_WPB, I_WGATE, I_WOUT, I_NFW, I_WFI, I_CW, I_CB, I_WFO, I_NFIN };

template <int MODE>
__device__ __forceinline__ void tr_item(const float* W, int K, int N, int Npad, bf16_t* WT, LAS float* scr, int item, int lane) {
    const int nblk = Npad / 32, kb = item / nblk, nb = item % nblk, k0 = 64 * kb, n0 = 32 * nb;
    int s0 = n0; bool valid = n0 < N;
    if (MODE == 1) { const int T = n0 >> 8, w = n0 & 255; s0 = (w < 128) ? T * 128 + w : DFF + T * 128 + (w - 128); valid = true; }
    if (valid) {
#pragma unroll 8
        for (int i = 0; i < 32; ++i) { const int kk = 2 * i + (lane >> 5); scr[kk * 33 + (lane & 31)] = W[(size_t)(k0 + kk) * N + s0 + (lane & 31)]; }
    } else {
#pragma unroll 8
        for (int i = 0; i < 32; ++i) { const int kk = 2 * i + (lane >> 5); scr[kk * 33 + (lane & 31)] = 0.f; }
    }
    LDS_WAIT(); __builtin_amdgcn_wave_barrier();
    const int c = lane & 7;
#pragma unroll
    for (int j = 0; j < 4; ++j) { const int n = (lane >> 3) + 8 * j; const LAS float* s = scr + (8 * c) * 33 + n;
        u32x4 o; o.x = pk2(s[0 * 33], s[1 * 33]); o.y = pk2(s[2 * 33], s[3 * 33]); o.z = pk2(s[4 * 33], s[5 * 33]); o.w = pk2(s[6 * 33], s[7 * 33]);
        *(u32x4*)(WT + (size_t)(n0 + n) * K + k0 + 8 * c) = o; }
    LDS_WAIT(); __builtin_amdgcn_wave_barrier();
}
__device__ __forceinline__ void colmax_item(const float* W, int N, unsigned* cmx, int it) {
    const int nb = (N + 511) / 512, kc = it / nb, n = (it % nb) * 512 + threadIdx.x;
    if (n < N) { float m = 0.f; const float* wp = W + (size_t)kc * 64 * N + n;
#pragma unroll 8
        for (int k = 0; k < 64; ++k) m = fmaxf(m, fabsf(wp[(size_t)k * N]));
        atomicMax(cmx + n, __float_as_uint(m)); }
}
template <int MODE>
__device__ __forceinline__ void tr_item_i8(const float* W, int K, int N, int Npad, signed char* WT, const unsigned* cmx, float* sbdst, LAS float* scr, int item, int lane) {
    const int nblk = Npad / 32, kb = item / nblk, nb = item % nblk, k0 = 64 * kb, n0 = 32 * nb;
    int s0 = n0; bool valid = n0 < N;
    if (MODE == 1) { const int T = n0 >> 8, w = n0 & 255; s0 = (w < 128) ? T * 128 + w : DFF + T * 128 + (w - 128); valid = true; }
    if (valid) {
#pragma unroll 8
        for (int i = 0; i < 32; ++i) { const int kk = 2 * i + (lane >> 5); scr[kk * 33 + (lane & 31)] = W[(size_t)(k0 + kk) * N + s0 + (lane & 31)]; }
    } else {
#pragma unroll 8
        for (int i = 0; i < 32; ++i) { const int kk = 2 * i + (lane >> 5); scr[kk * 33 + (lane & 31)] = 0.f; }
    }
    LDS_WAIT(); __builtin_amdgcn_wave_barrier();
    const int n = lane >> 1, half = lane & 1;
    const float mx = valid ? __uint_as_float(cmx[s0 + n]) : 0.f; const float inv = mx > 0.f ? 127.f / mx : 0.f;
    unsigned o[8];
#pragma unroll
    for (int c = 0; c < 8; ++c) { unsigned w = 0u;
#pragma unroll
        for (int e = 0; e < 4; ++e) { const int qv = (int)rintf(scr[(half * 32 + c * 4 + e) * 33 + n] * inv); w |= ((unsigned)qv & 0xffu) << (8 * e); }
        o[c] = w; }
    *(u32x4*)(WT + (size_t)(n0 + n) * K + k0 + half * 32) = (u32x4){o[0], o[1], o[2], o[3]};
    *(u32x4*)(WT + (size_t)(n0 + n) * K + k0 + half * 32 + 16) = (u32x4){o[4], o[5], o[6], o[7]};
    if (kb == 0 && half == 0) sbdst[n0 + n] = mx * (1.f / 127.f);
    LDS_WAIT(); __builtin_amdgcn_wave_barrier();
}
template <bool DUAL = false> __device__ __forceinline__ void rms_row_i8(const float* src, const float* w, signed char* dst, float* sa, int lane, float eps, bf16_t* dstb = nullptr) {
    if (src == nullptr) {
        if (DUAL) {
#pragma unroll
            for (int j = 0; j < 8; ++j) *(u32x4*)(dstb + (j * 64 + lane) * 8) = (u32x4){0u, 0u, 0u, 0u}; }
#pragma unroll
        for (int j = 0; j < 4; ++j) *(u32x4*)(dst + (j * 64 + lane) * 16) = (u32x4){0u, 0u, 0u, 0u};
        if (lane == 0) *sa = 1.f;
        return;
    }
    f32x4 v[16]; float s = 0.f;
#pragma unroll
    for (int j = 0; j < 16; ++j) { v[j] = *(const f32x4*)(src + (j * 64 + lane) * 4); s += (v[j].x * v[j].x + v[j].y * v[j].y) + (v[j].z * v[j].z + v[j].w * v[j].w); }
    const float r = rsqrtf(wave_sum(s) * (1.f / D) + eps);
    float mx = 0.f;
#pragma unroll
    for (int j = 0; j < 16; ++j) { const f32x4 g = *(const f32x4*)(w + (j * 64 + lane) * 4); v[j] = v[j] * r * g; mx = fmaxf(mx, fmaxf(fmaxf(fabsf(v[j].x), fabsf(v[j].y)), fmaxf(fabsf(v[j].z), fabsf(v[j].w))));
        if (DUAL) { u32x2 o; o.x = pk2(v[j].x, v[j].y); o.y = pk2(v[j].z, v[j].w); *(u32x2*)(dstb + (j * 64 + lane) * 4) = o; } }
    mx = wave_max(mx);
    const float inv = mx > 0.f ? 127.f / mx : 0.f;
#pragma unroll
    for (int j = 0; j < 16; ++j) { const unsigned q = ((unsigned)(int)rintf(v[j].x * inv) & 0xffu) | (((unsigned)(int)rintf(v[j].y * inv) & 0xffu) << 8) | (((unsigned)(int)rintf(v[j].z * inv) & 0xffu) << 16) | (((unsigned)(int)rintf(v[j].w * inv) & 0xffu) << 24);
        *(unsigned*)(dst + (j * 64 + lane) * 4) = q; }
    if (lane == 0) *sa = mx > 0.f ? mx * (1.f / 127.f) : 1.f;
}
__device__ __forceinline__ void rms_row_bf16(const float* src, const float* w, bf16_t* dst, int lane, float eps) {
    if (src == nullptr) {
#pragma unroll
        for (int j = 0; j < 8; ++j) *(u32x4*)(dst + (j * 64 + lane) * 8) = (u32x4){0u, 0u, 0u, 0u};
        return;
    }
    f32x4 v[16]; float s = 0.f;
#pragma unroll
    for (int j = 0; j < 16; ++j) { v[j] = *(const f32x4*)(src + (j * 64 + lane) * 4); s += (v[j].x * v[j].x + v[j].y * v[j].y) + (v[j].z * v[j].z + v[j].w * v[j].w); }
    const float r = rsqrtf(wave_sum(s) * (1.f / D) + eps);
#pragma unroll
    for (int j = 0; j < 16; ++j) { const f32x4 g = *(const f32x4*)(w + (j * 64 + lane) * 4);
        u32x2 o; o.x = pk2(v[j].x * r * g.x, v[j].y * r * g.y); o.y = pk2(v[j].z * r * g.z, v[j].w * r * g.w);
        *(u32x2*)(dst + (j * 64 + lane) * 4) = o; }
}
__device__ __forceinline__ void p0_prologue_a(const P& p, LAS unsigned char* lds, int G) {
    const int tid = threadIdx.x, lane = tid & 63, wave = tid >> 6;
    LAS float* scr = (LAS float*)(lds + wave * 16384);
    const int gw = blockIdx.x * NWAVES + wave, NGW = G * NWAVES;
    unsigned char* ws = p.ws;
    {
        constexpr int C0 = 64 * ((IN_COLS + 511) / 512), C1 = 64 * (8192 / 512), C2 = 64 * (NFI / 512);
        for (int it = blockIdx.x; it < C0 + C1 + C2; it += G) {
            if (it < C0) colmax_item(p.in[I_WIN], IN_COLS, (unsigned*)(ws + WS_CTL + CT_CMX_IN), it);
            else if (it < C0 + C1) colmax_item(p.in[I_WGATE], 8192, (unsigned*)(ws + WS_CTL + CT_CMX_G), it - C0);
            else colmax_item(p.in[I_WFI], NFI, (unsigned*)(ws + WS_CTL + CT_CMX_F), it - C0 - C1);
        } }
    for (int it = gw; it < 16 * 32; it += NGW) { const int hh = it >> 5;
        tr_item<0>(p.in[I_WUV] + (size_t)hh * KVR * HD_B, KVR, HD_B, HD_B, (bf16_t*)(ws + WS_WUVT) + (size_t)hh * HD_B * KVR, scr, it & 31, lane); }
    for (size_t i = (size_t)blockIdx.x * NT + threadIdx.x; i < (size_t)16 * 512 * 128 / 4; i += (size_t)G * NT) {
        const f32x4 v = *(const f32x4*)(p.in[I_WUK] + i * 4); u32x2 o; o.x = pk2(v.x, v.y); o.y = pk2(v.z, v.w); *(u32x2*)((bf16_t*)(ws + WS_WUKB) + i * 4) = o; }
    for (int i = blockIdx.x * NT + threadIdx.x; i < 448 * 2048; i += G * NT) { const int j = i >> 11, c = i & 2047;
        const float v = j < 96 ? p.in[I_W2][(size_t)j * 2048 + c] : (j < 192 ? p.in[I_A2][(size_t)(j - 96) * 2048 + c] : p.in[I_G2][(size_t)(j - 192) * 2048 + c]);
        ((bf16_t*)(ws + WS_WLT))[(size_t)c * 448 + j] = f2bf(v); }
    signed char* U8 = (signed char*)(ws + WS_U); float* SA = (float*)(ws + WS_CTL + CT_SA);
    for (int m = gw; m < MP; m += NGW) {
        const float* src = m < NMETA ? p.in[I_META] + (size_t)m * D : (m < L ? p.in[I_X] + (size_t)(m - NMETA) * D : nullptr);
        rms_row_i8<true>(src, p.in[I_NMW], U8 + (size_t)m * D, SA + m, lane, 1e-6f, (bf16_t*)(ws + WS_R1) + (size_t)m * D);
    }
}
__device__ __forceinline__ void p0_prologue_b(const P& p, LAS unsigned char* lds, int G) {
    const int lane = threadIdx.x & 63, wave = threadIdx.x >> 6;
    LAS float* scr = (LAS float*)(lds + wave * 16384);
    const int gw = blockIdx.x * NWAVES + wave, NGW = G * NWAVES;
    constexpr int I0 = (4096 / 64) * (NZ / 32);
    for (int it = gw; it < I0; it += NGW) {
        const int nb = it % (NZ / 32);
        if (nb * 32 < NZ8) tr_item_i8<0>(p.in[I_WIN], 4096, IN_COLS, NZ, (signed char*)(p.ws + WS_WINT), (const unsigned*)(p.ws + WS_CTL + CT_CMX_IN), (float*)(p.ws + WS_CTL + CT_SB_IN), scr, it, lane);
        else tr_item<0>(p.in[I_WIN], 4096, IN_COLS, NZ, (bf16_t*)(p.ws + WS_WINT + WINT_BF_OFF) - (size_t)NZ8 * 4096, scr, it, lane);
    }
}
__device__ __forceinline__ void p0b_weights(const P& p, LAS unsigned char* lds, int vw, int nvw) {
    const int lane = threadIdx.x & 63, wave = threadIdx.x >> 6;
    LAS float* scr = (LAS float*)(lds + wave * 16384);
    unsigned char* ws = p.ws;
    constexpr int I1 = (4096 / 64) * (8192 / 32), I2 = (2048 / 64) * (4096 / 32), I3 = I2, I4 = (4096 / 64) * (4096 / 32), I5 = (4096 / 64) * (NFI / 32), I6 = (DFF / 64) * (4096 / 32);
    constexpr int NITEMS = I1 + I2 + I3 + I4 + I5 + I6;
    for (int it = vw; it < NITEMS; it += nvw) {
        int r = it;
        if (r < I1) { tr_item_i8<0>(p.in[I_WGATE], 4096, 8192, 8192, (signed char*)(ws + WS_WGT), (const unsigned*)(ws + WS_CTL + CT_CMX_G), (float*)(ws + WS_CTL + CT_SB_G), scr, r, lane); continue; } r -= I1;
        if (r < I2) { tr_item<0>(p.in[I_WPA], 2048, 4096, 4096, (bf16_t*)(ws + WS_WPAT), scr, r, lane); continue; } r -= I2;
        if (r < I3) { tr_item<0>(p.in[I_WPB], 2048, 4096, 4096, (bf16_t*)(ws + WS_WPBT), scr, r, lane); continue; } r -= I3;
        if (r < I4) { tr_item<0>(p.in[I_WOUT], 4096, 4096, 4096, (bf16_t*)(ws + WS_WOUTT), scr, r, lane); continue; } r -= I4;
        if (r < I5) { tr_item_i8<1>(p.in[I_WFI], 4096, NFI, NFI, (signed char*)(ws + WS_WFIT), (const unsigned*)(ws + WS_CTL + CT_CMX_F), (float*)(ws + WS_CTL + CT_SB_F), scr, r, lane); continue; } r -= I5;
        tr_item<0>(p.in[I_WFO], DFF, 4096, 4096, (bf16_t*)(ws + WS_WFOT), scr, r, lane);
    }
}

typedef short bf16x8p_t __attribute__((ext_vector_type(8)));
template <int CTRL> __device__ __forceinline__ float dpp_shr0(float v) { return __builtin_bit_cast(float, __builtin_amdgcn_update_dpp(0, __builtin_bit_cast(int, v), CTRL, 0xf, 0xf, true)); }
__device__ __forceinline__ void p2_rwkv_prep(const P& p, LAS unsigned char* lds, int G) {
    const int tid = threadIdx.x, lane = tid & 63, wave = __builtin_amdgcn_readfirstlane(tid >> 6), r16 = lane & 15, q = lane >> 4;
    const bf16_t* Z = (const bf16_t*)(p.ws + WS_Z); const bf16_t* WLT = (const bf16_t*)(p.ws + WS_WLT);
    float* CSo = (float*)(p.ws + WS_LD); bf16_t* AAo = (bf16_t*)(p.ws + WS_AA); bf16_t* GGo = (bf16_t*)(p.ws + WS_GG);
    constexpr int AST = 456;
    LAS bf16_t* act = (LAS bf16_t*)lds;
    const float* mu = p.in[I_MU] + 6144;
    for (int item = blockIdx.x; item < 256; item += G) {
        const int ct = item & 15, tr = item >> 4;
        const int ch = ct * 128 + wave * 16 + r16;
        bf16x8p_t af[14];
#pragma unroll
        for (int ks = 0; ks < 14; ++ks) af[ks] = *(const bf16x8p_t*)(WLT + (size_t)ch * 448 + ks * 32 + q * 8);
        const int c4 = ct * 128 + wave * 16 + q * 4;
        const f32x4 w0v = *(const f32x4*)(p.in[I_W0] + c4), a0v = *(const f32x4*)(p.in[I_A0] + c4);
        const int st0 = tr * 16, st1 = tr == 15 ? 257 : st0 + 16;
        for (int st = st0; st < st1; ++st) {
            const int t0 = st * 64;
            __syncthreads();
            {
                u32x4 za[7], zp[7];
#pragma unroll
                for (int k = 0; k < 7; ++k) { const int cidx = tid + k * NT, t = cidx / 56, j8 = (cidx % 56) * 8; int tg = t0 + t; if (tg > L - 1) tg = L - 1; const int tp = tg > 0 ? tg - 1 : 0;
                    za[k] = *(const u32x4*)(Z + (size_t)tg * NZ + 6144 + j8); zp[k] = *(const u32x4*)(Z + (size_t)tp * NZ + 6144 + j8); }
#pragma unroll
                for (int k = 0; k < 7; ++k) { const int cidx = tid + k * NT, t = cidx / 56, j8 = (cidx % 56) * 8, tg = t0 + t;
                    u32x4 o = (u32x4){0u, 0u, 0u, 0u};
                    if (tg < L) {
                        const f32x4 m0 = *(const f32x4*)(mu + j8), m1 = *(const f32x4*)(mu + j8 + 4);
                        const float a[8] = {blo(za[k].x), bhi(za[k].x), blo(za[k].y), bhi(za[k].y), blo(za[k].z), bhi(za[k].z), blo(za[k].w), bhi(za[k].w)};
                        float b[8] = {blo(zp[k].x), bhi(zp[k].x), blo(zp[k].y), bhi(zp[k].y), blo(zp[k].z), bhi(zp[k].z), blo(zp[k].w), bhi(zp[k].w)};
                        if (tg == 0) {
#pragma unroll
                            for (int e = 0; e < 8; ++e) b[e] = 0.f; }
                        const float m[8] = {m0.x, m0.y, m0.z, m0.w, m1.x, m1.y, m1.z, m1.w};
                        float v[8];
#pragma unroll
                        for (int e = 0; e < 8; ++e) { const float zs = a[e] + (b[e] - a[e]) * m[e]; const bool ist = j8 < 96, isi = j8 < 192;
                            const float r = __builtin_amdgcn_rcpf(1.f + __expf(ist ? 2.f * zs : -zs)); v[e] = ist ? 1.f - 2.f * r : (isi ? zs : r); }
                        o.x = pk2(v[0], v[1]); o.y = pk2(v[2], v[3]); o.z = pk2(v[4], v[5]); o.w = pk2(v[6], v[7]);
                    }
                    *(LAS u32x4*)(act + t * AST + j8) = o; }
            }
            __syncthreads();
#pragma unroll 1
            for (int nt = 0; nt < 4; ++nt) {
                f32x4 cw = {0.f, 0.f, 0.f, 0.f}, ca = cw, cg = cw;
                const LAS bf16_t* ar = act + (nt * 16 + r16) * AST + q * 8;
#pragma unroll
                for (int ks = 0; ks < 3; ++ks) cw = __builtin_amdgcn_mfma_f32_16x16x32_bf16(af[ks], *(const LAS bf16x8p_t*)(ar + ks * 32), cw, 0, 0, 0);
#pragma unroll
                for (int ks = 3; ks < 6; ++ks) ca = __builtin_amdgcn_mfma_f32_16x16x32_bf16(af[ks], *(const LAS bf16x8p_t*)(ar + ks * 32), ca, 0, 0, 0);
#pragma unroll
                for (int ks = 6; ks < 14; ++ks) cg = __builtin_amdgcn_mfma_f32_16x16x32_bf16(af[ks], *(const LAS bf16x8p_t*)(ar + ks * 32), cg, 0, 0, 0);
                f32x4 ld;
#pragma unroll
                for (int e = 0; e < 4; ++e) { const float xx = -(w0v[e] + cw[e]); const float sp = xx > 20.f ? xx : __logf(1.f + __expf(xx)); ld[e] = -__expf(-sp - 0.5f); }
#pragma unroll
                for (int e = 0; e < 4; ++e) { float x = ld[e]; x += dpp_shr0<0x111>(x); x += dpp_shr0<0x112>(x); x += dpp_shr0<0x114>(x); x += dpp_shr0<0x118>(x); ld[e] = x; }
                const int tg = t0 + nt * 16 + r16;
                if (tg < L) {
                    *(f32x4*)(CSo + (size_t)tg * A_W + c4) = ld;
                    u32x2 oa, og; oa.x = pk2(sigm(a0v[0] + ca[0]), sigm(a0v[1] + ca[1])); oa.y = pk2(sigm(a0v[2] + ca[2]), sigm(a0v[3] + ca[3]));
                    og.x = pk2(cg[0], cg[1]); og.y = pk2(cg[2], cg[3]);
                    *(u32x2*)(AAo + (size_t)tg * A_W + c4) = oa; *(u32x2*)(GGo + (size_t)tg * A_W + c4) = og;
                }
            }
        }
    }
}


typedef short bf16x8_t __attribute__((ext_vector_type(8)));
constexpr int NCHUNK = 257, NITEM = NCHUNK * 32, RS = 72, SLOT = 64 * RS * 2;
constexpr int GAM_OFF = 15 * SLOT;
constexpr size_t GTP_OFF = 0, HT_OFF = (size_t)8192 * 8192;
typedef __bf16 bf16x2v_t __attribute__((ext_vector_type(2)));
typedef float f32x2v_t __attribute__((ext_vector_type(2)));
__device__ __forceinline__ unsigned cvtpk(float lo, float hi) { const f32x2v_t v = {lo, hi}; const bf16x2v_t b = __builtin_convertvector(v, bf16x2v_t); return __builtin_bit_cast(unsigned, b); }
__device__ __forceinline__ void mm2(const LAS bf16_t* X, const LAS bf16_t* Y, int tm, int tn0, int r, int q, f32x4& c0, f32x4& c1) {
#pragma unroll
    for (int s = 0; s < 2; ++s) {
        const bf16x8_t a = *(const LAS bf16x8_t*)(X + (tm * 16 + r) * RS + s * 32 + q * 8);
        const bf16x8_t b0 = *(const LAS bf16x8_t*)(Y + (tn0 * 16 + r) * RS + s * 32 + q * 8);
        const bf16x8_t b1 = *(const LAS bf16x8_t*)(Y + ((tn0 + 1) * 16 + r) * RS + s * 32 + q * 8);
        c0 = __builtin_amdgcn_mfma_f32_16x16x32_bf16(a, b0, c0, 0, 0, 0);
        c1 = __builtin_amdgcn_mfma_f32_16x16x32_bf16(a, b1, c1, 0, 0, 0);
    }
}
__device__ __forceinline__ void st_cheap(LAS bf16_t* B, int m0, int n, const f32x4& c) {
    u32x2 w; w.x = cvtpk(c[0], c[1]); w.y = cvtpk(c[2], c[3]); *(LAS u32x2*)(B + n * RS + m0) = w;
}
__device__ __forceinline__ void st_scat(LAS bf16_t* B, int m0, int n, const f32x4& c) {
#pragma unroll
    for (int e = 0; e < 4; ++e) B[(m0 + e) * RS + n] = f2bf(c[e]);
}
template <int CTRL> __device__ __forceinline__ float dpp_add(float v) { return v + dpp_f<CTRL>(v); }
__device__ __forceinline__ float sum8(float v) { v = dpp_add<0xB1>(v); v = dpp_add<0x4E>(v); v = dpp_add<0x141>(v); return v; }

struct RaIn { u32x4 r0, k0, v0, r1, k1, v1, a0; f32x4 c0v, c1v, p0, p1, ba[3], bb[3]; };
__device__ __forceinline__ void ra_load(RaIn& I, const bf16_t* Z, const float* CS, const bf16_t* AAi, int ch, int h, int tid) {
    const int t = tid >> 3, k8 = (tid & 7) * 8, c0 = h * 64 + k8; int tg = ch * 64 + t; if (tg > L - 1) tg = L - 1; const int tp = tg > 0 ? tg - 1 : 0;
    const bf16_t* zr = Z + (size_t)tg * NZ + c0; const bf16_t* zp = Z + (size_t)tp * NZ + c0;
    I.r0 = *(const u32x4*)zr; I.k0 = *(const u32x4*)(zr + 2048); I.v0 = *(const u32x4*)(zr + 4096);
    I.r1 = *(const u32x4*)zp; I.k1 = *(const u32x4*)(zp + 2048); I.v1 = *(const u32x4*)(zp + 4096);
    I.a0 = *(const u32x4*)(AAi + (size_t)tg * A_W + c0);
    const float* cs = CS + (size_t)tg * A_W + c0; const float* cp = CS + (size_t)tp * A_W + c0;
    I.c0v = *(const f32x4*)cs; I.c1v = *(const f32x4*)(cs + 4); I.p0 = *(const f32x4*)cp; I.p1 = *(const f32x4*)(cp + 4);
#pragma unroll
    for (int b = 0; b < 3; ++b) { int rb = ch * 64 + b * 16 + 15; if (rb > L - 1) rb = L - 1; const float* ce = CS + (size_t)rb * A_W + c0; I.ba[b] = *(const f32x4*)ce; I.bb[b] = *(const f32x4*)(ce + 4); }
}
#define LDS_BARRIER() do { asm volatile("s_waitcnt lgkmcnt(0)" ::: "memory"); __builtin_amdgcn_s_barrier(); asm volatile("" ::: "memory"); } while (0)
__device__ __forceinline__ void ra_items(const P& p, LAS unsigned char* lds, int G) {
    const int tid = threadIdx.x, lane = tid & 63, wave = __builtin_amdgcn_readfirstlane(tid >> 6), r16 = lane & 15, q = lane >> 4;
    const int tm = wave >> 1, tn0 = (wave & 1) * 2;
    const bf16_t* Z = (const bf16_t*)(p.ws + WS_Z); const float* CS = (const float*)(p.ws + WS_LD); const bf16_t* AAi = (const bf16_t*)(p.ws + WS_AA);
    bf16_t* GTP = (bf16_t*)((unsigned char*)p.out + GTP_OFF); float* HT = (float*)((unsigned char*)p.out + HT_OFF);
    bf16_t* PPo = (bf16_t*)(p.ws + WS_YB); bf16_t* Y0o = (bf16_t*)(p.ws + WS_YA); float* BS = (float*)(p.ws + WS_BS);
    LAS bf16_t* sl[15];
#pragma unroll
    for (int i = 0; i < 15; ++i) sl[i] = (LAS bf16_t*)(lds + i * SLOT);
    LAS float* gam = (LAS float*)(lds + GAM_OFF);
    LAS bf16_t *Al_r = sl[0], *Be_r = sl[1], *Ka_r = sl[2], *Al_t = sl[3], *Be_t = sl[4], *Ka_t = sl[5], *Rh_r = sl[6], *V_t = sl[7];
    LAS bf16_t *N_r = sl[8], *N_t = sl[9], *LAK = sl[10], *MRK = sl[11], *MRB = sl[12], *Q_t = sl[13], *T_a = sl[14], *T_b = sl[0], *Q_r = sl[1];
    LAS bf16_t *W_t = sl[8], *X1_t = sl[9], *U0_t = sl[1];
    const bool fixed_h = (G & 31) == 0;
    const int nit = fixed_h ? (NCHUNK - (int)(blockIdx.x >> 5) + (G >> 5) - 1) / (G >> 5) : (NITEM - (int)blockIdx.x + G - 1) / G;
    auto item_of = [&](int i, int& ch, int& h) { if (fixed_h) { h = blockIdx.x & 31; ch = (int)(blockIdx.x >> 5) + i * (G >> 5); } else { const int it = (int)blockIdx.x + i * G; ch = it >> 5; h = it & 31; } };
    float pmr[8], pmk[8], pmv[8], pkk[8], pka[8], prk[8]; int h_par = -1;
    RaIn I; { int ch0, h0; item_of(0, ch0, h0); if (nit > 0) ra_load(I, Z, CS, AAi, ch0, h0, tid); }
    for (int ii = 0; ii < nit; ++ii) {
        int ch, h; item_of(ii, ch, h); const int item = ch * 32 + h;
        if (h != h_par) { const int c0 = h * 64 + (tid & 7) * 8;
#pragma unroll
            for (int e = 0; e < 8; ++e) { pmr[e] = p.in[I_MU][c0 + e]; pmk[e] = p.in[I_MU][2048 + c0 + e]; pmv[e] = p.in[I_MU][4096 + c0 + e]; pkk[e] = p.in[I_KK][c0 + e]; pka[e] = p.in[I_KA][c0 + e]; prk[e] = p.in[I_RK][c0 + e]; }
            h_par = h; }
        LDS_BARRIER();
        {
            const int t = tid >> 3, k8 = (tid & 7) * 8, tg = ch * 64 + t;
            float Av[8], Bv[8], Kv[8], Rv[8], Vv[8];
            const bool valid = tg < L, hasp = tg > 0;
            {
                float lc[8], lx[8];
                {   float base[8];
#pragma unroll
                    for (int e = 0; e < 8; ++e) base[e] = 0.f;
#pragma unroll
                    for (int b = 0; b < 3; ++b) if (b < (t >> 4)) {
#pragma unroll
                        for (int e = 0; e < 4; ++e) { base[e] += I.ba[b][e]; base[4 + e] += I.bb[b][e]; } }
                    const bool pin = (t & 15) != 0;
#pragma unroll
                    for (int e = 0; e < 4; ++e) { lc[e] = base[e] + I.c0v[e]; lc[4 + e] = base[4 + e] + I.c1v[e]; lx[e] = base[e] + (pin ? I.p0[e] : 0.f); lx[4 + e] = base[4 + e] + (pin ? I.p1[e] : 0.f); }
                }
                const unsigned rw[4] = {I.r0.x, I.r0.y, I.r0.z, I.r0.w}, kw[4] = {I.k0.x, I.k0.y, I.k0.z, I.k0.w}, vw[4] = {I.v0.x, I.v0.y, I.v0.z, I.v0.w};
                const unsigned rp[4] = {I.r1.x, I.r1.y, I.r1.z, I.r1.w}, kq[4] = {I.k1.x, I.k1.y, I.k1.z, I.k1.w}, vq[4] = {I.v1.x, I.v1.y, I.v1.z, I.v1.w}, aw[4] = {I.a0.x, I.a0.y, I.a0.z, I.a0.w};
                float rr[8], kk[8], kp[8], aa[8]; float ss = 0.f, bs = 0.f;
#pragma unroll
                for (int e = 0; e < 8; ++e) {
                    const int wi = e >> 1; const bool hi = e & 1;
                    const float zr_ = hi ? bhi(rw[wi]) : blo(rw[wi]), zk_ = hi ? bhi(kw[wi]) : blo(kw[wi]), zv_ = hi ? bhi(vw[wi]) : blo(vw[wi]);
                    float pr_ = hi ? bhi(rp[wi]) : blo(rp[wi]), pk_ = hi ? bhi(kq[wi]) : blo(kq[wi]), pv_ = hi ? bhi(vq[wi]) : blo(vq[wi]);
                    if (!hasp) { pr_ = 0.f; pk_ = 0.f; pv_ = 0.f; }
                    aa[e] = hi ? bhi(aw[wi]) : blo(aw[wi]);
                    rr[e] = zr_ + (pr_ - zr_) * pmr[e]; const float k_ = zk_ + (pk_ - zk_) * pmk[e]; Vv[e] = zv_ + (pv_ - zv_) * pmv[e];
                    kk[e] = k_ * pkk[e]; ss += kk[e] * kk[e];
                    kp[e] = k_ * (1.f + (aa[e] - 1.f) * pka[e]);
                    bs += rr[e] * kp[e] * prk[e];
                }
                ss = sum8(ss); bs = sum8(bs);
                const float rn = rsqrtf(ss + 1e-12f);
                if (valid && (tid & 7) == 0) BS[(size_t)tg * 32 + h] = bs;
#pragma unroll
                for (int e = 0; e < 8; ++e) {
                    const float kn = kk[e] * rn; const float ex = __expf(lx[e]), em = __expf(-lc[e]), ep = __expf(lc[e]);
                    Av[e] = kn * ex; Bv[e] = kn * aa[e] * em; Kv[e] = kp[e] * em; Rv[e] = rr[e] * ep;
                }
                if (t == 63) {
#pragma unroll
                    for (int e = 0; e < 8; ++e) gam[k8 + e] = __expf(valid ? lc[e] : (e < 4 ? I.c0v[e] : I.c1v[e - 4]));
                }
                if (!valid) {
#pragma unroll
                    for (int e = 0; e < 8; ++e) { Av[e] = 0.f; Bv[e] = 0.f; Kv[e] = 0.f; Rv[e] = 0.f; Vv[e] = 0.f; }
                }
            }
            u32x4 w;
            w.x = cvtpk(Av[0], Av[1]); w.y = cvtpk(Av[2], Av[3]); w.z = cvtpk(Av[4], Av[5]); w.w = cvtpk(Av[6], Av[7]); *(LAS u32x4*)(Al_r + t * RS + k8) = w;
            w.x = cvtpk(Bv[0], Bv[1]); w.y = cvtpk(Bv[2], Bv[3]); w.z = cvtpk(Bv[4], Bv[5]); w.w = cvtpk(Bv[6], Bv[7]); *(LAS u32x4*)(Be_r + t * RS + k8) = w;
            w.x = cvtpk(Kv[0], Kv[1]); w.y = cvtpk(Kv[2], Kv[3]); w.z = cvtpk(Kv[4], Kv[5]); w.w = cvtpk(Kv[6], Kv[7]); *(LAS u32x4*)(Ka_r + t * RS + k8) = w;
            w.x = cvtpk(Rv[0], Rv[1]); w.y = cvtpk(Rv[2], Rv[3]); w.z = cvtpk(Rv[4], Rv[5]); w.w = cvtpk(Rv[6], Rv[7]); *(LAS u32x4*)(Rh_r + t * RS + k8) = w;
#pragma unroll
            for (int e = 0; e < 8; ++e) { Al_t[(k8 + e) * RS + t] = f2bf(Av[e]); Be_t[(k8 + e) * RS + t] = f2bf(Bv[e]); Ka_t[(k8 + e) * RS + t] = f2bf(Kv[e]); V_t[(k8 + e) * RS + t] = f2bf(Vv[e]); }
        }
        if (ii + 1 < nit) { int ch1, h1; item_of(ii + 1, ch1, h1); ra_load(I, Z, CS, AAi, ch1, h1, tid); }
        LDS_BARRIER();
        {
            f32x4 cab0 = {0.f, 0.f, 0.f, 0.f}, cab1 = cab0, cak0 = cab0, cak1 = cab0, crk0 = cab0, crk1 = cab0, crb0 = cab0, crb1 = cab0;
            mm2(Be_r, Al_r, tm, tn0, r16, q, cab0, cab1); mm2(Ka_r, Al_r, tm, tn0, r16, q, cak0, cak1);
            mm2(Ka_r, Rh_r, tm, tn0, r16, q, crk0, crk1); mm2(Be_r, Rh_r, tm, tn0, r16, q, crb0, crb1);
            const int s0 = tm * 16 + q * 4;
#pragma unroll
            for (int j = 0; j < 2; ++j) {
                const int t = (tn0 + j) * 16 + r16;
                f32x4 ab = j ? cab1 : cab0, ak = j ? cak1 : cak0, rk = j ? crk1 : crk0, rb = j ? crb1 : crb0, nn, t0;
#pragma unroll
                for (int e = 0; e < 4; ++e) { const int s = s0 + e; nn[e] = s < t ? -ab[e] : 0.f; t0[e] = nn[e] + (s == t ? 1.f : 0.f); ak[e] = s < t ? ak[e] : 0.f; rk[e] = s <= t ? rk[e] : 0.f; rb[e] = s <= t ? rb[e] : 0.f; }
                st_cheap(N_r, s0, t, nn); st_scat(N_t, s0, t, nn); st_cheap(T_a, s0, t, t0); st_cheap(LAK, s0, t, ak); st_cheap(MRK, s0, t, rk); st_cheap(MRB, s0, t, rb);
            }
        }
        LDS_BARRIER();
        {
            LAS bf16_t* Pr = N_r; LAS bf16_t* Pt = N_t; LAS bf16_t* Qr = Q_r; LAS bf16_t* Qt = Q_t; LAS bf16_t* Tc = T_a; LAS bf16_t* Tn = T_b;
#pragma unroll 1
            for (int it = 0; it < 5; ++it) {
                {   f32x4 c0 = {0.f, 0.f, 0.f, 0.f}, c1 = c0;
                    mm2(Pr, Pt, tm, tn0, r16, q, c0, c1);
                    const int m0 = tm * 16 + q * 4;
                    st_cheap(Qt, m0, tn0 * 16 + r16, c0); st_cheap(Qt, m0, (tn0 + 1) * 16 + r16, c1);
                    st_scat(Qr, m0, tn0 * 16 + r16, c0); st_scat(Qr, m0, (tn0 + 1) * 16 + r16, c1); }
                LDS_BARRIER();
                {   f32x4 c0 = {0.f, 0.f, 0.f, 0.f}, c1 = c0;
                    mm2(Qt, Tc, tm, tn0, r16, q, c0, c1);
                    const int b0 = tm * 16 + q * 4;
#pragma unroll
                    for (int j = 0; j < 2; ++j) { const int a = (tn0 + j) * 16 + r16; const u32x2 o = *(const LAS u32x2*)(Tc + a * RS + b0); f32x4 c = j ? c1 : c0;
                        c[0] += blo(o.x); c[1] += bhi(o.x); c[2] += blo(o.y); c[3] += bhi(o.y); st_cheap(Tn, b0, a, c); } }
                LDS_BARRIER();
                LAS bf16_t* x = Pr; Pr = Qr; Qr = x; x = Pt; Pt = Qt; Qt = x; x = Tc; Tc = Tn; Tn = x;
            }
        }
        {
            f32x4 c0 = {0.f, 0.f, 0.f, 0.f}, c1 = c0, d0 = c0, d1 = c0;
            mm2(T_b, Al_t, tm, tn0, r16, q, c0, c1);
            mm2(LAK, V_t, tm, tn0, r16, q, d0, d1);
            const int t0 = tm * 16 + q * 4;
            st_cheap(W_t, t0, tn0 * 16 + r16, c0); st_cheap(W_t, t0, (tn0 + 1) * 16 + r16, c1);
            st_cheap(X1_t, t0, tn0 * 16 + r16, d0); st_cheap(X1_t, t0, (tn0 + 1) * 16 + r16, d1);
        }
        LDS_BARRIER();
        {
            f32x4 c0 = {0.f, 0.f, 0.f, 0.f}, c1 = c0;
            mm2(T_b, X1_t, tm, tn0, r16, q, c0, c1);
            const int t0 = tm * 16 + q * 4;
            st_cheap(U0_t, t0, tn0 * 16 + r16, c0); st_cheap(U0_t, t0, (tn0 + 1) * 16 + r16, c1);
        }
        LDS_BARRIER();
        {
            const int m0 = tm * 16 + q * 4;
            if (ch < 256) {
                f32x4 g0 = {0.f, 0.f, 0.f, 0.f}, g1 = g0, h0 = g0, h1 = g0, u0 = g0, u1 = g0;
                mm2(W_t, Be_t, tm, tn0, r16, q, g0, g1);
                mm2(Ka_t, V_t, tm, tn0, r16, q, h0, h1);
                mm2(Be_t, U0_t, tm, tn0, r16, q, u0, u1);
                const size_t it8 = (size_t)item;
#pragma unroll
                for (int j = 0; j < 2; ++j) {
                    const int n = (tn0 + j) * 16 + r16; const f32x4 g = j ? g1 : g0; const float gc = gam[n];
                    f32x4 o;
#pragma unroll
                    for (int e = 0; e < 4; ++e) o[e] = ((m0 + e == n ? 1.f : 0.f) - g[e]) * gc;
                    u32x2 w; w.x = cvtpk(o[0], o[1]); w.y = cvtpk(o[2], o[3]);
                    *(u32x2*)(GTP + it8 * 4096 + (size_t)n * 64 + 32 * (tm >> 1) + 8 * q + 4 * (tm & 1)) = w;
                    const f32x4 hh = (j ? h1 : h0) - (j ? u1 : u0);
                    const f32x4 gk = *(const LAS f32x4*)(gam + m0);
                    *(f32x4*)(HT + (it8 * 16 + tm * 4 + (tn0 + j)) * 256 + lane * 4) = hh * gk;
                }
            }
            f32x4 p0 = {0.f, 0.f, 0.f, 0.f}, p1 = p0, y0 = p0, y1 = p0, z0 = p0, z1 = p0;
            mm2(W_t, MRB, tm, tn0, r16, q, p0, p1);
            mm2(V_t, MRK, tm, tn0, r16, q, y0, y1);
            mm2(U0_t, MRB, tm, tn0, r16, q, z0, z1);
#pragma unroll
            for (int j = 0; j < 2; ++j) {
                const int t = (tn0 + j) * 16 + r16, tg = ch * 64 + t;
                const u32x2 o = *(const LAS u32x2*)(Rh_r + t * RS + m0); const f32x4 pm = j ? p1 : p0;
                u32x2 w; w.x = cvtpk(blo(o.x) - pm[0], bhi(o.x) - pm[1]); w.y = cvtpk(blo(o.y) - pm[2], bhi(o.y) - pm[3]);
                *(u32x2*)(PPo + (size_t)item * 4096 + t * 64 + m0) = w;
                if (tg < L) { const f32x4 yy = (j ? y1 : y0) - (j ? z1 : z0); u32x2 wy; wy.x = cvtpk(yy[0], yy[1]); wy.y = cvtpk(yy[2], yy[3]);
                    *(u32x2*)(Y0o + (size_t)tg * A_W + h * 64 + m0) = wy; }
            }
        }
    }
}

struct RbSet { bf16x8_t ga[4][2]; f32x4 hv[4]; };
__device__ __forceinline__ void rb_load(RbSet& S, const bf16_t* GTP, const float* HT, int c, int h, int vg, int lane, int r16, int q) {
    const size_t it8 = (size_t)(c < 256 ? c : 255) * 32 + h;
#pragma unroll
    for (int i = 0; i < 4; ++i) { S.hv[i] = *(const f32x4*)(HT + (it8 * 16 + i * 4 + vg) * 256 + lane * 4);
#pragma unroll
        for (int s = 0; s < 2; ++s) S.ga[i][s] = *(const bf16x8_t*)(GTP + it8 * 4096 + (size_t)(i * 16 + r16) * 64 + s * 32 + q * 8); }
}
__device__ __forceinline__ void rb_step(f32x4 (&acc)[4], const RbSet& S, bf16_t* ST, int c, int h, int vg, int r16, int q) {
    const size_t item = (size_t)c * 32 + h;
    unsigned w[8];
#pragma unroll
    for (int i = 0; i < 4; ++i) { w[2 * i] = cvtpk(acc[i][0], acc[i][1]); w[2 * i + 1] = cvtpk(acc[i][2], acc[i][3]);
        u32x2 o; o.x = w[2 * i]; o.y = w[2 * i + 1]; *(u32x2*)(ST + item * 4096 + (size_t)(vg * 16 + r16) * 64 + i * 16 + q * 4) = o; }
    const u32x4 b0 = (u32x4){w[0], w[1], w[2], w[3]}, b1 = (u32x4){w[4], w[5], w[6], w[7]};
    const bf16x8_t f0 = __builtin_bit_cast(bf16x8_t, b0), f1 = __builtin_bit_cast(bf16x8_t, b1);
#pragma unroll
    for (int i = 0; i < 4; ++i) { f32x4 a = S.hv[i];
        a = __builtin_amdgcn_mfma_f32_16x16x32_bf16(S.ga[i][0], f0, a, 0, 0, 0);
        a = __builtin_amdgcn_mfma_f32_16x16x32_bf16(S.ga[i][1], f1, a, 0, 0, 0);
        acc[i] = a; }
}
__device__ __forceinline__ void rb_chain(const P& p, int G) {
    const int tid = threadIdx.x, lane = tid & 63, wave = __builtin_amdgcn_readfirstlane(tid >> 6), r16 = lane & 15, q = lane >> 4;
    if (wave == 0) for (int cw = blockIdx.x; cw < 128; cw += G) {
        const int h = cw >> 2, vg = cw & 3;
        const bf16_t* GTP = (const bf16_t*)((const unsigned char*)p.out + GTP_OFF); const float* HT = (const float*)((const unsigned char*)p.out + HT_OFF);
        bf16_t* ST = (bf16_t*)(p.ws + WS_ST);
        f32x4 acc[4];
#pragma unroll
        for (int i = 0; i < 4; ++i) acc[i] = (f32x4){0.f, 0.f, 0.f, 0.f};
        RbSet S0, S1, S2, S3;
        rb_load(S0, GTP, HT, 0, h, vg, lane, r16, q); rb_load(S1, GTP, HT, 1, h, vg, lane, r16, q); rb_load(S2, GTP, HT, 2, h, vg, lane, r16, q); rb_load(S3, GTP, HT, 3, h, vg, lane, r16, q);
#pragma unroll 1
        for (int c = 0; c < 256; c += 4) {
            rb_step(acc, S0, ST, c, h, vg, r16, q);     rb_load(S0, GTP, HT, c + 4, h, vg, lane, r16, q);
            rb_step(acc, S1, ST, c + 1, h, vg, r16, q); rb_load(S1, GTP, HT, c + 5, h, vg, lane, r16, q);
            rb_step(acc, S2, ST, c + 2, h, vg, r16, q); rb_load(S2, GTP, HT, c + 6, h, vg, lane, r16, q);
            rb_step(acc, S3, ST, c + 3, h, vg, r16, q); rb_load(S3, GTP, HT, c + 7, h, vg, lane, r16, q);
        }
        {
            const size_t item = (size_t)256 * 32 + h;
#pragma unroll
            for (int i = 0; i < 4; ++i) { u32x2 o; o.x = cvtpk(acc[i][0], acc[i][1]); o.y = cvtpk(acc[i][2], acc[i][3]); *(u32x2*)(ST + item * 4096 + (size_t)(vg * 16 + r16) * 64 + i * 16 + q * 4) = o; }
        }
    }
}

__device__ __forceinline__ void rc_out(const P& p, int G) {
    const int tid = threadIdx.x, lane = tid & 63, wave = __builtin_amdgcn_readfirstlane(tid >> 6), r16 = lane & 15, q = lane >> 4;
    const bf16_t* Z = (const bf16_t*)(p.ws + WS_Z); const bf16_t* GGi = (const bf16_t*)(p.ws + WS_GG); const float* BS = (const float*)(p.ws + WS_BS);
    const bf16_t* ST = (const bf16_t*)(p.ws + WS_ST); const bf16_t* PPi = (const bf16_t*)(p.ws + WS_YB); bf16_t* YA = (bf16_t*)(p.ws + WS_YA);
    for (size_t i = (size_t)blockIdx.x * NT + tid; i < (size_t)(MP - L) * A_W / 8; i += (size_t)G * NT) *(u32x4*)(YA + (size_t)L * A_W + i * 8) = (u32x4){0u, 0u, 0u, 0u};
    const int tt = wave & 3;
    for (int item = blockIdx.x * 2 + (wave >> 2); item < NITEM; item += 2 * G) {
        const int ch = item >> 5, h = item & 31;
        const int t = tt * 16 + r16, tg = ch * 64 + t;
        f32x4 acc[4];
#pragma unroll
        for (int i = 0; i < 4; ++i) acc[i] = (f32x4){0.f, 0.f, 0.f, 0.f};
        const bf16_t* sp = ST + (size_t)item * 4096; const bf16_t* pp = PPi + (size_t)item * 4096 + (size_t)t * 64;
#pragma unroll
        for (int s = 0; s < 2; ++s) {
            const bf16x8_t b = *(const bf16x8_t*)(pp + s * 32 + q * 8);
#pragma unroll
            for (int i = 0; i < 4; ++i) { const bf16x8_t a = *(const bf16x8_t*)(sp + (size_t)(i * 16 + r16) * 64 + s * 32 + q * 8);
                acc[i] = __builtin_amdgcn_mfma_f32_16x16x32_bf16(a, b, acc[i], 0, 0, 0); }
        }
        if (tg < L) {
            float s1 = 0.f;
#pragma unroll
            for (int i = 0; i < 4; ++i) { const u32x2 y0 = *(const u32x2*)(YA + (size_t)tg * A_W + h * 64 + i * 16 + q * 4);
                acc[i][0] += blo(y0.x); acc[i][1] += bhi(y0.x); acc[i][2] += blo(y0.y); acc[i][3] += bhi(y0.y);
                s1 += (acc[i][0] + acc[i][1]) + (acc[i][2] + acc[i][3]); }
            s1 += __shfl_xor(s1, 16); s1 += __shfl_xor(s1, 32);
            const float mean = s1 * (1.f / 64.f);
            float s2 = 0.f;
#pragma unroll
            for (int i = 0; i < 4; ++i)
#pragma unroll
                for (int e = 0; e < 4; ++e) { const float d = acc[i][e] - mean; s2 += d * d; }
            s2 += __shfl_xor(s2, 16); s2 += __shfl_xor(s2, 32);
            const float rstd = rsqrtf(s2 * (1.f / 64.f) + 64e-5f);
            const float bs = BS[(size_t)tg * 32 + h];
#pragma unroll
            for (int i = 0; i < 4; ++i) {
                const int c = h * 64 + i * 16 + q * 4;
                const u32x2 zv = *(const u32x2*)(Z + (size_t)tg * NZ + 4096 + c);
                u32x2 pv = (u32x2){0u, 0u}; if (tg > 0) pv = *(const u32x2*)(Z + (size_t)(tg - 1) * NZ + 4096 + c);
                const u32x2 gg = *(const u32x2*)(GGi + (size_t)tg * A_W + c);
                const f32x4 lw = *(const f32x4*)(p.in[I_LNW] + c), lb = *(const f32x4*)(p.in[I_LNB] + c), mv = *(const f32x4*)(p.in[I_MU] + 4096 + c);
                const float zz[4] = {blo(zv.x), bhi(zv.x), blo(zv.y), bhi(zv.y)}, pz[4] = {blo(pv.x), bhi(pv.x), blo(pv.y), bhi(pv.y)}, gv[4] = {blo(gg.x), bhi(gg.x), blo(gg.y), bhi(gg.y)};
                float o[4];
#pragma unroll
                for (int e = 0; e < 4; ++e) { const float vv = zz[e] + (pz[e] - zz[e]) * mv[e]; const float yn = (acc[i][e] - mean) * rstd * lw[e] + lb[e]; o[e] = (yn + bs * vv) * gv[e]; }
                u32x2 w; w.x = cvtpk(o[0], o[1]); w.y = cvtpk(o[2], o[3]);
                *(u32x2*)(YA + (size_t)tg * A_W + c) = w;
            }
        }
    }
}


__device__ __forceinline__ void p4_dsa_prep(const P& p, int G) {
    const int tid = threadIdx.x, lane = tid & 63, wave = tid >> 6;
    const bf16_t* Z = (const bf16_t*)(p.ws + WS_Z);
    bf16_t* CKV = (bf16_t*)(p.ws + WS_CKV); float* KIDX = (float*)(p.ws + WS_KIDX);
    for (int t = blockIdx.x * NWAVES + wave; t < L; t += G * NWAVES) {
        const u32x4 raw = *(const u32x4*)(Z + (size_t)t * NZ + ZCKV + lane * 8);
        float x[8] = {blo(raw.x), bhi(raw.x), blo(raw.y), bhi(raw.y), blo(raw.z), bhi(raw.z), blo(raw.w), bhi(raw.w)};
        float s = 0.f;
#pragma unroll
        for (int e = 0; e < 8; ++e) s += x[e] * x[e];
        const float r = rsqrtf(wave_sum(s) * (1.f / KVR) + 1e-6f);
        const f32x4 w0 = *(const f32x4*)(p.in[I_KVNW] + lane * 8), w1 = *(const f32x4*)(p.in[I_KVNW] + lane * 8 + 4);
        u32x4 o; o.x = pk2(x[0] * r * w0.x, x[1] * r * w0.y); o.y = pk2(x[2] * r * w0.z, x[3] * r * w0.w); o.z = pk2(x[4] * r * w1.x, x[5] * r * w1.y); o.w = pk2(x[6] * r * w1.z, x[7] * r * w1.w);
        *(u32x4*)(CKV + (size_t)t * KVR + lane * 8) = o;
        const float ki = bf2f(Z[(size_t)t * NZ + ZKI + lane]);
        const float mean = wave_sum(ki) * (1.f / 64.f), dk = ki - mean, var = wave_sum(dk * dk) * (1.f / 64.f);
        const float kn_ = dk * rsqrtf(var + 1e-6f) * p.in[I_ILNW][lane] + p.in[I_ILNB][lane];
        KIDX[(size_t)t * IDXD + lane] = kn_;
        ((bf16_t*)(p.ws + WS_KIDXB))[(size_t)t * IDXD + lane] = f2bf(kn_);
    }
}

__device__ __forceinline__ unsigned fkey(float f) { const unsigned u = __float_as_uint(f); return (u & 0x80000000u) ? ~u : (u | 0x80000000u); }


typedef float f32x16 __attribute__((ext_vector_type(16)));
constexpr int SCR_N = 16416;
__device__ __forceinline__ unsigned lds_add(LAS unsigned* p, unsigned v) { return __hip_atomic_fetch_add(p, v, __ATOMIC_RELAXED, __HIP_MEMORY_SCOPE_WORKGROUP); }
constexpr int KST = 72, SELB = 8;
template <int NBL> __device__ __forceinline__ void wfind(const LAS unsigned* hist, unsigned target, int lane, unsigned& b, unsigned& ab) {
    unsigned loc[NBL]; unsigned s = 0;
#pragma unroll
    for (int j = 0; j < NBL; j += 4) { const u32x4 v4 = *(const LAS u32x4*)(hist + lane * NBL + j); loc[j] = v4.x; loc[j + 1] = v4.y; loc[j + 2] = v4.z; loc[j + 3] = v4.w; s += (v4.x + v4.y) + (v4.z + v4.w); }
    unsigned v = s;
#pragma unroll
    for (int d = 1; d < 64; d <<= 1) { const unsigned o = (unsigned)__shfl_down((int)v, d); if (lane + d < 64) v += o; }
    const unsigned above = v - s;
    const bool found = above < target && above + s >= target;
    unsigned bb = 0u, aa = 0u;
    if (found) { unsigned a = above;
#pragma unroll
        for (int j = NBL - 1; j >= 0; --j) { if (a < target && a + loc[j] >= target) { bb = (unsigned)(lane * NBL + j); aa = a; } a += loc[j]; } }
    const unsigned long long m = __ballot(found);
    const int src = m ? (int)__builtin_ctzll(m) : 0;
    b = (unsigned)__shfl((int)bb, src); ab = (unsigned)__shfl((int)aa, src);
}
__device__ __forceinline__ void d2_topk(const P& p, LAS unsigned char* lds, int G) {
    const int tid = threadIdx.x, lane = tid & 63, wave = __builtin_amdgcn_readfirstlane(tid >> 6);
    const bf16_t* Z = (const bf16_t*)(p.ws + WS_Z); const bf16_t* KB = (const bf16_t*)(p.ws + WS_KIDXB); int* SEL = (int*)(p.ws + WS_SEL);
    float* scr = (float*)(p.ws + WS_R1) + ((size_t)blockIdx.x * NWAVES + wave) * 2 * SCR_N;
    LAS bf16_t* ksb = (LAS bf16_t*)lds;
    LAS unsigned* hw = (LAS unsigned*)(lds + 73728) + wave * 2048;
    const int key_l = lane & 31, hh = lane >> 5;
    for (int t = blockIdx.x; t < NMETA + 192; t += G) { const int n = t < NMETA ? NMETA : NMETA + 64 * (1 + (t - NMETA) / 64);
        if (tid < TOPK) SEL[(size_t)t * TOPK + tid] = tid < n ? tid : -1; }
    const int nui = (G == 256) ? 4 : (1012 + G - 1) / G;
    for (int ui = 0; ui < nui; ++ui) {
        int i = (int)blockIdx.x + ui * G;
        if (G == 256) i = ui == 0 ? (int)blockIdx.x : (ui == 1 ? 511 - (int)blockIdx.x : (ui == 2 ? 512 + (int)blockIdx.x : 1023 - (int)blockIdx.x));
        if (i >= 1012) continue;
        const int c = 256 - (i >> 2), r = i & 3, n = NMETA + 64 * c;
        const int tA = NMETA + 64 * (c - 1) + 16 * r + 2 * wave;
        bf16x8_t af[2][4]; float wv[2][16];
#pragma unroll
        for (int qq = 0; qq < 2; ++qq) {
            const bf16_t* zr = Z + (size_t)(tA + qq) * NZ;
#pragma unroll
            for (int ks = 0; ks < 4; ++ks) af[qq][ks] = *(const bf16x8_t*)(zr + ZQI + key_l * 64 + ks * 16 + hh * 8);
#pragma unroll
            for (int g = 0; g < 4; ++g) { const u32x2 w2 = *(const u32x2*)(zr + ZWI + 8 * g + 4 * hh);
                wv[qq][g * 4 + 0] = blo(w2.x) * 0.02209708691207961f; wv[qq][g * 4 + 1] = bhi(w2.x) * 0.02209708691207961f;
                wv[qq][g * 4 + 2] = blo(w2.y) * 0.02209708691207961f; wv[qq][g * 4 + 3] = bhi(w2.y) * 0.02209708691207961f; }
        }
#pragma unroll
        for (int j = 0; j < 8; ++j) *(LAS u32x4*)(hw + (j * 64 + lane) * 4) = (u32x4){0u, 0u, 0u, 0u};
        const int nblk = (n + 255) >> 8;
        __syncthreads();
        {
            const int kk = tid >> 1, hf = tid & 1; const int src = kk < n ? kk : n - 1;
            const u32x4* gp = (const u32x4*)(KB + (size_t)src * IDXD + hf * 32);
#pragma unroll
            for (int j = 0; j < 4; ++j) *(LAS u32x4*)(ksb + kk * KST + hf * 32 + j * 8) = gp[j];
        }
        __syncthreads();
        for (int b = 0; b < nblk; ++b) {
            u32x4 pre[4];
            const bool more = b + 1 < nblk;
            if (more) { const int kk = (b + 1) * 256 + (tid >> 1); const int src = kk < n ? kk : n - 1; const u32x4* gp = (const u32x4*)(KB + (size_t)src * IDXD + (tid & 1) * 32);
#pragma unroll
                for (int j = 0; j < 4; ++j) pre[j] = gp[j]; }
            const LAS bf16_t* kb = ksb + (b & 1) * 256 * KST;
#pragma unroll 2
            for (int tt = 0; tt < 8; ++tt) {
                const int s0 = b * 256 + tt * 32;
                if (s0 < n) {
                    bf16x8_t bfr[4];
#pragma unroll
                    for (int ks = 0; ks < 4; ++ks) bfr[ks] = *(const LAS bf16x8_t*)(kb + (tt * 32 + key_l) * KST + ks * 16 + hh * 8);
                    float part[2];
#pragma unroll
                    for (int qq = 0; qq < 2; ++qq) {
                        f32x16 acc;
#pragma unroll
                        for (int e = 0; e < 16; ++e) acc[e] = 0.f;
#pragma unroll
                        for (int ks = 0; ks < 4; ++ks) acc = __builtin_amdgcn_mfma_f32_32x32x16_bf16(af[qq][ks], bfr[ks], acc, 0, 0, 0);
                        float s = 0.f;
                        float s0_ = 0.f, s1_ = 0.f;
#pragma unroll
                        for (int e = 0; e < 16; e += 2) { s0_ += wv[qq][e] * __builtin_amdgcn_fmed3f(acc[e], 0.f, 3.0e38f); s1_ += wv[qq][e + 1] * __builtin_amdgcn_fmed3f(acc[e + 1], 0.f, 3.0e38f); }
                        part[qq] = s0_ + s1_; (void)s;
                    }
                    const float mine = hh ? part[1] : part[0], give = hh ? part[0] : part[1];
                    const float score = mine + __shfl_xor(give, 32);
                    const int key = s0 + key_l;
                    if (key < n) { scr[hh * SCR_N + key] = score; lds_add(hw + hh * 1024 + (fkey(score) >> 22), 1u); }
                }
            }
            if (more) { const int kk = tid >> 1, hf = tid & 1;
#pragma unroll
                for (int j = 0; j < 4; ++j) *(LAS u32x4*)(ksb + ((b + 1) & 1) * 256 * KST + kk * KST + hf * 32 + j * 8) = pre[j]; }
            __syncthreads();
        }
        unsigned b1[2], ab1[2];
        wfind<16>(hw, TOPK, lane, b1[0], ab1[0]); wfind<16>(hw + 1024, TOPK, lane, b1[1], ab1[1]);
        const int nv4 = (n + 3) >> 2;
#pragma unroll
        for (int j = 0; j < 8; ++j) *(LAS u32x4*)(hw + (j * 64 + lane) * 4) = (u32x4){0u, 0u, 0u, 0u};
        for (int sb = 0; sb < nv4; sb += 64 * SELB) {
            f32x4 va[SELB], vb[SELB];
#pragma unroll
            for (int u = 0; u < SELB; ++u) { const int s4 = sb + u * 64 + lane; const int sc = s4 < nv4 ? s4 : nv4 - 1; va[u] = *(const f32x4*)(scr + sc * 4); vb[u] = *(const f32x4*)(scr + SCR_N + sc * 4); }
#pragma unroll
            for (int u = 0; u < SELB; ++u) if (sb + u * 64 + lane < nv4) {
#pragma unroll
                for (int e = 0; e < 4; ++e) { const unsigned ka = fkey(va[u][e]), kb = fkey(vb[u][e]);
                    if ((ka >> 22) == b1[0]) lds_add(hw + ((ka >> 12) & 1023u), 1u);
                    if ((kb >> 22) == b1[1]) lds_add(hw + 1024 + ((kb >> 12) & 1023u), 1u); } } }
        unsigned b2[2], ab2[2];
        wfind<16>(hw, TOPK - ab1[0], lane, b2[0], ab2[0]); wfind<16>(hw + 1024, TOPK - ab1[1], lane, b2[1], ab2[1]);
        const unsigned pfx0 = (b1[0] << 10) | b2[0], pfx1 = (b1[1] << 10) | b2[1];
        const unsigned need0 = (unsigned)TOPK - ab1[0] - ab2[0], need1 = (unsigned)TOPK - ab1[1] - ab2[1];
        LAS unsigned* cl0 = hw; LAS unsigned* cl1 = hw + 1024;
        unsigned cnt0 = 0u, cnt1 = 0u, cc0 = 0u, cc1 = 0u; int* sel0 = SEL + (size_t)tA * TOPK; int* sel1 = sel0 + TOPK;
        const unsigned long long lt = (1ull << lane) - 1ull;
        for (int sb = 0; sb < nv4; sb += 64 * SELB) {
            f32x4 va[SELB], vb[SELB];
#pragma unroll
            for (int u = 0; u < SELB; ++u) { const int s4 = sb + u * 64 + lane; const int sc = s4 < nv4 ? s4 : nv4 - 1; va[u] = *(const f32x4*)(scr + sc * 4); vb[u] = *(const f32x4*)(scr + SCR_N + sc * 4); }
#pragma unroll
            for (int u = 0; u < SELB; ++u) { const int s4 = sb + u * 64 + lane; const bool inr = s4 < nv4;
                if (sb + u * 64 < nv4) {
#pragma unroll
                    for (int e = 0; e < 4; ++e) {
                        {   const unsigned k = fkey(va[u][e]); const bool gt = inr && (k >> 12) > pfx0, eq = inr && (k >> 12) == pfx0;
                            const unsigned long long mg = __ballot(gt), me = __ballot(eq);
                            if (gt) { const unsigned pos = cnt0 + (unsigned)__builtin_popcountll(mg & lt); if (pos < (unsigned)TOPK) sel0[pos] = s4 * 4 + e; }
                            if (eq) { const unsigned ci = cc0 + (unsigned)__builtin_popcountll(me & lt); if (ci < 512u) { cl0[2 * ci] = k; cl0[2 * ci + 1] = (unsigned)(s4 * 4 + e); } }
                            cnt0 += (unsigned)__builtin_popcountll(mg); cc0 += (unsigned)__builtin_popcountll(me); }
                        {   const unsigned k = fkey(vb[u][e]); const bool gt = inr && (k >> 12) > pfx1, eq = inr && (k >> 12) == pfx1;
                            const unsigned long long mg = __ballot(gt), me = __ballot(eq);
                            if (gt) { const unsigned pos = cnt1 + (unsigned)__builtin_popcountll(mg & lt); if (pos < (unsigned)TOPK) sel1[pos] = s4 * 4 + e; }
                            if (eq) { const unsigned ci = cc1 + (unsigned)__builtin_popcountll(me & lt); if (ci < 512u) { cl1[2 * ci] = k; cl1[2 * ci + 1] = (unsigned)(s4 * 4 + e); } }
                            cnt1 += (unsigned)__builtin_popcountll(mg); cc1 += (unsigned)__builtin_popcountll(me); }
                    } } } }
#pragma unroll 1
        for (int qq = 0; qq < 2; ++qq) {
            const LAS unsigned* cl = qq ? cl1 : cl0; const unsigned c = min(qq ? cc1 : cc0, 512u), need = qq ? need1 : need0, base = qq ? cnt1 : cnt0; int* sel = qq ? sel1 : sel0;
            for (unsigned i = lane; i < c; i += 64) { const unsigned k = cl[2 * i], ix = cl[2 * i + 1]; unsigned rank = 0;
                for (unsigned j = 0; j < c; ++j) { const unsigned kj = cl[2 * j], ij = cl[2 * j + 1]; rank += (kj > k || (kj == k && ij < ix)) ? 1u : 0u; }
                if (rank < need && base + rank < (unsigned)TOPK) sel[base + rank] = (int)ix; }
        }
    }
}

__device__ __forceinline__ void d3_qlat(const P& p, int G) {
    const int tid = threadIdx.x, lane = tid & 63, wave = __builtin_amdgcn_readfirstlane(tid >> 6), r16 = lane & 15, q = lane >> 4;
    const bf16_t* Z = (const bf16_t*)(p.ws + WS_Z); const bf16_t* WK = (const bf16_t*)(p.ws + WS_WUKB); bf16_t* QL = (bf16_t*)(p.ws + WS_QLAT);
    constexpr int NB = L / 16;
    for (int item = blockIdx.x; item < 256; item += G) {
        const int h = item & 15, qr = item >> 4; const int b0 = qr * 64, b1 = qr == 15 ? NB : b0 + 64;
        bf16x8_t af[4][4];
#pragma unroll
        for (int mt = 0; mt < 4; ++mt)
#pragma unroll
            for (int ks = 0; ks < 4; ++ks) af[mt][ks] = *(const bf16x8_t*)(WK + ((size_t)h * KVR + wave * 64 + mt * 16 + r16) * HD_B + ks * 32 + q * 8);
        bf16x8_t bq[4];
#pragma unroll
        for (int ks = 0; ks < 4; ++ks) bq[ks] = *(const bf16x8_t*)(Z + (size_t)(b0 * 16 + r16) * NZ + ZQ + h * 128 + ks * 32 + q * 8);
        for (int b = b0; b < b1; ++b) {
            bf16x8_t bn[4];
            const int bnx = b + 1 < b1 ? b + 1 : b;
#pragma unroll
            for (int ks = 0; ks < 4; ++ks) bn[ks] = *(const bf16x8_t*)(Z + (size_t)(bnx * 16 + r16) * NZ + ZQ + h * 128 + ks * 32 + q * 8);
#pragma unroll
            for (int mt = 0; mt < 4; ++mt) {
                f32x4 acc = {0.f, 0.f, 0.f, 0.f};
#pragma unroll
                for (int ks = 0; ks < 4; ++ks) acc = __builtin_amdgcn_mfma_f32_16x16x32_bf16(af[mt][ks], bq[ks], acc, 0, 0, 0);
                u32x2 w; w.x = cvtpk(acc[0], acc[1]); w.y = cvtpk(acc[2], acc[3]);
                *(u32x2*)(QL + (size_t)(b * 16 + r16) * 8192 + h * 512 + wave * 64 + mt * 16 + q * 4) = w;
            }
#pragma unroll
            for (int ks = 0; ks < 4; ++ks) bq[ks] = bn[ks];
        }
    }
}
__device__ __forceinline__ void d5_oproj(const P& p, int G) {
    const int tid = threadIdx.x, lane = tid & 63, wave = __builtin_amdgcn_readfirstlane(tid >> 6), r16 = lane & 15, q = lane >> 4;
    const bf16_t* OL = (const bf16_t*)(p.ws + WS_QLAT); const bf16_t* WV = (const bf16_t*)(p.ws + WS_WUVT); bf16_t* YB = (bf16_t*)(p.ws + WS_YB);
    for (size_t i = (size_t)blockIdx.x * NT + tid; i < (size_t)(MP - L) * A_W / 8; i += (size_t)G * NT) *(u32x4*)(YB + (size_t)L * A_W + i * 8) = (u32x4){0u, 0u, 0u, 0u};
    constexpr int NB = L / 16;
    for (int item = blockIdx.x; item < 256; item += G) {
        const int h = item & 15, qr = item >> 4; const int b0 = qr * 64, b1 = qr == 15 ? NB : b0 + 64;
        bf16x8_t af[16];
#pragma unroll
        for (int ks = 0; ks < 16; ++ks) af[ks] = *(const bf16x8_t*)(WV + ((size_t)h * HD_B + wave * 16 + r16) * KVR + ks * 32 + q * 8);
        bf16x8_t bo[16];
#pragma unroll
        for (int ks = 0; ks < 16; ++ks) bo[ks] = *(const bf16x8_t*)(OL + (size_t)(b0 * 16 + r16) * 8192 + h * 512 + ks * 32 + q * 8);
        for (int b = b0; b < b1; ++b) {
            f32x4 acc0 = {0.f, 0.f, 0.f, 0.f}, acc1 = acc0;
#pragma unroll
            for (int ks = 0; ks < 16; ks += 2) { acc0 = __builtin_amdgcn_mfma_f32_16x16x32_bf16(af[ks], bo[ks], acc0, 0, 0, 0); acc1 = __builtin_amdgcn_mfma_f32_16x16x32_bf16(af[ks + 1], bo[ks + 1], acc1, 0, 0, 0); }
            const int bnx = b + 1 < b1 ? b + 1 : b;
#pragma unroll
            for (int ks = 0; ks < 16; ++ks) bo[ks] = *(const bf16x8_t*)(OL + (size_t)(bnx * 16 + r16) * 8192 + h * 512 + ks * 32 + q * 8);
            const f32x4 acc = acc0 + acc1;
            u32x2 w; w.x = cvtpk(acc[0], acc[1]); w.y = cvtpk(acc[2], acc[3]);
            *(u32x2*)(YB + (size_t)(b * 16 + r16) * A_W + h * HD_B + wave * 16 + q * 4) = w;
        }
    }
}

typedef short s16x4_t __attribute__((ext_vector_type(4)));
constexpr int QLS = 520, PLS = 264, CTS = 528;
#ifndef ATT_REG
#define ATT_REG 0
#endif
#if ATT_REG > 0
#define AREG_T() const unsigned long long tt_ = __builtin_amdgcn_s_memrealtime()
#ifndef ATT_BLK
#define ATT_BLK 0
#endif
#define AREG(k) do { if (ATT_REG == (k) && blockIdx.x == ATT_BLK && threadIdx.x == 0) { const unsigned long long t1_ = __builtin_amdgcn_s_memrealtime(); areg_acc += t1_ - areg_t0; } if (ATT_REG != 9 && blockIdx.x == ATT_BLK && threadIdx.x == 0) areg_t0 = __builtin_amdgcn_s_memrealtime(); } while (0)
#else
#define AREG(k) do {} while (0)
#endif
__device__ __forceinline__ void d4_attn(const P& p, LAS unsigned char* lds, int G) {
    unsigned long long areg_acc = 0, areg_t0 = 0; (void)areg_acc; (void)areg_t0;
    const int tid = threadIdx.x, lane = tid & 63, wave = __builtin_amdgcn_readfirstlane(tid >> 6), r16 = lane & 15, q = lane >> 4;
    bf16_t* QO = (bf16_t*)(p.ws + WS_QLAT); const bf16_t* CKV = (const bf16_t*)(p.ws + WS_CKV); const int* SEL = (const int*)(p.ws + WS_SEL);
    LAS bf16_t* ql = (LAS bf16_t*)lds;
    LAS float* lg = (LAS float*)(lds + 16640);
    LAS bf16_t* pl = (LAS bf16_t*)(lds + 49408);
    LAS int* sl = (LAS int*)(lds + 57856);
    LAS bf16_t* ct = (LAS bf16_t*)(lds + 58880);
    LAS bf16_t* cx = (LAS bf16_t*)(lds + 126464);
    const float scale = 0.08838834764831845f;
    u32x4 qn0 = (u32x4){0u, 0u, 0u, 0u}, qn1 = qn0; int seln = -1;
    const bool xdeal = (G == 256);
    const int tq0 = xdeal ? ((int)(blockIdx.x & 7) * (L / 8) + (int)(blockIdx.x >> 3)) : (int)blockIdx.x, tqs = xdeal ? 32 : G, tq1 = xdeal ? ((int)(blockIdx.x & 7) + 1) * (L / 8) : L;
    {   const int t = tq0;
        if (t < tq1) { qn0 = *(const u32x4*)(QO + (size_t)t * 8192 + tid * 8); qn1 = *(const u32x4*)(QO + (size_t)t * 8192 + 4096 + tid * 8); if (tid < TOPK) seln = SEL[(size_t)t * TOPK + tid]; } }
#if ATT_REG == 9
    if (blockIdx.x == ATT_BLK && threadIdx.x == 0) areg_t0 = __builtin_amdgcn_s_memrealtime();
#endif
    for (int t = tq0; t < tq1; t += tqs) {
        AREG(5);
        LDS_BARRIER();
        {   const int i0_ = tid, i1_ = tid + 512;
            *(LAS u32x4*)(ql + (i0_ >> 6) * QLS + (i0_ & 63) * 8) = qn0; *(LAS u32x4*)(ql + (i1_ >> 6) * QLS + (i1_ & 63) * 8) = qn1;
            if (tid < TOPK) sl[tid] = seln; }
        LDS_BARRIER();
        AREG(1);
        u32x4 st[8];
#pragma unroll
        for (int i = 0; i < 8; ++i) { const int idx = sl[wave + 8 * i]; st[i] = *(const u32x4*)(CKV + (size_t)(idx < 0 ? 0 : idx) * KVR + lane * 8); }
        const int kk = wave & 3, kh = wave >> 2;
        bf16x8_t af[8];
#pragma unroll
        for (int ks = 0; ks < 8; ++ks) af[ks] = *(const LAS bf16x8_t*)(ql + r16 * QLS + kh * 256 + ks * 32 + q * 8);
        for (int kt = 0; kt < 4; ++kt) {
            LDS_BARRIER();
#pragma unroll
            for (int i = 0; i < 8; ++i) { LAS bf16_t* dst = (kt == 2 && i >= 4) ? cx + (wave + 8 * i - 32) * CTS : ct + (wave + 8 * i) * CTS; *(LAS u32x4*)(dst + lane * 8) = st[i]; }
            if (kt < 3) {
#pragma unroll
                for (int i = 0; i < 8; ++i) { const int idx = sl[(kt + 1) * 64 + wave + 8 * i]; st[i] = *(const u32x4*)(CKV + (size_t)(idx < 0 ? 0 : idx) * KVR + lane * 8); }
            } else {
#pragma unroll
                for (int i = 0; i < 4; ++i) { const int idx = sl[128 + wave + 8 * i]; st[i] = *(const u32x4*)(CKV + (size_t)(idx < 0 ? 0 : idx) * KVR + lane * 8); }
            }
            LDS_BARRIER();
            const LAS bf16_t* kb = (kt == 2 && kk >= 2) ? cx + ((kk - 2) * 16 + r16) * CTS : ct + (kk * 16 + r16) * CTS;
            f32x4 c0 = {0.f, 0.f, 0.f, 0.f};
#pragma unroll
            for (int ks = 0; ks < 8; ++ks) {
                const bf16x8_t b = *(const LAS bf16x8_t*)(kb + kh * 256 + ks * 32 + q * 8);
                c0 = __builtin_amdgcn_mfma_f32_16x16x32_bf16(af[ks], b, c0, 0, 0, 0);
            }
            const int key = kt * 64 + kk * 16 + r16; const bool inval = sl[key] < 0;
#pragma unroll
            for (int e = 0; e < 4; ++e) lg[kh * 4096 + (4 * q + e) * 256 + key] = inval ? (kh ? 0.f : -INFINITY) : c0[e] * scale;
        }
        LDS_BARRIER();
        AREG(2);
        for (int hd = wave * 2; hd < wave * 2 + 2; ++hd) {
            float v[4]; float mx = -INFINITY;
#pragma unroll
            for (int k = 0; k < 4; ++k) { v[k] = lg[hd * 256 + k * 64 + lane] + lg[4096 + hd * 256 + k * 64 + lane]; mx = fmaxf(mx, v[k]); }
            mx = wave_max(mx);
            float s = 0.f;
#pragma unroll
            for (int k = 0; k < 4; ++k) { v[k] = __expf(v[k] - mx); s += v[k]; }
            s = 1.f / wave_sum(s);
#pragma unroll
            for (int k = 0; k < 4; ++k) pl[hd * PLS + k * 64 + lane] = f2bf(v[k] * s);
        }
        f32x4 acc[4];
#pragma unroll
        for (int m = 0; m < 4; ++m) acc[m] = (f32x4){0.f, 0.f, 0.f, 0.f};
        {   const int tn = t + tqs;
            if (tn < tq1) { qn0 = *(const u32x4*)(QO + (size_t)tn * 8192 + tid * 8); qn1 = *(const u32x4*)(QO + (size_t)tn * 8192 + 4096 + tid * 8); if (tid < TOPK) seln = SEL[(size_t)tn * TOPK + tid]; } }
        AREG(3);
        for (int j2 = 0; j2 < 4; ++j2) {
            const int kt = 3 - j2;
            LDS_BARRIER();
            if (j2 > 0) {
                if (j2 == 1) {
#pragma unroll
                    for (int i = 0; i < 4; ++i) *(LAS u32x4*)(ct + (wave + 8 * i) * CTS + lane * 8) = st[i];
                } else {
#pragma unroll
                    for (int i = 0; i < 8; ++i) *(LAS u32x4*)(ct + (wave + 8 * i) * CTS + lane * 8) = st[i];
                }
                if (j2 < 3) {
#pragma unroll
                    for (int i = 0; i < 8; ++i) { const int idx = sl[(kt - 1) * 64 + wave + 8 * i]; st[i] = *(const u32x4*)(CKV + (size_t)(idx < 0 ? 0 : idx) * KVR + lane * 8); } }
                LDS_BARRIER();
            }
            const int kq = 16 * (q >> 1) + 4 * (q & 1);
#pragma unroll
            for (int s = 0; s < 2; ++s) {
                const u32x2 pa = *(const LAS u32x2*)(pl + r16 * PLS + kt * 64 + s * 32 + kq), pb = *(const LAS u32x2*)(pl + r16 * PLS + kt * 64 + s * 32 + kq + 8);
                const u32x4 pw = (u32x4){pa.x, pa.y, pb.x, pb.y}; const bf16x8_t b = __builtin_bit_cast(bf16x8_t, pw);
                const LAS bf16_t* cb = (kt == 2 && s == 1) ? cx : ct + s * 32 * CTS;
                const LAS bf16_t* tp = cb + (kq + (r16 >> 2)) * CTS + wave * 64 + (r16 & 3) * 4;
#pragma unroll
                for (int m = 0; m < 4; ++m) {
                    const s16x4_t lo = __builtin_amdgcn_ds_read_tr16_b64_v4i16((LAS s16x4_t*)(tp + m * 16)), hi = __builtin_amdgcn_ds_read_tr16_b64_v4i16((LAS s16x4_t*)(tp + 8 * CTS + m * 16));
                    const bf16x8_t a = (bf16x8_t){lo[0], lo[1], lo[2], lo[3], hi[0], hi[1], hi[2], hi[3]};
                    acc[m] = __builtin_amdgcn_mfma_f32_16x16x32_bf16(a, b, acc[m], 0, 0, 0);
                }
            }
        }
        AREG(4);
#pragma unroll
        for (int m = 0; m < 4; ++m) { u32x2 w; w.x = cvtpk(acc[m][0], acc[m][1]); w.y = cvtpk(acc[m][2], acc[m][3]);
            *(u32x2*)(QO + (size_t)t * 8192 + r16 * 512 + wave * 64 + m * 16 + q * 4) = w; }
    }
#if ATT_REG == 9
    if (blockIdx.x == ATT_BLK && threadIdx.x == 0) areg_acc = __builtin_amdgcn_s_memrealtime() - areg_t0;
#endif
#if ATT_REG > 0
    if (blockIdx.x == ATT_BLK && threadIdx.x == 0) __hip_atomic_store((unsigned*)(p.ws + WS_CTL) + 65540, (unsigned)areg_acc, __ATOMIC_RELAXED, __HIP_MEMORY_SCOPE_AGENT);
#endif
}


__device__ __forceinline__ const float* h1_row(const P& p, int m) { const float* hmeta = (const float*)(p.ws + WS_HMETA); return m < NMETA ? hmeta + (size_t)m * D : p.out + (size_t)(m - NMETA) * D; }
__device__ __forceinline__ void p12_norm(const P& p, int G) {
    const int lane = threadIdx.x & 63, wave = threadIdx.x >> 6;
    signed char* U8 = (signed char*)(p.ws + WS_U); const float* w = p.in[I_NFW];
    float wm = 0.f;
#pragma unroll
    for (int j = 0; j < 16; ++j) { const f32x4 g = *(const f32x4*)(w + (j * 64 + lane) * 4); wm += (g.x * g.x + g.y * g.y) + (g.z * g.z + g.w * g.w); }
    wm = sqrtf(wave_sum(wm) * (1.f / D));
    const float amc = 4.0f * wm;
    const float inv = amc > 0.f ? 127.f / amc : 0.f;
    if (blockIdx.x == 0 && threadIdx.x == 0) *(float*)(p.ws + WS_CTL + CT_SAG) = amc > 0.f ? amc * (1.f / 127.f) : 1.f;
    for (int m = blockIdx.x * NWAVES + wave; m < MP; m += G * NWAVES) {
        signed char* dst = U8 + (size_t)m * D;
        if (m >= L) {
#pragma unroll
            for (int j = 0; j < 4; ++j) *(u32x4*)(dst + (j * 64 + lane) * 16) = (u32x4){0u, 0u, 0u, 0u};
            continue; }
        const float* src = h1_row(p, m);
        f32x4 v[16]; float s = 0.f;
#pragma unroll
        for (int j = 0; j < 16; ++j) { v[j] = *(const f32x4*)(src + (j * 64 + lane) * 4); s += (v[j].x * v[j].x + v[j].y * v[j].y) + (v[j].z * v[j].z + v[j].w * v[j].w); }
        const float ri = rsqrtf(wave_sum(s) * (1.f / D) + 1e-6f) * inv;
#pragma unroll
        for (int j = 0; j < 16; ++j) { const f32x4 x = v[j] * ri; const f32x4 g = *(const f32x4*)(w + (j * 64 + lane) * 4);
            const unsigned q = ((unsigned)(int)rintf(fminf(fmaxf(x.x * g.x, -127.f), 127.f)) & 0xffu) | (((unsigned)(int)rintf(fminf(fmaxf(x.y * g.y, -127.f), 127.f)) & 0xffu) << 8) | (((unsigned)(int)rintf(fminf(fmaxf(x.z * g.z, -127.f), 127.f)) & 0xffu) << 16) | (((unsigned)(int)rintf(fminf(fmaxf(x.w * g.w, -127.f), 127.f)) & 0xffu) << 24);
            *(unsigned*)(dst + (j * 64 + lane) * 4) = q; }
    }
}
__device__ __forceinline__ void p18_final_norm(const P& p, int G) {
    const int tid = threadIdx.x, lane = tid & 63, wave = tid >> 6;
    const float* w = p.in[I_NFIN];
    for (int m = blockIdx.x * NWAVES + wave; m < SEQ; m += G * NWAVES) {
        float* row = p.out + (size_t)m * D;
        f32x4 v[16]; float s = 0.f;
#pragma unroll
        for (int j = 0; j < 16; ++j) { v[j] = *(const f32x4*)(row + (j * 64 + lane) * 4); s += (v[j].x * v[j].x + v[j].y * v[j].y) + (v[j].z * v[j].z + v[j].w * v[j].w); }
        float r = rsqrtf(wave_sum(s) * (1.f / D) + 1e-6f);
#if STAMP_A0 >= 0
        r *= 1.f + 1e-7f * (float)__hip_atomic_load((const unsigned*)(p.ws + WS_CTL) + 65536, __ATOMIC_RELAXED, __HIP_MEMORY_SCOPE_AGENT);
#endif
#pragma unroll
        for (int j = 0; j < 16; ++j) { const f32x4 g = *(const f32x4*)(w + (j * 64 + lane) * 4); *(f32x4*)(row + (j * 64 + lane) * 4) = v[j] * r * g; }
    }
}

__device__ __forceinline__ void p14_conv_act(const P& p, int G, int pass) {
    const int tid = threadIdx.x;
    const bf16_t* ZF = (const bf16_t*)(p.ws + WS_ZF); bf16_t* ACT = (bf16_t*)(p.ws + WS_ACT);
    const float* cw = p.in[I_CW]; const float* cb = p.in[I_CB];
    const size_t nitems = (size_t)MP * 43 * 16;
    for (size_t it = (size_t)blockIdx.x * NT + tid; it < nitems; it += (size_t)G * NT) {
        const int g8 = (int)(it % 16), tl = (int)((it / 16) % 43), t = (int)(it / (16 * 43));
        const int ch = (pass * 43 + tl) * 128 + g8 * 8;
        u32x4 o = (u32x4){0u, 0u, 0u, 0u};
        if (t < L) {
            float zg[8], zu[8];
#pragma unroll
            for (int e = 0; e < 8; ++e) { zg[e] = cb[ch + e]; zu[e] = cb[DFF + ch + e]; }
#pragma unroll
            for (int i = 0; i < 3; ++i) { const int tt = t - 2 + i;
                if (tt >= 0) {
                    const u32x4 a = *(const u32x4*)(ZF + (size_t)tt * DFF + tl * 256 + g8 * 8), b = *(const u32x4*)(ZF + (size_t)tt * DFF + tl * 256 + 128 + g8 * 8);
                    const float xa[8] = {blo(a.x), bhi(a.x), blo(a.y), bhi(a.y), blo(a.z), bhi(a.z), blo(a.w), bhi(a.w)};
                    const float xb[8] = {blo(b.x), bhi(b.x), blo(b.y), bhi(b.y), blo(b.z), bhi(b.z), blo(b.w), bhi(b.w)};
#pragma unroll
                    for (int e = 0; e < 8; ++e) { zg[e] += cw[(size_t)i * NFI + ch + e] * xa[e]; zu[e] += cw[(size_t)i * NFI + DFF + ch + e] * xb[e]; }
                } }
            float r[8];
#pragma unroll
            for (int e = 0; e < 8; ++e) r[e] = zg[e] * sigm(zg[e]) * zu[e];
            o.x = pk2(r[0], r[1]); o.y = pk2(r[2], r[3]); o.z = pk2(r[4], r[5]); o.w = pk2(r[6], r[7]);
        }
        *(u32x4*)(ACT + (size_t)t * DFF + ch) = o;
    }
}

template <int K, class F> __device__ __forceinline__ void side2(const bf16_t* A14, int lda, const bf16_t* Bt, int N, int G, F f) {
    const int lane = threadIdx.x & 63, gw = blockIdx.x * NWAVES + (threadIdx.x >> 6);
    constexpr int NC = K / 512;
    u32x4 a0[NC], a1[NC];
#pragma unroll
    for (int i = 0; i < NC; ++i) { a0[i] = *(const u32x4*)(A14 + i * 512 + lane * 8); a1[i] = *(const u32x4*)(A14 + lda + i * 512 + lane * 8); }
    for (int n = gw; n < N; n += G * NWAVES) {
        float s0 = 0.f, s1 = 0.f;
#pragma unroll
        for (int i = 0; i < NC; ++i) { const u32x4 b = *(const u32x4*)(Bt + (size_t)n * K + i * 512 + lane * 8);
            const unsigned bw[4] = {b.x, b.y, b.z, b.w}, x0[4] = {a0[i].x, a0[i].y, a0[i].z, a0[i].w}, x1[4] = {a1[i].x, a1[i].y, a1[i].z, a1[i].w};
#pragma unroll
            for (int e = 0; e < 4; ++e) { s0 += blo(x0[e]) * blo(bw[e]) + bhi(x0[e]) * bhi(bw[e]); s1 += blo(x1[e]) * blo(bw[e]) + bhi(x1[e]) * bhi(bw[e]); } }
        s0 = wave_sum(s0); s1 = wave_sum(s1);
        if (lane == 0) f(n, s0, s1);
    }
}

template <class F> __device__ __forceinline__ void side2_i8(const signed char* A14, const signed char* Bt, int N, int G, F f) {
    const int lane = threadIdx.x & 63, gw = blockIdx.x * NWAVES + (threadIdx.x >> 6);
    u32x4 a0[4], a1[4];
#pragma unroll
    for (int i = 0; i < 4; ++i) { a0[i] = *(const u32x4*)(A14 + i * 1024 + lane * 16); a1[i] = *(const u32x4*)(A14 + 4096 + i * 1024 + lane * 16); }
    for (int n = gw; n < N; n += G * NWAVES) {
        int s0 = 0, s1 = 0;
#pragma unroll
        for (int i = 0; i < 4; ++i) { const u32x4 b = *(const u32x4*)(Bt + (size_t)n * 4096 + i * 1024 + lane * 16);
            s0 = __builtin_amdgcn_sdot4((int)a0[i].x, (int)b.x, s0, false); s0 = __builtin_amdgcn_sdot4((int)a0[i].y, (int)b.y, s0, false); s0 = __builtin_amdgcn_sdot4((int)a0[i].z, (int)b.z, s0, false); s0 = __builtin_amdgcn_sdot4((int)a0[i].w, (int)b.w, s0, false);
            s1 = __builtin_amdgcn_sdot4((int)a1[i].x, (int)b.x, s1, false); s1 = __builtin_amdgcn_sdot4((int)a1[i].y, (int)b.y, s1, false); s1 = __builtin_amdgcn_sdot4((int)a1[i].z, (int)b.z, s1, false); s1 = __builtin_amdgcn_sdot4((int)a1[i].w, (int)b.w, s1, false); }
#pragma unroll
        for (int d = 32; d >= 1; d >>= 1) { s0 += __shfl_xor(s0, d); s1 += __shfl_xor(s1, d); }
        if (lane == 0) f(n, s0, s1);
    }
}

__device__ __forceinline__ void p_conv_fix(const P& p, int G) {
    const int tid = threadIdx.x;
    const float* HALO = (const float*)(p.ws + WS_ZF); bf16_t* ACT = (bf16_t*)(p.ws + WS_ACT);
    const float* cw = p.in[I_CW]; const float* cb = p.in[I_CB];
    const int nitems = 64 * 2 * DFF;
    for (int it = blockIdx.x * NT + tid; it < nitems; it += G * NT) {
        const int c = it % DFF, d = (it / DFF) & 1, pm = 1 + it / (2 * DFF);
        const int r = pm * 256 + d; if (r >= L) continue;
        const int T = c >> 7, cl = c & 127; const int colg = T * 256 + cl, colu = colg + 128;
        const float* h0 = HALO + ((size_t)(pm - 1) * 4 + 2 + d) * NFI; const float* h1 = d == 0 ? HALO + ((size_t)(pm - 1) * 4 + 3) * NFI : HALO + ((size_t)pm * 4 + 0) * NFI; const float* h2 = HALO + ((size_t)pm * 4 + d) * NFI;
        const float zg = cb[c] + cw[c] * h0[colg] + cw[(size_t)NFI + c] * h1[colg] + cw[(size_t)2 * NFI + c] * h2[colg];
        const float zu = cb[DFF + c] + cw[DFF + c] * h0[colu] + cw[(size_t)NFI + DFF + c] * h1[colu] + cw[(size_t)2 * NFI + DFF + c] * h2[colu];
        ACT[(size_t)r * DFF + c] = f2bf(zg * sigm(zg) * zu);
    }
}

constexpr int NPHASE = 20;
__global__ void __launch_bounds__(NT, 2) fwd_kernel(P p) {
    extern __shared__ __attribute__((aligned(16))) unsigned char lds_raw[];
    LAS unsigned char* lds = (LAS unsigned char*)lds_raw;
    const int G = gridDim.x;
    unsigned char* ws = p.ws;
    volatile LAS unsigned* MISC = (volatile LAS unsigned*)(lds + MISC_OFF);
    if (threadIdx.x < 16) MISC[threadIdx.x] = 0u;
    __syncthreads();
#if MK_ONE_LAUNCH
    XcdBarrier bar = xcd_barrier_post((unsigned*)(ws + WS_CTL), MISC + 8);
#define GRID_BAR() xcd_barrier(bar)
#else
#define GRID_BAR() do {} while (0)
#endif
    unsigned long long tsA0 = 0, tsA1 = 0, tsB0 = 0, tsB1 = 0; (void)tsA0; (void)tsA1; (void)tsB0; (void)tsB1;
    const int lo = p.ph_lo, hi = p.ph_hi;
#ifndef PHASE_MASK
#define PHASE_MASK 0xFFFFFFFu
#endif
#define IN(k) ((((PHASE_MASK) >> (k)) & 1u) && lo <= (k) && (k) < hi)
#ifndef STAMP_A0
#define STAMP_A0 -1
#endif
#if STAMP_A0 >= 0
#define STAMP(k) do { if (blockIdx.x == 0 && threadIdx.x == 0) { const unsigned long long t_ = __builtin_amdgcn_s_memrealtime(); if ((k) == STAMP_A0) tsA0 = t_; if ((k) == STAMP_A1) tsA1 = t_; if ((k) == STAMP_B0) tsB0 = t_; if ((k) == STAMP_B1) { tsB1 = t_; \
    __hip_atomic_store((unsigned*)(ws + WS_CTL) + 65536, (unsigned)(tsB1 - tsB0), __ATOMIC_RELAXED, __HIP_MEMORY_SCOPE_AGENT); } } } while (0)
#else
#define STAMP(k) do {} while (0)
#endif
#define SEAM(k) do { if (IN((k) + 1)) GRID_BAR(); STAMP((k) + 1); } while (0)
    STAMP(0);
#ifndef PROBE_REP_MASK
#define PROBE_REP_MASK 0u
#endif
#define NREP(k) ((((PROBE_REP_MASK) >> (k)) & 1u) ? 2 : 1)
    bf16_t* U = (bf16_t*)(ws + WS_U);
    if (IN(0)) _Pragma("unroll") for (int rep_ = 0; rep_ < NREP(0); ++rep_) { p0_prologue_a(p, lds, G); GRID_BAR(); p0_prologue_b(p, lds, G); if (rep_ == NREP(0) - 1) SEAM(0); }
    if (IN(1)) _Pragma("unroll") for (int rep_ = 0; rep_ < NREP(1); ++rep_) {
        {   pg8::Gemm g{U, (const bf16_t*)(ws + WS_WINT), MP, NZ8, D / 2, (const float*)(ws + WS_CTL + CT_SA), (const float*)(ws + WS_CTL + CT_SB_IN)}; pg8::StaticOrder S; S.init(MP, NZ8, G, (int)blockIdx.x);
            pg8::EpiBf16<0> E{(bf16_t*)(ws + WS_Z), NZ};
            pg8::gemm_phase<pg8::EpiBf16<0>, pg8::StaticOrder, true, true, true>(lds, g, S, E); }
        {   pg8::Gemm g{(const bf16_t*)(ws + WS_R1), (const bf16_t*)(ws + WS_WINT + WINT_BF_OFF), MP, NZ - NZ8, D}; pg8::StaticOrder S; S.init(MP, NZ - NZ8, G, (int)blockIdx.x);
            pg8::EpiBf16<0> E{(bf16_t*)(ws + WS_Z) + NZ8, NZ};
            pg8::gemm_phase<pg8::EpiBf16<0>, pg8::StaticOrder, true, true, false>(lds, g, S, E); }
        if (rep_ == NREP(1) - 1) SEAM(1);
    }
    if (IN(2)) _Pragma("unroll") for (int rep_ = 0; rep_ < NREP(2); ++rep_) { p2_rwkv_prep(p, lds, G); if (rep_ == NREP(2) - 1) SEAM(2); }
    if (IN(3)) _Pragma("unroll") for (int rep_ = 0; rep_ < NREP(3); ++rep_) { ra_items(p, lds, G); if (rep_ == NREP(3) - 1) SEAM(3); }
    if (IN(4)) _Pragma("unroll") for (int rep_ = 0; rep_ < NREP(4); ++rep_) { rb_chain(p, G);
        {
            const int wv_ = threadIdx.x >> 6, nch_ = G < 128 ? G : 128; const int nvw_ = nch_ * 7 + (G - nch_) * 8;
            const int vw_ = (int)blockIdx.x < nch_ ? ((int)blockIdx.x * 7 + wv_ - 1) : (nch_ * 7 + ((int)blockIdx.x - nch_) * 8 + wv_);
            if (!((int)blockIdx.x < nch_ && wv_ == 0)) p0b_weights(p, lds, vw_, nvw_); }
        if (rep_ == NREP(4) - 1) SEAM(4); }
    if (IN(5)) _Pragma("unroll") for (int rep_ = 0; rep_ < NREP(5); ++rep_) { rc_out(p, G); if (rep_ == NREP(5) - 1) SEAM(5); }
    if (IN(6)) _Pragma("unroll") for (int rep_ = 0; rep_ < NREP(6); ++rep_) { p4_dsa_prep(p, G); if (rep_ == NREP(6) - 1) SEAM(6); }
    if (IN(7)) _Pragma("unroll") for (int rep_ = 0; rep_ < NREP(7); ++rep_) { d2_topk(p, lds, G); if (rep_ == NREP(7) - 1) SEAM(7); }
    if (IN(8)) _Pragma("unroll") for (int rep_ = 0; rep_ < NREP(8); ++rep_) { d3_qlat(p, G); if (rep_ == NREP(8) - 1) SEAM(8); }
    if (IN(9)) _Pragma("unroll") for (int rep_ = 0; rep_ < NREP(9); ++rep_) { d4_attn(p, lds, G); if (rep_ == NREP(9) - 1) SEAM(9); }
    if (IN(11)) _Pragma("unroll") for (int rep_ = 0; rep_ < NREP(11); ++rep_) {
        d5_oproj(p, G);
        pg8::Gemm g{U + (size_t)NMETA * (D / 2), (const bf16_t*)(ws + WS_WGT), SEQ, 8192, D / 2, (const float*)(ws + WS_CTL + CT_SA) + NMETA, (const float*)(ws + WS_CTL + CT_SB_G)}; pg8::StaticOrder S; S.init(SEQ, 8192, G, (int)blockIdx.x);
        pg8::EpiBf16<1> E{(bf16_t*)(ws + WS_GATES) + (size_t)NMETA * 8192, 8192};
        pg8::gemm_phase<pg8::EpiBf16<1>, pg8::StaticOrder, true, true, true>(lds, g, S, E);
        {   const float* SA_ = (const float*)(ws + WS_CTL + CT_SA); const float* SB_ = (const float*)(ws + WS_CTL + CT_SB_G); bf16_t* GT = (bf16_t*)(ws + WS_GATES);
            side2_i8((const signed char*)(ws + WS_U) + (size_t)14 * D, (const signed char*)(ws + WS_WGT), 8192, G, [&](int n, int i0, int i1) {
                GT[(size_t)14 * 8192 + n] = f2bf(1.f / (1.f + __expf(-(float)i0 * SA_[14] * SB_[n]))); GT[(size_t)15 * 8192 + n] = f2bf(1.f / (1.f + __expf(-(float)i1 * SA_[15] * SB_[n]))); }); }
        if (rep_ == NREP(11) - 1) SEAM(11);
    }
    if (IN(12)) _Pragma("unroll") for (int rep_ = 0; rep_ < NREP(12); ++rep_) {
        pg8::Gemm g{(const bf16_t*)(ws + WS_YA) + (size_t)NMETA * A_W, (const bf16_t*)(ws + WS_WPAT), SEQ, D, A_W}; pg8::StaticOrder S; S.init(SEQ, D, G, (int)blockIdx.x);
        pg8::EpiGateMulF32 E{(bf16_t*)(ws + WS_MF) + (size_t)NMETA * D, D, (const bf16_t*)(ws + WS_GATES) + (size_t)NMETA * 8192, 8192, 0};
        pg8::gemm_phase<pg8::EpiGateMulF32, pg8::StaticOrder, true, true>(lds, g, S, E);
        {   bf16_t* MA = (bf16_t*)(ws + WS_MF); const bf16_t* GT = (const bf16_t*)(ws + WS_GATES);
            side2<2048>((const bf16_t*)(ws + WS_YA) + (size_t)14 * A_W, A_W, (const bf16_t*)(ws + WS_WPAT), D, G, [&](int n, float s0, float s1) {
                MA[(size_t)14 * D + n] = f2bf(bf2f(GT[(size_t)14 * 8192 + n]) * s0); MA[(size_t)15 * D + n] = f2bf(bf2f(GT[(size_t)15 * 8192 + n]) * s1); }); }
        if (rep_ == NREP(12) - 1) SEAM(12);
    }
    if (IN(13)) _Pragma("unroll") for (int rep_ = 0; rep_ < NREP(13); ++rep_) {
        pg8::Gemm g{(const bf16_t*)(ws + WS_YB) + (size_t)NMETA * A_W, (const bf16_t*)(ws + WS_WPBT), SEQ, D, A_W}; pg8::StaticOrder S; S.init(SEQ, D, G, (int)blockIdx.x);
        pg8::EpiGateMulAddBf16 E{U + (size_t)NMETA * D, D, (const bf16_t*)(ws + WS_MF) + (size_t)NMETA * D, (const bf16_t*)(ws + WS_GATES) + (size_t)NMETA * 8192, 8192, D};
        pg8::gemm_phase<pg8::EpiGateMulAddBf16, pg8::StaticOrder, true, true>(lds, g, S, E);
        {   const bf16_t* MA = (const bf16_t*)(ws + WS_MF); const bf16_t* GT = (const bf16_t*)(ws + WS_GATES);
            side2<2048>((const bf16_t*)(ws + WS_YB) + (size_t)14 * A_W, A_W, (const bf16_t*)(ws + WS_WPBT), D, G, [&](int n, float s0, float s1) {
                U[(size_t)14 * D + n] = f2bf(bf2f(MA[(size_t)14 * D + n]) + bf2f(GT[(size_t)14 * 8192 + D + n]) * s0); U[(size_t)15 * D + n] = f2bf(bf2f(MA[(size_t)15 * D + n]) + bf2f(GT[(size_t)15 * 8192 + D + n]) * s1); }); }
        if (rep_ == NREP(13) - 1) SEAM(13);
    }
    if (IN(14)) _Pragma("unroll") for (int rep_ = 0; rep_ < NREP(14); ++rep_) {
        pg8::Gemm g{U + (size_t)NMETA * D, (const bf16_t*)(ws + WS_WOUTT), SEQ, D, D}; pg8::StaticOrder S; S.init(SEQ, D, G, (int)blockIdx.x);
        pg8::EpiResid E{p.in[I_X], p.in[I_X], p.out, p.out, D, 0, SEQ};
        pg8::gemm_phase<pg8::EpiResid, pg8::StaticOrder, true, true>(lds, g, S, E);
        {   float* HM = (float*)(ws + WS_HMETA); const float* mt = p.in[I_META];
            for (int i2 = blockIdx.x * NT + threadIdx.x; i2 < 14 * D; i2 += G * NT) HM[i2] = mt[i2];
            side2<4096>(U + (size_t)14 * D, D, (const bf16_t*)(ws + WS_WOUTT), D, G, [&](int n, float s0, float s1) { HM[(size_t)14 * D + n] = mt[(size_t)14 * D + n] + s0; HM[(size_t)15 * D + n] = mt[(size_t)15 * D + n] + s1; }); }
        if (rep_ == NREP(14) - 1) SEAM(14);
    }
    if (IN(15)) _Pragma("unroll") for (int rep_ = 0; rep_ < NREP(15); ++rep_) { p12_norm(p, G); if (rep_ == NREP(15) - 1) SEAM(15); }
    if (IN(16)) _Pragma("unroll") for (int rep_ = 0; rep_ < NREP(16); ++rep_) {
        pg8::Gemm g{U, (const bf16_t*)(ws + WS_WFIT), MP, NFI, D / 2, (const float*)(ws + WS_CTL + CT_SA), (const float*)(ws + WS_CTL + CT_SB_F)}; pg8::StaticOrder S; S.init(MP, NFI, G, (int)blockIdx.x);
        pg8::EpiConvAct E{(bf16_t*)(ws + WS_ACT), DFF, (float*)(ws + WS_ZF), NFI, p.in[I_CW], p.in[I_CB], DFF, (PG8_LAS float*)(lds + 131072), (const float*)(ws + WS_CTL + CT_SAG), (const float*)(ws + WS_CTL + CT_SB_F)};
        pg8::gemm_phase<pg8::EpiConvAct, pg8::StaticOrder, true, true, true>(lds, g, S, E);
        if (rep_ == NREP(16) - 1) SEAM(16);
    }
    if (IN(17)) _Pragma("unroll") for (int rep_ = 0; rep_ < NREP(17); ++rep_) { p_conv_fix(p, G); if (rep_ == NREP(17) - 1) SEAM(17); }
    if (IN(18)) _Pragma("unroll") for (int rep_ = 0; rep_ < NREP(18); ++rep_) {
        pg8::Gemm g{(const bf16_t*)(ws + WS_ACT) + (size_t)NMETA * DFF, (const bf16_t*)(ws + WS_WFOT), SEQ, D, DFF}; pg8::StaticOrder S; S.init(SEQ, D, G, (int)blockIdx.x);
        pg8::EpiResid E{p.out, p.out, p.out, p.out, D, 0, SEQ};
        pg8::gemm_phase<pg8::EpiResid, pg8::StaticOrder, true, true>(lds, g, S, E);
        if (rep_ == NREP(18) - 1) SEAM(18);
    }
    if (IN(19)) _Pragma("unroll") for (int rep_ = 0; rep_ < NREP(19); ++rep_) { p18_final_norm(p, G); }
#if STAMP_A0 >= 0
    if (blockIdx.x == 0 && threadIdx.x == 0) { const unsigned long long t_end = __builtin_amdgcn_s_memrealtime(); unsigned long long dA = (tsA1 - tsA0) * 64ull;
#if defined(ATT_REG) && ATT_REG > 0
        dA = (unsigned long long)__hip_atomic_load((const unsigned*)(ws + WS_CTL) + 65540, __ATOMIC_RELAXED, __HIP_MEMORY_SCOPE_AGENT) * 64ull;
#endif
        while (__builtin_amdgcn_s_memrealtime() - t_end < dA) __builtin_amdgcn_s_sleep(8); }
#endif
#undef IN
#undef SEAM
}

extern "C" void kernel_launch(void* const* d_in, const int* in_sizes, int n_in, void* d_out, int out_size, void* d_ws, size_t ws_size, hipStream_t stream) {
    static int grid = 0;
    if (grid == 0) {
        if (n_in != 30 || out_size != SEQ * D || ws_size < WS_END2) { fprintf(stderr, "kernel_launch: unexpected shapes (n_in %d out %d ws %zu need %zu)\n", n_in, out_size, ws_size, (size_t)WS_END); grid = -1; return; }
        int dev = 0, cus = 0, per_cu = 0;
        if (hipGetDevice(&dev) != hipSuccess || hipDeviceGetAttribute(&cus, hipDeviceAttributeMultiprocessorCount, dev) != hipSuccess) { grid = -1; return; }
        if (hipFuncSetAttribute((const void*)fwd_kernel, hipFuncAttributeMaxDynamicSharedMemorySize, LDS_BYTES) != hipSuccess) { fprintf(stderr, "kernel_launch: hipFuncSetAttribute failed\n"); grid = -1; return; }
        if (hipOccupancyMaxActiveBlocksPerMultiprocessor(&per_cu, (const void*)fwd_kernel, NT, LDS_BYTES) != hipSuccess || per_cu < 1) fprintf(stderr, "kernel_launch: occupancy query says %d\n", per_cu);
        (void)hipGetLastError();
        grid = cus;
    }
    if (grid < 0) return;
    (void)hipMemsetAsync((char*)d_ws + WS_CTL, 0, CTL_BYTES, stream);
    P a{};
    for (int i = 0; i < 30; ++i) a.in[i] = (const float*)d_in[i];
    a.out = (float*)d_out; a.ws = (unsigned char*)d_ws;
#if MK_ONE_LAUNCH
    a.ph_lo = 0; a.ph_hi = NPHASE;
    hipLaunchKernelGGL(fwd_kernel, dim3(grid), dim3(NT), LDS_BYTES, stream, a);
#else
    for (int k = 0; k < NPHASE; ++k) { a.ph_lo = k; a.ph_hi = k + 1; hipLaunchKernelGGL(fwd_kernel, dim3(grid), dim3(NT), LDS_BYTES, stream, a); }
#endif
}
```

```cpp
#include <hip/hip_runtime.h>
#include <cstdio>
#include <cstdint>
#define MK_ONE_LAUNCH 1
namespace pg8 {
#define PG8_LAS __attribute__((address_space(3)))
typedef unsigned short bf16_t;
typedef short bf16x8 __attribute__((ext_vector_type(8)));
typedef float f32x4 __attribute__((ext_vector_type(4)));
typedef unsigned u32x4 __attribute__((ext_vector_type(4)));
typedef int i32x4 __attribute__((ext_vector_type(4)));
constexpr int BM = 256, BK = 64, HALF = 128, HTB = HALF * BK * 2  , STAGE_BYTES = 8 * HTB, NXCD = 8, WGM = 4;

__host__ __device__ __forceinline__ int lds_byte(int r, int c) { const int st = (r >> 4) * 2 + (c >> 5), rr = r & 15, cc = c & 31, ob = rr * 64 + cc * 2; return st * 1024 + (ob ^ (((ob >> 9) & 1) << 5)); }
__host__ __device__ __forceinline__ void stage_rc(int b, int& R, int& C) { const int st = b / 1024, sb = b % 1024, swz = sb ^ (((sb >> 9) & 1) << 5); R = (st >> 1) * 16 + swz / 64; C = (st & 1) * 32 + (swz % 64) / 2; }
__host__ __device__ __forceinline__ int perm32(int rho) { const int n = rho >> 4, i = rho & 15; return 8 * (i >> 2) + 4 * n + (i & 3); }

struct Unit { int pm, pn; };
struct Gemm { const bf16_t* A; const bf16_t* Bt; int M, N, K; const float* sa; const float* sb; };

struct StaticOrder {
    int nM, nN, nwg, G, c;
    __host__ __device__ void init(int M, int N, int G_, int c_) { nM = M / BM; nN = N / BM; nwg = nM * nN; G = G_; c = c_; }
    __host__ __device__ bool next(int i, Unit& u) const {
        const long L = (long)i * G + c; if (L >= nwg) return false;
        int wgid = (int)L; { const int q = nwg / NXCD, r = nwg % NXCD, xcd = wgid % NXCD, off = wgid / NXCD; wgid = (xcd < r ? xcd * (q + 1) : r * (q + 1) + (xcd - r) * q) + off; }
        const int nig = WGM * nN, gid = wgid / nig, fm = gid * WGM, gsz = (nM - fm) < WGM ? (nM - fm) : WGM;
        u.pm = fm + ((wgid % nig) % gsz); u.pn = (wgid % nig) / gsz; return true;
    }
    __device__ __forceinline__ void a_ready(const Unit&) const {}
    __device__ __forceinline__ void done(const Unit&) const {}
};

__device__ __forceinline__ unsigned cvt_pk_bf16(float lo, float hi) { unsigned r; asm volatile("v_cvt_pk_bf16_f32 %0, %1, %2" : "=v"(r) : "v"(lo), "v"(hi)); return r; }
typedef float f32x2 __attribute__((ext_vector_type(2)));

typedef unsigned u32x2 __attribute__((ext_vector_type(2)));
__device__ __forceinline__ float bf_lo(unsigned w) { return __uint_as_float(w << 16); }
__device__ __forceinline__ float bf_hi(unsigned w) { return __uint_as_float(w & 0xffff0000u); }
__device__ __forceinline__ float sigmoidf_(float x) { return 1.f / (1.f + __expf(-x)); }

template <int ACT> struct EpiBf16 {
    static constexpr bool PERM = true, AFTER_DRAIN = false, SELF_SCALE = false;
    bf16_t* O; int ldc;
    __device__ __forceinline__ void operator()(const f32x4 (&acc)[2][2][4][2], const Unit& u, int wr, int wc, int fr, int fq) const {
        const int row0 = u.pm * BM + wr * 64 + fr; const int col0 = u.pn * BM + wc * 32 + 8 * fq;
#pragma unroll
        for (int ai = 0; ai < 2; ++ai)
#pragma unroll
            for (int m = 0; m < 4; ++m) { bf16_t* rowp = O + (size_t)(row0 + ai * HALF + m * 16) * ldc + col0;
#pragma unroll
                for (int bj = 0; bj < 2; ++bj) { f32x4 v0 = acc[ai][bj][m][0], v1 = acc[ai][bj][m][1];
                    if (ACT == 1) {
#pragma unroll
                        for (int e = 0; e < 4; ++e) { v0[e] = sigmoidf_(v0[e]); v1[e] = sigmoidf_(v1[e]); } }
                    u32x4 w; w.x = cvt_pk_bf16(v0[0], v0[1]); w.y = cvt_pk_bf16(v0[2], v0[3]); w.z = cvt_pk_bf16(v1[0], v1[1]); w.w = cvt_pk_bf16(v1[2], v1[3]);
                    *(u32x4*)(rowp + bj * HALF) = w; } }
    }
};
struct EpiGateMulF32 {
    static constexpr bool PERM = true, AFTER_DRAIN = false, SELF_SCALE = false;
    bf16_t* MA; int ldc; const bf16_t* G; int ldg; int gcol0;
    __device__ __forceinline__ void operator()(const f32x4 (&acc)[2][2][4][2], const Unit& u, int wr, int wc, int fr, int fq) const {
        const int row0 = u.pm * BM + wr * 64 + fr, col0 = u.pn * BM + wc * 32 + 8 * fq;
#pragma unroll
        for (int ai = 0; ai < 2; ++ai)
#pragma unroll
            for (int m = 0; m < 4; ++m) { const size_t r = (size_t)(row0 + ai * HALF + m * 16); bf16_t* rowp = MA + r * ldc + col0; const bf16_t* gp = G + r * ldg + gcol0 + col0;
#pragma unroll
                for (int bj = 0; bj < 2; ++bj) { const u32x4 g = *(const u32x4*)(gp + bj * HALF); const f32x4 a0 = acc[ai][bj][m][0], a1 = acc[ai][bj][m][1];
                    u32x4 w; w.x = cvt_pk_bf16(a0[0] * bf_lo(g.x), a0[1] * bf_hi(g.x)); w.y = cvt_pk_bf16(a0[2] * bf_lo(g.y), a0[3] * bf_hi(g.y));
                    w.z = cvt_pk_bf16(a1[0] * bf_lo(g.z), a1[1] * bf_hi(g.z)); w.w = cvt_pk_bf16(a1[2] * bf_lo(g.w), a1[3] * bf_hi(g.w));
                    *(u32x4*)(rowp + bj * HALF) = w; } }
    }
};
struct EpiGateMulAddBf16 {
    static constexpr bool PERM = true, AFTER_DRAIN = false, SELF_SCALE = false;
    bf16_t* MB; int ldc; const bf16_t* MA; const bf16_t* G; int ldg; int gcol0;
    __device__ __forceinline__ void operator()(const f32x4 (&acc)[2][2][4][2], const Unit& u, int wr, int wc, int fr, int fq) const {
        const int row0 = u.pm * BM + wr * 64 + fr, col0 = u.pn * BM + wc * 32 + 8 * fq;
#pragma unroll
        for (int ai = 0; ai < 2; ++ai)
#pragma unroll
            for (int m = 0; m < 4; ++m) { const size_t r = (size_t)(row0 + ai * HALF + m * 16); bf16_t* rowp = MB + r * ldc + col0; const bf16_t* mp = MA + r * ldc + col0; const bf16_t* gp = G + r * ldg + gcol0 + col0;
#pragma unroll
                for (int bj = 0; bj < 2; ++bj) { const u32x4 g = *(const u32x4*)(gp + bj * HALF); const u32x4 mm = *(const u32x4*)(mp + bj * HALF);
                    const f32x4 a0 = acc[ai][bj][m][0], a1 = acc[ai][bj][m][1];
                    u32x4 w; w.x = cvt_pk_bf16(bf_lo(mm.x) + a0[0] * bf_lo(g.x), bf_hi(mm.x) + a0[1] * bf_hi(g.x)); w.y = cvt_pk_bf16(bf_lo(mm.y) + a0[2] * bf_lo(g.y), bf_hi(mm.y) + a0[3] * bf_hi(g.y));
                    w.z = cvt_pk_bf16(bf_lo(mm.z) + a1[0] * bf_lo(g.z), bf_hi(mm.z) + a1[1] * bf_hi(g.z)); w.w = cvt_pk_bf16(bf_lo(mm.w) + a1[2] * bf_lo(g.w), bf_hi(mm.w) + a1[3] * bf_hi(g.w));
                    *(u32x4*)(rowp + bj * HALF) = w; } }
    }
};
struct EpiResid {
    static constexpr bool PERM = false, AFTER_DRAIN = false, SELF_SCALE = false;
    const float* smeta; const float* sreal; float* dmeta; float* dreal; int ld; int nmeta; int nrows;
    __device__ __forceinline__ void operator()(const f32x4 (&acc)[2][2][4][2], const Unit& u, int wr, int wc, int fr, int fq) const {
        const int row0 = u.pm * BM + wr * 64 + fr, col0 = u.pn * BM + wc * 32 + 4 * fq;
#pragma unroll
        for (int ai = 0; ai < 2; ++ai)
#pragma unroll
            for (int m = 0; m < 4; ++m) { const int r = row0 + ai * HALF + m * 16;
                if (r < nrows) {
                    const float* sp = (r < nmeta ? smeta + (size_t)r * ld : sreal + (size_t)(r - nmeta) * ld) + col0;
                    float* dp = (r < nmeta ? dmeta + (size_t)r * ld : dreal + (size_t)(r - nmeta) * ld) + col0;
#pragma unroll
                    for (int bj = 0; bj < 2; ++bj)
#pragma unroll
                        for (int n = 0; n < 2; ++n) *(f32x4*)(dp + bj * HALF + n * 16) = *(const f32x4*)(sp + bj * HALF + n * 16) + acc[ai][bj][m][n];
                } }
    }
};

template <int CTRL> __device__ __forceinline__ float dpp_mov(float v) { return __builtin_bit_cast(float, __builtin_amdgcn_update_dpp(0, __builtin_bit_cast(int, v), CTRL, 0xf, 0xf, false)); }
struct EpiConvAct {
    static constexpr bool PERM = true, AFTER_DRAIN = false, SELF_SCALE = true;
    bf16_t* ACT; int ldact; float* HALO; int ldh; const float* cw; const float* cb; int dff; PG8_LAS float* hx; const float* sag; const float* sb;
    __device__ __forceinline__ void operator()(const f32x4 (&acc)[2][2][4][2], const Unit& u, int wr, int wc, int fr, int fq) const {
        const int cl = wc * 32 + 8 * fq;
        const int ch = u.pn * 128 + cl;
        if (fr >= 14) {
#pragma unroll
            for (int ai = 0; ai < 2; ++ai)
#pragma unroll
                for (int bj = 0; bj < 2; ++bj)
#pragma unroll
                    for (int n = 0; n < 2; ++n) *(PG8_LAS f32x4*)(hx + (((ai * 2 + wr) * 2 + (fr - 14)) * 256 + bj * 128 + cl + 4 * n)) = acc[ai][bj][3][n];
        }
        if (wr == 0 && fr < 2) {
            float* hp = HALO + ((size_t)u.pm * 4 + fr) * ldh + u.pn * 256 + cl;
#pragma unroll
            for (int bj = 0; bj < 2; ++bj)
#pragma unroll
                for (int n = 0; n < 2; ++n) *(f32x4*)(hp + bj * 128 + 4 * n) = acc[0][bj][0][n] * (*(const f32x4*)(sb + u.pn * 256 + bj * 128 + cl + 4 * n) * sag[0]);
        }
        if (wr == 1 && fr >= 14) {
            float* hp = HALO + ((size_t)u.pm * 4 + (fr - 12)) * ldh + u.pn * 256 + cl;
#pragma unroll
            for (int bj = 0; bj < 2; ++bj)
#pragma unroll
                for (int n = 0; n < 2; ++n) *(f32x4*)(hp + bj * 128 + 4 * n) = acc[1][bj][3][n] * (*(const f32x4*)(sb + u.pn * 256 + bj * 128 + cl + 4 * n) * sag[0]);
        }
        asm volatile("s_waitcnt lgkmcnt(0)" ::: "memory"); __builtin_amdgcn_s_barrier(); asm volatile("" ::: "memory");
#pragma unroll
        for (int n = 0; n < 2; ++n) {
            f32x4 wt[2][3], bb[2];
#pragma unroll
            for (int bj = 0; bj < 2; ++bj) { bb[bj] = *(const f32x4*)(cb + bj * dff + ch + 4 * n);
#pragma unroll
                for (int i = 0; i < 3; ++i) wt[bj][i] = *(const f32x4*)(cw + (size_t)i * 2 * dff + bj * dff + ch + 4 * n) * (*(const f32x4*)(sb + u.pn * 256 + bj * 128 + cl + 4 * n) * sag[0]); }
#pragma unroll
            for (int ai = 0; ai < 2; ++ai) {
                const bool hasprev = (ai | wr) != 0; const int pb = ai * 2 + wr - 1;
                f32x4 xp[2];
#pragma unroll
                for (int bj = 0; bj < 2; ++bj) { xp[bj] = (f32x4){0.f, 0.f, 0.f, 0.f};
                    if (hasprev && fr >= 14) xp[bj] = *(const PG8_LAS f32x4*)(hx + ((pb * 2 + (fr - 14)) * 256 + bj * 128 + cl + 4 * n)); }
#pragma unroll
                for (int m = 0; m < 4; ++m) {
                    f32x4 z[2];
#pragma unroll
                    for (int bj = 0; bj < 2; ++bj) {
                        const f32x4 x = acc[ai][bj][m][n];
#pragma unroll
                        for (int j = 0; j < 4; ++j) {
                            const float a1 = dpp_mov<0x121>(x[j]), p1 = dpp_mov<0x121>(xp[bj][j]), a2 = dpp_mov<0x122>(x[j]), p2 = dpp_mov<0x122>(xp[bj][j]);
                            const float s1 = fr == 0 ? p1 : a1, s2 = fr < 2 ? p2 : a2;
                            z[bj][j] = bb[bj][j] + wt[bj][2][j] * x[j] + wt[bj][1][j] * s1 + wt[bj][0][j] * s2;
                        }
                        xp[bj] = x;
                    }
                    const int r = u.pm * BM + ai * HALF + wr * 64 + m * 16 + fr;
                    float o[4];
#pragma unroll
                    for (int j = 0; j < 4; ++j) { const float g = z[0][j]; o[j] = g * __builtin_amdgcn_rcpf(1.f + __expf(-g)) * z[1][j]; }
                    u32x2 w; w.x = cvt_pk_bf16(o[0], o[1]); w.y = cvt_pk_bf16(o[2], o[3]);
                    *(u32x2*)(ACT + (size_t)r * ldact + ch + 4 * n) = w;
                }
                asm volatile("" ::: "memory");
            }
        }
    }
};
template <class Epi, class Sched, bool ALIGN_EPI = false, bool SP2 = false, bool I8 = false>
__device__ __forceinline__ void gemm_phase(PG8_LAS unsigned char* lds, const Gemm g, const Sched& S, const Epi& E) {
    const int tid = threadIdx.x, wid = __builtin_amdgcn_readfirstlane(tid >> 6), lane = tid & 63, wr = wid >> 2, wc = wid & 3, fr = lane & 15, fq = lane >> 4;
    const int K = g.K, nt = K / BK;
    unsigned voffA[2], voffB[2];
#pragma unroll
    for (int i = 0; i < 2; ++i) { int R, C; stage_rc(tid * 16 + i * 8192, R, C); const int Rb = Epi::PERM ? ((R & ~31) + perm32(R & 31)) : R;
        voffA[i] = (unsigned)(R * K + C) * 2u; voffB[i] = (unsigned)(Rb * K + C) * 2u; }
    const size_t kstep = (size_t)(BK * 2);
    const size_t hstep = (size_t)HALF * K * 2;
    const size_t tstep = 2 * hstep;
    const unsigned ldsw = (unsigned)wid * 1024u;
    const int aoff = lds_byte(wr * 64 + fr, fq * 8), boff = lds_byte(wc * 32 + fr, fq * 8);
#define PG8_SA(b, h) (((b) * 2 + (h)) * HTB)
#define PG8_SB(b, h) ((4 + (b) * 2 + (h)) * HTB)
#define PG8_STAGE(bufoff, gbase, voff) do { _Pragma("unroll") for (int _i = 0; _i < 2; ++_i) \
        __builtin_amdgcn_global_load_lds((const unsigned*)((const char*)(gbase) + (voff)[_i]), (PG8_LAS unsigned*)(lds + (bufoff) + ldsw + _i * 8192), 16, 0, 0); } while (0)
#define PG8_LDA(dst, b, h) do { _Pragma("unroll") for (int m = 0; m < 4; ++m) _Pragma("unroll") for (int k = 0; k < 2; ++k) dst[m][k] = *(const PG8_LAS bf16x8*)(lds + PG8_SA(b, h) + aoff + m * 2048 + k * 1024); } while (0)
#define PG8_LDB(dst, b, h) do { _Pragma("unroll") for (int n = 0; n < 2; ++n) _Pragma("unroll") for (int k = 0; k < 2; ++k) dst[n][k] = *(const PG8_LAS bf16x8*)(lds + PG8_SB(b, h) + boff + n * 2048 + k * 1024); } while (0)
#define PG8_MMA(ai, bj, At, Bt) do { __builtin_amdgcn_s_setprio(1); _Pragma("unroll") for (int m = 0; m < 4; ++m) _Pragma("unroll") for (int n = 0; n < 2; ++n) _Pragma("unroll") for (int k = 0; k < 2; ++k) { \
        if constexpr (I8) acc[ai][bj][m][n] = __builtin_bit_cast(f32x4, __builtin_amdgcn_mfma_i32_16x16x64_i8(__builtin_bit_cast(i32x4, Bt[n][k]), __builtin_bit_cast(i32x4, At[m][k]), __builtin_bit_cast(i32x4, acc[ai][bj][m][n]), 0, 0, 0)); \
        else acc[ai][bj][m][n] = __builtin_amdgcn_mfma_f32_16x16x32_bf16(Bt[n][k], At[m][k], acc[ai][bj][m][n], 0, 0, 0); } __builtin_amdgcn_s_setprio(0); } while (0)
#define PG8_WAIT_V(n) asm volatile("s_waitcnt vmcnt(" #n ")" ::: "memory")
#define PG8_WAIT_L(n) asm volatile("s_waitcnt lgkmcnt(" #n ")" ::: "memory")
#define PG8_BAR __builtin_amdgcn_s_barrier()
#define PG8_SCHED __builtin_amdgcn_sched_barrier(0)
    Unit cur, nxt; int ui = 0;
    if (!S.next(0, cur)) return;
    f32x4 acc[2][2][4][2];
#pragma unroll
    for (int a = 0; a < 2; ++a)
#pragma unroll
        for (int b = 0; b < 2; ++b)
#pragma unroll
            for (int m = 0; m < 4; ++m)
#pragma unroll
                for (int n = 0; n < 2; ++n) acc[a][b][m][n] = (f32x4){0.f, 0.f, 0.f, 0.f};
    bf16x8 At[4][2], B0[2][2], B1[2][2];
    const char* cA = (const char*)g.A + (size_t)cur.pm * tstep; const char* cB = (const char*)g.Bt + (size_t)cur.pn * tstep;
    S.a_ready(cur);
    if constexpr (SP2) {
        PG8_STAGE(PG8_SB(0, 0), cB, voffB); PG8_STAGE(PG8_SB(0, 1), cB + hstep, voffB); PG8_STAGE(PG8_SA(0, 0), cA, voffA); PG8_STAGE(PG8_SA(0, 1), cA + hstep, voffA);
        if (wr == 1) PG8_BAR;
        PG8_WAIT_V(2); PG8_BAR;
        PG8_STAGE(PG8_SB(1, 0), cB + kstep, voffB); PG8_STAGE(PG8_SA(1, 0), cA + kstep, voffA); PG8_STAGE(PG8_SB(1, 1), cB + hstep + kstep, voffB);
        PG8_WAIT_V(6); PG8_BAR;
    } else {
        PG8_STAGE(PG8_SB(0, 0), cB, voffB); PG8_STAGE(PG8_SA(0, 0), cA, voffA); PG8_STAGE(PG8_SB(0, 1), cB + hstep, voffB); PG8_STAGE(PG8_SA(0, 1), cA + hstep, voffA);
        if (wr == 1) PG8_BAR;
        PG8_WAIT_V(4); PG8_BAR;
        PG8_STAGE(PG8_SB(1, 0), cB + kstep, voffB); PG8_STAGE(PG8_SA(1, 0), cA + kstep, voffA); PG8_STAGE(PG8_SB(1, 1), cB + hstep + kstep, voffB);
        PG8_WAIT_V(6); PG8_BAR;
    }
    for (;;) {
        const bool has_next = S.next(ui + 1, nxt);
        const char* nA = has_next ? (const char*)g.A + (size_t)nxt.pm * tstep : cA; const char* nB = has_next ? (const char*)g.Bt + (size_t)nxt.pn * tstep : cB;
        for (int t = 0; t < nt; t += 2) {
            const bool last = (t == nt - 2);
            const char* a1 = cA + (size_t)(t + 1) * kstep;
            const char* a2 = last ? nA : cA + (size_t)(t + 2) * kstep; const char* b2 = last ? nB : cB + (size_t)(t + 2) * kstep;
            const char* a3 = a2 + kstep; const char* b3 = b2 + kstep;
            if (last && has_next) S.a_ready(nxt);
            if constexpr (SP2) {
            PG8_LDB(B0, 0, 0); PG8_LDB(B1, 0, 1); PG8_SCHED; PG8_LDA(At, 0, 0); PG8_STAGE(PG8_SA(1, 1), a1 + hstep, voffA);
            PG8_WAIT_V(8); PG8_WAIT_L(0); PG8_BAR; PG8_MMA(0, 0, At, B0); PG8_MMA(0, 1, At, B1); PG8_BAR; PG8_SCHED;
            PG8_LDA(At, 0, 1); PG8_STAGE(PG8_SB(0, 0), b2, voffB); PG8_STAGE(PG8_SB(0, 1), b2 + hstep, voffB); PG8_STAGE(PG8_SA(0, 0), a2, voffA);
            PG8_WAIT_V(8); PG8_WAIT_L(0); PG8_BAR; PG8_MMA(1, 0, At, B0); PG8_MMA(1, 1, At, B1); PG8_BAR; PG8_SCHED;
            PG8_LDB(B0, 1, 0); PG8_LDB(B1, 1, 1); PG8_SCHED; PG8_LDA(At, 1, 0); PG8_STAGE(PG8_SA(0, 1), a2 + hstep, voffA);
            PG8_WAIT_V(8); PG8_WAIT_L(0); PG8_BAR; PG8_MMA(0, 0, At, B0); PG8_MMA(0, 1, At, B1); PG8_BAR; PG8_SCHED;
            PG8_LDA(At, 1, 1); PG8_STAGE(PG8_SB(1, 0), b3, voffB); PG8_STAGE(PG8_SB(1, 1), b3 + hstep, voffB); PG8_STAGE(PG8_SA(1, 0), a3, voffA);
            PG8_WAIT_V(8); PG8_WAIT_L(0); PG8_BAR; PG8_MMA(1, 0, At, B0); PG8_MMA(1, 1, At, B1); PG8_BAR; PG8_SCHED;
            } else {
            PG8_LDB(B0, 0, 0); PG8_SCHED; PG8_LDA(At, 0, 0); PG8_STAGE(PG8_SA(1, 1), a1 + hstep, voffA);
            PG8_WAIT_L(8); PG8_BAR; PG8_WAIT_L(0); PG8_MMA(0, 0, At, B0); PG8_BAR; PG8_SCHED;
            PG8_LDB(B1, 0, 1); PG8_STAGE(PG8_SB(0, 0), b2, voffB);
            PG8_BAR; PG8_WAIT_L(0); PG8_MMA(0, 1, At, B1); PG8_BAR;
            PG8_LDA(At, 0, 1); PG8_STAGE(PG8_SA(0, 0), a2, voffA);
            PG8_BAR; PG8_WAIT_L(0); PG8_MMA(1, 0, At, B0); PG8_BAR; PG8_SCHED;
            PG8_STAGE(PG8_SB(0, 1), b2 + hstep, voffB);
            PG8_WAIT_V(6); PG8_BAR; PG8_MMA(1, 1, At, B1); PG8_BAR;
            PG8_LDB(B0, 1, 0); PG8_SCHED; PG8_LDA(At, 1, 0); PG8_STAGE(PG8_SA(0, 1), a2 + hstep, voffA);
            PG8_WAIT_L(8); PG8_BAR; PG8_WAIT_L(0); PG8_MMA(0, 0, At, B0); PG8_BAR; PG8_SCHED;
            PG8_LDB(B1, 1, 1); PG8_STAGE(PG8_SB(1, 0), b3, voffB);
            PG8_BAR; PG8_WAIT_L(0); PG8_MMA(0, 1, At, B1); PG8_BAR;
            PG8_LDA(At, 1, 1); PG8_STAGE(PG8_SA(1, 0), a3, voffA);
            PG8_BAR; PG8_WAIT_L(0); PG8_MMA(1, 0, At, B0); PG8_BAR; PG8_SCHED;
            PG8_STAGE(PG8_SB(1, 1), b3 + hstep, voffB);
            PG8_WAIT_V(6); PG8_BAR; PG8_MMA(1, 1, At, B1); PG8_BAR;
            }
        }
        if constexpr (ALIGN_EPI) { if (wr == 0) PG8_BAR; }
        if constexpr (I8) {
            asm volatile("s_nop 15\n\ts_nop 15" ::: "memory");
#pragma unroll
            for (int ai = 0; ai < 2; ++ai)
#pragma unroll
                for (int bj = 0; bj < 2; ++bj)
#pragma unroll
                    for (int m = 0; m < 4; ++m)
#pragma unroll
                        for (int n = 0; n < 2; ++n)
#pragma unroll
                            for (int j = 0; j < 4; ++j) { float x = acc[ai][bj][m][n][j]; asm volatile("v_cvt_f32_i32 %0, %0" : "+v"(x)); acc[ai][bj][m][n][j] = x; }
            if constexpr (!Epi::SELF_SCALE) {
                const int row0 = cur.pm * BM + wr * 64 + fr, col0 = cur.pn * BM + wc * 32 + (Epi::PERM ? 8 * fq : 4 * fq);
#pragma unroll
                for (int bj = 0; bj < 2; ++bj)
#pragma unroll
                    for (int n = 0; n < 2; ++n) { const f32x4 sc = *(const f32x4*)(g.sb + col0 + bj * HALF + (Epi::PERM ? 4 * n : 16 * n));
#pragma unroll
                        for (int ai = 0; ai < 2; ++ai)
#pragma unroll
                            for (int m = 0; m < 4; ++m) { const float sr = g.sa[row0 + ai * HALF + m * 16]; acc[ai][bj][m][n] = acc[ai][bj][m][n] * (sc * sr); } }
            }
        }
        if constexpr (!Epi::AFTER_DRAIN) { E(acc, cur, wr, wc, fr, fq); S.done(cur); }
        if (!has_next) break;
#pragma unroll
        for (int a = 0; a < 2; ++a)
#pragma unroll
            for (int b = 0; b < 2; ++b)
#pragma unroll
                for (int m = 0; m < 4; ++m)
#pragma unroll
                    for (int n = 0; n < 2; ++n) acc[a][b][m][n] = (f32x4){0.f, 0.f, 0.f, 0.f};
        cur = nxt; cA = nA; cB = nB; ++ui;
        if constexpr (ALIGN_EPI) { if (wr == 1) PG8_BAR; }
    }
    PG8_WAIT_V(0);
    if constexpr (!ALIGN_EPI) { if (wr == 0) PG8_BAR; }
    PG8_BAR;
    if constexpr (Epi::AFTER_DRAIN) { E.fused(acc, cur, wr, wc, fr, fq, lds, wid, lane); S.done(cur); }
#undef PG8_SA
#undef PG8_SB
#undef PG8_STAGE
#undef PG8_LDA
#undef PG8_LDB
#undef PG8_MMA
#undef PG8_WAIT_V
#undef PG8_WAIT_L
#undef PG8_BAR
#undef PG8_SCHED
}
}
#define XB_TMO      128
#define XB_XCNT(j)  (256  + 64 * (j))
#define XB_XSUB(j)  (1280 + 64 * (j))
#define XB_XGEN(j)  (2304 + 64 * (j))
#define XB_TOP      3328
#define XB_TOPGEN   3392
#define XCD_BAR_WORDS 3456
#define XB_SPIN_CAP (1u << 18)
#define LAS __attribute__((address_space(3)))

__device__ __forceinline__ unsigned xb_ld(unsigned* p)              { return __hip_atomic_load(p, __ATOMIC_RELAXED, __HIP_MEMORY_SCOPE_AGENT); }
__device__ __forceinline__ unsigned xb_add(unsigned* p, unsigned v) { return __hip_atomic_fetch_add(p, v, __ATOMIC_RELAXED, __HIP_MEMORY_SCOPE_AGENT); }
__device__ __forceinline__ unsigned xb_xcc_id() { return (unsigned)__builtin_amdgcn_s_getreg((3 << 11) | 20) & 0xFu; }
#define XB_SPIN(cond, bar) do { unsigned _sp = 0; while (cond) { __builtin_amdgcn_s_sleep(1); \
    if ((++_sp & 255u) == 0u) { if (xb_ld(&(bar)[XB_TMO])) break; if (_sp > XB_SPIN_CAP) { atomicAdd(&(bar)[XB_TMO], 1u); break; } } } } while (0)

struct XcdBarrier {
    unsigned* bar; unsigned x;
    volatile LAS unsigned* st;
};

__device__ __forceinline__ XcdBarrier xcd_barrier_post(unsigned* bar, volatile LAS unsigned* st) {
    XcdBarrier b; b.bar = bar; b.x = xb_xcc_id(); b.st = st;
    if (threadIdx.x == 0) (void)xb_add(&bar[XB_XCNT(b.x)], 1u);
    return b;
}
__device__ __forceinline__ void xcd_barrier_complete(unsigned* bar, unsigned x, unsigned& nloc, unsigned& nx) {
    const unsigned G = gridDim.x * gridDim.y * gridDim.z;
    unsigned sum, cnt, mine, sp = 0u;
    for (;;) {
        sum = 0u; cnt = 0u; mine = 0u;
#pragma unroll
        for (unsigned j = 0; j < 16; ++j) { const unsigned c = xb_ld(&bar[XB_XCNT(j)]); sum += c; cnt += (c > 0u) ? 1u : 0u; mine = (j == x) ? c : mine; }
        if (sum == G) break;
        __builtin_amdgcn_s_sleep(1);
        if ((++sp & 255u) == 0u) { if (xb_ld(&bar[XB_TMO])) break; if (sp > XB_SPIN_CAP) { atomicAdd(&bar[XB_TMO], 1u); break; } }
    }
    nloc = mine > 0u ? mine : 1u; nx = cnt > 0u ? cnt : 1u;
}

__device__ __forceinline__ void xcd_barrier(const XcdBarrier& b) {
    asm volatile("s_waitcnt vmcnt(0)" ::: "memory");
    __syncthreads();
    if (threadIdx.x == 0) {
        unsigned* bar = b.bar;
        __builtin_amdgcn_s_waitcnt(0);
        unsigned nloc = b.st[0], nx = b.st[1];
        if (nloc == 0u) { xcd_barrier_complete(bar, b.x, nloc, nx); b.st[0] = nloc; b.st[1] = nx; }
        const unsigned old = xb_add(&bar[XB_XSUB(b.x)], 1u);
        const unsigned gen = old / nloc;
        if (old + 1u == (gen + 1u) * nloc) {
            __builtin_amdgcn_fence(__ATOMIC_RELEASE, "agent");
            asm volatile("s_waitcnt vmcnt(0)" ::: "memory");
            const unsigned og = xb_add(&bar[XB_TOP], 1u);
            const unsigned tg = og / nx;
            if (og + 1u == (tg + 1u) * nx) xb_add(&bar[XB_TOPGEN], 1u);
            else XB_SPIN(xb_ld(&bar[XB_TOPGEN]) == tg, bar);
            __builtin_amdgcn_fence(__ATOMIC_ACQUIRE, "agent");
            xb_add(&bar[XB_XGEN(b.x)], 1u);
            asm volatile("s_waitcnt vmcnt(0)" ::: "memory");
        } else {
            XB_SPIN(xb_ld(&bar[XB_XGEN(b.x)]) == gen, bar);
            __builtin_amdgcn_fence(__ATOMIC_ACQUIRE, "agent");
            asm volatile("s_waitcnt vmcnt(0)" ::: "memory");
        }
    }
    __syncthreads();
}

#define LAS __attribute__((address_space(3)))
typedef unsigned short bf16_t;
typedef float f32x4 __attribute__((ext_vector_type(4)));
typedef unsigned u32x4 __attribute__((ext_vector_type(4)));
typedef unsigned u32x2 __attribute__((ext_vector_type(2)));

#ifndef MK_ONE_LAUNCH
#define MK_ONE_LAUNCH 0
#endif

constexpr int NWAVES = 8, NT = NWAVES * 64;
constexpr int D = 4096, SEQ = 16384, NMETA = 16, L = SEQ + NMETA, MP = 16640;
constexpr int A_W = 2048, A_COLS = 6592, B_COLS = 4704, IN_COLS = A_COLS + B_COLS, NZ = 11520;
constexpr int ZQ = A_COLS, ZCKV = A_COLS + 2048, ZQI = A_COLS + 2560, ZKI = A_COLS + 4608, ZWI = A_COLS + 4672;
constexpr int DFF = 11008, NFI = 2 * DFF;
constexpr int KVR = 512, NH_B = 16, HD_B = 128, IDXH = 32, IDXD = 64, TOPK = 256;
constexpr int LDS_BYTES = 163840, MISC_OFF = 163584;
constexpr int NZ8 = 8960;
constexpr size_t WINT_BF_OFF = (size_t)40 << 20;

constexpr size_t al256(size_t x) { return (x + 255) & ~(size_t)255; }
constexpr size_t WS_CTL = 0, CTL_BYTES = 1u << 20;
constexpr size_t WS_WGT = WS_CTL + CTL_BYTES;
constexpr size_t WS_WPAT = WS_WGT + (size_t)8192 * 4096 * 2;
constexpr size_t WS_WPBT = WS_WPAT + (size_t)4096 * 2048 * 2;
constexpr size_t WS_WOUTT = WS_WPBT + (size_t)4096 * 2048 * 2;
constexpr size_t WS_WFIT = WS_WOUTT + (size_t)4096 * 4096 * 2;
constexpr size_t WS_WFOT = WS_WFIT + (size_t)NFI * 4096 * 2;
constexpr size_t WS_WINT = WS_WFOT + (size_t)4096 * DFF * 2;
constexpr size_t WS_U = WS_WINT + (size_t)NZ * 4096 * 2;
constexpr size_t WS_BIG = WS_U + (size_t)MP * D * 2;
constexpr size_t WS_Z = WS_BIG;
constexpr size_t WS_R1 = WS_Z + (size_t)MP * NZ * 2;
constexpr size_t R1_BYTES = (size_t)MP * D * 4;
constexpr size_t WS_LD = WS_R1;
constexpr size_t WS_AA = WS_LD + (size_t)L * A_W * 4;
constexpr size_t WS_GG = WS_AA + (size_t)L * A_W * 2;
constexpr size_t WS_QLAT = WS_R1;
constexpr size_t WS_MF = WS_R1;
constexpr size_t WS_YA = WS_R1 + R1_BYTES;
constexpr size_t WS_YB = WS_YA + (size_t)MP * A_W * 2;
constexpr size_t WS_END = WS_YB + (size_t)MP * A_W * 2;
constexpr size_t WS_GATES = WS_Z;
constexpr size_t WS_ZF = WS_BIG;
constexpr size_t WS_ACT = WS_BIG + (size_t)MP * DFF * 2;
constexpr size_t WS_CKV = WS_WINT;
constexpr size_t WS_KIDX = WS_CKV + al256((size_t)L * KVR * 2);
constexpr size_t WS_SEL = WS_KIDX + al256((size_t)L * IDXD * 4);
constexpr size_t WS_HMETA = WS_SEL + al256((size_t)L * TOPK * 4);
static_assert(WS_HMETA + (size_t)NMETA * D * 4 <= WS_U, "DSA overlays exceed WINT");
constexpr size_t WS_KIDXB = WS_HMETA + al256((size_t)NMETA * D * 4);
static_assert(WS_KIDXB + (size_t)L * IDXD * 2 <= WS_U, "KIDXB");
constexpr size_t WS_WUKB = WS_END;
constexpr size_t WS_WUVT = WS_WUKB + (size_t)16 * 512 * 128 * 2;
constexpr size_t WS_WLT = WS_WUVT + (size_t)16 * 512 * 128 * 2;
constexpr size_t WS_END2 = WS_WLT + (size_t)2048 * 448 * 2;
static_assert(WS_END2 <= (size_t)4 * 4096 * 22016 * 4, "workspace");
constexpr size_t CT_CMX_IN = 524288, CT_CMX_G = CT_CMX_IN + (size_t)NZ * 4, CT_CMX_F = CT_CMX_G + 8192 * 4, CT_SB_IN = CT_CMX_F + (size_t)NFI * 4, CT_SB_G = CT_SB_IN + (size_t)NZ * 4,
                 CT_SB_F = CT_SB_G + 8192 * 4, CT_SA = CT_SB_F + (size_t)NFI * 4, CT_AMAX = CT_SA + (size_t)MP * 4, CT_SAG = CT_AMAX + 256, CT_END = CT_SAG + 256;
static_assert(CT_END <= CTL_BYTES, "control region");
constexpr size_t WS_ST = WS_WINT;
constexpr size_t WS_BS = WS_ST + al256((size_t)257 * 32 * 4096 * 2);
static_assert(WS_BS + (size_t)L * 32 * 4 <= WS_U, "RWKV overlays exceed WINT");
static_assert((size_t)L * A_W * 4 + 2 * (size_t)L * A_W * 2 <= R1_BYTES && (size_t)L * 8192 * 2 <= R1_BYTES, "R1");
static_assert(WS_ACT + (size_t)MP * DFF * 2 <= WS_END, "ACT");
static_assert((size_t)MP * 8192 * 2 <= (size_t)MP * NZ * 2, "GATES");
static_assert(WS_END <= (size_t)4 * 4096 * 22016 * 4, "workspace");

__device__ __forceinline__ float bf2f(bf16_t b) { return __uint_as_float(((unsigned)b) << 16); }
__device__ __forceinline__ bf16_t f2bf(float f) { unsigned u = __float_as_uint(f); u += 0x7FFFu + ((u >> 16) & 1u); return (bf16_t)(u >> 16); }
__device__ __forceinline__ unsigned pk2(float lo, float hi) { return (unsigned)f2bf(lo) | ((unsigned)f2bf(hi) << 16); }
__device__ __forceinline__ float blo(unsigned w) { return __uint_as_float(w << 16); }
__device__ __forceinline__ float bhi(unsigned w) { return __uint_as_float(w & 0xffff0000u); }
__device__ __forceinline__ float sigm(float x) { return 1.f / (1.f + __expf(-x)); }
template <int CTRL> __device__ __forceinline__ float dpp_f(float v) { return __builtin_bit_cast(float, __builtin_amdgcn_update_dpp(0, __builtin_bit_cast(int, v), CTRL, 0xf, 0xf, false)); }
__device__ __forceinline__ float wave_sum(float v) {
    v += dpp_f<0xB1>(v);
    v += dpp_f<0x4E>(v);
    v += dpp_f<0x141>(v);
    v += dpp_f<0x140>(v);
    const float a = __builtin_bit_cast(float, __builtin_amdgcn_readlane(__builtin_bit_cast(int, v), 0));
    const float b = __builtin_bit_cast(float, __builtin_amdgcn_readlane(__builtin_bit_cast(int, v), 16));
    const float c = __builtin_bit_cast(float, __builtin_amdgcn_readlane(__builtin_bit_cast(int, v), 32));
    const float d = __builtin_bit_cast(float, __builtin_amdgcn_readlane(__builtin_bit_cast(int, v), 48));
    return (a + b) + (c + d);
}
__device__ __forceinline__ float wave_max(float v) {
    v = fmaxf(v, dpp_f<0xB1>(v)); v = fmaxf(v, dpp_f<0x4E>(v)); v = fmaxf(v, dpp_f<0x141>(v)); v = fmaxf(v, dpp_f<0x140>(v));
    const float a = __builtin_bit_cast(float, __builtin_amdgcn_readlane(__builtin_bit_cast(int, v), 0));
    const float b = __builtin_bit_cast(float, __builtin_amdgcn_readlane(__builtin_bit_cast(int, v), 16));
    const float c = __builtin_bit_cast(float, __builtin_amdgcn_readlane(__builtin_bit_cast(int, v), 32));
    const float d = __builtin_bit_cast(float, __builtin_amdgcn_readlane(__builtin_bit_cast(int, v), 48));
    return fmaxf(fmaxf(a, b), fmaxf(c, d));
}
#define LDS_WAIT() asm volatile("s_waitcnt lgkmcnt(0)" ::: "memory")

struct P {
    const float* in[30]; float* out; unsigned char* ws; int ph_lo, ph_hi;
};
enum { I_X = 0, I_META, I_NMW, I_WIN, I_MU, I_W0, I_W2, I_A0, I_A2, I_G2, I_KK, I_KA, I_RK, I_LNW, I_LNB, I_KVNW, I_WUK, I_WUV, I_ILNW, I_ILNB,
       I_WPA, I_WPB, I_WGATE, I_WOUT, I_NFW, I_WFI, I_CW, I_CB, I_WFO, I_NFIN };

template <int MODE>
__device__ __forceinline__ void tr_item(const float* W, int K, int N, int Npad, bf16_t* WT, LAS float* scr, int item, int lane) {
    const int nblk = Npad / 32, kb = item / nblk, nb = item % nblk, k0 = 64 * kb, n0 = 32 * nb;
    int s0 = n0; bool valid = n0 < N;
    if (MODE == 1) { const int T = n0 >> 8, w = n0 & 255; s0 = (w < 128) ? T * 128 + w : DFF + T * 128 + (w - 128); valid = true; }
    if (valid) {
#pragma unroll 8
        for (int i = 0; i < 32; ++i) { const int kk = 2 * i + (lane >> 5); scr[kk * 33 + (lane & 31)] = W[(size_t)(k0 + kk) * N + s0 + (lane & 31)]; }
    } else {
#pragma unroll 8
        for (int i = 0; i < 32; ++i) { const int kk = 2 * i + (lane >> 5); scr[kk * 33 + (lane & 31)] = 0.f; }
    }
    LDS_WAIT(); __builtin_amdgcn_wave_barrier();
    const int c = lane & 7;
#pragma unroll
    for (int j = 0; j < 4; ++j) { const int n = (lane >> 3) + 8 * j; const LAS float* s = scr + (8 * c) * 33 + n;
        u32x4 o; o.x = pk2(s[0 * 33], s[1 * 33]); o.y = pk2(s[2 * 33], s[3 * 33]); o.z = pk2(s[4 * 33], s[5 * 33]); o.w = pk2(s[6 * 33], s[7 * 33]);
        *(u32x4*)(WT + (size_t)(n0 + n) * K + k0 + 8 * c) = o; }
    LDS_WAIT(); __builtin_amdgcn_wave_barrier();
}
__device__ __forceinline__ void colmax_item(const float* W, int N, unsigned* cmx, int it) {
    const int nb = (N + 2047) / 2048, kc = it / nb, n = (it % nb) * 2048 + threadIdx.x * 4;
    if (n < N) { f32x4 m = {0.f, 0.f, 0.f, 0.f}; const float* wp = W + (size_t)kc * 32 * N + n;
#pragma unroll 8
        for (int k = 0; k < 32; ++k) { const f32x4 v = *(const f32x4*)(wp + (size_t)k * N); m.x = fmaxf(m.x, fabsf(v.x)); m.y = fmaxf(m.y, fabsf(v.y)); m.z = fmaxf(m.z, fabsf(v.z)); m.w = fmaxf(m.w, fabsf(v.w)); }
        atomicMax(cmx + n, __float_as_uint(m.x)); atomicMax(cmx + n + 1, __float_as_uint(m.y)); atomicMax(cmx + n + 2, __float_as_uint(m.z)); atomicMax(cmx + n + 3, __float_as_uint(m.w)); }
}
template <int MODE>
__device__ __forceinline__ void tr_item_i8(const float* W, int K, int N, int Npad, signed char* WT, const unsigned* cmx, float* sbdst, LAS float* scr, int item, int lane) {
    const int nblk = Npad / 32, kb = item / nblk, nb = item % nblk, k0 = 64 * kb, n0 = 32 * nb;
    int s0 = n0; bool valid = n0 < N;
    if (MODE == 1) { const int T = n0 >> 8, w = n0 & 255; s0 = (w < 128) ? T * 128 + w : DFF + T * 128 + (w - 128); valid = true; }
    if (valid) {
#pragma unroll 8
        for (int i = 0; i < 32; ++i) { const int kk = 2 * i + (lane >> 5); scr[kk * 33 + (lane & 31)] = W[(size_t)(k0 + kk) * N + s0 + (lane & 31)]; }
    } else {
#pragma unroll 8
        for (int i = 0; i < 32; ++i) { const int kk = 2 * i + (lane >> 5); scr[kk * 33 + (lane & 31)] = 0.f; }
    }
    LDS_WAIT(); __builtin_amdgcn_wave_barrier();
    const int n = lane >> 1, half = lane & 1;
    const float mx = valid ? __uint_as_float(cmx[s0 + n]) : 0.f; const float inv = mx > 0.f ? 127.f / mx : 0.f;
    unsigned o[8];
#pragma unroll
    for (int c = 0; c < 8; ++c) { unsigned w = 0u;
#pragma unroll
        for (int e = 0; e < 4; ++e) { const int qv = (int)rintf(scr[(half * 32 + c * 4 + e) * 33 + n] * inv); w |= ((unsigned)qv & 0xffu) << (8 * e); }
        o[c] = w; }
    *(u32x4*)(WT + (size_t)(n0 + n) * K + k0 + half * 32) = (u32x4){o[0], o[1], o[2], o[3]};
    *(u32x4*)(WT + (size_t)(n0 + n) * K + k0 + half * 32 + 16) = (u32x4){o[4], o[5], o[6], o[7]};
    if (kb == 0 && half == 0) sbdst[n0 + n] = mx * (1.f / 127.f);
    LDS_WAIT(); __builtin_amdgcn_wave_barrier();
}
template <bool DUAL = false> __device__ __forceinline__ void rms_row_i8(const float* src, const float* w, signed char* dst, float* sa, int lane, float eps, bf16_t* dstb = nullptr) {
    if (src == nullptr) {
        if (DUAL) {
#pragma unroll
            for (int j = 0; j < 8; ++j) *(u32x4*)(dstb + (j * 64 + lane) * 8) = (u32x4){0u, 0u, 0u, 0u}; }
#pragma unroll
        for (int j = 0; j < 4; ++j) *(u32x4*)(dst + (j * 64 + lane) * 16) = (u32x4){0u, 0u, 0u, 0u};
        if (lane == 0) *sa = 1.f;
        return;
    }
    f32x4 v[16]; float s = 0.f;
#pragma unroll
    for (int j = 0; j < 16; ++j) { v[j] = *(const f32x4*)(src + (j * 64 + lane) * 4); s += (v[j].x * v[j].x + v[j].y * v[j].y) + (v[j].z * v[j].z + v[j].w * v[j].w); }
    const float r = rsqrtf(wave_sum(s) * (1.f / D) + eps);
    float mx = 0.f;
#pragma unroll
    for (int j = 0; j < 16; ++j) { const f32x4 g = *(const f32x4*)(w + (j * 64 + lane) * 4); v[j] = v[j] * r * g; mx = fmaxf(mx, fmaxf(fmaxf(fabsf(v[j].x), fabsf(v[j].y)), fmaxf(fabsf(v[j].z), fabsf(v[j].w))));
        if (DUAL) { u32x2 o; o.x = pk2(v[j].x, v[j].y); o.y = pk2(v[j].z, v[j].w); *(u32x2*)(dstb + (j * 64 + lane) * 4) = o; } }
    mx = wave_max(mx);
    const float inv = mx > 0.f ? 127.f / mx : 0.f;
#pragma unroll
    for (int j = 0; j < 16; ++j) { const unsigned q = ((unsigned)(int)rintf(v[j].x * inv) & 0xffu) | (((unsigned)(int)rintf(v[j].y * inv) & 0xffu) << 8) | (((unsigned)(int)rintf(v[j].z * inv) & 0xffu) << 16) | (((unsigned)(int)rintf(v[j].w * inv) & 0xffu) << 24);
        *(unsigned*)(dst + (j * 64 + lane) * 4) = q; }
    if (lane == 0) *sa = mx > 0.f ? mx * (1.f / 127.f) : 1.f;
}
__device__ __forceinline__ void rms_row_bf16(const float* src, const float* w, bf16_t* dst, int lane, float eps) {
    if (src == nullptr) {
#pragma unroll
        for (int j = 0; j < 8; ++j) *(u32x4*)(dst + (j * 64 + lane) * 8) = (u32x4){0u, 0u, 0u, 0u};
        return;
    }
    f32x4 v[16]; float s = 0.f;
#pragma unroll
    for (int j = 0; j < 16; ++j) { v[j] = *(const f32x4*)(src + (j * 64 + lane) * 4); s += (v[j].x * v[j].x + v[j].y * v[j].y) + (v[j].z * v[j].z + v[j].w * v[j].w); }
    const float r = rsqrtf(wave_sum(s) * (1.f / D) + eps);
#pragma unroll
    for (int j = 0; j < 16; ++j) { const f32x4 g = *(const f32x4*)(w + (j * 64 + lane) * 4);
        u32x2 o; o.x = pk2(v[j].x * r * g.x, v[j].y * r * g.y); o.y = pk2(v[j].z * r * g.z, v[j].w * r * g.w);
        *(u32x2*)(dst + (j * 64 + lane) * 4) = o; }
}
__device__ __forceinline__ void p0_prologue_a(const P& p, LAS unsigned char* lds, int G) {
    const int tid = threadIdx.x, lane = tid & 63, wave = tid >> 6;
    LAS float* scr = (LAS float*)(lds + wave * 16384);
    const int gw = blockIdx.x * NWAVES + wave, NGW = G * NWAVES;
    unsigned char* ws = p.ws;
    {
        constexpr int C0 = 128 * ((IN_COLS + 2047) / 2048), C1 = 128 * (8192 / 2048), C2 = 128 * ((NFI + 2047) / 2048);
        for (int it = blockIdx.x; it < C0 + C1 + C2; it += G) {
            if (it < C0) colmax_item(p.in[I_WIN], IN_COLS, (unsigned*)(ws + WS_CTL + CT_CMX_IN), it);
            else if (it < C0 + C1) colmax_item(p.in[I_WGATE], 8192, (unsigned*)(ws + WS_CTL + CT_CMX_G), it - C0);
            else colmax_item(p.in[I_WFI], NFI, (unsigned*)(ws + WS_CTL + CT_CMX_F), it - C0 - C1);
        } }
    for (int it = gw; it < 16 * 32; it += NGW) { const int hh = it >> 5;
        tr_item<0>(p.in[I_WUV] + (size_t)hh * KVR * HD_B, KVR, HD_B, HD_B, (bf16_t*)(ws + WS_WUVT) + (size_t)hh * HD_B * KVR, scr, it & 31, lane); }
    for (size_t i = (size_t)blockIdx.x * NT + threadIdx.x; i < (size_t)16 * 512 * 128 / 4; i += (size_t)G * NT) {
        const f32x4 v = *(const f32x4*)(p.in[I_WUK] + i * 4); u32x2 o; o.x = pk2(v.x, v.y); o.y = pk2(v.z, v.w); *(u32x2*)((bf16_t*)(ws + WS_WUKB) + i * 4) = o; }
    for (int i = blockIdx.x * NT + threadIdx.x; i < 448 * 2048; i += G * NT) { const int j = i >> 11, c = i & 2047;
        const float v = j < 96 ? p.in[I_W2][(size_t)j * 2048 + c] : (j < 192 ? p.in[I_A2][(size_t)(j - 96) * 2048 + c] : p.in[I_G2][(size_t)(j - 192) * 2048 + c]);
        ((bf16_t*)(ws + WS_WLT))[(size_t)c * 448 + j] = f2bf(v); }
    signed char* U8 = (signed char*)(ws + WS_U); float* SA = (float*)(ws + WS_CTL + CT_SA);
    for (int m = gw; m < MP; m += NGW) {
        const float* src = m < NMETA ? p.in[I_META] + (size_t)m * D : (m < L ? p.in[I_X] + (size_t)(m - NMETA) * D : nullptr);
        rms_row_i8<true>(src, p.in[I_NMW], U8 + (size_t)m * D, SA + m, lane, 1e-6f, (bf16_t*)(ws + WS_R1) + (size_t)m * D);
    }
}
__device__ __forceinline__ void p0_prologue_b(const P& p, LAS unsigned char* lds, int G) {
    const int lane = threadIdx.x & 63, wave = threadIdx.x >> 6;
    LAS float* scr = (LAS float*)(lds + wave * 16384);
    const int gw = blockIdx.x * NWAVES + wave, NGW = G * NWAVES;
    constexpr int I0 = (4096 / 64) * (NZ / 32);
    for (int it = gw; it < I0; it += NGW) {
        const int nb = it % (NZ / 32);
        if (nb * 32 < NZ8) tr_item_i8<0>(p.in[I_WIN], 4096, IN_COLS, NZ, (signed char*)(p.ws + WS_WINT), (const unsigned*)(p.ws + WS_CTL + CT_CMX_IN), (float*)(p.ws + WS_CTL + CT_SB_IN), scr, it, lane);
        else tr_item<0>(p.in[I_WIN], 4096, IN_COLS, NZ, (bf16_t*)(p.ws + WS_WINT + WINT_BF_OFF) - (size_t)NZ8 * 4096, scr, it, lane);
    }
}
__device__ __forceinline__ void p0b_weights(const P& p, LAS unsigned char* lds, int vw, int nvw) {
    const int lane = threadIdx.x & 63, wave = threadIdx.x >> 6;
    LAS float* scr = (LAS float*)(lds + wave * 16384);
    unsigned char* ws = p.ws;
    constexpr int I1 = (4096 / 64) * (8192 / 32), I2 = (2048 / 64) * (4096 / 32), I3 = I2, I4 = (4096 / 64) * (4096 / 32), I5 = (4096 / 64) * (NFI / 32), I6 = (DFF / 64) * (4096 / 32);
    constexpr int NITEMS = I1 + I2 + I3 + I4 + I5 + I6;
    for (int it = vw; it < NITEMS; it += nvw) {
        int r = it;
        if (r < I1) { tr_item_i8<0>(p.in[I_WGATE], 4096, 8192, 8192, (signed char*)(ws + WS_WGT), (const unsigned*)(ws + WS_CTL + CT_CMX_G), (float*)(ws + WS_CTL + CT_SB_G), scr, r, lane); continue; } r -= I1;
        if (r < I2) { tr_item<0>(p.in[I_WPA], 2048, 4096, 4096, (bf16_t*)(ws + WS_WPAT), scr, r, lane); continue; } r -= I2;
        if (r < I3) { tr_item<0>(p.in[I_WPB], 2048, 4096, 4096, (bf16_t*)(ws + WS_WPBT), scr, r, lane); continue; } r -= I3;
        if (r < I4) { tr_item<0>(p.in[I_WOUT], 4096, 4096, 4096, (bf16_t*)(ws + WS_WOUTT), scr, r, lane); continue; } r -= I4;
        if (r < I5) { tr_item_i8<1>(p.in[I_WFI], 4096, NFI, NFI, (signed char*)(ws + WS_WFIT), (const unsigned*)(ws + WS_CTL + CT_CMX_F), (float*)(ws + WS_CTL + CT_SB_F), scr, r, lane); continue; } r -= I5;
        tr_item<0>(p.in[I_WFO], DFF, 4096, 4096, (bf16_t*)(ws + WS_WFOT), scr, r, lane);
    }
}

typedef short bf16x8p_t __attribute__((ext_vector_type(8)));
template <int CTRL> __device__ __forceinline__ float dpp_shr0(float v) { return __builtin_bit_cast(float, __builtin_amdgcn_update_dpp(0, __builtin_bit_cast(int, v), CTRL, 0xf, 0xf, true)); }
__device__ __forceinline__ void p2_rwkv_prep(const P& p, LAS unsigned char* lds, int G) {
    const int tid = threadIdx.x, lane = tid & 63, wave = __builtin_amdgcn_readfirstlane(tid >> 6), r16 = lane & 15, q = lane >> 4;
    const bf16_t* Z = (const bf16_t*)(p.ws + WS_Z); const bf16_t* WLT = (const bf16_t*)(p.ws + WS_WLT);
    float* CSo = (float*)(p.ws + WS_LD); bf16_t* AAo = (bf16_t*)(p.ws + WS_AA); bf16_t* GGo = (bf16_t*)(p.ws + WS_GG);
    constexpr int AST = 456;
    LAS bf16_t* act = (LAS bf16_t*)lds;
    const float* mu = p.in[I_MU] + 6144;
    for (int item = blockIdx.x; item < 256; item += G) {
        const int ct = item & 15, tr = item >> 4;
        const int ch = ct * 128 + wave * 16 + r16;
        bf16x8p_t af[14];
#pragma unroll
        for (int ks = 0; ks < 14; ++ks) af[ks] = *(const bf16x8p_t*)(WLT + (size_t)ch * 448 + ks * 32 + q * 8);
        const int c4 = ct * 128 + wave * 16 + q * 4;
        const f32x4 w0v = *(const f32x4*)(p.in[I_W0] + c4), a0v = *(const f32x4*)(p.in[I_A0] + c4);
        const int st0 = tr * 16, st1 = tr == 15 ? 257 : st0 + 16;
        for (int st = st0; st < st1; ++st) {
            const int t0 = st * 64;
            __syncthreads();
            {
                u32x4 za[7], zp[7];
#pragma unroll
                for (int k = 0; k < 7; ++k) { const int cidx = tid + k * NT, t = cidx / 56, j8 = (cidx % 56) * 8; int tg = t0 + t; if (tg > L - 1) tg = L - 1; const int tp = tg > 0 ? tg - 1 : 0;
                    za[k] = *(const u32x4*)(Z + (size_t)tg * NZ + 6144 + j8); zp[k] = *(const u32x4*)(Z + (size_t)tp * NZ + 6144 + j8); }
#pragma unroll
                for (int k = 0; k < 7; ++k) { const int cidx = tid + k * NT, t = cidx / 56, j8 = (cidx % 56) * 8, tg = t0 + t;
                    u32x4 o = (u32x4){0u, 0u, 0u, 0u};
                    if (tg < L) {
                        const f32x4 m0 = *(const f32x4*)(mu + j8), m1 = *(const f32x4*)(mu + j8 + 4);
                        const float a[8] = {blo(za[k].x), bhi(za[k].x), blo(za[k].y), bhi(za[k].y), blo(za[k].z), bhi(za[k].z), blo(za[k].w), bhi(za[k].w)};
                        float b[8] = {blo(zp[k].x), bhi(zp[k].x), blo(zp[k].y), bhi(zp[k].y), blo(zp[k].z), bhi(zp[k].z), blo(zp[k].w), bhi(zp[k].w)};
                        if (tg == 0) {
#pragma unroll
                            for (int e = 0; e < 8; ++e) b[e] = 0.f; }
                        const float m[8] = {m0.x, m0.y, m0.z, m0.w, m1.x, m1.y, m1.z, m1.w};
                        float v[8];
#pragma unroll
                        for (int e = 0; e < 8; ++e) { const float zs = a[e] + (b[e] - a[e]) * m[e]; const bool ist = j8 < 96, isi = j8 < 192;
                            const float r = __builtin_amdgcn_rcpf(1.f + __expf(ist ? 2.f * zs : -zs)); v[e] = ist ? 1.f - 2.f * r : (isi ? zs : r); }
                        o.x = pk2(v[0], v[1]); o.y = pk2(v[2], v[3]); o.z = pk2(v[4], v[5]); o.w = pk2(v[6], v[7]);
                    }
                    *(LAS u32x4*)(act + t * AST + j8) = o; }
            }
            __syncthreads();
#pragma unroll 1
            for (int nt = 0; nt < 4; ++nt) {
                f32x4 cw = {0.f, 0.f, 0.f, 0.f}, ca = cw, cg = cw;
                const LAS bf16_t* ar = act + (nt * 16 + r16) * AST + q * 8;
#pragma unroll
                for (int ks = 0; ks < 3; ++ks) cw = __builtin_amdgcn_mfma_f32_16x16x32_bf16(af[ks], *(const LAS bf16x8p_t*)(ar + ks * 32), cw, 0, 0, 0);
#pragma unroll
                for (int ks = 3; ks < 6; ++ks) ca = __builtin_amdgcn_mfma_f32_16x16x32_bf16(af[ks], *(const LAS bf16x8p_t*)(ar + ks * 32), ca, 0, 0, 0);
#pragma unroll
                for (int ks = 6; ks < 14; ++ks) cg = __builtin_amdgcn_mfma_f32_16x16x32_bf16(af[ks], *(const LAS bf16x8p_t*)(ar + ks * 32), cg, 0, 0, 0);
                f32x4 ld;
#pragma unroll
                for (int e = 0; e < 4; ++e) { const float xx = -(w0v[e] + cw[e]); const float sp = xx > 20.f ? xx : __logf(1.f + __expf(xx)); ld[e] = -__expf(-sp - 0.5f); }
#pragma unroll
                for (int e = 0; e < 4; ++e) { float x = ld[e]; x += dpp_shr0<0x111>(x); x += dpp_shr0<0x112>(x); x += dpp_shr0<0x114>(x); x += dpp_shr0<0x118>(x); ld[e] = x; }
                const int tg = t0 + nt * 16 + r16;
                if (tg < L) {
                    *(f32x4*)(CSo + (size_t)tg * A_W + c4) = ld;
                    u32x2 oa, og; oa.x = pk2(sigm(a0v[0] + ca[0]), sigm(a0v[1] + ca[1])); oa.y = pk2(sigm(a0v[2] + ca[2]), sigm(a0v[3] + ca[3]));
                    og.x = pk2(cg[0], cg[1]); og.y = pk2(cg[2], cg[3]);
                    *(u32x2*)(AAo + (size_t)tg * A_W + c4) = oa; *(u32x2*)(GGo + (size_t)tg * A_W + c4) = og;
                }
            }
        }
    }
}


typedef short bf16x8_t __attribute__((ext_vector_type(8)));
constexpr int NCHUNK = 257, NITEM = NCHUNK * 32, RS = 72, SLOT = 64 * RS * 2;
constexpr int GAM_OFF = 15 * SLOT;
constexpr size_t GTP_OFF = 0, HT_OFF = (size_t)8192 * 8192;
typedef __bf16 bf16x2v_t __attribute__((ext_vector_type(2)));
typedef float f32x2v_t __attribute__((ext_vector_type(2)));
__device__ __forceinline__ unsigned cvtpk(float lo, float hi) { const f32x2v_t v = {lo, hi}; const bf16x2v_t b = __builtin_convertvector(v, bf16x2v_t); return __builtin_bit_cast(unsigned, b); }
__device__ __forceinline__ void mm2(const LAS bf16_t* X, const LAS bf16_t* Y, int tm, int tn0, int r, int q, f32x4& c0, f32x4& c1) {
#pragma unroll
    for (int s = 0; s < 2; ++s) {
        const bf16x8_t a = *(const LAS bf16x8_t*)(X + (tm * 16 + r) * RS + s * 32 + q * 8);
        const bf16x8_t b0 = *(const LAS bf16x8_t*)(Y + (tn0 * 16 + r) * RS + s * 32 + q * 8);
        const bf16x8_t b1 = *(const LAS bf16x8_t*)(Y + ((tn0 + 1) * 16 + r) * RS + s * 32 + q * 8);
        c0 = __builtin_amdgcn_mfma_f32_16x16x32_bf16(a, b0, c0, 0, 0, 0);
        c1 = __builtin_amdgcn_mfma_f32_16x16x32_bf16(a, b1, c1, 0, 0, 0);
    }
}
__device__ __forceinline__ void st_cheap(LAS bf16_t* B, int m0, int n, const f32x4& c) {
    u32x2 w; w.x = cvtpk(c[0], c[1]); w.y = cvtpk(c[2], c[3]); *(LAS u32x2*)(B + n * RS + m0) = w;
}
__device__ __forceinline__ void st_scat(LAS bf16_t* B, int m0, int n, const f32x4& c) {
#pragma unroll
    for (int e = 0; e < 4; ++e) B[(m0 + e) * RS + n] = f2bf(c[e]);
}
template <int CTRL> __device__ __forceinline__ float dpp_add(float v) { return v + dpp_f<CTRL>(v); }
__device__ __forceinline__ float sum8(float v) { v = dpp_add<0xB1>(v); v = dpp_add<0x4E>(v); v = dpp_add<0x141>(v); return v; }

struct RaIn { u32x4 r0, k0, v0, r1, k1, v1, a0; f32x4 c0v, c1v, p0, p1, ba[3], bb[3]; };
__device__ __forceinline__ void ra_load(RaIn& I, const bf16_t* Z, const float* CS, const bf16_t* AAi, int ch, int h, int tid) {
    const int t = tid >> 3, k8 = (tid & 7) * 8, c0 = h * 64 + k8; int tg = ch * 64 + t; if (tg > L - 1) tg = L - 1; const int tp = tg > 0 ? tg - 1 : 0;
    const bf16_t* zr = Z + (size_t)tg * NZ + c0; const bf16_t* zp = Z + (size_t)tp * NZ + c0;
    I.r0 = *(const u32x4*)zr; I.k0 = *(const u32x4*)(zr + 2048); I.v0 = *(const u32x4*)(zr + 4096);
    I.r1 = *(const u32x4*)zp; I.k1 = *(const u32x4*)(zp + 2048); I.v1 = *(const u32x4*)(zp + 4096);
    I.a0 = *(const u32x4*)(AAi + (size_t)tg * A_W + c0);
    const float* cs = CS + (size_t)tg * A_W + c0; const float* cp = CS + (size_t)tp * A_W + c0;
    I.c0v = *(const f32x4*)cs; I.c1v = *(const f32x4*)(cs + 4); I.p0 = *(const f32x4*)cp; I.p1 = *(const f32x4*)(cp + 4);
#pragma unroll
    for (int b = 0; b < 3; ++b) { int rb = ch * 64 + b * 16 + 15; if (rb > L - 1) rb = L - 1; const float* ce = CS + (size_t)rb * A_W + c0; I.ba[b] = *(const f32x4*)ce; I.bb[b] = *(const f32x4*)(ce + 4); }
}
#define LDS_BARRIER() do { asm volatile("s_waitcnt lgkmcnt(0)" ::: "memory"); __builtin_amdgcn_s_barrier(); asm volatile("" ::: "memory"); } while (0)
__device__ __forceinline__ void ra_items(const P& p, LAS unsigned char* lds, int G) {
    const int tid = threadIdx.x, lane = tid & 63, wave = __builtin_amdgcn_readfirstlane(tid >> 6), r16 = lane & 15, q = lane >> 4;
    const int tm = wave >> 1, tn0 = (wave & 1) * 2;
    const bf16_t* Z = (const bf16_t*)(p.ws + WS_Z); const float* CS = (const float*)(p.ws + WS_LD); const bf16_t* AAi = (const bf16_t*)(p.ws + WS_AA);
    bf16_t* GTP = (bf16_t*)((unsigned char*)p.out + GTP_OFF); float* HT = (float*)((unsigned char*)p.out + HT_OFF);
    bf16_t* PPo = (bf16_t*)(p.ws + WS_YB); bf16_t* Y0o = (bf16_t*)(p.ws + WS_YA); float* BS = (float*)(p.ws + WS_BS);
    LAS bf16_t* sl[15];
#pragma unroll
    for (int i = 0; i < 15; ++i) sl[i] = (LAS bf16_t*)(lds + i * SLOT);
    LAS float* gam = (LAS float*)(lds + GAM_OFF);
    LAS bf16_t *Al_r = sl[0], *Be_r = sl[1], *Ka_r = sl[2], *Al_t = sl[3], *Be_t = sl[4], *Ka_t = sl[5], *Rh_r = sl[6], *V_t = sl[7];
    LAS bf16_t *N_r = sl[8], *N_t = sl[9], *LAK = sl[10], *MRK = sl[11], *MRB = sl[12], *Q_t = sl[13], *T_a = sl[14], *T_b = sl[0], *Q_r = sl[1];
    LAS bf16_t *W_t = sl[8], *X1_t = sl[9], *U0_t = sl[1];
    const bool fixed_h = (G & 31) == 0;
    const int nit = fixed_h ? (NCHUNK - (int)(blockIdx.x >> 5) + (G >> 5) - 1) / (G >> 5) : (NITEM - (int)blockIdx.x + G - 1) / G;
    auto item_of = [&](int i, int& ch, int& h) { if (fixed_h) { h = blockIdx.x & 31; ch = (int)(blockIdx.x >> 5) + i * (G >> 5); } else { const int it = (int)blockIdx.x + i * G; ch = it >> 5; h = it & 31; } };
    float pmr[8], pmk[8], pmv[8], pkk[8], pka[8], prk[8]; int h_par = -1;
    RaIn I; { int ch0, h0; item_of(0, ch0, h0); if (nit > 0) ra_load(I, Z, CS, AAi, ch0, h0, tid); }
    for (int ii = 0; ii < nit; ++ii) {
        int ch, h; item_of(ii, ch, h); const int item = ch * 32 + h;
        if (h != h_par) { const int c0 = h * 64 + (tid & 7) * 8;
#pragma unroll
            for (int e = 0; e < 8; ++e) { pmr[e] = p.in[I_MU][c0 + e]; pmk[e] = p.in[I_MU][2048 + c0 + e]; pmv[e] = p.in[I_MU][4096 + c0 + e]; pkk[e] = p.in[I_KK][c0 + e]; pka[e] = p.in[I_KA][c0 + e]; prk[e] = p.in[I_RK][c0 + e]; }
            h_par = h; }
        LDS_BARRIER();
        {
            const int t = tid >> 3, k8 = (tid & 7) * 8, tg = ch * 64 + t;
            float Av[8], Bv[8], Kv[8], Rv[8], Vv[8];
            const bool valid = tg < L, hasp = tg > 0;
            {
                float lc[8], lx[8];
                {   float base[8];
#pragma unroll
                    for (int e = 0; e < 8; ++e) base[e] = 0.f;
#pragma unroll
                    for (int b = 0; b < 3; ++b) if (b < (t >> 4)) {
#pragma unroll
                        for (int e = 0; e < 4; ++e) { base[e] += I.ba[b][e]; base[4 + e] += I.bb[b][e]; } }
                    const bool pin = (t & 15) != 0;
#pragma unroll
                    for (int e = 0; e < 4; ++e) { lc[e] = base[e] + I.c0v[e]; lc[4 + e] = base[4 + e] + I.c1v[e]; lx[e] = base[e] + (pin ? I.p0[e] : 0.f); lx[4 + e] = base[4 + e] + (pin ? I.p1[e] : 0.f); }
                }
                const unsigned rw[4] = {I.r0.x, I.r0.y, I.r0.z, I.r0.w}, kw[4] = {I.k0.x, I.k0.y, I.k0.z, I.k0.w}, vw[4] = {I.v0.x, I.v0.y, I.v0.z, I.v0.w};
                const unsigned rp[4] = {I.r1.x, I.r1.y, I.r1.z, I.r1.w}, kq[4] = {I.k1.x, I.k1.y, I.k1.z, I.k1.w}, vq[4] = {I.v1.x, I.v1.y, I.v1.z, I.v1.w}, aw[4] = {I.a0.x, I.a0.y, I.a0.z, I.a0.w};
                float rr[8], kk[8], kp[8], aa[8]; float ss = 0.f, bs = 0.f;
#pragma unroll
                for (int e = 0; e < 8; ++e) {
                    const int wi = e >> 1; const bool hi = e & 1;
                    const float zr_ = hi ? bhi(rw[wi]) : blo(rw[wi]), zk_ = hi ? bhi(kw[wi]) : blo(kw[wi]), zv_ = hi ? bhi(vw[wi]) : blo(vw[wi]);
                    float pr_ = hi ? bhi(rp[wi]) : blo(rp[wi]), pk_ = hi ? bhi(kq[wi]) : blo(kq[wi]), pv_ = hi ? bhi(vq[wi]) : blo(vq[wi]);
                    if (!hasp) { pr_ = 0.f; pk_ = 0.f; pv_ = 0.f; }
                    aa[e] = hi ? bhi(aw[wi]) : blo(aw[wi]);
                    rr[e] = zr_ + (pr_ - zr_) * pmr[e]; const float k_ = zk_ + (pk_ - zk_) * pmk[e]; Vv[e] = zv_ + (pv_ - zv_) * pmv[e];
                    kk[e] = k_ * pkk[e]; ss += kk[e] * kk[e];
                    kp[e] = k_ * (1.f + (aa[e] - 1.f) * pka[e]);
                    bs += rr[e] * kp[e] * prk[e];
                }
                ss = sum8(ss); bs = sum8(bs);
                const float rn = rsqrtf(ss + 1e-12f);
                if (valid && (tid & 7) == 0) BS[(size_t)tg * 32 + h] = bs;
#pragma unroll
                for (int e = 0; e < 8; ++e) {
                    const float kn = kk[e] * rn; const float ex = __expf(lx[e]), em = __expf(-lc[e]), ep = __expf(lc[e]);
                    Av[e] = kn * ex; Bv[e] = kn * aa[e] * em; Kv[e] = kp[e] * em; Rv[e] = rr[e] * ep;
                }
                if (t == 63) {
#pragma unroll
                    for (int e = 0; e < 8; ++e) gam[k8 + e] = __expf(valid ? lc[e] : (e < 4 ? I.c0v[e] : I.c1v[e - 4]));
                }
                if (!valid) {
#pragma unroll
                    for (int e = 0; e < 8; ++e) { Av[e] = 0.f; Bv[e] = 0.f; Kv[e] = 0.f; Rv[e] = 0.f; Vv[e] = 0.f; }
                }
            }
            u32x4 w;
            w.x = cvtpk(Av[0], Av[1]); w.y = cvtpk(Av[2], Av[3]); w.z = cvtpk(Av[4], Av[5]); w.w = cvtpk(Av[6], Av[7]); *(LAS u32x4*)(Al_r + t * RS + k8) = w;
            w.x = cvtpk(Bv[0], Bv[1]); w.y = cvtpk(Bv[2], Bv[3]); w.z = cvtpk(Bv[4], Bv[5]); w.w = cvtpk(Bv[6], Bv[7]); *(LAS u32x4*)(Be_r + t * RS + k8) = w;
            w.x = cvtpk(Kv[0], Kv[1]); w.y = cvtpk(Kv[2], Kv[3]); w.z = cvtpk(Kv[4], Kv[5]); w.w = cvtpk(Kv[6], Kv[7]); *(LAS u32x4*)(Ka_r + t * RS + k8) = w;
            w.x = cvtpk(Rv[0], Rv[1]); w.y = cvtpk(Rv[2], Rv[3]); w.z = cvtpk(Rv[4], Rv[5]); w.w = cvtpk(Rv[6], Rv[7]); *(LAS u32x4*)(Rh_r + t * RS + k8) = w;
#pragma unroll
            for (int e = 0; e < 8; ++e) { Al_t[(k8 + e) * RS + t] = f2bf(Av[e]); Be_t[(k8 + e) * RS + t] = f2bf(Bv[e]); Ka_t[(k8 + e) * RS + t] = f2bf(Kv[e]); V_t[(k8 + e) * RS + t] = f2bf(Vv[e]); }
        }
        if (ii + 1 < nit) { int ch1, h1; item_of(ii + 1, ch1, h1); ra_load(I, Z, CS, AAi, ch1, h1, tid); }
        LDS_BARRIER();
        {
            f32x4 cab0 = {0.f, 0.f, 0.f, 0.f}, cab1 = cab0, cak0 = cab0, cak1 = cab0, crk0 = cab0, crk1 = cab0, crb0 = cab0, crb1 = cab0;
            mm2(Be_r, Al_r, tm, tn0, r16, q, cab0, cab1); mm2(Ka_r, Al_r, tm, tn0, r16, q, cak0, cak1);
            mm2(Ka_r, Rh_r, tm, tn0, r16, q, crk0, crk1); mm2(Be_r, Rh_r, tm, tn0, r16, q, crb0, crb1);
            const int s0 = tm * 16 + q * 4;
#pragma unroll
            for (int j = 0; j < 2; ++j) {
                const int t = (tn0 + j) * 16 + r16;
                f32x4 ab = j ? cab1 : cab0, ak = j ? cak1 : cak0, rk = j ? crk1 : crk0, rb = j ? crb1 : crb0, nn, t0;
#pragma unroll
                for (int e = 0; e < 4; ++e) { const int s = s0 + e; nn[e] = s < t ? -ab[e] : 0.f; t0[e] = nn[e] + (s == t ? 1.f : 0.f); ak[e] = s < t ? ak[e] : 0.f; rk[e] = s <= t ? rk[e] : 0.f; rb[e] = s <= t ? rb[e] : 0.f; }
                st_cheap(N_r, s0, t, nn); st_scat(N_t, s0, t, nn); st_cheap(T_a, s0, t, t0); st_cheap(LAK, s0, t, ak); st_cheap(MRK, s0, t, rk); st_cheap(MRB, s0, t, rb);
            }
        }
        LDS_BARRIER();
        {
            LAS bf16_t* Pr = N_r; LAS bf16_t* Pt = N_t; LAS bf16_t* Qr = Q_r; LAS bf16_t* Qt = Q_t; LAS bf16_t* Tc = T_a; LAS bf16_t* Tn = T_b;
#pragma unroll 1
            for (int it = 0; it < 5; ++it) {
                {   f32x4 c0 = {0.f, 0.f, 0.f, 0.f}, c1 = c0;
                    mm2(Pr, Pt, tm, tn0, r16, q, c0, c1);
                    const int m0 = tm * 16 + q * 4;
                    st_cheap(Qt, m0, tn0 * 16 + r16, c0); st_cheap(Qt, m0, (tn0 + 1) * 16 + r16, c1);
                    st_scat(Qr, m0, tn0 * 16 + r16, c0); st_scat(Qr, m0, (tn0 + 1) * 16 + r16, c1); }
                LDS_BARRIER();
                {   f32x4 c0 = {0.f, 0.f, 0.f, 0.f}, c1 = c0;
                    mm2(Qt, Tc, tm, tn0, r16, q, c0, c1);
                    const int b0 = tm * 16 + q * 4;
#pragma unroll
                    for (int j = 0; j < 2; ++j) { const int a = (tn0 + j) * 16 + r16; const u32x2 o = *(const LAS u32x2*)(Tc + a * RS + b0); f32x4 c = j ? c1 : c0;
                        c[0] += blo(o.x); c[1] += bhi(o.x); c[2] += blo(o.y); c[3] += bhi(o.y); st_cheap(Tn, b0, a, c); } }
                LDS_BARRIER();
                LAS bf16_t* x = Pr; Pr = Qr; Qr = x; x = Pt; Pt = Qt; Qt = x; x = Tc; Tc = Tn; Tn = x;
            }
        }
        {
            f32x4 c0 = {0.f, 0.f, 0.f, 0.f}, c1 = c0, d0 = c0, d1 = c0;
            mm2(T_b, Al_t, tm, tn0, r16, q, c0, c1);
            mm2(LAK, V_t, tm, tn0, r16, q, d0, d1);
            const int t0 = tm * 16 + q * 4;
            st_cheap(W_t, t0, tn0 * 16 + r16, c0); st_cheap(W_t, t0, (tn0 + 1) * 16 + r16, c1);
            st_cheap(X1_t, t0, tn0 * 16 + r16, d0); st_cheap(X1_t, t0, (tn0 + 1) * 16 + r16, d1);
        }
        LDS_BARRIER();
        {
            f32x4 c0 = {0.f, 0.f, 0.f, 0.f}, c1 = c0;
            mm2(T_b, X1_t, tm, tn0, r16, q, c0, c1);
            const int t0 = tm * 16 + q * 4;
            st_cheap(U0_t, t0, tn0 * 16 + r16, c0); st_cheap(U0_t, t0, (tn0 + 1) * 16 + r16, c1);
        }
        LDS_BARRIER();
        {
            const int m0 = tm * 16 + q * 4;
            if (ch < 256) {
                f32x4 g0 = {0.f, 0.f, 0.f, 0.f}, g1 = g0, h0 = g0, h1 = g0, u0 = g0, u1 = g0;
                mm2(W_t, Be_t, tm, tn0, r16, q, g0, g1);
                mm2(Ka_t, V_t, tm, tn0, r16, q, h0, h1);
                mm2(Be_t, U0_t, tm, tn0, r16, q, u0, u1);
                const size_t it8 = (size_t)item;
#pragma unroll
                for (int j = 0; j < 2; ++j) {
                    const int n = (tn0 + j) * 16 + r16; const f32x4 g = j ? g1 : g0; const float gc = gam[n];
                    f32x4 o;
#pragma unroll
                    for (int e = 0; e < 4; ++e) o[e] = ((m0 + e == n ? 1.f : 0.f) - g[e]) * gc;
                    u32x2 w; w.x = cvtpk(o[0], o[1]); w.y = cvtpk(o[2], o[3]);
                    *(u32x2*)(GTP + it8 * 4096 + (size_t)n * 64 + 32 * (tm >> 1) + 8 * q + 4 * (tm & 1)) = w;
                    const f32x4 hh = (j ? h1 : h0) - (j ? u1 : u0);
                    const f32x4 gk = *(const LAS f32x4*)(gam + m0);
                    *(f32x4*)(HT + (it8 * 16 + tm * 4 + (tn0 + j)) * 256 + lane * 4) = hh * gk;
                }
            }
            f32x4 p0 = {0.f, 0.f, 0.f, 0.f}, p1 = p0, y0 = p0, y1 = p0, z0 = p0, z1 = p0;
            mm2(W_t, MRB, tm, tn0, r16, q, p0, p1);
            mm2(V_t, MRK, tm, tn0, r16, q, y0, y1);
            mm2(U0_t, MRB, tm, tn0, r16, q, z0, z1);
#pragma unroll
            for (int j = 0; j < 2; ++j) {
                const int t = (tn0 + j) * 16 + r16, tg = ch * 64 + t;
                const u32x2 o = *(const LAS u32x2*)(Rh_r + t * RS + m0); const f32x4 pm = j ? p1 : p0;
                u32x2 w; w.x = cvtpk(blo(o.x) - pm[0], bhi(o.x) - pm[1]); w.y = cvtpk(blo(o.y) - pm[2], bhi(o.y) - pm[3]);
                *(u32x2*)(PPo + (size_t)item * 4096 + t * 64 + m0) = w;
                if (tg < L) { const f32x4 yy = (j ? y1 : y0) - (j ? z1 : z0); u32x2 wy; wy.x = cvtpk(yy[0], yy[1]); wy.y = cvtpk(yy[2], yy[3]);
                    *(u32x2*)(Y0o + (size_t)tg * A_W + h * 64 + m0) = wy; }
            }
        }
    }
}

struct RbSet { bf16x8_t ga[4][2]; f32x4 hv[4]; };
__device__ __forceinline__ void rb_load(RbSet& S, const bf16_t* GTP, const float* HT, int c, int h, int vg, int lane, int r16, int q) {
    const size_t it8 = (size_t)(c < 256 ? c : 255) * 32 + h;
#pragma unroll
    for (int i = 0; i < 4; ++i) { S.hv[i] = *(const f32x4*)(HT + (it8 * 16 + i * 4 + vg) * 256 + lane * 4);
#pragma unroll
        for (int s = 0; s < 2; ++s) S.ga[i][s] = *(const bf16x8_t*)(GTP + it8 * 4096 + (size_t)(i * 16 + r16) * 64 + s * 32 + q * 8); }
}
__device__ __forceinline__ void rb_step(f32x4 (&acc)[4], const RbSet& S, bf16_t* ST, int c, int h, int vg, int r16, int q) {
    const size_t item = (size_t)c * 32 + h;
    unsigned w[8];
#pragma unroll
    for (int i = 0; i < 4; ++i) { w[2 * i] = cvtpk(acc[i][0], acc[i][1]); w[2 * i + 1] = cvtpk(acc[i][2], acc[i][3]);
        u32x2 o; o.x = w[2 * i]; o.y = w[2 * i + 1]; *(u32x2*)(ST + item * 4096 + (size_t)(vg * 16 + r16) * 64 + i * 16 + q * 4) = o; }
    const u32x4 b0 = (u32x4){w[0], w[1], w[2], w[3]}, b1 = (u32x4){w[4], w[5], w[6], w[7]};
    const bf16x8_t f0 = __builtin_bit_cast(bf16x8_t, b0), f1 = __builtin_bit_cast(bf16x8_t, b1);
#pragma unroll
    for (int i = 0; i < 4; ++i) { f32x4 a = S.hv[i];
        a = __builtin_amdgcn_mfma_f32_16x16x32_bf16(S.ga[i][0], f0, a, 0, 0, 0);
        a = __builtin_amdgcn_mfma_f32_16x16x32_bf16(S.ga[i][1], f1, a, 0, 0, 0);
        acc[i] = a; }
}
__device__ __forceinline__ void rb_chain(const P& p, int G) {
    const int tid = threadIdx.x, lane = tid & 63, wave = __builtin_amdgcn_readfirstlane(tid >> 6), r16 = lane & 15, q = lane >> 4;
    if (wave == 0) for (int cw = blockIdx.x; cw < 128; cw += G) {
        const int h = cw >> 2, vg = cw & 3;
        const bf16_t* GTP = (const bf16_t*)((const unsigned char*)p.out + GTP_OFF); const float* HT = (const float*)((const unsigned char*)p.out + HT_OFF);
        bf16_t* ST = (bf16_t*)(p.ws + WS_ST);
        f32x4 acc[4];
#pragma unroll
        for (int i = 0; i < 4; ++i) acc[i] = (f32x4){0.f, 0.f, 0.f, 0.f};
        RbSet S0, S1, S2, S3;
        rb_load(S0, GTP, HT, 0, h, vg, lane, r16, q); rb_load(S1, GTP, HT, 1, h, vg, lane, r16, q); rb_load(S2, GTP, HT, 2, h, vg, lane, r16, q); rb_load(S3, GTP, HT, 3, h, vg, lane, r16, q);
#pragma unroll 1
        for (int c = 0; c < 256; c += 4) {
            rb_step(acc, S0, ST, c, h, vg, r16, q);     rb_load(S0, GTP, HT, c + 4, h, vg, lane, r16, q);
            rb_step(acc, S1, ST, c + 1, h, vg, r16, q); rb_load(S1, GTP, HT, c + 5, h, vg, lane, r16, q);
            rb_step(acc, S2, ST, c + 2, h, vg, r16, q); rb_load(S2, GTP, HT, c + 6, h, vg, lane, r16, q);
            rb_step(acc, S3, ST, c + 3, h, vg, r16, q); rb_load(S3, GTP, HT, c + 7, h, vg, lane, r16, q);
        }
        {
            const size_t item = (size_t)256 * 32 + h;
#pragma unroll
            for (int i = 0; i < 4; ++i) { u32x2 o; o.x = cvtpk(acc[i][0], acc[i][1]); o.y = cvtpk(acc[i][2], acc[i][3]); *(u32x2*)(ST + item * 4096 + (size_t)(vg * 16 + r16) * 64 + i * 16 + q * 4) = o; }
        }
    }
}

__device__ __forceinline__ void rc_out(const P& p, int G) {
    const int tid = threadIdx.x, lane = tid & 63, wave = __builtin_amdgcn_readfirstlane(tid >> 6), r16 = lane & 15, q = lane >> 4;
    const bf16_t* Z = (const bf16_t*)(p.ws + WS_Z); const bf16_t* GGi = (const bf16_t*)(p.ws + WS_GG); const float* BS = (const float*)(p.ws + WS_BS);
    const bf16_t* ST = (const bf16_t*)(p.ws + WS_ST); const bf16_t* PPi = (const bf16_t*)(p.ws + WS_YB); bf16_t* YA = (bf16_t*)(p.ws + WS_YA);
    for (size_t i = (size_t)blockIdx.x * NT + tid; i < (size_t)(MP - L) * A_W / 8; i += (size_t)G * NT) *(u32x4*)(YA + (size_t)L * A_W + i * 8) = (u32x4){0u, 0u, 0u, 0u};
    const int tt = wave & 3;
    for (int item = blockIdx.x * 2 + (wave >> 2); item < NITEM; item += 2 * G) {
        const int ch = item >> 5, h = item & 31;
        const int t = tt * 16 + r16, tg = ch * 64 + t;
        f32x4 acc[4];
#pragma unroll
        for (int i = 0; i < 4; ++i) acc[i] = (f32x4){0.f, 0.f, 0.f, 0.f};
        const bf16_t* sp = ST + (size_t)item * 4096; const bf16_t* pp = PPi + (size_t)item * 4096 + (size_t)t * 64;
#pragma unroll
        for (int s = 0; s < 2; ++s) {
            const bf16x8_t b = *(const bf16x8_t*)(pp + s * 32 + q * 8);
#pragma unroll
            for (int i = 0; i < 4; ++i) { const bf16x8_t a = *(const bf16x8_t*)(sp + (size_t)(i * 16 + r16) * 64 + s * 32 + q * 8);
                acc[i] = __builtin_amdgcn_mfma_f32_16x16x32_bf16(a, b, acc[i], 0, 0, 0); }
        }
        if (tg < L) {
            float s1 = 0.f;
#pragma unroll
            for (int i = 0; i < 4; ++i) { const u32x2 y0 = *(const u32x2*)(YA + (size_t)tg * A_W + h * 64 + i * 16 + q * 4);
                acc[i][0] += blo(y0.x); acc[i][1] += bhi(y0.x); acc[i][2] += blo(y0.y); acc[i][3] += bhi(y0.y);
                s1 += (acc[i][0] + acc[i][1]) + (acc[i][2] + acc[i][3]); }
            s1 += __shfl_xor(s1, 16); s1 += __shfl_xor(s1, 32);
            const float mean = s1 * (1.f / 64.f);
            float s2 = 0.f;
#pragma unroll
            for (int i = 0; i < 4; ++i)
#pragma unroll
                for (int e = 0; e < 4; ++e) { const float d = acc[i][e] - mean; s2 += d * d; }
            s2 += __shfl_xor(s2, 16); s2 += __shfl_xor(s2, 32);
            const float rstd = rsqrtf(s2 * (1.f / 64.f) + 64e-5f);
            const float bs = BS[(size_t)tg * 32 + h];
#pragma unroll
            for (int i = 0; i < 4; ++i) {
                const int c = h * 64 + i * 16 + q * 4;
                const u32x2 zv = *(const u32x2*)(Z + (size_t)tg * NZ + 4096 + c);
                u32x2 pv = (u32x2){0u, 0u}; if (tg > 0) pv = *(const u32x2*)(Z + (size_t)(tg - 1) * NZ + 4096 + c);
                const u32x2 gg = *(const u32x2*)(GGi + (size_t)tg * A_W + c);
                const f32x4 lw = *(const f32x4*)(p.in[I_LNW] + c), lb = *(const f32x4*)(p.in[I_LNB] + c), mv = *(const f32x4*)(p.in[I_MU] + 4096 + c);
                const float zz[4] = {blo(zv.x), bhi(zv.x), blo(zv.y), bhi(zv.y)}, pz[4] = {blo(pv.x), bhi(pv.x), blo(pv.y), bhi(pv.y)}, gv[4] = {blo(gg.x), bhi(gg.x), blo(gg.y), bhi(gg.y)};
                float o[4];
#pragma unroll
                for (int e = 0; e < 4; ++e) { const float vv = zz[e] + (pz[e] - zz[e]) * mv[e]; const float yn = (acc[i][e] - mean) * rstd * lw[e] + lb[e]; o[e] = (yn + bs * vv) * gv[e]; }
                u32x2 w; w.x = cvtpk(o[0], o[1]); w.y = cvtpk(o[2], o[3]);
                *(u32x2*)(YA + (size_t)tg * A_W + c) = w;
            }
        }
    }
}


__device__ __forceinline__ void p4_dsa_prep(const P& p, int G) {
    const int tid = threadIdx.x, lane = tid & 63, wave = tid >> 6;
    const bf16_t* Z = (const bf16_t*)(p.ws + WS_Z);
    bf16_t* CKV = (bf16_t*)(p.ws + WS_CKV); float* KIDX = (float*)(p.ws + WS_KIDX);
    for (int t = blockIdx.x * NWAVES + wave; t < L; t += G * NWAVES) {
        const u32x4 raw = *(const u32x4*)(Z + (size_t)t * NZ + ZCKV + lane * 8);
        float x[8] = {blo(raw.x), bhi(raw.x), blo(raw.y), bhi(raw.y), blo(raw.z), bhi(raw.z), blo(raw.w), bhi(raw.w)};
        float s = 0.f;
#pragma unroll
        for (int e = 0; e < 8; ++e) s += x[e] * x[e];
        const float r = rsqrtf(wave_sum(s) * (1.f / KVR) + 1e-6f);
        const f32x4 w0 = *(const f32x4*)(p.in[I_KVNW] + lane * 8), w1 = *(const f32x4*)(p.in[I_KVNW] + lane * 8 + 4);
        u32x4 o; o.x = pk2(x[0] * r * w0.x, x[1] * r * w0.y); o.y = pk2(x[2] * r * w0.z, x[3] * r * w0.w); o.z = pk2(x[4] * r * w1.x, x[5] * r * w1.y); o.w = pk2(x[6] * r * w1.z, x[7] * r * w1.w);
        *(u32x4*)(CKV + (size_t)t * KVR + lane * 8) = o;
        const float ki = bf2f(Z[(size_t)t * NZ + ZKI + lane]);
        const float mean = wave_sum(ki) * (1.f / 64.f), dk = ki - mean, var = wave_sum(dk * dk) * (1.f / 64.f);
        const float kn_ = dk * rsqrtf(var + 1e-6f) * p.in[I_ILNW][lane] + p.in[I_ILNB][lane];
        KIDX[(size_t)t * IDXD + lane] = kn_;
        ((bf16_t*)(p.ws + WS_KIDXB))[(size_t)t * IDXD + lane] = f2bf(kn_);
    }
}

__device__ __forceinline__ unsigned fkey(float f) { const unsigned u = __float_as_uint(f); return (u & 0x80000000u) ? ~u : (u | 0x80000000u); }


typedef float f32x16 __attribute__((ext_vector_type(16)));
constexpr int SCR_N = 16416;
__device__ __forceinline__ unsigned lds_add(LAS unsigned* p, unsigned v) { return __hip_atomic_fetch_add(p, v, __ATOMIC_RELAXED, __HIP_MEMORY_SCOPE_WORKGROUP); }
constexpr int KST = 72, SELB = 8;
template <int NBL> __device__ __forceinline__ void wfind(const LAS unsigned* hist, unsigned target, int lane, unsigned& b, unsigned& ab) {
    unsigned loc[NBL]; unsigned s = 0;
#pragma unroll
    for (int j = 0; j < NBL; j += 4) { const u32x4 v4 = *(const LAS u32x4*)(hist + lane * NBL + j); loc[j] = v4.x; loc[j + 1] = v4.y; loc[j + 2] = v4.z; loc[j + 3] = v4.w; s += (v4.x + v4.y) + (v4.z + v4.w); }
    unsigned v = s;
#pragma unroll
    for (int d = 1; d < 64; d <<= 1) { const unsigned o = (unsigned)__shfl_down((int)v, d); if (lane + d < 64) v += o; }
    const unsigned above = v - s;
    const bool found = above < target && above + s >= target;
    unsigned bb = 0u, aa = 0u;
    if (found) { unsigned a = above;
#pragma unroll
        for (int j = NBL - 1; j >= 0; --j) { if (a < target && a + loc[j] >= target) { bb = (unsigned)(lane * NBL + j); aa = a; } a += loc[j]; } }
    const unsigned long long m = __ballot(found);
    const int src = m ? (int)__builtin_ctzll(m) : 0;
    b = (unsigned)__shfl((int)bb, src); ab = (unsigned)__shfl((int)aa, src);
}
__device__ __forceinline__ void d2_topk(const P& p, LAS unsigned char* lds, int G) {
    const int tid = threadIdx.x, lane = tid & 63, wave = __builtin_amdgcn_readfirstlane(tid >> 6);
    const bf16_t* Z = (const bf16_t*)(p.ws + WS_Z); const bf16_t* KB = (const bf16_t*)(p.ws + WS_KIDXB); int* SEL = (int*)(p.ws + WS_SEL);
    float* scr = (float*)(p.ws + WS_R1) + ((size_t)blockIdx.x * NWAVES + wave) * 2 * SCR_N;
    LAS bf16_t* ksb = (LAS bf16_t*)lds;
    LAS unsigned* hw = (LAS unsigned*)(lds + 73728) + wave * 2048;
    const int key_l = lane & 31, hh = lane >> 5;
    for (int t = blockIdx.x; t < NMETA + 192; t += G) { const int n = t < NMETA ? NMETA : NMETA + 64 * (1 + (t - NMETA) / 64);
        if (tid < TOPK) SEL[(size_t)t * TOPK + tid] = tid < n ? tid : -1; }
    const int nui = (G == 256) ? 4 : (1012 + G - 1) / G;
    for (int ui = 0; ui < nui; ++ui) {
        int i = (int)blockIdx.x + ui * G;
        if (G == 256) i = ui == 0 ? (int)blockIdx.x : (ui == 1 ? 511 - (int)blockIdx.x : (ui == 2 ? 512 + (int)blockIdx.x : 1023 - (int)blockIdx.x));
        if (i >= 1012) continue;
        const int c = 256 - (i >> 2), r = i & 3, n = NMETA + 64 * c;
        const int tA = NMETA + 64 * (c - 1) + 16 * r + 2 * wave;
        bf16x8_t af[2][4]; float wv[2][16];
#pragma unroll
        for (int qq = 0; qq < 2; ++qq) {
            const bf16_t* zr = Z + (size_t)(tA + qq) * NZ;
#pragma unroll
            for (int ks = 0; ks < 4; ++ks) af[qq][ks] = *(const bf16x8_t*)(zr + ZQI + key_l * 64 + ks * 16 + hh * 8);
#pragma unroll
            for (int g = 0; g < 4; ++g) { const u32x2 w2 = *(const u32x2*)(zr + ZWI + 8 * g + 4 * hh);
                wv[qq][g * 4 + 0] = blo(w2.x) * 0.02209708691207961f; wv[qq][g * 4 + 1] = bhi(w2.x) * 0.02209708691207961f;
                wv[qq][g * 4 + 2] = blo(w2.y) * 0.02209708691207961f; wv[qq][g * 4 + 3] = bhi(w2.y) * 0.02209708691207961f; }
        }
#pragma unroll
        for (int j = 0; j < 8; ++j) *(LAS u32x4*)(hw + (j * 64 + lane) * 4) = (u32x4){0u, 0u, 0u, 0u};
        const int nblk = (n + 255) >> 8;
        __syncthreads();
        {
            const int kk = tid >> 1, hf = tid & 1; const int src = kk < n ? kk : n - 1;
            const u32x4* gp = (const u32x4*)(KB + (size_t)src * IDXD + hf * 32);
#pragma unroll
            for (int j = 0; j < 4; ++j) *(LAS u32x4*)(ksb + kk * KST + hf * 32 + j * 8) = gp[j];
        }
        __syncthreads();
        for (int b = 0; b < nblk; ++b) {
            u32x4 pre[4];
            const bool more = b + 1 < nblk;
            if (more) { const int kk = (b + 1) * 256 + (tid >> 1); const int src = kk < n ? kk : n - 1; const u32x4* gp = (const u32x4*)(KB + (size_t)src * IDXD + (tid & 1) * 32);
#pragma unroll
                for (int j = 0; j < 4; ++j) pre[j] = gp[j]; }
            const LAS bf16_t* kb = ksb + (b & 1) * 256 * KST;
#pragma unroll 2
            for (int tt = 0; tt < 8; ++tt) {
                const int s0 = b * 256 + tt * 32;
                if (s0 < n) {
                    bf16x8_t bfr[4];
#pragma unroll
                    for (int ks = 0; ks < 4; ++ks) bfr[ks] = *(const LAS bf16x8_t*)(kb + (tt * 32 + key_l) * KST + ks * 16 + hh * 8);
                    float part[2];
#pragma unroll
                    for (int qq = 0; qq < 2; ++qq) {
                        f32x16 acc;
#pragma unroll
                        for (int e = 0; e < 16; ++e) acc[e] = 0.f;
#pragma unroll
                        for (int ks = 0; ks < 4; ++ks) acc = __builtin_amdgcn_mfma_f32_32x32x16_bf16(af[qq][ks], bfr[ks], acc, 0, 0, 0);
                        float s = 0.f;
                        float s0_ = 0.f, s1_ = 0.f;
#pragma unroll
                        for (int e = 0; e < 16; e += 2) { s0_ += wv[qq][e] * __builtin_amdgcn_fmed3f(acc[e], 0.f, 3.0e38f); s1_ += wv[qq][e + 1] * __builtin_amdgcn_fmed3f(acc[e + 1], 0.f, 3.0e38f); }
                        part[qq] = s0_ + s1_; (void)s;
                    }
                    const float mine = hh ? part[1] : part[0], give = hh ? part[0] : part[1];
                    const float score = mine + __shfl_xor(give, 32);
                    const int key = s0 + key_l;
                    if (key < n) { scr[hh * SCR_N + key] = score; lds_add(hw + hh * 1024 + (fkey(score) >> 22), 1u); }
                }
            }
            if (more) { const int kk = tid >> 1, hf = tid & 1;
#pragma unroll
                for (int j = 0; j < 4; ++j) *(LAS u32x4*)(ksb + ((b + 1) & 1) * 256 * KST + kk * KST + hf * 32 + j * 8) = pre[j]; }
            __syncthreads();
        }
        unsigned b1[2], ab1[2];
        wfind<16>(hw, TOPK, lane, b1[0], ab1[0]); wfind<16>(hw + 1024, TOPK, lane, b1[1], ab1[1]);
        const int nv4 = (n + 3) >> 2;
#pragma unroll
        for (int j = 0; j < 8; ++j) *(LAS u32x4*)(hw + (j * 64 + lane) * 4) = (u32x4){0u, 0u, 0u, 0u};
        for (int sb = 0; sb < nv4; sb += 64 * SELB) {
            f32x4 va[SELB], vb[SELB];
#pragma unroll
            for (int u = 0; u < SELB; ++u) { const int s4 = sb + u * 64 + lane; const int sc = s4 < nv4 ? s4 : nv4 - 1; va[u] = *(const f32x4*)(scr + sc * 4); vb[u] = *(const f32x4*)(scr + SCR_N + sc * 4); }
#pragma unroll
            for (int u = 0; u < SELB; ++u) if (sb + u * 64 + lane < nv4) {
#pragma unroll
                for (int e = 0; e < 4; ++e) { const unsigned ka = fkey(va[u][e]), kb = fkey(vb[u][e]);
                    if ((ka >> 22) == b1[0]) lds_add(hw + ((ka >> 12) & 1023u), 1u);
                    if ((kb >> 22) == b1[1]) lds_add(hw + 1024 + ((kb >> 12) & 1023u), 1u); } } }
        unsigned b2[2], ab2[2];
        wfind<16>(hw, TOPK - ab1[0], lane, b2[0], ab2[0]); wfind<16>(hw + 1024, TOPK - ab1[1], lane, b2[1], ab2[1]);
        const unsigned pfx0 = (b1[0] << 10) | b2[0], pfx1 = (b1[1] << 10) | b2[1];
        const unsigned need0 = (unsigned)TOPK - ab1[0] - ab2[0], need1 = (unsigned)TOPK - ab1[1] - ab2[1];
        LAS unsigned* cl0 = hw; LAS unsigned* cl1 = hw + 1024;
        unsigned cnt0 = 0u, cnt1 = 0u, cc0 = 0u, cc1 = 0u; int* sel0 = SEL + (size_t)tA * TOPK; int* sel1 = sel0 + TOPK;
        const unsigned long long lt = (1ull << lane) - 1ull;
        for (int sb = 0; sb < nv4; sb += 64 * SELB) {
            f32x4 va[SELB], vb[SELB];
#pragma unroll
            for (int u = 0; u < SELB; ++u) { const int s4 = sb + u * 64 + lane; const int sc = s4 < nv4 ? s4 : nv4 - 1; va[u] = *(const f32x4*)(scr + sc * 4); vb[u] = *(const f32x4*)(scr + SCR_N + sc * 4); }
#pragma unroll
            for (int u = 0; u < SELB; ++u) { const int s4 = sb + u * 64 + lane; const bool inr = s4 < nv4;
                if (sb + u * 64 < nv4) {
#pragma unroll
                    for (int e = 0; e < 4; ++e) {
                        {   const unsigned k = fkey(va[u][e]); const bool gt = inr && (k >> 12) > pfx0, eq = inr && (k >> 12) == pfx0;
                            const unsigned long long mg = __ballot(gt), me = __ballot(eq);
                            if (gt) { const unsigned pos = cnt0 + (unsigned)__builtin_popcountll(mg & lt); if (pos < (unsigned)TOPK) sel0[pos] = s4 * 4 + e; }
                            if (eq) { const unsigned ci = cc0 + (unsigned)__builtin_popcountll(me & lt); if (ci < 512u) { cl0[2 * ci] = k; cl0[2 * ci + 1] = (unsigned)(s4 * 4 + e); } }
                            cnt0 += (unsigned)__builtin_popcountll(mg); cc0 += (unsigned)__builtin_popcountll(me); }
                        {   const unsigned k = fkey(vb[u][e]); const bool gt = inr && (k >> 12) > pfx1, eq = inr && (k >> 12) == pfx1;
                            const unsigned long long mg = __ballot(gt), me = __ballot(eq);
                            if (gt) { const unsigned pos = cnt1 + (unsigned)__builtin_popcountll(mg & lt); if (pos < (unsigned)TOPK) sel1[pos] = s4 * 4 + e; }
                            if (eq) { const unsigned ci = cc1 + (unsigned)__builtin_popcountll(me & lt); if (ci < 512u) { cl1[2 * ci] = k; cl1[2 * ci + 1] = (unsigned)(s4 * 4 + e); } }
                            cnt1 += (unsigned)__builtin_popcountll(mg); cc1 += (unsigned)__builtin_popcountll(me); }
                    } } } }
#pragma unroll 1
        for (int qq = 0; qq < 2; ++qq) {
            const LAS unsigned* cl = qq ? cl1 : cl0; const unsigned c = min(qq ? cc1 : cc0, 512u), need = qq ? need1 : need0, base = qq ? cnt1 : cnt0; int* sel = qq ? sel1 : sel0;
            for (unsigned i = lane; i < c; i += 64) { const unsigned k = cl[2 * i], ix = cl[2 * i + 1]; unsigned rank = 0;
                for (unsigned j = 0; j < c; ++j) { const unsigned kj = cl[2 * j], ij = cl[2 * j + 1]; rank += (kj > k || (kj == k && ij < ix)) ? 1u : 0u; }
                if (rank < need && base + rank < (unsigned)TOPK) sel[base + rank] = (int)ix; }
        }
    }
}

__device__ __forceinline__ void d3_qlat(const P& p, int G) {
    const int tid = threadIdx.x, lane = tid & 63, wave = __builtin_amdgcn_readfirstlane(tid >> 6), r16 = lane & 15, q = lane >> 4;
    const bf16_t* Z = (const bf16_t*)(p.ws + WS_Z); const bf16_t* WK = (const bf16_t*)(p.ws + WS_WUKB); bf16_t* QL = (bf16_t*)(p.ws + WS_QLAT);
    constexpr int NB = L / 16;
    for (int item = blockIdx.x; item < 256; item += G) {
        const int h = item & 15, qr = item >> 4; const int b0 = qr * 64, b1 = qr == 15 ? NB : b0 + 64;
        bf16x8_t af[4][4];
#pragma unroll
        for (int mt = 0; mt < 4; ++mt)
#pragma unroll
            for (int ks = 0; ks < 4; ++ks) af[mt][ks] = *(const bf16x8_t*)(WK + ((size_t)h * KVR + wave * 64 + mt * 16 + r16) * HD_B + ks * 32 + q * 8);
        bf16x8_t bq[4];
#pragma unroll
        for (int ks = 0; ks < 4; ++ks) bq[ks] = *(const bf16x8_t*)(Z + (size_t)(b0 * 16 + r16) * NZ + ZQ + h * 128 + ks * 32 + q * 8);
        for (int b = b0; b < b1; ++b) {
            bf16x8_t bn[4];
            const int bnx = b + 1 < b1 ? b + 1 : b;
#pragma unroll
            for (int ks = 0; ks < 4; ++ks) bn[ks] = *(const bf16x8_t*)(Z + (size_t)(bnx * 16 + r16) * NZ + ZQ + h * 128 + ks * 32 + q * 8);
#pragma unroll
            for (int mt = 0; mt < 4; ++mt) {
                f32x4 acc = {0.f, 0.f, 0.f, 0.f};
#pragma unroll
                for (int ks = 0; ks < 4; ++ks) acc = __builtin_amdgcn_mfma_f32_16x16x32_bf16(af[mt][ks], bq[ks], acc, 0, 0, 0);
                u32x2 w; w.x = cvtpk(acc[0], acc[1]); w.y = cvtpk(acc[2], acc[3]);
                *(u32x2*)(QL + (size_t)(b * 16 + r16) * 8192 + h * 512 + wave * 64 + mt * 16 + q * 4) = w;
            }
#pragma unroll
            for (int ks = 0; ks < 4; ++ks) bq[ks] = bn[ks];
        }
    }
}
__device__ __forceinline__ void d5_oproj(const P& p, int G) {
    const int tid = threadIdx.x, lane = tid & 63, wave = __builtin_amdgcn_readfirstlane(tid >> 6), r16 = lane & 15, q = lane >> 4;
    const bf16_t* OL = (const bf16_t*)(p.ws + WS_QLAT); const bf16_t* WV = (const bf16_t*)(p.ws + WS_WUVT); bf16_t* YB = (bf16_t*)(p.ws + WS_YB);
    for (size_t i = (size_t)blockIdx.x * NT + tid; i < (size_t)(MP - L) * A_W / 8; i += (size_t)G * NT) *(u32x4*)(YB + (size_t)L * A_W + i * 8) = (u32x4){0u, 0u, 0u, 0u};
    constexpr int NB = L / 16;
    for (int item = blockIdx.x; item < 256; item += G) {
        const int h = item & 15, qr = item >> 4; const int b0 = qr * 64, b1 = qr == 15 ? NB : b0 + 64;
        bf16x8_t af[16];
#pragma unroll
        for (int ks = 0; ks < 16; ++ks) af[ks] = *(const bf16x8_t*)(WV + ((size_t)h * HD_B + wave * 16 + r16) * KVR + ks * 32 + q * 8);
        bf16x8_t bo[16];
#pragma unroll
        for (int ks = 0; ks < 16; ++ks) bo[ks] = *(const bf16x8_t*)(OL + (size_t)(b0 * 16 + r16) * 8192 + h * 512 + ks * 32 + q * 8);
        for (int b = b0; b < b1; ++b) {
            f32x4 acc0 = {0.f, 0.f, 0.f, 0.f}, acc1 = acc0;
#pragma unroll
            for (int ks = 0; ks < 16; ks += 2) { acc0 = __builtin_amdgcn_mfma_f32_16x16x32_bf16(af[ks], bo[ks], acc0, 0, 0, 0); acc1 = __builtin_amdgcn_mfma_f32_16x16x32_bf16(af[ks + 1], bo[ks + 1], acc1, 0, 0, 0); }
            const int bnx = b + 1 < b1 ? b + 1 : b;
#pragma unroll
            for (int ks = 0; ks < 16; ++ks) bo[ks] = *(const bf16x8_t*)(OL + (size_t)(bnx * 16 + r16) * 8192 + h * 512 + ks * 32 + q * 8);
            const f32x4 acc = acc0 + acc1;
            u32x2 w; w.x = cvtpk(acc[0], acc[1]); w.y = cvtpk(acc[2], acc[3]);
            *(u32x2*)(YB + (size_t)(b * 16 + r16) * A_W + h * HD_B + wave * 16 + q * 4) = w;
        }
    }
}

typedef short s16x4_t __attribute__((ext_vector_type(4)));
constexpr int QLS = 520, PLS = 264, CTS = 528;
#ifndef ATT_REG
#define ATT_REG 0
#endif
#if ATT_REG > 0
#define AREG_T() const unsigned long long tt_ = __builtin_amdgcn_s_memrealtime()
#ifndef ATT_BLK
#define ATT_BLK 0
#endif
#define AREG(k) do { if (ATT_REG == (k) && blockIdx.x == ATT_BLK && threadIdx.x == 0) { const unsigned long long t1_ = __builtin_amdgcn_s_memrealtime(); areg_acc += t1_ - areg_t0; } if (ATT_REG != 9 && blockIdx.x == ATT_BLK && threadIdx.x == 0) areg_t0 = __builtin_amdgcn_s_memrealtime(); } while (0)
#else
#define AREG(k) do {} while (0)
#endif
__device__ __forceinline__ void d4_attn(const P& p, LAS unsigned char* lds, int G) {
    unsigned long long areg_acc = 0, areg_t0 = 0; (void)areg_acc; (void)areg_t0;
    const int tid = threadIdx.x, lane = tid & 63, wave = __builtin_amdgcn_readfirstlane(tid >> 6), r16 = lane & 15, q = lane >> 4;
    bf16_t* QO = (bf16_t*)(p.ws + WS_QLAT); const bf16_t* CKV = (const bf16_t*)(p.ws + WS_CKV); const int* SEL = (const int*)(p.ws + WS_SEL);
    LAS bf16_t* ql = (LAS bf16_t*)lds;
    LAS float* lg = (LAS float*)(lds + 16640);
    LAS bf16_t* pl = (LAS bf16_t*)(lds + 49408);
    LAS int* sl = (LAS int*)(lds + 57856);
    LAS bf16_t* ct = (LAS bf16_t*)(lds + 58880);
    LAS bf16_t* cx = (LAS bf16_t*)(lds + 126464);
    const float scale = 0.08838834764831845f;
    u32x4 qn0 = (u32x4){0u, 0u, 0u, 0u}, qn1 = qn0; int seln = -1;
    const bool xdeal = (G == 256);
    const int tq0 = xdeal ? ((int)(blockIdx.x & 7) * (L / 8) + (int)(blockIdx.x >> 3)) : (int)blockIdx.x, tqs = xdeal ? 32 : G, tq1 = xdeal ? ((int)(blockIdx.x & 7) + 1) * (L / 8) : L;
    {   const int t = tq0;
        if (t < tq1) { qn0 = *(const u32x4*)(QO + (size_t)t * 8192 + tid * 8); qn1 = *(const u32x4*)(QO + (size_t)t * 8192 + 4096 + tid * 8); if (tid < TOPK) seln = SEL[(size_t)t * TOPK + tid]; } }
#if ATT_REG == 9
    if (blockIdx.x == ATT_BLK && threadIdx.x == 0) areg_t0 = __builtin_amdgcn_s_memrealtime();
#endif
    for (int t = tq0; t < tq1; t += tqs) {
        AREG(5);
        LDS_BARRIER();
        {   const int i0_ = tid, i1_ = tid + 512;
            *(LAS u32x4*)(ql + (i0_ >> 6) * QLS + (i0_ & 63) * 8) = qn0; *(LAS u32x4*)(ql + (i1_ >> 6) * QLS + (i1_ & 63) * 8) = qn1;
            if (tid < TOPK) sl[tid] = seln; }
        LDS_BARRIER();
        AREG(1);
        u32x4 st[8];
#pragma unroll
        for (int i = 0; i < 8; ++i) { const int idx = sl[wave + 8 * i]; st[i] = *(const u32x4*)(CKV + (size_t)(idx < 0 ? 0 : idx) * KVR + lane * 8); }
        const int kk = wave & 3, kh = wave >> 2;
        bf16x8_t af[8];
#pragma unroll
        for (int ks = 0; ks < 8; ++ks) af[ks] = *(const LAS bf16x8_t*)(ql + r16 * QLS + kh * 256 + ks * 32 + q * 8);
        for (int kt = 0; kt < 4; ++kt) {
            LDS_BARRIER();
#pragma unroll
            for (int i = 0; i < 8; ++i) { LAS bf16_t* dst = (kt == 2 && i >= 4) ? cx + (wave + 8 * i - 32) * CTS : ct + (wave + 8 * i) * CTS; *(LAS u32x4*)(dst + lane * 8) = st[i]; }
            if (kt < 3) {
#pragma unroll
                for (int i = 0; i < 8; ++i) { const int idx = sl[(kt + 1) * 64 + wave + 8 * i]; st[i] = *(const u32x4*)(CKV + (size_t)(idx < 0 ? 0 : idx) * KVR + lane * 8); }
            } else {
#pragma unroll
                for (int i = 0; i < 4; ++i) { const int idx = sl[128 + wave + 8 * i]; st[i] = *(const u32x4*)(CKV + (size_t)(idx < 0 ? 0 : idx) * KVR + lane * 8); }
            }
            LDS_BARRIER();
            const LAS bf16_t* kb = (kt == 2 && kk >= 2) ? cx + ((kk - 2) * 16 + r16) * CTS : ct + (kk * 16 + r16) * CTS;
            f32x4 c0 = {0.f, 0.f, 0.f, 0.f};
#pragma unroll
            for (int ks = 0; ks < 8; ++ks) {
                const bf16x8_t b = *(const LAS bf16x8_t*)(kb + kh * 256 + ks * 32 + q * 8);
                c0 = __builtin_amdgcn_mfma_f32_16x16x32_bf16(af[ks], b, c0, 0, 0, 0);
            }
            const int key = kt * 64 + kk * 16 + r16; const bool inval = sl[key] < 0;
#pragma unroll
            for (int e = 0; e < 4; ++e) lg[kh * 4096 + (4 * q + e) * 256 + key] = inval ? (kh ? 0.f : -INFINITY) : c0[e] * scale;
        }
        LDS_BARRIER();
        AREG(2);
        for (int hd = wave * 2; hd < wave * 2 + 2; ++hd) {
            float v[4]; float mx = -INFINITY;
#pragma unroll
            for (int k = 0; k < 4; ++k) { v[k] = lg[hd * 256 + k * 64 + lane] + lg[4096 + hd * 256 + k * 64 + lane]; mx = fmaxf(mx, v[k]); }
            mx = wave_max(mx);
            float s = 0.f;
#pragma unroll
            for (int k = 0; k < 4; ++k) { v[k] = __expf(v[k] - mx); s += v[k]; }
            s = 1.f / wave_sum(s);
#pragma unroll
            for (int k = 0; k < 4; ++k) pl[hd * PLS + k * 64 + lane] = f2bf(v[k] * s);
        }
        f32x4 acc[4];
#pragma unroll
        for (int m = 0; m < 4; ++m) acc[m] = (f32x4){0.f, 0.f, 0.f, 0.f};
        {   const int tn = t + tqs;
            if (tn < tq1) { qn0 = *(const u32x4*)(QO + (size_t)tn * 8192 + tid * 8); qn1 = *(const u32x4*)(QO + (size_t)tn * 8192 + 4096 + tid * 8); if (tid < TOPK) seln = SEL[(size_t)tn * TOPK + tid]; } }
        AREG(3);
        for (int j2 = 0; j2 < 4; ++j2) {
            const int kt = 3 - j2;
            LDS_BARRIER();
            if (j2 > 0) {
                if (j2 == 1) {
#pragma unroll
                    for (int i = 0; i < 4; ++i) *(LAS u32x4*)(ct + (wave + 8 * i) * CTS + lane * 8) = st[i];
                } else {
#pragma unroll
                    for (int i = 0; i < 8; ++i) *(LAS u32x4*)(ct + (wave + 8 * i) * CTS + lane * 8) = st[i];
                }
                if (j2 < 3) {
#pragma unroll
                    for (int i = 0; i < 8; ++i) { const int idx = sl[(kt - 1) * 64 + wave + 8 * i]; st[i] = *(const u32x4*)(CKV + (size_t)(idx < 0 ? 0 : idx) * KVR + lane * 8); } }
                LDS_BARRIER();
            }
            const int kq = 16 * (q >> 1) + 4 * (q & 1);
#pragma unroll
            for (int s = 0; s < 2; ++s) {
                const u32x2 pa = *(const LAS u32x2*)(pl + r16 * PLS + kt * 64 + s * 32 + kq), pb = *(const LAS u32x2*)(pl + r16 * PLS + kt * 64 + s * 32 + kq + 8);
                const u32x4 pw = (u32x4){pa.x, pa.y, pb.x, pb.y}; const bf16x8_t b = __builtin_bit_cast(bf16x8_t, pw);
                const LAS bf16_t* cb = (kt == 2 && s == 1) ? cx : ct + s * 32 * CTS;
                const LAS bf16_t* tp = cb + (kq + (r16 >> 2)) * CTS + wave * 64 + (r16 & 3) * 4;
#pragma unroll
                for (int m = 0; m < 4; ++m) {
                    const s16x4_t lo = __builtin_amdgcn_ds_read_tr16_b64_v4i16((LAS s16x4_t*)(tp + m * 16)), hi = __builtin_amdgcn_ds_read_tr16_b64_v4i16((LAS s16x4_t*)(tp + 8 * CTS + m * 16));
                    const bf16x8_t a = (bf16x8_t){lo[0], lo[1], lo[2], lo[3], hi[0], hi[1], hi[2], hi[3]};
                    acc[m] = __builtin_amdgcn_mfma_f32_16x16x32_bf16(a, b, acc[m], 0, 0, 0);
                }
            }
        }
        AREG(4);
#pragma unroll
        for (int m = 0; m < 4; ++m) { u32x2 w; w.x = cvtpk(acc[m][0], acc[m][1]); w.y = cvtpk(acc[m][2], acc[m][3]);
            *(u32x2*)(QO + (size_t)t * 8192 + r16 * 512 + wave * 64 + m * 16 + q * 4) = w; }
    }
#if ATT_REG == 9
    if (blockIdx.x == ATT_BLK && threadIdx.x == 0) areg_acc = __builtin_amdgcn_s_memrealtime() - areg_t0;
#endif
#if ATT_REG > 0
    if (blockIdx.x == ATT_BLK && threadIdx.x == 0) __hip_atomic_store((unsigned*)(p.ws + WS_CTL) + 65540, (unsigned)areg_acc, __ATOMIC_RELAXED, __HIP_MEMORY_SCOPE_AGENT);
#endif
}


__device__ __forceinline__ const float* h1_row(const P& p, int m) { const float* hmeta = (const float*)(p.ws + WS_HMETA); return m < NMETA ? hmeta + (size_t)m * D : p.out + (size_t)(m - NMETA) * D; }
__device__ __forceinline__ void p12_norm(const P& p, int G) {
    const int lane = threadIdx.x & 63, wave = threadIdx.x >> 6;
    signed char* U8 = (signed char*)(p.ws + WS_U); const float* w = p.in[I_NFW];
    float wm = 0.f;
#pragma unroll
    for (int j = 0; j < 16; ++j) { const f32x4 g = *(const f32x4*)(w + (j * 64 + lane) * 4); wm += (g.x * g.x + g.y * g.y) + (g.z * g.z + g.w * g.w); }
    wm = sqrtf(wave_sum(wm) * (1.f / D));
    const float amc = 4.0f * wm;
    const float inv = amc > 0.f ? 127.f / amc : 0.f;
    if (blockIdx.x == 0 && threadIdx.x == 0) *(float*)(p.ws + WS_CTL + CT_SAG) = amc > 0.f ? amc * (1.f / 127.f) : 1.f;
    for (int m = blockIdx.x * NWAVES + wave; m < MP; m += G * NWAVES) {
        signed char* dst = U8 + (size_t)m * D;
        if (m >= L) {
#pragma unroll
            for (int j = 0; j < 4; ++j) *(u32x4*)(dst + (j * 64 + lane) * 16) = (u32x4){0u, 0u, 0u, 0u};
            continue; }
        const float* src = h1_row(p, m);
        f32x4 v[16]; float s = 0.f;
#pragma unroll
        for (int j = 0; j < 16; ++j) { v[j] = *(const f32x4*)(src + (j * 64 + lane) * 4); s += (v[j].x * v[j].x + v[j].y * v[j].y) + (v[j].z * v[j].z + v[j].w * v[j].w); }
        const float ri = rsqrtf(wave_sum(s) * (1.f / D) + 1e-6f) * inv;
#pragma unroll
        for (int j = 0; j < 16; ++j) { const f32x4 x = v[j] * ri; const f32x4 g = *(const f32x4*)(w + (j * 64 + lane) * 4);
            const unsigned q = ((unsigned)(int)rintf(fminf(fmaxf(x.x * g.x, -127.f), 127.f)) & 0xffu) | (((unsigned)(int)rintf(fminf(fmaxf(x.y * g.y, -127.f), 127.f)) & 0xffu) << 8) | (((unsigned)(int)rintf(fminf(fmaxf(x.z * g.z, -127.f), 127.f)) & 0xffu) << 16) | (((unsigned)(int)rintf(fminf(fmaxf(x.w * g.w, -127.f), 127.f)) & 0xffu) << 24);
            *(unsigned*)(dst + (j * 64 + lane) * 4) = q; }
    }
}
__device__ __forceinline__ void p18_final_norm(const P& p, int G) {
    const int tid = threadIdx.x, lane = tid & 63, wave = tid >> 6;
    const float* w = p.in[I_NFIN];
    for (int m = blockIdx.x * NWAVES + wave; m < SEQ; m += G * NWAVES) {
        float* row = p.out + (size_t)m * D;
        f32x4 v[16]; float s = 0.f;
#pragma unroll
        for (int j = 0; j < 16; ++j) { v[j] = *(const f32x4*)(row + (j * 64 + lane) * 4); s += (v[j].x * v[j].x + v[j].y * v[j].y) + (v[j].z * v[j].z + v[j].w * v[j].w); }
        float r = rsqrtf(wave_sum(s) * (1.f / D) + 1e-6f);
#if STAMP_A0 >= 0
        r *= 1.f + 1e-7f * (float)__hip_atomic_load((const unsigned*)(p.ws + WS_CTL) + 65536, __ATOMIC_RELAXED, __HIP_MEMORY_SCOPE_AGENT);
#endif
#pragma unroll
        for (int j = 0; j < 16; ++j) { const f32x4 g = *(const f32x4*)(w + (j * 64 + lane) * 4); *(f32x4*)(row + (j * 64 + lane) * 4) = v[j] * r * g; }
    }
}

__device__ __forceinline__ void p14_conv_act(const P& p, int G, int pass) {
    const int tid = threadIdx.x;
    const bf16_t* ZF = (const bf16_t*)(p.ws + WS_ZF); bf16_t* ACT = (bf16_t*)(p.ws + WS_ACT);
    const float* cw = p.in[I_CW]; const float* cb = p.in[I_CB];
    const size_t nitems = (size_t)MP * 43 * 16;
    for (size_t it = (size_t)blockIdx.x * NT + tid; it < nitems; it += (size_t)G * NT) {
        const int g8 = (int)(it % 16), tl = (int)((it / 16) % 43), t = (int)(it / (16 * 43));
        const int ch = (pass * 43 + tl) * 128 + g8 * 8;
        u32x4 o = (u32x4){0u, 0u, 0u, 0u};
        if (t < L) {
            float zg[8], zu[8];
#pragma unroll
            for (int e = 0; e < 8; ++e) { zg[e] = cb[ch + e]; zu[e] = cb[DFF + ch + e]; }
#pragma unroll
            for (int i = 0; i < 3; ++i) { const int tt = t - 2 + i;
                if (tt >= 0) {
                    const u32x4 a = *(const u32x4*)(ZF + (size_t)tt * DFF + tl * 256 + g8 * 8), b = *(const u32x4*)(ZF + (size_t)tt * DFF + tl * 256 + 128 + g8 * 8);
                    const float xa[8] = {blo(a.x), bhi(a.x), blo(a.y), bhi(a.y), blo(a.z), bhi(a.z), blo(a.w), bhi(a.w)};
                    const float xb[8] = {blo(b.x), bhi(b.x), blo(b.y), bhi(b.y), blo(b.z), bhi(b.z), blo(b.w), bhi(b.w)};
#pragma unroll
                    for (int e = 0; e < 8; ++e) { zg[e] += cw[(size_t)i * NFI + ch + e] * xa[e]; zu[e] += cw[(size_t)i * NFI + DFF + ch + e] * xb[e]; }
                } }
            float r[8];
#pragma unroll
            for (int e = 0; e < 8; ++e) r[e] = zg[e] * sigm(zg[e]) * zu[e];
            o.x = pk2(r[0], r[1]); o.y = pk2(r[2], r[3]); o.z = pk2(r[4], r[5]); o.w = pk2(r[6], r[7]);
        }
        *(u32x4*)(ACT + (size_t)t * DFF + ch) = o;
    }
}

template <int K, class F> __device__ __forceinline__ void side2(const bf16_t* A14, int lda, const bf16_t* Bt, int N, int G, F f) {
    const int lane = threadIdx.x & 63, gw = blockIdx.x * NWAVES + (threadIdx.x >> 6);
    constexpr int NC = K / 512;
    u32x4 a0[NC], a1[NC];
#pragma unroll
    for (int i = 0; i < NC; ++i) { a0[i] = *(const u32x4*)(A14 + i * 512 + lane * 8); a1[i] = *(const u32x4*)(A14 + lda + i * 512 + lane * 8); }
    for (int n = gw; n < N; n += G * NWAVES) {
        float s0 = 0.f, s1 = 0.f;
#pragma unroll
        for (int i = 0; i < NC; ++i) { const u32x4 b = *(const u32x4*)(Bt + (size_t)n * K + i * 512 + lane * 8);
            const unsigned bw[4] = {b.x, b.y, b.z, b.w}, x0[4] = {a0[i].x, a0[i].y, a0[i].z, a0[i].w}, x1[4] = {a1[i].x, a1[i].y, a1[i].z, a1[i].w};
#pragma unroll
            for (int e = 0; e < 4; ++e) { s0 += blo(x0[e]) * blo(bw[e]) + bhi(x0[e]) * bhi(bw[e]); s1 += blo(x1[e]) * blo(bw[e]) + bhi(x1[e]) * bhi(bw[e]); } }
        s0 = wave_sum(s0); s1 = wave_sum(s1);
        if (lane == 0) f(n, s0, s1);
    }
}

template <class F> __device__ __forceinline__ void side2_i8(const signed char* A14, const signed char* Bt, int N, int G, F f) {
    const int lane = threadIdx.x & 63, gw = blockIdx.x * NWAVES + (threadIdx.x >> 6);
    u32x4 a0[4], a1[4];
#pragma unroll
    for (int i = 0; i < 4; ++i) { a0[i] = *(const u32x4*)(A14 + i * 1024 + lane * 16); a1[i] = *(const u32x4*)(A14 + 4096 + i * 1024 + lane * 16); }
    for (int n = gw; n < N; n += G * NWAVES) {
        int s0 = 0, s1 = 0;
#pragma unroll
        for (int i = 0; i < 4; ++i) { const u32x4 b = *(const u32x4*)(Bt + (size_t)n * 4096 + i * 1024 + lane * 16);
            s0 = __builtin_amdgcn_sdot4((int)a0[i].x, (int)b.x, s0, false); s0 = __builtin_amdgcn_sdot4((int)a0[i].y, (int)b.y, s0, false); s0 = __builtin_amdgcn_sdot4((int)a0[i].z, (int)b.z, s0, false); s0 = __builtin_amdgcn_sdot4((int)a0[i].w, (int)b.w, s0, false);
            s1 = __builtin_amdgcn_sdot4((int)a1[i].x, (int)b.x, s1, false); s1 = __builtin_amdgcn_sdot4((int)a1[i].y, (int)b.y, s1, false); s1 = __builtin_amdgcn_sdot4((int)a1[i].z, (int)b.z, s1, false); s1 = __builtin_amdgcn_sdot4((int)a1[i].w, (int)b.w, s1, false); }
#pragma unroll
        for (int d = 32; d >= 1; d >>= 1) { s0 += __shfl_xor(s0, d); s1 += __shfl_xor(s1, d); }
        if (lane == 0) f(n, s0, s1);
    }
}

__device__ __forceinline__ void p_conv_fix(const P& p, int G) {
    const int tid = threadIdx.x;
    const float* HALO = (const float*)(p.ws + WS_ZF); bf16_t* ACT = (bf16_t*)(p.ws + WS_ACT);
    const float* cw = p.in[I_CW]; const float* cb = p.in[I_CB];
    const int nitems = 64 * 2 * DFF;
    for (int it = blockIdx.x * NT + tid; it < nitems; it += G * NT) {
        const int c = it % DFF, d = (it / DFF) & 1, pm = 1 + it / (2 * DFF);
        const int r = pm * 256 + d; if (r >= L) continue;
        const int T = c >> 7, cl = c & 127; const int colg = T * 256 + cl, colu = colg + 128;
        const float* h0 = HALO + ((size_t)(pm - 1) * 4 + 2 + d) * NFI; const float* h1 = d == 0 ? HALO + ((size_t)(pm - 1) * 4 + 3) * NFI : HALO + ((size_t)pm * 4 + 0) * NFI; const float* h2 = HALO + ((size_t)pm * 4 + d) * NFI;
        const float zg = cb[c] + cw[c] * h0[colg] + cw[(size_t)NFI + c] * h1[colg] + cw[(size_t)2 * NFI + c] * h2[colg];
        const float zu = cb[DFF + c] + cw[DFF + c] * h0[colu] + cw[(size_t)NFI + DFF + c] * h1[colu] + cw[(size_t)2 * NFI + DFF + c] * h2[colu];
        ACT[(size_t)r * DFF + c] = f2bf(zg * sigm(zg) * zu);
    }
}

constexpr int NPHASE = 20;
__global__ void __launch_bounds__(NT, 2) fwd_kernel(P p) {
    extern __shared__ __attribute__((aligned(16))) unsigned char lds_raw[];
    LAS unsigned char* lds = (LAS unsigned char*)lds_raw;
    const int G = gridDim.x;
    unsigned char* ws = p.ws;
    volatile LAS unsigned* MISC = (volatile LAS unsigned*)(lds + MISC_OFF);
    if (threadIdx.x < 16) MISC[threadIdx.x] = 0u;
    __syncthreads();
#if MK_ONE_LAUNCH
    XcdBarrier bar = xcd_barrier_post((unsigned*)(ws + WS_CTL), MISC + 8);
#define GRID_BAR() xcd_barrier(bar)
#else
#define GRID_BAR() do {} while (0)
#endif
    unsigned long long tsA0 = 0, tsA1 = 0, tsB0 = 0, tsB1 = 0; (void)tsA0; (void)tsA1; (void)tsB0; (void)tsB1;
    const int lo = p.ph_lo, hi = p.ph_hi;
#ifndef PHASE_MASK
#define PHASE_MASK 0xFFFFFFFu
#endif
#define IN(k) ((((PHASE_MASK) >> (k)) & 1u) && lo <= (k) && (k) < hi)
#ifndef STAMP_A0
#define STAMP_A0 -1
#endif
#if STAMP_A0 >= 0
#define STAMP(k) do { if (blockIdx.x == 0 && threadIdx.x == 0) { const unsigned long long t_ = __builtin_amdgcn_s_memrealtime(); if ((k) == STAMP_A0) tsA0 = t_; if ((k) == STAMP_A1) tsA1 = t_; if ((k) == STAMP_B0) tsB0 = t_; if ((k) == STAMP_B1) { tsB1 = t_; \
    __hip_atomic_store((unsigned*)(ws + WS_CTL) + 65536, (unsigned)(tsB1 - tsB0), __ATOMIC_RELAXED, __HIP_MEMORY_SCOPE_AGENT); } } } while (0)
#else
#define STAMP(k) do {} while (0)
#endif
#define SEAM(k) do { if (IN((k) + 1)) GRID_BAR(); STAMP((k) + 1); } while (0)
    STAMP(0);
#ifndef PROBE_REP_MASK
#define PROBE_REP_MASK 0u
#endif
#define NREP(k) ((((PROBE_REP_MASK) >> (k)) & 1u) ? 2 : 1)
    bf16_t* U = (bf16_t*)(ws + WS_U);
    if (IN(0)) _Pragma("unroll") for (int rep_ = 0; rep_ < NREP(0); ++rep_) { p0_prologue_a(p, lds, G); GRID_BAR(); p0_prologue_b(p, lds, G); if (rep_ == NREP(0) - 1) SEAM(0); }
    if (IN(1)) _Pragma("unroll") for (int rep_ = 0; rep_ < NREP(1); ++rep_) {
        {   pg8::Gemm g{U, (const bf16_t*)(ws + WS_WINT), MP, NZ8, D / 2, (const float*)(ws + WS_CTL + CT_SA), (const float*)(ws + WS_CTL + CT_SB_IN)}; pg8::StaticOrder S; S.init(MP, NZ8, G, (int)blockIdx.x);
            pg8::EpiBf16<0> E{(bf16_t*)(ws + WS_Z), NZ};
            pg8::gemm_phase<pg8::EpiBf16<0>, pg8::StaticOrder, true, true, true>(lds, g, S, E); }
        {   pg8::Gemm g{(const bf16_t*)(ws + WS_R1), (const bf16_t*)(ws + WS_WINT + WINT_BF_OFF), MP, NZ - NZ8, D}; pg8::StaticOrder S; S.init(MP, NZ - NZ8, G, (int)blockIdx.x);
            pg8::EpiBf16<0> E{(bf16_t*)(ws + WS_Z) + NZ8, NZ};
            pg8::gemm_phase<pg8::EpiBf16<0>, pg8::StaticOrder, true, true, false>(lds, g, S, E); }
        if (rep_ == NREP(1) - 1) SEAM(1);
    }
    if (IN(2)) _Pragma("unroll") for (int rep_ = 0; rep_ < NREP(2); ++rep_) { p2_rwkv_prep(p, lds, G); if (rep_ == NREP(2) - 1) SEAM(2); }
    if (IN(3)) _Pragma("unroll") for (int rep_ = 0; rep_ < NREP(3); ++rep_) { ra_items(p, lds, G); if (rep_ == NREP(3) - 1) SEAM(3); }
    if (IN(4)) _Pragma("unroll") for (int rep_ = 0; rep_ < NREP(4); ++rep_) { rb_chain(p, G);
        {
            const int wv_ = threadIdx.x >> 6, nch_ = G < 128 ? G : 128; const int nvw_ = nch_ * 7 + (G - nch_) * 8;
            const int vw_ = (int)blockIdx.x < nch_ ? ((int)blockIdx.x * 7 + wv_ - 1) : (nch_ * 7 + ((int)blockIdx.x - nch_) * 8 + wv_);
            if (!((int)blockIdx.x < nch_ && wv_ == 0)) p0b_weights(p, lds, vw_, nvw_); }
        if (rep_ == NREP(4) - 1) SEAM(4); }
    if (IN(5)) _Pragma("unroll") for (int rep_ = 0; rep_ < NREP(5); ++rep_) { rc_out(p, G); if (rep_ == NREP(5) - 1) SEAM(5); }
    if (IN(6)) _Pragma("unroll") for (int rep_ = 0; rep_ < NREP(6); ++rep_) { p4_dsa_prep(p, G); if (rep_ == NREP(6) - 1) SEAM(6); }
    if (IN(7)) _Pragma("unroll") for (int rep_ = 0; rep_ < NREP(7); ++rep_) { d2_topk(p, lds, G); if (rep_ == NREP(7) - 1) SEAM(7); }
    if (IN(8)) _Pragma("unroll") for (int rep_ = 0; rep_ < NREP(8); ++rep_) { d3_qlat(p, G); if (rep_ == NREP(8) - 1) SEAM(8); }
    if (IN(9)) _Pragma("unroll") for (int rep_ = 0; rep_ < NREP(9); ++rep_) { d4_attn(p, lds, G); if (rep_ == NREP(9) - 1) SEAM(9); }
    if (IN(11)) _Pragma("unroll") for (int rep_ = 0; rep_ < NREP(11); ++rep_) {
        d5_oproj(p, G);
        pg8::Gemm g{U + (size_t)NMETA * (D / 2), (const bf16_t*)(ws + WS_WGT), SEQ, 8192, D / 2, (const float*)(ws + WS_CTL + CT_SA) + NMETA, (const float*)(ws + WS_CTL + CT_SB_G)}; pg8::StaticOrder S; S.init(SEQ, 8192, G, (int)blockIdx.x);
        pg8::EpiBf16<1> E{(bf16_t*)(ws + WS_GATES) + (size_t)NMETA * 8192, 8192};
        pg8::gemm_phase<pg8::EpiBf16<1>, pg8::StaticOrder, true, true, true>(lds, g, S, E);
        {   const float* SA_ = (const float*)(ws + WS_CTL + CT_SA); const float* SB_ = (const float*)(ws + WS_CTL + CT_SB_G); bf16_t* GT = (bf16_t*)(ws + WS_GATES);
            side2_i8((const signed char*)(ws + WS_U) + (size_t)14 * D, (const signed char*)(ws + WS_WGT), 8192, G, [&](int n, int i0, int i1) {
                GT[(size_t)14 * 8192 + n] = f2bf(1.f / (1.f + __expf(-(float)i0 * SA_[14] * SB_[n]))); GT[(size_t)15 * 8192 + n] = f2bf(1.f / (1.f + __expf(-(float)i1 * SA_[15] * SB_[n]))); }); }
        if (rep_ == NREP(11) - 1) SEAM(11);
    }
    if (IN(12)) _Pragma("unroll") for (int rep_ = 0; rep_ < NREP(12); ++rep_) {
        pg8::Gemm g{(const bf16_t*)(ws + WS_YA) + (size_t)NMETA * A_W, (const bf16_t*)(ws + WS_WPAT), SEQ, D, A_W}; pg8::StaticOrder S; S.init(SEQ, D, G, (int)blockIdx.x);
        pg8::EpiGateMulF32 E{(bf16_t*)(ws + WS_MF) + (size_t)NMETA * D, D, (const bf16_t*)(ws + WS_GATES) + (size_t)NMETA * 8192, 8192, 0};
        pg8::gemm_phase<pg8::EpiGateMulF32, pg8::StaticOrder, true, true>(lds, g, S, E);
        {   bf16_t* MA = (bf16_t*)(ws + WS_MF); const bf16_t* GT = (const bf16_t*)(ws + WS_GATES);
            side2<2048>((const bf16_t*)(ws + WS_YA) + (size_t)14 * A_W, A_W, (const bf16_t*)(ws + WS_WPAT), D, G, [&](int n, float s0, float s1) {
                MA[(size_t)14 * D + n] = f2bf(bf2f(GT[(size_t)14 * 8192 + n]) * s0); MA[(size_t)15 * D + n] = f2bf(bf2f(GT[(size_t)15 * 8192 + n]) * s1); }); }
        if (rep_ == NREP(12) - 1) SEAM(12);
    }
    if (IN(13)) _Pragma("unroll") for (int rep_ = 0; rep_ < NREP(13); ++rep_) {
        pg8::Gemm g{(const bf16_t*)(ws + WS_YB) + (size_t)NMETA * A_W, (const bf16_t*)(ws + WS_WPBT), SEQ, D, A_W}; pg8::StaticOrder S; S.init(SEQ, D, G, (int)blockIdx.x);
        pg8::EpiGateMulAddBf16 E{U + (size_t)NMETA * D, D, (const bf16_t*)(ws + WS_MF) + (size_t)NMETA * D, (const bf16_t*)(ws + WS_GATES) + (size_t)NMETA * 8192, 8192, D};
        pg8::gemm_phase<pg8::EpiGateMulAddBf16, pg8::StaticOrder, true, true>(lds, g, S, E);
        {   const bf16_t* MA = (const bf16_t*)(ws + WS_MF); const bf16_t* GT = (const bf16_t*)(ws + WS_GATES);
            side2<2048>((const bf16_t*)(ws + WS_YB) + (size_t)14 * A_W, A_W, (const bf16_t*)(ws + WS_WPBT), D, G, [&](int n, float s0, float s1) {
                U[(size_t)14 * D + n] = f2bf(bf2f(MA[(size_t)14 * D + n]) + bf2f(GT[(size_t)14 * 8192 + D + n]) * s0); U[(size_t)15 * D + n] = f2bf(bf2f(MA[(size_t)15 * D + n]) + bf2f(GT[(size_t)15 * 8192 + D + n]) * s1); }); }
        if (rep_ == NREP(13) - 1) SEAM(13);
    }
    if (IN(14)) _Pragma("unroll") for (int rep_ = 0; rep_ < NREP(14); ++rep_) {
        pg8::Gemm g{U + (size_t)NMETA * D, (const bf16_t*)(ws + WS_WOUTT), SEQ, D, D}; pg8::StaticOrder S; S.init(SEQ, D, G, (int)blockIdx.x);
        pg8::EpiResid E{p.in[I_X], p.in[I_X], p.out, p.out, D, 0, SEQ};
        pg8::gemm_phase<pg8::EpiResid, pg8::StaticOrder, true, true>(lds, g, S, E);
        {   float* HM = (float*)(ws + WS_HMETA); const float* mt = p.in[I_META];
            for (int i2 = blockIdx.x * NT + threadIdx.x; i2 < 14 * D; i2 += G * NT) HM[i2] = mt[i2];
            side2<4096>(U + (size_t)14 * D, D, (const bf16_t*)(ws + WS_WOUTT), D, G, [&](int n, float s0, float s1) { HM[(size_t)14 * D + n] = mt[(size_t)14 * D + n] + s0; HM[(size_t)15 * D + n] = mt[(size_t)15 * D + n] + s1; }); }
        if (rep_ == NREP(14) - 1) SEAM(14);
    }
    if (IN(15)) _Pragma("unroll") for (int rep_ = 0; rep_ < NREP(15); ++rep_) { p12_norm(p, G); if (rep_ == NREP(15) - 1) SEAM(15); }
    if (IN(16)) _Pragma("unroll") for (int rep_ = 0; rep_ < NREP(16); ++rep_) {
        pg8::Gemm g{U, (const bf16_t*)(ws + WS_WFIT), MP, NFI, D / 2, (const float*)(ws + WS_CTL + CT_SA), (const float*)(ws + WS_CTL + CT_SB_F)}; pg8::StaticOrder S; S.init(MP, NFI, G, (int)blockIdx.x);
        pg8::EpiConvAct E{(bf16_t*)(ws + WS_ACT), DFF, (float*)(ws + WS_ZF), NFI, p.in[I_CW], p.in[I_CB], DFF, (PG8_LAS float*)(lds + 131072), (const float*)(ws + WS_CTL + CT_SAG), (const float*)(ws + WS_CTL + CT_SB_F)};
        pg8::gemm_phase<pg8::EpiConvAct, pg8::StaticOrder, true, true, true>(lds, g, S, E);
        if (rep_ == NREP(16) - 1) SEAM(16);
    }
    if (IN(17)) _Pragma("unroll") for (int rep_ = 0; rep_ < NREP(17); ++rep_) { p_conv_fix(p, G); if (rep_ == NREP(17) - 1) SEAM(17); }
    if (IN(18)) _Pragma("unroll") for (int rep_ = 0; rep_ < NREP(18); ++rep_) {
        pg8::Gemm g{(const bf16_t*)(ws + WS_ACT) + (size_t)NMETA * DFF, (const bf16_t*)(ws + WS_WFOT), SEQ, D, DFF}; pg8::StaticOrder S; S.init(SEQ, D, G, (int)blockIdx.x);
        pg8::EpiResid E{p.out, p.out, p.out, p.out, D, 0, SEQ};
        pg8::gemm_phase<pg8::EpiResid, pg8::StaticOrder, true, true>(lds, g, S, E);
        if (rep_ == NREP(18) - 1) SEAM(18);
    }
    if (IN(19)) _Pragma("unroll") for (int rep_ = 0; rep_ < NREP(19); ++rep_) { p18_final_norm(p, G); }
#if STAMP_A0 >= 0
    if (blockIdx.x == 0 && threadIdx.x == 0) { const unsigned long long t_end = __builtin_amdgcn_s_memrealtime(); unsigned long long dA = (tsA1 - tsA0) * 64ull;
#if defined(ATT_REG) && ATT_REG > 0
        dA = (unsigned long long)__hip_atomic_load((const unsigned*)(ws + WS_CTL) + 65540, __ATOMIC_RELAXED, __HIP_MEMORY_SCOPE_AGENT) * 64ull;
#endif
        while (__builtin_amdgcn_s_memrealtime() - t_end < dA) __builtin_amdgcn_s_sleep(8); }
#endif
#undef IN
#undef SEAM
}

extern "C" void kernel_launch(void* const* d_in, const int* in_sizes, int n_in, void* d_out, int out_size, void* d_ws, size_t ws_size, hipStream_t stream) {
    static int grid = 0;
    if (grid == 0) {
        if (n_in != 30 || out_size != SEQ * D || ws_size < WS_END2) { fprintf(stderr, "kernel_launch: unexpected shapes (n_in %d out %d ws %zu need %zu)\n", n_in, out_size, ws_size, (size_t)WS_END); grid = -1; return; }
        int dev = 0, cus = 0, per_cu = 0;
        if (hipGetDevice(&dev) != hipSuccess || hipDeviceGetAttribute(&cus, hipDeviceAttributeMultiprocessorCount, dev) != hipSuccess) { grid = -1; return; }
        if (hipFuncSetAttribute((const void*)fwd_kernel, hipFuncAttributeMaxDynamicSharedMemorySize, LDS_BYTES) != hipSuccess) { fprintf(stderr, "kernel_launch: hipFuncSetAttribute failed\n"); grid = -1; return; }
        if (hipOccupancyMaxActiveBlocksPerMultiprocessor(&per_cu, (const void*)fwd_kernel, NT, LDS_BYTES) != hipSuccess || per_cu < 1) fprintf(stderr, "kernel_launch: occupancy query says %d\n", per_cu);
        (void)hipGetLastError();
        grid = cus;
    }
    if (grid < 0) return;
    (void)hipMemsetAsync((char*)d_ws + WS_CTL, 0, CTL_BYTES, stream);
    P a{};
    for (int i = 0; i < 30; ++i) a.in[i] = (const float*)d_in[i];
    a.out = (float*)d_out; a.ws = (unsigned char*)d_ws;
#if MK_ONE_LAUNCH
    a.ph_lo = 0; a.ph_hi = NPHASE;
    hipLaunchKernelGGL(fwd_kernel, dim3(grid), dim3(NT), LDS_BYTES, stream, a);
#else
    for (int k = 0; k < NPHASE; ++k) { a.ph_lo = k; a.ph_hi = k + 1; hipLaunchKernelGGL(fwd_kernel, dim3(grid), dim3(NT), LDS_BYTES, stream, a); }
#endif
}
```

```cpp
#include <hip/hip_runtime.h>
#include <cstdio>
#include <cstdint>
#define MK_ONE_LAUNCH 1
namespace pg8 {
#define PG8_LAS __attribute__((address_space(3)))
typedef unsigned short bf16_t;
typedef short bf16x8 __attribute__((ext_vector_type(8)));
typedef float f32x4 __attribute__((ext_vector_type(4)));
typedef unsigned u32x4 __attribute__((ext_vector_type(4)));
typedef int i32x4 __attribute__((ext_vector_type(4)));
constexpr int BM = 256, BK = 64, HALF = 128, HTB = HALF * BK * 2  , STAGE_BYTES = 8 * HTB, NXCD = 8, WGM = 4;

__host__ __device__ __forceinline__ int lds_byte(int r, int c) { const int st = (r >> 4) * 2 + (c >> 5), rr = r & 15, cc = c & 31, ob = rr * 64 + cc * 2; return st * 1024 + (ob ^ (((ob >> 9) & 1) << 5)); }
__host__ __device__ __forceinline__ void stage_rc(int b, int& R, int& C) { const int st = b / 1024, sb = b % 1024, swz = sb ^ (((sb >> 9) & 1) << 5); R = (st >> 1) * 16 + swz / 64; C = (st & 1) * 32 + (swz % 64) / 2; }
__host__ __device__ __forceinline__ int perm32(int rho) { const int n = rho >> 4, i = rho & 15; return 8 * (i >> 2) + 4 * n + (i & 3); }

struct Unit { int pm, pn; };
struct Gemm { const bf16_t* A; const bf16_t* Bt; int M, N, K; const float* sa; const float* sb; };

struct StaticOrder {
    int nM, nN, nwg, G, c;
    __host__ __device__ void init(int M, int N, int G_, int c_) { nM = M / BM; nN = N / BM; nwg = nM * nN; G = G_; c = c_; }
    __host__ __device__ bool next(int i, Unit& u) const {
        const long L = (long)i * G + c; if (L >= nwg) return false;
        int wgid = (int)L; { const int q = nwg / NXCD, r = nwg % NXCD, xcd = wgid % NXCD, off = wgid / NXCD; wgid = (xcd < r ? xcd * (q + 1) : r * (q + 1) + (xcd - r) * q) + off; }
        const int nig = WGM * nN, gid = wgid / nig, fm = gid * WGM, gsz = (nM - fm) < WGM ? (nM - fm) : WGM;
        u.pm = fm + ((wgid % nig) % gsz); u.pn = (wgid % nig) / gsz; return true;
    }
    __device__ __forceinline__ void a_ready(const Unit&) const {}
    __device__ __forceinline__ void done(const Unit&) const {}
};

__device__ __forceinline__ unsigned cvt_pk_bf16(float lo, float hi) { unsigned r; asm volatile("v_cvt_pk_bf16_f32 %0, %1, %2" : "=v"(r) : "v"(lo), "v"(hi)); return r; }
typedef float f32x2 __attribute__((ext_vector_type(2)));

typedef unsigned u32x2 __attribute__((ext_vector_type(2)));
__device__ __forceinline__ float bf_lo(unsigned w) { return __uint_as_float(w << 16); }
__device__ __forceinline__ float bf_hi(unsigned w) { return __uint_as_float(w & 0xffff0000u); }
__device__ __forceinline__ float sigmoidf_(float x) { return 1.f / (1.f + __expf(-x)); }

template <int ACT> struct EpiBf16 {
    static constexpr bool PERM = true, AFTER_DRAIN = false, SELF_SCALE = false;
    bf16_t* O; int ldc;
    __device__ __forceinline__ void operator()(const f32x4 (&acc)[2][2][4][2], const Unit& u, int wr, int wc, int fr, int fq) const {
        const int row0 = u.pm * BM + wr * 64 + fr; const int col0 = u.pn * BM + wc * 32 + 8 * fq;
#pragma unroll
        for (int ai = 0; ai < 2; ++ai)
#pragma unroll
            for (int m = 0; m < 4; ++m) { bf16_t* rowp = O + (size_t)(row0 + ai * HALF + m * 16) * ldc + col0;
#pragma unroll
                for (int bj = 0; bj < 2; ++bj) { f32x4 v0 = acc[ai][bj][m][0], v1 = acc[ai][bj][m][1];
                    if (ACT == 1) {
#pragma unroll
                        for (int e = 0; e < 4; ++e) { v0[e] = sigmoidf_(v0[e]); v1[e] = sigmoidf_(v1[e]); } }
                    u32x4 w; w.x = cvt_pk_bf16(v0[0], v0[1]); w.y = cvt_pk_bf16(v0[2], v0[3]); w.z = cvt_pk_bf16(v1[0], v1[1]); w.w = cvt_pk_bf16(v1[2], v1[3]);
                    *(u32x4*)(rowp + bj * HALF) = w; } }
    }
};
struct EpiGateMulF32 {
    static constexpr bool PERM = true, AFTER_DRAIN = false, SELF_SCALE = false;
    bf16_t* MA; int ldc; const bf16_t* G; int ldg; int gcol0;
    __device__ __forceinline__ void operator()(const f32x4 (&acc)[2][2][4][2], const Unit& u, int wr, int wc, int fr, int fq) const {
        const int row0 = u.pm * BM + wr * 64 + fr, col0 = u.pn * BM + wc * 32 + 8 * fq;
#pragma unroll
        for (int ai = 0; ai < 2; ++ai)
#pragma unroll
            for (int m = 0; m < 4; ++m) { const size_t r = (size_t)(row0 + ai * HALF + m * 16); bf16_t* rowp = MA + r * ldc + col0; const bf16_t* gp = G + r * ldg + gcol0 + col0;
#pragma unroll
                for (int bj = 0; bj < 2; ++bj) { const u32x4 g = *(const u32x4*)(gp + bj * HALF); const f32x4 a0 = acc[ai][bj][m][0], a1 = acc[ai][bj][m][1];
                    u32x4 w; w.x = cvt_pk_bf16(a0[0] * bf_lo(g.x), a0[1] * bf_hi(g.x)); w.y = cvt_pk_bf16(a0[2] * bf_lo(g.y), a0[3] * bf_hi(g.y));
                    w.z = cvt_pk_bf16(a1[0] * bf_lo(g.z), a1[1] * bf_hi(g.z)); w.w = cvt_pk_bf16(a1[2] * bf_lo(g.w), a1[3] * bf_hi(g.w));
                    *(u32x4*)(rowp + bj * HALF) = w; } }
    }
};
struct EpiGateMulAddBf16 {
    static constexpr bool PERM = true, AFTER_DRAIN = false, SELF_SCALE = false;
    bf16_t* MB; int ldc; const bf16_t* MA; const bf16_t* G; int ldg; int gcol0;
    __device__ __forceinline__ void operator()(const f32x4 (&acc)[2][2][4][2], const Unit& u, int wr, int wc, int fr, int fq) const {
        const int row0 = u.pm * BM + wr * 64 + fr, col0 = u.pn * BM + wc * 32 + 8 * fq;
#pragma unroll
        for (int ai = 0; ai < 2; ++ai)
#pragma unroll
            for (int m = 0; m < 4; ++m) { const size_t r = (size_t)(row0 + ai * HALF + m * 16); bf16_t* rowp = MB + r * ldc + col0; const bf16_t* mp = MA + r * ldc + col0; const bf16_t* gp = G + r * ldg + gcol0 + col0;
#pragma unroll
                for (int bj = 0; bj < 2; ++bj) { const u32x4 g = *(const u32x4*)(gp + bj * HALF); const u32x4 mm = *(const u32x4*)(mp + bj * HALF);
                    const f32x4 a0 = acc[ai][bj][m][0], a1 = acc[ai][bj][m][1];
                    u32x4 w; w.x = cvt_pk_bf16(bf_lo(mm.x) + a0[0] * bf_lo(g.x), bf_hi(mm.x) + a0[1] * bf_hi(g.x)); w.y = cvt_pk_bf16(bf_lo(mm.y) + a0[2] * bf_lo(g.y), bf_hi(mm.y) + a0[3] * bf_hi(g.y));
                    w.z = cvt_pk_bf16(bf_lo(mm.z) + a1[0] * bf_lo(g.z), bf_hi(mm.z) + a1[1] * bf_hi(g.z)); w.w = cvt_pk_bf16(bf_lo(mm.w) + a1[2] * bf_lo(g.w), bf_hi(mm.w) + a1[3] * bf_hi(g.w));
                    *(u32x4*)(rowp + bj * HALF) = w; } }
    }
};
struct EpiResid {
    static constexpr bool PERM = false, AFTER_DRAIN = false, SELF_SCALE = false;
    const float* smeta; const float* sreal; float* dmeta; float* dreal; int ld; int nmeta; int nrows;
    __device__ __forceinline__ void operator()(const f32x4 (&acc)[2][2][4][2], const Unit& u, int wr, int wc, int fr, int fq) const {
        const int row0 = u.pm * BM + wr * 64 + fr, col0 = u.pn * BM + wc * 32 + 4 * fq;
#pragma unroll
        for (int ai = 0; ai < 2; ++ai)
#pragma unroll
            for (int m = 0; m < 4; ++m) { const int r = row0 + ai * HALF + m * 16;
                if (r < nrows) {
                    const float* sp = (r < nmeta ? smeta + (size_t)r * ld : sreal + (size_t)(r - nmeta) * ld) + col0;
                    float* dp = (r < nmeta ? dmeta + (size_t)r * ld : dreal + (size_t)(r - nmeta) * ld) + col0;
#pragma unroll
                    for (int bj = 0; bj < 2; ++bj)
#pragma unroll
                        for (int n = 0; n < 2; ++n) *(f32x4*)(dp + bj * HALF + n * 16) = *(const f32x4*)(sp + bj * HALF + n * 16) + acc[ai][bj][m][n];
                } }
    }
};

template <int CTRL> __device__ __forceinline__ float dpp_mov(float v) { return __builtin_bit_cast(float, __builtin_amdgcn_update_dpp(0, __builtin_bit_cast(int, v), CTRL, 0xf, 0xf, false)); }
struct EpiConvAct {
    static constexpr bool PERM = true, AFTER_DRAIN = false, SELF_SCALE = true;
    bf16_t* ACT; int ldact; float* HALO; int ldh; const float* cw; const float* cb; int dff; PG8_LAS float* hx; const float* sag; const float* sb;
    __device__ __forceinline__ void operator()(const f32x4 (&acc)[2][2][4][2], const Unit& u, int wr, int wc, int fr, int fq) const {
        const int cl = wc * 32 + 8 * fq;
        const int ch = u.pn * 128 + cl;
        if (fr >= 14) {
#pragma unroll
            for (int ai = 0; ai < 2; ++ai)
#pragma unroll
                for (int bj = 0; bj < 2; ++bj)
#pragma unroll
                    for (int n = 0; n < 2; ++n) *(PG8_LAS f32x4*)(hx + (((ai * 2 + wr) * 2 + (fr - 14)) * 256 + bj * 128 + cl + 4 * n)) = acc[ai][bj][3][n];
        }
        if (wr == 0 && fr < 2) {
            float* hp = HALO + ((size_t)u.pm * 4 + fr) * ldh + u.pn * 256 + cl;
#pragma unroll
            for (int bj = 0; bj < 2; ++bj)
#pragma unroll
                for (int n = 0; n < 2; ++n) *(f32x4*)(hp + bj * 128 + 4 * n) = acc[0][bj][0][n] * (*(const f32x4*)(sb + u.pn * 256 + bj * 128 + cl + 4 * n) * sag[0]);
        }
        if (wr == 1 && fr >= 14) {
            float* hp = HALO + ((size_t)u.pm * 4 + (fr - 12)) * ldh + u.pn * 256 + cl;
#pragma unroll
            for (int bj = 0; bj < 2; ++bj)
#pragma unroll
                for (int n = 0; n < 2; ++n) *(f32x4*)(hp + bj * 128 + 4 * n) = acc[1][bj][3][n] * (*(const f32x4*)(sb + u.pn * 256 + bj * 128 + cl + 4 * n) * sag[0]);
        }
        asm volatile("s_waitcnt lgkmcnt(0)" ::: "memory"); __builtin_amdgcn_s_barrier(); asm volatile("" ::: "memory");
#pragma unroll
        for (int n = 0; n < 2; ++n) {
            f32x4 wt[2][3], bb[2];
#pragma unroll
            for (int bj = 0; bj < 2; ++bj) { bb[bj] = *(const f32x4*)(cb + bj * dff + ch + 4 * n);
#pragma unroll
                for (int i = 0; i < 3; ++i) wt[bj][i] = *(const f32x4*)(cw + (size_t)i * 2 * dff + bj * dff + ch + 4 * n) * (*(const f32x4*)(sb + u.pn * 256 + bj * 128 + cl + 4 * n) * sag[0]); }
#pragma unroll
            for (int ai = 0; ai < 2; ++ai) {
                const bool hasprev = (ai | wr) != 0; const int pb = ai * 2 + wr - 1;
                f32x4 xp[2];
#pragma unroll
                for (int bj = 0; bj < 2; ++bj) { xp[bj] = (f32x4){0.f, 0.f, 0.f, 0.f};
                    if (hasprev && fr >= 14) xp[bj] = *(const PG8_LAS f32x4*)(hx + ((pb * 2 + (fr - 14)) * 256 + bj * 128 + cl + 4 * n)); }
#pragma unroll
                for (int m = 0; m < 4; ++m) {
                    f32x4 z[2];
#pragma unroll
                    for (int bj = 0; bj < 2; ++bj) {
                        const f32x4 x = acc[ai][bj][m][n];
#pragma unroll
                        for (int j = 0; j < 4; ++j) {
                            const float a1 = dpp_mov<0x121>(x[j]), p1 = dpp_mov<0x121>(xp[bj][j]), a2 = dpp_mov<0x122>(x[j]), p2 = dpp_mov<0x122>(xp[bj][j]);
                            const float s1 = fr == 0 ? p1 : a1, s2 = fr < 2 ? p2 : a2;
                            z[bj][j] = bb[bj][j] + wt[bj][2][j] * x[j] + wt[bj][1][j] * s1 + wt[bj][0][j] * s2;
                        }
                        xp[bj] = x;
                    }
                    const int r = u.pm * BM + ai * HALF + wr * 64 + m * 16 + fr;
                    float o[4];
#pragma unroll
                    for (int j = 0; j < 4; ++j) { const float g = z[0][j]; o[j] = g * __builtin_amdgcn_rcpf(1.f + __expf(-g)) * z[1][j]; }
                    u32x2 w; w.x = cvt_pk_bf16(o[0], o[1]); w.y = cvt_pk_bf16(o[2], o[3]);
                    *(u32x2*)(ACT + (size_t)r * ldact + ch + 4 * n) = w;
                }
                asm volatile("" ::: "memory");
            }
        }
    }
};
template <class Epi, class Sched, bool ALIGN_EPI = false, bool SP2 = false, bool I8 = false>
__device__ __forceinline__ void gemm_phase(PG8_LAS unsigned char* lds, const Gemm g, const Sched& S, const Epi& E) {
    const int tid = threadIdx.x, wid = __builtin_amdgcn_readfirstlane(tid >> 6), lane = tid & 63, wr = wid >> 2, wc = wid & 3, fr = lane & 15, fq = lane >> 4;
    const int K = g.K, nt = K / BK;
    unsigned voffA[2], voffB[2];
#pragma unroll
    for (int i = 0; i < 2; ++i) { int R, C; stage_rc(tid * 16 + i * 8192, R, C); const int Rb = Epi::PERM ? ((R & ~31) + perm32(R & 31)) : R;
        voffA[i] = (unsigned)(R * K + C) * 2u; voffB[i] = (unsigned)(Rb * K + C) * 2u; }
    const size_t kstep = (size_t)(BK * 2);
    const size_t hstep = (size_t)HALF * K * 2;
    const size_t tstep = 2 * hstep;
    const unsigned ldsw = (unsigned)wid * 1024u;
    const int aoff = lds_byte(wr * 64 + fr, fq * 8), boff = lds_byte(wc * 32 + fr, fq * 8);
#define PG8_SA(b, h) (((b) * 2 + (h)) * HTB)
#define PG8_SB(b, h) ((4 + (b) * 2 + (h)) * HTB)
#define PG8_STAGE(bufoff, gbase, voff) do { _Pragma("unroll") for (int _i = 0; _i < 2; ++_i) \
        __builtin_amdgcn_global_load_lds((const unsigned*)((const char*)(gbase) + (voff)[_i]), (PG8_LAS unsigned*)(lds + (bufoff) + ldsw + _i * 8192), 16, 0, 0); } while (0)
#define PG8_LDA(dst, b, h) do { _Pragma("unroll") for (int m = 0; m < 4; ++m) _Pragma("unroll") for (int k = 0; k < 2; ++k) dst[m][k] = *(const PG8_LAS bf16x8*)(lds + PG8_SA(b, h) + aoff + m * 2048 + k * 1024); } while (0)
#define PG8_LDB(dst, b, h) do { _Pragma("unroll") for (int n = 0; n < 2; ++n) _Pragma("unroll") for (int k = 0; k < 2; ++k) dst[n][k] = *(const PG8_LAS bf16x8*)(lds + PG8_SB(b, h) + boff + n * 2048 + k * 1024); } while (0)
#define PG8_MMA(ai, bj, At, Bt) do { __builtin_amdgcn_s_setprio(1); _Pragma("unroll") for (int m = 0; m < 4; ++m) _Pragma("unroll") for (int n = 0; n < 2; ++n) _Pragma("unroll") for (int k = 0; k < 2; ++k) { \
        if constexpr (I8) acc[ai][bj][m][n] = __builtin_bit_cast(f32x4, __builtin_amdgcn_mfma_i32_16x16x64_i8(__builtin_bit_cast(i32x4, Bt[n][k]), __builtin_bit_cast(i32x4, At[m][k]), __builtin_bit_cast(i32x4, acc[ai][bj][m][n]), 0, 0, 0)); \
        else acc[ai][bj][m][n] = __builtin_amdgcn_mfma_f32_16x16x32_bf16(Bt[n][k], At[m][k], acc[ai][bj][m][n], 0, 0, 0); } __builtin_amdgcn_s_setprio(0); } while (0)
#define PG8_WAIT_V(n) asm volatile("s_waitcnt vmcnt(" #n ")" ::: "memory")
#define PG8_WAIT_L(n) asm volatile("s_waitcnt lgkmcnt(" #n ")" ::: "memory")
#define PG8_BAR __builtin_amdgcn_s_barrier()
#define PG8_SCHED __builtin_amdgcn_sched_barrier(0)
    Unit cur, nxt; int ui = 0;
    if (!S.next(0, cur)) return;
    f32x4 acc[2][2][4][2];
#pragma unroll
    for (int a = 0; a < 2; ++a)
#pragma unroll
        for (int b = 0; b < 2; ++b)
#pragma unroll
            for (int m = 0; m < 4; ++m)
#pragma unroll
                for (int n = 0; n < 2; ++n) acc[a][b][m][n] = (f32x4){0.f, 0.f, 0.f, 0.f};
    bf16x8 At[4][2], B0[2][2], B1[2][2];
    const char* cA = (const char*)g.A + (size_t)cur.pm * tstep; const char* cB = (const char*)g.Bt + (size_t)cur.pn * tstep;
    S.a_ready(cur);
    if constexpr (SP2) {
        PG8_STAGE(PG8_SB(0, 0), cB, voffB); PG8_STAGE(PG8_SB(0, 1), cB + hstep, voffB); PG8_STAGE(PG8_SA(0, 0), cA, voffA); PG8_STAGE(PG8_SA(0, 1), cA + hstep, voffA);
        if (wr == 1) PG8_BAR;
        PG8_WAIT_V(2); PG8_BAR;
        PG8_STAGE(PG8_SB(1, 0), cB + kstep, voffB); PG8_STAGE(PG8_SA(1, 0), cA + kstep, voffA); PG8_STAGE(PG8_SB(1, 1), cB + hstep + kstep, voffB);
        PG8_WAIT_V(6); PG8_BAR;
    } else {
        PG8_STAGE(PG8_SB(0, 0), cB, voffB); PG8_STAGE(PG8_SA(0, 0), cA, voffA); PG8_STAGE(PG8_SB(0, 1), cB + hstep, voffB); PG8_STAGE(PG8_SA(0, 1), cA + hstep, voffA);
        if (wr == 1) PG8_BAR;
        PG8_WAIT_V(4); PG8_BAR;
        PG8_STAGE(PG8_SB(1, 0), cB + kstep, voffB); PG8_STAGE(PG8_SA(1, 0), cA + kstep, voffA); PG8_STAGE(PG8_SB(1, 1), cB + hstep + kstep, voffB);
        PG8_WAIT_V(6); PG8_BAR;
    }
    for (;;) {
        const bool has_next = S.next(ui + 1, nxt);
        const char* nA = has_next ? (const char*)g.A + (size_t)nxt.pm * tstep : cA; const char* nB = has_next ? (const char*)g.Bt + (size_t)nxt.pn * tstep : cB;
        for (int t = 0; t < nt; t += 2) {
            const bool last = (t == nt - 2);
            const char* a1 = cA + (size_t)(t + 1) * kstep;
            const char* a2 = last ? nA : cA + (size_t)(t + 2) * kstep; const char* b2 = last ? nB : cB + (size_t)(t + 2) * kstep;
            const char* a3 = a2 + kstep; const char* b3 = b2 + kstep;
            if (last && has_next) S.a_ready(nxt);
            if constexpr (SP2) {
            PG8_LDB(B0, 0, 0); PG8_LDB(B1, 0, 1); PG8_SCHED; PG8_LDA(At, 0, 0); PG8_STAGE(PG8_SA(1, 1), a1 + hstep, voffA);
            PG8_WAIT_V(8); PG8_WAIT_L(0); PG8_BAR; PG8_MMA(0, 0, At, B0); PG8_MMA(0, 1, At, B1); PG8_BAR; PG8_SCHED;
            PG8_LDA(At, 0, 1); PG8_STAGE(PG8_SB(0, 0), b2, voffB); PG8_STAGE(PG8_SB(0, 1), b2 + hstep, voffB); PG8_STAGE(PG8_SA(0, 0), a2, voffA);
            PG8_WAIT_V(8); PG8_WAIT_L(0); PG8_BAR; PG8_MMA(1, 0, At, B0); PG8_MMA(1, 1, At, B1); PG8_BAR; PG8_SCHED;
            PG8_LDB(B0, 1, 0); PG8_LDB(B1, 1, 1); PG8_SCHED; PG8_LDA(At, 1, 0); PG8_STAGE(PG8_SA(0, 1), a2 + hstep, voffA);
            PG8_WAIT_V(8); PG8_WAIT_L(0); PG8_BAR; PG8_MMA(0, 0, At, B0); PG8_MMA(0, 1, At, B1); PG8_BAR; PG8_SCHED;
            PG8_LDA(At, 1, 1); PG8_STAGE(PG8_SB(1, 0), b3, voffB); PG8_STAGE(PG8_SB(1, 1), b3 + hstep, voffB); PG8_STAGE(PG8_SA(1, 0), a3, voffA);
            PG8_WAIT_V(8); PG8_WAIT_L(0); PG8_BAR; PG8_MMA(1, 0, At, B0); PG8_MMA(1, 1, At, B1); PG8_BAR; PG8_SCHED;
            } else {
            PG8_LDB(B0, 0, 0); PG8_SCHED; PG8_LDA(At, 0, 0); PG8_STAGE(PG8_SA(1, 1), a1 + hstep, voffA);
            PG8_WAIT_L(8); PG8_BAR; PG8_WAIT_L(0); PG8_MMA(0, 0, At, B0); PG8_BAR; PG8_SCHED;
            PG8_LDB(B1, 0, 1); PG8_STAGE(PG8_SB(0, 0), b2, voffB);
            PG8_BAR; PG8_WAIT_L(0); PG8_MMA(0, 1, At, B1); PG8_BAR;
            PG8_LDA(At, 0, 1); PG8_STAGE(PG8_SA(0, 0), a2, voffA);
            PG8_BAR; PG8_WAIT_L(0); PG8_MMA(1, 0, At, B0); PG8_BAR; PG8_SCHED;
            PG8_STAGE(PG8_SB(0, 1), b2 + hstep, voffB);
            PG8_WAIT_V(6); PG8_BAR; PG8_MMA(1, 1, At, B1); PG8_BAR;
            PG8_LDB(B0, 1, 0); PG8_SCHED; PG8_LDA(At, 1, 0); PG8_STAGE(PG8_SA(0, 1), a2 + hstep, voffA);
            PG8_WAIT_L(8); PG8_BAR; PG8_WAIT_L(0); PG8_MMA(0, 0, At, B0); PG8_BAR; PG8_SCHED;
            PG8_LDB(B1, 1, 1); PG8_STAGE(PG8_SB(1, 0), b3, voffB);
            PG8_BAR; PG8_WAIT_L(0); PG8_MMA(0, 1, At, B1); PG8_BAR;
            PG8_LDA(At, 1, 1); PG8_STAGE(PG8_SA(1, 0), a3, voffA);
            PG8_BAR; PG8_WAIT_L(0); PG8_MMA(1, 0, At, B0); PG8_BAR; PG8_SCHED;
            PG8_STAGE(PG8_SB(1, 1), b3 + hstep, voffB);
            PG8_WAIT_V(6); PG8_BAR; PG8_MMA(1, 1, At, B1); PG8_BAR;
            }
        }
        if constexpr (ALIGN_EPI) { if (wr == 0) PG8_BAR; }
        if constexpr (I8) {
            asm volatile("s_nop 15\n\ts_nop 15" ::: "memory");
#pragma unroll
            for (int ai = 0; ai < 2; ++ai)
#pragma unroll
                for (int bj = 0; bj < 2; ++bj)
#pragma unroll
                    for (int m = 0; m < 4; ++m)
#pragma unroll
                        for (int n = 0; n < 2; ++n)
#pragma unroll
                            for (int j = 0; j < 4; ++j) { float x = acc[ai][bj][m][n][j]; asm volatile("v_cvt_f32_i32 %0, %0" : "+v"(x)); acc[ai][bj][m][n][j] = x; }
            if constexpr (!Epi::SELF_SCALE) {
                const int row0 = cur.pm * BM + wr * 64 + fr, col0 = cur.pn * BM + wc * 32 + (Epi::PERM ? 8 * fq : 4 * fq);
#pragma unroll
                for (int bj = 0; bj < 2; ++bj)
#pragma unroll
                    for (int n = 0; n < 2; ++n) { const f32x4 sc = *(const f32x4*)(g.sb + col0 + bj * HALF + (Epi::PERM ? 4 * n : 16 * n));
#pragma unroll
                        for (int ai = 0; ai < 2; ++ai)
#pragma unroll
                            for (int m = 0; m < 4; ++m) { const float sr = g.sa[row0 + ai * HALF + m * 16]; acc[ai][bj][m][n] = acc[ai][bj][m][n] * (sc * sr); } }
            }
        }
        if constexpr (!Epi::AFTER_DRAIN) { E(acc, cur, wr, wc, fr, fq); S.done(cur); }
        if (!has_next) break;
#pragma unroll
        for (int a = 0; a < 2; ++a)
#pragma unroll
            for (int b = 0; b < 2; ++b)
#pragma unroll
                for (int m = 0; m < 4; ++m)
#pragma unroll
                    for (int n = 0; n < 2; ++n) acc[a][b][m][n] = (f32x4){0.f, 0.f, 0.f, 0.f};
        cur = nxt; cA = nA; cB = nB; ++ui;
        if constexpr (ALIGN_EPI) { if (wr == 1) PG8_BAR; }
    }
    PG8_WAIT_V(0);
    if constexpr (!ALIGN_EPI) { if (wr == 0) PG8_BAR; }
    PG8_BAR;
    if constexpr (Epi::AFTER_DRAIN) { E.fused(acc, cur, wr, wc, fr, fq, lds, wid, lane); S.done(cur); }
#undef PG8_SA
#undef PG8_SB
#undef PG8_STAGE
#undef PG8_LDA
#undef PG8_LDB
#undef PG8_MMA
#undef PG8_WAIT_V
#undef PG8_WAIT_L
#undef PG8_BAR
#undef PG8_SCHED
}
}
#define XB_TMO      128
#define XB_XCNT(j)  (256  + 64 * (j))
#define XB_XSUB(j)  (1280 + 64 * (j))
#define XB_XGEN(j)  (2304 + 64 * (j))
#define XB_TOP      3328
#define XB_TOPGEN   3392
#define XCD_BAR_WORDS 3456
#define XB_SPIN_CAP (1u << 18)
#define LAS __attribute__((address_space(3)))

__device__ __forceinline__ unsigned xb_ld(unsigned* p)              { return __hip_atomic_load(p, __ATOMIC_RELAXED, __HIP_MEMORY_SCOPE_AGENT); }
__device__ __forceinline__ unsigned xb_add(unsigned* p, unsigned v) { return __hip_atomic_fetch_add(p, v, __ATOMIC_RELAXED, __HIP_MEMORY_SCOPE_AGENT); }
__device__ __forceinline__ unsigned xb_xcc_id() { return (unsigned)__builtin_amdgcn_s_getreg((3 << 11) | 20) & 0xFu; }
#define XB_SPIN(cond, bar) do { unsigned _sp = 0; while (cond) { __builtin_amdgcn_s_sleep(1); \
    if ((++_sp & 255u) == 0u) { if (xb_ld(&(bar)[XB_TMO])) break; if (_sp > XB_SPIN_CAP) { atomicAdd(&(bar)[XB_TMO], 1u); break; } } } } while (0)

struct XcdBarrier {
    unsigned* bar; unsigned x;
    volatile LAS unsigned* st;
};

__device__ __forceinline__ XcdBarrier xcd_barrier_post(unsigned* bar, volatile LAS unsigned* st) {
    XcdBarrier b; b.bar = bar; b.x = xb_xcc_id(); b.st = st;
    if (threadIdx.x == 0) (void)xb_add(&bar[XB_XCNT(b.x)], 1u);
    return b;
}
__device__ __forceinline__ void xcd_barrier_complete(unsigned* bar, unsigned x, unsigned& nloc, unsigned& nx) {
    const unsigned G = gridDim.x * gridDim.y * gridDim.z;
    unsigned sum, cnt, mine, sp = 0u;
    for (;;) {
        sum = 0u; cnt = 0u; mine = 0u;
#pragma unroll
        for (unsigned j = 0; j < 16; ++j) { const unsigned c = xb_ld(&bar[XB_XCNT(j)]); sum += c; cnt += (c > 0u) ? 1u : 0u; mine = (j == x) ? c : mine; }
        if (sum == G) break;
        __builtin_amdgcn_s_sleep(1);
        if ((++sp & 255u) == 0u) { if (xb_ld(&bar[XB_TMO])) break; if (sp > XB_SPIN_CAP) { atomicAdd(&bar[XB_TMO], 1u); break; } }
    }
    nloc = mine > 0u ? mine : 1u; nx = cnt > 0u ? cnt : 1u;
}

__device__ __forceinline__ void xcd_barrier(const XcdBarrier& b) {
    asm volatile("s_waitcnt vmcnt(0)" ::: "memory");
    __syncthreads();
    if (threadIdx.x == 0) {
        unsigned* bar = b.bar;
        __builtin_amdgcn_s_waitcnt(0);
        unsigned nloc = b.st[0], nx = b.st[1];
        if (nloc == 0u) { xcd_barrier_complete(bar, b.x, nloc, nx); b.st[0] = nloc; b.st[1] = nx; }
        const unsigned old = xb_add(&bar[XB_XSUB(b.x)], 1u);
        const unsigned gen = old / nloc;
        if (old + 1u == (gen + 1u) * nloc) {
            __builtin_amdgcn_fence(__ATOMIC_RELEASE, "agent");
            asm volatile("s_waitcnt vmcnt(0)" ::: "memory");
            const unsigned og = xb_add(&bar[XB_TOP], 1u);
            const unsigned tg = og / nx;
            if (og + 1u == (tg + 1u) * nx) xb_add(&bar[XB_TOPGEN], 1u);
            else XB_SPIN(xb_ld(&bar[XB_TOPGEN]) == tg, bar);
            __builtin_amdgcn_fence(__ATOMIC_ACQUIRE, "agent");
            xb_add(&bar[XB_XGEN(b.x)], 1u);
            asm volatile("s_waitcnt vmcnt(0)" ::: "memory");
        } else {
            XB_SPIN(xb_ld(&bar[XB_XGEN(b.x)]) == gen, bar);
            __builtin_amdgcn_fence(__ATOMIC_ACQUIRE, "agent");
            asm volatile("s_waitcnt vmcnt(0)" ::: "memory");
        }
    }
    __syncthreads();
}

#define LAS __attribute__((address_space(3)))
typedef unsigned short bf16_t;
typedef float f32x4 __attribute__((ext_vector_type(4)));
typedef unsigned u32x4 __attribute__((ext_vector_type(4)));
typedef unsigned u32x2 __attribute__((ext_vector_type(2)));

#ifndef MK_ONE_LAUNCH
#define MK_ONE_LAUNCH 0
#endif

constexpr int NWAVES = 8, NT = NWAVES * 64;
constexpr int D = 4096, SEQ = 16384, NMETA = 16, L = SEQ + NMETA, MP = 16640;
constexpr int A_W = 2048, A_COLS = 6592, B_COLS = 4704, IN_COLS = A_COLS + B_COLS, NZ = 11520;
constexpr int ZQ = A_COLS, ZCKV = A_COLS + 2048, ZQI = A_COLS + 2560, ZKI = A_COLS + 4608, ZWI = A_COLS + 4672;
constexpr int DFF = 11008, NFI = 2 * DFF;
constexpr int KVR = 512, NH_B = 16, HD_B = 128, IDXH = 32, IDXD = 64, TOPK = 256;
constexpr int LDS_BYTES = 163840, MISC_OFF = 163584;
constexpr int NZ8 = 8960;
constexpr size_t WINT_BF_OFF = (size_t)40 << 20;

constexpr size_t al256(size_t x) { return (x + 255) & ~(size_t)255; }
constexpr size_t WS_CTL = 0, CTL_BYTES = 1u << 20;
constexpr size_t WS_WGT = WS_CTL + CTL_BYTES;
constexpr size_t WS_WPAT = WS_WGT + (size_t)8192 * 4096 * 2;
constexpr size_t WS_WPBT = WS_WPAT + (size_t)4096 * 2048 * 2;
constexpr size_t WS_WOUTT = WS_WPBT + (size_t)4096 * 2048 * 2;
constexpr size_t WS_WFIT = WS_WOUTT + (size_t)4096 * 4096 * 2;
constexpr size_t WS_WFOT = WS_WFIT + (size_t)NFI * 4096 * 2;
constexpr size_t WS_WINT = WS_WFOT + (size_t)4096 * DFF * 2;
constexpr size_t WS_U = WS_WINT + (size_t)NZ * 4096 * 2;
constexpr size_t WS_BIG = WS_U + (size_t)MP * D * 2;
constexpr size_t WS_Z = WS_BIG;
constexpr size_t WS_R1 = WS_Z + (size_t)MP * NZ * 2;
constexpr size_t R1_BYTES = (size_t)MP * D * 4;
constexpr size_t WS_LD = WS_R1;
constexpr size_t WS_AA = WS_LD + (size_t)L * A_W * 4;
constexpr size_t WS_GG = WS_AA + (size_t)L * A_W * 2;
constexpr size_t WS_QLAT = WS_R1;
constexpr size_t WS_MF = WS_R1;
constexpr size_t WS_YA = WS_R1 + R1_BYTES;
constexpr size_t WS_YB = WS_YA + (size_t)MP * A_W * 2;
constexpr size_t WS_END = WS_YB + (size_t)MP * A_W * 2;
constexpr size_t WS_GATES = WS_Z;
constexpr size_t WS_ZF = WS_BIG;
constexpr size_t WS_ACT = WS_BIG + (size_t)MP * DFF * 2;
constexpr size_t WS_CKV = WS_WINT;
constexpr size_t WS_KIDX = WS_CKV + al256((size_t)L * KVR * 2);
constexpr size_t WS_SEL = WS_KIDX + al256((size_t)L * IDXD * 4);
constexpr size_t WS_HMETA = WS_SEL + al256((size_t)L * TOPK * 4);
static_assert(WS_HMETA + (size_t)NMETA * D * 4 <= WS_U, "DSA overlays exceed WINT");
constexpr size_t WS_KIDXB = WS_HMETA + al256((size_t)NMETA * D * 4);
static_assert(WS_KIDXB + (size_t)L * IDXD * 2 <= WS_U, "KIDXB");
constexpr size_t WS_WUKB = WS_END;
constexpr size_t WS_WUVT = WS_WUKB + (size_t)16 * 512 * 128 * 2;
constexpr size_t WS_WLT = WS_WUVT + (size_t)16 * 512 * 128 * 2;
constexpr size_t WS_END2 = WS_WLT + (size_t)2048 * 448 * 2;
static_assert(WS_END2 <= (size_t)4 * 4096 * 22016 * 4, "workspace");
constexpr size_t CT_CMX_IN = 524288, CT_CMX_G = CT_CMX_IN + (size_t)NZ * 4, CT_CMX_F = CT_CMX_G + 8192 * 4, CT_SB_IN = CT_CMX_F + (size_t)NFI * 4, CT_SB_G = CT_SB_IN + (size_t)NZ * 4,
                 CT_SB_F = CT_SB_G + 8192 * 4, CT_SA = CT_SB_F + (size_t)NFI * 4, CT_AMAX = CT_SA + (size_t)MP * 4, CT_SAG = CT_AMAX + 256, CT_END = CT_SAG + 256;
static_assert(CT_END <= CTL_BYTES, "control region");
constexpr size_t WS_ST = WS_WINT;
constexpr size_t WS_BS = WS_ST + al256((size_t)257 * 32 * 4096 * 2);
static_assert(WS_BS + (size_t)L * 32 * 4 <= WS_U, "RWKV overlays exceed WINT");
static_assert((size_t)L * A_W * 4 + 2 * (size_t)L * A_W * 2 <= R1_BYTES && (size_t)L * 8192 * 2 <= R1_BYTES, "R1");
static_assert(WS_ACT + (size_t)MP * DFF * 2 <= WS_END, "ACT");
static_assert((size_t)MP * 8192 * 2 <= (size_t)MP * NZ * 2, "GATES");
static_assert(WS_END <= (size_t)4 * 4096 * 22016 * 4, "workspace");

__device__ __forceinline__ float bf2f(bf16_t b) { return __uint_as_float(((unsigned)b) << 16); }
__device__ __forceinline__ bf16_t f2bf(float f) { unsigned u = __float_as_uint(f); u += 0x7FFFu + ((u >> 16) & 1u); return (bf16_t)(u >> 16); }
__device__ __forceinline__ unsigned pk2(float lo, float hi) { return (unsigned)f2bf(lo) | ((unsigned)f2bf(hi) << 16); }
__device__ __forceinline__ float blo(unsigned w) { return __uint_as_float(w << 16); }
__device__ __forceinline__ float bhi(unsigned w) { return __uint_as_float(w & 0xffff0000u); }
__device__ __forceinline__ float sigm(float x) { return 1.f / (1.f + __expf(-x)); }
template <int CTRL> __device__ __forceinline__ float dpp_f(float v) { return __builtin_bit_cast(float, __builtin_amdgcn_update_dpp(0, __builtin_bit_cast(int, v), CTRL, 0xf, 0xf, false)); }
__device__ __forceinline__ float wave_sum(float v) {
    v += dpp_f<0xB1>(v);
    v += dpp_f<0x4E>(v);
    v += dpp_f<0x141>(v);
    v += dpp_f<0x140>(v);
    const float a = __builtin_bit_cast(float, __builtin_amdgcn_readlane(__builtin_bit_cast(int, v), 0));
    const float b = __builtin_bit_cast(float, __builtin_amdgcn_readlane(__builtin_bit_cast(int, v), 16));
    const float c = __builtin_bit_cast(float, __builtin_amdgcn_readlane(__builtin_bit_cast(int, v), 32));
    const float d = __builtin_bit_cast(float, __builtin_amdgcn_readlane(__builtin_bit_cast(int, v), 48));
    return (a + b) + (c + d);
}
__device__ __forceinline__ float wave_max(float v) {
    v = fmaxf(v, dpp_f<0xB1>(v)); v = fmaxf(v, dpp_f<0x4E>(v)); v = fmaxf(v, dpp_f<0x141>(v)); v = fmaxf(v, dpp_f<0x140>(v));
    const float a = __builtin_bit_cast(float, __builtin_amdgcn_readlane(__builtin_bit_cast(int, v), 0));
    const float b = __builtin_bit_cast(float, __builtin_amdgcn_readlane(__builtin_bit_cast(int, v), 16));
    const float c = __builtin_bit_cast(float, __builtin_amdgcn_readlane(__builtin_bit_cast(int, v), 32));
    const float d = __builtin_bit_cast(float, __builtin_amdgcn_readlane(__builtin_bit_cast(int, v), 48));
    return fmaxf(fmaxf(a, b), fmaxf(c, d));
}
#define LDS_WAIT() asm volatile("s_waitcnt lgkmcnt(0)" ::: "memory")

struct P {
    const float* in[30]; float* out; unsigned char* ws; int ph_lo, ph_hi;
};
enum { I_X = 0, I_META, I_NMW, I_WIN, I_MU, I_W0, I_W2, I_A0, I_A2, I_G2, I_KK, I_KA, I_RK, I_LNW, I_LNB, I_KVNW, I_WUK, I_WUV, I_ILNW, I_ILNB,
       I_WPA, I_WPB, I_WGATE, I_WOUT, I_NFW, I_WFI, I_CW, I_CB, I_WFO, I_NFIN };

template <int MODE>
__device__ __forceinline__ void tr_item(const float* W, int K, int N, int Npad, bf16_t* WT, LAS float* scr, int item, int lane) {
    const int nblk = Npad / 32, kb = item / nblk, nb = item % nblk, k0 = 64 * kb, n0 = 32 * nb;
    int s0 = n0; bool valid = n0 < N;
    if (MODE == 1) { const int T = n0 >> 8, w = n0 & 255; s0 = (w < 128) ? T * 128 + w : DFF + T * 128 + (w - 128); valid = true; }
    if (valid) {
#pragma unroll
        for (int i = 0; i < 8; ++i) { const int kk = 8 * i + (lane >> 3), c4 = 4 * (lane & 7); const f32x4 v_ = *(const f32x4*)(W + (size_t)(k0 + kk) * N + s0 + c4);
            LAS float* d_ = scr + kk * 33 + c4; d_[0] = v_.x; d_[1] = v_.y; d_[2] = v_.z; d_[3] = v_.w; }
    } else {
#pragma unroll 8
        for (int i = 0; i < 32; ++i) { const int kk = 2 * i + (lane >> 5); scr[kk * 33 + (lane & 31)] = 0.f; }
    }
    LDS_WAIT(); __builtin_amdgcn_wave_barrier();
    const int c = lane & 7;
#pragma unroll
    for (int j = 0; j < 4; ++j) { const int n = (lane >> 3) + 8 * j; const LAS float* s = scr + (8 * c) * 33 + n;
        u32x4 o; o.x = pk2(s[0 * 33], s[1 * 33]); o.y = pk2(s[2 * 33], s[3 * 33]); o.z = pk2(s[4 * 33], s[5 * 33]); o.w = pk2(s[6 * 33], s[7 * 33]);
        *(u32x4*)(WT + (size_t)(n0 + n) * K + k0 + 8 * c) = o; }
    LDS_WAIT(); __builtin_amdgcn_wave_barrier();
}
__device__ __forceinline__ void colmax_item(const float* W, int N, unsigned* cmx, int it) {
    const int nb = (N + 2047) / 2048, kc = it / nb, n = (it % nb) * 2048 + threadIdx.x * 4;
    if (n < N) { f32x4 m = {0.f, 0.f, 0.f, 0.f}; const float* wp = W + (size_t)kc * 32 * N + n;
#pragma unroll 8
        for (int k = 0; k < 32; ++k) { const f32x4 v = *(const f32x4*)(wp + (size_t)k * N); m.x = fmaxf(m.x, fabsf(v.x)); m.y = fmaxf(m.y, fabsf(v.y)); m.z = fmaxf(m.z, fabsf(v.z)); m.w = fmaxf(m.w, fabsf(v.w)); }
        atomicMax(cmx + n, __float_as_uint(m.x)); atomicMax(cmx + n + 1, __float_as_uint(m.y)); atomicMax(cmx + n + 2, __float_as_uint(m.z)); atomicMax(cmx + n + 3, __float_as_uint(m.w)); }
}
template <int MODE>
__device__ __forceinline__ void tr_item_i8(const float* W, int K, int N, int Npad, signed char* WT, const unsigned* cmx, float* sbdst, LAS float* scr, int item, int lane) {
    const int nblk = Npad / 32, kb = item / nblk, nb = item % nblk, k0 = 64 * kb, n0 = 32 * nb;
    int s0 = n0; bool valid = n0 < N;
    if (MODE == 1) { const int T = n0 >> 8, w = n0 & 255; s0 = (w < 128) ? T * 128 + w : DFF + T * 128 + (w - 128); valid = true; }
    if (valid) {
#pragma unroll
        for (int i = 0; i < 8; ++i) { const int kk = 8 * i + (lane >> 3), c4 = 4 * (lane & 7); const f32x4 v_ = *(const f32x4*)(W + (size_t)(k0 + kk) * N + s0 + c4);
            LAS float* d_ = scr + kk * 33 + c4; d_[0] = v_.x; d_[1] = v_.y; d_[2] = v_.z; d_[3] = v_.w; }
    } else {
#pragma unroll 8
        for (int i = 0; i < 32; ++i) { const int kk = 2 * i + (lane >> 5); scr[kk * 33 + (lane & 31)] = 0.f; }
    }
    LDS_WAIT(); __builtin_amdgcn_wave_barrier();
    const int n = lane >> 1, half = lane & 1;
    const float mx = valid ? __uint_as_float(cmx[s0 + n]) : 0.f; const float inv = mx > 0.f ? 127.f / mx : 0.f;
    unsigned o[8];
#pragma unroll
    for (int c = 0; c < 8; ++c) { unsigned w = 0u;
#pragma unroll
        for (int e = 0; e < 4; ++e) { const int qv = (int)rintf(scr[(half * 32 + c * 4 + e) * 33 + n] * inv); w |= ((unsigned)qv & 0xffu) << (8 * e); }
        o[c] = w; }
    *(u32x4*)(WT + (size_t)(n0 + n) * K + k0 + half * 32) = (u32x4){o[0], o[1], o[2], o[3]};
    *(u32x4*)(WT + (size_t)(n0 + n) * K + k0 + half * 32 + 16) = (u32x4){o[4], o[5], o[6], o[7]};
    if (kb == 0 && half == 0) sbdst[n0 + n] = mx * (1.f / 127.f);
    LDS_WAIT(); __builtin_amdgcn_wave_barrier();
}
template <bool DUAL = false> __device__ __forceinline__ void rms_row_i8(const float* src, const float* w, signed char* dst, float* sa, int lane, float eps, bf16_t* dstb = nullptr) {
    if (src == nullptr) {
        if (DUAL) {
#pragma unroll
            for (int j = 0; j < 8; ++j) *(u32x4*)(dstb + (j * 64 + lane) * 8) = (u32x4){0u, 0u, 0u, 0u}; }
#pragma unroll
        for (int j = 0; j < 4; ++j) *(u32x4*)(dst + (j * 64 + lane) * 16) = (u32x4){0u, 0u, 0u, 0u};
        if (lane == 0) *sa = 1.f;
        return;
    }
    f32x4 v[16]; float s = 0.f;
#pragma unroll
    for (int j = 0; j < 16; ++j) { v[j] = *(const f32x4*)(src + (j * 64 + lane) * 4); s += (v[j].x * v[j].x + v[j].y * v[j].y) + (v[j].z * v[j].z + v[j].w * v[j].w); }
    const float r = rsqrtf(wave_sum(s) * (1.f / D) + eps);
    float mx = 0.f;
#pragma unroll
    for (int j = 0; j < 16; ++j) { const f32x4 g = *(const f32x4*)(w + (j * 64 + lane) * 4); v[j] = v[j] * r * g; mx = fmaxf(mx, fmaxf(fmaxf(fabsf(v[j].x), fabsf(v[j].y)), fmaxf(fabsf(v[j].z), fabsf(v[j].w))));
        if (DUAL) { u32x2 o; o.x = pk2(v[j].x, v[j].y); o.y = pk2(v[j].z, v[j].w); *(u32x2*)(dstb + (j * 64 + lane) * 4) = o; } }
    mx = wave_max(mx);
    const float inv = mx > 0.f ? 127.f / mx : 0.f;
#pragma unroll
    for (int j = 0; j < 16; ++j) { const unsigned q = ((unsigned)(int)rintf(v[j].x * inv) & 0xffu) | (((unsigned)(int)rintf(v[j].y * inv) & 0xffu) << 8) | (((unsigned)(int)rintf(v[j].z * inv) & 0xffu) << 16) | (((unsigned)(int)rintf(v[j].w * inv) & 0xffu) << 24);
        *(unsigned*)(dst + (j * 64 + lane) * 4) = q; }
    if (lane == 0) *sa = mx > 0.f ? mx * (1.f / 127.f) : 1.f;
}
__device__ __forceinline__ void rms_row_bf16(const float* src, const float* w, bf16_t* dst, int lane, float eps) {
    if (src == nullptr) {
#pragma unroll
        for (int j = 0; j < 8; ++j) *(u32x4*)(dst + (j * 64 + lane) * 8) = (u32x4){0u, 0u, 0u, 0u};
        return;
    }
    f32x4 v[16]; float s = 0.f;
#pragma unroll
    for (int j = 0; j < 16; ++j) { v[j] = *(const f32x4*)(src + (j * 64 + lane) * 4); s += (v[j].x * v[j].x + v[j].y * v[j].y) + (v[j].z * v[j].z + v[j].w * v[j].w); }
    const float r = rsqrtf(wave_sum(s) * (1.f / D) + eps);
#pragma unroll
    for (int j = 0; j < 16; ++j) { const f32x4 g = *(const f32x4*)(w + (j * 64 + lane) * 4);
        u32x2 o; o.x = pk2(v[j].x * r * g.x, v[j].y * r * g.y); o.y = pk2(v[j].z * r * g.z, v[j].w * r * g.w);
        *(u32x2*)(dst + (j * 64 + lane) * 4) = o; }
}
__device__ __forceinline__ void p0_prologue_a(const P& p, LAS unsigned char* lds, int G) {
    const int tid = threadIdx.x, lane = tid & 63, wave = tid >> 6;
    LAS float* scr = (LAS float*)(lds + wave * 16384);
    const int gw = blockIdx.x * NWAVES + wave, NGW = G * NWAVES;
    unsigned char* ws = p.ws;
    {
        constexpr int C0 = 128 * ((IN_COLS + 2047) / 2048), C1 = 128 * (8192 / 2048), C2 = 128 * ((NFI + 2047) / 2048);
        for (int it = blockIdx.x; it < C0 + C1 + C2; it += G) {
            if (it < C0) colmax_item(p.in[I_WIN], IN_COLS, (unsigned*)(ws + WS_CTL + CT_CMX_IN), it);
            else if (it < C0 + C1) colmax_item(p.in[I_WGATE], 8192, (unsigned*)(ws + WS_CTL + CT_CMX_G), it - C0);
            else colmax_item(p.in[I_WFI], NFI, (unsigned*)(ws + WS_CTL + CT_CMX_F), it - C0 - C1);
        } }
    for (int it = gw; it < 16 * 32; it += NGW) { const int hh = it >> 5;
        tr_item<0>(p.in[I_WUV] + (size_t)hh * KVR * HD_B, KVR, HD_B, HD_B, (bf16_t*)(ws + WS_WUVT) + (size_t)hh * HD_B * KVR, scr, it & 31, lane); }
    for (size_t i = (size_t)blockIdx.x * NT + threadIdx.x; i < (size_t)16 * 512 * 128 / 4; i += (size_t)G * NT) {
        const f32x4 v = *(const f32x4*)(p.in[I_WUK] + i * 4); u32x2 o; o.x = pk2(v.x, v.y); o.y = pk2(v.z, v.w); *(u32x2*)((bf16_t*)(ws + WS_WUKB) + i * 4) = o; }
    for (int i = blockIdx.x * NT + threadIdx.x; i < 448 * 2048; i += G * NT) { const int j = i >> 11, c = i & 2047;
        const float v = j < 96 ? p.in[I_W2][(size_t)j * 2048 + c] : (j < 192 ? p.in[I_A2][(size_t)(j - 96) * 2048 + c] : p.in[I_G2][(size_t)(j - 192) * 2048 + c]);
        ((bf16_t*)(ws + WS_WLT))[(size_t)c * 448 + j] = f2bf(v); }
    signed char* U8 = (signed char*)(ws + WS_U); float* SA = (float*)(ws + WS_CTL + CT_SA);
    for (int m = gw; m < MP; m += NGW) {
        const float* src = m < NMETA ? p.in[I_META] + (size_t)m * D : (m < L ? p.in[I_X] + (size_t)(m - NMETA) * D : nullptr);
        rms_row_i8<true>(src, p.in[I_NMW], U8 + (size_t)m * D, SA + m, lane, 1e-6f, (bf16_t*)(ws + WS_R1) + (size_t)m * D);
    }
}
__device__ __forceinline__ void p0_prologue_b(const P& p, LAS unsigned char* lds, int G) {
    const int lane = threadIdx.x & 63, wave = threadIdx.x >> 6;
    LAS float* scr = (LAS float*)(lds + wave * 16384);
    const int gw = blockIdx.x * NWAVES + wave, NGW = G * NWAVES;
    constexpr int I0 = (4096 / 64) * (NZ / 32);
    for (int it = gw; it < I0; it += NGW) {
        const int nb = it % (NZ / 32);
        if (nb * 32 < NZ8) tr_item_i8<0>(p.in[I_WIN], 4096, IN_COLS, NZ, (signed char*)(p.ws + WS_WINT), (const unsigned*)(p.ws + WS_CTL + CT_CMX_IN), (float*)(p.ws + WS_CTL + CT_SB_IN), scr, it, lane);
        else tr_item<0>(p.in[I_WIN], 4096, IN_COLS, NZ, (bf16_t*)(p.ws + WS_WINT + WINT_BF_OFF) - (size_t)NZ8 * 4096, scr, it, lane);
    }
}
__device__ __forceinline__ void p0b_weights(const P& p, LAS unsigned char* lds, int vw, int nvw) {
    const int lane = threadIdx.x & 63, wave = threadIdx.x >> 6;
    LAS float* scr = (LAS float*)(lds + wave * 16384);
    unsigned char* ws = p.ws;
    constexpr int I1 = (4096 / 64) * (8192 / 32), I2 = (2048 / 64) * (4096 / 32), I3 = I2, I4 = (4096 / 64) * (4096 / 32), I5 = (4096 / 64) * (NFI / 32), I6 = (DFF / 64) * (4096 / 32);
    constexpr int NITEMS = I1 + I2 + I3 + I4 + I5 + I6;
    for (int it = vw; it < NITEMS; it += nvw) {
        int r = it;
        if (r < I1) { tr_item_i8<0>(p.in[I_WGATE], 4096, 8192, 8192, (signed char*)(ws + WS_WGT), (const unsigned*)(ws + WS_CTL + CT_CMX_G), (float*)(ws + WS_CTL + CT_SB_G), scr, r, lane); continue; } r -= I1;
        if (r < I2) { tr_item<0>(p.in[I_WPA], 2048, 4096, 4096, (bf16_t*)(ws + WS_WPAT), scr, r, lane); continue; } r -= I2;
        if (r < I3) { tr_item<0>(p.in[I_WPB], 2048, 4096, 4096, (bf16_t*)(ws + WS_WPBT), scr, r, lane); continue; } r -= I3;
        if (r < I4) { tr_item<0>(p.in[I_WOUT], 4096, 4096, 4096, (bf16_t*)(ws + WS_WOUTT), scr, r, lane); continue; } r -= I4;
        if (r < I5) { tr_item_i8<1>(p.in[I_WFI], 4096, NFI, NFI, (signed char*)(ws + WS_WFIT), (const unsigned*)(ws + WS_CTL + CT_CMX_F), (float*)(ws + WS_CTL + CT_SB_F), scr, r, lane); continue; } r -= I5;
        tr_item<0>(p.in[I_WFO], DFF, 4096, 4096, (bf16_t*)(ws + WS_WFOT), scr, r, lane);
    }
}

typedef short bf16x8p_t __attribute__((ext_vector_type(8)));
template <int CTRL> __device__ __forceinline__ float dpp_shr0(float v) { return __builtin_bit_cast(float, __builtin_amdgcn_update_dpp(0, __builtin_bit_cast(int, v), CTRL, 0xf, 0xf, true)); }
__device__ __forceinline__ void p2_rwkv_prep(const P& p, LAS unsigned char* lds, int G) {
    const int tid = threadIdx.x, lane = tid & 63, wave = __builtin_amdgcn_readfirstlane(tid >> 6), r16 = lane & 15, q = lane >> 4;
    const bf16_t* Z = (const bf16_t*)(p.ws + WS_Z); const bf16_t* WLT = (const bf16_t*)(p.ws + WS_WLT);
    float* CSo = (float*)(p.ws + WS_LD); bf16_t* AAo = (bf16_t*)(p.ws + WS_AA); bf16_t* GGo = (bf16_t*)(p.ws + WS_GG);
    constexpr int AST = 456;
    LAS bf16_t* act = (LAS bf16_t*)lds;
    const float* mu = p.in[I_MU] + 6144;
    for (int item = blockIdx.x; item < 256; item += G) {
        const int ct = item & 15, tr = item >> 4;
        const int ch = ct * 128 + wave * 16 + r16;
        bf16x8p_t af[14];
#pragma unroll
        for (int ks = 0; ks < 14; ++ks) af[ks] = *(const bf16x8p_t*)(WLT + (size_t)ch * 448 + ks * 32 + q * 8);
        const int c4 = ct * 128 + wave * 16 + q * 4;
        const f32x4 w0v = *(const f32x4*)(p.in[I_W0] + c4), a0v = *(const f32x4*)(p.in[I_A0] + c4);
        const int st0 = tr * 16, st1 = tr == 15 ? 257 : st0 + 16;
        for (int st = st0; st < st1; ++st) {
            const int t0 = st * 64;
            __syncthreads();
            {
                u32x4 za[7], zp[7];
#pragma unroll
                for (int k = 0; k < 7; ++k) { const int cidx = tid + k * NT, t = cidx / 56, j8 = (cidx % 56) * 8; int tg = t0 + t; if (tg > L - 1) tg = L - 1; const int tp = tg > 0 ? tg - 1 : 0;
                    za[k] = *(const u32x4*)(Z + (size_t)tg * NZ + 6144 + j8); zp[k] = *(const u32x4*)(Z + (size_t)tp * NZ + 6144 + j8); }
#pragma unroll
                for (int k = 0; k < 7; ++k) { const int cidx = tid + k * NT, t = cidx / 56, j8 = (cidx % 56) * 8, tg = t0 + t;
                    u32x4 o = (u32x4){0u, 0u, 0u, 0u};
                    if (tg < L) {
                        const f32x4 m0 = *(const f32x4*)(mu + j8), m1 = *(const f32x4*)(mu + j8 + 4);
                        const float a[8] = {blo(za[k].x), bhi(za[k].x), blo(za[k].y), bhi(za[k].y), blo(za[k].z), bhi(za[k].z), blo(za[k].w), bhi(za[k].w)};
                        float b[8] = {blo(zp[k].x), bhi(zp[k].x), blo(zp[k].y), bhi(zp[k].y), blo(zp[k].z), bhi(zp[k].z), blo(zp[k].w), bhi(zp[k].w)};
                        if (tg == 0) {
#pragma unroll
                            for (int e = 0; e < 8; ++e) b[e] = 0.f; }
                        const float m[8] = {m0.x, m0.y, m0.z, m0.w, m1.x, m1.y, m1.z, m1.w};
                        float v[8];
#pragma unroll
                        for (int e = 0; e < 8; ++e) { const float zs = a[e] + (b[e] - a[e]) * m[e]; const bool ist = j8 < 96, isi = j8 < 192;
                            const float r = __builtin_amdgcn_rcpf(1.f + __expf(ist ? 2.f * zs : -zs)); v[e] = ist ? 1.f - 2.f * r : (isi ? zs : r); }
                        o.x = pk2(v[0], v[1]); o.y = pk2(v[2], v[3]); o.z = pk2(v[4], v[5]); o.w = pk2(v[6], v[7]);
                    }
                    *(LAS u32x4*)(act + t * AST + j8) = o; }
            }
            __syncthreads();
#pragma unroll 1
            for (int nt = 0; nt < 4; ++nt) {
                f32x4 cw = {0.f, 0.f, 0.f, 0.f}, ca = cw, cg = cw;
                const LAS bf16_t* ar = act + (nt * 16 + r16) * AST + q * 8;
#pragma unroll
                for (int ks = 0; ks < 3; ++ks) cw = __builtin_amdgcn_mfma_f32_16x16x32_bf16(af[ks], *(const LAS bf16x8p_t*)(ar + ks * 32), cw, 0, 0, 0);
#pragma unroll
                for (int ks = 3; ks < 6; ++ks) ca = __builtin_amdgcn_mfma_f32_16x16x32_bf16(af[ks], *(const LAS bf16x8p_t*)(ar + ks * 32), ca, 0, 0, 0);
#pragma unroll
                for (int ks = 6; ks < 14; ++ks) cg = __builtin_amdgcn_mfma_f32_16x16x32_bf16(af[ks], *(const LAS bf16x8p_t*)(ar + ks * 32), cg, 0, 0, 0);
                f32x4 ld;
#pragma unroll
                for (int e = 0; e < 4; ++e) { const float xx = -(w0v[e] + cw[e]); const float sp = xx > 20.f ? xx : __logf(1.f + __expf(xx)); ld[e] = -__expf(-sp - 0.5f); }
#pragma unroll
                for (int e = 0; e < 4; ++e) { float x = ld[e]; x += dpp_shr0<0x111>(x); x += dpp_shr0<0x112>(x); x += dpp_shr0<0x114>(x); x += dpp_shr0<0x118>(x); ld[e] = x; }
                const int tg = t0 + nt * 16 + r16;
                if (tg < L) {
                    *(f32x4*)(CSo + (size_t)tg * A_W + c4) = ld;
                    u32x2 oa, og; oa.x = pk2(sigm(a0v[0] + ca[0]), sigm(a0v[1] + ca[1])); oa.y = pk2(sigm(a0v[2] + ca[2]), sigm(a0v[3] + ca[3]));
                    og.x = pk2(cg[0], cg[1]); og.y = pk2(cg[2], cg[3]);
                    *(u32x2*)(AAo + (size_t)tg * A_W + c4) = oa; *(u32x2*)(GGo + (size_t)tg * A_W + c4) = og;
                }
            }
        }
    }
}


typedef short bf16x8_t __attribute__((ext_vector_type(8)));
constexpr int NCHUNK = 257, NITEM = NCHUNK * 32, RS = 72, SLOT = 64 * RS * 2;
constexpr int GAM_OFF = 15 * SLOT;
constexpr size_t GTP_OFF = 0, HT_OFF = (size_t)8192 * 8192;
typedef __bf16 bf16x2v_t __attribute__((ext_vector_type(2)));
typedef float f32x2v_t __attribute__((ext_vector_type(2)));
__device__ __forceinline__ unsigned cvtpk(float lo, float hi) { const f32x2v_t v = {lo, hi}; const bf16x2v_t b = __builtin_convertvector(v, bf16x2v_t); return __builtin_bit_cast(unsigned, b); }
__device__ __forceinline__ void mm2(const LAS bf16_t* X, const LAS bf16_t* Y, int tm, int tn0, int r, int q, f32x4& c0, f32x4& c1) {
#pragma unroll
    for (int s = 0; s < 2; ++s) {
        const bf16x8_t a = *(const LAS bf16x8_t*)(X + (tm * 16 + r) * RS + s * 32 + q * 8);
        const bf16x8_t b0 = *(const LAS bf16x8_t*)(Y + (tn0 * 16 + r) * RS + s * 32 + q * 8);
        const bf16x8_t b1 = *(const LAS bf16x8_t*)(Y + ((tn0 + 1) * 16 + r) * RS + s * 32 + q * 8);
        c0 = __builtin_amdgcn_mfma_f32_16x16x32_bf16(a, b0, c0, 0, 0, 0);
        c1 = __builtin_amdgcn_mfma_f32_16x16x32_bf16(a, b1, c1, 0, 0, 0);
    }
}
__device__ __forceinline__ void st_cheap(LAS bf16_t* B, int m0, int n, const f32x4& c) {
    u32x2 w; w.x = cvtpk(c[0], c[1]); w.y = cvtpk(c[2], c[3]); *(LAS u32x2*)(B + n * RS + m0) = w;
}
__device__ __forceinline__ void st_scat(LAS bf16_t* B, int m0, int n, const f32x4& c) {
#pragma unroll
    for (int e = 0; e < 4; ++e) B[(m0 + e) * RS + n] = f2bf(c[e]);
}
template <int CTRL> __device__ __forceinline__ float dpp_add(float v) { return v + dpp_f<CTRL>(v); }
__device__ __forceinline__ float sum8(float v) { v = dpp_add<0xB1>(v); v = dpp_add<0x4E>(v); v = dpp_add<0x141>(v); return v; }

struct RaIn { u32x4 r0, k0, v0, r1, k1, v1, a0; f32x4 c0v, c1v, p0, p1, ba[3], bb[3]; };
__device__ __forceinline__ void ra_load(RaIn& I, const bf16_t* Z, const float* CS, const bf16_t* AAi, int ch, int h, int tid) {
    const int t = tid >> 3, k8 = (tid & 7) * 8, c0 = h * 64 + k8; int tg = ch * 64 + t; if (tg > L - 1) tg = L - 1; const int tp = tg > 0 ? tg - 1 : 0;
    const bf16_t* zr = Z + (size_t)tg * NZ + c0; const bf16_t* zp = Z + (size_t)tp * NZ + c0;
    I.r0 = *(const u32x4*)zr; I.k0 = *(const u32x4*)(zr + 2048); I.v0 = *(const u32x4*)(zr + 4096);
    I.r1 = *(const u32x4*)zp; I.k1 = *(const u32x4*)(zp + 2048); I.v1 = *(const u32x4*)(zp + 4096);
    I.a0 = *(const u32x4*)(AAi + (size_t)tg * A_W + c0);
    const float* cs = CS + (size_t)tg * A_W + c0; const float* cp = CS + (size_t)tp * A_W + c0;
    I.c0v = *(const f32x4*)cs; I.c1v = *(const f32x4*)(cs + 4); I.p0 = *(const f32x4*)cp; I.p1 = *(const f32x4*)(cp + 4);
#pragma unroll
    for (int b = 0; b < 3; ++b) { int rb = ch * 64 + b * 16 + 15; if (rb > L - 1) rb = L - 1; const float* ce = CS + (size_t)rb * A_W + c0; I.ba[b] = *(const f32x4*)ce; I.bb[b] = *(const f32x4*)(ce + 4); }
}
#define LDS_BARRIER() do { asm volatile("s_waitcnt lgkmcnt(0)" ::: "memory"); __builtin_amdgcn_s_barrier(); asm volatile("" ::: "memory"); } while (0)
__device__ __forceinline__ void ra_items(const P& p, LAS unsigned char* lds, int G) {
    const int tid = threadIdx.x, lane = tid & 63, wave = __builtin_amdgcn_readfirstlane(tid >> 6), r16 = lane & 15, q = lane >> 4;
    const int tm = wave >> 1, tn0 = (wave & 1) * 2;
    const bf16_t* Z = (const bf16_t*)(p.ws + WS_Z); const float* CS = (const float*)(p.ws + WS_LD); const bf16_t* AAi = (const bf16_t*)(p.ws + WS_AA);
    bf16_t* GTP = (bf16_t*)((unsigned char*)p.out + GTP_OFF); float* HT = (float*)((unsigned char*)p.out + HT_OFF);
    bf16_t* PPo = (bf16_t*)(p.ws + WS_YB); bf16_t* Y0o = (bf16_t*)(p.ws + WS_YA); float* BS = (float*)(p.ws + WS_BS);
    LAS bf16_t* sl[15];
#pragma unroll
    for (int i = 0; i < 15; ++i) sl[i] = (LAS bf16_t*)(lds + i * SLOT);
    LAS float* gam = (LAS float*)(lds + GAM_OFF);
    LAS bf16_t *Al_r = sl[0], *Be_r = sl[1], *Ka_r = sl[2], *Al_t = sl[3], *Be_t = sl[4], *Ka_t = sl[5], *Rh_r = sl[6], *V_t = sl[7];
    LAS bf16_t *N_r = sl[8], *N_t = sl[9], *LAK = sl[10], *MRK = sl[11], *MRB = sl[12], *Q_t = sl[13], *T_a = sl[14], *T_b = sl[0], *Q_r = sl[1];
    LAS bf16_t *W_t = sl[8], *X1_t = sl[9], *U0_t = sl[1];
    const bool fixed_h = (G & 31) == 0;
    const int nit = fixed_h ? (NCHUNK - (int)(blockIdx.x >> 5) + (G >> 5) - 1) / (G >> 5) : (NITEM - (int)blockIdx.x + G - 1) / G;
    auto item_of = [&](int i, int& ch, int& h) { if (fixed_h) { h = blockIdx.x & 31; ch = (int)(blockIdx.x >> 5) + i * (G >> 5); } else { const int it = (int)blockIdx.x + i * G; ch = it >> 5; h = it & 31; } };
    float pmr[8], pmk[8], pmv[8], pkk[8], pka[8], prk[8]; int h_par = -1;
    RaIn I; { int ch0, h0; item_of(0, ch0, h0); if (nit > 0) ra_load(I, Z, CS, AAi, ch0, h0, tid); }
    for (int ii = 0; ii < nit; ++ii) {
        int ch, h; item_of(ii, ch, h); const int item = ch * 32 + h;
        if (h != h_par) { const int c0 = h * 64 + (tid & 7) * 8;
#pragma unroll
            for (int e = 0; e < 8; ++e) { pmr[e] = p.in[I_MU][c0 + e]; pmk[e] = p.in[I_MU][2048 + c0 + e]; pmv[e] = p.in[I_MU][4096 + c0 + e]; pkk[e] = p.in[I_KK][c0 + e]; pka[e] = p.in[I_KA][c0 + e]; prk[e] = p.in[I_RK][c0 + e]; }
            h_par = h; }
        LDS_BARRIER();
        {
            const int t = tid >> 3, k8 = (tid & 7) * 8, tg = ch * 64 + t;
            float Av[8], Bv[8], Kv[8], Rv[8], Vv[8];
            const bool valid = tg < L, hasp = tg > 0;
            {
                float lc[8], lx[8];
                {   float base[8];
#pragma unroll
                    for (int e = 0; e < 8; ++e) base[e] = 0.f;
#pragma unroll
                    for (int b = 0; b < 3; ++b) if (b < (t >> 4)) {
#pragma unroll
                        for (int e = 0; e < 4; ++e) { base[e] += I.ba[b][e]; base[4 + e] += I.bb[b][e]; } }
                    const bool pin = (t & 15) != 0;
#pragma unroll
                    for (int e = 0; e < 4; ++e) { lc[e] = base[e] + I.c0v[e]; lc[4 + e] = base[4 + e] + I.c1v[e]; lx[e] = base[e] + (pin ? I.p0[e] : 0.f); lx[4 + e] = base[4 + e] + (pin ? I.p1[e] : 0.f); }
                }
                const unsigned rw[4] = {I.r0.x, I.r0.y, I.r0.z, I.r0.w}, kw[4] = {I.k0.x, I.k0.y, I.k0.z, I.k0.w}, vw[4] = {I.v0.x, I.v0.y, I.v0.z, I.v0.w};
                const unsigned rp[4] = {I.r1.x, I.r1.y, I.r1.z, I.r1.w}, kq[4] = {I.k1.x, I.k1.y, I.k1.z, I.k1.w}, vq[4] = {I.v1.x, I.v1.y, I.v1.z, I.v1.w}, aw[4] = {I.a0.x, I.a0.y, I.a0.z, I.a0.w};
                float rr[8], kk[8], kp[8], aa[8]; float ss = 0.f, bs = 0.f;
#pragma unroll
                for (int e = 0; e < 8; ++e) {
                    const int wi = e >> 1; const bool hi = e & 1;
                    const float zr_ = hi ? bhi(rw[wi]) : blo(rw[wi]), zk_ = hi ? bhi(kw[wi]) : blo(kw[wi]), zv_ = hi ? bhi(vw[wi]) : blo(vw[wi]);
                    float pr_ = hi ? bhi(rp[wi]) : blo(rp[wi]), pk_ = hi ? bhi(kq[wi]) : blo(kq[wi]), pv_ = hi ? bhi(vq[wi]) : blo(vq[wi]);
                    if (!hasp) { pr_ = 0.f; pk_ = 0.f; pv_ = 0.f; }
                    aa[e] = hi ? bhi(aw[wi]) : blo(aw[wi]);
                    rr[e] = zr_ + (pr_ - zr_) * pmr[e]; const float k_ = zk_ + (pk_ - zk_) * pmk[e]; Vv[e] = zv_ + (pv_ - zv_) * pmv[e];
                    kk[e] = k_ * pkk[e]; ss += kk[e] * kk[e];
                    kp[e] = k_ * (1.f + (aa[e] - 1.f) * pka[e]);
                    bs += rr[e] * kp[e] * prk[e];
                }
                ss = sum8(ss); bs = sum8(bs);
                const float rn = rsqrtf(ss + 1e-12f);
                if (valid && (tid & 7) == 0) BS[(size_t)tg * 32 + h] = bs;
#pragma unroll
                for (int e = 0; e < 8; ++e) {
                    const float kn = kk[e] * rn; const float ex = __expf(lx[e]), em = __expf(-lc[e]), ep = __expf(lc[e]);
                    Av[e] = kn * ex; Bv[e] = kn * aa[e] * em; Kv[e] = kp[e] * em; Rv[e] = rr[e] * ep;
                }
                if (t == 63) {
#pragma unroll
                    for (int e = 0; e < 8; ++e) gam[k8 + e] = __expf(valid ? lc[e] : (e < 4 ? I.c0v[e] : I.c1v[e - 4]));
                }
                if (!valid) {
#pragma unroll
                    for (int e = 0; e < 8; ++e) { Av[e] = 0.f; Bv[e] = 0.f; Kv[e] = 0.f; Rv[e] = 0.f; Vv[e] = 0.f; }
                }
            }
            u32x4 w;
            w.x = cvtpk(Av[0], Av[1]); w.y = cvtpk(Av[2], Av[3]); w.z = cvtpk(Av[4], Av[5]); w.w = cvtpk(Av[6], Av[7]); *(LAS u32x4*)(Al_r + t * RS + k8) = w;
            w.x = cvtpk(Bv[0], Bv[1]); w.y = cvtpk(Bv[2], Bv[3]); w.z = cvtpk(Bv[4], Bv[5]); w.w = cvtpk(Bv[6], Bv[7]); *(LAS u32x4*)(Be_r + t * RS + k8) = w;
            w.x = cvtpk(Kv[0], Kv[1]); w.y = cvtpk(Kv[2], Kv[3]); w.z = cvtpk(Kv[4], Kv[5]); w.w = cvtpk(Kv[6], Kv[7]); *(LAS u32x4*)(Ka_r + t * RS + k8) = w;
            w.x = cvtpk(Rv[0], Rv[1]); w.y = cvtpk(Rv[2], Rv[3]); w.z = cvtpk(Rv[4], Rv[5]); w.w = cvtpk(Rv[6], Rv[7]); *(LAS u32x4*)(Rh_r + t * RS + k8) = w;
#pragma unroll
            for (int e = 0; e < 8; ++e) { Al_t[(k8 + e) * RS + t] = f2bf(Av[e]); Be_t[(k8 + e) * RS + t] = f2bf(Bv[e]); Ka_t[(k8 + e) * RS + t] = f2bf(Kv[e]); V_t[(k8 + e) * RS + t] = f2bf(Vv[e]); }
        }
        if (ii + 1 < nit) { int ch1, h1; item_of(ii + 1, ch1, h1); ra_load(I, Z, CS, AAi, ch1, h1, tid); }
        LDS_BARRIER();
        {
            f32x4 cab0 = {0.f, 0.f, 0.f, 0.f}, cab1 = cab0, cak0 = cab0, cak1 = cab0, crk0 = cab0, crk1 = cab0, crb0 = cab0, crb1 = cab0;
            mm2(Be_r, Al_r, tm, tn0, r16, q, cab0, cab1); mm2(Ka_r, Al_r, tm, tn0, r16, q, cak0, cak1);
            mm2(Ka_r, Rh_r, tm, tn0, r16, q, crk0, crk1); mm2(Be_r, Rh_r, tm, tn0, r16, q, crb0, crb1);
            const int s0 = tm * 16 + q * 4;
#pragma unroll
            for (int j = 0; j < 2; ++j) {
                const int t = (tn0 + j) * 16 + r16;
                f32x4 ab = j ? cab1 : cab0, ak = j ? cak1 : cak0, rk = j ? crk1 : crk0, rb = j ? crb1 : crb0, nn, t0;
#pragma unroll
                for (int e = 0; e < 4; ++e) { const int s = s0 + e; nn[e] = s < t ? -ab[e] : 0.f; t0[e] = nn[e] + (s == t ? 1.f : 0.f); ak[e] = s < t ? ak[e] : 0.f; rk[e] = s <= t ? rk[e] : 0.f; rb[e] = s <= t ? rb[e] : 0.f; }
                st_cheap(N_r, s0, t, nn); st_scat(N_t, s0, t, nn); st_cheap(T_a, s0, t, t0); st_cheap(LAK, s0, t, ak); st_cheap(MRK, s0, t, rk); st_cheap(MRB, s0, t, rb);
            }
        }
        LDS_BARRIER();
        {
            LAS bf16_t* Pr = N_r; LAS bf16_t* Pt = N_t; LAS bf16_t* Qr = Q_r; LAS bf16_t* Qt = Q_t; LAS bf16_t* Tc = T_a; LAS bf16_t* Tn = T_b;
#pragma unroll 1
            for (int it = 0; it < 5; ++it) {
                {   f32x4 c0 = {0.f, 0.f, 0.f, 0.f}, c1 = c0;
                    mm2(Pr, Pt, tm, tn0, r16, q, c0, c1);
                    const int m0 = tm * 16 + q * 4;
                    st_cheap(Qt, m0, tn0 * 16 + r16, c0); st_cheap(Qt, m0, (tn0 + 1) * 16 + r16, c1);
                    st_scat(Qr, m0, tn0 * 16 + r16, c0); st_scat(Qr, m0, (tn0 + 1) * 16 + r16, c1); }
                LDS_BARRIER();
                {   f32x4 c0 = {0.f, 0.f, 0.f, 0.f}, c1 = c0;
                    mm2(Qt, Tc, tm, tn0, r16, q, c0, c1);
                    const int b0 = tm * 16 + q * 4;
#pragma unroll
                    for (int j = 0; j < 2; ++j) { const int a = (tn0 + j) * 16 + r16; const u32x2 o = *(const LAS u32x2*)(Tc + a * RS + b0); f32x4 c = j ? c1 : c0;
                        c[0] += blo(o.x); c[1] += bhi(o.x); c[2] += blo(o.y); c[3] += bhi(o.y); st_cheap(Tn, b0, a, c); } }
                LDS_BARRIER();
                LAS bf16_t* x = Pr; Pr = Qr; Qr = x; x = Pt; Pt = Qt; Qt = x; x = Tc; Tc = Tn; Tn = x;
            }
        }
        {
            f32x4 c0 = {0.f, 0.f, 0.f, 0.f}, c1 = c0, d0 = c0, d1 = c0;
            mm2(T_b, Al_t, tm, tn0, r16, q, c0, c1);
            mm2(LAK, V_t, tm, tn0, r16, q, d0, d1);
            const int t0 = tm * 16 + q * 4;
            st_cheap(W_t, t0, tn0 * 16 + r16, c0); st_cheap(W_t, t0, (tn0 + 1) * 16 + r16, c1);
            st_cheap(X1_t, t0, tn0 * 16 + r16, d0); st_cheap(X1_t, t0, (tn0 + 1) * 16 + r16, d1);
        }
        LDS_BARRIER();
        {
            f32x4 c0 = {0.f, 0.f, 0.f, 0.f}, c1 = c0;
            mm2(T_b, X1_t, tm, tn0, r16, q, c0, c1);
            const int t0 = tm * 16 + q * 4;
            st_cheap(U0_t, t0, tn0 * 16 + r16, c0); st_cheap(U0_t, t0, (tn0 + 1) * 16 + r16, c1);
        }
        LDS_BARRIER();
        {
            const int m0 = tm * 16 + q * 4;
            if (ch < 256) {
                f32x4 g0 = {0.f, 0.f, 0.f, 0.f}, g1 = g0, h0 = g0, h1 = g0, u0 = g0, u1 = g0;
                mm2(W_t, Be_t, tm, tn0, r16, q, g0, g1);
                mm2(Ka_t, V_t, tm, tn0, r16, q, h0, h1);
                mm2(Be_t, U0_t, tm, tn0, r16, q, u0, u1);
                const size_t it8 = (size_t)item;
#pragma unroll
                for (int j = 0; j < 2; ++j) {
                    const int n = (tn0 + j) * 16 + r16; const f32x4 g = j ? g1 : g0; const float gc = gam[n];
                    f32x4 o;
#pragma unroll
                    for (int e = 0; e < 4; ++e) o[e] = ((m0 + e == n ? 1.f : 0.f) - g[e]) * gc;
                    u32x2 w; w.x = cvtpk(o[0], o[1]); w.y = cvtpk(o[2], o[3]);
                    *(u32x2*)(GTP + it8 * 4096 + (size_t)n * 64 + 32 * (tm >> 1) + 8 * q + 4 * (tm & 1)) = w;
                    const f32x4 hh = (j ? h1 : h0) - (j ? u1 : u0);
                    const f32x4 gk = *(const LAS f32x4*)(gam + m0);
                    *(f32x4*)(HT + (it8 * 16 + tm * 4 + (tn0 + j)) * 256 + lane * 4) = hh * gk;
                }
            }
            f32x4 p0 = {0.f, 0.f, 0.f, 0.f}, p1 = p0, y0 = p0, y1 = p0, z0 = p0, z1 = p0;
            mm2(W_t, MRB, tm, tn0, r16, q, p0, p1);
            mm2(V_t, MRK, tm, tn0, r16, q, y0, y1);
            mm2(U0_t, MRB, tm, tn0, r16, q, z0, z1);
#pragma unroll
            for (int j = 0; j < 2; ++j) {
                const int t = (tn0 + j) * 16 + r16, tg = ch * 64 + t;
                const u32x2 o = *(const LAS u32x2*)(Rh_r + t * RS + m0); const f32x4 pm = j ? p1 : p0;
                u32x2 w; w.x = cvtpk(blo(o.x) - pm[0], bhi(o.x) - pm[1]); w.y = cvtpk(blo(o.y) - pm[2], bhi(o.y) - pm[3]);
                *(u32x2*)(PPo + (size_t)item * 4096 + t * 64 + m0) = w;
                if (tg < L) { const f32x4 yy = (j ? y1 : y0) - (j ? z1 : z0); u32x2 wy; wy.x = cvtpk(yy[0], yy[1]); wy.y = cvtpk(yy[2], yy[3]);
                    *(u32x2*)(Y0o + (size_t)tg * A_W + h * 64 + m0) = wy; }
            }
        }
    }
}

struct RbSet { bf16x8_t ga[4][2]; f32x4 hv[4]; };
__device__ __forceinline__ void rb_load(RbSet& S, const bf16_t* GTP, const float* HT, int c, int h, int vg, int lane, int r16, int q) {
    const size_t it8 = (size_t)(c < 256 ? c : 255) * 32 + h;
#pragma unroll
    for (int i = 0; i < 4; ++i) { S.hv[i] = *(const f32x4*)(HT + (it8 * 16 + i * 4 + vg) * 256 + lane * 4);
#pragma unroll
        for (int s = 0; s < 2; ++s) S.ga[i][s] = *(const bf16x8_t*)(GTP + it8 * 4096 + (size_t)(i * 16 + r16) * 64 + s * 32 + q * 8); }
}
__device__ __forceinline__ void rb_step(f32x4 (&acc)[4], const RbSet& S, bf16_t* ST, int c, int h, int vg, int r16, int q) {
    const size_t item = (size_t)c * 32 + h;
    unsigned w[8];
#pragma unroll
    for (int i = 0; i < 4; ++i) { w[2 * i] = cvtpk(acc[i][0], acc[i][1]); w[2 * i + 1] = cvtpk(acc[i][2], acc[i][3]);
        u32x2 o; o.x = w[2 * i]; o.y = w[2 * i + 1]; *(u32x2*)(ST + item * 4096 + (size_t)(vg * 16 + r16) * 64 + i * 16 + q * 4) = o; }
    const u32x4 b0 = (u32x4){w[0], w[1], w[2], w[3]}, b1 = (u32x4){w[4], w[5], w[6], w[7]};
    const bf16x8_t f0 = __builtin_bit_cast(bf16x8_t, b0), f1 = __builtin_bit_cast(bf16x8_t, b1);
#pragma unroll
    for (int i = 0; i < 4; ++i) { f32x4 a = S.hv[i];
        a = __builtin_amdgcn_mfma_f32_16x16x32_bf16(S.ga[i][0], f0, a, 0, 0, 0);
        a = __builtin_amdgcn_mfma_f32_16x16x32_bf16(S.ga[i][1], f1, a, 0, 0, 0);
        acc[i] = a; }
}
__device__ __forceinline__ void rb_chain(const P& p, int G) {
    const int tid = threadIdx.x, lane = tid & 63, wave = __builtin_amdgcn_readfirstlane(tid >> 6), r16 = lane & 15, q = lane >> 4;
    if (wave == 0) for (int cw = blockIdx.x; cw < 128; cw += G) {
        const int h = cw >> 2, vg = cw & 3;
        const bf16_t* GTP = (const bf16_t*)((const unsigned char*)p.out + GTP_OFF); const float* HT = (const float*)((const unsigned char*)p.out + HT_OFF);
        bf16_t* ST = (bf16_t*)(p.ws + WS_ST);
        f32x4 acc[4];
#pragma unroll
        for (int i = 0; i < 4; ++i) acc[i] = (f32x4){0.f, 0.f, 0.f, 0.f};
        RbSet S0, S1, S2, S3;
        rb_load(S0, GTP, HT, 0, h, vg, lane, r16, q); rb_load(S1, GTP, HT, 1, h, vg, lane, r16, q); rb_load(S2, GTP, HT, 2, h, vg, lane, r16, q); rb_load(S3, GTP, HT, 3, h, vg, lane, r16, q);
#pragma unroll 1
        for (int c = 0; c < 256; c += 4) {
            rb_step(acc, S0, ST, c, h, vg, r16, q);     rb_load(S0, GTP, HT, c + 4, h, vg, lane, r16, q);
            rb_step(acc, S1, ST, c + 1, h, vg, r16, q); rb_load(S1, GTP, HT, c + 5, h, vg, lane, r16, q);
            rb_step(acc, S2, ST, c + 2, h, vg, r16, q); rb_load(S2, GTP, HT, c + 6, h, vg, lane, r16, q);
            rb_step(acc, S3, ST, c + 3, h, vg, r16, q); rb_load(S3, GTP, HT, c + 7, h, vg, lane, r16, q);
        }
        {
            const size_t item = (size_t)256 * 32 + h;
#pragma unroll
            for (int i = 0; i < 4; ++i) { u32x2 o; o.x = cvtpk(acc[i][0], acc[i][1]); o.y = cvtpk(acc[i][2], acc[i][3]); *(u32x2*)(ST + item * 4096 + (size_t)(vg * 16 + r16) * 64 + i * 16 + q * 4) = o; }
        }
    }
}

__device__ __forceinline__ void rc_out(const P& p, int G) {
    const int tid = threadIdx.x, lane = tid & 63, wave = __builtin_amdgcn_readfirstlane(tid >> 6), r16 = lane & 15, q = lane >> 4;
    const bf16_t* Z = (const bf16_t*)(p.ws + WS_Z); const bf16_t* GGi = (const bf16_t*)(p.ws + WS_GG); const float* BS = (const float*)(p.ws + WS_BS);
    const bf16_t* ST = (const bf16_t*)(p.ws + WS_ST); const bf16_t* PPi = (const bf16_t*)(p.ws + WS_YB); bf16_t* YA = (bf16_t*)(p.ws + WS_YA);
    for (size_t i = (size_t)blockIdx.x * NT + tid; i < (size_t)(MP - L) * A_W / 8; i += (size_t)G * NT) *(u32x4*)(YA + (size_t)L * A_W + i * 8) = (u32x4){0u, 0u, 0u, 0u};
    const int tt = wave & 3;
    for (int item = blockIdx.x * 2 + (wave >> 2); item < NITEM; item += 2 * G) {
        const int ch = item >> 5, h = item & 31;
        const int t = tt * 16 + r16, tg = ch * 64 + t;
        f32x4 acc[4];
#pragma unroll
        for (int i = 0; i < 4; ++i) acc[i] = (f32x4){0.f, 0.f, 0.f, 0.f};
        const bf16_t* sp = ST + (size_t)item * 4096; const bf16_t* pp = PPi + (size_t)item * 4096 + (size_t)t * 64;
#pragma unroll
        for (int s = 0; s < 2; ++s) {
            const bf16x8_t b = *(const bf16x8_t*)(pp + s * 32 + q * 8);
#pragma unroll
            for (int i = 0; i < 4; ++i) { const bf16x8_t a = *(const bf16x8_t*)(sp + (size_t)(i * 16 + r16) * 64 + s * 32 + q * 8);
                acc[i] = __builtin_amdgcn_mfma_f32_16x16x32_bf16(a, b, acc[i], 0, 0, 0); }
        }
        if (tg < L) {
            float s1 = 0.f;
#pragma unroll
            for (int i = 0; i < 4; ++i) { const u32x2 y0 = *(const u32x2*)(YA + (size_t)tg * A_W + h * 64 + i * 16 + q * 4);
                acc[i][0] += blo(y0.x); acc[i][1] += bhi(y0.x); acc[i][2] += blo(y0.y); acc[i][3] += bhi(y0.y);
                s1 += (acc[i][0] + acc[i][1]) + (acc[i][2] + acc[i][3]); }
            s1 += __shfl_xor(s1, 16); s1 += __shfl_xor(s1, 32);
            const float mean = s1 * (1.f / 64.f);
            float s2 = 0.f;
#pragma unroll
            for (int i = 0; i < 4; ++i)
#pragma unroll
                for (int e = 0; e < 4; ++e) { const float d = acc[i][e] - mean; s2 += d * d; }
            s2 += __shfl_xor(s2, 16); s2 += __shfl_xor(s2, 32);
            const float rstd = rsqrtf(s2 * (1.f / 64.f) + 64e-5f);
            const float bs = BS[(size_t)tg * 32 + h];
#pragma unroll
            for (int i = 0; i < 4; ++i) {
                const int c = h * 64 + i * 16 + q * 4;
                const u32x2 zv = *(const u32x2*)(Z + (size_t)tg * NZ + 4096 + c);
                u32x2 pv = (u32x2){0u, 0u}; if (tg > 0) pv = *(const u32x2*)(Z + (size_t)(tg - 1) * NZ + 4096 + c);
                const u32x2 gg = *(const u32x2*)(GGi + (size_t)tg * A_W + c);
                const f32x4 lw = *(const f32x4*)(p.in[I_LNW] + c), lb = *(const f32x4*)(p.in[I_LNB] + c), mv = *(const f32x4*)(p.in[I_MU] + 4096 + c);
                const float zz[4] = {blo(zv.x), bhi(zv.x), blo(zv.y), bhi(zv.y)}, pz[4] = {blo(pv.x), bhi(pv.x), blo(pv.y), bhi(pv.y)}, gv[4] = {blo(gg.x), bhi(gg.x), blo(gg.y), bhi(gg.y)};
                float o[4];
#pragma unroll
                for (int e = 0; e < 4; ++e) { const float vv = zz[e] + (pz[e] - zz[e]) * mv[e]; const float yn = (acc[i][e] - mean) * rstd * lw[e] + lb[e]; o[e] = (yn + bs * vv) * gv[e]; }
                u32x2 w; w.x = cvtpk(o[0], o[1]); w.y = cvtpk(o[2], o[3]);
                *(u32x2*)(YA + (size_t)tg * A_W + c) = w;
            }
        }
    }
}


__device__ __forceinline__ void p4_dsa_prep(const P& p, int G) {
    const int tid = threadIdx.x, lane = tid & 63, wave = tid >> 6;
    const bf16_t* Z = (const bf16_t*)(p.ws + WS_Z);
    bf16_t* CKV = (bf16_t*)(p.ws + WS_CKV); float* KIDX = (float*)(p.ws + WS_KIDX);
    for (int t = blockIdx.x * NWAVES + wave; t < L; t += G * NWAVES) {
        const u32x4 raw = *(const u32x4*)(Z + (size_t)t * NZ + ZCKV + lane * 8);
        float x[8] = {blo(raw.x), bhi(raw.x), blo(raw.y), bhi(raw.y), blo(raw.z), bhi(raw.z), blo(raw.w), bhi(raw.w)};
        float s = 0.f;
#pragma unroll
        for (int e = 0; e < 8; ++e) s += x[e] * x[e];
        const float r = rsqrtf(wave_sum(s) * (1.f / KVR) + 1e-6f);
        const f32x4 w0 = *(const f32x4*)(p.in[I_KVNW] + lane * 8), w1 = *(const f32x4*)(p.in[I_KVNW] + lane * 8 + 4);
        u32x4 o; o.x = pk2(x[0] * r * w0.x, x[1] * r * w0.y); o.y = pk2(x[2] * r * w0.z, x[3] * r * w0.w); o.z = pk2(x[4] * r * w1.x, x[5] * r * w1.y); o.w = pk2(x[6] * r * w1.z, x[7] * r * w1.w);
        *(u32x4*)(CKV + (size_t)t * KVR + lane * 8) = o;
        const float ki = bf2f(Z[(size_t)t * NZ + ZKI + lane]);
        const float mean = wave_sum(ki) * (1.f / 64.f), dk = ki - mean, var = wave_sum(dk * dk) * (1.f / 64.f);
        const float kn_ = dk * rsqrtf(var + 1e-6f) * p.in[I_ILNW][lane] + p.in[I_ILNB][lane];
        KIDX[(size_t)t * IDXD + lane] = kn_;
        ((bf16_t*)(p.ws + WS_KIDXB))[(size_t)t * IDXD + lane] = f2bf(kn_);
    }
}

__device__ __forceinline__ unsigned fkey(float f) { const unsigned u = __float_as_uint(f); return (u & 0x80000000u) ? ~u : (u | 0x80000000u); }


typedef float f32x16 __attribute__((ext_vector_type(16)));
constexpr int SCR_N = 16416;
__device__ __forceinline__ unsigned lds_add(LAS unsigned* p, unsigned v) { return __hip_atomic_fetch_add(p, v, __ATOMIC_RELAXED, __HIP_MEMORY_SCOPE_WORKGROUP); }
constexpr int KST = 72, SELB = 8;
template <int NBL> __device__ __forceinline__ void wfind(const LAS unsigned* hist, unsigned target, int lane, unsigned& b, unsigned& ab) {
    unsigned loc[NBL]; unsigned s = 0;
#pragma unroll
    for (int j = 0; j < NBL; j += 4) { const u32x4 v4 = *(const LAS u32x4*)(hist + lane * NBL + j); loc[j] = v4.x; loc[j + 1] = v4.y; loc[j + 2] = v4.z; loc[j + 3] = v4.w; s += (v4.x + v4.y) + (v4.z + v4.w); }
    unsigned v = s;
#pragma unroll
    for (int d = 1; d < 64; d <<= 1) { const unsigned o = (unsigned)__shfl_down((int)v, d); if (lane + d < 64) v += o; }
    const unsigned above = v - s;
    const bool found = above < target && above + s >= target;
    unsigned bb = 0u, aa = 0u;
    if (found) { unsigned a = above;
#pragma unroll
        for (int j = NBL - 1; j >= 0; --j) { if (a < target && a + loc[j] >= target) { bb = (unsigned)(lane * NBL + j); aa = a; } a += loc[j]; } }
    const unsigned long long m = __ballot(found);
    const int src = m ? (int)__builtin_ctzll(m) : 0;
    b = (unsigned)__shfl((int)bb, src); ab = (unsigned)__shfl((int)aa, src);
}
__device__ __forceinline__ void d2_topk(const P& p, LAS unsigned char* lds, int G) {
    const int tid = threadIdx.x, lane = tid & 63, wave = __builtin_amdgcn_readfirstlane(tid >> 6);
    const bf16_t* Z = (const bf16_t*)(p.ws + WS_Z); const bf16_t* KB = (const bf16_t*)(p.ws + WS_KIDXB); int* SEL = (int*)(p.ws + WS_SEL);
    float* scr = (float*)(p.ws + WS_R1) + ((size_t)blockIdx.x * NWAVES + wave) * 2 * SCR_N;
    LAS bf16_t* ksb = (LAS bf16_t*)lds;
    LAS unsigned* hw = (LAS unsigned*)(lds + 73728) + wave * 2048;
    const int key_l = lane & 31, hh = lane >> 5;
    for (int t = blockIdx.x; t < NMETA + 192; t += G) { const int n = t < NMETA ? NMETA : NMETA + 64 * (1 + (t - NMETA) / 64);
        if (tid < TOPK) SEL[(size_t)t * TOPK + tid] = tid < n ? tid : -1; }
    const int nui = (G == 256) ? 4 : (1012 + G - 1) / G;
    for (int ui = 0; ui < nui; ++ui) {
        int i = (int)blockIdx.x + ui * G;
        if (G == 256) i = ui == 0 ? (int)blockIdx.x : (ui == 1 ? 511 - (int)blockIdx.x : (ui == 2 ? 512 + (int)blockIdx.x : 1023 - (int)blockIdx.x));
        if (i >= 1012) continue;
        const int c = 256 - (i >> 2), r = i & 3, n = NMETA + 64 * c;
        const int tA = NMETA + 64 * (c - 1) + 16 * r + 2 * wave;
        bf16x8_t af[2][4]; float wv[2][16];
#pragma unroll
        for (int qq = 0; qq < 2; ++qq) {
            const bf16_t* zr = Z + (size_t)(tA + qq) * NZ;
#pragma unroll
            for (int ks = 0; ks < 4; ++ks) af[qq][ks] = *(const bf16x8_t*)(zr + ZQI + key_l * 64 + ks * 16 + hh * 8);
#pragma unroll
            for (int g = 0; g < 4; ++g) { const u32x2 w2 = *(const u32x2*)(zr + ZWI + 8 * g + 4 * hh);
                wv[qq][g * 4 + 0] = blo(w2.x) * 0.02209708691207961f; wv[qq][g * 4 + 1] = bhi(w2.x) * 0.02209708691207961f;
                wv[qq][g * 4 + 2] = blo(w2.y) * 0.02209708691207961f; wv[qq][g * 4 + 3] = bhi(w2.y) * 0.02209708691207961f; }
        }
#pragma unroll
        for (int j = 0; j < 8; ++j) *(LAS u32x4*)(hw + (j * 64 + lane) * 4) = (u32x4){0u, 0u, 0u, 0u};
        const int nblk = (n + 255) >> 8;
        __syncthreads();
        {
            const int kk = tid >> 1, hf = tid & 1; const int src = kk < n ? kk : n - 1;
            const u32x4* gp = (const u32x4*)(KB + (size_t)src * IDXD + hf * 32);
#pragma unroll
            for (int j = 0; j < 4; ++j) *(LAS u32x4*)(ksb + kk * KST + hf * 32 + j * 8) = gp[j];
        }
        __syncthreads();
        for (int b = 0; b < nblk; ++b) {
            u32x4 pre[4];
            const bool more = b + 1 < nblk;
            if (more) { const int kk = (b + 1) * 256 + (tid >> 1); const int src = kk < n ? kk : n - 1; const u32x4* gp = (const u32x4*)(KB + (size_t)src * IDXD + (tid & 1) * 32);
#pragma unroll
                for (int j = 0; j < 4; ++j) pre[j] = gp[j]; }
            const LAS bf16_t* kb = ksb + (b & 1) * 256 * KST;
#pragma unroll 2
            for (int tt = 0; tt < 8; ++tt) {
                const int s0 = b * 256 + tt * 32;
                if (s0 < n) {
                    bf16x8_t bfr[4];
#pragma unroll
                    for (int ks = 0; ks < 4; ++ks) bfr[ks] = *(const LAS bf16x8_t*)(kb + (tt * 32 + key_l) * KST + ks * 16 + hh * 8);
                    float part[2];
#pragma unroll
                    for (int qq = 0; qq < 2; ++qq) {
                        f32x16 acc;
#pragma unroll
                        for (int e = 0; e < 16; ++e) acc[e] = 0.f;
#pragma unroll
                        for (int ks = 0; ks < 4; ++ks) acc = __builtin_amdgcn_mfma_f32_32x32x16_bf16(af[qq][ks], bfr[ks], acc, 0, 0, 0);
                        float s = 0.f;
                        float s0_ = 0.f, s1_ = 0.f;
#pragma unroll
                        for (int e = 0; e < 16; e += 2) { s0_ += wv[qq][e] * __builtin_amdgcn_fmed3f(acc[e], 0.f, 3.0e38f); s1_ += wv[qq][e + 1] * __builtin_amdgcn_fmed3f(acc[e + 1], 0.f, 3.0e38f); }
                        part[qq] = s0_ + s1_; (void)s;
                    }
                    const float mine = hh ? part[1] : part[0], give = hh ? part[0] : part[1];
                    const float score = mine + __shfl_xor(give, 32);
                    const int key = s0 + key_l;
                    if (key < n) { scr[hh * SCR_N + key] = score; lds_add(hw + hh * 1024 + (fkey(score) >> 22), 1u); }
                }
            }
            if (more) { const int kk = tid >> 1, hf = tid & 1;
#pragma unroll
                for (int j = 0; j < 4; ++j) *(LAS u32x4*)(ksb + ((b + 1) & 1) * 256 * KST + kk * KST + hf * 32 + j * 8) = pre[j]; }
            __syncthreads();
        }
        unsigned b1[2], ab1[2];
        wfind<16>(hw, TOPK, lane, b1[0], ab1[0]); wfind<16>(hw + 1024, TOPK, lane, b1[1], ab1[1]);
        const int nv4 = (n + 3) >> 2;
#pragma unroll
        for (int j = 0; j < 8; ++j) *(LAS u32x4*)(hw + (j * 64 + lane) * 4) = (u32x4){0u, 0u, 0u, 0u};
        for (int sb = 0; sb < nv4; sb += 64 * SELB) {
            f32x4 va[SELB], vb[SELB];
#pragma unroll
            for (int u = 0; u < SELB; ++u) { const int s4 = sb + u * 64 + lane; const int sc = s4 < nv4 ? s4 : nv4 - 1; va[u] = *(const f32x4*)(scr + sc * 4); vb[u] = *(const f32x4*)(scr + SCR_N + sc * 4); }
#pragma unroll
            for (int u = 0; u < SELB; ++u) if (sb + u * 64 + lane < nv4) {
#pragma unroll
                for (int e = 0; e < 4; ++e) { const unsigned ka = fkey(va[u][e]), kb = fkey(vb[u][e]);
                    if ((ka >> 22) == b1[0]) lds_add(hw + ((ka >> 12) & 1023u), 1u);
                    if ((kb >> 22) == b1[1]) lds_add(hw + 1024 + ((kb >> 12) & 1023u), 1u); } } }
        unsigned b2[2], ab2[2];
        wfind<16>(hw, TOPK - ab1[0], lane, b2[0], ab2[0]); wfind<16>(hw + 1024, TOPK - ab1[1], lane, b2[1], ab2[1]);
        const unsigned pfx0 = (b1[0] << 10) | b2[0], pfx1 = (b1[1] << 10) | b2[1];
        const unsigned need0 = (unsigned)TOPK - ab1[0] - ab2[0], need1 = (unsigned)TOPK - ab1[1] - ab2[1];
        LAS unsigned* cl0 = hw; LAS unsigned* cl1 = hw + 1024;
        unsigned cnt0 = 0u, cnt1 = 0u, cc0 = 0u, cc1 = 0u; int* sel0 = SEL + (size_t)tA * TOPK; int* sel1 = sel0 + TOPK;
        const unsigned long long lt = (1ull << lane) - 1ull;
        for (int sb = 0; sb < nv4; sb += 64 * SELB) {
            f32x4 va[SELB], vb[SELB];
#pragma unroll
            for (int u = 0; u < SELB; ++u) { const int s4 = sb + u * 64 + lane; const int sc = s4 < nv4 ? s4 : nv4 - 1; va[u] = *(const f32x4*)(scr + sc * 4); vb[u] = *(const f32x4*)(scr + SCR_N + sc * 4); }
#pragma unroll
            for (int u = 0; u < SELB; ++u) { const int s4 = sb + u * 64 + lane; const bool inr = s4 < nv4;
                if (sb + u * 64 < nv4) {
#pragma unroll
                    for (int e = 0; e < 4; ++e) {
                        {   const unsigned k = fkey(va[u][e]); const bool gt = inr && (k >> 12) > pfx0, eq = inr && (k >> 12) == pfx0;
                            const unsigned long long mg = __ballot(gt), me = __ballot(eq);
                            if (gt) { const unsigned pos = cnt0 + (unsigned)__builtin_popcountll(mg & lt); if (pos < (unsigned)TOPK) sel0[pos] = s4 * 4 + e; }
                            if (eq) { const unsigned ci = cc0 + (unsigned)__builtin_popcountll(me & lt); if (ci < 512u) { cl0[2 * ci] = k; cl0[2 * ci + 1] = (unsigned)(s4 * 4 + e); } }
                            cnt0 += (unsigned)__builtin_popcountll(mg); cc0 += (unsigned)__builtin_popcountll(me); }
                        {   const unsigned k = fkey(vb[u][e]); const bool gt = inr && (k >> 12) > pfx1, eq = inr && (k >> 12) == pfx1;
                            const unsigned long long mg = __ballot(gt), me = __ballot(eq);
                            if (gt) { const unsigned pos = cnt1 + (unsigned)__builtin_popcountll(mg & lt); if (pos < (unsigned)TOPK) sel1[pos] = s4 * 4 + e; }
                            if (eq) { const unsigned ci = cc1 + (unsigned)__builtin_popcountll(me & lt); if (ci < 512u) { cl1[2 * ci] = k; cl1[2 * ci + 1] = (unsigned)(s4 * 4 + e); } }
                            cnt1 += (unsigned)__builtin_popcountll(mg); cc1 += (unsigned)__builtin_popcountll(me); }
                    } } } }
#pragma unroll 1
        for (int qq = 0; qq < 2; ++qq) {
            const LAS unsigned* cl = qq ? cl1 : cl0; const unsigned c = min(qq ? cc1 : cc0, 512u), need = qq ? need1 : need0, base = qq ? cnt1 : cnt0; int* sel = qq ? sel1 : sel0;
            for (unsigned i = lane; i < c; i += 64) { const unsigned k = cl[2 * i], ix = cl[2 * i + 1]; unsigned rank = 0;
                for (unsigned j = 0; j < c; ++j) { const unsigned kj = cl[2 * j], ij = cl[2 * j + 1]; rank += (kj > k || (kj == k && ij < ix)) ? 1u : 0u; }
                if (rank < need && base + rank < (unsigned)TOPK) sel[base + rank] = (int)ix; }
        }
    }
}

__device__ __forceinline__ void d3_qlat(const P& p, int G) {
    const int tid = threadIdx.x, lane = tid & 63, wave = __builtin_amdgcn_readfirstlane(tid >> 6), r16 = lane & 15, q = lane >> 4;
    const bf16_t* Z = (const bf16_t*)(p.ws + WS_Z); const bf16_t* WK = (const bf16_t*)(p.ws + WS_WUKB); bf16_t* QL = (bf16_t*)(p.ws + WS_QLAT);
    constexpr int NB = L / 16;
    for (int item = blockIdx.x; item < 256; item += G) {
        const int h = item & 15, qr = item >> 4; const int b0 = qr * 64, b1 = qr == 15 ? NB : b0 + 64;
        bf16x8_t af[4][4];
#pragma unroll
        for (int mt = 0; mt < 4; ++mt)
#pragma unroll
            for (int ks = 0; ks < 4; ++ks) af[mt][ks] = *(const bf16x8_t*)(WK + ((size_t)h * KVR + wave * 64 + mt * 16 + r16) * HD_B + ks * 32 + q * 8);
        bf16x8_t bq[4];
#pragma unroll
        for (int ks = 0; ks < 4; ++ks) bq[ks] = *(const bf16x8_t*)(Z + (size_t)(b0 * 16 + r16) * NZ + ZQ + h * 128 + ks * 32 + q * 8);
        for (int b = b0; b < b1; ++b) {
            bf16x8_t bn[4];
            const int bnx = b + 1 < b1 ? b + 1 : b;
#pragma unroll
            for (int ks = 0; ks < 4; ++ks) bn[ks] = *(const bf16x8_t*)(Z + (size_t)(bnx * 16 + r16) * NZ + ZQ + h * 128 + ks * 32 + q * 8);
#pragma unroll
            for (int mt = 0; mt < 4; ++mt) {
                f32x4 acc = {0.f, 0.f, 0.f, 0.f};
#pragma unroll
                for (int ks = 0; ks < 4; ++ks) acc = __builtin_amdgcn_mfma_f32_16x16x32_bf16(af[mt][ks], bq[ks], acc, 0, 0, 0);
                u32x2 w; w.x = cvtpk(acc[0], acc[1]); w.y = cvtpk(acc[2], acc[3]);
                *(u32x2*)(QL + (size_t)(b * 16 + r16) * 8192 + h * 512 + wave * 64 + mt * 16 + q * 4) = w;
            }
#pragma unroll
            for (int ks = 0; ks < 4; ++ks) bq[ks] = bn[ks];
        }
    }
}
__device__ __forceinline__ void d5_oproj(const P& p, int G) {
    const int tid = threadIdx.x, lane = tid & 63, wave = __builtin_amdgcn_readfirstlane(tid >> 6), r16 = lane & 15, q = lane >> 4;
    const bf16_t* OL = (const bf16_t*)(p.ws + WS_QLAT); const bf16_t* WV = (const bf16_t*)(p.ws + WS_WUVT); bf16_t* YB = (bf16_t*)(p.ws + WS_YB);
    for (size_t i = (size_t)blockIdx.x * NT + tid; i < (size_t)(MP - L) * A_W / 8; i += (size_t)G * NT) *(u32x4*)(YB + (size_t)L * A_W + i * 8) = (u32x4){0u, 0u, 0u, 0u};
    constexpr int NB = L / 16;
    for (int item = blockIdx.x; item < 256; item += G) {
        const int h = item & 15, qr = item >> 4; const int b0 = qr * 64, b1 = qr == 15 ? NB : b0 + 64;
        bf16x8_t af[16];
#pragma unroll
        for (int ks = 0; ks < 16; ++ks) af[ks] = *(const bf16x8_t*)(WV + ((size_t)h * HD_B + wave * 16 + r16) * KVR + ks * 32 + q * 8);
        bf16x8_t bo[16];
#pragma unroll
        for (int ks = 0; ks < 16; ++ks) bo[ks] = *(const bf16x8_t*)(OL + (size_t)(b0 * 16 + r16) * 8192 + h * 512 + ks * 32 + q * 8);
        for (int b = b0; b < b1; ++b) {
            f32x4 acc0 = {0.f, 0.f, 0.f, 0.f}, acc1 = acc0;
#pragma unroll
            for (int ks = 0; ks < 16; ks += 2) { acc0 = __builtin_amdgcn_mfma_f32_16x16x32_bf16(af[ks], bo[ks], acc0, 0, 0, 0); acc1 = __builtin_amdgcn_mfma_f32_16x16x32_bf16(af[ks + 1], bo[ks + 1], acc1, 0, 0, 0); }
            const int bnx = b + 1 < b1 ? b + 1 : b;
#pragma unroll
            for (int ks = 0; ks < 16; ++ks) bo[ks] = *(const bf16x8_t*)(OL + (size_t)(bnx * 16 + r16) * 8192 + h * 512 + ks * 32 + q * 8);
            const f32x4 acc = acc0 + acc1;
            u32x2 w; w.x = cvtpk(acc[0], acc[1]); w.y = cvtpk(acc[2], acc[3]);
            *(u32x2*)(YB + (size_t)(b * 16 + r16) * A_W + h * HD_B + wave * 16 + q * 4) = w;
        }
    }
}

typedef short s16x4_t __attribute__((ext_vector_type(4)));
constexpr int QLS = 520, PLS = 264, CTS = 528;
#ifndef ATT_REG
#define ATT_REG 0
#endif
#if ATT_REG > 0
#define AREG_T() const unsigned long long tt_ = __builtin_amdgcn_s_memrealtime()
#ifndef ATT_BLK
#define ATT_BLK 0
#endif
#define AREG(k) do { if (ATT_REG == (k) && blockIdx.x == ATT_BLK && threadIdx.x == 0) { const unsigned long long t1_ = __builtin_amdgcn_s_memrealtime(); areg_acc += t1_ - areg_t0; } if (ATT_REG != 9 && blockIdx.x == ATT_BLK && threadIdx.x == 0) areg_t0 = __builtin_amdgcn_s_memrealtime(); } while (0)
#else
#define AREG(k) do {} while (0)
#endif
__device__ __forceinline__ void d4_attn(const P& p, LAS unsigned char* lds, int G) {
    unsigned long long areg_acc = 0, areg_t0 = 0; (void)areg_acc; (void)areg_t0;
    const int tid = threadIdx.x, lane = tid & 63, wave = __builtin_amdgcn_readfirstlane(tid >> 6), r16 = lane & 15, q = lane >> 4;
    bf16_t* QO = (bf16_t*)(p.ws + WS_QLAT); const bf16_t* CKV = (const bf16_t*)(p.ws + WS_CKV); const int* SEL = (const int*)(p.ws + WS_SEL);
    LAS bf16_t* ql = (LAS bf16_t*)lds;
    LAS float* lg = (LAS float*)(lds + 16640);
    LAS bf16_t* pl = (LAS bf16_t*)(lds + 49408);
    LAS int* sl = (LAS int*)(lds + 57856);
    LAS bf16_t* ct = (LAS bf16_t*)(lds + 58880);
    LAS bf16_t* cx = (LAS bf16_t*)(lds + 126464);
    const float scale = 0.08838834764831845f;
    u32x4 qn0 = (u32x4){0u, 0u, 0u, 0u}, qn1 = qn0; int seln = -1;
    const bool xdeal = (G == 256);
    const int tq0 = xdeal ? ((int)(blockIdx.x & 7) * (L / 8) + (int)(blockIdx.x >> 3)) : (int)blockIdx.x, tqs = xdeal ? 32 : G, tq1 = xdeal ? ((int)(blockIdx.x & 7) + 1) * (L / 8) : L;
    {   const int t = tq0;
        if (t < tq1) { qn0 = *(const u32x4*)(QO + (size_t)t * 8192 + tid * 8); qn1 = *(const u32x4*)(QO + (size_t)t * 8192 + 4096 + tid * 8); if (tid < TOPK) seln = SEL[(size_t)t * TOPK + tid]; } }
#if ATT_REG == 9
    if (blockIdx.x == ATT_BLK && threadIdx.x == 0) areg_t0 = __builtin_amdgcn_s_memrealtime();
#endif
    for (int t = tq0; t < tq1; t += tqs) {
        AREG(5);
        LDS_BARRIER();
        {   const int i0_ = tid, i1_ = tid + 512;
            *(LAS u32x4*)(ql + (i0_ >> 6) * QLS + (i0_ & 63) * 8) = qn0; *(LAS u32x4*)(ql + (i1_ >> 6) * QLS + (i1_ & 63) * 8) = qn1;
            if (tid < TOPK) sl[tid] = seln; }
        LDS_BARRIER();
        AREG(1);
        u32x4 st[8];
#pragma unroll
        for (int i = 0; i < 8; ++i) { const int idx = sl[wave + 8 * i]; st[i] = *(const u32x4*)(CKV + (size_t)(idx < 0 ? 0 : idx) * KVR + lane * 8); }
        const int kk = wave & 3, kh = wave >> 2;
        bf16x8_t af[8];
#pragma unroll
        for (int ks = 0; ks < 8; ++ks) af[ks] = *(const LAS bf16x8_t*)(ql + r16 * QLS + kh * 256 + ks * 32 + q * 8);
        for (int kt = 0; kt < 4; ++kt) {
            LDS_BARRIER();
#pragma unroll
            for (int i = 0; i < 8; ++i) { LAS bf16_t* dst = (kt == 2 && i >= 4) ? cx + (wave + 8 * i - 32) * CTS : ct + (wave + 8 * i) * CTS; *(LAS u32x4*)(dst + lane * 8) = st[i]; }
            if (kt < 3) {
#pragma unroll
                for (int i = 0; i < 8; ++i) { const int idx = sl[(kt + 1) * 64 + wave + 8 * i]; st[i] = *(const u32x4*)(CKV + (size_t)(idx < 0 ? 0 : idx) * KVR + lane * 8); }
            } else {
#pragma unroll
                for (int i = 0; i < 4; ++i) { const int idx = sl[128 + wave + 8 * i]; st[i] = *(const u32x4*)(CKV + (size_t)(idx < 0 ? 0 : idx) * KVR + lane * 8); }
            }
            LDS_BARRIER();
            const LAS bf16_t* kb = (kt == 2 && kk >= 2) ? cx + ((kk - 2) * 16 + r16) * CTS : ct + (kk * 16 + r16) * CTS;
            f32x4 c0 = {0.f, 0.f, 0.f, 0.f};
#pragma unroll
            for (int ks = 0; ks < 8; ++ks) {
                const bf16x8_t b = *(const LAS bf16x8_t*)(kb + kh * 256 + ks * 32 + q * 8);
                c0 = __builtin_amdgcn_mfma_f32_16x16x32_bf16(af[ks], b, c0, 0, 0, 0);
            }
            const int key = kt * 64 + kk * 16 + r16; const bool inval = sl[key] < 0;
#pragma unroll
            for (int e = 0; e < 4; ++e) lg[kh * 4096 + (4 * q + e) * 256 + key] = inval ? (kh ? 0.f : -INFINITY) : c0[e] * scale;
        }
        LDS_BARRIER();
        AREG(2);
        for (int hd = wave * 2; hd < wave * 2 + 2; ++hd) {
            float v[4]; float mx = -INFINITY;
#pragma unroll
            for (int k = 0; k < 4; ++k) { v[k] = lg[hd * 256 + k * 64 + lane] + lg[4096 + hd * 256 + k * 64 + lane]; mx = fmaxf(mx, v[k]); }
            mx = wave_max(mx);
            float s = 0.f;
#pragma unroll
            for (int k = 0; k < 4; ++k) { v[k] = __expf(v[k] - mx); s += v[k]; }
            s = 1.f / wave_sum(s);
#pragma unroll
            for (int k = 0; k < 4; ++k) pl[hd * PLS + k * 64 + lane] = f2bf(v[k] * s);
        }
        f32x4 acc[4];
#pragma unroll
        for (int m = 0; m < 4; ++m) acc[m] = (f32x4){0.f, 0.f, 0.f, 0.f};
        {   const int tn = t + tqs;
            if (tn < tq1) { qn0 = *(const u32x4*)(QO + (size_t)tn * 8192 + tid * 8); qn1 = *(const u32x4*)(QO + (size_t)tn * 8192 + 4096 + tid * 8); if (tid < TOPK) seln = SEL[(size_t)tn * TOPK + tid]; } }
        AREG(3);
        for (int j2 = 0; j2 < 4; ++j2) {
            const int kt = 3 - j2;
            LDS_BARRIER();
            if (j2 > 0) {
                if (j2 == 1) {
#pragma unroll
                    for (int i = 0; i < 4; ++i) *(LAS u32x4*)(ct + (wave + 8 * i) * CTS + lane * 8) = st[i];
                } else {
#pragma unroll
                    for (int i = 0; i < 8; ++i) *(LAS u32x4*)(ct + (wave + 8 * i) * CTS + lane * 8) = st[i];
                }
                if (j2 < 3) {
#pragma unroll
                    for (int i = 0; i < 8; ++i) { const int idx = sl[(kt - 1) * 64 + wave + 8 * i]; st[i] = *(const u32x4*)(CKV + (size_t)(idx < 0 ? 0 : idx) * KVR + lane * 8); } }
                LDS_BARRIER();
            }
            const int kq = 16 * (q >> 1) + 4 * (q & 1);
#pragma unroll
            for (int s = 0; s < 2; ++s) {
                const u32x2 pa = *(const LAS u32x2*)(pl + r16 * PLS + kt * 64 + s * 32 + kq), pb = *(const LAS u32x2*)(pl + r16 * PLS + kt * 64 + s * 32 + kq + 8);
                const u32x4 pw = (u32x4){pa.x, pa.y, pb.x, pb.y}; const bf16x8_t b = __builtin_bit_cast(bf16x8_t, pw);
                const LAS bf16_t* cb = (kt == 2 && s == 1) ? cx : ct + s * 32 * CTS;
                const LAS bf16_t* tp = cb + (kq + (r16 >> 2)) * CTS + wave * 64 + (r16 & 3) * 4;
#pragma unroll
                for (int m = 0; m < 4; ++m) {
                    const s16x4_t lo = __builtin_amdgcn_ds_read_tr16_b64_v4i16((LAS s16x4_t*)(tp + m * 16)), hi = __builtin_amdgcn_ds_read_tr16_b64_v4i16((LAS s16x4_t*)(tp + 8 * CTS + m * 16));
                    const bf16x8_t a = (bf16x8_t){lo[0], lo[1], lo[2], lo[3], hi[0], hi[1], hi[2], hi[3]};
                    acc[m] = __builtin_amdgcn_mfma_f32_16x16x32_bf16(a, b, acc[m], 0, 0, 0);
                }
            }
        }
        AREG(4);
#pragma unroll
        for (int m = 0; m < 4; ++m) { u32x2 w; w.x = cvtpk(acc[m][0], acc[m][1]); w.y = cvtpk(acc[m][2], acc[m][3]);
            *(u32x2*)(QO + (size_t)t * 8192 + r16 * 512 + wave * 64 + m * 16 + q * 4) = w; }
    }
#if ATT_REG == 9
    if (blockIdx.x == ATT_BLK && threadIdx.x == 0) areg_acc = __builtin_amdgcn_s_memrealtime() - areg_t0;
#endif
#if ATT_REG > 0
    if (blockIdx.x == ATT_BLK && threadIdx.x == 0) __hip_atomic_store((unsigned*)(p.ws + WS_CTL) + 65540, (unsigned)areg_acc, __ATOMIC_RELAXED, __HIP_MEMORY_SCOPE_AGENT);
#endif
}


__device__ __forceinline__ const float* h1_row(const P& p, int m) { const float* hmeta = (const float*)(p.ws + WS_HMETA); return m < NMETA ? hmeta + (size_t)m * D : p.out + (size_t)(m - NMETA) * D; }
__device__ __forceinline__ void p12_norm(const P& p, int G) {
    const int lane = threadIdx.x & 63, wave = threadIdx.x >> 6;
    signed char* U8 = (signed char*)(p.ws + WS_U); const float* w = p.in[I_NFW];
    float wm = 0.f;
#pragma unroll
    for (int j = 0; j < 16; ++j) { const f32x4 g = *(const f32x4*)(w + (j * 64 + lane) * 4); wm += (g.x * g.x + g.y * g.y) + (g.z * g.z + g.w * g.w); }
    wm = sqrtf(wave_sum(wm) * (1.f / D));
    const float amc = 4.0f * wm;
    const float inv = amc > 0.f ? 127.f / amc : 0.f;
    if (blockIdx.x == 0 && threadIdx.x == 0) *(float*)(p.ws + WS_CTL + CT_SAG) = amc > 0.f ? amc * (1.f / 127.f) : 1.f;
    for (int m = blockIdx.x * NWAVES + wave; m < MP; m += G * NWAVES) {
        signed char* dst = U8 + (size_t)m * D;
        if (m >= L) {
#pragma unroll
            for (int j = 0; j < 4; ++j) *(u32x4*)(dst + (j * 64 + lane) * 16) = (u32x4){0u, 0u, 0u, 0u};
            continue; }
        const float* src = h1_row(p, m);
        f32x4 v[16]; float s = 0.f;
#pragma unroll
        for (int j = 0; j < 16; ++j) { v[j] = *(const f32x4*)(src + (j * 64 + lane) * 4); s += (v[j].x * v[j].x + v[j].y * v[j].y) + (v[j].z * v[j].z + v[j].w * v[j].w); }
        const float ri = rsqrtf(wave_sum(s) * (1.f / D) + 1e-6f) * inv;
#pragma unroll
        for (int j = 0; j < 16; ++j) { const f32x4 x = v[j] * ri; const f32x4 g = *(const f32x4*)(w + (j * 64 + lane) * 4);
            const unsigned q = ((unsigned)(int)rintf(fminf(fmaxf(x.x * g.x, -127.f), 127.f)) & 0xffu) | (((unsigned)(int)rintf(fminf(fmaxf(x.y * g.y, -127.f), 127.f)) & 0xffu) << 8) | (((unsigned)(int)rintf(fminf(fmaxf(x.z * g.z, -127.f), 127.f)) & 0xffu) << 16) | (((unsigned)(int)rintf(fminf(fmaxf(x.w * g.w, -127.f), 127.f)) & 0xffu) << 24);
            *(unsigned*)(dst + (j * 64 + lane) * 4) = q; }
    }
}
__device__ __forceinline__ void p18_final_norm(const P& p, int G) {
    const int tid = threadIdx.x, lane = tid & 63, wave = tid >> 6;
    const float* w = p.in[I_NFIN];
    for (int m = blockIdx.x * NWAVES + wave; m < SEQ; m += G * NWAVES) {
        float* row = p.out + (size_t)m * D;
        f32x4 v[16]; float s = 0.f;
#pragma unroll
        for (int j = 0; j < 16; ++j) { v[j] = *(const f32x4*)(row + (j * 64 + lane) * 4); s += (v[j].x * v[j].x + v[j].y * v[j].y) + (v[j].z * v[j].z + v[j].w * v[j].w); }
        float r = rsqrtf(wave_sum(s) * (1.f / D) + 1e-6f);
#if STAMP_A0 >= 0
        r *= 1.f + 1e-7f * (float)__hip_atomic_load((const unsigned*)(p.ws + WS_CTL) + 65536, __ATOMIC_RELAXED, __HIP_MEMORY_SCOPE_AGENT);
#endif
#pragma unroll
        for (int j = 0; j < 16; ++j) { const f32x4 g = *(const f32x4*)(w + (j * 64 + lane) * 4); *(f32x4*)(row + (j * 64 + lane) * 4) = v[j] * r * g; }
    }
}

__device__ __forceinline__ void p14_conv_act(const P& p, int G, int pass) {
    const int tid = threadIdx.x;
    const bf16_t* ZF = (const bf16_t*)(p.ws + WS_ZF); bf16_t* ACT = (bf16_t*)(p.ws + WS_ACT);
    const float* cw = p.in[I_CW]; const float* cb = p.in[I_CB];
    const size_t nitems = (size_t)MP * 43 * 16;
    for (size_t it = (size_t)blockIdx.x * NT + tid; it < nitems; it += (size_t)G * NT) {
        const int g8 = (int)(it % 16), tl = (int)((it / 16) % 43), t = (int)(it / (16 * 43));
        const int ch = (pass * 43 + tl) * 128 + g8 * 8;
        u32x4 o = (u32x4){0u, 0u, 0u, 0u};
        if (t < L) {
            float zg[8], zu[8];
#pragma unroll
            for (int e = 0; e < 8; ++e) { zg[e] = cb[ch + e]; zu[e] = cb[DFF + ch + e]; }
#pragma unroll
            for (int i = 0; i < 3; ++i) { const int tt = t - 2 + i;
                if (tt >= 0) {
                    const u32x4 a = *(const u32x4*)(ZF + (size_t)tt * DFF + tl * 256 + g8 * 8), b = *(const u32x4*)(ZF + (size_t)tt * DFF + tl * 256 + 128 + g8 * 8);
                    const float xa[8] = {blo(a.x), bhi(a.x), blo(a.y), bhi(a.y), blo(a.z), bhi(a.z), blo(a.w), bhi(a.w)};
                    const float xb[8] = {blo(b.x), bhi(b.x), blo(b.y), bhi(b.y), blo(b.z), bhi(b.z), blo(b.w), bhi(b.w)};
#pragma unroll
                    for (int e = 0; e < 8; ++e) { zg[e] += cw[(size_t)i * NFI + ch + e] * xa[e]; zu[e] += cw[(size_t)i * NFI + DFF + ch + e] * xb[e]; }
                } }
            float r[8];
#pragma unroll
            for (int e = 0; e < 8; ++e) r[e] = zg[e] * sigm(zg[e]) * zu[e];
            o.x = pk2(r[0], r[1]); o.y = pk2(r[2], r[3]); o.z = pk2(r[4], r[5]); o.w = pk2(r[6], r[7]);
        }
        *(u32x4*)(ACT + (size_t)t * DFF + ch) = o;
    }
}

template <int K, class F> __device__ __forceinline__ void side2(const bf16_t* A14, int lda, const bf16_t* Bt, int N, int G, F f) {
    const int lane = threadIdx.x & 63, gw = blockIdx.x * NWAVES + (threadIdx.x >> 6);
    constexpr int NC = K / 512;
    u32x4 a0[NC], a1[NC];
#pragma unroll
    for (int i = 0; i < NC; ++i) { a0[i] = *(const u32x4*)(A14 + i * 512 + lane * 8); a1[i] = *(const u32x4*)(A14 + lda + i * 512 + lane * 8); }
    for (int n = gw; n < N; n += G * NWAVES) {
        float s0 = 0.f, s1 = 0.f;
#pragma unroll
        for (int i = 0; i < NC; ++i) { const u32x4 b = *(const u32x4*)(Bt + (size_t)n * K + i * 512 + lane * 8);
            const unsigned bw[4] = {b.x, b.y, b.z, b.w}, x0[4] = {a0[i].x, a0[i].y, a0[i].z, a0[i].w}, x1[4] = {a1[i].x, a1[i].y, a1[i].z, a1[i].w};
#pragma unroll
            for (int e = 0; e < 4; ++e) { s0 += blo(x0[e]) * blo(bw[e]) + bhi(x0[e]) * bhi(bw[e]); s1 += blo(x1[e]) * blo(bw[e]) + bhi(x1[e]) * bhi(bw[e]); } }
        s0 = wave_sum(s0); s1 = wave_sum(s1);
        if (lane == 0) f(n, s0, s1);
    }
}

template <class F> __device__ __forceinline__ void side2_i8(const signed char* A14, const signed char* Bt, int N, int G, F f) {
    const int lane = threadIdx.x & 63, gw = blockIdx.x * NWAVES + (threadIdx.x >> 6);
    u32x4 a0[4], a1[4];
#pragma unroll
    for (int i = 0; i < 4; ++i) { a0[i] = *(const u32x4*)(A14 + i * 1024 + lane * 16); a1[i] = *(const u32x4*)(A14 + 4096 + i * 1024 + lane * 16); }
    for (int n = gw; n < N; n += G * NWAVES) {
        int s0 = 0, s1 = 0;
#pragma unroll
        for (int i = 0; i < 4; ++i) { const u32x4 b = *(const u32x4*)(Bt + (size_t)n * 4096 + i * 1024 + lane * 16);
            s0 = __builtin_amdgcn_sdot4((int)a0[i].x, (int)b.x, s0, false); s0 = __builtin_amdgcn_sdot4((int)a0[i].y, (int)b.y, s0, false); s0 = __builtin_amdgcn_sdot4((int)a0[i].z, (int)b.z, s0, false); s0 = __builtin_amdgcn_sdot4((int)a0[i].w, (int)b.w, s0, false);
            s1 = __builtin_amdgcn_sdot4((int)a1[i].x, (int)b.x, s1, false); s1 = __builtin_amdgcn_sdot4((int)a1[i].y, (int)b.y, s1, false); s1 = __builtin_amdgcn_sdot4((int)a1[i].z, (int)b.z, s1, false); s1 = __builtin_amdgcn_sdot4((int)a1[i].w, (int)b.w, s1, false); }
#pragma unroll
        for (int d = 32; d >= 1; d >>= 1) { s0 += __shfl_xor(s0, d); s1 += __shfl_xor(s1, d); }
        if (lane == 0) f(n, s0, s1);
    }
}

__device__ __forceinline__ void p_conv_fix(const P& p, int G) {
    const int tid = threadIdx.x;
    const float* HALO = (const float*)(p.ws + WS_ZF); bf16_t* ACT = (bf16_t*)(p.ws + WS_ACT);
    const float* cw = p.in[I_CW]; const float* cb = p.in[I_CB];
    const int nitems = 64 * 2 * DFF;
    for (int it = blockIdx.x * NT + tid; it < nitems; it += G * NT) {
        const int c = it % DFF, d = (it / DFF) & 1, pm = 1 + it / (2 * DFF);
        const int r = pm * 256 + d; if (r >= L) continue;
        const int T = c >> 7, cl = c & 127; const int colg = T * 256 + cl, colu = colg + 128;
        const float* h0 = HALO + ((size_t)(pm - 1) * 4 + 2 + d) * NFI; const float* h1 = d == 0 ? HALO + ((size_t)(pm - 1) * 4 + 3) * NFI : HALO + ((size_t)pm * 4 + 0) * NFI; const float* h2 = HALO + ((size_t)pm * 4 + d) * NFI;
        const float zg = cb[c] + cw[c] * h0[colg] + cw[(size_t)NFI + c] * h1[colg] + cw[(size_t)2 * NFI + c] * h2[colg];
        const float zu = cb[DFF + c] + cw[DFF + c] * h0[colu] + cw[(size_t)NFI + DFF + c] * h1[colu] + cw[(size_t)2 * NFI + DFF + c] * h2[colu];
        ACT[(size_t)r * DFF + c] = f2bf(zg * sigm(zg) * zu);
    }
}

constexpr int NPHASE = 20;
__global__ void __launch_bounds__(NT, 2) fwd_kernel(P p) {
    extern __shared__ __attribute__((aligned(16))) unsigned char lds_raw[];
    LAS unsigned char* lds = (LAS unsigned char*)lds_raw;
    const int G = gridDim.x;
    unsigned char* ws = p.ws;
    volatile LAS unsigned* MISC = (volatile LAS unsigned*)(lds + MISC_OFF);
    if (threadIdx.x < 16) MISC[threadIdx.x] = 0u;
    __syncthreads();
#if MK_ONE_LAUNCH
    XcdBarrier bar = xcd_barrier_post((unsigned*)(ws + WS_CTL), MISC + 8);
#define GRID_BAR() xcd_barrier(bar)
#else
#define GRID_BAR() do {} while (0)
#endif
    unsigned long long tsA0 = 0, tsA1 = 0, tsB0 = 0, tsB1 = 0; (void)tsA0; (void)tsA1; (void)tsB0; (void)tsB1;
    const int lo = p.ph_lo, hi = p.ph_hi;
#ifndef PHASE_MASK
#define PHASE_MASK 0xFFFFFFFu
#endif
#define IN(k) ((((PHASE_MASK) >> (k)) & 1u) && lo <= (k) && (k) < hi)
#ifndef STAMP_A0
#define STAMP_A0 -1
#endif
#if STAMP_A0 >= 0
#define STAMP(k) do { if (blockIdx.x == 0 && threadIdx.x == 0) { const unsigned long long t_ = __builtin_amdgcn_s_memrealtime(); if ((k) == STAMP_A0) tsA0 = t_; if ((k) == STAMP_A1) tsA1 = t_; if ((k) == STAMP_B0) tsB0 = t_; if ((k) == STAMP_B1) { tsB1 = t_; \
    __hip_atomic_store((unsigned*)(ws + WS_CTL) + 65536, (unsigned)(tsB1 - tsB0), __ATOMIC_RELAXED, __HIP_MEMORY_SCOPE_AGENT); } } } while (0)
#else
#define STAMP(k) do {} while (0)
#endif
#define SEAM(k) do { if (IN((k) + 1)) GRID_BAR(); STAMP((k) + 1); } while (0)
    STAMP(0);
#ifndef PROBE_REP_MASK
#define PROBE_REP_MASK 0u
#endif
#define NREP(k) ((((PROBE_REP_MASK) >> (k)) & 1u) ? 2 : 1)
    bf16_t* U = (bf16_t*)(ws + WS_U);
    if (IN(0)) _Pragma("unroll") for (int rep_ = 0; rep_ < NREP(0); ++rep_) { p0_prologue_a(p, lds, G); GRID_BAR(); p0_prologue_b(p, lds, G); if (rep_ == NREP(0) - 1) SEAM(0); }
    if (IN(1)) _Pragma("unroll") for (int rep_ = 0; rep_ < NREP(1); ++rep_) {
        {   pg8::Gemm g{U, (const bf16_t*)(ws + WS_WINT), MP, NZ8, D / 2, (const float*)(ws + WS_CTL + CT_SA), (const float*)(ws + WS_CTL + CT_SB_IN)}; pg8::StaticOrder S; S.init(MP, NZ8, G, (int)blockIdx.x);
            pg8::EpiBf16<0> E{(bf16_t*)(ws + WS_Z), NZ};
            pg8::gemm_phase<pg8::EpiBf16<0>, pg8::StaticOrder, true, true, true>(lds, g, S, E); }
        {   pg8::Gemm g{(const bf16_t*)(ws + WS_R1), (const bf16_t*)(ws + WS_WINT + WINT_BF_OFF), MP, NZ - NZ8, D}; pg8::StaticOrder S; S.init(MP, NZ - NZ8, G, (int)blockIdx.x);
            pg8::EpiBf16<0> E{(bf16_t*)(ws + WS_Z) + NZ8, NZ};
            pg8::gemm_phase<pg8::EpiBf16<0>, pg8::StaticOrder, true, true, false>(lds, g, S, E); }
        if (rep_ == NREP(1) - 1) SEAM(1);
    }
    if (IN(2)) _Pragma("unroll") for (int rep_ = 0; rep_ < NREP(2); ++rep_) { p2_rwkv_prep(p, lds, G); if (rep_ == NREP(2) - 1) SEAM(2); }
    if (IN(3)) _Pragma("unroll") for (int rep_ = 0; rep_ < NREP(3); ++rep_) { ra_items(p, lds, G); if (rep_ == NREP(3) - 1) SEAM(3); }
    if (IN(4)) _Pragma("unroll") for (int rep_ = 0; rep_ < NREP(4); ++rep_) { rb_chain(p, G);
        {
            const int wv_ = threadIdx.x >> 6, nch_ = G < 128 ? G : 128; const int nvw_ = nch_ * 7 + (G - nch_) * 8;
            const int vw_ = (int)blockIdx.x < nch_ ? ((int)blockIdx.x * 7 + wv_ - 1) : (nch_ * 7 + ((int)blockIdx.x - nch_) * 8 + wv_);
            if (!((int)blockIdx.x < nch_ && wv_ == 0)) p0b_weights(p, lds, vw_, nvw_); }
        if (rep_ == NREP(4) - 1) SEAM(4); }
    if (IN(5)) _Pragma("unroll") for (int rep_ = 0; rep_ < NREP(5); ++rep_) { rc_out(p, G); if (rep_ == NREP(5) - 1) SEAM(5); }
    if (IN(6)) _Pragma("unroll") for (int rep_ = 0; rep_ < NREP(6); ++rep_) { p4_dsa_prep(p, G); if (rep_ == NREP(6) - 1) SEAM(6); }
    if (IN(7)) _Pragma("unroll") for (int rep_ = 0; rep_ < NREP(7); ++rep_) { d2_topk(p, lds, G); if (rep_ == NREP(7) - 1) SEAM(7); }
    if (IN(8)) _Pragma("unroll") for (int rep_ = 0; rep_ < NREP(8); ++rep_) { d3_qlat(p, G); if (rep_ == NREP(8) - 1) SEAM(8); }
    if (IN(9)) _Pragma("unroll") for (int rep_ = 0; rep_ < NREP(9); ++rep_) { d4_attn(p, lds, G); if (rep_ == NREP(9) - 1) SEAM(9); }
    if (IN(11)) _Pragma("unroll") for (int rep_ = 0; rep_ < NREP(11); ++rep_) {
        d5_oproj(p, G);
        pg8::Gemm g{U + (size_t)NMETA * (D / 2), (const bf16_t*)(ws + WS_WGT), SEQ, 8192, D / 2, (const float*)(ws + WS_CTL + CT_SA) + NMETA, (const float*)(ws + WS_CTL + CT_SB_G)}; pg8::StaticOrder S; S.init(SEQ, 8192, G, (int)blockIdx.x);
        pg8::EpiBf16<1> E{(bf16_t*)(ws + WS_GATES) + (size_t)NMETA * 8192, 8192};
        pg8::gemm_phase<pg8::EpiBf16<1>, pg8::StaticOrder, true, true, true>(lds, g, S, E);
        {   const float* SA_ = (const float*)(ws + WS_CTL + CT_SA); const float* SB_ = (const float*)(ws + WS_CTL + CT_SB_G); bf16_t* GT = (bf16_t*)(ws + WS_GATES);
            side2_i8((const signed char*)(ws + WS_U) + (size_t)14 * D, (const signed char*)(ws + WS_WGT), 8192, G, [&](int n, int i0, int i1) {
                GT[(size_t)14 * 8192 + n] = f2bf(1.f / (1.f + __expf(-(float)i0 * SA_[14] * SB_[n]))); GT[(size_t)15 * 8192 + n] = f2bf(1.f / (1.f + __expf(-(float)i1 * SA_[15] * SB_[n]))); }); }
        if (rep_ == NREP(11) - 1) SEAM(11);
    }
    if (IN(12)) _Pragma("unroll") for (int rep_ = 0; rep_ < NREP(12); ++rep_) {
        pg8::Gemm g{(const bf16_t*)(ws + WS_YA) + (size_t)NMETA * A_W, (const bf16_t*)(ws + WS_WPAT), SEQ, D, A_W}; pg8::StaticOrder S; S.init(SEQ, D, G, (int)blockIdx.x);
        pg8::EpiGateMulF32 E{(bf16_t*)(ws + WS_MF) + (size_t)NMETA * D, D, (const bf16_t*)(ws + WS_GATES) + (size_t)NMETA * 8192, 8192, 0};
        pg8::gemm_phase<pg8::EpiGateMulF32, pg8::StaticOrder, true, true>(lds, g, S, E);
        {   bf16_t* MA = (bf16_t*)(ws + WS_MF); const bf16_t* GT = (const bf16_t*)(ws + WS_GATES);
            side2<2048>((const bf16_t*)(ws + WS_YA) + (size_t)14 * A_W, A_W, (const bf16_t*)(ws + WS_WPAT), D, G, [&](int n, float s0, float s1) {
                MA[(size_t)14 * D + n] = f2bf(bf2f(GT[(size_t)14 * 8192 + n]) * s0); MA[(size_t)15 * D + n] = f2bf(bf2f(GT[(size_t)15 * 8192 + n]) * s1); }); }
        if (rep_ == NREP(12) - 1) SEAM(12);
    }
    if (IN(13)) _Pragma("unroll") for (int rep_ = 0; rep_ < NREP(13); ++rep_) {
        pg8::Gemm g{(const bf16_t*)(ws + WS_YB) + (size_t)NMETA * A_W, (const bf16_t*)(ws + WS_WPBT), SEQ, D, A_W}; pg8::StaticOrder S; S.init(SEQ, D, G, (int)blockIdx.x);
        pg8::EpiGateMulAddBf16 E{U + (size_t)NMETA * D, D, (const bf16_t*)(ws + WS_MF) + (size_t)NMETA * D, (const bf16_t*)(ws + WS_GATES) + (size_t)NMETA * 8192, 8192, D};
        pg8::gemm_phase<pg8::EpiGateMulAddBf16, pg8::StaticOrder, true, true>(lds, g, S, E);
        {   const bf16_t* MA = (const bf16_t*)(ws + WS_MF); const bf16_t* GT = (const bf16_t*)(ws + WS_GATES);
            side2<2048>((const bf16_t*)(ws + WS_YB) + (size_t)14 * A_W, A_W, (const bf16_t*)(ws + WS_WPBT), D, G, [&](int n, float s0, float s1) {
                U[(size_t)14 * D + n] = f2bf(bf2f(MA[(size_t)14 * D + n]) + bf2f(GT[(size_t)14 * 8192 + D + n]) * s0); U[(size_t)15 * D + n] = f2bf(bf2f(MA[(size_t)15 * D + n]) + bf2f(GT[(size_t)15 * 8192 + D + n]) * s1); }); }
        if (rep_ == NREP(13) - 1) SEAM(13);
    }
    if (IN(14)) _Pragma("unroll") for (int rep_ = 0; rep_ < NREP(14); ++rep_) {
        pg8::Gemm g{U + (size_t)NMETA * D, (const bf16_t*)(ws + WS_WOUTT), SEQ, D, D}; pg8::StaticOrder S; S.init(SEQ, D, G, (int)blockIdx.x);
        pg8::EpiResid E{p.in[I_X], p.in[I_X], p.out, p.out, D, 0, SEQ};
        pg8::gemm_phase<pg8::EpiResid, pg8::StaticOrder, true, true>(lds, g, S, E);
        {   float* HM = (float*)(ws + WS_HMETA); const float* mt = p.in[I_META];
            for (int i2 = blockIdx.x * NT + threadIdx.x; i2 < 14 * D; i2 += G * NT) HM[i2] = mt[i2];
            side2<4096>(U + (size_t)14 * D, D, (const bf16_t*)(ws + WS_WOUTT), D, G, [&](int n, float s0, float s1) { HM[(size_t)14 * D + n] = mt[(size_t)14 * D + n] + s0; HM[(size_t)15 * D + n] = mt[(size_t)15 * D + n] + s1; }); }
        if (rep_ == NREP(14) - 1) SEAM(14);
    }
    if (IN(15)) _Pragma("unroll") for (int rep_ = 0; rep_ < NREP(15); ++rep_) { p12_norm(p, G); if (rep_ == NREP(15) - 1) SEAM(15); }
    if (IN(16)) _Pragma("unroll") for (int rep_ = 0; rep_ < NREP(16); ++rep_) {
        pg8::Gemm g{U, (const bf16_t*)(ws + WS_WFIT), MP, NFI, D / 2, (const float*)(ws + WS_CTL + CT_SA), (const float*)(ws + WS_CTL + CT_SB_F)}; pg8::StaticOrder S; S.init(MP, NFI, G, (int)blockIdx.x);
        pg8::EpiConvAct E{(bf16_t*)(ws + WS_ACT), DFF, (float*)(ws + WS_ZF), NFI, p.in[I_CW], p.in[I_CB], DFF, (PG8_LAS float*)(lds + 131072), (const float*)(ws + WS_CTL + CT_SAG), (const float*)(ws + WS_CTL + CT_SB_F)};
        pg8::gemm_phase<pg8::EpiConvAct, pg8::StaticOrder, true, true, true>(lds, g, S, E);
        if (rep_ == NREP(16) - 1) SEAM(16);
    }
    if (IN(17)) _Pragma("unroll") for (int rep_ = 0; rep_ < NREP(17); ++rep_) { p_conv_fix(p, G); if (rep_ == NREP(17) - 1) SEAM(17); }
    if (IN(18)) _Pragma("unroll") for (int rep_ = 0; rep_ < NREP(18); ++rep_) {
        pg8::Gemm g{(const bf16_t*)(ws + WS_ACT) + (size_t)NMETA * DFF, (const bf16_t*)(ws + WS_WFOT), SEQ, D, DFF}; pg8::StaticOrder S; S.init(SEQ, D, G, (int)blockIdx.x);
        pg8::EpiResid E{p.out, p.out, p.out, p.out, D, 0, SEQ};
        pg8::gemm_phase<pg8::EpiResid, pg8::StaticOrder, true, true>(lds, g, S, E);
        if (rep_ == NREP(18) - 1) SEAM(18);
    }
    if (IN(19)) _Pragma("unroll") for (int rep_ = 0; rep_ < NREP(19); ++rep_) { p18_final_norm(p, G); }
#if STAMP_A0 >= 0
    if (blockIdx.x == 0 && threadIdx.x == 0) { const unsigned long long t_end = __builtin_amdgcn_s_memrealtime(); unsigned long long dA = (tsA1 - tsA0) * 64ull;
#if defined(ATT_REG) && ATT_REG > 0
        dA = (unsigned long long)__hip_atomic_load((const unsigned*)(ws + WS_CTL) + 65540, __ATOMIC_RELAXED, __HIP_MEMORY_SCOPE_AGENT) * 64ull;
#endif
        while (__builtin_amdgcn_s_memrealtime() - t_end < dA) __builtin_amdgcn_s_sleep(8); }
#endif
#undef IN
#undef SEAM
}

extern "C" void kernel_launch(void* const* d_in, const int* in_sizes, int n_in, void* d_out, int out_size, void* d_ws, size_t ws_size, hipStream_t stream) {
    static int grid = 0;
    if (grid == 0) {
        if (n_in != 30 || out_size != SEQ * D || ws_size < WS_END2) { fprintf(stderr, "kernel_launch: unexpected shapes (n_in %d out %d ws %zu need %zu)\n", n_in, out_size, ws_size, (size_t)WS_END); grid = -1; return; }
        int dev = 0, cus = 0, per_cu = 0;
        if (hipGetDevice(&dev) != hipSuccess || hipDeviceGetAttribute(&cus, hipDeviceAttributeMultiprocessorCount, dev) != hipSuccess) { grid = -1; return; }
        if (hipFuncSetAttribute((const void*)fwd_kernel, hipFuncAttributeMaxDynamicSharedMemorySize, LDS_BYTES) != hipSuccess) { fprintf(stderr, "kernel_launch: hipFuncSetAttribute failed\n"); grid = -1; return; }
        if (hipOccupancyMaxActiveBlocksPerMultiprocessor(&per_cu, (const void*)fwd_kernel, NT, LDS_BYTES) != hipSuccess || per_cu < 1) fprintf(stderr, "kernel_launch: occupancy query says %d\n", per_cu);
        (void)hipGetLastError();
        grid = cus;
    }
    if (grid < 0) return;
    (void)hipMemsetAsync((char*)d_ws + WS_CTL, 0, CTL_BYTES, stream);
    P a{};
    for (int i = 0; i < 30; ++i) a.in[i] = (const float*)d_in[i];
    a.out = (float*)d_out; a.ws = (unsigned char*)d_ws;
#if MK_ONE_LAUNCH
    a.ph_lo = 0; a.ph_hi = NPHASE;
    hipLaunchKernelGGL(fwd_kernel, dim3(grid), dim3(NT), LDS_BYTES, stream, a);
#else
    for (int k = 0; k < NPHASE; ++k) { a.ph_lo = k; a.ph_hi = k + 1; hipLaunchKernelGGL(fwd_kernel, dim3(grid), dim3(NT), LDS_BYTES, stream, a); }
#endif
}
```

```cpp
#include <hip/hip_runtime.h>
#include <cstdio>
#include <cstdint>
#define MK_ONE_LAUNCH 1
namespace pg8 {
#define PG8_LAS __attribute__((address_space(3)))
typedef unsigned short bf16_t;
typedef short bf16x8 __attribute__((ext_vector_type(8)));
typedef float f32x4 __attribute__((ext_vector_type(4)));
typedef unsigned u32x4 __attribute__((ext_vector_type(4)));
typedef int i32x4 __attribute__((ext_vector_type(4)));
constexpr int BM = 256, BK = 64, HALF = 128, HTB = HALF * BK * 2  , STAGE_BYTES = 8 * HTB, NXCD = 8, WGM = 4;

__host__ __device__ __forceinline__ int lds_byte(int r, int c) { const int st = (r >> 4) * 2 + (c >> 5), rr = r & 15, cc = c & 31, ob = rr * 64 + cc * 2; return st * 1024 + (ob ^ (((ob >> 9) & 1) << 5)); }
__host__ __device__ __forceinline__ void stage_rc(int b, int& R, int& C) { const int st = b / 1024, sb = b % 1024, swz = sb ^ (((sb >> 9) & 1) << 5); R = (st >> 1) * 16 + swz / 64; C = (st & 1) * 32 + (swz % 64) / 2; }
__host__ __device__ __forceinline__ int perm32(int rho) { const int n = rho >> 4, i = rho & 15; return 8 * (i >> 2) + 4 * n + (i & 3); }

struct Unit { int pm, pn; };
struct Gemm { const bf16_t* A; const bf16_t* Bt; int M, N, K; const float* sa; const float* sb; };

struct StaticOrder {
    int nM, nN, nwg, G, c;
    __host__ __device__ void init(int M, int N, int G_, int c_) { nM = M / BM; nN = N / BM; nwg = nM * nN; G = G_; c = c_; }
    __host__ __device__ bool next(int i, Unit& u) const {
        const long L = (long)i * G + c; if (L >= nwg) return false;
        int wgid = (int)L; { const int q = nwg / NXCD, r = nwg % NXCD, xcd = wgid % NXCD, off = wgid / NXCD; wgid = (xcd < r ? xcd * (q + 1) : r * (q + 1) + (xcd - r) * q) + off; }
        const int nig = WGM * nN, gid = wgid / nig, fm = gid * WGM, gsz = (nM - fm) < WGM ? (nM - fm) : WGM;
        u.pm = fm + ((wgid % nig) % gsz); u.pn = (wgid % nig) / gsz; return true;
    }
    __device__ __forceinline__ void a_ready(const Unit&) const {}
    __device__ __forceinline__ void done(const Unit&) const {}
};

__device__ __forceinline__ unsigned cvt_pk_bf16(float lo, float hi) { unsigned r; asm volatile("v_cvt_pk_bf16_f32 %0, %1, %2" : "=v"(r) : "v"(lo), "v"(hi)); return r; }
typedef float f32x2 __attribute__((ext_vector_type(2)));

typedef unsigned u32x2 __attribute__((ext_vector_type(2)));
__device__ __forceinline__ float bf_lo(unsigned w) { return __uint_as_float(w << 16); }
__device__ __forceinline__ float bf_hi(unsigned w) { return __uint_as_float(w & 0xffff0000u); }
__device__ __forceinline__ float sigmoidf_(float x) { return 1.f / (1.f + __expf(-x)); }

template <int ACT> struct EpiBf16 {
    static constexpr bool PERM = true, AFTER_DRAIN = false, SELF_SCALE = false;
    bf16_t* O; int ldc;
    __device__ __forceinline__ void operator()(const f32x4 (&acc)[2][2][4][2], const Unit& u, int wr, int wc, int fr, int fq) const {
        const int row0 = u.pm * BM + wr * 64 + fr; const int col0 = u.pn * BM + wc * 32 + 8 * fq;
#pragma unroll
        for (int ai = 0; ai < 2; ++ai)
#pragma unroll
            for (int m = 0; m < 4; ++m) { bf16_t* rowp = O + (size_t)(row0 + ai * HALF + m * 16) * ldc + col0;
#pragma unroll
                for (int bj = 0; bj < 2; ++bj) { f32x4 v0 = acc[ai][bj][m][0], v1 = acc[ai][bj][m][1];
                    if (ACT == 1) {
#pragma unroll
                        for (int e = 0; e < 4; ++e) { v0[e] = sigmoidf_(v0[e]); v1[e] = sigmoidf_(v1[e]); } }
                    u32x4 w; w.x = cvt_pk_bf16(v0[0], v0[1]); w.y = cvt_pk_bf16(v0[2], v0[3]); w.z = cvt_pk_bf16(v1[0], v1[1]); w.w = cvt_pk_bf16(v1[2], v1[3]);
                    *(u32x4*)(rowp + bj * HALF) = w; } }
    }
};
struct EpiGateMulF32 {
    static constexpr bool PERM = true, AFTER_DRAIN = false, SELF_SCALE = false;
    bf16_t* MA; int ldc; const bf16_t* G; int ldg; int gcol0;
    __device__ __forceinline__ void operator()(const f32x4 (&acc)[2][2][4][2], const Unit& u, int wr, int wc, int fr, int fq) const {
        const int row0 = u.pm * BM + wr * 64 + fr, col0 = u.pn * BM + wc * 32 + 8 * fq;
#pragma unroll
        for (int ai = 0; ai < 2; ++ai)
#pragma unroll
            for (int m = 0; m < 4; ++m) { const size_t r = (size_t)(row0 + ai * HALF + m * 16); bf16_t* rowp = MA + r * ldc + col0; const bf16_t* gp = G + r * ldg + gcol0 + col0;
#pragma unroll
                for (int bj = 0; bj < 2; ++bj) { const u32x4 g = *(const u32x4*)(gp + bj * HALF); const f32x4 a0 = acc[ai][bj][m][0], a1 = acc[ai][bj][m][1];
                    u32x4 w; w.x = cvt_pk_bf16(a0[0] * bf_lo(g.x), a0[1] * bf_hi(g.x)); w.y = cvt_pk_bf16(a0[2] * bf_lo(g.y), a0[3] * bf_hi(g.y));
                    w.z = cvt_pk_bf16(a1[0] * bf_lo(g.z), a1[1] * bf_hi(g.z)); w.w = cvt_pk_bf16(a1[2] * bf_lo(g.w), a1[3] * bf_hi(g.w));
                    *(u32x4*)(rowp + bj * HALF) = w; } }
    }
};
struct EpiGateMulAddBf16 {
    static constexpr bool PERM = true, AFTER_DRAIN = false, SELF_SCALE = false;
    bf16_t* MB; int ldc; const bf16_t* MA; const bf16_t* G; int ldg; int gcol0;
    __device__ __forceinline__ void operator()(const f32x4 (&acc)[2][2][4][2], const Unit& u, int wr, int wc, int fr, int fq) const {
        const int row0 = u.pm * BM + wr * 64 + fr, col0 = u.pn * BM + wc * 32 + 8 * fq;
#pragma unroll
        for (int ai = 0; ai < 2; ++ai)
#pragma unroll
            for (int m = 0; m < 4; ++m) { const size_t r = (size_t)(row0 + ai * HALF + m * 16); bf16_t* rowp = MB + r * ldc + col0; const bf16_t* mp = MA + r * ldc + col0; const bf16_t* gp = G + r * ldg + gcol0 + col0;
#pragma unroll
                for (int bj = 0; bj < 2; ++bj) { const u32x4 g = *(const u32x4*)(gp + bj * HALF); const u32x4 mm = *(const u32x4*)(mp + bj * HALF);
                    const f32x4 a0 = acc[ai][bj][m][0], a1 = acc[ai][bj][m][1];
                    u32x4 w; w.x = cvt_pk_bf16(bf_lo(mm.x) + a0[0] * bf_lo(g.x), bf_hi(mm.x) + a0[1] * bf_hi(g.x)); w.y = cvt_pk_bf16(bf_lo(mm.y) + a0[2] * bf_lo(g.y), bf_hi(mm.y) + a0[3] * bf_hi(g.y));
                    w.z = cvt_pk_bf16(bf_lo(mm.z) + a1[0] * bf_lo(g.z), bf_hi(mm.z) + a1[1] * bf_hi(g.z)); w.w = cvt_pk_bf16(bf_lo(mm.w) + a1[2] * bf_lo(g.w), bf_hi(mm.w) + a1[3] * bf_hi(g.w));
                    *(u32x4*)(rowp + bj * HALF) = w; } }
    }
};
struct EpiResid {
    static constexpr bool PERM = false, AFTER_DRAIN = false, SELF_SCALE = false;
    const float* smeta; const float* sreal; float* dmeta; float* dreal; int ld; int nmeta; int nrows;
    __device__ __forceinline__ void operator()(const f32x4 (&acc)[2][2][4][2], const Unit& u, int wr, int wc, int fr, int fq) const {
        const int row0 = u.pm * BM + wr * 64 + fr, col0 = u.pn * BM + wc * 32 + 4 * fq;
#pragma unroll
        for (int ai = 0; ai < 2; ++ai)
#pragma unroll
            for (int m = 0; m < 4; ++m) { const int r = row0 + ai * HALF + m * 16;
                if (r < nrows) {
                    const float* sp = (r < nmeta ? smeta + (size_t)r * ld : sreal + (size_t)(r - nmeta) * ld) + col0;
                    float* dp = (r < nmeta ? dmeta + (size_t)r * ld : dreal + (size_t)(r - nmeta) * ld) + col0;
#pragma unroll
                    for (int bj = 0; bj < 2; ++bj)
#pragma unroll
                        for (int n = 0; n < 2; ++n) *(f32x4*)(dp + bj * HALF + n * 16) = *(const f32x4*)(sp + bj * HALF + n * 16) + acc[ai][bj][m][n];
                } }
    }
};

template <int CTRL> __device__ __forceinline__ float dpp_mov(float v) { return __builtin_bit_cast(float, __builtin_amdgcn_update_dpp(0, __builtin_bit_cast(int, v), CTRL, 0xf, 0xf, false)); }
struct EpiConvAct {
    static constexpr bool PERM = true, AFTER_DRAIN = false, SELF_SCALE = true;
    bf16_t* ACT; int ldact; float* HALO; int ldh; const float* cw; const float* cb; int dff; PG8_LAS float* hx; const float* sag; const float* sb;
    __device__ __forceinline__ void operator()(const f32x4 (&acc)[2][2][4][2], const Unit& u, int wr, int wc, int fr, int fq) const {
        const int cl = wc * 32 + 8 * fq;
        const int ch = u.pn * 128 + cl;
        if (fr >= 14) {
#pragma unroll
            for (int ai = 0; ai < 2; ++ai)
#pragma unroll
                for (int bj = 0; bj < 2; ++bj)
#pragma unroll
                    for (int n = 0; n < 2; ++n) *(PG8_LAS f32x4*)(hx + (((ai * 2 + wr) * 2 + (fr - 14)) * 256 + bj * 128 + cl + 4 * n)) = acc[ai][bj][3][n];
        }
        if (wr == 0 && fr < 2) {
            float* hp = HALO + ((size_t)u.pm * 4 + fr) * ldh + u.pn * 256 + cl;
#pragma unroll
            for (int bj = 0; bj < 2; ++bj)
#pragma unroll
                for (int n = 0; n < 2; ++n) *(f32x4*)(hp + bj * 128 + 4 * n) = acc[0][bj][0][n] * (*(const f32x4*)(sb + u.pn * 256 + bj * 128 + cl + 4 * n) * sag[0]);
        }
        if (wr == 1 && fr >= 14) {
            float* hp = HALO + ((size_t)u.pm * 4 + (fr - 12)) * ldh + u.pn * 256 + cl;
#pragma unroll
            for (int bj = 0; bj < 2; ++bj)
#pragma unroll
                for (int n = 0; n < 2; ++n) *(f32x4*)(hp + bj * 128 + 4 * n) = acc[1][bj][3][n] * (*(const f32x4*)(sb + u.pn * 256 + bj * 128 + cl + 4 * n) * sag[0]);
        }
        asm volatile("s_waitcnt lgkmcnt(0)" ::: "memory"); __builtin_amdgcn_s_barrier(); asm volatile("" ::: "memory");
#pragma unroll
        for (int n = 0; n < 2; ++n) {
            f32x4 wt[2][3], bb[2];
#pragma unroll
            for (int bj = 0; bj < 2; ++bj) { bb[bj] = *(const f32x4*)(cb + bj * dff + ch + 4 * n);
#pragma unroll
                for (int i = 0; i < 3; ++i) wt[bj][i] = *(const f32x4*)(cw + (size_t)i * 2 * dff + bj * dff + ch + 4 * n) * (*(const f32x4*)(sb + u.pn * 256 + bj * 128 + cl + 4 * n) * sag[0]); }
#pragma unroll
            for (int ai = 0; ai < 2; ++ai) {
                const bool hasprev = (ai | wr) != 0; const int pb = ai * 2 + wr - 1;
                f32x4 xp[2];
#pragma unroll
                for (int bj = 0; bj < 2; ++bj) { xp[bj] = (f32x4){0.f, 0.f, 0.f, 0.f};
                    if (hasprev && fr >= 14) xp[bj] = *(const PG8_LAS f32x4*)(hx + ((pb * 2 + (fr - 14)) * 256 + bj * 128 + cl + 4 * n)); }
#pragma unroll
                for (int m = 0; m < 4; ++m) {
                    f32x4 z[2];
#pragma unroll
                    for (int bj = 0; bj < 2; ++bj) {
                        const f32x4 x = acc[ai][bj][m][n];
#pragma unroll
                        for (int j = 0; j < 4; ++j) {
                            const float a1 = dpp_mov<0x121>(x[j]), p1 = dpp_mov<0x121>(xp[bj][j]), a2 = dpp_mov<0x122>(x[j]), p2 = dpp_mov<0x122>(xp[bj][j]);
                            const float s1 = fr == 0 ? p1 : a1, s2 = fr < 2 ? p2 : a2;
                            z[bj][j] = bb[bj][j] + wt[bj][2][j] * x[j] + wt[bj][1][j] * s1 + wt[bj][0][j] * s2;
                        }
                        xp[bj] = x;
                    }
                    const int r = u.pm * BM + ai * HALF + wr * 64 + m * 16 + fr;
                    float o[4];
#pragma unroll
                    for (int j = 0; j < 4; ++j) { const float g = z[0][j]; o[j] = g * __builtin_amdgcn_rcpf(1.f + __expf(-g)) * z[1][j]; }
                    u32x2 w; w.x = cvt_pk_bf16(o[0], o[1]); w.y = cvt_pk_bf16(o[2], o[3]);
                    *(u32x2*)(ACT + (size_t)r * ldact + ch + 4 * n) = w;
                }
                asm volatile("" ::: "memory");
            }
        }
    }
};
template <class Epi, class Sched, bool ALIGN_EPI = false, bool SP2 = false, bool I8 = false>
__device__ __forceinline__ void gemm_phase(PG8_LAS unsigned char* lds, const Gemm g, const Sched& S, const Epi& E) {
    const int tid = threadIdx.x, wid = __builtin_amdgcn_readfirstlane(tid >> 6), lane = tid & 63, wr = wid >> 2, wc = wid & 3, fr = lane & 15, fq = lane >> 4;
    const int K = g.K, nt = K / BK;
    unsigned voffA[2], voffB[2];
#pragma unroll
    for (int i = 0; i < 2; ++i) { int R, C; stage_rc(tid * 16 + i * 8192, R, C); const int Rb = Epi::PERM ? ((R & ~31) + perm32(R & 31)) : R;
        voffA[i] = (unsigned)(R * K + C) * 2u; voffB[i] = (unsigned)(Rb * K + C) * 2u; }
    const size_t kstep = (size_t)(BK * 2);
    const size_t hstep = (size_t)HALF * K * 2;
    const size_t tstep = 2 * hstep;
    const unsigned ldsw = (unsigned)wid * 1024u;
    const int aoff = lds_byte(wr * 64 + fr, fq * 8), boff = lds_byte(wc * 32 + fr, fq * 8);
#define PG8_SA(b, h) (((b) * 2 + (h)) * HTB)
#define PG8_SB(b, h) ((4 + (b) * 2 + (h)) * HTB)
#define PG8_STAGE(bufoff, gbase, voff) do { _Pragma("unroll") for (int _i = 0; _i < 2; ++_i) \
        __builtin_amdgcn_global_load_lds((const unsigned*)((const char*)(gbase) + (voff)[_i]), (PG8_LAS unsigned*)(lds + (bufoff) + ldsw + _i * 8192), 16, 0, 0); } while (0)
#define PG8_LDA(dst, b, h) do { _Pragma("unroll") for (int m = 0; m < 4; ++m) _Pragma("unroll") for (int k = 0; k < 2; ++k) dst[m][k] = *(const PG8_LAS bf16x8*)(lds + PG8_SA(b, h) + aoff + m * 2048 + k * 1024); } while (0)
#define PG8_LDB(dst, b, h) do { _Pragma("unroll") for (int n = 0; n < 2; ++n) _Pragma("unroll") for (int k = 0; k < 2; ++k) dst[n][k] = *(const PG8_LAS bf16x8*)(lds + PG8_SB(b, h) + boff + n * 2048 + k * 1024); } while (0)
#define PG8_MMA(ai, bj, At, Bt) do { __builtin_amdgcn_s_setprio(1); _Pragma("unroll") for (int m = 0; m < 4; ++m) _Pragma("unroll") for (int n = 0; n < 2; ++n) _Pragma("unroll") for (int k = 0; k < 2; ++k) { \
        if constexpr (I8) acc[ai][bj][m][n] = __builtin_bit_cast(f32x4, __builtin_amdgcn_mfma_i32_16x16x64_i8(__builtin_bit_cast(i32x4, Bt[n][k]), __builtin_bit_cast(i32x4, At[m][k]), __builtin_bit_cast(i32x4, acc[ai][bj][m][n]), 0, 0, 0)); \
        else acc[ai][bj][m][n] = __builtin_amdgcn_mfma_f32_16x16x32_bf16(Bt[n][k], At[m][k], acc[ai][bj][m][n], 0, 0, 0); } __builtin_amdgcn_s_setprio(0); } while (0)
#define PG8_WAIT_V(n) asm volatile("s_waitcnt vmcnt(" #n ")" ::: "memory")
#define PG8_WAIT_L(n) asm volatile("s_waitcnt lgkmcnt(" #n ")" ::: "memory")
#define PG8_BAR __builtin_amdgcn_s_barrier()
#define PG8_SCHED __builtin_amdgcn_sched_barrier(0)
    Unit cur, nxt; int ui = 0;
    if (!S.next(0, cur)) return;
    f32x4 acc[2][2][4][2];
#pragma unroll
    for (int a = 0; a < 2; ++a)
#pragma unroll
        for (int b = 0; b < 2; ++b)
#pragma unroll
            for (int m = 0; m < 4; ++m)
#pragma unroll
                for (int n = 0; n < 2; ++n) acc[a][b][m][n] = (f32x4){0.f, 0.f, 0.f, 0.f};
    bf16x8 At[4][2], B0[2][2], B1[2][2];
    const char* cA = (const char*)g.A + (size_t)cur.pm * tstep; const char* cB = (const char*)g.Bt + (size_t)cur.pn * tstep;
    S.a_ready(cur);
    if constexpr (SP2) {
        PG8_STAGE(PG8_SB(0, 0), cB, voffB); PG8_STAGE(PG8_SB(0, 1), cB + hstep, voffB); PG8_STAGE(PG8_SA(0, 0), cA, voffA); PG8_STAGE(PG8_SA(0, 1), cA + hstep, voffA);
        if (wr == 1) PG8_BAR;
        PG8_WAIT_V(2); PG8_BAR;
        PG8_STAGE(PG8_SB(1, 0), cB + kstep, voffB); PG8_STAGE(PG8_SA(1, 0), cA + kstep, voffA); PG8_STAGE(PG8_SB(1, 1), cB + hstep + kstep, voffB);
        PG8_WAIT_V(6); PG8_BAR;
    } else {
        PG8_STAGE(PG8_SB(0, 0), cB, voffB); PG8_STAGE(PG8_SA(0, 0), cA, voffA); PG8_STAGE(PG8_SB(0, 1), cB + hstep, voffB); PG8_STAGE(PG8_SA(0, 1), cA + hstep, voffA);
        if (wr == 1) PG8_BAR;
        PG8_WAIT_V(4); PG8_BAR;
        PG8_STAGE(PG8_SB(1, 0), cB + kstep, voffB); PG8_STAGE(PG8_SA(1, 0), cA + kstep, voffA); PG8_STAGE(PG8_SB(1, 1), cB + hstep + kstep, voffB);
        PG8_WAIT_V(6); PG8_BAR;
    }
    for (;;) {
        const bool has_next = S.next(ui + 1, nxt);
        const char* nA = has_next ? (const char*)g.A + (size_t)nxt.pm * tstep : cA; const char* nB = has_next ? (const char*)g.Bt + (size_t)nxt.pn * tstep : cB;
        for (int t = 0; t < nt; t += 2) {
            const bool last = (t == nt - 2);
            const char* a1 = cA + (size_t)(t + 1) * kstep;
            const char* a2 = last ? nA : cA + (size_t)(t + 2) * kstep; const char* b2 = last ? nB : cB + (size_t)(t + 2) * kstep;
            const char* a3 = a2 + kstep; const char* b3 = b2 + kstep;
            if (last && has_next) S.a_ready(nxt);
            if constexpr (SP2) {
            PG8_LDB(B0, 0, 0); PG8_LDB(B1, 0, 1); PG8_SCHED; PG8_LDA(At, 0, 0); PG8_STAGE(PG8_SA(1, 1), a1 + hstep, voffA);
            PG8_WAIT_V(8); PG8_WAIT_L(0); PG8_BAR; PG8_MMA(0, 0, At, B0); PG8_MMA(0, 1, At, B1); PG8_BAR; PG8_SCHED;
            PG8_LDA(At, 0, 1); PG8_STAGE(PG8_SB(0, 0), b2, voffB); PG8_STAGE(PG8_SB(0, 1), b2 + hstep, voffB); PG8_STAGE(PG8_SA(0, 0), a2, voffA);
            PG8_WAIT_V(8); PG8_WAIT_L(0); PG8_BAR; PG8_MMA(1, 0, At, B0); PG8_MMA(1, 1, At, B1); PG8_BAR; PG8_SCHED;
            PG8_LDB(B0, 1, 0); PG8_LDB(B1, 1, 1); PG8_SCHED; PG8_LDA(At, 1, 0); PG8_STAGE(PG8_SA(0, 1), a2 + hstep, voffA);
            PG8_WAIT_V(8); PG8_WAIT_L(0); PG8_BAR; PG8_MMA(0, 0, At, B0); PG8_MMA(0, 1, At, B1); PG8_BAR; PG8_SCHED;
            PG8_LDA(At, 1, 1); PG8_STAGE(PG8_SB(1, 0), b3, voffB); PG8_STAGE(PG8_SB(1, 1), b3 + hstep, voffB); PG8_STAGE(PG8_SA(1, 0), a3, voffA);
            PG8_WAIT_V(8); PG8_WAIT_L(0); PG8_BAR; PG8_MMA(1, 0, At, B0); PG8_MMA(1, 1, At, B1); PG8_BAR; PG8_SCHED;
            } else {
            PG8_LDB(B0, 0, 0); PG8_SCHED; PG8_LDA(At, 0, 0); PG8_STAGE(PG8_SA(1, 1), a1 + hstep, voffA);
            PG8_WAIT_L(8); PG8_BAR; PG8_WAIT_L(0); PG8_MMA(0, 0, At, B0); PG8_BAR; PG8_SCHED;
            PG8_LDB(B1, 0, 1); PG8_STAGE(PG8_SB(0, 0), b2, voffB);
            PG8_BAR; PG8_WAIT_L(0); PG8_MMA(0, 1, At, B1); PG8_BAR;
            PG8_LDA(At, 0, 1); PG8_STAGE(PG8_SA(0, 0), a2, voffA);
            PG8_BAR; PG8_WAIT_L(0); PG8_MMA(1, 0, At, B0); PG8_BAR; PG8_SCHED;
            PG8_STAGE(PG8_SB(0, 1), b2 + hstep, voffB);
            PG8_WAIT_V(6); PG8_BAR; PG8_MMA(1, 1, At, B1); PG8_BAR;
            PG8_LDB(B0, 1, 0); PG8_SCHED; PG8_LDA(At, 1, 0); PG8_STAGE(PG8_SA(0, 1), a2 + hstep, voffA);
            PG8_WAIT_L(8); PG8_BAR; PG8_WAIT_L(0); PG8_MMA(0, 0, At, B0); PG8_BAR; PG8_SCHED;
            PG8_LDB(B1, 1, 1); PG8_STAGE(PG8_SB(1, 0), b3, voffB);
            PG8_BAR; PG8_WAIT_L(0); PG8_MMA(0, 1, At, B1); PG8_BAR;
            PG8_LDA(At, 1, 1); PG8_STAGE(PG8_SA(1, 0), a3, voffA);
            PG8_BAR; PG8_WAIT_L(0); PG8_MMA(1, 0, At, B0); PG8_BAR; PG8_SCHED;
            PG8_STAGE(PG8_SB(1, 1), b3 + hstep, voffB);
            PG8_WAIT_V(6); PG8_BAR; PG8_MMA(1, 1, At, B1); PG8_BAR;
            }
        }
        if constexpr (ALIGN_EPI) { if (wr == 0) PG8_BAR; }
        if constexpr (I8) {
            asm volatile("s_nop 15\n\ts_nop 15" ::: "memory");
#pragma unroll
            for (int ai = 0; ai < 2; ++ai)
#pragma unroll
                for (int bj = 0; bj < 2; ++bj)
#pragma unroll
                    for (int m = 0; m < 4; ++m)
#pragma unroll
                        for (int n = 0; n < 2; ++n)
#pragma unroll
                            for (int j = 0; j < 4; ++j) { float x = acc[ai][bj][m][n][j]; asm volatile("v_cvt_f32_i32 %0, %0" : "+v"(x)); acc[ai][bj][m][n][j] = x; }
            if constexpr (!Epi::SELF_SCALE) {
                const int row0 = cur.pm * BM + wr * 64 + fr, col0 = cur.pn * BM + wc * 32 + (Epi::PERM ? 8 * fq : 4 * fq);
#pragma unroll
                for (int bj = 0; bj < 2; ++bj)
#pragma unroll
                    for (int n = 0; n < 2; ++n) { const f32x4 sc = *(const f32x4*)(g.sb + col0 + bj * HALF + (Epi::PERM ? 4 * n : 16 * n));
#pragma unroll
                        for (int ai = 0; ai < 2; ++ai)
#pragma unroll
                            for (int m = 0; m < 4; ++m) { const float sr = g.sa[row0 + ai * HALF + m * 16]; acc[ai][bj][m][n] = acc[ai][bj][m][n] * (sc * sr); } }
            }
        }
        if constexpr (!Epi::AFTER_DRAIN) { E(acc, cur, wr, wc, fr, fq); S.done(cur); }
        if (!has_next) break;
#pragma unroll
        for (int a = 0; a < 2; ++a)
#pragma unroll
            for (int b = 0; b < 2; ++b)
#pragma unroll
                for (int m = 0; m < 4; ++m)
#pragma unroll
                    for (int n = 0; n < 2; ++n) acc[a][b][m][n] = (f32x4){0.f, 0.f, 0.f, 0.f};
        cur = nxt; cA = nA; cB = nB; ++ui;
        if constexpr (ALIGN_EPI) { if (wr == 1) PG8_BAR; }
    }
    PG8_WAIT_V(0);
    if constexpr (!ALIGN_EPI) { if (wr == 0) PG8_BAR; }
    PG8_BAR;
    if constexpr (Epi::AFTER_DRAIN) { E.fused(acc, cur, wr, wc, fr, fq, lds, wid, lane); S.done(cur); }
#undef PG8_SA
#undef PG8_SB
#undef PG8_STAGE
#undef PG8_LDA
#undef PG8_LDB
#undef PG8_MMA
#undef PG8_WAIT_V
#undef PG8_WAIT_L
#undef PG8_BAR
#undef PG8_SCHED
}
}
#define XB_TMO      128
#define XB_XCNT(j)  (256  + 64 * (j))
#define XB_XSUB(j)  (1280 + 64 * (j))
#define XB_XGEN(j)  (2304 + 64 * (j))
#define XB_TOP      3328
#define XB_TOPGEN   3392
#define XCD_BAR_WORDS 3456
#define XB_SPIN_CAP (1u << 18)
#define LAS __attribute__((address_space(3)))

__device__ __forceinline__ unsigned xb_ld(unsigned* p)              { return __hip_atomic_load(p, __ATOMIC_RELAXED, __HIP_MEMORY_SCOPE_AGENT); }
__device__ __forceinline__ unsigned xb_add(unsigned* p, unsigned v) { return __hip_atomic_fetch_add(p, v, __ATOMIC_RELAXED, __HIP_MEMORY_SCOPE_AGENT); }
__device__ __forceinline__ unsigned xb_xcc_id() { return (unsigned)__builtin_amdgcn_s_getreg((3 << 11) | 20) & 0xFu; }
#define XB_SPIN(cond, bar) do { unsigned _sp = 0; while (cond) { __builtin_amdgcn_s_sleep(1); \
    if ((++_sp & 255u) == 0u) { if (xb_ld(&(bar)[XB_TMO])) break; if (_sp > XB_SPIN_CAP) { atomicAdd(&(bar)[XB_TMO], 1u); break; } } } } while (0)

struct XcdBarrier {
    unsigned* bar; unsigned x;
    volatile LAS unsigned* st;
};

__device__ __forceinline__ XcdBarrier xcd_barrier_post(unsigned* bar, volatile LAS unsigned* st) {
    XcdBarrier b; b.bar = bar; b.x = xb_xcc_id(); b.st = st;
    if (threadIdx.x == 0) (void)xb_add(&bar[XB_XCNT(b.x)], 1u);
    return b;
}
__device__ __forceinline__ void xcd_barrier_complete(unsigned* bar, unsigned x, unsigned& nloc, unsigned& nx) {
    const unsigned G = gridDim.x * gridDim.y * gridDim.z;
    unsigned sum, cnt, mine, sp = 0u;
    for (;;) {
        sum = 0u; cnt = 0u; mine = 0u;
#pragma unroll
        for (unsigned j = 0; j < 16; ++j) { const unsigned c = xb_ld(&bar[XB_XCNT(j)]); sum += c; cnt += (c > 0u) ? 1u : 0u; mine = (j == x) ? c : mine; }
        if (sum == G) break;
        __builtin_amdgcn_s_sleep(1);
        if ((++sp & 255u) == 0u) { if (xb_ld(&bar[XB_TMO])) break; if (sp > XB_SPIN_CAP) { atomicAdd(&bar[XB_TMO], 1u); break; } }
    }
    nloc = mine > 0u ? mine : 1u; nx = cnt > 0u ? cnt : 1u;
}

__device__ __forceinline__ void xcd_barrier(const XcdBarrier& b) {
    asm volatile("s_waitcnt vmcnt(0)" ::: "memory");
    __syncthreads();
    if (threadIdx.x == 0) {
        unsigned* bar = b.bar;
        __builtin_amdgcn_s_waitcnt(0);
        unsigned nloc = b.st[0], nx = b.st[1];
        if (nloc == 0u) { xcd_barrier_complete(bar, b.x, nloc, nx); b.st[0] = nloc; b.st[1] = nx; }
        const unsigned old = xb_add(&bar[XB_XSUB(b.x)], 1u);
        const unsigned gen = old / nloc;
        if (old + 1u == (gen + 1u) * nloc) {
            __builtin_amdgcn_fence(__ATOMIC_RELEASE, "agent");
            asm volatile("s_waitcnt vmcnt(0)" ::: "memory");
            const unsigned og = xb_add(&bar[XB_TOP], 1u);
            const unsigned tg = og / nx;
            if (og + 1u == (tg + 1u) * nx) xb_add(&bar[XB_TOPGEN], 1u);
            else XB_SPIN(xb_ld(&bar[XB_TOPGEN]) == tg, bar);
            __builtin_amdgcn_fence(__ATOMIC_ACQUIRE, "agent");
            xb_add(&bar[XB_XGEN(b.x)], 1u);
            asm volatile("s_waitcnt vmcnt(0)" ::: "memory");
        } else {
            XB_SPIN(xb_ld(&bar[XB_XGEN(b.x)]) == gen, bar);
            __builtin_amdgcn_fence(__ATOMIC_ACQUIRE, "agent");
            asm volatile("s_waitcnt vmcnt(0)" ::: "memory");
        }
    }
    __syncthreads();
}

#define LAS __attribute__((address_space(3)))
typedef unsigned short bf16_t;
typedef float f32x4 __attribute__((ext_vector_type(4)));
typedef unsigned u32x4 __attribute__((ext_vector_type(4)));
typedef unsigned u32x2 __attribute__((ext_vector_type(2)));

#ifndef MK_ONE_LAUNCH
#define MK_ONE_LAUNCH 0
#endif

constexpr int NWAVES = 8, NT = NWAVES * 64;
constexpr int D = 4096, SEQ = 16384, NMETA = 16, L = SEQ + NMETA, MP = 16640;
constexpr int A_W = 2048, A_COLS = 6592, B_COLS = 4704, IN_COLS = A_COLS + B_COLS, NZ = 11520;
constexpr int ZQ = A_COLS, ZCKV = A_COLS + 2048, ZQI = A_COLS + 2560, ZKI = A_COLS + 4608, ZWI = A_COLS + 4672;
constexpr int DFF = 11008, NFI = 2 * DFF;
constexpr int KVR = 512, NH_B = 16, HD_B = 128, IDXH = 32, IDXD = 64, TOPK = 256;
constexpr int LDS_BYTES = 163840, MISC_OFF = 163584;
constexpr int NZ8 = 8960;
constexpr size_t WINT_BF_OFF = (size_t)40 << 20;

constexpr size_t al256(size_t x) { return (x + 255) & ~(size_t)255; }
constexpr size_t WS_CTL = 0, CTL_BYTES = 1u << 20;
constexpr size_t WS_WGT = WS_CTL + CTL_BYTES;
constexpr size_t WS_WPAT = WS_WGT + (size_t)8192 * 4096 * 2;
constexpr size_t WS_WPBT = WS_WPAT + (size_t)4096 * 2048 * 2;
constexpr size_t WS_WOUTT = WS_WPBT + (size_t)4096 * 2048 * 2;
constexpr size_t WS_WFIT = WS_WOUTT + (size_t)4096 * 4096 * 2;
constexpr size_t WS_WFOT = WS_WFIT + (size_t)NFI * 4096 * 2;
constexpr size_t WS_WINT = WS_WFOT + (size_t)4096 * DFF * 2;
constexpr size_t WS_U = WS_WINT + (size_t)NZ * 4096 * 2;
constexpr size_t WS_BIG = WS_U + (size_t)MP * D * 2;
constexpr size_t WS_Z = WS_BIG;
constexpr size_t WS_R1 = WS_Z + (size_t)MP * NZ * 2;
constexpr size_t R1_BYTES = (size_t)MP * D * 4;
constexpr size_t WS_LD = WS_R1;
constexpr size_t WS_AA = WS_LD + (size_t)L * A_W * 4;
constexpr size_t WS_GG = WS_AA + (size_t)L * A_W * 2;
constexpr size_t WS_QLAT = WS_R1;
constexpr size_t WS_MF = WS_R1;
constexpr size_t WS_YA = WS_R1 + R1_BYTES;
constexpr size_t WS_YB = WS_YA + (size_t)MP * A_W * 2;
constexpr size_t WS_END = WS_YB + (size_t)MP * A_W * 2;
constexpr size_t WS_GATES = WS_Z;
constexpr size_t WS_ZF = WS_BIG;
constexpr size_t WS_ACT = WS_BIG + (size_t)MP * DFF * 2;
constexpr size_t WS_CKV = WS_WINT;
constexpr size_t WS_KIDX = WS_CKV + al256((size_t)L * KVR * 2);
constexpr size_t WS_SEL = WS_KIDX + al256((size_t)L * IDXD * 4);
constexpr size_t WS_HMETA = WS_SEL + al256((size_t)L * TOPK * 4);
static_assert(WS_HMETA + (size_t)NMETA * D * 4 <= WS_U, "DSA overlays exceed WINT");
constexpr size_t WS_KIDXB = WS_HMETA + al256((size_t)NMETA * D * 4);
static_assert(WS_KIDXB + (size_t)L * IDXD * 2 <= WS_U, "KIDXB");
constexpr size_t WS_WUKB = WS_END;
constexpr size_t WS_WUVT = WS_WUKB + (size_t)16 * 512 * 128 * 2;
constexpr size_t WS_WLT = WS_WUVT + (size_t)16 * 512 * 128 * 2;
constexpr size_t WS_END2 = WS_WLT + (size_t)2048 * 448 * 2;
static_assert(WS_END2 <= (size_t)4 * 4096 * 22016 * 4, "workspace");
constexpr size_t CT_CMX_IN = 524288, CT_CMX_G = CT_CMX_IN + (size_t)NZ * 4, CT_CMX_F = CT_CMX_G + 8192 * 4, CT_SB_IN = CT_CMX_F + (size_t)NFI * 4, CT_SB_G = CT_SB_IN + (size_t)NZ * 4,
                 CT_SB_F = CT_SB_G + 8192 * 4, CT_SA = CT_SB_F + (size_t)NFI * 4, CT_AMAX = CT_SA + (size_t)MP * 4, CT_SAG = CT_AMAX + 256, CT_END = CT_SAG + 256;
static_assert(CT_END <= CTL_BYTES, "control region");
constexpr size_t WS_ST = WS_WINT;
constexpr size_t WS_BS = WS_ST + al256((size_t)257 * 32 * 4096 * 2);
static_assert(WS_BS + (size_t)L * 32 * 4 <= WS_U, "RWKV overlays exceed WINT");
static_assert((size_t)L * A_W * 4 + 2 * (size_t)L * A_W * 2 <= R1_BYTES && (size_t)L * 8192 * 2 <= R1_BYTES, "R1");
static_assert(WS_ACT + (size_t)MP * DFF * 2 <= WS_END, "ACT");
static_assert((size_t)MP * 8192 * 2 <= (size_t)MP * NZ * 2, "GATES");
static_assert(WS_END <= (size_t)4 * 4096 * 22016 * 4, "workspace");

__device__ __forceinline__ float bf2f(bf16_t b) { return __uint_as_float(((unsigned)b) << 16); }
__device__ __forceinline__ bf16_t f2bf(float f) { unsigned u = __float_as_uint(f); u += 0x7FFFu + ((u >> 16) & 1u); return (bf16_t)(u >> 16); }
__device__ __forceinline__ unsigned pk2(float lo, float hi) { return (unsigned)f2bf(lo) | ((unsigned)f2bf(hi) << 16); }
__device__ __forceinline__ float blo(unsigned w) { return __uint_as_float(w << 16); }
__device__ __forceinline__ float bhi(unsigned w) { return __uint_as_float(w & 0xffff0000u); }
__device__ __forceinline__ float sigm(float x) { return 1.f / (1.f + __expf(-x)); }
template <int CTRL> __device__ __forceinline__ float dpp_f(float v) { return __builtin_bit_cast(float, __builtin_amdgcn_update_dpp(0, __builtin_bit_cast(int, v), CTRL, 0xf, 0xf, false)); }
__device__ __forceinline__ float wave_sum(float v) {
    v += dpp_f<0xB1>(v);
    v += dpp_f<0x4E>(v);
    v += dpp_f<0x141>(v);
    v += dpp_f<0x140>(v);
    const float a = __builtin_bit_cast(float, __builtin_amdgcn_readlane(__builtin_bit_cast(int, v), 0));
    const float b = __builtin_bit_cast(float, __builtin_amdgcn_readlane(__builtin_bit_cast(int, v), 16));
    const float c = __builtin_bit_cast(float, __builtin_amdgcn_readlane(__builtin_bit_cast(int, v), 32));
    const float d = __builtin_bit_cast(float, __builtin_amdgcn_readlane(__builtin_bit_cast(int, v), 48));
    return (a + b) + (c + d);
}
__device__ __forceinline__ float wave_max(float v) {
    v = fmaxf(v, dpp_f<0xB1>(v)); v = fmaxf(v, dpp_f<0x4E>(v)); v = fmaxf(v, dpp_f<0x141>(v)); v = fmaxf(v, dpp_f<0x140>(v));
    const float a = __builtin_bit_cast(float, __builtin_amdgcn_readlane(__builtin_bit_cast(int, v), 0));
    const float b = __builtin_bit_cast(float, __builtin_amdgcn_readlane(__builtin_bit_cast(int, v), 16));
    const float c = __builtin_bit_cast(float, __builtin_amdgcn_readlane(__builtin_bit_cast(int, v), 32));
    const float d = __builtin_bit_cast(float, __builtin_amdgcn_readlane(__builtin_bit_cast(int, v), 48));
    return fmaxf(fmaxf(a, b), fmaxf(c, d));
}
#define LDS_WAIT() asm volatile("s_waitcnt lgkmcnt(0)" ::: "memory")

struct P {
    const float* in[30]; float* out; unsigned char* ws; int ph_lo, ph_hi;
};
enum { I_X = 0, I_META, I_NMW, I_WIN, I_MU, I_W0, I_W2, I_A0, I_A2, I_G2, I_KK, I_KA, I_RK, I_LNW, I_LNB, I_KVNW, I_WUK, I_WUV, I_ILNW, I_ILNB,
       I_WPA, I_WPB, I_WGATE, I_WOUT, I_NFW, I_WFI, I_CW, I_CB, I_WFO, I_NFIN };

template <int MODE>
__device__ __forceinline__ void tr_item(const float* W, int K, int N, int Npad, bf16_t* WT, LAS float* scr, int item, int lane) {
    const int nblk = Npad / 32, kb = item / nblk, nb = item % nblk, k0 = 64 * kb, n0 = 32 * nb;
    int s0 = n0; bool valid = n0 < N;
    if (MODE == 1) { const int T = n0 >> 8, w = n0 & 255; s0 = (w < 128) ? T * 128 + w : DFF + T * 128 + (w - 128); valid = true; }
    if (valid) {
#pragma unroll
        for (int i = 0; i < 8; ++i) { const int kk = 8 * i + (lane >> 3), c4 = 4 * (lane & 7); const f32x4 v_ = *(const f32x4*)(W + (size_t)(k0 + kk) * N + s0 + c4);
            LAS float* d_ = scr + kk * 33 + c4; d_[0] = v_.x; d_[1] = v_.y; d_[2] = v_.z; d_[3] = v_.w; }
    } else {
#pragma unroll 8
        for (int i = 0; i < 32; ++i) { const int kk = 2 * i + (lane >> 5); scr[kk * 33 + (lane & 31)] = 0.f; }
    }
    LDS_WAIT(); __builtin_amdgcn_wave_barrier();
    const int c = lane & 7;
#pragma unroll
    for (int j = 0; j < 4; ++j) { const int n = (lane >> 3) + 8 * j; const LAS float* s = scr + (8 * c) * 33 + n;
        u32x4 o; o.x = pk2(s[0 * 33], s[1 * 33]); o.y = pk2(s[2 * 33], s[3 * 33]); o.z = pk2(s[4 * 33], s[5 * 33]); o.w = pk2(s[6 * 33], s[7 * 33]);
        *(u32x4*)(WT + (size_t)(n0 + n) * K + k0 + 8 * c) = o; }
    LDS_WAIT(); __builtin_amdgcn_wave_barrier();
}
__device__ __forceinline__ void colmax_item(const float* W, int N, unsigned* cmx, int it) {
    const int nb = (N + 2047) / 2048, kc = it / nb, n = (it % nb) * 2048 + threadIdx.x * 4;
    if (n < N) { f32x4 m = {0.f, 0.f, 0.f, 0.f}; const float* wp = W + (size_t)kc * 32 * N + n;
#pragma unroll 8
        for (int k = 0; k < 32; ++k) { const f32x4 v = *(const f32x4*)(wp + (size_t)k * N); m.x = fmaxf(m.x, fabsf(v.x)); m.y = fmaxf(m.y, fabsf(v.y)); m.z = fmaxf(m.z, fabsf(v.z)); m.w = fmaxf(m.w, fabsf(v.w)); }
        atomicMax(cmx + n, __float_as_uint(m.x)); atomicMax(cmx + n + 1, __float_as_uint(m.y)); atomicMax(cmx + n + 2, __float_as_uint(m.z)); atomicMax(cmx + n + 3, __float_as_uint(m.w)); }
}
template <int MODE>
__device__ __forceinline__ void tr_item_i8(const float* W, int K, int N, int Npad, signed char* WT, const unsigned* cmx, float* sbdst, LAS float* scr, int item, int lane) {
    const int nblk = Npad / 32, kb = item / nblk, nb = item % nblk, k0 = 64 * kb, n0 = 32 * nb;
    int s0 = n0; bool valid = n0 < N;
    if (MODE == 1) { const int T = n0 >> 8, w = n0 & 255; s0 = (w < 128) ? T * 128 + w : DFF + T * 128 + (w - 128); valid = true; }
    if (valid) {
#pragma unroll
        for (int i = 0; i < 8; ++i) { const int kk = 8 * i + (lane >> 3), c4 = 4 * (lane & 7); const f32x4 v_ = *(const f32x4*)(W + (size_t)(k0 + kk) * N + s0 + c4);
            LAS float* d_ = scr + kk * 33 + c4; d_[0] = v_.x; d_[1] = v_.y; d_[2] = v_.z; d_[3] = v_.w; }
    } else {
#pragma unroll 8
        for (int i = 0; i < 32; ++i) { const int kk = 2 * i + (lane >> 5); scr[kk * 33 + (lane & 31)] = 0.f; }
    }
    LDS_WAIT(); __builtin_amdgcn_wave_barrier();
    const int n = lane >> 1, half = lane & 1;
    const float mx = valid ? __uint_as_float(cmx[s0 + n]) : 0.f; const float inv = mx > 0.f ? 127.f / mx : 0.f;
    unsigned o[8];
#pragma unroll
    for (int c = 0; c < 8; ++c) { unsigned w = 0u;
#pragma unroll
        for (int e = 0; e < 4; ++e) { const int qv = (int)rintf(scr[(half * 32 + c * 4 + e) * 33 + n] * inv); w |= ((unsigned)qv & 0xffu) << (8 * e); }
        o[c] = w; }
    *(u32x4*)(WT + (size_t)(n0 + n) * K + k0 + half * 32) = (u32x4){o[0], o[1], o[2], o[3]};
    *(u32x4*)(WT + (size_t)(n0 + n) * K + k0 + half * 32 + 16) = (u32x4){o[4], o[5], o[6], o[7]};
    if (kb == 0 && half == 0) sbdst[n0 + n] = mx * (1.f / 127.f);
    LDS_WAIT(); __builtin_amdgcn_wave_barrier();
}
template <bool DUAL = false> __device__ __forceinline__ void rms_row_i8(const float* src, const float* w, signed char* dst, float* sa, int lane, float eps, bf16_t* dstb = nullptr) {
    if (src == nullptr) {
        if (DUAL) {
#pragma unroll
            for (int j = 0; j < 8; ++j) *(u32x4*)(dstb + (j * 64 + lane) * 8) = (u32x4){0u, 0u, 0u, 0u}; }
#pragma unroll
        for (int j = 0; j < 4; ++j) *(u32x4*)(dst + (j * 64 + lane) * 16) = (u32x4){0u, 0u, 0u, 0u};
        if (lane == 0) *sa = 1.f;
        return;
    }
    f32x4 v[16]; float s = 0.f;
#pragma unroll
    for (int j = 0; j < 16; ++j) { v[j] = *(const f32x4*)(src + (j * 64 + lane) * 4); s += (v[j].x * v[j].x + v[j].y * v[j].y) + (v[j].z * v[j].z + v[j].w * v[j].w); }
    const float r = rsqrtf(wave_sum(s) * (1.f / D) + eps);
    float mx = 0.f;
#pragma unroll
    for (int j = 0; j < 16; ++j) { const f32x4 g = *(const f32x4*)(w + (j * 64 + lane) * 4); v[j] = v[j] * r * g; mx = fmaxf(mx, fmaxf(fmaxf(fabsf(v[j].x), fabsf(v[j].y)), fmaxf(fabsf(v[j].z), fabsf(v[j].w))));
        if (DUAL) { u32x2 o; o.x = pk2(v[j].x, v[j].y); o.y = pk2(v[j].z, v[j].w); *(u32x2*)(dstb + (j * 64 + lane) * 4) = o; } }
    mx = wave_max(mx);
    const float inv = mx > 0.f ? 127.f / mx : 0.f;
#pragma unroll
    for (int j = 0; j < 16; ++j) { const unsigned q = ((unsigned)(int)rintf(v[j].x * inv) & 0xffu) | (((unsigned)(int)rintf(v[j].y * inv) & 0xffu) << 8) | (((unsigned)(int)rintf(v[j].z * inv) & 0xffu) << 16) | (((unsigned)(int)rintf(v[j].w * inv) & 0xffu) << 24);
        *(unsigned*)(dst + (j * 64 + lane) * 4) = q; }
    if (lane == 0) *sa = mx > 0.f ? mx * (1.f / 127.f) : 1.f;
}
__device__ __forceinline__ void rms_row_bf16(const float* src, const float* w, bf16_t* dst, int lane, float eps) {
    if (src == nullptr) {
#pragma unroll
        for (int j = 0; j < 8; ++j) *(u32x4*)(dst + (j * 64 + lane) * 8) = (u32x4){0u, 0u, 0u, 0u};
        return;
    }
    f32x4 v[16]; float s = 0.f;
#pragma unroll
    for (int j = 0; j < 16; ++j) { v[j] = *(const f32x4*)(src + (j * 64 + lane) * 4); s += (v[j].x * v[j].x + v[j].y * v[j].y) + (v[j].z * v[j].z + v[j].w * v[j].w); }
    const float r = rsqrtf(wave_sum(s) * (1.f / D) + eps);
#pragma unroll
    for (int j = 0; j < 16; ++j) { const f32x4 g = *(const f32x4*)(w + (j * 64 + lane) * 4);
        u32x2 o; o.x = pk2(v[j].x * r * g.x, v[j].y * r * g.y); o.y = pk2(v[j].z * r * g.z, v[j].w * r * g.w);
        *(u32x2*)(dst + (j * 64 + lane) * 4) = o; }
}
__device__ __forceinline__ void p0_prologue_a(const P& p, LAS unsigned char* lds, int G) {
    const int tid = threadIdx.x, lane = tid & 63, wave = tid >> 6;
    LAS float* scr = (LAS float*)(lds + wave * 16384);
    const int gw = blockIdx.x * NWAVES + wave, NGW = G * NWAVES;
    unsigned char* ws = p.ws;
    {
        constexpr int C0 = 128 * ((IN_COLS + 2047) / 2048), C1 = 128 * (8192 / 2048), C2 = 128 * ((NFI + 2047) / 2048);
        for (int it = blockIdx.x; it < C0 + C1 + C2; it += G) {
            if (it < C0) colmax_item(p.in[I_WIN], IN_COLS, (unsigned*)(ws + WS_CTL + CT_CMX_IN), it);
            else if (it < C0 + C1) colmax_item(p.in[I_WGATE], 8192, (unsigned*)(ws + WS_CTL + CT_CMX_G), it - C0);
            else colmax_item(p.in[I_WFI], NFI, (unsigned*)(ws + WS_CTL + CT_CMX_F), it - C0 - C1);
        } }
    for (int it = gw; it < 16 * 32; it += NGW) { const int hh = it >> 5;
        tr_item<0>(p.in[I_WUV] + (size_t)hh * KVR * HD_B, KVR, HD_B, HD_B, (bf16_t*)(ws + WS_WUVT) + (size_t)hh * HD_B * KVR, scr, it & 31, lane); }
    for (size_t i = (size_t)blockIdx.x * NT + threadIdx.x; i < (size_t)16 * 512 * 128 / 4; i += (size_t)G * NT) {
        const f32x4 v = *(const f32x4*)(p.in[I_WUK] + i * 4); u32x2 o; o.x = pk2(v.x, v.y); o.y = pk2(v.z, v.w); *(u32x2*)((bf16_t*)(ws + WS_WUKB) + i * 4) = o; }
    for (int i = blockIdx.x * NT + threadIdx.x; i < 448 * 2048; i += G * NT) { const int j = i >> 11, c = i & 2047;
        const float v = j < 96 ? p.in[I_W2][(size_t)j * 2048 + c] : (j < 192 ? p.in[I_A2][(size_t)(j - 96) * 2048 + c] : p.in[I_G2][(size_t)(j - 192) * 2048 + c]);
        ((bf16_t*)(ws + WS_WLT))[(size_t)c * 448 + j] = f2bf(v); }
    signed char* U8 = (signed char*)(ws + WS_U); float* SA = (float*)(ws + WS_CTL + CT_SA);
    for (int m = gw; m < MP; m += NGW) {
        const float* src = m < NMETA ? p.in[I_META] + (size_t)m * D : (m < L ? p.in[I_X] + (size_t)(m - NMETA) * D : nullptr);
        rms_row_i8<true>(src, p.in[I_NMW], U8 + (size_t)m * D, SA + m, lane, 1e-6f, (bf16_t*)(ws + WS_R1) + (size_t)m * D);
    }
}
__device__ __forceinline__ void p0_prologue_b(const P& p, LAS unsigned char* lds, int G) {
    const int lane = threadIdx.x & 63, wave = threadIdx.x >> 6;
    LAS float* scr = (LAS float*)(lds + wave * 16384);
    const int gw = blockIdx.x * NWAVES + wave, NGW = G * NWAVES;
    constexpr int I0 = (4096 / 64) * (NZ / 32);
    for (int it = gw; it < I0; it += NGW) {
        const int nb = it % (NZ / 32);
        if (nb * 32 < NZ8) tr_item_i8<0>(p.in[I_WIN], 4096, IN_COLS, NZ, (signed char*)(p.ws + WS_WINT), (const unsigned*)(p.ws + WS_CTL + CT_CMX_IN), (float*)(p.ws + WS_CTL + CT_SB_IN), scr, it, lane);
        else tr_item<0>(p.in[I_WIN], 4096, IN_COLS, NZ, (bf16_t*)(p.ws + WS_WINT + WINT_BF_OFF) - (size_t)NZ8 * 4096, scr, it, lane);
    }
}
__device__ __forceinline__ void p0b_weights(const P& p, LAS unsigned char* lds, int vw, int nvw) {
    const int lane = threadIdx.x & 63, wave = threadIdx.x >> 6;
    LAS float* scr = (LAS float*)(lds + wave * 16384);
    unsigned char* ws = p.ws;
    constexpr int I1 = (4096 / 64) * (8192 / 32), I2 = (2048 / 64) * (4096 / 32), I3 = I2, I4 = (4096 / 64) * (4096 / 32), I5 = (4096 / 64) * (NFI / 32), I6 = (DFF / 64) * (4096 / 32);
    constexpr int NITEMS = I1 + I2 + I3 + I4 + I5 + I6;
    for (int it = vw; it < NITEMS; it += nvw) {
        int r = it;
        if (r < I1) { tr_item_i8<0>(p.in[I_WGATE], 4096, 8192, 8192, (signed char*)(ws + WS_WGT), (const unsigned*)(ws + WS_CTL + CT_CMX_G), (float*)(ws + WS_CTL + CT_SB_G), scr, r, lane); continue; } r -= I1;
        if (r < I2) { tr_item<0>(p.in[I_WPA], 2048, 4096, 4096, (bf16_t*)(ws + WS_WPAT), scr, r, lane); continue; } r -= I2;
        if (r < I3) { tr_item<0>(p.in[I_WPB], 2048, 4096, 4096, (bf16_t*)(ws + WS_WPBT), scr, r, lane); continue; } r -= I3;
        if (r < I4) { tr_item<0>(p.in[I_WOUT], 4096, 4096, 4096, (bf16_t*)(ws + WS_WOUTT), scr, r, lane); continue; } r -= I4;
        if (r < I5) { tr_item_i8<1>(p.in[I_WFI], 4096, NFI, NFI, (signed char*)(ws + WS_WFIT), (const unsigned*)(ws + WS_CTL + CT_CMX_F), (float*)(ws + WS_CTL + CT_SB_F), scr, r, lane); continue; } r -= I5;
        tr_item<0>(p.in[I_WFO], DFF, 4096, 4096, (bf16_t*)(ws + WS_WFOT), scr, r, lane);
    }
}

typedef short bf16x8p_t __attribute__((ext_vector_type(8)));
template <int CTRL> __device__ __forceinline__ float dpp_shr0(float v) { return __builtin_bit_cast(float, __builtin_amdgcn_update_dpp(0, __builtin_bit_cast(int, v), CTRL, 0xf, 0xf, true)); }
__device__ __forceinline__ void p2_rwkv_prep(const P& p, LAS unsigned char* lds, int G) {
    const int tid = threadIdx.x, lane = tid & 63, wave = __builtin_amdgcn_readfirstlane(tid >> 6), r16 = lane & 15, q = lane >> 4;
    const bf16_t* Z = (const bf16_t*)(p.ws + WS_Z); const bf16_t* WLT = (const bf16_t*)(p.ws + WS_WLT);
    float* CSo = (float*)(p.ws + WS_LD); bf16_t* AAo = (bf16_t*)(p.ws + WS_AA); bf16_t* GGo = (bf16_t*)(p.ws + WS_GG);
    constexpr int AST = 456;
    LAS bf16_t* act = (LAS bf16_t*)lds;
    const float* mu = p.in[I_MU] + 6144;
    for (int item = blockIdx.x; item < 256; item += G) {
        const int ct = item & 15, tr = item >> 4;
        const int ch = ct * 128 + wave * 16 + r16;
        bf16x8p_t af[14];
#pragma unroll
        for (int ks = 0; ks < 14; ++ks) af[ks] = *(const bf16x8p_t*)(WLT + (size_t)ch * 448 + ks * 32 + q * 8);
        const int c4 = ct * 128 + wave * 16 + q * 4;
        const f32x4 w0v = *(const f32x4*)(p.in[I_W0] + c4), a0v = *(const f32x4*)(p.in[I_A0] + c4);
        const int st0 = tr * 16, st1 = tr == 15 ? 257 : st0 + 16;
        for (int st = st0; st < st1; ++st) {
            const int t0 = st * 64;
            __syncthreads();
            {
                u32x4 za[7], zp[7];
#pragma unroll
                for (int k = 0; k < 7; ++k) { const int cidx = tid + k * NT, t = cidx / 56, j8 = (cidx % 56) * 8; int tg = t0 + t; if (tg > L - 1) tg = L - 1; const int tp = tg > 0 ? tg - 1 : 0;
                    za[k] = *(const u32x4*)(Z + (size_t)tg * NZ + 6144 + j8); zp[k] = *(const u32x4*)(Z + (size_t)tp * NZ + 6144 + j8); }
#pragma unroll
                for (int k = 0; k < 7; ++k) { const int cidx = tid + k * NT, t = cidx / 56, j8 = (cidx % 56) * 8, tg = t0 + t;
                    u32x4 o = (u32x4){0u, 0u, 0u, 0u};
                    if (tg < L) {
                        const f32x4 m0 = *(const f32x4*)(mu + j8), m1 = *(const f32x4*)(mu + j8 + 4);
                        const float a[8] = {blo(za[k].x), bhi(za[k].x), blo(za[k].y), bhi(za[k].y), blo(za[k].z), bhi(za[k].z), blo(za[k].w), bhi(za[k].w)};
                        float b[8] = {blo(zp[k].x), bhi(zp[k].x), blo(zp[k].y), bhi(zp[k].y), blo(zp[k].z), bhi(zp[k].z), blo(zp[k].w), bhi(zp[k].w)};
                        if (tg == 0) {
#pragma unroll
                            for (int e = 0; e < 8; ++e) b[e] = 0.f; }
                        const float m[8] = {m0.x, m0.y, m0.z, m0.w, m1.x, m1.y, m1.z, m1.w};
                        float v[8];
#pragma unroll
                        for (int e = 0; e < 8; ++e) { const float zs = a[e] + (b[e] - a[e]) * m[e]; const bool ist = j8 < 96, isi = j8 < 192;
                            const float r = __builtin_amdgcn_rcpf(1.f + __expf(ist ? 2.f * zs : -zs)); v[e] = ist ? 1.f - 2.f * r : (isi ? zs : r); }
                        o.x = pk2(v[0], v[1]); o.y = pk2(v[2], v[3]); o.z = pk2(v[4], v[5]); o.w = pk2(v[6], v[7]);
                    }
                    *(LAS u32x4*)(act + t * AST + j8) = o; }
            }
            __syncthreads();
#pragma unroll 1
            for (int nt = 0; nt < 4; ++nt) {
                f32x4 cw = {0.f, 0.f, 0.f, 0.f}, ca = cw, cg = cw;
                const LAS bf16_t* ar = act + (nt * 16 + r16) * AST + q * 8;
#pragma unroll
                for (int ks = 0; ks < 3; ++ks) cw = __builtin_amdgcn_mfma_f32_16x16x32_bf16(af[ks], *(const LAS bf16x8p_t*)(ar + ks * 32), cw, 0, 0, 0);
#pragma unroll
                for (int ks = 3; ks < 6; ++ks) ca = __builtin_amdgcn_mfma_f32_16x16x32_bf16(af[ks], *(const LAS bf16x8p_t*)(ar + ks * 32), ca, 0, 0, 0);
#pragma unroll
                for (int ks = 6; ks < 14; ++ks) cg = __builtin_amdgcn_mfma_f32_16x16x32_bf16(af[ks], *(const LAS bf16x8p_t*)(ar + ks * 32), cg, 0, 0, 0);
                f32x4 ld;
#pragma unroll
                for (int e = 0; e < 4; ++e) { const float xx = -(w0v[e] + cw[e]); const float sp = xx > 20.f ? xx : __logf(1.f + __expf(xx)); ld[e] = -__expf(-sp - 0.5f); }
#pragma unroll
                for (int e = 0; e < 4; ++e) { float x = ld[e]; x += dpp_shr0<0x111>(x); x += dpp_shr0<0x112>(x); x += dpp_shr0<0x114>(x); x += dpp_shr0<0x118>(x); ld[e] = x; }
                const int tg = t0 + nt * 16 + r16;
                if (tg < L) {
                    *(f32x4*)(CSo + (size_t)tg * A_W + c4) = ld;
                    u32x2 oa, og; oa.x = pk2(sigm(a0v[0] + ca[0]), sigm(a0v[1] + ca[1])); oa.y = pk2(sigm(a0v[2] + ca[2]), sigm(a0v[3] + ca[3]));
                    og.x = pk2(cg[0], cg[1]); og.y = pk2(cg[2], cg[3]);
                    *(u32x2*)(AAo + (size_t)tg * A_W + c4) = oa; *(u32x2*)(GGo + (size_t)tg * A_W + c4) = og;
                }
            }
        }
    }
}


typedef short bf16x8_t __attribute__((ext_vector_type(8)));
constexpr int NCHUNK = 257, NITEM = NCHUNK * 32, RS = 72, SLOT = 64 * RS * 2;
constexpr int GAM_OFF = 15 * SLOT;
constexpr size_t GTP_OFF = 0, HT_OFF = (size_t)8192 * 8192;
typedef __bf16 bf16x2v_t __attribute__((ext_vector_type(2)));
typedef float f32x2v_t __attribute__((ext_vector_type(2)));
__device__ __forceinline__ unsigned cvtpk(float lo, float hi) { const f32x2v_t v = {lo, hi}; const bf16x2v_t b = __builtin_convertvector(v, bf16x2v_t); return __builtin_bit_cast(unsigned, b); }
__device__ __forceinline__ void mm2(const LAS bf16_t* X, const LAS bf16_t* Y, int tm, int tn0, int r, int q, f32x4& c0, f32x4& c1) {
#pragma unroll
    for (int s = 0; s < 2; ++s) {
        const bf16x8_t a = *(const LAS bf16x8_t*)(X + (tm * 16 + r) * RS + s * 32 + q * 8);
        const bf16x8_t b0 = *(const LAS bf16x8_t*)(Y + (tn0 * 16 + r) * RS + s * 32 + q * 8);
        const bf16x8_t b1 = *(const LAS bf16x8_t*)(Y + ((tn0 + 1) * 16 + r) * RS + s * 32 + q * 8);
        c0 = __builtin_amdgcn_mfma_f32_16x16x32_bf16(a, b0, c0, 0, 0, 0);
        c1 = __builtin_amdgcn_mfma_f32_16x16x32_bf16(a, b1, c1, 0, 0, 0);
    }
}
__device__ __forceinline__ void st_cheap(LAS bf16_t* B, int m0, int n, const f32x4& c) {
    u32x2 w; w.x = cvtpk(c[0], c[1]); w.y = cvtpk(c[2], c[3]); *(LAS u32x2*)(B + n * RS + m0) = w;
}
__device__ __forceinline__ void st_scat(LAS bf16_t* B, int m0, int n, const f32x4& c) {
#pragma unroll
    for (int e = 0; e < 4; ++e) B[(m0 + e) * RS + n] = f2bf(c[e]);
}
template <int CTRL> __device__ __forceinline__ float dpp_add(float v) { return v + dpp_f<CTRL>(v); }
__device__ __forceinline__ float sum8(float v) { v = dpp_add<0xB1>(v); v = dpp_add<0x4E>(v); v = dpp_add<0x141>(v); return v; }

struct RaIn { u32x4 r0, k0, v0, r1, k1, v1, a0; f32x4 c0v, c1v, p0, p1, ba[3], bb[3]; };
__device__ __forceinline__ void ra_load(RaIn& I, const bf16_t* Z, const float* CS, const bf16_t* AAi, int ch, int h, int tid) {
    const int t = tid >> 3, k8 = (tid & 7) * 8, c0 = h * 64 + k8; int tg = ch * 64 + t; if (tg > L - 1) tg = L - 1; const int tp = tg > 0 ? tg - 1 : 0;
    const bf16_t* zr = Z + (size_t)tg * NZ + c0; const bf16_t* zp = Z + (size_t)tp * NZ + c0;
    I.r0 = *(const u32x4*)zr; I.k0 = *(const u32x4*)(zr + 2048); I.v0 = *(const u32x4*)(zr + 4096);
    I.r1 = *(const u32x4*)zp; I.k1 = *(const u32x4*)(zp + 2048); I.v1 = *(const u32x4*)(zp + 4096);
    I.a0 = *(const u32x4*)(AAi + (size_t)tg * A_W + c0);
    const float* cs = CS + (size_t)tg * A_W + c0; const float* cp = CS + (size_t)tp * A_W + c0;
    I.c0v = *(const f32x4*)cs; I.c1v = *(const f32x4*)(cs + 4); I.p0 = *(const f32x4*)cp; I.p1 = *(const f32x4*)(cp + 4);
#pragma unroll
    for (int b = 0; b < 3; ++b) { int rb = ch * 64 + b * 16 + 15; if (rb > L - 1) rb = L - 1; const float* ce = CS + (size_t)rb * A_W + c0; I.ba[b] = *(const f32x4*)ce; I.bb[b] = *(const f32x4*)(ce + 4); }
}
#define LDS_BARRIER() do { asm volatile("s_waitcnt lgkmcnt(0)" ::: "memory"); __builtin_amdgcn_s_barrier(); asm volatile("" ::: "memory"); } while (0)
__device__ __forceinline__ void ra_items(const P& p, LAS unsigned char* lds, int G) {
    const int tid = threadIdx.x, lane = tid & 63, wave = __builtin_amdgcn_readfirstlane(tid >> 6), r16 = lane & 15, q = lane >> 4;
    const int tm = wave >> 1, tn0 = (wave & 1) * 2;
    const bf16_t* Z = (const bf16_t*)(p.ws + WS_Z); const float* CS = (const float*)(p.ws + WS_LD); const bf16_t* AAi = (const bf16_t*)(p.ws + WS_AA);
    bf16_t* GTP = (bf16_t*)((unsigned char*)p.out + GTP_OFF); float* HT = (float*)((unsigned char*)p.out + HT_OFF);
    bf16_t* PPo = (bf16_t*)(p.ws + WS_YB); bf16_t* Y0o = (bf16_t*)(p.ws + WS_YA); float* BS = (float*)(p.ws + WS_BS);
    LAS bf16_t* sl[15];
#pragma unroll
    for (int i = 0; i < 15; ++i) sl[i] = (LAS bf16_t*)(lds + i * SLOT);
    LAS float* gam = (LAS float*)(lds + GAM_OFF);
    LAS bf16_t *Al_r = sl[0], *Be_r = sl[1], *Ka_r = sl[2], *Al_t = sl[3], *Be_t = sl[4], *Ka_t = sl[5], *Rh_r = sl[6], *V_t = sl[7];
    LAS bf16_t *N_r = sl[8], *N_t = sl[9], *LAK = sl[10], *MRK = sl[11], *MRB = sl[12], *Q_t = sl[13], *T_a = sl[14], *T_b = sl[0], *Q_r = sl[1];
    LAS bf16_t *W_t = sl[8], *X1_t = sl[9], *U0_t = sl[1];
    const bool fixed_h = (G & 31) == 0;
    const int nit = fixed_h ? (NCHUNK - (int)(blockIdx.x >> 5) + (G >> 5) - 1) / (G >> 5) : (NITEM - (int)blockIdx.x + G - 1) / G;
    auto item_of = [&](int i, int& ch, int& h) { if (fixed_h) { h = blockIdx.x & 31; ch = (int)(blockIdx.x >> 5) + i * (G >> 5); } else { const int it = (int)blockIdx.x + i * G; ch = it >> 5; h = it & 31; } };
    float pmr[8], pmk[8], pmv[8], pkk[8], pka[8], prk[8]; int h_par = -1;
    RaIn I; { int ch0, h0; item_of(0, ch0, h0); if (nit > 0) ra_load(I, Z, CS, AAi, ch0, h0, tid); }
    for (int ii = 0; ii < nit; ++ii) {
        int ch, h; item_of(ii, ch, h); const int item = ch * 32 + h;
        if (h != h_par) { const int c0 = h * 64 + (tid & 7) * 8;
#pragma unroll
            for (int e = 0; e < 8; ++e) { pmr[e] = p.in[I_MU][c0 + e]; pmk[e] = p.in[I_MU][2048 + c0 + e]; pmv[e] = p.in[I_MU][4096 + c0 + e]; pkk[e] = p.in[I_KK][c0 + e]; pka[e] = p.in[I_KA][c0 + e]; prk[e] = p.in[I_RK][c0 + e]; }
            h_par = h; }
        LDS_BARRIER();
        {
            const int t = tid >> 3, k8 = (tid & 7) * 8, tg = ch * 64 + t;
            float Av[8], Bv[8], Kv[8], Rv[8], Vv[8];
            const bool valid = tg < L, hasp = tg > 0;
            {
                float lc[8], lx[8];
                {   float base[8];
#pragma unroll
                    for (int e = 0; e < 8; ++e) base[e] = 0.f;
#pragma unroll
                    for (int b = 0; b < 3; ++b) if (b < (t >> 4)) {
#pragma unroll
                        for (int e = 0; e < 4; ++e) { base[e] += I.ba[b][e]; base[4 + e] += I.bb[b][e]; } }
                    const bool pin = (t & 15) != 0;
#pragma unroll
                    for (int e = 0; e < 4; ++e) { lc[e] = base[e] + I.c0v[e]; lc[4 + e] = base[4 + e] + I.c1v[e]; lx[e] = base[e] + (pin ? I.p0[e] : 0.f); lx[4 + e] = base[4 + e] + (pin ? I.p1[e] : 0.f); }
                }
                const unsigned rw[4] = {I.r0.x, I.r0.y, I.r0.z, I.r0.w}, kw[4] = {I.k0.x, I.k0.y, I.k0.z, I.k0.w}, vw[4] = {I.v0.x, I.v0.y, I.v0.z, I.v0.w};
                const unsigned rp[4] = {I.r1.x, I.r1.y, I.r1.z, I.r1.w}, kq[4] = {I.k1.x, I.k1.y, I.k1.z, I.k1.w}, vq[4] = {I.v1.x, I.v1.y, I.v1.z, I.v1.w}, aw[4] = {I.a0.x, I.a0.y, I.a0.z, I.a0.w};
                float rr[8], kk[8], kp[8], aa[8]; float ss = 0.f, bs = 0.f;
#pragma unroll
                for (int e = 0; e < 8; ++e) {
                    const int wi = e >> 1; const bool hi = e & 1;
                    const float zr_ = hi ? bhi(rw[wi]) : blo(rw[wi]), zk_ = hi ? bhi(kw[wi]) : blo(kw[wi]), zv_ = hi ? bhi(vw[wi]) : blo(vw[wi]);
                    float pr_ = hi ? bhi(rp[wi]) : blo(rp[wi]), pk_ = hi ? bhi(kq[wi]) : blo(kq[wi]), pv_ = hi ? bhi(vq[wi]) : blo(vq[wi]);
                    if (!hasp) { pr_ = 0.f; pk_ = 0.f; pv_ = 0.f; }
                    aa[e] = hi ? bhi(aw[wi]) : blo(aw[wi]);
                    rr[e] = zr_ + (pr_ - zr_) * pmr[e]; const float k_ = zk_ + (pk_ - zk_) * pmk[e]; Vv[e] = zv_ + (pv_ - zv_) * pmv[e];
                    kk[e] = k_ * pkk[e]; ss += kk[e] * kk[e];
                    kp[e] = k_ * (1.f + (aa[e] - 1.f) * pka[e]);
                    bs += rr[e] * kp[e] * prk[e];
                }
                ss = sum8(ss); bs = sum8(bs);
                const float rn = rsqrtf(ss + 1e-12f);
                if (valid && (tid & 7) == 0) BS[(size_t)tg * 32 + h] = bs;
#pragma unroll
                for (int e = 0; e < 8; ++e) {
                    const float kn = kk[e] * rn; const float ex = __expf(lx[e]), em = __expf(-lc[e]), ep = __expf(lc[e]);
                    Av[e] = kn * ex; Bv[e] = kn * aa[e] * em; Kv[e] = kp[e] * em; Rv[e] = rr[e] * ep;
                }
                if (t == 63) {
#pragma unroll
                    for (int e = 0; e < 8; ++e) gam[k8 + e] = __expf(valid ? lc[e] : (e < 4 ? I.c0v[e] : I.c1v[e - 4]));
                }
                if (!valid) {
#pragma unroll
                    for (int e = 0; e < 8; ++e) { Av[e] = 0.f; Bv[e] = 0.f; Kv[e] = 0.f; Rv[e] = 0.f; Vv[e] = 0.f; }
                }
            }
            u32x4 w;
            w.x = cvtpk(Av[0], Av[1]); w.y = cvtpk(Av[2], Av[3]); w.z = cvtpk(Av[4], Av[5]); w.w = cvtpk(Av[6], Av[7]); *(LAS u32x4*)(Al_r + t * RS + k8) = w;
            w.x = cvtpk(Bv[0], Bv[1]); w.y = cvtpk(Bv[2], Bv[3]); w.z = cvtpk(Bv[4], Bv[5]); w.w = cvtpk(Bv[6], Bv[7]); *(LAS u32x4*)(Be_r + t * RS + k8) = w;
            w.x = cvtpk(Kv[0], Kv[1]); w.y = cvtpk(Kv[2], Kv[3]); w.z = cvtpk(Kv[4], Kv[5]); w.w = cvtpk(Kv[6], Kv[7]); *(LAS u32x4*)(Ka_r + t * RS + k8) = w;
            w.x = cvtpk(Rv[0], Rv[1]); w.y = cvtpk(Rv[2], Rv[3]); w.z = cvtpk(Rv[4], Rv[5]); w.w = cvtpk(Rv[6], Rv[7]); *(LAS u32x4*)(Rh_r + t * RS + k8) = w;
#pragma unroll
            for (int e = 0; e < 8; ++e) { Al_t[(k8 + e) * RS + t] = f2bf(Av[e]); Be_t[(k8 + e) * RS + t] = f2bf(Bv[e]); Ka_t[(k8 + e) * RS + t] = f2bf(Kv[e]); V_t[(k8 + e) * RS + t] = f2bf(Vv[e]); }
        }
        if (ii + 1 < nit) { int ch1, h1; item_of(ii + 1, ch1, h1); ra_load(I, Z, CS, AAi, ch1, h1, tid); }
        LDS_BARRIER();
        {
            f32x4 cab0 = {0.f, 0.f, 0.f, 0.f}, cab1 = cab0, cak0 = cab0, cak1 = cab0, crk0 = cab0, crk1 = cab0, crb0 = cab0, crb1 = cab0;
            mm2(Be_r, Al_r, tm, tn0, r16, q, cab0, cab1); mm2(Ka_r, Al_r, tm, tn0, r16, q, cak0, cak1);
            mm2(Ka_r, Rh_r, tm, tn0, r16, q, crk0, crk1); mm2(Be_r, Rh_r, tm, tn0, r16, q, crb0, crb1);
            const int s0 = tm * 16 + q * 4;
#pragma unroll
            for (int j = 0; j < 2; ++j) {
                const int t = (tn0 + j) * 16 + r16;
                f32x4 ab = j ? cab1 : cab0, ak = j ? cak1 : cak0, rk = j ? crk1 : crk0, rb = j ? crb1 : crb0, nn, t0;
#pragma unroll
                for (int e = 0; e < 4; ++e) { const int s = s0 + e; nn[e] = s < t ? -ab[e] : 0.f; t0[e] = nn[e] + (s == t ? 1.f : 0.f); ak[e] = s < t ? ak[e] : 0.f; rk[e] = s <= t ? rk[e] : 0.f; rb[e] = s <= t ? rb[e] : 0.f; }
                st_cheap(N_r, s0, t, nn); st_scat(N_t, s0, t, nn); st_cheap(T_a, s0, t, t0); st_cheap(LAK, s0, t, ak); st_cheap(MRK, s0, t, rk); st_cheap(MRB, s0, t, rb);
            }
        }
        LDS_BARRIER();
        {
            LAS bf16_t* Pr = N_r; LAS bf16_t* Pt = N_t; LAS bf16_t* Qr = Q_r; LAS bf16_t* Qt = Q_t; LAS bf16_t* Tc = T_a; LAS bf16_t* Tn = T_b;
#pragma unroll 1
            for (int it = 0; it < 5; ++it) {
                {   f32x4 c0 = {0.f, 0.f, 0.f, 0.f}, c1 = c0;
                    mm2(Pr, Pt, tm, tn0, r16, q, c0, c1);
                    const int m0 = tm * 16 + q * 4;
                    st_cheap(Qt, m0, tn0 * 16 + r16, c0); st_cheap(Qt, m0, (tn0 + 1) * 16 + r16, c1);
                    st_scat(Qr, m0, tn0 * 16 + r16, c0); st_scat(Qr, m0, (tn0 + 1) * 16 + r16, c1); }
                LDS_BARRIER();
                {   f32x4 c0 = {0.f, 0.f, 0.f, 0.f}, c1 = c0;
                    mm2(Qt, Tc, tm, tn0, r16, q, c0, c1);
                    const int b0 = tm * 16 + q * 4;
#pragma unroll
                    for (int j = 0; j < 2; ++j) { const int a = (tn0 + j) * 16 + r16; const u32x2 o = *(const LAS u32x2*)(Tc + a * RS + b0); f32x4 c = j ? c1 : c0;
                        c[0] += blo(o.x); c[1] += bhi(o.x); c[2] += blo(o.y); c[3] += bhi(o.y); st_cheap(Tn, b0, a, c); } }
                LDS_BARRIER();
                LAS bf16_t* x = Pr; Pr = Qr; Qr = x; x = Pt; Pt = Qt; Qt = x; x = Tc; Tc = Tn; Tn = x;
            }
        }
        {
            f32x4 c0 = {0.f, 0.f, 0.f, 0.f}, c1 = c0, d0 = c0, d1 = c0;
            mm2(T_b, Al_t, tm, tn0, r16, q, c0, c1);
            mm2(LAK, V_t, tm, tn0, r16, q, d0, d1);
            const int t0 = tm * 16 + q * 4;
            st_cheap(W_t, t0, tn0 * 16 + r16, c0); st_cheap(W_t, t0, (tn0 + 1) * 16 + r16, c1);
            st_cheap(X1_t, t0, tn0 * 16 + r16, d0); st_cheap(X1_t, t0, (tn0 + 1) * 16 + r16, d1);
        }
        LDS_BARRIER();
        {
            f32x4 c0 = {0.f, 0.f, 0.f, 0.f}, c1 = c0;
            mm2(T_b, X1_t, tm, tn0, r16, q, c0, c1);
            const int t0 = tm * 16 + q * 4;
            st_cheap(U0_t, t0, tn0 * 16 + r16, c0); st_cheap(U0_t, t0, (tn0 + 1) * 16 + r16, c1);
        }
        LDS_BARRIER();
        {
            const int m0 = tm * 16 + q * 4;
            if (ch < 256) {
                f32x4 g0 = {0.f, 0.f, 0.f, 0.f}, g1 = g0, h0 = g0, h1 = g0, u0 = g0, u1 = g0;
                mm2(W_t, Be_t, tm, tn0, r16, q, g0, g1);
                mm2(Ka_t, V_t, tm, tn0, r16, q, h0, h1);
                mm2(Be_t, U0_t, tm, tn0, r16, q, u0, u1);
                const size_t it8 = (size_t)item;
#pragma unroll
                for (int j = 0; j < 2; ++j) {
                    const int n = (tn0 + j) * 16 + r16; const f32x4 g = j ? g1 : g0; const float gc = gam[n];
                    f32x4 o;
#pragma unroll
                    for (int e = 0; e < 4; ++e) o[e] = ((m0 + e == n ? 1.f : 0.f) - g[e]) * gc;
                    u32x2 w; w.x = cvtpk(o[0], o[1]); w.y = cvtpk(o[2], o[3]);
                    *(u32x2*)(GTP + it8 * 4096 + (size_t)n * 64 + 32 * (tm >> 1) + 8 * q + 4 * (tm & 1)) = w;
                    const f32x4 hh = (j ? h1 : h0) - (j ? u1 : u0);
                    const f32x4 gk = *(const LAS f32x4*)(gam + m0);
                    *(f32x4*)(HT + (it8 * 16 + tm * 4 + (tn0 + j)) * 256 + lane * 4) = hh * gk;
                }
            }
            f32x4 p0 = {0.f, 0.f, 0.f, 0.f}, p1 = p0, y0 = p0, y1 = p0, z0 = p0, z1 = p0;
            mm2(W_t, MRB, tm, tn0, r16, q, p0, p1);
            mm2(V_t, MRK, tm, tn0, r16, q, y0, y1);
            mm2(U0_t, MRB, tm, tn0, r16, q, z0, z1);
#pragma unroll
            for (int j = 0; j < 2; ++j) {
                const int t = (tn0 + j) * 16 + r16, tg = ch * 64 + t;
                const u32x2 o = *(const LAS u32x2*)(Rh_r + t * RS + m0); const f32x4 pm = j ? p1 : p0;
                u32x2 w; w.x = cvtpk(blo(o.x) - pm[0], bhi(o.x) - pm[1]); w.y = cvtpk(blo(o.y) - pm[2], bhi(o.y) - pm[3]);
                *(u32x2*)(PPo + (size_t)item * 4096 + t * 64 + m0) = w;
                if (tg < L) { const f32x4 yy = (j ? y1 : y0) - (j ? z1 : z0); u32x2 wy; wy.x = cvtpk(yy[0], yy[1]); wy.y = cvtpk(yy[2], yy[3]);
                    *(u32x2*)(Y0o + (size_t)tg * A_W + h * 64 + m0) = wy; }
            }
        }
    }
}

struct RbSet { bf16x8_t ga[4][2]; f32x4 hv[4]; };
__device__ __forceinline__ void rb_load(RbSet& S, const bf16_t* GTP, const float* HT, int c, int h, int vg, int lane, int r16, int q) {
    const size_t it8 = (size_t)(c < 256 ? c : 255) * 32 + h;
#pragma unroll
    for (int i = 0; i < 4; ++i) { S.hv[i] = *(const f32x4*)(HT + (it8 * 16 + i * 4 + vg) * 256 + lane * 4);
#pragma unroll
        for (int s = 0; s < 2; ++s) S.ga[i][s] = *(const bf16x8_t*)(GTP + it8 * 4096 + (size_t)(i * 16 + r16) * 64 + s * 32 + q * 8); }
}
__device__ __forceinline__ void rb_step(f32x4 (&acc)[4], const RbSet& S, bf16_t* ST, int c, int h, int vg, int r16, int q) {
    const size_t item = (size_t)c * 32 + h;
    unsigned w[8];
#pragma unroll
    for (int i = 0; i < 4; ++i) { w[2 * i] = cvtpk(acc[i][0], acc[i][1]); w[2 * i + 1] = cvtpk(acc[i][2], acc[i][3]);
        u32x2 o; o.x = w[2 * i]; o.y = w[2 * i + 1]; *(u32x2*)(ST + item * 4096 + (size_t)(vg * 16 + r16) * 64 + i * 16 + q * 4) = o; }
    const u32x4 b0 = (u32x4){w[0], w[1], w[2], w[3]}, b1 = (u32x4){w[4], w[5], w[6], w[7]};
    const bf16x8_t f0 = __builtin_bit_cast(bf16x8_t, b0), f1 = __builtin_bit_cast(bf16x8_t, b1);
#pragma unroll
    for (int i = 0; i < 4; ++i) { f32x4 a = S.hv[i];
        a = __builtin_amdgcn_mfma_f32_16x16x32_bf16(S.ga[i][0], f0, a, 0, 0, 0);
        a = __builtin_amdgcn_mfma_f32_16x16x32_bf16(S.ga[i][1], f1, a, 0, 0, 0);
        acc[i] = a; }
}
__device__ __forceinline__ void rb_chain(const P& p, int G) {
    const int tid = threadIdx.x, lane = tid & 63, wave = __builtin_amdgcn_readfirstlane(tid >> 6), r16 = lane & 15, q = lane >> 4;
    if (wave == 0) for (int cw = blockIdx.x; cw < 128; cw += G) {
        const int h = cw >> 2, vg = cw & 3;
        const bf16_t* GTP = (const bf16_t*)((const unsigned char*)p.out + GTP_OFF); const float* HT = (const float*)((const unsigned char*)p.out + HT_OFF);
        bf16_t* ST = (bf16_t*)(p.ws + WS_ST);
        f32x4 acc[4];
#pragma unroll
        for (int i = 0; i < 4; ++i) acc[i] = (f32x4){0.f, 0.f, 0.f, 0.f};
        RbSet S0, S1, S2, S3;
        rb_load(S0, GTP, HT, 0, h, vg, lane, r16, q); rb_load(S1, GTP, HT, 1, h, vg, lane, r16, q); rb_load(S2, GTP, HT, 2, h, vg, lane, r16, q); rb_load(S3, GTP, HT, 3, h, vg, lane, r16, q);
#pragma unroll 1
        for (int c = 0; c < 256; c += 4) {
            rb_step(acc, S0, ST, c, h, vg, r16, q);     rb_load(S0, GTP, HT, c + 4, h, vg, lane, r16, q);
            rb_step(acc, S1, ST, c + 1, h, vg, r16, q); rb_load(S1, GTP, HT, c + 5, h, vg, lane, r16, q);
            rb_step(acc, S2, ST, c + 2, h, vg, r16, q); rb_load(S2, GTP, HT, c + 6, h, vg, lane, r16, q);
            rb_step(acc, S3, ST, c + 3, h, vg, r16, q); rb_load(S3, GTP, HT, c + 7, h, vg, lane, r16, q);
        }
        {
            const size_t item = (size_t)256 * 32 + h;
#pragma unroll
            for (int i = 0; i < 4; ++i) { u32x2 o; o.x = cvtpk(acc[i][0], acc[i][1]); o.y = cvtpk(acc[i][2], acc[i][3]); *(u32x2*)(ST + item * 4096 + (size_t)(vg * 16 + r16) * 64 + i * 16 + q * 4) = o; }
        }
    }
}

__device__ __forceinline__ void rc_out(const P& p, int G) {
    const int tid = threadIdx.x, lane = tid & 63, wave = __builtin_amdgcn_readfirstlane(tid >> 6), r16 = lane & 15, q = lane >> 4;
    const bf16_t* Z = (const bf16_t*)(p.ws + WS_Z); const bf16_t* GGi = (const bf16_t*)(p.ws + WS_GG); const float* BS = (const float*)(p.ws + WS_BS);
    const bf16_t* ST = (const bf16_t*)(p.ws + WS_ST); const bf16_t* PPi = (const bf16_t*)(p.ws + WS_YB); bf16_t* YA = (bf16_t*)(p.ws + WS_YA);
    for (size_t i = (size_t)blockIdx.x * NT + tid; i < (size_t)(MP - L) * A_W / 8; i += (size_t)G * NT) *(u32x4*)(YA + (size_t)L * A_W + i * 8) = (u32x4){0u, 0u, 0u, 0u};
    const int tt = wave & 3;
    for (int item = blockIdx.x * 2 + (wave >> 2); item < NITEM; item += 2 * G) {
        const int ch = item >> 5, h = item & 31;
        const int t = tt * 16 + r16, tg = ch * 64 + t;
        f32x4 acc[4];
#pragma unroll
        for (int i = 0; i < 4; ++i) acc[i] = (f32x4){0.f, 0.f, 0.f, 0.f};
        const bf16_t* sp = ST + (size_t)item * 4096; const bf16_t* pp = PPi + (size_t)item * 4096 + (size_t)t * 64;
#pragma unroll
        for (int s = 0; s < 2; ++s) {
            const bf16x8_t b = *(const bf16x8_t*)(pp + s * 32 + q * 8);
#pragma unroll
            for (int i = 0; i < 4; ++i) { const bf16x8_t a = *(const bf16x8_t*)(sp + (size_t)(i * 16 + r16) * 64 + s * 32 + q * 8);
                acc[i] = __builtin_amdgcn_mfma_f32_16x16x32_bf16(a, b, acc[i], 0, 0, 0); }
        }
        if (tg < L) {
            float s1 = 0.f;
#pragma unroll
            for (int i = 0; i < 4; ++i) { const u32x2 y0 = *(const u32x2*)(YA + (size_t)tg * A_W + h * 64 + i * 16 + q * 4);
                acc[i][0] += blo(y0.x); acc[i][1] += bhi(y0.x); acc[i][2] += blo(y0.y); acc[i][3] += bhi(y0.y);
                s1 += (acc[i][0] + acc[i][1]) + (acc[i][2] + acc[i][3]); }
            s1 += __shfl_xor(s1, 16); s1 += __shfl_xor(s1, 32);
            const float mean = s1 * (1.f / 64.f);
            float s2 = 0.f;
#pragma unroll
            for (int i = 0; i < 4; ++i)
#pragma unroll
                for (int e = 0; e < 4; ++e) { const float d = acc[i][e] - mean; s2 += d * d; }
            s2 += __shfl_xor(s2, 16); s2 += __shfl_xor(s2, 32);
            const float rstd = rsqrtf(s2 * (1.f / 64.f) + 64e-5f);
            const float bs = BS[(size_t)tg * 32 + h];
#pragma unroll
            for (int i = 0; i < 4; ++i) {
                const int c = h * 64 + i * 16 + q * 4;
                const u32x2 zv = *(const u32x2*)(Z + (size_t)tg * NZ + 4096 + c);
                u32x2 pv = (u32x2){0u, 0u}; if (tg > 0) pv = *(const u32x2*)(Z + (size_t)(tg - 1) * NZ + 4096 + c);
                const u32x2 gg = *(const u32x2*)(GGi + (size_t)tg * A_W + c);
                const f32x4 lw = *(const f32x4*)(p.in[I_LNW] + c), lb = *(const f32x4*)(p.in[I_LNB] + c), mv = *(const f32x4*)(p.in[I_MU] + 4096 + c);
                const float zz[4] = {blo(zv.x), bhi(zv.x), blo(zv.y), bhi(zv.y)}, pz[4] = {blo(pv.x), bhi(pv.x), blo(pv.y), bhi(pv.y)}, gv[4] = {blo(gg.x), bhi(gg.x), blo(gg.y), bhi(gg.y)};
                float o[4];
#pragma unroll
                for (int e = 0; e < 4; ++e) { const float vv = zz[e] + (pz[e] - zz[e]) * mv[e]; const float yn = (acc[i][e] - mean) * rstd * lw[e] + lb[e]; o[e] = (yn + bs * vv) * gv[e]; }
                u32x2 w; w.x = cvtpk(o[0], o[1]); w.y = cvtpk(o[2], o[3]);
                *(u32x2*)(YA + (size_t)tg * A_W + c) = w;
            }
        }
    }
}


__device__ __forceinline__ void p4_dsa_prep(const P& p, int G) {
    const int tid = threadIdx.x, lane = tid & 63, wave = tid >> 6;
    const bf16_t* Z = (const bf16_t*)(p.ws + WS_Z);
    bf16_t* CKV = (bf16_t*)(p.ws + WS_CKV); float* KIDX = (float*)(p.ws + WS_KIDX);
    for (int t = blockIdx.x * NWAVES + wave; t < L; t += G * NWAVES) {
        const u32x4 raw = *(const u32x4*)(Z + (size_t)t * NZ + ZCKV + lane * 8);
        float x[8] = {blo(raw.x), bhi(raw.x), blo(raw.y), bhi(raw.y), blo(raw.z), bhi(raw.z), blo(raw.w), bhi(raw.w)};
        float s = 0.f;
#pragma unroll
        for (int e = 0; e < 8; ++e) s += x[e] * x[e];
        const float r = rsqrtf(wave_sum(s) * (1.f / KVR) + 1e-6f);
        const f32x4 w0 = *(const f32x4*)(p.in[I_KVNW] + lane * 8), w1 = *(const f32x4*)(p.in[I_KVNW] + lane * 8 + 4);
        u32x4 o; o.x = pk2(x[0] * r * w0.x, x[1] * r * w0.y); o.y = pk2(x[2] * r * w0.z, x[3] * r * w0.w); o.z = pk2(x[4] * r * w1.x, x[5] * r * w1.y); o.w = pk2(x[6] * r * w1.z, x[7] * r * w1.w);
        *(u32x4*)(CKV + (size_t)t * KVR + lane * 8) = o;
        const float ki = bf2f(Z[(size_t)t * NZ + ZKI + lane]);
        const float mean = wave_sum(ki) * (1.f / 64.f), dk = ki - mean, var = wave_sum(dk * dk) * (1.f / 64.f);
        const float kn_ = dk * rsqrtf(var + 1e-6f) * p.in[I_ILNW][lane] + p.in[I_ILNB][lane];
        KIDX[(size_t)t * IDXD + lane] = kn_;
        ((bf16_t*)(p.ws + WS_KIDXB))[(size_t)t * IDXD + lane] = f2bf(kn_);
    }
}

__device__ __forceinline__ unsigned fkey(float f) { const unsigned u = __float_as_uint(f); return (u & 0x80000000u) ? ~u : (u | 0x80000000u); }


typedef float f32x16 __attribute__((ext_vector_type(16)));
constexpr int SCR_N = 16416;
__device__ __forceinline__ unsigned lds_add(LAS unsigned* p, unsigned v) { return __hip_atomic_fetch_add(p, v, __ATOMIC_RELAXED, __HIP_MEMORY_SCOPE_WORKGROUP); }
constexpr int KST = 72, SELB = 8;
template <int NBL> __device__ __forceinline__ void wfind(const LAS unsigned* hist, unsigned target, int lane, unsigned& b, unsigned& ab) {
    unsigned loc[NBL]; unsigned s = 0;
#pragma unroll
    for (int j = 0; j < NBL; j += 4) { const u32x4 v4 = *(const LAS u32x4*)(hist + lane * NBL + j); loc[j] = v4.x; loc[j + 1] = v4.y; loc[j + 2] = v4.z; loc[j + 3] = v4.w; s += (v4.x + v4.y) + (v4.z + v4.w); }
    unsigned v = s;
#pragma unroll
    for (int d = 1; d < 64; d <<= 1) { const unsigned o = (unsigned)__shfl_down((int)v, d); if (lane + d < 64) v += o; }
    const unsigned above = v - s;
    const bool found = above < target && above + s >= target;
    unsigned bb = 0u, aa = 0u;
    if (found) { unsigned a = above;
#pragma unroll
        for (int j = NBL - 1; j >= 0; --j) { if (a < target && a + loc[j] >= target) { bb = (unsigned)(lane * NBL + j); aa = a; } a += loc[j]; } }
    const unsigned long long m = __ballot(found);
    const int src = m ? (int)__builtin_ctzll(m) : 0;
    b = (unsigned)__shfl((int)bb, src); ab = (unsigned)__shfl((int)aa, src);
}
__device__ __forceinline__ void d2_topk(const P& p, LAS unsigned char* lds, int G) {
    const int tid = threadIdx.x, lane = tid & 63, wave = __builtin_amdgcn_readfirstlane(tid >> 6);
    const bf16_t* Z = (const bf16_t*)(p.ws + WS_Z); const bf16_t* KB = (const bf16_t*)(p.ws + WS_KIDXB); int* SEL = (int*)(p.ws + WS_SEL);
    float* scr = (float*)(p.ws + WS_R1) + ((size_t)blockIdx.x * NWAVES + wave) * 2 * SCR_N;
    LAS bf16_t* ksb = (LAS bf16_t*)lds;
    LAS unsigned* hw = (LAS unsigned*)(lds + 73728) + wave * 2048;
    const int key_l = lane & 31, hh = lane >> 5;
    for (int t = blockIdx.x; t < NMETA + 192; t += G) { const int n = t < NMETA ? NMETA : NMETA + 64 * (1 + (t - NMETA) / 64);
        if (tid < TOPK) SEL[(size_t)t * TOPK + tid] = tid < n ? tid : -1; }
    const int nui = (G == 256) ? 4 : (1012 + G - 1) / G;
    for (int ui = 0; ui < nui; ++ui) {
        int i = (int)blockIdx.x + ui * G;
        if (G == 256) i = ui == 0 ? (int)blockIdx.x : (ui == 1 ? 511 - (int)blockIdx.x : (ui == 2 ? 512 + (int)blockIdx.x : 1023 - (int)blockIdx.x));
        if (i >= 1012) continue;
        const int c = 256 - (i >> 2), r = i & 3, n = NMETA + 64 * c;
        const int tA = NMETA + 64 * (c - 1) + 16 * r + 2 * wave;
        bf16x8_t af[2][4]; float wv[2][16];
#pragma unroll
        for (int qq = 0; qq < 2; ++qq) {
            const bf16_t* zr = Z + (size_t)(tA + qq) * NZ;
#pragma unroll
            for (int ks = 0; ks < 4; ++ks) af[qq][ks] = *(const bf16x8_t*)(zr + ZQI + key_l * 64 + ks * 16 + hh * 8);
#pragma unroll
            for (int g = 0; g < 4; ++g) { const u32x2 w2 = *(const u32x2*)(zr + ZWI + 8 * g + 4 * hh);
                wv[qq][g * 4 + 0] = blo(w2.x) * 0.02209708691207961f; wv[qq][g * 4 + 1] = bhi(w2.x) * 0.02209708691207961f;
                wv[qq][g * 4 + 2] = blo(w2.y) * 0.02209708691207961f; wv[qq][g * 4 + 3] = bhi(w2.y) * 0.02209708691207961f; }
        }
#pragma unroll
        for (int j = 0; j < 8; ++j) *(LAS u32x4*)(hw + (j * 64 + lane) * 4) = (u32x4){0u, 0u, 0u, 0u};
        const int nblk = (n + 255) >> 8;
        __syncthreads();
        {
            const int kk = tid >> 1, hf = tid & 1; const int src = kk < n ? kk : n - 1;
            const u32x4* gp = (const u32x4*)(KB + (size_t)src * IDXD + hf * 32);
#pragma unroll
            for (int j = 0; j < 4; ++j) *(LAS u32x4*)(ksb + kk * KST + hf * 32 + j * 8) = gp[j];
        }
        __syncthreads();
        for (int b = 0; b < nblk; ++b) {
            u32x4 pre[4];
            const bool more = b + 1 < nblk;
            if (more) { const int kk = (b + 1) * 256 + (tid >> 1); const int src = kk < n ? kk : n - 1; const u32x4* gp = (const u32x4*)(KB + (size_t)src * IDXD + (tid & 1) * 32);
#pragma unroll
                for (int j = 0; j < 4; ++j) pre[j] = gp[j]; }
            const LAS bf16_t* kb = ksb + (b & 1) * 256 * KST;
#pragma unroll 2
            for (int tt = 0; tt < 8; ++tt) {
                const int s0 = b * 256 + tt * 32;
                if (s0 < n) {
                    bf16x8_t bfr[4];
#pragma unroll
                    for (int ks = 0; ks < 4; ++ks) bfr[ks] = *(const LAS bf16x8_t*)(kb + (tt * 32 + key_l) * KST + ks * 16 + hh * 8);
                    float part[2];
#pragma unroll
                    for (int qq = 0; qq < 2; ++qq) {
                        f32x16 acc;
#pragma unroll
                        for (int e = 0; e < 16; ++e) acc[e] = 0.f;
#pragma unroll
                        for (int ks = 0; ks < 4; ++ks) acc = __builtin_amdgcn_mfma_f32_32x32x16_bf16(af[qq][ks], bfr[ks], acc, 0, 0, 0);
                        float s = 0.f;
                        float s0_ = 0.f, s1_ = 0.f;
#pragma unroll
                        for (int e = 0; e < 16; e += 2) { s0_ += wv[qq][e] * __builtin_amdgcn_fmed3f(acc[e], 0.f, 3.0e38f); s1_ += wv[qq][e + 1] * __builtin_amdgcn_fmed3f(acc[e + 1], 0.f, 3.0e38f); }
                        part[qq] = s0_ + s1_; (void)s;
                    }
                    const float mine = hh ? part[1] : part[0], give = hh ? part[0] : part[1];
                    const float score = mine + __shfl_xor(give, 32);
                    const int key = s0 + key_l;
                    if (key < n) { scr[hh * SCR_N + key] = score; lds_add(hw + hh * 1024 + (fkey(score) >> 22), 1u); }
                }
            }
            if (more) { const int kk = tid >> 1, hf = tid & 1;
#pragma unroll
                for (int j = 0; j < 4; ++j) *(LAS u32x4*)(ksb + ((b + 1) & 1) * 256 * KST + kk * KST + hf * 32 + j * 8) = pre[j]; }
            __syncthreads();
        }
        unsigned b1[2], ab1[2];
        wfind<16>(hw, TOPK, lane, b1[0], ab1[0]); wfind<16>(hw + 1024, TOPK, lane, b1[1], ab1[1]);
        const int nv4 = (n + 3) >> 2;
#pragma unroll
        for (int j = 0; j < 8; ++j) *(LAS u32x4*)(hw + (j * 64 + lane) * 4) = (u32x4){0u, 0u, 0u, 0u};
        for (int sb = 0; sb < nv4; sb += 64 * SELB) {
            f32x4 va[SELB], vb[SELB];
#pragma unroll
            for (int u = 0; u < SELB; ++u) { const int s4 = sb + u * 64 + lane; const int sc = s4 < nv4 ? s4 : nv4 - 1; va[u] = *(const f32x4*)(scr + sc * 4); vb[u] = *(const f32x4*)(scr + SCR_N + sc * 4); }
#pragma unroll
            for (int u = 0; u < SELB; ++u) if (sb + u * 64 + lane < nv4) {
#pragma unroll
                for (int e = 0; e < 4; ++e) { const unsigned ka = fkey(va[u][e]), kb = fkey(vb[u][e]);
                    if ((ka >> 22) == b1[0]) lds_add(hw + ((ka >> 12) & 1023u), 1u);
                    if ((kb >> 22) == b1[1]) lds_add(hw + 1024 + ((kb >> 12) & 1023u), 1u); } } }
        unsigned b2[2], ab2[2];
        wfind<16>(hw, TOPK - ab1[0], lane, b2[0], ab2[0]); wfind<16>(hw + 1024, TOPK - ab1[1], lane, b2[1], ab2[1]);
        const unsigned pfx0 = (b1[0] << 10) | b2[0], pfx1 = (b1[1] << 10) | b2[1];
        const unsigned need0 = (unsigned)TOPK - ab1[0] - ab2[0], need1 = (unsigned)TOPK - ab1[1] - ab2[1];
        LAS unsigned* cl0 = hw; LAS unsigned* cl1 = hw + 1024;
        unsigned cnt0 = 0u, cnt1 = 0u, cc0 = 0u, cc1 = 0u; int* sel0 = SEL + (size_t)tA * TOPK; int* sel1 = sel0 + TOPK;
        const unsigned long long lt = (1ull << lane) - 1ull;
        for (int sb = 0; sb < nv4; sb += 64 * SELB) {
            f32x4 va[SELB], vb[SELB];
#pragma unroll
            for (int u = 0; u < SELB; ++u) { const int s4 = sb + u * 64 + lane; const int sc = s4 < nv4 ? s4 : nv4 - 1; va[u] = *(const f32x4*)(scr + sc * 4); vb[u] = *(const f32x4*)(scr + SCR_N + sc * 4); }
#pragma unroll
            for (int u = 0; u < SELB; ++u) { const int s4 = sb + u * 64 + lane; const bool inr = s4 < nv4;
                if (sb + u * 64 < nv4) {
#pragma unroll
                    for (int e = 0; e < 4; ++e) {
                        {   const unsigned k = fkey(va[u][e]); const bool gt = inr && (k >> 12) > pfx0, eq = inr && (k >> 12) == pfx0;
                            const unsigned long long mg = __ballot(gt), me = __ballot(eq);
                            if (gt) { const unsigned pos = cnt0 + (unsigned)__builtin_popcountll(mg & lt); if (pos < (unsigned)TOPK) sel0[pos] = s4 * 4 + e; }
                            if (eq) { const unsigned ci = cc0 + (unsigned)__builtin_popcountll(me & lt); if (ci < 512u) { cl0[2 * ci] = k; cl0[2 * ci + 1] = (unsigned)(s4 * 4 + e); } }
                            cnt0 += (unsigned)__builtin_popcountll(mg); cc0 += (unsigned)__builtin_popcountll(me); }
                        {   const unsigned k = fkey(vb[u][e]); const bool gt = inr && (k >> 12) > pfx1, eq = inr && (k >> 12) == pfx1;
                            const unsigned long long mg = __ballot(gt), me = __ballot(eq);
                            if (gt) { const unsigned pos = cnt1 + (unsigned)__builtin_popcountll(mg & lt); if (pos < (unsigned)TOPK) sel1[pos] = s4 * 4 + e; }
                            if (eq) { const unsigned ci = cc1 + (unsigned)__builtin_popcountll(me & lt); if (ci < 512u) { cl1[2 * ci] = k; cl1[2 * ci + 1] = (unsigned)(s4 * 4 + e); } }
                            cnt1 += (unsigned)__builtin_popcountll(mg); cc1 += (unsigned)__builtin_popcountll(me); }
                    } } } }
#pragma unroll 1
        for (int qq = 0; qq < 2; ++qq) {
            const LAS unsigned* cl = qq ? cl1 : cl0; const unsigned c = min(qq ? cc1 : cc0, 512u), need = qq ? need1 : need0, base = qq ? cnt1 : cnt0; int* sel = qq ? sel1 : sel0;
            for (unsigned i = lane; i < c; i += 64) { const unsigned k = cl[2 * i], ix = cl[2 * i + 1]; unsigned rank = 0;
                for (unsigned j = 0; j < c; ++j) { const unsigned kj = cl[2 * j], ij = cl[2 * j + 1]; rank += (kj > k || (kj == k && ij < ix)) ? 1u : 0u; }
                if (rank < need && base + rank < (unsigned)TOPK) sel[base + rank] = (int)ix; }
        }
    }
}

__device__ __forceinline__ void d3_qlat(const P& p, int G) {
    const int tid = threadIdx.x, lane = tid & 63, wave = __builtin_amdgcn_readfirstlane(tid >> 6), r16 = lane & 15, q = lane >> 4;
    const bf16_t* Z = (const bf16_t*)(p.ws + WS_Z); const bf16_t* WK = (const bf16_t*)(p.ws + WS_WUKB); bf16_t* QL = (bf16_t*)(p.ws + WS_QLAT);
    constexpr int NB = L / 16;
    for (int item = blockIdx.x; item < 256; item += G) {
        const int h = item & 15, qr = item >> 4; const int b0 = qr * 64, b1 = qr == 15 ? NB : b0 + 64;
        bf16x8_t af[4][4];
#pragma unroll
        for (int mt = 0; mt < 4; ++mt)
#pragma unroll
            for (int ks = 0; ks < 4; ++ks) af[mt][ks] = *(const bf16x8_t*)(WK + ((size_t)h * KVR + wave * 64 + 32 * (mt >> 1) + 8 * (r16 >> 2) + 4 * (mt & 1) + (r16 & 3)) * HD_B + ks * 32 + q * 8);
        bf16x8_t bq[4];
#pragma unroll
        for (int ks = 0; ks < 4; ++ks) bq[ks] = *(const bf16x8_t*)(Z + (size_t)(b0 * 16 + r16) * NZ + ZQ + h * 128 + ks * 32 + q * 8);
        for (int b = b0; b < b1; ++b) {
            bf16x8_t bn[4];
            const int bnx = b + 1 < b1 ? b + 1 : b;
#pragma unroll
            for (int ks = 0; ks < 4; ++ks) bn[ks] = *(const bf16x8_t*)(Z + (size_t)(bnx * 16 + r16) * NZ + ZQ + h * 128 + ks * 32 + q * 8);
#pragma unroll
            for (int mp = 0; mp < 2; ++mp) {
                f32x4 acc0 = {0.f, 0.f, 0.f, 0.f}, acc1 = acc0;
#pragma unroll
                for (int ks = 0; ks < 4; ++ks) { acc0 = __builtin_amdgcn_mfma_f32_16x16x32_bf16(af[2 * mp][ks], bq[ks], acc0, 0, 0, 0); acc1 = __builtin_amdgcn_mfma_f32_16x16x32_bf16(af[2 * mp + 1][ks], bq[ks], acc1, 0, 0, 0); }
                u32x4 w; w.x = cvtpk(acc0[0], acc0[1]); w.y = cvtpk(acc0[2], acc0[3]); w.z = cvtpk(acc1[0], acc1[1]); w.w = cvtpk(acc1[2], acc1[3]);
                *(u32x4*)(QL + (size_t)(b * 16 + r16) * 8192 + h * 512 + wave * 64 + mp * 32 + q * 8) = w;
            }
#pragma unroll
            for (int ks = 0; ks < 4; ++ks) bq[ks] = bn[ks];
        }
    }
}
__device__ __forceinline__ void d5_oproj(const P& p, int G) {
    const int tid = threadIdx.x, lane = tid & 63, wave = __builtin_amdgcn_readfirstlane(tid >> 6), r16 = lane & 15, q = lane >> 4;
    const bf16_t* OL = (const bf16_t*)(p.ws + WS_QLAT); const bf16_t* WV = (const bf16_t*)(p.ws + WS_WUVT); bf16_t* YB = (bf16_t*)(p.ws + WS_YB);
    for (size_t i = (size_t)blockIdx.x * NT + tid; i < (size_t)(MP - L) * A_W / 8; i += (size_t)G * NT) *(u32x4*)(YB + (size_t)L * A_W + i * 8) = (u32x4){0u, 0u, 0u, 0u};
    constexpr int NB = L / 16;
    for (int item = blockIdx.x; item < 256; item += G) {
        const int h = item & 15, qr = item >> 4; const int b0 = qr * 64, b1 = qr == 15 ? NB : b0 + 64;
        bf16x8_t af[16];
#pragma unroll
        for (int ks = 0; ks < 16; ++ks) af[ks] = *(const bf16x8_t*)(WV + ((size_t)h * HD_B + wave * 16 + r16) * KVR + ks * 32 + q * 8);
        bf16x8_t bo[16];
#pragma unroll
        for (int ks = 0; ks < 16; ++ks) bo[ks] = *(const bf16x8_t*)(OL + (size_t)(b0 * 16 + r16) * 8192 + h * 512 + ks * 32 + q * 8);
        for (int b = b0; b < b1; ++b) {
            f32x4 acc0 = {0.f, 0.f, 0.f, 0.f}, acc1 = acc0;
#pragma unroll
            for (int ks = 0; ks < 16; ks += 2) { acc0 = __builtin_amdgcn_mfma_f32_16x16x32_bf16(af[ks], bo[ks], acc0, 0, 0, 0); acc1 = __builtin_amdgcn_mfma_f32_16x16x32_bf16(af[ks + 1], bo[ks + 1], acc1, 0, 0, 0); }
            const int bnx = b + 1 < b1 ? b + 1 : b;
#pragma unroll
            for (int ks = 0; ks < 16; ++ks) bo[ks] = *(const bf16x8_t*)(OL + (size_t)(bnx * 16 + r16) * 8192 + h * 512 + ks * 32 + q * 8);
            const f32x4 acc = acc0 + acc1;
            u32x2 w; w.x = cvtpk(acc[0], acc[1]); w.y = cvtpk(acc[2], acc[3]);
            *(u32x2*)(YB + (size_t)(b * 16 + r16) * A_W + h * HD_B + wave * 16 + q * 4) = w;
        }
    }
}

typedef short s16x4_t __attribute__((ext_vector_type(4)));
constexpr int QLS = 520, PLS = 264, CTS = 528;
#ifndef ATT_REG
#define ATT_REG 0
#endif
#if ATT_REG > 0
#define AREG_T() const unsigned long long tt_ = __builtin_amdgcn_s_memrealtime()
#ifndef ATT_BLK
#define ATT_BLK 0
#endif
#define AREG(k) do { if (ATT_REG == (k) && blockIdx.x == ATT_BLK && threadIdx.x == 0) { const unsigned long long t1_ = __builtin_amdgcn_s_memrealtime(); areg_acc += t1_ - areg_t0; } if (ATT_REG != 9 && blockIdx.x == ATT_BLK && threadIdx.x == 0) areg_t0 = __builtin_amdgcn_s_memrealtime(); } while (0)
#else
#define AREG(k) do {} while (0)
#endif
__device__ __forceinline__ void d4_attn(const P& p, LAS unsigned char* lds, int G) {
    unsigned long long areg_acc = 0, areg_t0 = 0; (void)areg_acc; (void)areg_t0;
    const int tid = threadIdx.x, lane = tid & 63, wave = __builtin_amdgcn_readfirstlane(tid >> 6), r16 = lane & 15, q = lane >> 4;
    bf16_t* QO = (bf16_t*)(p.ws + WS_QLAT); const bf16_t* CKV = (const bf16_t*)(p.ws + WS_CKV); const int* SEL = (const int*)(p.ws + WS_SEL);
    LAS bf16_t* ql = (LAS bf16_t*)lds;
    LAS float* lg = (LAS float*)(lds + 16640);
    LAS bf16_t* pl = (LAS bf16_t*)(lds + 49408);
    LAS int* sl = (LAS int*)(lds + 57856);
    LAS bf16_t* ct = (LAS bf16_t*)(lds + 58880);
    LAS bf16_t* cx = (LAS bf16_t*)(lds + 126464);
    const float scale = 0.08838834764831845f;
    u32x4 qn0 = (u32x4){0u, 0u, 0u, 0u}, qn1 = qn0; int seln = -1;
    const bool xdeal = (G == 256);
    const int tq0 = xdeal ? ((int)(blockIdx.x & 7) * (L / 8) + (int)(blockIdx.x >> 3)) : (int)blockIdx.x, tqs = xdeal ? 32 : G, tq1 = xdeal ? ((int)(blockIdx.x & 7) + 1) * (L / 8) : L;
    {   const int t = tq0;
        if (t < tq1) { qn0 = *(const u32x4*)(QO + (size_t)t * 8192 + tid * 8); qn1 = *(const u32x4*)(QO + (size_t)t * 8192 + 4096 + tid * 8); if (tid < TOPK) seln = SEL[(size_t)t * TOPK + tid]; } }
#if ATT_REG == 9
    if (blockIdx.x == ATT_BLK && threadIdx.x == 0) areg_t0 = __builtin_amdgcn_s_memrealtime();
#endif
    for (int t = tq0; t < tq1; t += tqs) {
        AREG(5);
        LDS_BARRIER();
        {   const int i0_ = tid, i1_ = tid + 512;
            *(LAS u32x4*)(ql + (i0_ >> 6) * QLS + (i0_ & 63) * 8) = qn0; *(LAS u32x4*)(ql + (i1_ >> 6) * QLS + (i1_ & 63) * 8) = qn1;
            if (tid < TOPK) sl[tid] = seln; }
        LDS_BARRIER();
        AREG(1);
        u32x4 st[8];
#pragma unroll
        for (int i = 0; i < 8; ++i) { const int idx = sl[wave + 8 * i]; st[i] = *(const u32x4*)(CKV + (size_t)(idx < 0 ? 0 : idx) * KVR + lane * 8); }
        const int kk = wave & 3, kh = wave >> 2;
        bf16x8_t af[8];
#pragma unroll
        for (int ks = 0; ks < 8; ++ks) af[ks] = *(const LAS bf16x8_t*)(ql + r16 * QLS + kh * 256 + ks * 32 + q * 8);
        for (int kt = 0; kt < 4; ++kt) {
            LDS_BARRIER();
#pragma unroll
            for (int i = 0; i < 8; ++i) { LAS bf16_t* dst = (kt == 2 && i >= 4) ? cx + (wave + 8 * i - 32) * CTS : ct + (wave + 8 * i) * CTS; *(LAS u32x4*)(dst + lane * 8) = st[i]; }
            if (kt < 3) {
#pragma unroll
                for (int i = 0; i < 8; ++i) { const int idx = sl[(kt + 1) * 64 + wave + 8 * i]; st[i] = *(const u32x4*)(CKV + (size_t)(idx < 0 ? 0 : idx) * KVR + lane * 8); }
            } else {
#pragma unroll
                for (int i = 0; i < 4; ++i) { const int idx = sl[128 + wave + 8 * i]; st[i] = *(const u32x4*)(CKV + (size_t)(idx < 0 ? 0 : idx) * KVR + lane * 8); }
            }
            LDS_BARRIER();
            const LAS bf16_t* kb = (kt == 2 && kk >= 2) ? cx + ((kk - 2) * 16 + r16) * CTS : ct + (kk * 16 + r16) * CTS;
            f32x4 c0 = {0.f, 0.f, 0.f, 0.f};
#pragma unroll
            for (int ks = 0; ks < 8; ++ks) {
                const bf16x8_t b = *(const LAS bf16x8_t*)(kb + kh * 256 + ks * 32 + q * 8);
                c0 = __builtin_amdgcn_mfma_f32_16x16x32_bf16(af[ks], b, c0, 0, 0, 0);
            }
            const int key = kt * 64 + kk * 16 + r16; const bool inval = sl[key] < 0;
#pragma unroll
            for (int e = 0; e < 4; ++e) lg[kh * 4096 + (4 * q + e) * 256 + key] = inval ? (kh ? 0.f : -INFINITY) : c0[e] * scale;
        }
        LDS_BARRIER();
        AREG(2);
        for (int hd = wave * 2; hd < wave * 2 + 2; ++hd) {
            float v[4]; float mx = -INFINITY;
#pragma unroll
            for (int k = 0; k < 4; ++k) { v[k] = lg[hd * 256 + k * 64 + lane] + lg[4096 + hd * 256 + k * 64 + lane]; mx = fmaxf(mx, v[k]); }
            mx = wave_max(mx);
            float s = 0.f;
#pragma unroll
            for (int k = 0; k < 4; ++k) { v[k] = __expf(v[k] - mx); s += v[k]; }
            s = 1.f / wave_sum(s);
#pragma unroll
            for (int k = 0; k < 4; ++k) pl[hd * PLS + k * 64 + lane] = f2bf(v[k] * s);
        }
        f32x4 acc[4];
#pragma unroll
        for (int m = 0; m < 4; ++m) acc[m] = (f32x4){0.f, 0.f, 0.f, 0.f};
        {   const int tn = t + tqs;
            if (tn < tq1) { qn0 = *(const u32x4*)(QO + (size_t)tn * 8192 + tid * 8); qn1 = *(const u32x4*)(QO + (size_t)tn * 8192 + 4096 + tid * 8); if (tid < TOPK) seln = SEL[(size_t)tn * TOPK + tid]; } }
        AREG(3);
        for (int j2 = 0; j2 < 4; ++j2) {
            const int kt = 3 - j2;
            LDS_BARRIER();
            if (j2 > 0) {
                if (j2 == 1) {
#pragma unroll
                    for (int i = 0; i < 4; ++i) *(LAS u32x4*)(ct + (wave + 8 * i) * CTS + lane * 8) = st[i];
                } else {
#pragma unroll
                    for (int i = 0; i < 8; ++i) *(LAS u32x4*)(ct + (wave + 8 * i) * CTS + lane * 8) = st[i];
                }
                if (j2 < 3) {
#pragma unroll
                    for (int i = 0; i < 8; ++i) { const int idx = sl[(kt - 1) * 64 + wave + 8 * i]; st[i] = *(const u32x4*)(CKV + (size_t)(idx < 0 ? 0 : idx) * KVR + lane * 8); } }
                LDS_BARRIER();
            }
            const int kq = 16 * (q >> 1) + 4 * (q & 1);
#pragma unroll
            for (int s = 0; s < 2; ++s) {
                const u32x2 pa = *(const LAS u32x2*)(pl + r16 * PLS + kt * 64 + s * 32 + kq), pb = *(const LAS u32x2*)(pl + r16 * PLS + kt * 64 + s * 32 + kq + 8);
                const u32x4 pw = (u32x4){pa.x, pa.y, pb.x, pb.y}; const bf16x8_t b = __builtin_bit_cast(bf16x8_t, pw);
                const LAS bf16_t* cb = (kt == 2 && s == 1) ? cx : ct + s * 32 * CTS;
                const LAS bf16_t* tp = cb + (kq + (r16 >> 2)) * CTS + wave * 64 + (r16 & 3) * 4;
#pragma unroll
                for (int m = 0; m < 4; ++m) {
                    const s16x4_t lo = __builtin_amdgcn_ds_read_tr16_b64_v4i16((LAS s16x4_t*)(tp + m * 16)), hi = __builtin_amdgcn_ds_read_tr16_b64_v4i16((LAS s16x4_t*)(tp + 8 * CTS + m * 16));
                    const bf16x8_t a = (bf16x8_t){lo[0], lo[1], lo[2], lo[3], hi[0], hi[1], hi[2], hi[3]};
                    acc[m] = __builtin_amdgcn_mfma_f32_16x16x32_bf16(a, b, acc[m], 0, 0, 0);
                }
            }
        }
        AREG(4);
#pragma unroll
        for (int m = 0; m < 4; ++m) { u32x2 w; w.x = cvtpk(acc[m][0], acc[m][1]); w.y = cvtpk(acc[m][2], acc[m][3]);
            *(u32x2*)(QO + (size_t)t * 8192 + r16 * 512 + wave * 64 + m * 16 + q * 4) = w; }
    }
#if ATT_REG == 9
    if (blockIdx.x == ATT_BLK && threadIdx.x == 0) areg_acc = __builtin_amdgcn_s_memrealtime() - areg_t0;
#endif
#if ATT_REG > 0
    if (blockIdx.x == ATT_BLK && threadIdx.x == 0) __hip_atomic_store((unsigned*)(p.ws + WS_CTL) + 65540, (unsigned)areg_acc, __ATOMIC_RELAXED, __HIP_MEMORY_SCOPE_AGENT);
#endif
}


__device__ __forceinline__ const float* h1_row(const P& p, int m) { const float* hmeta = (const float*)(p.ws + WS_HMETA); return m < NMETA ? hmeta + (size_t)m * D : p.out + (size_t)(m - NMETA) * D; }
__device__ __forceinline__ void p12_norm(const P& p, int G) {
    const int lane = threadIdx.x & 63, wave = threadIdx.x >> 6;
    signed char* U8 = (signed char*)(p.ws + WS_U); const float* w = p.in[I_NFW];
    float wm = 0.f;
#pragma unroll
    for (int j = 0; j < 16; ++j) { const f32x4 g = *(const f32x4*)(w + (j * 64 + lane) * 4); wm += (g.x * g.x + g.y * g.y) + (g.z * g.z + g.w * g.w); }
    wm = sqrtf(wave_sum(wm) * (1.f / D));
    const float amc = 4.0f * wm;
    const float inv = amc > 0.f ? 127.f / amc : 0.f;
    if (blockIdx.x == 0 && threadIdx.x == 0) *(float*)(p.ws + WS_CTL + CT_SAG) = amc > 0.f ? amc * (1.f / 127.f) : 1.f;
    for (int m = blockIdx.x * NWAVES + wave; m < MP; m += G * NWAVES) {
        signed char* dst = U8 + (size_t)m * D;
        if (m >= L) {
#pragma unroll
            for (int j = 0; j < 4; ++j) *(u32x4*)(dst + (j * 64 + lane) * 16) = (u32x4){0u, 0u, 0u, 0u};
            continue; }
        const float* src = h1_row(p, m);
        f32x4 v[16]; float s = 0.f;
#pragma unroll
        for (int j = 0; j < 16; ++j) { v[j] = *(const f32x4*)(src + (j * 64 + lane) * 4); s += (v[j].x * v[j].x + v[j].y * v[j].y) + (v[j].z * v[j].z + v[j].w * v[j].w); }
        const float ri = rsqrtf(wave_sum(s) * (1.f / D) + 1e-6f) * inv;
#pragma unroll
        for (int j = 0; j < 16; ++j) { const f32x4 x = v[j] * ri; const f32x4 g = *(const f32x4*)(w + (j * 64 + lane) * 4);
            const unsigned q = ((unsigned)(int)rintf(fminf(fmaxf(x.x * g.x, -127.f), 127.f)) & 0xffu) | (((unsigned)(int)rintf(fminf(fmaxf(x.y * g.y, -127.f), 127.f)) & 0xffu) << 8) | (((unsigned)(int)rintf(fminf(fmaxf(x.z * g.z, -127.f), 127.f)) & 0xffu) << 16) | (((unsigned)(int)rintf(fminf(fmaxf(x.w * g.w, -127.f), 127.f)) & 0xffu) << 24);
            *(unsigned*)(dst + (j * 64 + lane) * 4) = q; }
    }
}
__device__ __forceinline__ void p18_final_norm(const P& p, int G) {
    const int tid = threadIdx.x, lane = tid & 63, wave = tid >> 6;
    const float* w = p.in[I_NFIN];
    for (int m = blockIdx.x * NWAVES + wave; m < SEQ; m += G * NWAVES) {
        float* row = p.out + (size_t)m * D;
        f32x4 v[16]; float s = 0.f;
#pragma unroll
        for (int j = 0; j < 16; ++j) { v[j] = *(const f32x4*)(row + (j * 64 + lane) * 4); s += (v[j].x * v[j].x + v[j].y * v[j].y) + (v[j].z * v[j].z + v[j].w * v[j].w); }
        float r = rsqrtf(wave_sum(s) * (1.f / D) + 1e-6f);
#if STAMP_A0 >= 0
        r *= 1.f + 1e-7f * (float)__hip_atomic_load((const unsigned*)(p.ws + WS_CTL) + 65536, __ATOMIC_RELAXED, __HIP_MEMORY_SCOPE_AGENT);
#endif
#pragma unroll
        for (int j = 0; j < 16; ++j) { const f32x4 g = *(const f32x4*)(w + (j * 64 + lane) * 4); *(f32x4*)(row + (j * 64 + lane) * 4) = v[j] * r * g; }
    }
}

__device__ __forceinline__ void p14_conv_act(const P& p, int G, int pass) {
    const int tid = threadIdx.x;
    const bf16_t* ZF = (const bf16_t*)(p.ws + WS_ZF); bf16_t* ACT = (bf16_t*)(p.ws + WS_ACT);
    const float* cw = p.in[I_CW]; const float* cb = p.in[I_CB];
    const size_t nitems = (size_t)MP * 43 * 16;
    for (size_t it = (size_t)blockIdx.x * NT + tid; it < nitems; it += (size_t)G * NT) {
        const int g8 = (int)(it % 16), tl = (int)((it / 16) % 43), t = (int)(it / (16 * 43));
        const int ch = (pass * 43 + tl) * 128 + g8 * 8;
        u32x4 o = (u32x4){0u, 0u, 0u, 0u};
        if (t < L) {
            float zg[8], zu[8];
#pragma unroll
            for (int e = 0; e < 8; ++e) { zg[e] = cb[ch + e]; zu[e] = cb[DFF + ch + e]; }
#pragma unroll
            for (int i = 0; i < 3; ++i) { const int tt = t - 2 + i;
                if (tt >= 0) {
                    const u32x4 a = *(const u32x4*)(ZF + (size_t)tt * DFF + tl * 256 + g8 * 8), b = *(const u32x4*)(ZF + (size_t)tt * DFF + tl * 256 + 128 + g8 * 8);
                    const float xa[8] = {blo(a.x), bhi(a.x), blo(a.y), bhi(a.y), blo(a.z), bhi(a.z), blo(a.w), bhi(a.w)};
                    const float xb[8] = {blo(b.x), bhi(b.x), blo(b.y), bhi(b.y), blo(b.z), bhi(b.z), blo(b.w), bhi(b.w)};
#pragma unroll
                    for (int e = 0; e < 8; ++e) { zg[e] += cw[(size_t)i * NFI + ch + e] * xa[e]; zu[e] += cw[(size_t)i * NFI + DFF + ch + e] * xb[e]; }
                } }
            float r[8];
#pragma unroll
            for (int e = 0; e < 8; ++e) r[e] = zg[e] * sigm(zg[e]) * zu[e];
            o.x = pk2(r[0], r[1]); o.y = pk2(r[2], r[3]); o.z = pk2(r[4], r[5]); o.w = pk2(r[6], r[7]);
        }
        *(u32x4*)(ACT + (size_t)t * DFF + ch) = o;
    }
}

template <int K, class F> __device__ __forceinline__ void side2(const bf16_t* A14, int lda, const bf16_t* Bt, int N, int G, F f) {
    const int lane = threadIdx.x & 63, gw = blockIdx.x * NWAVES + (threadIdx.x >> 6);
    constexpr int NC = K / 512;
    u32x4 a0[NC], a1[NC];
#pragma unroll
    for (int i = 0; i < NC; ++i) { a0[i] = *(const u32x4*)(A14 + i * 512 + lane * 8); a1[i] = *(const u32x4*)(A14 + lda + i * 512 + lane * 8); }
    for (int n = gw; n < N; n += G * NWAVES) {
        float s0 = 0.f, s1 = 0.f;
#pragma unroll
        for (int i = 0; i < NC; ++i) { const u32x4 b = *(const u32x4*)(Bt + (size_t)n * K + i * 512 + lane * 8);
            const unsigned bw[4] = {b.x, b.y, b.z, b.w}, x0[4] = {a0[i].x, a0[i].y, a0[i].z, a0[i].w}, x1[4] = {a1[i].x, a1[i].y, a1[i].z, a1[i].w};
#pragma unroll
            for (int e = 0; e < 4; ++e) { s0 += blo(x0[e]) * blo(bw[e]) + bhi(x0[e]) * bhi(bw[e]); s1 += blo(x1[e]) * blo(bw[e]) + bhi(x1[e]) * bhi(bw[e]); } }
        s0 = wave_sum(s0); s1 = wave_sum(s1);
        if (lane == 0) f(n, s0, s1);
    }
}

template <class F> __device__ __forceinline__ void side2_i8(const signed char* A14, const signed char* Bt, int N, int G, F f) {
    const int lane = threadIdx.x & 63, gw = blockIdx.x * NWAVES + (threadIdx.x >> 6);
    u32x4 a0[4], a1[4];
#pragma unroll
    for (int i = 0; i < 4; ++i) { a0[i] = *(const u32x4*)(A14 + i * 1024 + lane * 16); a1[i] = *(const u32x4*)(A14 + 4096 + i * 1024 + lane * 16); }
    for (int n = gw; n < N; n += G * NWAVES) {
        int s0 = 0, s1 = 0;
#pragma unroll
        for (int i = 0; i < 4; ++i) { const u32x4 b = *(const u32x4*)(Bt + (size_t)n * 4096 + i * 1024 + lane * 16);
            s0 = __builtin_amdgcn_sdot4((int)a0[i].x, (int)b.x, s0, false); s0 = __builtin_amdgcn_sdot4((int)a0[i].y, (int)b.y, s0, false); s0 = __builtin_amdgcn_sdot4((int)a0[i].z, (int)b.z, s0, false); s0 = __builtin_amdgcn_sdot4((int)a0[i].w, (int)b.w, s0, false);
            s1 = __builtin_amdgcn_sdot4((int)a1[i].x, (int)b.x, s1, false); s1 = __builtin_amdgcn_sdot4((int)a1[i].y, (int)b.y, s1, false); s1 = __builtin_amdgcn_sdot4((int)a1[i].z, (int)b.z, s1, false); s1 = __builtin_amdgcn_sdot4((int)a1[i].w, (int)b.w, s1, false); }
#pragma unroll
        for (int d = 32; d >= 1; d >>= 1) { s0 += __shfl_xor(s0, d); s1 += __shfl_xor(s1, d); }
        if (lane == 0) f(n, s0, s1);
    }
}

__device__ __forceinline__ void p_conv_fix(const P& p, int G) {
    const int tid = threadIdx.x;
    const float* HALO = (const float*)(p.ws + WS_ZF); bf16_t* ACT = (bf16_t*)(p.ws + WS_ACT);
    const float* cw = p.in[I_CW]; const float* cb = p.in[I_CB];
    const int nitems = 64 * 2 * DFF;
    for (int it = blockIdx.x * NT + tid; it < nitems; it += G * NT) {
        const int c = it % DFF, d = (it / DFF) & 1, pm = 1 + it / (2 * DFF);
        const int r = pm * 256 + d; if (r >= L) continue;
        const int T = c >> 7, cl = c & 127; const int colg = T * 256 + cl, colu = colg + 128;
        const float* h0 = HALO + ((size_t)(pm - 1) * 4 + 2 + d) * NFI; const float* h1 = d == 0 ? HALO + ((size_t)(pm - 1) * 4 + 3) * NFI : HALO + ((size_t)pm * 4 + 0) * NFI; const float* h2 = HALO + ((size_t)pm * 4 + d) * NFI;
        const float zg = cb[c] + cw[c] * h0[colg] + cw[(size_t)NFI + c] * h1[colg] + cw[(size_t)2 * NFI + c] * h2[colg];
        const float zu = cb[DFF + c] + cw[DFF + c] * h0[colu] + cw[(size_t)NFI + DFF + c] * h1[colu] + cw[(size_t)2 * NFI + DFF + c] * h2[colu];
        ACT[(size_t)r * DFF + c] = f2bf(zg * sigm(zg) * zu);
    }
}

constexpr int NPHASE = 20;
__global__ void __launch_bounds__(NT, 2) fwd_kernel(P p) {
    extern __shared__ __attribute__((aligned(16))) unsigned char lds_raw[];
    LAS unsigned char* lds = (LAS unsigned char*)lds_raw;
    const int G = gridDim.x;
    unsigned char* ws = p.ws;
    volatile LAS unsigned* MISC = (volatile LAS unsigned*)(lds + MISC_OFF);
    if (threadIdx.x < 16) MISC[threadIdx.x] = 0u;
    __syncthreads();
#if MK_ONE_LAUNCH
    XcdBarrier bar = xcd_barrier_post((unsigned*)(ws + WS_CTL), MISC + 8);
#define GRID_BAR() xcd_barrier(bar)
#else
#define GRID_BAR() do {} while (0)
#endif
    unsigned long long tsA0 = 0, tsA1 = 0, tsB0 = 0, tsB1 = 0; (void)tsA0; (void)tsA1; (void)tsB0; (void)tsB1;
    const int lo = p.ph_lo, hi = p.ph_hi;
#ifndef PHASE_MASK
#define PHASE_MASK 0xFFFFFFFu
#endif
#define IN(k) ((((PHASE_MASK) >> (k)) & 1u) && lo <= (k) && (k) < hi)
#ifndef STAMP_A0
#define STAMP_A0 -1
#endif
#if STAMP_A0 >= 0
#define STAMP(k) do { if (blockIdx.x == 0 && threadIdx.x == 0) { const unsigned long long t_ = __builtin_amdgcn_s_memrealtime(); if ((k) == STAMP_A0) tsA0 = t_; if ((k) == STAMP_A1) tsA1 = t_; if ((k) == STAMP_B0) tsB0 = t_; if ((k) == STAMP_B1) { tsB1 = t_; \
    __hip_atomic_store((unsigned*)(ws + WS_CTL) + 65536, (unsigned)(tsB1 - tsB0), __ATOMIC_RELAXED, __HIP_MEMORY_SCOPE_AGENT); } } } while (0)
#else
#define STAMP(k) do {} while (0)
#endif
#define SEAM(k) do { if (IN((k) + 1)) GRID_BAR(); STAMP((k) + 1); } while (0)
    STAMP(0);
#ifndef PROBE_REP_MASK
#define PROBE_REP_MASK 0u
#endif
#define NREP(k) ((((PROBE_REP_MASK) >> (k)) & 1u) ? 2 : 1)
    bf16_t* U = (bf16_t*)(ws + WS_U);
    if (IN(0)) _Pragma("unroll") for (int rep_ = 0; rep_ < NREP(0); ++rep_) { p0_prologue_a(p, lds, G); GRID_BAR(); p0_prologue_b(p, lds, G); if (rep_ == NREP(0) - 1) SEAM(0); }
    if (IN(1)) _Pragma("unroll") for (int rep_ = 0; rep_ < NREP(1); ++rep_) {
        {   pg8::Gemm g{U, (const bf16_t*)(ws + WS_WINT), MP, NZ8, D / 2, (const float*)(ws + WS_CTL + CT_SA), (const float*)(ws + WS_CTL + CT_SB_IN)}; pg8::StaticOrder S; S.init(MP, NZ8, G, (int)blockIdx.x);
            pg8::EpiBf16<0> E{(bf16_t*)(ws + WS_Z), NZ};
            pg8::gemm_phase<pg8::EpiBf16<0>, pg8::StaticOrder, true, true, true>(lds, g, S, E); }
        {   pg8::Gemm g{(const bf16_t*)(ws + WS_R1), (const bf16_t*)(ws + WS_WINT + WINT_BF_OFF), MP, NZ - NZ8, D}; pg8::StaticOrder S; S.init(MP, NZ - NZ8, G, (int)blockIdx.x);
            pg8::EpiBf16<0> E{(bf16_t*)(ws + WS_Z) + NZ8, NZ};
            pg8::gemm_phase<pg8::EpiBf16<0>, pg8::StaticOrder, true, true, false>(lds, g, S, E); }
        if (rep_ == NREP(1) - 1) SEAM(1);
    }
    if (IN(2)) _Pragma("unroll") for (int rep_ = 0; rep_ < NREP(2); ++rep_) { p2_rwkv_prep(p, lds, G); if (rep_ == NREP(2) - 1) SEAM(2); }
    if (IN(3)) _Pragma("unroll") for (int rep_ = 0; rep_ < NREP(3); ++rep_) { ra_items(p, lds, G); if (rep_ == NREP(3) - 1) SEAM(3); }
    if (IN(4)) _Pragma("unroll") for (int rep_ = 0; rep_ < NREP(4); ++rep_) { rb_chain(p, G);
        {
            const int wv_ = threadIdx.x >> 6, nch_ = G < 128 ? G : 128; const int nvw_ = nch_ * 7 + (G - nch_) * 8;
            const int vw_ = (int)blockIdx.x < nch_ ? ((int)blockIdx.x * 7 + wv_ - 1) : (nch_ * 7 + ((int)blockIdx.x - nch_) * 8 + wv_);
            if (!((int)blockIdx.x < nch_ && wv_ == 0)) p0b_weights(p, lds, vw_, nvw_); }
        if (rep_ == NREP(4) - 1) SEAM(4); }
    if (IN(5)) _Pragma("unroll") for (int rep_ = 0; rep_ < NREP(5); ++rep_) { rc_out(p, G); if (rep_ == NREP(5) - 1) SEAM(5); }
    if (IN(6)) _Pragma("unroll") for (int rep_ = 0; rep_ < NREP(6); ++rep_) { p4_dsa_prep(p, G); if (rep_ == NREP(6) - 1) SEAM(6); }
    if (IN(7)) _Pragma("unroll") for (int rep_ = 0; rep_ < NREP(7); ++rep_) { d2_topk(p, lds, G); if (rep_ == NREP(7) - 1) SEAM(7); }
    if (IN(8)) _Pragma("unroll") for (int rep_ = 0; rep_ < NREP(8); ++rep_) { d3_qlat(p, G); if (rep_ == NREP(8) - 1) SEAM(8); }
    if (IN(9)) _Pragma("unroll") for (int rep_ = 0; rep_ < NREP(9); ++rep_) { d4_attn(p, lds, G); if (rep_ == NREP(9) - 1) SEAM(9); }
    if (IN(11)) _Pragma("unroll") for (int rep_ = 0; rep_ < NREP(11); ++rep_) {
        d5_oproj(p, G);
        pg8::Gemm g{U + (size_t)NMETA * (D / 2), (const bf16_t*)(ws + WS_WGT), SEQ, 8192, D / 2, (const float*)(ws + WS_CTL + CT_SA) + NMETA, (const float*)(ws + WS_CTL + CT_SB_G)}; pg8::StaticOrder S; S.init(SEQ, 8192, G, (int)blockIdx.x);
        pg8::EpiBf16<1> E{(bf16_t*)(ws + WS_GATES) + (size_t)NMETA * 8192, 8192};
        pg8::gemm_phase<pg8::EpiBf16<1>, pg8::StaticOrder, true, true, true>(lds, g, S, E);
        {   const float* SA_ = (const float*)(ws + WS_CTL + CT_SA); const float* SB_ = (const float*)(ws + WS_CTL + CT_SB_G); bf16_t* GT = (bf16_t*)(ws + WS_GATES);
            side2_i8((const signed char*)(ws + WS_U) + (size_t)14 * D, (const signed char*)(ws + WS_WGT), 8192, G, [&](int n, int i0, int i1) {
                GT[(size_t)14 * 8192 + n] = f2bf(1.f / (1.f + __expf(-(float)i0 * SA_[14] * SB_[n]))); GT[(size_t)15 * 8192 + n] = f2bf(1.f / (1.f + __expf(-(float)i1 * SA_[15] * SB_[n]))); }); }
        if (rep_ == NREP(11) - 1) SEAM(11);
    }
    if (IN(12)) _Pragma("unroll") for (int rep_ = 0; rep_ < NREP(12); ++rep_) {
        pg8::Gemm g{(const bf16_t*)(ws + WS_YA) + (size_t)NMETA * A_W, (const bf16_t*)(ws + WS_WPAT), SEQ, D, A_W}; pg8::StaticOrder S; S.init(SEQ, D, G, (int)blockIdx.x);
        pg8::EpiGateMulF32 E{(bf16_t*)(ws + WS_MF) + (size_t)NMETA * D, D, (const bf16_t*)(ws + WS_GATES) + (size_t)NMETA * 8192, 8192, 0};
        pg8::gemm_phase<pg8::EpiGateMulF32, pg8::StaticOrder, true, true>(lds, g, S, E);
        {   bf16_t* MA = (bf16_t*)(ws + WS_MF); const bf16_t* GT = (const bf16_t*)(ws + WS_GATES);
            side2<2048>((const bf16_t*)(ws + WS_YA) + (size_t)14 * A_W, A_W, (const bf16_t*)(ws + WS_WPAT), D, G, [&](int n, float s0, float s1) {
                MA[(size_t)14 * D + n] = f2bf(bf2f(GT[(size_t)14 * 8192 + n]) * s0); MA[(size_t)15 * D + n] = f2bf(bf2f(GT[(size_t)15 * 8192 + n]) * s1); }); }
        if (rep_ == NREP(12) - 1) SEAM(12);
    }
    if (IN(13)) _Pragma("unroll") for (int rep_ = 0; rep_ < NREP(13); ++rep_) {
        pg8::Gemm g{(const bf16_t*)(ws + WS_YB) + (size_t)NMETA * A_W, (const bf16_t*)(ws + WS_WPBT), SEQ, D, A_W}; pg8::StaticOrder S; S.init(SEQ, D, G, (int)blockIdx.x);
        pg8::EpiGateMulAddBf16 E{U + (size_t)NMETA * D, D, (const bf16_t*)(ws + WS_MF) + (size_t)NMETA * D, (const bf16_t*)(ws + WS_GATES) + (size_t)NMETA * 8192, 8192, D};
        pg8::gemm_phase<pg8::EpiGateMulAddBf16, pg8::StaticOrder, true, true>(lds, g, S, E);
        {   const bf16_t* MA = (const bf16_t*)(ws + WS_MF); const bf16_t* GT = (const bf16_t*)(ws + WS_GATES);
            side2<2048>((const bf16_t*)(ws + WS_YB) + (size_t)14 * A_W, A_W, (const bf16_t*)(ws + WS_WPBT), D, G, [&](int n, float s0, float s1) {
                U[(size_t)14 * D + n] = f2bf(bf2f(MA[(size_t)14 * D + n]) + bf2f(GT[(size_t)14 * 8192 + D + n]) * s0); U[(size_t)15 * D + n] = f2bf(bf2f(MA[(size_t)15 * D + n]) + bf2f(GT[(size_t)15 * 8192 + D + n]) * s1); }); }
        if (rep_ == NREP(13) - 1) SEAM(13);
    }
    if (IN(14)) _Pragma("unroll") for (int rep_ = 0; rep_ < NREP(14); ++rep_) {
        pg8::Gemm g{U + (size_t)NMETA * D, (const bf16_t*)(ws + WS_WOUTT), SEQ, D, D}; pg8::StaticOrder S; S.init(SEQ, D, G, (int)blockIdx.x);
        pg8::EpiResid E{p.in[I_X], p.in[I_X], p.out, p.out, D, 0, SEQ};
        pg8::gemm_phase<pg8::EpiResid, pg8::StaticOrder, true, true>(lds, g, S, E);
        {   float* HM = (float*)(ws + WS_HMETA); const float* mt = p.in[I_META];
            for (int i2 = blockIdx.x * NT + threadIdx.x; i2 < 14 * D; i2 += G * NT) HM[i2] = mt[i2];
            side2<4096>(U + (size_t)14 * D, D, (const bf16_t*)(ws + WS_WOUTT), D, G, [&](int n, float s0, float s1) { HM[(size_t)14 * D + n] = mt[(size_t)14 * D + n] + s0; HM[(size_t)15 * D + n] = mt[(size_t)15 * D + n] + s1; }); }
        if (rep_ == NREP(14) - 1) SEAM(14);
    }
    if (IN(15)) _Pragma("unroll") for (int rep_ = 0; rep_ < NREP(15); ++rep_) { p12_norm(p, G); if (rep_ == NREP(15) - 1) SEAM(15); }
    if (IN(16)) _Pragma("unroll") for (int rep_ = 0; rep_ < NREP(16); ++rep_) {
        pg8::Gemm g{U, (const bf16_t*)(ws + WS_WFIT), MP, NFI, D / 2, (const float*)(ws + WS_CTL + CT_SA), (const float*)(ws + WS_CTL + CT_SB_F)}; pg8::StaticOrder S; S.init(MP, NFI, G, (int)blockIdx.x);
        pg8::EpiConvAct E{(bf16_t*)(ws + WS_ACT), DFF, (float*)(ws + WS_ZF), NFI, p.in[I_CW], p.in[I_CB], DFF, (PG8_LAS float*)(lds + 131072), (const float*)(ws + WS_CTL + CT_SAG), (const float*)(ws + WS_CTL + CT_SB_F)};
        pg8::gemm_phase<pg8::EpiConvAct, pg8::StaticOrder, true, true, true>(lds, g, S, E);
        if (rep_ == NREP(16) - 1) SEAM(16);
    }
    if (IN(17)) _Pragma("unroll") for (int rep_ = 0; rep_ < NREP(17); ++rep_) { p_conv_fix(p, G); if (rep_ == NREP(17) - 1) SEAM(17); }
    if (IN(18)) _Pragma("unroll") for (int rep_ = 0; rep_ < NREP(18); ++rep_) {
        pg8::Gemm g{(const bf16_t*)(ws + WS_ACT) + (size_t)NMETA * DFF, (const bf16_t*)(ws + WS_WFOT), SEQ, D, DFF}; pg8::StaticOrder S; S.init(SEQ, D, G, (int)blockIdx.x);
        pg8::EpiResid E{p.out, p.out, p.out, p.out, D, 0, SEQ};
        pg8::gemm_phase<pg8::EpiResid, pg8::StaticOrder, true, true>(lds, g, S, E);
        if (rep_ == NREP(18) - 1) SEAM(18);
    }
    if (IN(19)) _Pragma("unroll") for (int rep_ = 0; rep_ < NREP(19); ++rep_) { p18_final_norm(p, G); }
#if STAMP_A0 >= 0
    if (blockIdx.x == 0 && threadIdx.x == 0) { const unsigned long long t_end = __builtin_amdgcn_s_memrealtime(); unsigned long long dA = (tsA1 - tsA0) * 64ull;
#if defined(ATT_REG) && ATT_REG > 0
        dA = (unsigned long long)__hip_atomic_load((const unsigned*)(ws + WS_CTL) + 65540, __ATOMIC_RELAXED, __HIP_MEMORY_SCOPE_AGENT) * 64ull;
#endif
        while (__builtin_amdgcn_s_memrealtime() - t_end < dA) __builtin_amdgcn_s_sleep(8); }
#endif
#undef IN
#undef SEAM
}

extern "C" void kernel_launch(void* const* d_in, const int* in_sizes, int n_in, void* d_out, int out_size, void* d_ws, size_t ws_size, hipStream_t stream) {
    static int grid = 0;
    if (grid == 0) {
        if (n_in != 30 || out_size != SEQ * D || ws_size < WS_END2) { fprintf(stderr, "kernel_launch: unexpected shapes (n_in %d out %d ws %zu need %zu)\n", n_in, out_size, ws_size, (size_t)WS_END); grid = -1; return; }
        int dev = 0, cus = 0, per_cu = 0;
        if (hipGetDevice(&dev) != hipSuccess || hipDeviceGetAttribute(&cus, hipDeviceAttributeMultiprocessorCount, dev) != hipSuccess) { grid = -1; return; }
        if (hipFuncSetAttribute((const void*)fwd_kernel, hipFuncAttributeMaxDynamicSharedMemorySize, LDS_BYTES) != hipSuccess) { fprintf(stderr, "kernel_launch: hipFuncSetAttribute failed\n"); grid = -1; return; }
        if (hipOccupancyMaxActiveBlocksPerMultiprocessor(&per_cu, (const void*)fwd_kernel, NT, LDS_BYTES) != hipSuccess || per_cu < 1) fprintf(stderr, "kernel_launch: occupancy query says %d\n", per_cu);
        (void)hipGetLastError();
        grid = cus;
    }
    if (grid < 0) return;
    (void)hipMemsetAsync((char*)d_ws + WS_CTL, 0, CTL_BYTES, stream);
    P a{};
    for (int i = 0; i < 30; ++i) a.in[i] = (const float*)d_in[i];
    a.out = (float*)d_out; a.ws = (unsigned char*)d_ws;
#if MK_ONE_LAUNCH
    a.ph_lo = 0; a.ph_hi = NPHASE;
    hipLaunchKernelGGL(fwd_kernel, dim3(grid), dim3(NT), LDS_BYTES, stream, a);
#else
    for (int k = 0; k < NPHASE; ++k) { a.ph_lo = k; a.ph_hi = k + 1; hipLaunchKernelGGL(fwd_kernel, dim3(grid), dim3(NT), LDS_BYTES, stream, a); }
#endif
}
```

```cpp
#include <hip/hip_runtime.h>
#include <cstdio>
#include <cstdint>
#define MK_ONE_LAUNCH 1
namespace pg8 {
#define PG8_LAS __attribute__((address_space(3)))
typedef unsigned short bf16_t;
typedef short bf16x8 __attribute__((ext_vector_type(8)));
typedef float f32x4 __attribute__((ext_vector_type(4)));
typedef unsigned u32x4 __attribute__((ext_vector_type(4)));
typedef int i32x4 __attribute__((ext_vector_type(4)));
constexpr int BM = 256, BK = 64, HALF = 128, HTB = HALF * BK * 2  , STAGE_BYTES = 8 * HTB, NXCD = 8, WGM = 4;

__host__ __device__ __forceinline__ int lds_byte(int r, int c) { const int st = (r >> 4) * 2 + (c >> 5), rr = r & 15, cc = c & 31, ob = rr * 64 + cc * 2; return st * 1024 + (ob ^ (((ob >> 9) & 1) << 5)); }
__host__ __device__ __forceinline__ void stage_rc(int b, int& R, int& C) { const int st = b / 1024, sb = b % 1024, swz = sb ^ (((sb >> 9) & 1) << 5); R = (st >> 1) * 16 + swz / 64; C = (st & 1) * 32 + (swz % 64) / 2; }
__host__ __device__ __forceinline__ int perm32(int rho) { const int n = rho >> 4, i = rho & 15; return 8 * (i >> 2) + 4 * n + (i & 3); }

struct Unit { int pm, pn; };
struct Gemm { const bf16_t* A; const bf16_t* Bt; int M, N, K; const float* sa; const float* sb; };

struct StaticOrder {
    int nM, nN, nwg, G, c;
    __host__ __device__ void init(int M, int N, int G_, int c_) { nM = M / BM; nN = N / BM; nwg = nM * nN; G = G_; c = c_; }
    __host__ __device__ bool next(int i, Unit& u) const {
        const long L = (long)i * G + c; if (L >= nwg) return false;
        int wgid = (int)L; { const int q = nwg / NXCD, r = nwg % NXCD, xcd = wgid % NXCD, off = wgid / NXCD; wgid = (xcd < r ? xcd * (q + 1) : r * (q + 1) + (xcd - r) * q) + off; }
        const int nig = WGM * nN, gid = wgid / nig, fm = gid * WGM, gsz = (nM - fm) < WGM ? (nM - fm) : WGM;
        u.pm = fm + ((wgid % nig) % gsz); u.pn = (wgid % nig) / gsz; return true;
    }
    __device__ __forceinline__ void a_ready(const Unit&) const {}
    __device__ __forceinline__ void done(const Unit&) const {}
};

__device__ __forceinline__ unsigned cvt_pk_bf16(float lo, float hi) { unsigned r; asm volatile("v_cvt_pk_bf16_f32 %0, %1, %2" : "=v"(r) : "v"(lo), "v"(hi)); return r; }
typedef float f32x2 __attribute__((ext_vector_type(2)));

typedef unsigned u32x2 __attribute__((ext_vector_type(2)));
__device__ __forceinline__ float bf_lo(unsigned w) { return __uint_as_float(w << 16); }
__device__ __forceinline__ float bf_hi(unsigned w) { return __uint_as_float(w & 0xffff0000u); }
__device__ __forceinline__ float sigmoidf_(float x) { return 1.f / (1.f + __expf(-x)); }

template <int ACT> struct EpiBf16 {
    static constexpr bool PERM = true, AFTER_DRAIN = false, SELF_SCALE = false;
    bf16_t* O; int ldc;
    __device__ __forceinline__ void operator()(const f32x4 (&acc)[2][2][4][2], const Unit& u, int wr, int wc, int fr, int fq) const {
        const int row0 = u.pm * BM + wr * 64 + fr; const int col0 = u.pn * BM + wc * 32 + 8 * fq;
#pragma unroll
        for (int ai = 0; ai < 2; ++ai)
#pragma unroll
            for (int m = 0; m < 4; ++m) { bf16_t* rowp = O + (size_t)(row0 + ai * HALF + m * 16) * ldc + col0;
#pragma unroll
                for (int bj = 0; bj < 2; ++bj) { f32x4 v0 = acc[ai][bj][m][0], v1 = acc[ai][bj][m][1];
                    if (ACT == 1) {
#pragma unroll
                        for (int e = 0; e < 4; ++e) { v0[e] = sigmoidf_(v0[e]); v1[e] = sigmoidf_(v1[e]); } }
                    u32x4 w; w.x = cvt_pk_bf16(v0[0], v0[1]); w.y = cvt_pk_bf16(v0[2], v0[3]); w.z = cvt_pk_bf16(v1[0], v1[1]); w.w = cvt_pk_bf16(v1[2], v1[3]);
                    *(u32x4*)(rowp + bj * HALF) = w; } }
    }
};
struct EpiGateMulF32 {
    static constexpr bool PERM = true, AFTER_DRAIN = false, SELF_SCALE = false;
    bf16_t* MA; int ldc; const bf16_t* G; int ldg; int gcol0;
    __device__ __forceinline__ void operator()(const f32x4 (&acc)[2][2][4][2], const Unit& u, int wr, int wc, int fr, int fq) const {
        const int row0 = u.pm * BM + wr * 64 + fr, col0 = u.pn * BM + wc * 32 + 8 * fq;
#pragma unroll
        for (int ai = 0; ai < 2; ++ai)
#pragma unroll
            for (int m = 0; m < 4; ++m) { const size_t r = (size_t)(row0 + ai * HALF + m * 16); bf16_t* rowp = MA + r * ldc + col0; const bf16_t* gp = G + r * ldg + gcol0 + col0;
#pragma unroll
                for (int bj = 0; bj < 2; ++bj) { const u32x4 g = *(const u32x4*)(gp + bj * HALF); const f32x4 a0 = acc[ai][bj][m][0], a1 = acc[ai][bj][m][1];
                    u32x4 w; w.x = cvt_pk_bf16(a0[0] * bf_lo(g.x), a0[1] * bf_hi(g.x)); w.y = cvt_pk_bf16(a0[2] * bf_lo(g.y), a0[3] * bf_hi(g.y));
                    w.z = cvt_pk_bf16(a1[0] * bf_lo(g.z), a1[1] * bf_hi(g.z)); w.w = cvt_pk_bf16(a1[2] * bf_lo(g.w), a1[3] * bf_hi(g.w));
                    *(u32x4*)(rowp + bj * HALF) = w; } }
    }
};
struct EpiGateMulAddBf16 {
    static constexpr bool PERM = true, AFTER_DRAIN = false, SELF_SCALE = false;
    bf16_t* MB; int ldc; const bf16_t* MA; const bf16_t* G; int ldg; int gcol0;
    __device__ __forceinline__ void operator()(const f32x4 (&acc)[2][2][4][2], const Unit& u, int wr, int wc, int fr, int fq) const {
        const int row0 = u.pm * BM + wr * 64 + fr, col0 = u.pn * BM + wc * 32 + 8 * fq;
#pragma unroll
        for (int ai = 0; ai < 2; ++ai)
#pragma unroll
            for (int m = 0; m < 4; ++m) { const size_t r = (size_t)(row0 + ai * HALF + m * 16); bf16_t* rowp = MB + r * ldc + col0; const bf16_t* mp = MA + r * ldc + col0; const bf16_t* gp = G + r * ldg + gcol0 + col0;
#pragma unroll
                for (int bj = 0; bj < 2; ++bj) { const u32x4 g = *(const u32x4*)(gp + bj * HALF); const u32x4 mm = *(const u32x4*)(mp + bj * HALF);
                    const f32x4 a0 = acc[ai][bj][m][0], a1 = acc[ai][bj][m][1];
                    u32x4 w; w.x = cvt_pk_bf16(bf_lo(mm.x) + a0[0] * bf_lo(g.x), bf_hi(mm.x) + a0[1] * bf_hi(g.x)); w.y = cvt_pk_bf16(bf_lo(mm.y) + a0[2] * bf_lo(g.y), bf_hi(mm.y) + a0[3] * bf_hi(g.y));
                    w.z = cvt_pk_bf16(bf_lo(mm.z) + a1[0] * bf_lo(g.z), bf_hi(mm.z) + a1[1] * bf_hi(g.z)); w.w = cvt_pk_bf16(bf_lo(mm.w) + a1[2] * bf_lo(g.w), bf_hi(mm.w) + a1[3] * bf_hi(g.w));
                    *(u32x4*)(rowp + bj * HALF) = w; } }
    }
};
struct EpiResid {
    static constexpr bool PERM = false, AFTER_DRAIN = false, SELF_SCALE = false;
    const float* smeta; const float* sreal; float* dmeta; float* dreal; int ld; int nmeta; int nrows;
    __device__ __forceinline__ void operator()(const f32x4 (&acc)[2][2][4][2], const Unit& u, int wr, int wc, int fr, int fq) const {
        const int row0 = u.pm * BM + wr * 64 + fr, col0 = u.pn * BM + wc * 32 + 4 * fq;
#pragma unroll
        for (int ai = 0; ai < 2; ++ai)
#pragma unroll
            for (int m = 0; m < 4; ++m) { const int r = row0 + ai * HALF + m * 16;
                if (r < nrows) {
                    const float* sp = (r < nmeta ? smeta + (size_t)r * ld : sreal + (size_t)(r - nmeta) * ld) + col0;
                    float* dp = (r < nmeta ? dmeta + (size_t)r * ld : dreal + (size_t)(r - nmeta) * ld) + col0;
#pragma unroll
                    for (int bj = 0; bj < 2; ++bj)
#pragma unroll
                        for (int n = 0; n < 2; ++n) *(f32x4*)(dp + bj * HALF + n * 16) = *(const f32x4*)(sp + bj * HALF + n * 16) + acc[ai][bj][m][n];
                } }
    }
};

template <int CTRL> __device__ __forceinline__ float dpp_mov(float v) { return __builtin_bit_cast(float, __builtin_amdgcn_update_dpp(0, __builtin_bit_cast(int, v), CTRL, 0xf, 0xf, false)); }
struct EpiConvAct {
    static constexpr bool PERM = true, AFTER_DRAIN = false, SELF_SCALE = true;
    bf16_t* ACT; int ldact; float* HALO; int ldh; const float* cw; const float* cb; int dff; PG8_LAS float* hx; const float* sag; const float* sb;
    __device__ __forceinline__ void operator()(const f32x4 (&acc)[2][2][4][2], const Unit& u, int wr, int wc, int fr, int fq) const {
        const int cl = wc * 32 + 8 * fq;
        const int ch = u.pn * 128 + cl;
        if (fr >= 14) {
#pragma unroll
            for (int ai = 0; ai < 2; ++ai)
#pragma unroll
                for (int bj = 0; bj < 2; ++bj)
#pragma unroll
                    for (int n = 0; n < 2; ++n) *(PG8_LAS f32x4*)(hx + (((ai * 2 + wr) * 2 + (fr - 14)) * 256 + bj * 128 + cl + 4 * n)) = acc[ai][bj][3][n];
        }
        if (wr == 0 && fr < 2) {
            float* hp = HALO + ((size_t)u.pm * 4 + fr) * ldh + u.pn * 256 + cl;
#pragma unroll
            for (int bj = 0; bj < 2; ++bj)
#pragma unroll
                for (int n = 0; n < 2; ++n) *(f32x4*)(hp + bj * 128 + 4 * n) = acc[0][bj][0][n] * (*(const f32x4*)(sb + u.pn * 256 + bj * 128 + cl + 4 * n) * sag[0]);
        }
        if (wr == 1 && fr >= 14) {
            float* hp = HALO + ((size_t)u.pm * 4 + (fr - 12)) * ldh + u.pn * 256 + cl;
#pragma unroll
            for (int bj = 0; bj < 2; ++bj)
#pragma unroll
                for (int n = 0; n < 2; ++n) *(f32x4*)(hp + bj * 128 + 4 * n) = acc[1][bj][3][n] * (*(const f32x4*)(sb + u.pn * 256 + bj * 128 + cl + 4 * n) * sag[0]);
        }
        asm volatile("s_waitcnt lgkmcnt(0)" ::: "memory"); __builtin_amdgcn_s_barrier(); asm volatile("" ::: "memory");
#pragma unroll
        for (int n = 0; n < 2; ++n) {
            f32x4 wt[2][3], bb[2];
#pragma unroll
            for (int bj = 0; bj < 2; ++bj) { bb[bj] = *(const f32x4*)(cb + bj * dff + ch + 4 * n);
#pragma unroll
                for (int i = 0; i < 3; ++i) wt[bj][i] = *(const f32x4*)(cw + (size_t)i * 2 * dff + bj * dff + ch + 4 * n) * (*(const f32x4*)(sb + u.pn * 256 + bj * 128 + cl + 4 * n) * sag[0]); }
#pragma unroll
            for (int ai = 0; ai < 2; ++ai) {
                const bool hasprev = (ai | wr) != 0; const int pb = ai * 2 + wr - 1;
                f32x4 xp[2];
#pragma unroll
                for (int bj = 0; bj < 2; ++bj) { xp[bj] = (f32x4){0.f, 0.f, 0.f, 0.f};
                    if (hasprev && fr >= 14) xp[bj] = *(const PG8_LAS f32x4*)(hx + ((pb * 2 + (fr - 14)) * 256 + bj * 128 + cl + 4 * n)); }
#pragma unroll
                for (int m = 0; m < 4; ++m) {
                    f32x4 z[2];
#pragma unroll
                    for (int bj = 0; bj < 2; ++bj) {
                        const f32x4 x = acc[ai][bj][m][n];
#pragma unroll
                        for (int j = 0; j < 4; ++j) {
                            const float a1 = dpp_mov<0x121>(x[j]), p1 = dpp_mov<0x121>(xp[bj][j]), a2 = dpp_mov<0x122>(x[j]), p2 = dpp_mov<0x122>(xp[bj][j]);
                            const float s1 = fr == 0 ? p1 : a1, s2 = fr < 2 ? p2 : a2;
                            z[bj][j] = bb[bj][j] + wt[bj][2][j] * x[j] + wt[bj][1][j] * s1 + wt[bj][0][j] * s2;
                        }
                        xp[bj] = x;
                    }
                    const int r = u.pm * BM + ai * HALF + wr * 64 + m * 16 + fr;
                    float o[4];
#pragma unroll
                    for (int j = 0; j < 4; ++j) { const float g = z[0][j]; o[j] = g * __builtin_amdgcn_rcpf(1.f + __expf(-g)) * z[1][j]; }
                    u32x2 w; w.x = cvt_pk_bf16(o[0], o[1]); w.y = cvt_pk_bf16(o[2], o[3]);
                    *(u32x2*)(ACT + (size_t)r * ldact + ch + 4 * n) = w;
                }
                asm volatile("" ::: "memory");
            }
        }
    }
};
template <class Epi, class Sched, bool ALIGN_EPI = false, bool SP2 = false, bool I8 = false>
__device__ __forceinline__ void gemm_phase(PG8_LAS unsigned char* lds, const Gemm g, const Sched& S, const Epi& E) {
    const int tid = threadIdx.x, wid = __builtin_amdgcn_readfirstlane(tid >> 6), lane = tid & 63, wr = wid >> 2, wc = wid & 3, fr = lane & 15, fq = lane >> 4;
    const int K = g.K, nt = K / BK;
    unsigned voffA[2], voffB[2];
#pragma unroll
    for (int i = 0; i < 2; ++i) { int R, C; stage_rc(tid * 16 + i * 8192, R, C); const int Rb = Epi::PERM ? ((R & ~31) + perm32(R & 31)) : R;
        voffA[i] = (unsigned)(R * K + C) * 2u; voffB[i] = (unsigned)(Rb * K + C) * 2u; }
    const size_t kstep = (size_t)(BK * 2);
    const size_t hstep = (size_t)HALF * K * 2;
    const size_t tstep = 2 * hstep;
    const unsigned ldsw = (unsigned)wid * 1024u;
    const int aoff = lds_byte(wr * 64 + fr, fq * 8), boff = lds_byte(wc * 32 + fr, fq * 8);
#define PG8_SA(b, h) (((b) * 2 + (h)) * HTB)
#define PG8_SB(b, h) ((4 + (b) * 2 + (h)) * HTB)
#define PG8_STAGE(bufoff, gbase, voff) do { _Pragma("unroll") for (int _i = 0; _i < 2; ++_i) \
        __builtin_amdgcn_global_load_lds((const unsigned*)((const char*)(gbase) + (voff)[_i]), (PG8_LAS unsigned*)(lds + (bufoff) + ldsw + _i * 8192), 16, 0, 0); } while (0)
#define PG8_LDA(dst, b, h) do { _Pragma("unroll") for (int m = 0; m < 4; ++m) _Pragma("unroll") for (int k = 0; k < 2; ++k) dst[m][k] = *(const PG8_LAS bf16x8*)(lds + PG8_SA(b, h) + aoff + m * 2048 + k * 1024); } while (0)
#define PG8_LDB(dst, b, h) do { _Pragma("unroll") for (int n = 0; n < 2; ++n) _Pragma("unroll") for (int k = 0; k < 2; ++k) dst[n][k] = *(const PG8_LAS bf16x8*)(lds + PG8_SB(b, h) + boff + n * 2048 + k * 1024); } while (0)
#define PG8_MMA(ai, bj, At, Bt) do { __builtin_amdgcn_s_setprio(1); _Pragma("unroll") for (int m = 0; m < 4; ++m) _Pragma("unroll") for (int n = 0; n < 2; ++n) _Pragma("unroll") for (int k = 0; k < 2; ++k) { \
        if constexpr (I8) acc[ai][bj][m][n] = __builtin_bit_cast(f32x4, __builtin_amdgcn_mfma_i32_16x16x64_i8(__builtin_bit_cast(i32x4, Bt[n][k]), __builtin_bit_cast(i32x4, At[m][k]), __builtin_bit_cast(i32x4, acc[ai][bj][m][n]), 0, 0, 0)); \
        else acc[ai][bj][m][n] = __builtin_amdgcn_mfma_f32_16x16x32_bf16(Bt[n][k], At[m][k], acc[ai][bj][m][n], 0, 0, 0); } __builtin_amdgcn_s_setprio(0); } while (0)
#define PG8_WAIT_V(n) asm volatile("s_waitcnt vmcnt(" #n ")" ::: "memory")
#define PG8_WAIT_L(n) asm volatile("s_waitcnt lgkmcnt(" #n ")" ::: "memory")
#define PG8_BAR __builtin_amdgcn_s_barrier()
#define PG8_SCHED __builtin_amdgcn_sched_barrier(0)
    Unit cur, nxt; int ui = 0;
    if (!S.next(0, cur)) return;
    f32x4 acc[2][2][4][2];
#pragma unroll
    for (int a = 0; a < 2; ++a)
#pragma unroll
        for (int b = 0; b < 2; ++b)
#pragma unroll
            for (int m = 0; m < 4; ++m)
#pragma unroll
                for (int n = 0; n < 2; ++n) acc[a][b][m][n] = (f32x4){0.f, 0.f, 0.f, 0.f};
    bf16x8 At[4][2], B0[2][2], B1[2][2];
    const char* cA = (const char*)g.A + (size_t)cur.pm * tstep; const char* cB = (const char*)g.Bt + (size_t)cur.pn * tstep;
    S.a_ready(cur);
    if constexpr (SP2) {
        PG8_STAGE(PG8_SB(0, 0), cB, voffB); PG8_STAGE(PG8_SB(0, 1), cB + hstep, voffB); PG8_STAGE(PG8_SA(0, 0), cA, voffA); PG8_STAGE(PG8_SA(0, 1), cA + hstep, voffA);
        if (wr == 1) PG8_BAR;
        PG8_WAIT_V(2); PG8_BAR;
        PG8_STAGE(PG8_SB(1, 0), cB + kstep, voffB); PG8_STAGE(PG8_SA(1, 0), cA + kstep, voffA); PG8_STAGE(PG8_SB(1, 1), cB + hstep + kstep, voffB);
        PG8_WAIT_V(6); PG8_BAR;
    } else {
        PG8_STAGE(PG8_SB(0, 0), cB, voffB); PG8_STAGE(PG8_SA(0, 0), cA, voffA); PG8_STAGE(PG8_SB(0, 1), cB + hstep, voffB); PG8_STAGE(PG8_SA(0, 1), cA + hstep, voffA);
        if (wr == 1) PG8_BAR;
        PG8_WAIT_V(4); PG8_BAR;
        PG8_STAGE(PG8_SB(1, 0), cB + kstep, voffB); PG8_STAGE(PG8_SA(1, 0), cA + kstep, voffA); PG8_STAGE(PG8_SB(1, 1), cB + hstep + kstep, voffB);
        PG8_WAIT_V(6); PG8_BAR;
    }
    for (;;) {
        const bool has_next = S.next(ui + 1, nxt);
        const char* nA = has_next ? (const char*)g.A + (size_t)nxt.pm * tstep : cA; const char* nB = has_next ? (const char*)g.Bt + (size_t)nxt.pn * tstep : cB;
        for (int t = 0; t < nt; t += 2) {
            const bool last = (t == nt - 2);
            const char* a1 = cA + (size_t)(t + 1) * kstep;
            const char* a2 = last ? nA : cA + (size_t)(t + 2) * kstep; const char* b2 = last ? nB : cB + (size_t)(t + 2) * kstep;
            const char* a3 = a2 + kstep; const char* b3 = b2 + kstep;
            if (last && has_next) S.a_ready(nxt);
            if constexpr (SP2) {
            PG8_LDB(B0, 0, 0); PG8_LDB(B1, 0, 1); PG8_SCHED; PG8_LDA(At, 0, 0); PG8_STAGE(PG8_SA(1, 1), a1 + hstep, voffA);
            PG8_WAIT_V(8); PG8_WAIT_L(0); PG8_BAR; PG8_MMA(0, 0, At, B0); PG8_MMA(0, 1, At, B1); PG8_BAR; PG8_SCHED;
            PG8_LDA(At, 0, 1); PG8_STAGE(PG8_SB(0, 0), b2, voffB); PG8_STAGE(PG8_SB(0, 1), b2 + hstep, voffB); PG8_STAGE(PG8_SA(0, 0), a2, voffA);
            PG8_WAIT_V(8); PG8_WAIT_L(0); PG8_BAR; PG8_MMA(1, 0, At, B0); PG8_MMA(1, 1, At, B1); PG8_BAR; PG8_SCHED;
            PG8_LDB(B0, 1, 0); PG8_LDB(B1, 1, 1); PG8_SCHED; PG8_LDA(At, 1, 0); PG8_STAGE(PG8_SA(0, 1), a2 + hstep, voffA);
            PG8_WAIT_V(8); PG8_WAIT_L(0); PG8_BAR; PG8_MMA(0, 0, At, B0); PG8_MMA(0, 1, At, B1); PG8_BAR; PG8_SCHED;
            PG8_LDA(At, 1, 1); PG8_STAGE(PG8_SB(1, 0), b3, voffB); PG8_STAGE(PG8_SB(1, 1), b3 + hstep, voffB); PG8_STAGE(PG8_SA(1, 0), a3, voffA);
            PG8_WAIT_V(8); PG8_WAIT_L(0); PG8_BAR; PG8_MMA(1, 0, At, B0); PG8_MMA(1, 1, At, B1); PG8_BAR; PG8_SCHED;
            } else {
            PG8_LDB(B0, 0, 0); PG8_SCHED; PG8_LDA(At, 0, 0); PG8_STAGE(PG8_SA(1, 1), a1 + hstep, voffA);
            PG8_WAIT_L(8); PG8_BAR; PG8_WAIT_L(0); PG8_MMA(0, 0, At, B0); PG8_BAR; PG8_SCHED;
            PG8_LDB(B1, 0, 1); PG8_STAGE(PG8_SB(0, 0), b2, voffB);
            PG8_BAR; PG8_WAIT_L(0); PG8_MMA(0, 1, At, B1); PG8_BAR;
            PG8_LDA(At, 0, 1); PG8_STAGE(PG8_SA(0, 0), a2, voffA);
            PG8_BAR; PG8_WAIT_L(0); PG8_MMA(1, 0, At, B0); PG8_BAR; PG8_SCHED;
            PG8_STAGE(PG8_SB(0, 1), b2 + hstep, voffB);
            PG8_WAIT_V(6); PG8_BAR; PG8_MMA(1, 1, At, B1); PG8_BAR;
            PG8_LDB(B0, 1, 0); PG8_SCHED; PG8_LDA(At, 1, 0); PG8_STAGE(PG8_SA(0, 1), a2 + hstep, voffA);
            PG8_WAIT_L(8); PG8_BAR; PG8_WAIT_L(0); PG8_MMA(0, 0, At, B0); PG8_BAR; PG8_SCHED;
            PG8_LDB(B1, 1, 1); PG8_STAGE(PG8_SB(1, 0), b3, voffB);
            PG8_BAR; PG8_WAIT_L(0); PG8_MMA(0, 1, At, B1); PG8_BAR;
            PG8_LDA(At, 1, 1); PG8_STAGE(PG8_SA(1, 0), a3, voffA);
            PG8_BAR; PG8_WAIT_L(0); PG8_MMA(1, 0, At, B0); PG8_BAR; PG8_SCHED;
            PG8_STAGE(PG8_SB(1, 1), b3 + hstep, voffB);
            PG8_WAIT_V(6); PG8_BAR; PG8_MMA(1, 1, At, B1); PG8_BAR;
            }
        }
        if constexpr (ALIGN_EPI) { if (wr == 0) PG8_BAR; }
        if constexpr (I8) {
            asm volatile("s_nop 15\n\ts_nop 15" ::: "memory");
#pragma unroll
            for (int ai = 0; ai < 2; ++ai)
#pragma unroll
                for (int bj = 0; bj < 2; ++bj)
#pragma unroll
                    for (int m = 0; m < 4; ++m)
#pragma unroll
                        for (int n = 0; n < 2; ++n)
#pragma unroll
                            for (int j = 0; j < 4; ++j) { float x = acc[ai][bj][m][n][j]; asm volatile("v_cvt_f32_i32 %0, %0" : "+v"(x)); acc[ai][bj][m][n][j] = x; }
            if constexpr (!Epi::SELF_SCALE) {
                const int row0 = cur.pm * BM + wr * 64 + fr, col0 = cur.pn * BM + wc * 32 + (Epi::PERM ? 8 * fq : 4 * fq);
#pragma unroll
                for (int bj = 0; bj < 2; ++bj)
#pragma unroll
                    for (int n = 0; n < 2; ++n) { const f32x4 sc = *(const f32x4*)(g.sb + col0 + bj * HALF + (Epi::PERM ? 4 * n : 16 * n));
#pragma unroll
                        for (int ai = 0; ai < 2; ++ai)
#pragma unroll
                            for (int m = 0; m < 4; ++m) { const float sr = g.sa[row0 + ai * HALF + m * 16]; acc[ai][bj][m][n] = acc[ai][bj][m][n] * (sc * sr); } }
            }
        }
        if constexpr (!Epi::AFTER_DRAIN) { E(acc, cur, wr, wc, fr, fq); S.done(cur); }
        if (!has_next) break;
#pragma unroll
        for (int a = 0; a < 2; ++a)
#pragma unroll
            for (int b = 0; b < 2; ++b)
#pragma unroll
                for (int m = 0; m < 4; ++m)
#pragma unroll
                    for (int n = 0; n < 2; ++n) acc[a][b][m][n] = (f32x4){0.f, 0.f, 0.f, 0.f};
        cur = nxt; cA = nA; cB = nB; ++ui;
        if constexpr (ALIGN_EPI) { if (wr == 1) PG8_BAR; }
    }
    PG8_WAIT_V(0);
    if constexpr (!ALIGN_EPI) { if (wr == 0) PG8_BAR; }
    PG8_BAR;
    if constexpr (Epi::AFTER_DRAIN) { E.fused(acc, cur, wr, wc, fr, fq, lds, wid, lane); S.done(cur); }
#undef PG8_SA
#undef PG8_SB
#undef PG8_STAGE
#undef PG8_LDA
#undef PG8_LDB
#undef PG8_MMA
#undef PG8_WAIT_V
#undef PG8_WAIT_L
#undef PG8_BAR
#undef PG8_SCHED
}
}
#define XB_TMO      128
#define XB_XCNT(j)  (256  + 64 * (j))
#define XB_XSUB(j)  (1280 + 64 * (j))
#define XB_XGEN(j)  (2304 + 64 * (j))
#define XB_TOP      3328
#define XB_TOPGEN   3392
#define XCD_BAR_WORDS 3456
#define XB_SPIN_CAP (1u << 18)
#define LAS __attribute__((address_space(3)))

__device__ __forceinline__ unsigned xb_ld(unsigned* p)              { return __hip_atomic_load(p, __ATOMIC_RELAXED, __HIP_MEMORY_SCOPE_AGENT); }
__device__ __forceinline__ unsigned xb_add(unsigned* p, unsigned v) { return __hip_atomic_fetch_add(p, v, __ATOMIC_RELAXED, __HIP_MEMORY_SCOPE_AGENT); }
__device__ __forceinline__ unsigned xb_xcc_id() { return (unsigned)__builtin_amdgcn_s_getreg((3 << 11) | 20) & 0xFu; }
#define XB_SPIN(cond, bar) do { unsigned _sp = 0; while (cond) { __builtin_amdgcn_s_sleep(1); \
    if ((++_sp & 255u) == 0u) { if (xb_ld(&(bar)[XB_TMO])) break; if (_sp > XB_SPIN_CAP) { atomicAdd(&(bar)[XB_TMO], 1u); break; } } } } while (0)

struct XcdBarrier {
    unsigned* bar; unsigned x;
    volatile LAS unsigned* st;
};

__device__ __forceinline__ XcdBarrier xcd_barrier_post(unsigned* bar, volatile LAS unsigned* st) {
    XcdBarrier b; b.bar = bar; b.x = xb_xcc_id(); b.st = st;
    if (threadIdx.x == 0) (void)xb_add(&bar[XB_XCNT(b.x)], 1u);
    return b;
}
__device__ __forceinline__ void xcd_barrier_complete(unsigned* bar, unsigned x, unsigned& nloc, unsigned& nx) {
    const unsigned G = gridDim.x * gridDim.y * gridDim.z;
    unsigned sum, cnt, mine, sp = 0u;
    for (;;) {
        sum = 0u; cnt = 0u; mine = 0u;
#pragma unroll
        for (unsigned j = 0; j < 16; ++j) { const unsigned c = xb_ld(&bar[XB_XCNT(j)]); sum += c; cnt += (c > 0u) ? 1u : 0u; mine = (j == x) ? c : mine; }
        if (sum == G) break;
        __builtin_amdgcn_s_sleep(1);
        if ((++sp & 255u) == 0u) { if (xb_ld(&bar[XB_TMO])) break; if (sp > XB_SPIN_CAP) { atomicAdd(&bar[XB_TMO], 1u); break; } }
    }
    nloc = mine > 0u ? mine : 1u; nx = cnt > 0u ? cnt : 1u;
}

__device__ __forceinline__ void xcd_barrier(const XcdBarrier& b) {
    asm volatile("s_waitcnt vmcnt(0)" ::: "memory");
    __syncthreads();
    if (threadIdx.x == 0) {
        unsigned* bar = b.bar;
        __builtin_amdgcn_s_waitcnt(0);
        unsigned nloc = b.st[0], nx = b.st[1];
        if (nloc == 0u) { xcd_barrier_complete(bar, b.x, nloc, nx); b.st[0] = nloc; b.st[1] = nx; }
        const unsigned old = xb_add(&bar[XB_XSUB(b.x)], 1u);
        const unsigned gen = old / nloc;
        if (old + 1u == (gen + 1u) * nloc) {
            __builtin_amdgcn_fence(__ATOMIC_RELEASE, "agent");
            asm volatile("s_waitcnt vmcnt(0)" ::: "memory");
            const unsigned og = xb_add(&bar[XB_TOP], 1u);
            const unsigned tg = og / nx;
            if (og + 1u == (tg + 1u) * nx) xb_add(&bar[XB_TOPGEN], 1u);
            else XB_SPIN(xb_ld(&bar[XB_TOPGEN]) == tg, bar);
            __builtin_amdgcn_fence(__ATOMIC_ACQUIRE, "agent");
            xb_add(&bar[XB_XGEN(b.x)], 1u);
            asm volatile("s_waitcnt vmcnt(0)" ::: "memory");
        } else {
            XB_SPIN(xb_ld(&bar[XB_XGEN(b.x)]) == gen, bar);
            __builtin_amdgcn_fence(__ATOMIC_ACQUIRE, "agent");
            asm volatile("s_waitcnt vmcnt(0)" ::: "memory");
        }
    }
    __syncthreads();
}

#define LAS __attribute__((address_space(3)))
typedef unsigned short bf16_t;
typedef float f32x4 __attribute__((ext_vector_type(4)));
typedef unsigned u32x4 __attribute__((ext_vector_type(4)));
typedef unsigned u32x2 __attribute__((ext_vector_type(2)));

#ifndef MK_ONE_LAUNCH
#define MK_ONE_LAUNCH 0
#endif

constexpr int NWAVES = 8, NT = NWAVES * 64;
constexpr int D = 4096, SEQ = 16384, NMETA = 16, L = SEQ + NMETA, MP = 16640;
constexpr int A_W = 2048, A_COLS = 6592, B_COLS = 4704, IN_COLS = A_COLS + B_COLS, NZ = 11520;
constexpr int ZQ = A_COLS, ZCKV = A_COLS + 2048, ZQI = A_COLS + 2560, ZKI = A_COLS + 4608, ZWI = A_COLS + 4672;
constexpr int DFF = 11008, NFI = 2 * DFF;
constexpr int KVR = 512, NH_B = 16, HD_B = 128, IDXH = 32, IDXD = 64, TOPK = 256;
constexpr int LDS_BYTES = 163840, MISC_OFF = 163584;
constexpr int NZ8 = 8960;
constexpr size_t WINT_BF_OFF = (size_t)40 << 20;

constexpr size_t al256(size_t x) { return (x + 255) & ~(size_t)255; }
constexpr size_t WS_CTL = 0, CTL_BYTES = 1u << 20;
constexpr size_t WS_WGT = WS_CTL + CTL_BYTES;
constexpr size_t WS_WPAT = WS_WGT + (size_t)8192 * 4096 * 2;
constexpr size_t WS_WPBT = WS_WPAT + (size_t)4096 * 2048 * 2;
constexpr size_t WS_WOUTT = WS_WPBT + (size_t)4096 * 2048 * 2;
constexpr size_t WS_WFIT = WS_WOUTT + (size_t)4096 * 4096 * 2;
constexpr size_t WS_WFOT = WS_WFIT + (size_t)NFI * 4096 * 2;
constexpr size_t WS_WINT = WS_WFOT + (size_t)4096 * DFF * 2;
constexpr size_t WS_U = WS_WINT + (size_t)NZ * 4096 * 2;
constexpr size_t WS_BIG = WS_U + (size_t)MP * D * 2;
constexpr size_t WS_Z = WS_BIG;
constexpr size_t WS_R1 = WS_Z + (size_t)MP * NZ * 2;
constexpr size_t R1_BYTES = (size_t)MP * D * 4;
constexpr size_t WS_LD = WS_R1;
constexpr size_t WS_AA = WS_LD + (size_t)L * A_W * 4;
constexpr size_t WS_GG = WS_AA + (size_t)L * A_W * 2;
constexpr size_t WS_QLAT = WS_R1;
constexpr size_t WS_MF = WS_R1;
constexpr size_t WS_YA = WS_R1 + R1_BYTES;
constexpr size_t WS_YB = WS_YA + (size_t)MP * A_W * 2;
constexpr size_t WS_END = WS_YB + (size_t)MP * A_W * 2;
constexpr size_t WS_GATES = WS_Z;
constexpr size_t WS_ZF = WS_BIG;
constexpr size_t WS_ACT = WS_BIG + (size_t)MP * DFF * 2;
constexpr size_t WS_CKV = WS_WINT;
constexpr size_t WS_KIDX = WS_CKV + al256((size_t)L * KVR * 2);
constexpr size_t WS_SEL = WS_KIDX + al256((size_t)L * IDXD * 4);
constexpr size_t WS_HMETA = WS_SEL + al256((size_t)L * TOPK * 4);
static_assert(WS_HMETA + (size_t)NMETA * D * 4 <= WS_U, "DSA overlays exceed WINT");
constexpr size_t WS_KIDXB = WS_HMETA + al256((size_t)NMETA * D * 4);
static_assert(WS_KIDXB + (size_t)L * IDXD * 2 <= WS_U, "KIDXB");
constexpr size_t WS_WUKB = WS_END;
constexpr size_t WS_WUVT = WS_WUKB + (size_t)16 * 512 * 128 * 2;
constexpr size_t WS_WLT = WS_WUVT + (size_t)16 * 512 * 128 * 2;
constexpr size_t WS_END2 = WS_WLT + (size_t)2048 * 448 * 2;
static_assert(WS_END2 <= (size_t)4 * 4096 * 22016 * 4, "workspace");
constexpr size_t CT_CMX_IN = 524288, CT_CMX_G = CT_CMX_IN + (size_t)NZ * 4, CT_CMX_F = CT_CMX_G + 8192 * 4, CT_SB_IN = CT_CMX_F + (size_t)NFI * 4, CT_SB_G = CT_SB_IN + (size_t)NZ * 4,
                 CT_SB_F = CT_SB_G + 8192 * 4, CT_SA = CT_SB_F + (size_t)NFI * 4, CT_AMAX = CT_SA + (size_t)MP * 4, CT_SAG = CT_AMAX + 256, CT_END = CT_SAG + 256;
static_assert(CT_END <= CTL_BYTES, "control region");
constexpr size_t WS_ST = WS_WINT;
constexpr size_t WS_BS = WS_ST + al256((size_t)257 * 32 * 4096 * 2);
static_assert(WS_BS + (size_t)L * 32 * 4 <= WS_U, "RWKV overlays exceed WINT");
static_assert((size_t)L * A_W * 4 + 2 * (size_t)L * A_W * 2 <= R1_BYTES && (size_t)L * 8192 * 2 <= R1_BYTES, "R1");
static_assert(WS_ACT + (size_t)MP * DFF * 2 <= WS_END, "ACT");
static_assert((size_t)MP * 8192 * 2 <= (size_t)MP * NZ * 2, "GATES");
static_assert(WS_END <= (size_t)4 * 4096 * 22016 * 4, "workspace");

__device__ __forceinline__ float bf2f(bf16_t b) { return __uint_as_float(((unsigned)b) << 16); }
__device__ __forceinline__ bf16_t f2bf(float f) { unsigned u = __float_as_uint(f); u += 0x7FFFu + ((u >> 16) & 1u); return (bf16_t)(u >> 16); }
__device__ __forceinline__ unsigned pk2(float lo, float hi) { return (unsigned)f2bf(lo) | ((unsigned)f2bf(hi) << 16); }
__device__ __forceinline__ float blo(unsigned w) { return __uint_as_float(w << 16); }
__device__ __forceinline__ float bhi(unsigned w) { return __uint_as_float(w & 0xffff0000u); }
__device__ __forceinline__ float sigm(float x) { return 1.f / (1.f + __expf(-x)); }
template <int CTRL> __device__ __forceinline__ float dpp_f(float v) { return __builtin_bit_cast(float, __builtin_amdgcn_update_dpp(0, __builtin_bit_cast(int, v), CTRL, 0xf, 0xf, false)); }
__device__ __forceinline__ float wave_sum(float v) {
    v += dpp_f<0xB1>(v);
    v += dpp_f<0x4E>(v);
    v += dpp_f<0x141>(v);
    v += dpp_f<0x140>(v);
    const float a = __builtin_bit_cast(float, __builtin_amdgcn_readlane(__builtin_bit_cast(int, v), 0));
    const float b = __builtin_bit_cast(float, __builtin_amdgcn_readlane(__builtin_bit_cast(int, v), 16));
    const float c = __builtin_bit_cast(float, __builtin_amdgcn_readlane(__builtin_bit_cast(int, v), 32));
    const float d = __builtin_bit_cast(float, __builtin_amdgcn_readlane(__builtin_bit_cast(int, v), 48));
    return (a + b) + (c + d);
}
__device__ __forceinline__ float wave_max(float v) {
    v = fmaxf(v, dpp_f<0xB1>(v)); v = fmaxf(v, dpp_f<0x4E>(v)); v = fmaxf(v, dpp_f<0x141>(v)); v = fmaxf(v, dpp_f<0x140>(v));
    const float a = __builtin_bit_cast(float, __builtin_amdgcn_readlane(__builtin_bit_cast(int, v), 0));
    const float b = __builtin_bit_cast(float, __builtin_amdgcn_readlane(__builtin_bit_cast(int, v), 16));
    const float c = __builtin_bit_cast(float, __builtin_amdgcn_readlane(__builtin_bit_cast(int, v), 32));
    const float d = __builtin_bit_cast(float, __builtin_amdgcn_readlane(__builtin_bit_cast(int, v), 48));
    return fmaxf(fmaxf(a, b), fmaxf(c, d));
}
#define LDS_WAIT() asm volatile("s_waitcnt lgkmcnt(0)" ::: "memory")

struct P {
    const float* in[30]; float* out; unsigned char* ws; int ph_lo, ph_hi;
};
enum { I_X = 0, I_META, I_NMW, I_WIN, I_MU, I_W0, I_W2, I_A0, I_A2, I_G2, I_KK, I_KA, I_RK, I_LNW, I_LNB, I_KVNW, I_WUK, I_WUV, I_ILNW, I_ILNB,
       I_WPA, I_WPB, I_WGATE, I_WOUT, I_NFW, I_WFI, I_CW, I_CB, I_WFO, I_NFIN };

template <int MODE>
__device__ __forceinline__ void tr_item(const float* W, int K, int N, int Npad, bf16_t* WT, LAS float* scr, int item, int lane) {
    const int nblk = Npad / 32, kb = item / nblk, nb = item % nblk, k0 = 64 * kb, n0 = 32 * nb;
    int s0 = n0; bool valid = n0 < N;
    if (MODE == 1) { const int T = n0 >> 8, w = n0 & 255; s0 = (w < 128) ? T * 128 + w : DFF + T * 128 + (w - 128); valid = true; }
    if (valid) {
#pragma unroll
        for (int i = 0; i < 8; ++i) { const int kk = 8 * i + (lane >> 3), c4 = 4 * (lane & 7); const f32x4 v_ = *(const f32x4*)(W + (size_t)(k0 + kk) * N + s0 + c4);
            LAS float* d_ = scr + kk * 33 + c4; d_[0] = v_.x; d_[1] = v_.y; d_[2] = v_.z; d_[3] = v_.w; }
    } else {
#pragma unroll 8
        for (int i = 0; i < 32; ++i) { const int kk = 2 * i + (lane >> 5); scr[kk * 33 + (lane & 31)] = 0.f; }
    }
    LDS_WAIT(); __builtin_amdgcn_wave_barrier();
    const int c = lane & 7;
#pragma unroll
    for (int j = 0; j < 4; ++j) { const int n = (lane >> 3) + 8 * j; const LAS float* s = scr + (8 * c) * 33 + n;
        u32x4 o; o.x = pk2(s[0 * 33], s[1 * 33]); o.y = pk2(s[2 * 33], s[3 * 33]); o.z = pk2(s[4 * 33], s[5 * 33]); o.w = pk2(s[6 * 33], s[7 * 33]);
        *(u32x4*)(WT + (size_t)(n0 + n) * K + k0 + 8 * c) = o; }
    LDS_WAIT(); __builtin_amdgcn_wave_barrier();
}
__device__ __forceinline__ void colmax_item(const float* W, int N, unsigned* cmx, int it) {
    const int nb = (N + 2047) / 2048, kc = it / nb, n = (it % nb) * 2048 + threadIdx.x * 4;
    if (n < N) { f32x4 m = {0.f, 0.f, 0.f, 0.f}; const float* wp = W + (size_t)kc * 32 * N + n;
#pragma unroll 8
        for (int k = 0; k < 32; ++k) { const f32x4 v = *(const f32x4*)(wp + (size_t)k * N); m.x = fmaxf(m.x, fabsf(v.x)); m.y = fmaxf(m.y, fabsf(v.y)); m.z = fmaxf(m.z, fabsf(v.z)); m.w = fmaxf(m.w, fabsf(v.w)); }
        atomicMax(cmx + n, __float_as_uint(m.x)); atomicMax(cmx + n + 1, __float_as_uint(m.y)); atomicMax(cmx + n + 2, __float_as_uint(m.z)); atomicMax(cmx + n + 3, __float_as_uint(m.w)); }
}
template <int MODE>
__device__ __forceinline__ void tr_item_i8(const float* W, int K, int N, int Npad, signed char* WT, const unsigned* cmx, float* sbdst, LAS float* scr, int item, int lane) {
    const int nblk = Npad / 32, kb = item / nblk, nb = item % nblk, k0 = 64 * kb, n0 = 32 * nb;
    int s0 = n0; bool valid = n0 < N;
    if (MODE == 1) { const int T = n0 >> 8, w = n0 & 255; s0 = (w < 128) ? T * 128 + w : DFF + T * 128 + (w - 128); valid = true; }
    if (valid) {
#pragma unroll
        for (int i = 0; i < 8; ++i) { const int kk = 8 * i + (lane >> 3), c4 = 4 * (lane & 7); const f32x4 v_ = *(const f32x4*)(W + (size_t)(k0 + kk) * N + s0 + c4);
            LAS float* d_ = scr + kk * 33 + c4; d_[0] = v_.x; d_[1] = v_.y; d_[2] = v_.z; d_[3] = v_.w; }
    } else {
#pragma unroll 8
        for (int i = 0; i < 32; ++i) { const int kk = 2 * i + (lane >> 5); scr[kk * 33 + (lane & 31)] = 0.f; }
    }
    LDS_WAIT(); __builtin_amdgcn_wave_barrier();
    const int n = lane >> 1, half = lane & 1;
    const float mx = valid ? __uint_as_float(cmx[s0 + n]) : 0.f; const float inv = mx > 0.f ? 127.f / mx : 0.f;
    unsigned o[8];
#pragma unroll
    for (int c = 0; c < 8; ++c) { unsigned w = 0u;
#pragma unroll
        for (int e = 0; e < 4; ++e) { const int qv = (int)rintf(scr[(half * 32 + c * 4 + e) * 33 + n] * inv); w |= ((unsigned)qv & 0xffu) << (8 * e); }
        o[c] = w; }
    *(u32x4*)(WT + (size_t)(n0 + n) * K + k0 + half * 32) = (u32x4){o[0], o[1], o[2], o[3]};
    *(u32x4*)(WT + (size_t)(n0 + n) * K + k0 + half * 32 + 16) = (u32x4){o[4], o[5], o[6], o[7]};
    if (kb == 0 && half == 0) sbdst[n0 + n] = mx * (1.f / 127.f);
    LDS_WAIT(); __builtin_amdgcn_wave_barrier();
}
template <bool DUAL = false> __device__ __forceinline__ void rms_row_i8(const float* src, const float* w, signed char* dst, float* sa, int lane, float eps, bf16_t* dstb = nullptr) {
    if (src == nullptr) {
        if (DUAL) {
#pragma unroll
            for (int j = 0; j < 8; ++j) *(u32x4*)(dstb + (j * 64 + lane) * 8) = (u32x4){0u, 0u, 0u, 0u}; }
#pragma unroll
        for (int j = 0; j < 4; ++j) *(u32x4*)(dst + (j * 64 + lane) * 16) = (u32x4){0u, 0u, 0u, 0u};
        if (lane == 0) *sa = 1.f;
        return;
    }
    f32x4 v[16]; float s = 0.f;
#pragma unroll
    for (int j = 0; j < 16; ++j) { v[j] = *(const f32x4*)(src + (j * 64 + lane) * 4); s += (v[j].x * v[j].x + v[j].y * v[j].y) + (v[j].z * v[j].z + v[j].w * v[j].w); }
    const float r = rsqrtf(wave_sum(s) * (1.f / D) + eps);
    float mx = 0.f;
#pragma unroll
    for (int j = 0; j < 16; ++j) { const f32x4 g = *(const f32x4*)(w + (j * 64 + lane) * 4); v[j] = v[j] * r * g; mx = fmaxf(mx, fmaxf(fmaxf(fabsf(v[j].x), fabsf(v[j].y)), fmaxf(fabsf(v[j].z), fabsf(v[j].w))));
        if (DUAL) { u32x2 o; o.x = pk2(v[j].x, v[j].y); o.y = pk2(v[j].z, v[j].w); *(u32x2*)(dstb + (j * 64 + lane) * 4) = o; } }
    mx = wave_max(mx);
    const float inv = mx > 0.f ? 127.f / mx : 0.f;
#pragma unroll
    for (int j = 0; j < 16; ++j) { const unsigned q = ((unsigned)(int)rintf(v[j].x * inv) & 0xffu) | (((unsigned)(int)rintf(v[j].y * inv) & 0xffu) << 8) | (((unsigned)(int)rintf(v[j].z * inv) & 0xffu) << 16) | (((unsigned)(int)rintf(v[j].w * inv) & 0xffu) << 24);
        *(unsigned*)(dst + (j * 64 + lane) * 4) = q; }
    if (lane == 0) *sa = mx > 0.f ? mx * (1.f / 127.f) : 1.f;
}
__device__ __forceinline__ void rms_row_bf16(const float* src, const float* w, bf16_t* dst, int lane, float eps) {
    if (src == nullptr) {
#pragma unroll
        for (int j = 0; j < 8; ++j) *(u32x4*)(dst + (j * 64 + lane) * 8) = (u32x4){0u, 0u, 0u, 0u};
        return;
    }
    f32x4 v[16]; float s = 0.f;
#pragma unroll
    for (int j = 0; j < 16; ++j) { v[j] = *(const f32x4*)(src + (j * 64 + lane) * 4); s += (v[j].x * v[j].x + v[j].y * v[j].y) + (v[j].z * v[j].z + v[j].w * v[j].w); }
    const float r = rsqrtf(wave_sum(s) * (1.f / D) + eps);
#pragma unroll
    for (int j = 0; j < 16; ++j) { const f32x4 g = *(const f32x4*)(w + (j * 64 + lane) * 4);
        u32x2 o; o.x = pk2(v[j].x * r * g.x, v[j].y * r * g.y); o.y = pk2(v[j].z * r * g.z, v[j].w * r * g.w);
        *(u32x2*)(dst + (j * 64 + lane) * 4) = o; }
}
__device__ __forceinline__ void p0_prologue_a(const P& p, LAS unsigned char* lds, int G) {
    const int tid = threadIdx.x, lane = tid & 63, wave = tid >> 6;
    LAS float* scr = (LAS float*)(lds + wave * 16384);
    const int gw = blockIdx.x * NWAVES + wave, NGW = G * NWAVES;
    unsigned char* ws = p.ws;
    {
        constexpr int C0 = 128 * ((IN_COLS + 2047) / 2048), C1 = 128 * (8192 / 2048), C2 = 128 * ((NFI + 2047) / 2048);
        for (int it = blockIdx.x; it < C0 + C1 + C2; it += G) {
            if (it < C0) colmax_item(p.in[I_WIN], IN_COLS, (unsigned*)(ws + WS_CTL + CT_CMX_IN), it);
            else if (it < C0 + C1) colmax_item(p.in[I_WGATE], 8192, (unsigned*)(ws + WS_CTL + CT_CMX_G), it - C0);
            else colmax_item(p.in[I_WFI], NFI, (unsigned*)(ws + WS_CTL + CT_CMX_F), it - C0 - C1);
        } }
    for (int it = gw; it < 16 * 32; it += NGW) { const int hh = it >> 5;
        tr_item<0>(p.in[I_WUV] + (size_t)hh * KVR * HD_B, KVR, HD_B, HD_B, (bf16_t*)(ws + WS_WUVT) + (size_t)hh * HD_B * KVR, scr, it & 31, lane); }
    for (size_t i = (size_t)blockIdx.x * NT + threadIdx.x; i < (size_t)16 * 512 * 128 / 4; i += (size_t)G * NT) {
        const f32x4 v = *(const f32x4*)(p.in[I_WUK] + i * 4); u32x2 o; o.x = pk2(v.x, v.y); o.y = pk2(v.z, v.w); *(u32x2*)((bf16_t*)(ws + WS_WUKB) + i * 4) = o; }
    for (int i = blockIdx.x * NT + threadIdx.x; i < 448 * 2048; i += G * NT) { const int j = i >> 11, c = i & 2047;
        const float v = j < 96 ? p.in[I_W2][(size_t)j * 2048 + c] : (j < 192 ? p.in[I_A2][(size_t)(j - 96) * 2048 + c] : p.in[I_G2][(size_t)(j - 192) * 2048 + c]);
        ((bf16_t*)(ws + WS_WLT))[(size_t)c * 448 + j] = f2bf(v); }
    signed char* U8 = (signed char*)(ws + WS_U); float* SA = (float*)(ws + WS_CTL + CT_SA);
    for (int m = gw; m < MP; m += NGW) {
        const float* src = m < NMETA ? p.in[I_META] + (size_t)m * D : (m < L ? p.in[I_X] + (size_t)(m - NMETA) * D : nullptr);
        rms_row_i8<true>(src, p.in[I_NMW], U8 + (size_t)m * D, SA + m, lane, 1e-6f, (bf16_t*)(ws + WS_R1) + (size_t)m * D);
    }
}
__device__ __forceinline__ void p0_prologue_b(const P& p, LAS unsigned char* lds, int G) {
    const int lane = threadIdx.x & 63, wave = threadIdx.x >> 6;
    LAS float* scr = (LAS float*)(lds + wave * 16384);
    const int gw = blockIdx.x * NWAVES + wave, NGW = G * NWAVES;
    constexpr int I0 = (4096 / 64) * (NZ / 32);
    for (int it = gw; it < I0; it += NGW) {
        const int nb = it % (NZ / 32);
        if (nb * 32 < NZ8) tr_item_i8<0>(p.in[I_WIN], 4096, IN_COLS, NZ, (signed char*)(p.ws + WS_WINT), (const unsigned*)(p.ws + WS_CTL + CT_CMX_IN), (float*)(p.ws + WS_CTL + CT_SB_IN), scr, it, lane);
        else tr_item<0>(p.in[I_WIN], 4096, IN_COLS, NZ, (bf16_t*)(p.ws + WS_WINT + WINT_BF_OFF) - (size_t)NZ8 * 4096, scr, it, lane);
    }
}
__device__ __forceinline__ void p0b_weights(const P& p, LAS unsigned char* lds, int vw, int nvw) {
    const int lane = threadIdx.x & 63, wave = threadIdx.x >> 6;
    LAS float* scr = (LAS float*)(lds + wave * 16384);
    unsigned char* ws = p.ws;
    constexpr int I1 = (4096 / 64) * (8192 / 32), I2 = (2048 / 64) * (4096 / 32), I3 = I2, I4 = (4096 / 64) * (4096 / 32), I5 = (4096 / 64) * (NFI / 32), I6 = (DFF / 64) * (4096 / 32);
    constexpr int NITEMS = I1 + I2 + I3 + I4 + I5 + I6;
    for (int it = vw; it < NITEMS; it += nvw) {
        int r = it;
        if (r < I1) { tr_item_i8<0>(p.in[I_WGATE], 4096, 8192, 8192, (signed char*)(ws + WS_WGT), (const unsigned*)(ws + WS_CTL + CT_CMX_G), (float*)(ws + WS_CTL + CT_SB_G), scr, r, lane); continue; } r -= I1;
        if (r < I2) { tr_item<0>(p.in[I_WPA], 2048, 4096, 4096, (bf16_t*)(ws + WS_WPAT), scr, r, lane); continue; } r -= I2;
        if (r < I3) { tr_item<0>(p.in[I_WPB], 2048, 4096, 4096, (bf16_t*)(ws + WS_WPBT), scr, r, lane); continue; } r -= I3;
        if (r < I4) { tr_item<0>(p.in[I_WOUT], 4096, 4096, 4096, (bf16_t*)(ws + WS_WOUTT), scr, r, lane); continue; } r -= I4;
        if (r < I5) { tr_item_i8<1>(p.in[I_WFI], 4096, NFI, NFI, (signed char*)(ws + WS_WFIT), (const unsigned*)(ws + WS_CTL + CT_CMX_F), (float*)(ws + WS_CTL + CT_SB_F), scr, r, lane); continue; } r -= I5;
        tr_item<0>(p.in[I_WFO], DFF, 4096, 4096, (bf16_t*)(ws + WS_WFOT), scr, r, lane);
    }
}

typedef short bf16x8p_t __attribute__((ext_vector_type(8)));
template <int CTRL> __device__ __forceinline__ float dpp_shr0(float v) { return __builtin_bit_cast(float, __builtin_amdgcn_update_dpp(0, __builtin_bit_cast(int, v), CTRL, 0xf, 0xf, true)); }
__device__ __forceinline__ void p2_rwkv_prep(const P& p, LAS unsigned char* lds, int G) {
    const int tid = threadIdx.x, lane = tid & 63, wave = __builtin_amdgcn_readfirstlane(tid >> 6), r16 = lane & 15, q = lane >> 4;
    const bf16_t* Z = (const bf16_t*)(p.ws + WS_Z); const bf16_t* WLT = (const bf16_t*)(p.ws + WS_WLT);
    float* CSo = (float*)(p.ws + WS_LD); bf16_t* AAo = (bf16_t*)(p.ws + WS_AA); bf16_t* GGo = (bf16_t*)(p.ws + WS_GG);
    constexpr int AST = 456;
    LAS bf16_t* act = (LAS bf16_t*)lds;
    const float* mu = p.in[I_MU] + 6144;
    for (int item = blockIdx.x; item < 256; item += G) {
        const int ct = item & 15, tr = item >> 4;
        const int ch = ct * 128 + wave * 16 + r16;
        bf16x8p_t af[14];
#pragma unroll
        for (int ks = 0; ks < 14; ++ks) af[ks] = *(const bf16x8p_t*)(WLT + (size_t)ch * 448 + ks * 32 + q * 8);
        const int c4 = ct * 128 + wave * 16 + q * 4;
        const f32x4 w0v = *(const f32x4*)(p.in[I_W0] + c4), a0v = *(const f32x4*)(p.in[I_A0] + c4);
        const int st0 = tr * 16, st1 = tr == 15 ? 257 : st0 + 16;
        for (int st = st0; st < st1; ++st) {
            const int t0 = st * 64;
            __syncthreads();
            {
                u32x4 za[7], zp[7];
#pragma unroll
                for (int k = 0; k < 7; ++k) { const int cidx = tid + k * NT, t = cidx / 56, j8 = (cidx % 56) * 8; int tg = t0 + t; if (tg > L - 1) tg = L - 1; const int tp = tg > 0 ? tg - 1 : 0;
                    za[k] = *(const u32x4*)(Z + (size_t)tg * NZ + 6144 + j8); zp[k] = *(const u32x4*)(Z + (size_t)tp * NZ + 6144 + j8); }
#pragma unroll
                for (int k = 0; k < 7; ++k) { const int cidx = tid + k * NT, t = cidx / 56, j8 = (cidx % 56) * 8, tg = t0 + t;
                    u32x4 o = (u32x4){0u, 0u, 0u, 0u};
                    if (tg < L) {
                        const f32x4 m0 = *(const f32x4*)(mu + j8), m1 = *(const f32x4*)(mu + j8 + 4);
                        const float a[8] = {blo(za[k].x), bhi(za[k].x), blo(za[k].y), bhi(za[k].y), blo(za[k].z), bhi(za[k].z), blo(za[k].w), bhi(za[k].w)};
                        float b[8] = {blo(zp[k].x), bhi(zp[k].x), blo(zp[k].y), bhi(zp[k].y), blo(zp[k].z), bhi(zp[k].z), blo(zp[k].w), bhi(zp[k].w)};
                        if (tg == 0) {
#pragma unroll
                            for (int e = 0; e < 8; ++e) b[e] = 0.f; }
                        const float m[8] = {m0.x, m0.y, m0.z, m0.w, m1.x, m1.y, m1.z, m1.w};
                        float v[8];
#pragma unroll
                        for (int e = 0; e < 8; ++e) { const float zs = a[e] + (b[e] - a[e]) * m[e]; const bool ist = j8 < 96, isi = j8 < 192;
                            const float r = __builtin_amdgcn_rcpf(1.f + __expf(ist ? 2.f * zs : -zs)); v[e] = ist ? 1.f - 2.f * r : (isi ? zs : r); }
                        o.x = pk2(v[0], v[1]); o.y = pk2(v[2], v[3]); o.z = pk2(v[4], v[5]); o.w = pk2(v[6], v[7]);
                    }
                    *(LAS u32x4*)(act + t * AST + j8) = o; }
            }
            __syncthreads();
#pragma unroll 1
            for (int nt = 0; nt < 4; ++nt) {
                f32x4 cw = {0.f, 0.f, 0.f, 0.f}, ca = cw, cg = cw;
                const LAS bf16_t* ar = act + (nt * 16 + r16) * AST + q * 8;
#pragma unroll
                for (int ks = 0; ks < 3; ++ks) cw = __builtin_amdgcn_mfma_f32_16x16x32_bf16(af[ks], *(const LAS bf16x8p_t*)(ar + ks * 32), cw, 0, 0, 0);
#pragma unroll
                for (int ks = 3; ks < 6; ++ks) ca = __builtin_amdgcn_mfma_f32_16x16x32_bf16(af[ks], *(const LAS bf16x8p_t*)(ar + ks * 32), ca, 0, 0, 0);
#pragma unroll
                for (int ks = 6; ks < 14; ++ks) cg = __builtin_amdgcn_mfma_f32_16x16x32_bf16(af[ks], *(const LAS bf16x8p_t*)(ar + ks * 32), cg, 0, 0, 0);
                f32x4 ld;
#pragma unroll
                for (int e = 0; e < 4; ++e) { const float xx = -(w0v[e] + cw[e]); const float sp = xx > 20.f ? xx : __logf(1.f + __expf(xx)); ld[e] = -__expf(-sp - 0.5f); }
#pragma unroll
                for (int e = 0; e < 4; ++e) { float x = ld[e]; x += dpp_shr0<0x111>(x); x += dpp_shr0<0x112>(x); x += dpp_shr0<0x114>(x); x += dpp_shr0<0x118>(x); ld[e] = x; }
                const int tg = t0 + nt * 16 + r16;
                if (tg < L) {
                    *(f32x4*)(CSo + (size_t)tg * A_W + c4) = ld;
                    u32x2 oa, og; oa.x = pk2(sigm(a0v[0] + ca[0]), sigm(a0v[1] + ca[1])); oa.y = pk2(sigm(a0v[2] + ca[2]), sigm(a0v[3] + ca[3]));
                    og.x = pk2(cg[0], cg[1]); og.y = pk2(cg[2], cg[3]);
                    *(u32x2*)(AAo + (size_t)tg * A_W + c4) = oa; *(u32x2*)(GGo + (size_t)tg * A_W + c4) = og;
                }
            }
        }
    }
}


typedef short bf16x8_t __attribute__((ext_vector_type(8)));
constexpr int NCHUNK = 257, NITEM = NCHUNK * 32, RS = 72, SLOT = 64 * RS * 2;
constexpr int GAM_OFF = 15 * SLOT;
constexpr size_t GTP_OFF = 0, HT_OFF = (size_t)8192 * 8192;
typedef __bf16 bf16x2v_t __attribute__((ext_vector_type(2)));
typedef float f32x2v_t __attribute__((ext_vector_type(2)));
__device__ __forceinline__ unsigned cvtpk(float lo, float hi) { const f32x2v_t v = {lo, hi}; const bf16x2v_t b = __builtin_convertvector(v, bf16x2v_t); return __builtin_bit_cast(unsigned, b); }
__device__ __forceinline__ void mm2(const LAS bf16_t* X, const LAS bf16_t* Y, int tm, int tn0, int r, int q, f32x4& c0, f32x4& c1) {
#pragma unroll
    for (int s = 0; s < 2; ++s) {
        const bf16x8_t a = *(const LAS bf16x8_t*)(X + (tm * 16 + r) * RS + s * 32 + q * 8);
        const bf16x8_t b0 = *(const LAS bf16x8_t*)(Y + (tn0 * 16 + r) * RS + s * 32 + q * 8);
        const bf16x8_t b1 = *(const LAS bf16x8_t*)(Y + ((tn0 + 1) * 16 + r) * RS + s * 32 + q * 8);
        c0 = __builtin_amdgcn_mfma_f32_16x16x32_bf16(a, b0, c0, 0, 0, 0);
        c1 = __builtin_amdgcn_mfma_f32_16x16x32_bf16(a, b1, c1, 0, 0, 0);
    }
}
__device__ __forceinline__ void st_cheap(LAS bf16_t* B, int m0, int n, const f32x4& c) {
    u32x2 w; w.x = cvtpk(c[0], c[1]); w.y = cvtpk(c[2], c[3]); *(LAS u32x2*)(B + n * RS + m0) = w;
}
__device__ __forceinline__ void st_scat(LAS bf16_t* B, int m0, int n, const f32x4& c) {
#pragma unroll
    for (int e = 0; e < 4; ++e) B[(m0 + e) * RS + n] = f2bf(c[e]);
}
template <int CTRL> __device__ __forceinline__ float dpp_add(float v) { return v + dpp_f<CTRL>(v); }
__device__ __forceinline__ float sum8(float v) { v = dpp_add<0xB1>(v); v = dpp_add<0x4E>(v); v = dpp_add<0x141>(v); return v; }

struct RaIn { u32x4 r0, k0, v0, r1, k1, v1, a0; f32x4 c0v, c1v, p0, p1, ba[3], bb[3]; };
__device__ __forceinline__ void ra_load(RaIn& I, const bf16_t* Z, const float* CS, const bf16_t* AAi, int ch, int h, int tid) {
    const int t = tid >> 3, k8 = (tid & 7) * 8, c0 = h * 64 + k8; int tg = ch * 64 + t; if (tg > L - 1) tg = L - 1; const int tp = tg > 0 ? tg - 1 : 0;
    const bf16_t* zr = Z + (size_t)tg * NZ + c0; const bf16_t* zp = Z + (size_t)tp * NZ + c0;
    I.r0 = *(const u32x4*)zr; I.k0 = *(const u32x4*)(zr + 2048); I.v0 = *(const u32x4*)(zr + 4096);
    I.r1 = *(const u32x4*)zp; I.k1 = *(const u32x4*)(zp + 2048); I.v1 = *(const u32x4*)(zp + 4096);
    I.a0 = *(const u32x4*)(AAi + (size_t)tg * A_W + c0);
    const float* cs = CS + (size_t)tg * A_W + c0; const float* cp = CS + (size_t)tp * A_W + c0;
    I.c0v = *(const f32x4*)cs; I.c1v = *(const f32x4*)(cs + 4); I.p0 = *(const f32x4*)cp; I.p1 = *(const f32x4*)(cp + 4);
#pragma unroll
    for (int b = 0; b < 3; ++b) { int rb = ch * 64 + b * 16 + 15; if (rb > L - 1) rb = L - 1; const float* ce = CS + (size_t)rb * A_W + c0; I.ba[b] = *(const f32x4*)ce; I.bb[b] = *(const f32x4*)(ce + 4); }
}
#define LDS_BARRIER() do { asm volatile("s_waitcnt lgkmcnt(0)" ::: "memory"); __builtin_amdgcn_s_barrier(); asm volatile("" ::: "memory"); } while (0)
__device__ __forceinline__ void ra_items(const P& p, LAS unsigned char* lds, int G) {
    const int tid = threadIdx.x, lane = tid & 63, wave = __builtin_amdgcn_readfirstlane(tid >> 6), r16 = lane & 15, q = lane >> 4;
    const int tm = wave >> 1, tn0 = (wave & 1) * 2;
    const bf16_t* Z = (const bf16_t*)(p.ws + WS_Z); const float* CS = (const float*)(p.ws + WS_LD); const bf16_t* AAi = (const bf16_t*)(p.ws + WS_AA);
    bf16_t* GTP = (bf16_t*)((unsigned char*)p.out + GTP_OFF); float* HT = (float*)((unsigned char*)p.out + HT_OFF);
    bf16_t* PPo = (bf16_t*)(p.ws + WS_YB); bf16_t* Y0o = (bf16_t*)(p.ws + WS_YA); float* BS = (float*)(p.ws + WS_BS);
    LAS bf16_t* sl[15];
#pragma unroll
    for (int i = 0; i < 15; ++i) sl[i] = (LAS bf16_t*)(lds + i * SLOT);
    LAS float* gam = (LAS float*)(lds + GAM_OFF);
    LAS bf16_t *Al_r = sl[0], *Be_r = sl[1], *Ka_r = sl[2], *Al_t = sl[3], *Be_t = sl[4], *Ka_t = sl[5], *Rh_r = sl[6], *V_t = sl[7];
    LAS bf16_t *N_r = sl[8], *N_t = sl[9], *LAK = sl[10], *MRK = sl[11], *MRB = sl[12], *Q_t = sl[13], *T_a = sl[14], *T_b = sl[0], *Q_r = sl[1];
    LAS bf16_t *W_t = sl[8], *X1_t = sl[9], *U0_t = sl[1];
    const bool fixed_h = (G & 31) == 0;
    const int nit = fixed_h ? (NCHUNK - (int)(blockIdx.x >> 5) + (G >> 5) - 1) / (G >> 5) : (NITEM - (int)blockIdx.x + G - 1) / G;
    auto item_of = [&](int i, int& ch, int& h) { if (fixed_h) { h = blockIdx.x & 31; ch = (int)(blockIdx.x >> 5) + i * (G >> 5); } else { const int it = (int)blockIdx.x + i * G; ch = it >> 5; h = it & 31; } };
    float pmr[8], pmk[8], pmv[8], pkk[8], pka[8], prk[8]; int h_par = -1;
    RaIn I; { int ch0, h0; item_of(0, ch0, h0); if (nit > 0) ra_load(I, Z, CS, AAi, ch0, h0, tid); }
    for (int ii = 0; ii < nit; ++ii) {
        int ch, h; item_of(ii, ch, h); const int item = ch * 32 + h;
        if (h != h_par) { const int c0 = h * 64 + (tid & 7) * 8;
#pragma unroll
            for (int e = 0; e < 8; ++e) { pmr[e] = p.in[I_MU][c0 + e]; pmk[e] = p.in[I_MU][2048 + c0 + e]; pmv[e] = p.in[I_MU][4096 + c0 + e]; pkk[e] = p.in[I_KK][c0 + e]; pka[e] = p.in[I_KA][c0 + e]; prk[e] = p.in[I_RK][c0 + e]; }
            h_par = h; }
        LDS_BARRIER();
        {
            const int t = tid >> 3, k8 = (tid & 7) * 8, tg = ch * 64 + t;
            float Av[8], Bv[8], Kv[8], Rv[8], Vv[8];
            const bool valid = tg < L, hasp = tg > 0;
            {
                float lc[8], lx[8];
                {   float base[8];
#pragma unroll
                    for (int e = 0; e < 8; ++e) base[e] = 0.f;
#pragma unroll
                    for (int b = 0; b < 3; ++b) if (b < (t >> 4)) {
#pragma unroll
                        for (int e = 0; e < 4; ++e) { base[e] += I.ba[b][e]; base[4 + e] += I.bb[b][e]; } }
                    const bool pin = (t & 15) != 0;
#pragma unroll
                    for (int e = 0; e < 4; ++e) { lc[e] = base[e] + I.c0v[e]; lc[4 + e] = base[4 + e] + I.c1v[e]; lx[e] = base[e] + (pin ? I.p0[e] : 0.f); lx[4 + e] = base[4 + e] + (pin ? I.p1[e] : 0.f); }
                }
                const unsigned rw[4] = {I.r0.x, I.r0.y, I.r0.z, I.r0.w}, kw[4] = {I.k0.x, I.k0.y, I.k0.z, I.k0.w}, vw[4] = {I.v0.x, I.v0.y, I.v0.z, I.v0.w};
                const unsigned rp[4] = {I.r1.x, I.r1.y, I.r1.z, I.r1.w}, kq[4] = {I.k1.x, I.k1.y, I.k1.z, I.k1.w}, vq[4] = {I.v1.x, I.v1.y, I.v1.z, I.v1.w}, aw[4] = {I.a0.x, I.a0.y, I.a0.z, I.a0.w};
                float rr[8], kk[8], kp[8], aa[8]; float ss = 0.f, bs = 0.f;
#pragma unroll
                for (int e = 0; e < 8; ++e) {
                    const int wi = e >> 1; const bool hi = e & 1;
                    const float zr_ = hi ? bhi(rw[wi]) : blo(rw[wi]), zk_ = hi ? bhi(kw[wi]) : blo(kw[wi]), zv_ = hi ? bhi(vw[wi]) : blo(vw[wi]);
                    float pr_ = hi ? bhi(rp[wi]) : blo(rp[wi]), pk_ = hi ? bhi(kq[wi]) : blo(kq[wi]), pv_ = hi ? bhi(vq[wi]) : blo(vq[wi]);
                    if (!hasp) { pr_ = 0.f; pk_ = 0.f; pv_ = 0.f; }
                    aa[e] = hi ? bhi(aw[wi]) : blo(aw[wi]);
                    rr[e] = zr_ + (pr_ - zr_) * pmr[e]; const float k_ = zk_ + (pk_ - zk_) * pmk[e]; Vv[e] = zv_ + (pv_ - zv_) * pmv[e];
                    kk[e] = k_ * pkk[e]; ss += kk[e] * kk[e];
                    kp[e] = k_ * (1.f + (aa[e] - 1.f) * pka[e]);
                    bs += rr[e] * kp[e] * prk[e];
                }
                ss = sum8(ss); bs = sum8(bs);
                const float rn = rsqrtf(ss + 1e-12f);
                if (valid && (tid & 7) == 0) BS[(size_t)tg * 32 + h] = bs;
#pragma unroll
                for (int e = 0; e < 8; ++e) {
                    const float kn = kk[e] * rn; const float ex = __expf(lx[e]), em = __expf(-lc[e]), ep = __expf(lc[e]);
                    Av[e] = kn * ex; Bv[e] = kn * aa[e] * em; Kv[e] = kp[e] * em; Rv[e] = rr[e] * ep;
                }
                if (t == 63) {
#pragma unroll
                    for (int e = 0; e < 8; ++e) gam[k8 + e] = __expf(valid ? lc[e] : (e < 4 ? I.c0v[e] : I.c1v[e - 4]));
                }
                if (!valid) {
#pragma unroll
                    for (int e = 0; e < 8; ++e) { Av[e] = 0.f; Bv[e] = 0.f; Kv[e] = 0.f; Rv[e] = 0.f; Vv[e] = 0.f; }
                }
            }
            u32x4 w;
            w.x = cvtpk(Av[0], Av[1]); w.y = cvtpk(Av[2], Av[3]); w.z = cvtpk(Av[4], Av[5]); w.w = cvtpk(Av[6], Av[7]); *(LAS u32x4*)(Al_r + t * RS + k8) = w;
            w.x = cvtpk(Bv[0], Bv[1]); w.y = cvtpk(Bv[2], Bv[3]); w.z = cvtpk(Bv[4], Bv[5]); w.w = cvtpk(Bv[6], Bv[7]); *(LAS u32x4*)(Be_r + t * RS + k8) = w;
            w.x = cvtpk(Kv[0], Kv[1]); w.y = cvtpk(Kv[2], Kv[3]); w.z = cvtpk(Kv[4], Kv[5]); w.w = cvtpk(Kv[6], Kv[7]); *(LAS u32x4*)(Ka_r + t * RS + k8) = w;
            w.x = cvtpk(Rv[0], Rv[1]); w.y = cvtpk(Rv[2], Rv[3]); w.z = cvtpk(Rv[4], Rv[5]); w.w = cvtpk(Rv[6], Rv[7]); *(LAS u32x4*)(Rh_r + t * RS + k8) = w;
#pragma unroll
            for (int e = 0; e < 8; ++e) { Al_t[(k8 + e) * RS + t] = f2bf(Av[e]); Be_t[(k8 + e) * RS + t] = f2bf(Bv[e]); Ka_t[(k8 + e) * RS + t] = f2bf(Kv[e]); V_t[(k8 + e) * RS + t] = f2bf(Vv[e]); }
        }
        if (ii + 1 < nit) { int ch1, h1; item_of(ii + 1, ch1, h1); ra_load(I, Z, CS, AAi, ch1, h1, tid); }
        LDS_BARRIER();
        {
            f32x4 cab0 = {0.f, 0.f, 0.f, 0.f}, cab1 = cab0, cak0 = cab0, cak1 = cab0, crk0 = cab0, crk1 = cab0, crb0 = cab0, crb1 = cab0;
            mm2(Be_r, Al_r, tm, tn0, r16, q, cab0, cab1); mm2(Ka_r, Al_r, tm, tn0, r16, q, cak0, cak1);
            mm2(Ka_r, Rh_r, tm, tn0, r16, q, crk0, crk1); mm2(Be_r, Rh_r, tm, tn0, r16, q, crb0, crb1);
            const int s0 = tm * 16 + q * 4;
#pragma unroll
            for (int j = 0; j < 2; ++j) {
                const int t = (tn0 + j) * 16 + r16;
                f32x4 ab = j ? cab1 : cab0, ak = j ? cak1 : cak0, rk = j ? crk1 : crk0, rb = j ? crb1 : crb0, nn, t0;
#pragma unroll
                for (int e = 0; e < 4; ++e) { const int s = s0 + e; nn[e] = s < t ? -ab[e] : 0.f; t0[e] = nn[e] + (s == t ? 1.f : 0.f); ak[e] = s < t ? ak[e] : 0.f; rk[e] = s <= t ? rk[e] : 0.f; rb[e] = s <= t ? rb[e] : 0.f; }
                st_cheap(N_r, s0, t, nn); st_scat(N_t, s0, t, nn); st_cheap(T_a, s0, t, t0); st_cheap(LAK, s0, t, ak); st_cheap(MRK, s0, t, rk); st_cheap(MRB, s0, t, rb);
            }
        }
        LDS_BARRIER();
        {
            LAS bf16_t* Pr = N_r; LAS bf16_t* Pt = N_t; LAS bf16_t* Qr = Q_r; LAS bf16_t* Qt = Q_t; LAS bf16_t* Tc = T_a; LAS bf16_t* Tn = T_b;
#pragma unroll 1
            for (int it = 0; it < 5; ++it) {
                {   f32x4 c0 = {0.f, 0.f, 0.f, 0.f}, c1 = c0;
                    mm2(Pr, Pt, tm, tn0, r16, q, c0, c1);
                    const int m0 = tm * 16 + q * 4;
                    st_cheap(Qt, m0, tn0 * 16 + r16, c0); st_cheap(Qt, m0, (tn0 + 1) * 16 + r16, c1);
                    st_scat(Qr, m0, tn0 * 16 + r16, c0); st_scat(Qr, m0, (tn0 + 1) * 16 + r16, c1); }
                LDS_BARRIER();
                {   f32x4 c0 = {0.f, 0.f, 0.f, 0.f}, c1 = c0;
                    mm2(Qt, Tc, tm, tn0, r16, q, c0, c1);
                    const int b0 = tm * 16 + q * 4;
#pragma unroll
                    for (int j = 0; j < 2; ++j) { const int a = (tn0 + j) * 16 + r16; const u32x2 o = *(const LAS u32x2*)(Tc + a * RS + b0); f32x4 c = j ? c1 : c0;
                        c[0] += blo(o.x); c[1] += bhi(o.x); c[2] += blo(o.y); c[3] += bhi(o.y); st_cheap(Tn, b0, a, c); } }
                LDS_BARRIER();
                LAS bf16_t* x = Pr; Pr = Qr; Qr = x; x = Pt; Pt = Qt; Qt = x; x = Tc; Tc = Tn; Tn = x;
            }
        }
        {
            f32x4 c0 = {0.f, 0.f, 0.f, 0.f}, c1 = c0, d0 = c0, d1 = c0;
            mm2(T_b, Al_t, tm, tn0, r16, q, c0, c1);
            mm2(LAK, V_t, tm, tn0, r16, q, d0, d1);
            const int t0 = tm * 16 + q * 4;
            st_cheap(W_t, t0, tn0 * 16 + r16, c0); st_cheap(W_t, t0, (tn0 + 1) * 16 + r16, c1);
            st_cheap(X1_t, t0, tn0 * 16 + r16, d0); st_cheap(X1_t, t0, (tn0 + 1) * 16 + r16, d1);
        }
        LDS_BARRIER();
        {
            f32x4 c0 = {0.f, 0.f, 0.f, 0.f}, c1 = c0;
            mm2(T_b, X1_t, tm, tn0, r16, q, c0, c1);
            const int t0 = tm * 16 + q * 4;
            st_cheap(U0_t, t0, tn0 * 16 + r16, c0); st_cheap(U0_t, t0, (tn0 + 1) * 16 + r16, c1);
        }
        LDS_BARRIER();
        {
            const int m0 = tm * 16 + q * 4;
            if (ch < 256) {
                f32x4 g0 = {0.f, 0.f, 0.f, 0.f}, g1 = g0, h0 = g0, h1 = g0, u0 = g0, u1 = g0;
                mm2(W_t, Be_t, tm, tn0, r16, q, g0, g1);
                mm2(Ka_t, V_t, tm, tn0, r16, q, h0, h1);
                mm2(Be_t, U0_t, tm, tn0, r16, q, u0, u1);
                const size_t it8 = (size_t)item;
#pragma unroll
                for (int j = 0; j < 2; ++j) {
                    const int n = (tn0 + j) * 16 + r16; const f32x4 g = j ? g1 : g0; const float gc = gam[n];
                    f32x4 o;
#pragma unroll
                    for (int e = 0; e < 4; ++e) o[e] = ((m0 + e == n ? 1.f : 0.f) - g[e]) * gc;
                    u32x2 w; w.x = cvtpk(o[0], o[1]); w.y = cvtpk(o[2], o[3]);
                    *(u32x2*)(GTP + it8 * 4096 + (size_t)n * 64 + 32 * (tm >> 1) + 8 * q + 4 * (tm & 1)) = w;
                    const f32x4 hh = (j ? h1 : h0) - (j ? u1 : u0);
                    const f32x4 gk = *(const LAS f32x4*)(gam + m0);
                    *(f32x4*)(HT + (it8 * 16 + tm * 4 + (tn0 + j)) * 256 + lane * 4) = hh * gk;
                }
            }
            f32x4 p0 = {0.f, 0.f, 0.f, 0.f}, p1 = p0, y0 = p0, y1 = p0, z0 = p0, z1 = p0;
            mm2(W_t, MRB, tm, tn0, r16, q, p0, p1);
            mm2(V_t, MRK, tm, tn0, r16, q, y0, y1);
            mm2(U0_t, MRB, tm, tn0, r16, q, z0, z1);
#pragma unroll
            for (int j = 0; j < 2; ++j) {
                const int t = (tn0 + j) * 16 + r16, tg = ch * 64 + t;
                const u32x2 o = *(const LAS u32x2*)(Rh_r + t * RS + m0); const f32x4 pm = j ? p1 : p0;
                u32x2 w; w.x = cvtpk(blo(o.x) - pm[0], bhi(o.x) - pm[1]); w.y = cvtpk(blo(o.y) - pm[2], bhi(o.y) - pm[3]);
                *(u32x2*)(PPo + (size_t)item * 4096 + t * 64 + m0) = w;
                if (tg < L) { const f32x4 yy = (j ? y1 : y0) - (j ? z1 : z0); u32x2 wy; wy.x = cvtpk(yy[0], yy[1]); wy.y = cvtpk(yy[2], yy[3]);
                    *(u32x2*)(Y0o + (size_t)tg * A_W + h * 64 + m0) = wy; }
            }
        }
    }
}

struct RbSet { bf16x8_t ga[4][2]; f32x4 hv[4]; };
__device__ __forceinline__ void rb_load(RbSet& S, const bf16_t* GTP, const float* HT, int c, int h, int vg, int lane, int r16, int q) {
    const size_t it8 = (size_t)(c < 256 ? c : 255) * 32 + h;
#pragma unroll
    for (int i = 0; i < 4; ++i) { S.hv[i] = *(const f32x4*)(HT + (it8 * 16 + i * 4 + vg) * 256 + lane * 4);
#pragma unroll
        for (int s = 0; s < 2; ++s) S.ga[i][s] = *(const bf16x8_t*)(GTP + it8 * 4096 + (size_t)(i * 16 + r16) * 64 + s * 32 + q * 8); }
}
__device__ __forceinline__ void rb_step(f32x4 (&acc)[4], const RbSet& S, bf16_t* ST, int c, int h, int vg, int r16, int q) {
    const size_t item = (size_t)c * 32 + h;
    unsigned w[8];
#pragma unroll
    for (int i = 0; i < 4; ++i) { w[2 * i] = cvtpk(acc[i][0], acc[i][1]); w[2 * i + 1] = cvtpk(acc[i][2], acc[i][3]);
        u32x2 o; o.x = w[2 * i]; o.y = w[2 * i + 1]; *(u32x2*)(ST + item * 4096 + (size_t)(vg * 16 + r16) * 64 + i * 16 + q * 4) = o; }
    const u32x4 b0 = (u32x4){w[0], w[1], w[2], w[3]}, b1 = (u32x4){w[4], w[5], w[6], w[7]};
    const bf16x8_t f0 = __builtin_bit_cast(bf16x8_t, b0), f1 = __builtin_bit_cast(bf16x8_t, b1);
#pragma unroll
    for (int i = 0; i < 4; ++i) { f32x4 a = S.hv[i];
        a = __builtin_amdgcn_mfma_f32_16x16x32_bf16(S.ga[i][0], f0, a, 0, 0, 0);
        a = __builtin_amdgcn_mfma_f32_16x16x32_bf16(S.ga[i][1], f1, a, 0, 0, 0);
        acc[i] = a; }
}
__device__ __forceinline__ void rb_chain(const P& p, int G) {
    const int tid = threadIdx.x, lane = tid & 63, wave = __builtin_amdgcn_readfirstlane(tid >> 6), r16 = lane & 15, q = lane >> 4;
    if (wave == 0) for (int cw = blockIdx.x; cw < 128; cw += G) {
        const int h = cw >> 2, vg = cw & 3;
        const bf16_t* GTP = (const bf16_t*)((const unsigned char*)p.out + GTP_OFF); const float* HT = (const float*)((const unsigned char*)p.out + HT_OFF);
        bf16_t* ST = (bf16_t*)(p.ws + WS_ST);
        f32x4 acc[4];
#pragma unroll
        for (int i = 0; i < 4; ++i) acc[i] = (f32x4){0.f, 0.f, 0.f, 0.f};
        RbSet S0, S1, S2, S3;
        rb_load(S0, GTP, HT, 0, h, vg, lane, r16, q); rb_load(S1, GTP, HT, 1, h, vg, lane, r16, q); rb_load(S2, GTP, HT, 2, h, vg, lane, r16, q); rb_load(S3, GTP, HT, 3, h, vg, lane, r16, q);
#pragma unroll 1
        for (int c = 0; c < 256; c += 4) {
            rb_step(acc, S0, ST, c, h, vg, r16, q);     rb_load(S0, GTP, HT, c + 4, h, vg, lane, r16, q);
            rb_step(acc, S1, ST, c + 1, h, vg, r16, q); rb_load(S1, GTP, HT, c + 5, h, vg, lane, r16, q);
            rb_step(acc, S2, ST, c + 2, h, vg, r16, q); rb_load(S2, GTP, HT, c + 6, h, vg, lane, r16, q);
            rb_step(acc, S3, ST, c + 3, h, vg, r16, q); rb_load(S3, GTP, HT, c + 7, h, vg, lane, r16, q);
        }
        {
            const size_t item = (size_t)256 * 32 + h;
#pragma unroll
            for (int i = 0; i < 4; ++i) { u32x2 o; o.x = cvtpk(acc[i][0], acc[i][1]); o.y = cvtpk(acc[i][2], acc[i][3]); *(u32x2*)(ST + item * 4096 + (size_t)(vg * 16 + r16) * 64 + i * 16 + q * 4) = o; }
        }
    }
}

__device__ __forceinline__ void rc_out(const P& p, int G) {
    const int tid = threadIdx.x, lane = tid & 63, wave = __builtin_amdgcn_readfirstlane(tid >> 6), r16 = lane & 15, q = lane >> 4;
    const bf16_t* Z = (const bf16_t*)(p.ws + WS_Z); const bf16_t* GGi = (const bf16_t*)(p.ws + WS_GG); const float* BS = (const float*)(p.ws + WS_BS);
    const bf16_t* ST = (const bf16_t*)(p.ws + WS_ST); const bf16_t* PPi = (const bf16_t*)(p.ws + WS_YB); bf16_t* YA = (bf16_t*)(p.ws + WS_YA);
    for (size_t i = (size_t)blockIdx.x * NT + tid; i < (size_t)(MP - L) * A_W / 8; i += (size_t)G * NT) *(u32x4*)(YA + (size_t)L * A_W + i * 8) = (u32x4){0u, 0u, 0u, 0u};
    const int tt = wave & 3;
    for (int item = blockIdx.x * 2 + (wave >> 2); item < NITEM; item += 2 * G) {
        const int ch = item >> 5, h = item & 31;
        const int t = tt * 16 + r16, tg = ch * 64 + t;
        f32x4 acc[4];
#pragma unroll
        for (int i = 0; i < 4; ++i) acc[i] = (f32x4){0.f, 0.f, 0.f, 0.f};
        const bf16_t* sp = ST + (size_t)item * 4096; const bf16_t* pp = PPi + (size_t)item * 4096 + (size_t)t * 64;
#pragma unroll
        for (int s = 0; s < 2; ++s) {
            const bf16x8_t b = *(const bf16x8_t*)(pp + s * 32 + q * 8);
#pragma unroll
            for (int i = 0; i < 4; ++i) { const bf16x8_t a = *(const bf16x8_t*)(sp + (size_t)(i * 16 + r16) * 64 + s * 32 + q * 8);
                acc[i] = __builtin_amdgcn_mfma_f32_16x16x32_bf16(a, b, acc[i], 0, 0, 0); }
        }
        if (tg < L) {
            float s1 = 0.f;
#pragma unroll
            for (int i = 0; i < 4; ++i) { const u32x2 y0 = *(const u32x2*)(YA + (size_t)tg * A_W + h * 64 + i * 16 + q * 4);
                acc[i][0] += blo(y0.x); acc[i][1] += bhi(y0.x); acc[i][2] += blo(y0.y); acc[i][3] += bhi(y0.y);
                s1 += (acc[i][0] + acc[i][1]) + (acc[i][2] + acc[i][3]); }
            s1 += __shfl_xor(s1, 16); s1 += __shfl_xor(s1, 32);
            const float mean = s1 * (1.f / 64.f);
            float s2 = 0.f;
#pragma unroll
            for (int i = 0; i < 4; ++i)
#pragma unroll
                for (int e = 0; e < 4; ++e) { const float d = acc[i][e] - mean; s2 += d * d; }
            s2 += __shfl_xor(s2, 16); s2 += __shfl_xor(s2, 32);
            const float rstd = rsqrtf(s2 * (1.f / 64.f) + 64e-5f);
            const float bs = BS[(size_t)tg * 32 + h];
#pragma unroll
            for (int i = 0; i < 4; ++i) {
                const int c = h * 64 + i * 16 + q * 4;
                const u32x2 zv = *(const u32x2*)(Z + (size_t)tg * NZ + 4096 + c);
                u32x2 pv = (u32x2){0u, 0u}; if (tg > 0) pv = *(const u32x2*)(Z + (size_t)(tg - 1) * NZ + 4096 + c);
                const u32x2 gg = *(const u32x2*)(GGi + (size_t)tg * A_W + c);
                const f32x4 lw = *(const f32x4*)(p.in[I_LNW] + c), lb = *(const f32x4*)(p.in[I_LNB] + c), mv = *(const f32x4*)(p.in[I_MU] + 4096 + c);
                const float zz[4] = {blo(zv.x), bhi(zv.x), blo(zv.y), bhi(zv.y)}, pz[4] = {blo(pv.x), bhi(pv.x), blo(pv.y), bhi(pv.y)}, gv[4] = {blo(gg.x), bhi(gg.x), blo(gg.y), bhi(gg.y)};
                float o[4];
#pragma unroll
                for (int e = 0; e < 4; ++e) { const float vv = zz[e] + (pz[e] - zz[e]) * mv[e]; const float yn = (acc[i][e] - mean) * rstd * lw[e] + lb[e]; o[e] = (yn + bs * vv) * gv[e]; }
                u32x2 w; w.x = cvtpk(o[0], o[1]); w.y = cvtpk(o[2], o[3]);
                *(u32x2*)(YA + (size_t)tg * A_W + c) = w;
            }
        }
    }
}


__device__ __forceinline__ void p4_dsa_prep(const P& p, int G) {
    const int tid = threadIdx.x, lane = tid & 63, wave = tid >> 6;
    const bf16_t* Z = (const bf16_t*)(p.ws + WS_Z);
    bf16_t* CKV = (bf16_t*)(p.ws + WS_CKV); float* KIDX = (float*)(p.ws + WS_KIDX);
    for (int t = blockIdx.x * NWAVES + wave; t < L; t += G * NWAVES) {
        const u32x4 raw = *(const u32x4*)(Z + (size_t)t * NZ + ZCKV + lane * 8);
        float x[8] = {blo(raw.x), bhi(raw.x), blo(raw.y), bhi(raw.y), blo(raw.z), bhi(raw.z), blo(raw.w), bhi(raw.w)};
        float s = 0.f;
#pragma unroll
        for (int e = 0; e < 8; ++e) s += x[e] * x[e];
        const float r = rsqrtf(wave_sum(s) * (1.f / KVR) + 1e-6f);
        const f32x4 w0 = *(const f32x4*)(p.in[I_KVNW] + lane * 8), w1 = *(const f32x4*)(p.in[I_KVNW] + lane * 8 + 4);
        u32x4 o; o.x = pk2(x[0] * r * w0.x, x[1] * r * w0.y); o.y = pk2(x[2] * r * w0.z, x[3] * r * w0.w); o.z = pk2(x[4] * r * w1.x, x[5] * r * w1.y); o.w = pk2(x[6] * r * w1.z, x[7] * r * w1.w);
        *(u32x4*)(CKV + (size_t)t * KVR + lane * 8) = o;
        const float ki = bf2f(Z[(size_t)t * NZ + ZKI + lane]);
        const float mean = wave_sum(ki) * (1.f / 64.f), dk = ki - mean, var = wave_sum(dk * dk) * (1.f / 64.f);
        const float kn_ = dk * rsqrtf(var + 1e-6f) * p.in[I_ILNW][lane] + p.in[I_ILNB][lane];
        KIDX[(size_t)t * IDXD + lane] = kn_;
        ((bf16_t*)(p.ws + WS_KIDXB))[(size_t)t * IDXD + lane] = f2bf(kn_);
    }
}

__device__ __forceinline__ unsigned fkey(float f) { const unsigned u = __float_as_uint(f); return (u & 0x80000000u) ? ~u : (u | 0x80000000u); }


typedef float f32x16 __attribute__((ext_vector_type(16)));
constexpr int SCR_N = 16416;
__device__ __forceinline__ unsigned lds_add(LAS unsigned* p, unsigned v) { return __hip_atomic_fetch_add(p, v, __ATOMIC_RELAXED, __HIP_MEMORY_SCOPE_WORKGROUP); }
constexpr int KST = 72, SELB = 8;
template <int NBL> __device__ __forceinline__ void wfind(const LAS unsigned* hist, unsigned target, int lane, unsigned& b, unsigned& ab) {
    unsigned loc[NBL]; unsigned s = 0;
#pragma unroll
    for (int j = 0; j < NBL; j += 4) { const u32x4 v4 = *(const LAS u32x4*)(hist + lane * NBL + j); loc[j] = v4.x; loc[j + 1] = v4.y; loc[j + 2] = v4.z; loc[j + 3] = v4.w; s += (v4.x + v4.y) + (v4.z + v4.w); }
    unsigned v = s;
#pragma unroll
    for (int d = 1; d < 64; d <<= 1) { const unsigned o = (unsigned)__shfl_down((int)v, d); if (lane + d < 64) v += o; }
    const unsigned above = v - s;
    const bool found = above < target && above + s >= target;
    unsigned bb = 0u, aa = 0u;
    if (found) { unsigned a = above;
#pragma unroll
        for (int j = NBL - 1; j >= 0; --j) { if (a < target && a + loc[j] >= target) { bb = (unsigned)(lane * NBL + j); aa = a; } a += loc[j]; } }
    const unsigned long long m = __ballot(found);
    const int src = m ? (int)__builtin_ctzll(m) : 0;
    b = (unsigned)__shfl((int)bb, src); ab = (unsigned)__shfl((int)aa, src);
}
__device__ __forceinline__ void d2_topk(const P& p, LAS unsigned char* lds, int G) {
    const int tid = threadIdx.x, lane = tid & 63, wave = __builtin_amdgcn_readfirstlane(tid >> 6);
    const bf16_t* Z = (const bf16_t*)(p.ws + WS_Z); const bf16_t* KB = (const bf16_t*)(p.ws + WS_KIDXB); int* SEL = (int*)(p.ws + WS_SEL);
    float* scr = (float*)(p.ws + WS_R1) + ((size_t)blockIdx.x * NWAVES + wave) * 2 * SCR_N;
    LAS bf16_t* ksb = (LAS bf16_t*)lds;
    LAS unsigned* hw = (LAS unsigned*)(lds + 73728) + wave * 2048;
    const int key_l = lane & 31, hh = lane >> 5;
    for (int t = blockIdx.x; t < NMETA + 192; t += G) { const int n = t < NMETA ? NMETA : NMETA + 64 * (1 + (t - NMETA) / 64);
        if (tid < TOPK) SEL[(size_t)t * TOPK + tid] = tid < n ? tid : -1; }
    const int nui = (G == 256) ? 4 : (1012 + G - 1) / G;
    for (int ui = 0; ui < nui; ++ui) {
        int i = (int)blockIdx.x + ui * G;
        if (G == 256) i = ui == 0 ? (int)blockIdx.x : (ui == 1 ? 511 - (int)blockIdx.x : (ui == 2 ? 512 + (int)blockIdx.x : 1023 - (int)blockIdx.x));
        if (i >= 1012) continue;
        const int c = 256 - (i >> 2), r = i & 3, n = NMETA + 64 * c;
        const int tA = NMETA + 64 * (c - 1) + 16 * r + 2 * wave;
        bf16x8_t af[2][4]; float wv[2][16];
#pragma unroll
        for (int qq = 0; qq < 2; ++qq) {
            const bf16_t* zr = Z + (size_t)(tA + qq) * NZ;
#pragma unroll
            for (int ks = 0; ks < 4; ++ks) af[qq][ks] = *(const bf16x8_t*)(zr + ZQI + key_l * 64 + ks * 16 + hh * 8);
#pragma unroll
            for (int g = 0; g < 4; ++g) { const u32x2 w2 = *(const u32x2*)(zr + ZWI + 8 * g + 4 * hh);
                wv[qq][g * 4 + 0] = blo(w2.x) * 0.02209708691207961f; wv[qq][g * 4 + 1] = bhi(w2.x) * 0.02209708691207961f;
                wv[qq][g * 4 + 2] = blo(w2.y) * 0.02209708691207961f; wv[qq][g * 4 + 3] = bhi(w2.y) * 0.02209708691207961f; }
        }
#pragma unroll
        for (int j = 0; j < 8; ++j) *(LAS u32x4*)(hw + (j * 64 + lane) * 4) = (u32x4){0u, 0u, 0u, 0u};
        const int nblk = (n + 255) >> 8;
        __syncthreads();
        {
            const int kk = tid >> 1, hf = tid & 1; const int src = kk < n ? kk : n - 1;
            const u32x4* gp = (const u32x4*)(KB + (size_t)src * IDXD + hf * 32);
#pragma unroll
            for (int j = 0; j < 4; ++j) *(LAS u32x4*)(ksb + kk * KST + hf * 32 + j * 8) = gp[j];
        }
        __syncthreads();
        for (int b = 0; b < nblk; ++b) {
            u32x4 pre[4];
            const bool more = b + 1 < nblk;
            if (more) { const int kk = (b + 1) * 256 + (tid >> 1); const int src = kk < n ? kk : n - 1; const u32x4* gp = (const u32x4*)(KB + (size_t)src * IDXD + (tid & 1) * 32);
#pragma unroll
                for (int j = 0; j < 4; ++j) pre[j] = gp[j]; }
            const LAS bf16_t* kb = ksb + (b & 1) * 256 * KST;
#pragma unroll 2
            for (int tt = 0; tt < 8; ++tt) {
                const int s0 = b * 256 + tt * 32;
                if (s0 < n) {
                    bf16x8_t bfr[4];
#pragma unroll
                    for (int ks = 0; ks < 4; ++ks) bfr[ks] = *(const LAS bf16x8_t*)(kb + (tt * 32 + key_l) * KST + ks * 16 + hh * 8);
                    float part[2];
#pragma unroll
                    for (int qq = 0; qq < 2; ++qq) {
                        f32x16 acc;
#pragma unroll
                        for (int e = 0; e < 16; ++e) acc[e] = 0.f;
#pragma unroll
                        for (int ks = 0; ks < 4; ++ks) acc = __builtin_amdgcn_mfma_f32_32x32x16_bf16(af[qq][ks], bfr[ks], acc, 0, 0, 0);
                        float s = 0.f;
                        float s0_ = 0.f, s1_ = 0.f;
#pragma unroll
                        for (int e = 0; e < 16; e += 2) { s0_ += wv[qq][e] * __builtin_amdgcn_fmed3f(acc[e], 0.f, 3.0e38f); s1_ += wv[qq][e + 1] * __builtin_amdgcn_fmed3f(acc[e + 1], 0.f, 3.0e38f); }
                        part[qq] = s0_ + s1_; (void)s;
                    }
                    const float mine = hh ? part[1] : part[0], give = hh ? part[0] : part[1];
                    const float score = mine + __shfl_xor(give, 32);
                    const int key = s0 + key_l;
                    if (key < n) { scr[hh * SCR_N + key] = score; lds_add(hw + hh * 1024 + (fkey(score) >> 22), 1u); }
                }
            }
            if (more) { const int kk = tid >> 1, hf = tid & 1;
#pragma unroll
                for (int j = 0; j < 4; ++j) *(LAS u32x4*)(ksb + ((b + 1) & 1) * 256 * KST + kk * KST + hf * 32 + j * 8) = pre[j]; }
            __syncthreads();
        }
        unsigned b1[2], ab1[2];
        wfind<16>(hw, TOPK, lane, b1[0], ab1[0]); wfind<16>(hw + 1024, TOPK, lane, b1[1], ab1[1]);
        const int nv4 = (n + 3) >> 2;
#pragma unroll
        for (int j = 0; j < 8; ++j) *(LAS u32x4*)(hw + (j * 64 + lane) * 4) = (u32x4){0u, 0u, 0u, 0u};
        for (int sb = 0; sb < nv4; sb += 64 * SELB) {
            f32x4 va[SELB], vb[SELB];
#pragma unroll
            for (int u = 0; u < SELB; ++u) { const int s4 = sb + u * 64 + lane; const int sc = s4 < nv4 ? s4 : nv4 - 1; va[u] = *(const f32x4*)(scr + sc * 4); vb[u] = *(const f32x4*)(scr + SCR_N + sc * 4); }
#pragma unroll
            for (int u = 0; u < SELB; ++u) if (sb + u * 64 + lane < nv4) {
#pragma unroll
                for (int e = 0; e < 4; ++e) { const unsigned ka = fkey(va[u][e]), kb = fkey(vb[u][e]);
                    if ((ka >> 22) == b1[0]) lds_add(hw + ((ka >> 12) & 1023u), 1u);
                    if ((kb >> 22) == b1[1]) lds_add(hw + 1024 + ((kb >> 12) & 1023u), 1u); } } }
        unsigned b2[2], ab2[2];
        wfind<16>(hw, TOPK - ab1[0], lane, b2[0], ab2[0]); wfind<16>(hw + 1024, TOPK - ab1[1], lane, b2[1], ab2[1]);
        const unsigned pfx0 = (b1[0] << 10) | b2[0], pfx1 = (b1[1] << 10) | b2[1];
        const unsigned need0 = (unsigned)TOPK - ab1[0] - ab2[0], need1 = (unsigned)TOPK - ab1[1] - ab2[1];
        LAS unsigned* cl0 = hw; LAS unsigned* cl1 = hw + 1024;
        unsigned cnt0 = 0u, cnt1 = 0u, cc0 = 0u, cc1 = 0u; int* sel0 = SEL + (size_t)tA * TOPK; int* sel1 = sel0 + TOPK;
        const unsigned long long lt = (1ull << lane) - 1ull;
        for (int sb = 0; sb < nv4; sb += 64 * SELB) {
            f32x4 va[SELB], vb[SELB];
#pragma unroll
            for (int u = 0; u < SELB; ++u) { const int s4 = sb + u * 64 + lane; const int sc = s4 < nv4 ? s4 : nv4 - 1; va[u] = *(const f32x4*)(scr + sc * 4); vb[u] = *(const f32x4*)(scr + SCR_N + sc * 4); }
#pragma unroll
            for (int u = 0; u < SELB; ++u) { const int s4 = sb + u * 64 + lane; const bool inr = s4 < nv4;
                if (sb + u * 64 < nv4) {
#pragma unroll
                    for (int e = 0; e < 4; ++e) {
                        {   const unsigned k = fkey(va[u][e]); const bool gt = inr && (k >> 12) > pfx0, eq = inr && (k >> 12) == pfx0;
                            const unsigned long long mg = __ballot(gt), me = __ballot(eq);
                            if (gt) { const unsigned pos = cnt0 + (unsigned)__builtin_popcountll(mg & lt); if (pos < (unsigned)TOPK) sel0[pos] = s4 * 4 + e; }
                            if (eq) { const unsigned ci = cc0 + (unsigned)__builtin_popcountll(me & lt); if (ci < 512u) { cl0[2 * ci] = k; cl0[2 * ci + 1] = (unsigned)(s4 * 4 + e); } }
                            cnt0 += (unsigned)__builtin_popcountll(mg); cc0 += (unsigned)__builtin_popcountll(me); }
                        {   const unsigned k = fkey(vb[u][e]); const bool gt = inr && (k >> 12) > pfx1, eq = inr && (k >> 12) == pfx1;
                            const unsigned long long mg = __ballot(gt), me = __ballot(eq);
                            if (gt) { const unsigned pos = cnt1 + (unsigned)__builtin_popcountll(mg & lt); if (pos < (unsigned)TOPK) sel1[pos] = s4 * 4 + e; }
                            if (eq) { const unsigned ci = cc1 + (unsigned)__builtin_popcountll(me & lt); if (ci < 512u) { cl1[2 * ci] = k; cl1[2 * ci + 1] = (unsigned)(s4 * 4 + e); } }
                            cnt1 += (unsigned)__builtin_popcountll(mg); cc1 += (unsigned)__builtin_popcountll(me); }
                    } } } }
#pragma unroll 1
        for (int qq = 0; qq < 2; ++qq) {
            const LAS unsigned* cl = qq ? cl1 : cl0; const unsigned c = min(qq ? cc1 : cc0, 512u), need = qq ? need1 : need0, base = qq ? cnt1 : cnt0; int* sel = qq ? sel1 : sel0;
            for (unsigned i = lane; i < c; i += 64) { const unsigned k = cl[2 * i], ix = cl[2 * i + 1]; unsigned rank = 0;
                for (unsigned j = 0; j < c; ++j) { const unsigned kj = cl[2 * j], ij = cl[2 * j + 1]; rank += (kj > k || (kj == k && ij < ix)) ? 1u : 0u; }
                if (rank < need && base + rank < (unsigned)TOPK) sel[base + rank] = (int)ix; }
        }
    }
}

__device__ __forceinline__ void d3_qlat(const P& p, int G) {
    const int tid = threadIdx.x, lane = tid & 63, wave = __builtin_amdgcn_readfirstlane(tid >> 6), r16 = lane & 15, q = lane >> 4;
    const bf16_t* Z = (const bf16_t*)(p.ws + WS_Z); const bf16_t* WK = (const bf16_t*)(p.ws + WS_WUKB); bf16_t* QL = (bf16_t*)(p.ws + WS_QLAT);
    constexpr int NB = L / 16;
    for (int item = blockIdx.x; item < 256; item += G) {
        const int h = item & 15, qr = item >> 4; const int b0 = qr * 64, b1 = qr == 15 ? NB : b0 + 64;
        bf16x8_t af[4][4];
#pragma unroll
        for (int mt = 0; mt < 4; ++mt)
#pragma unroll
            for (int ks = 0; ks < 4; ++ks) af[mt][ks] = *(const bf16x8_t*)(WK + ((size_t)h * KVR + wave * 64 + 32 * (mt >> 1) + 8 * (r16 >> 2) + 4 * (mt & 1) + (r16 & 3)) * HD_B + ks * 32 + q * 8);
        bf16x8_t bq[4];
#pragma unroll
        for (int ks = 0; ks < 4; ++ks) bq[ks] = *(const bf16x8_t*)(Z + (size_t)(b0 * 16 + r16) * NZ + ZQ + h * 128 + ks * 32 + q * 8);
        for (int b = b0; b < b1; ++b) {
            bf16x8_t bn[4];
            const int bnx = b + 1 < b1 ? b + 1 : b;
#pragma unroll
            for (int ks = 0; ks < 4; ++ks) bn[ks] = *(const bf16x8_t*)(Z + (size_t)(bnx * 16 + r16) * NZ + ZQ + h * 128 + ks * 32 + q * 8);
#pragma unroll
            for (int mp = 0; mp < 2; ++mp) {
                f32x4 acc0 = {0.f, 0.f, 0.f, 0.f}, acc1 = acc0;
#pragma unroll
                for (int ks = 0; ks < 4; ++ks) { acc0 = __builtin_amdgcn_mfma_f32_16x16x32_bf16(af[2 * mp][ks], bq[ks], acc0, 0, 0, 0); acc1 = __builtin_amdgcn_mfma_f32_16x16x32_bf16(af[2 * mp + 1][ks], bq[ks], acc1, 0, 0, 0); }
                u32x4 w; w.x = cvtpk(acc0[0], acc0[1]); w.y = cvtpk(acc0[2], acc0[3]); w.z = cvtpk(acc1[0], acc1[1]); w.w = cvtpk(acc1[2], acc1[3]);
                *(u32x4*)(QL + (size_t)(b * 16 + r16) * 8192 + h * 512 + wave * 64 + mp * 32 + q * 8) = w;
            }
#pragma unroll
            for (int ks = 0; ks < 4; ++ks) bq[ks] = bn[ks];
        }
    }
}
__device__ __forceinline__ void d5_oproj(const P& p, LAS unsigned char* lds, int G) {
    const int tid = threadIdx.x, lane = tid & 63, wave = __builtin_amdgcn_readfirstlane(tid >> 6), r16 = lane & 15, q = lane >> 4;
    const bf16_t* OL = (const bf16_t*)(p.ws + WS_QLAT); const bf16_t* WV = (const bf16_t*)(p.ws + WS_WUVT); bf16_t* YB = (bf16_t*)(p.ws + WS_YB);
    for (size_t i = (size_t)blockIdx.x * NT + tid; i < (size_t)(MP - L) * A_W / 8; i += (size_t)G * NT) *(u32x4*)(YB + (size_t)L * A_W + i * 8) = (u32x4){0u, 0u, 0u, 0u};
    constexpr int NB = L / 16, OLS = 520;
    LAS bf16_t* ob = (LAS bf16_t*)lds;
    const int srow = tid >> 5, scol = (tid & 31) * 8;
    for (int item = blockIdx.x; item < 256; item += G) {
        const int h = item & 15, qr = item >> 4; const int b0 = qr * 64, b1 = qr == 15 ? NB : b0 + 64;
        bf16x8_t af[16];
#pragma unroll
        for (int ks = 0; ks < 16; ++ks) af[ks] = *(const bf16x8_t*)(WV + ((size_t)h * HD_B + wave * 16 + r16) * KVR + ks * 32 + q * 8);
        u32x4 g0 = *(const u32x4*)(OL + (size_t)(b0 * 16 + srow) * 8192 + h * 512 + scol), g1 = *(const u32x4*)(OL + (size_t)(b0 * 16 + srow) * 8192 + h * 512 + scol + 256);
        __syncthreads();
        for (int b = b0; b < b1; ++b) {
            LAS bf16_t* buf = ob + ((b - b0) & 1) * 16 * OLS;
            *(LAS u32x4*)(buf + srow * OLS + scol) = g0; *(LAS u32x4*)(buf + srow * OLS + scol + 256) = g1;
            const int bnx = b + 1 < b1 ? b + 1 : b;
            g0 = *(const u32x4*)(OL + (size_t)(bnx * 16 + srow) * 8192 + h * 512 + scol); g1 = *(const u32x4*)(OL + (size_t)(bnx * 16 + srow) * 8192 + h * 512 + scol + 256);
            LDS_BARRIER();
            f32x4 acc0 = {0.f, 0.f, 0.f, 0.f}, acc1 = acc0;
#pragma unroll
            for (int ks = 0; ks < 16; ks += 2) {
                const bf16x8_t bo0 = *(const LAS bf16x8_t*)(buf + r16 * OLS + ks * 32 + q * 8), bo1 = *(const LAS bf16x8_t*)(buf + r16 * OLS + (ks + 1) * 32 + q * 8);
                acc0 = __builtin_amdgcn_mfma_f32_16x16x32_bf16(af[ks], bo0, acc0, 0, 0, 0); acc1 = __builtin_amdgcn_mfma_f32_16x16x32_bf16(af[ks + 1], bo1, acc1, 0, 0, 0); }
            const f32x4 acc = acc0 + acc1;
            u32x2 w; w.x = cvtpk(acc[0], acc[1]); w.y = cvtpk(acc[2], acc[3]);
            *(u32x2*)(YB + (size_t)(b * 16 + r16) * A_W + h * HD_B + wave * 16 + q * 4) = w;
        }
    }
    __syncthreads();
}

typedef short s16x4_t __attribute__((ext_vector_type(4)));
constexpr int QLS = 520, PLS = 264, CTS = 528;
#ifndef ATT_REG
#define ATT_REG 0
#endif
#if ATT_REG > 0
#define AREG_T() const unsigned long long tt_ = __builtin_amdgcn_s_memrealtime()
#ifndef ATT_BLK
#define ATT_BLK 0
#endif
#define AREG(k) do { if (ATT_REG == (k) && blockIdx.x == ATT_BLK && threadIdx.x == 0) { const unsigned long long t1_ = __builtin_amdgcn_s_memrealtime(); areg_acc += t1_ - areg_t0; } if (ATT_REG != 9 && blockIdx.x == ATT_BLK && threadIdx.x == 0) areg_t0 = __builtin_amdgcn_s_memrealtime(); } while (0)
#else
#define AREG(k) do {} while (0)
#endif
__device__ __forceinline__ void d4_attn(const P& p, LAS unsigned char* lds, int G) {
    unsigned long long areg_acc = 0, areg_t0 = 0; (void)areg_acc; (void)areg_t0;
    const int tid = threadIdx.x, lane = tid & 63, wave = __builtin_amdgcn_readfirstlane(tid >> 6), r16 = lane & 15, q = lane >> 4;
    bf16_t* QO = (bf16_t*)(p.ws + WS_QLAT); const bf16_t* CKV = (const bf16_t*)(p.ws + WS_CKV); const int* SEL = (const int*)(p.ws + WS_SEL);
    LAS bf16_t* ql = (LAS bf16_t*)lds;
    LAS float* lg = (LAS float*)(lds + 16640);
    LAS bf16_t* pl = (LAS bf16_t*)(lds + 49408);
    LAS int* sl = (LAS int*)(lds + 57856);
    LAS bf16_t* ct = (LAS bf16_t*)(lds + 58880);
    LAS bf16_t* cx = (LAS bf16_t*)(lds + 126464);
    const float scale = 0.08838834764831845f;
    u32x4 qn0 = (u32x4){0u, 0u, 0u, 0u}, qn1 = qn0; int seln = -1;
    const bool xdeal = (G == 256);
    const int tq0 = xdeal ? ((int)(blockIdx.x & 7) * (L / 8) + (int)(blockIdx.x >> 3)) : (int)blockIdx.x, tqs = xdeal ? 32 : G, tq1 = xdeal ? ((int)(blockIdx.x & 7) + 1) * (L / 8) : L;
    {   const int t = tq0;
        if (t < tq1) { qn0 = *(const u32x4*)(QO + (size_t)t * 8192 + tid * 8); qn1 = *(const u32x4*)(QO + (size_t)t * 8192 + 4096 + tid * 8); if (tid < TOPK) seln = SEL[(size_t)t * TOPK + tid]; } }
#if ATT_REG == 9
    if (blockIdx.x == ATT_BLK && threadIdx.x == 0) areg_t0 = __builtin_amdgcn_s_memrealtime();
#endif
    for (int t = tq0; t < tq1; t += tqs) {
        AREG(5);
        LDS_BARRIER();
        {   const int i0_ = tid, i1_ = tid + 512;
            *(LAS u32x4*)(ql + (i0_ >> 6) * QLS + (i0_ & 63) * 8) = qn0; *(LAS u32x4*)(ql + (i1_ >> 6) * QLS + (i1_ & 63) * 8) = qn1;
            if (tid < TOPK) sl[tid] = seln; }
        LDS_BARRIER();
        AREG(1);
        u32x4 st[8];
#pragma unroll
        for (int i = 0; i < 8; ++i) { const int idx = sl[wave + 8 * i]; st[i] = *(const u32x4*)(CKV + (size_t)(idx < 0 ? 0 : idx) * KVR + lane * 8); }
        const int kk = wave & 3, kh = wave >> 2;
        bf16x8_t af[8];
#pragma unroll
        for (int ks = 0; ks < 8; ++ks) af[ks] = *(const LAS bf16x8_t*)(ql + r16 * QLS + kh * 256 + ks * 32 + q * 8);
        for (int kt = 0; kt < 4; ++kt) {
            LDS_BARRIER();
#pragma unroll
            for (int i = 0; i < 8; ++i) { LAS bf16_t* dst = (kt == 2 && i >= 4) ? cx + (wave + 8 * i - 32) * CTS : ct + (wave + 8 * i) * CTS; *(LAS u32x4*)(dst + lane * 8) = st[i]; }
            if (kt < 3) {
#pragma unroll
                for (int i = 0; i < 8; ++i) { const int idx = sl[(kt + 1) * 64 + wave + 8 * i]; st[i] = *(const u32x4*)(CKV + (size_t)(idx < 0 ? 0 : idx) * KVR + lane * 8); }
            } else {
#pragma unroll
                for (int i = 0; i < 4; ++i) { const int idx = sl[128 + wave + 8 * i]; st[i] = *(const u32x4*)(CKV + (size_t)(idx < 0 ? 0 : idx) * KVR + lane * 8); }
            }
            LDS_BARRIER();
            const LAS bf16_t* kb = (kt == 2 && kk >= 2) ? cx + ((kk - 2) * 16 + r16) * CTS : ct + (kk * 16 + r16) * CTS;
            f32x4 c0 = {0.f, 0.f, 0.f, 0.f};
#pragma unroll
            for (int ks = 0; ks < 8; ++ks) {
                const bf16x8_t b = *(const LAS bf16x8_t*)(kb + kh * 256 + ks * 32 + q * 8);
                c0 = __builtin_amdgcn_mfma_f32_16x16x32_bf16(af[ks], b, c0, 0, 0, 0);
            }
            const int key = kt * 64 + kk * 16 + r16; const bool inval = sl[key] < 0;
#pragma unroll
            for (int e = 0; e < 4; ++e) lg[kh * 4096 + (4 * q + e) * 256 + key] = inval ? (kh ? 0.f : -INFINITY) : c0[e] * scale;
        }
        LDS_BARRIER();
        AREG(2);
        for (int hd = wave * 2; hd < wave * 2 + 2; ++hd) {
            float v[4]; float mx = -INFINITY;
#pragma unroll
            for (int k = 0; k < 4; ++k) { v[k] = lg[hd * 256 + k * 64 + lane] + lg[4096 + hd * 256 + k * 64 + lane]; mx = fmaxf(mx, v[k]); }
            mx = wave_max(mx);
            float s = 0.f;
#pragma unroll
            for (int k = 0; k < 4; ++k) { v[k] = __expf(v[k] - mx); s += v[k]; }
            s = 1.f / wave_sum(s);
#pragma unroll
            for (int k = 0; k < 4; ++k) pl[hd * PLS + k * 64 + lane] = f2bf(v[k] * s);
        }
        f32x4 acc[4];
#pragma unroll
        for (int m = 0; m < 4; ++m) acc[m] = (f32x4){0.f, 0.f, 0.f, 0.f};
        {   const int tn = t + tqs;
            if (tn < tq1) { qn0 = *(const u32x4*)(QO + (size_t)tn * 8192 + tid * 8); qn1 = *(const u32x4*)(QO + (size_t)tn * 8192 + 4096 + tid * 8); if (tid < TOPK) seln = SEL[(size_t)tn * TOPK + tid]; } }
        AREG(3);
        for (int j2 = 0; j2 < 4; ++j2) {
            const int kt = 3 - j2;
            LDS_BARRIER();
            if (j2 > 0) {
                if (j2 == 1) {
#pragma unroll
                    for (int i = 0; i < 4; ++i) *(LAS u32x4*)(ct + (wave + 8 * i) * CTS + lane * 8) = st[i];
                } else {
#pragma unroll
                    for (int i = 0; i < 8; ++i) *(LAS u32x4*)(ct + (wave + 8 * i) * CTS + lane * 8) = st[i];
                }
                if (j2 < 3) {
#pragma unroll
                    for (int i = 0; i < 8; ++i) { const int idx = sl[(kt - 1) * 64 + wave + 8 * i]; st[i] = *(const u32x4*)(CKV + (size_t)(idx < 0 ? 0 : idx) * KVR + lane * 8); } }
                LDS_BARRIER();
            }
            const int kq = 16 * (q >> 1) + 4 * (q & 1);
#pragma unroll
            for (int s = 0; s < 2; ++s) {
                const u32x2 pa = *(const LAS u32x2*)(pl + r16 * PLS + kt * 64 + s * 32 + kq), pb = *(const LAS u32x2*)(pl + r16 * PLS + kt * 64 + s * 32 + kq + 8);
                const u32x4 pw = (u32x4){pa.x, pa.y, pb.x, pb.y}; const bf16x8_t b = __builtin_bit_cast(bf16x8_t, pw);
                const LAS bf16_t* cb = (kt == 2 && s == 1) ? cx : ct + s * 32 * CTS;
                const LAS bf16_t* tp = cb + (kq + (r16 >> 2)) * CTS + wave * 64 + (r16 & 3) * 4;
#pragma unroll
                for (int m = 0; m < 4; ++m) {
                    const s16x4_t lo = __builtin_amdgcn_ds_read_tr16_b64_v4i16((LAS s16x4_t*)(tp + m * 16)), hi = __builtin_amdgcn_ds_read_tr16_b64_v4i16((LAS s16x4_t*)(tp + 8 * CTS + m * 16));
                    const bf16x8_t a = (bf16x8_t){lo[0], lo[1], lo[2], lo[3], hi[0], hi[1], hi[2], hi[3]};
                    acc[m] = __builtin_amdgcn_mfma_f32_16x16x32_bf16(a, b, acc[m], 0, 0, 0);
                }
            }
        }
        AREG(4);
#pragma unroll
        for (int m = 0; m < 4; ++m) { u32x2 w; w.x = cvtpk(acc[m][0], acc[m][1]); w.y = cvtpk(acc[m][2], acc[m][3]);
            *(u32x2*)(QO + (size_t)t * 8192 + r16 * 512 + wave * 64 + m * 16 + q * 4) = w; }
    }
#if ATT_REG == 9
    if (blockIdx.x == ATT_BLK && threadIdx.x == 0) areg_acc = __builtin_amdgcn_s_memrealtime() - areg_t0;
#endif
#if ATT_REG > 0
    if (blockIdx.x == ATT_BLK && threadIdx.x == 0) __hip_atomic_store((unsigned*)(p.ws + WS_CTL) + 65540, (unsigned)areg_acc, __ATOMIC_RELAXED, __HIP_MEMORY_SCOPE_AGENT);
#endif
}


__device__ __forceinline__ const float* h1_row(const P& p, int m) { const float* hmeta = (const float*)(p.ws + WS_HMETA); return m < NMETA ? hmeta + (size_t)m * D : p.out + (size_t)(m - NMETA) * D; }
__device__ __forceinline__ void p12_norm(const P& p, int G) {
    const int lane = threadIdx.x & 63, wave = threadIdx.x >> 6;
    signed char* U8 = (signed char*)(p.ws + WS_U); const float* w = p.in[I_NFW];
    float wm = 0.f;
#pragma unroll
    for (int j = 0; j < 16; ++j) { const f32x4 g = *(const f32x4*)(w + (j * 64 + lane) * 4); wm += (g.x * g.x + g.y * g.y) + (g.z * g.z + g.w * g.w); }
    wm = sqrtf(wave_sum(wm) * (1.f / D));
    const float amc = 4.0f * wm;
    const float inv = amc > 0.f ? 127.f / amc : 0.f;
    if (blockIdx.x == 0 && threadIdx.x == 0) *(float*)(p.ws + WS_CTL + CT_SAG) = amc > 0.f ? amc * (1.f / 127.f) : 1.f;
    for (int m = blockIdx.x * NWAVES + wave; m < MP; m += G * NWAVES) {
        signed char* dst = U8 + (size_t)m * D;
        if (m >= L) {
#pragma unroll
            for (int j = 0; j < 4; ++j) *(u32x4*)(dst + (j * 64 + lane) * 16) = (u32x4){0u, 0u, 0u, 0u};
            continue; }
        const float* src = h1_row(p, m);
        f32x4 v[16]; float s = 0.f;
#pragma unroll
        for (int j = 0; j < 16; ++j) { v[j] = *(const f32x4*)(src + (j * 64 + lane) * 4); s += (v[j].x * v[j].x + v[j].y * v[j].y) + (v[j].z * v[j].z + v[j].w * v[j].w); }
        const float ri = rsqrtf(wave_sum(s) * (1.f / D) + 1e-6f) * inv;
#pragma unroll
        for (int j = 0; j < 16; ++j) { const f32x4 x = v[j] * ri; const f32x4 g = *(const f32x4*)(w + (j * 64 + lane) * 4);
            const unsigned q = ((unsigned)(int)rintf(fminf(fmaxf(x.x * g.x, -127.f), 127.f)) & 0xffu) | (((unsigned)(int)rintf(fminf(fmaxf(x.y * g.y, -127.f), 127.f)) & 0xffu) << 8) | (((unsigned)(int)rintf(fminf(fmaxf(x.z * g.z, -127.f), 127.f)) & 0xffu) << 16) | (((unsigned)(int)rintf(fminf(fmaxf(x.w * g.w, -127.f), 127.f)) & 0xffu) << 24);
            *(unsigned*)(dst + (j * 64 + lane) * 4) = q; }
    }
}
__device__ __forceinline__ void p18_final_norm(const P& p, int G) {
    const int tid = threadIdx.x, lane = tid & 63, wave = tid >> 6;
    const float* w = p.in[I_NFIN];
    for (int m = blockIdx.x * NWAVES + wave; m < SEQ; m += G * NWAVES) {
        float* row = p.out + (size_t)m * D;
        f32x4 v[16]; float s = 0.f;
#pragma unroll
        for (int j = 0; j < 16; ++j) { v[j] = *(const f32x4*)(row + (j * 64 + lane) * 4); s += (v[j].x * v[j].x + v[j].y * v[j].y) + (v[j].z * v[j].z + v[j].w * v[j].w); }
        float r = rsqrtf(wave_sum(s) * (1.f / D) + 1e-6f);
#if STAMP_A0 >= 0
        r *= 1.f + 1e-7f * (float)__hip_atomic_load((const unsigned*)(p.ws + WS_CTL) + 65536, __ATOMIC_RELAXED, __HIP_MEMORY_SCOPE_AGENT);
#endif
#pragma unroll
        for (int j = 0; j < 16; ++j) { const f32x4 g = *(const f32x4*)(w + (j * 64 + lane) * 4); *(f32x4*)(row + (j * 64 + lane) * 4) = v[j] * r * g; }
    }
}

__device__ __forceinline__ void p14_conv_act(const P& p, int G, int pass) {
    const int tid = threadIdx.x;
    const bf16_t* ZF = (const bf16_t*)(p.ws + WS_ZF); bf16_t* ACT = (bf16_t*)(p.ws + WS_ACT);
    const float* cw = p.in[I_CW]; const float* cb = p.in[I_CB];
    const size_t nitems = (size_t)MP * 43 * 16;
    for (size_t it = (size_t)blockIdx.x * NT + tid; it < nitems; it += (size_t)G * NT) {
        const int g8 = (int)(it % 16), tl = (int)((it / 16) % 43), t = (int)(it / (16 * 43));
        const int ch = (pass * 43 + tl) * 128 + g8 * 8;
        u32x4 o = (u32x4){0u, 0u, 0u, 0u};
        if (t < L) {
            float zg[8], zu[8];
#pragma unroll
            for (int e = 0; e < 8; ++e) { zg[e] = cb[ch + e]; zu[e] = cb[DFF + ch + e]; }
#pragma unroll
            for (int i = 0; i < 3; ++i) { const int tt = t - 2 + i;
                if (tt >= 0) {
                    const u32x4 a = *(const u32x4*)(ZF + (size_t)tt * DFF + tl * 256 + g8 * 8), b = *(const u32x4*)(ZF + (size_t)tt * DFF + tl * 256 + 128 + g8 * 8);
                    const float xa[8] = {blo(a.x), bhi(a.x), blo(a.y), bhi(a.y), blo(a.z), bhi(a.z), blo(a.w), bhi(a.w)};
                    const float xb[8] = {blo(b.x), bhi(b.x), blo(b.y), bhi(b.y), blo(b.z), bhi(b.z), blo(b.w), bhi(b.w)};
#pragma unroll
                    for (int e = 0; e < 8; ++e) { zg[e] += cw[(size_t)i * NFI + ch + e] * xa[e]; zu[e] += cw[(size_t)i * NFI + DFF + ch + e] * xb[e]; }
                } }
            float r[8];
#pragma unroll
            for (int e = 0; e < 8; ++e) r[e] = zg[e] * sigm(zg[e]) * zu[e];
            o.x = pk2(r[0], r[1]); o.y = pk2(r[2], r[3]); o.z = pk2(r[4], r[5]); o.w = pk2(r[6], r[7]);
        }
        *(u32x4*)(ACT + (size_t)t * DFF + ch) = o;
    }
}

template <int K, class F> __device__ __forceinline__ void side2(const bf16_t* A14, int lda, const bf16_t* Bt, int N, int G, F f) {
    const int lane = threadIdx.x & 63, gw = blockIdx.x * NWAVES + (threadIdx.x >> 6);
    constexpr int NC = K / 512;
    u32x4 a0[NC], a1[NC];
#pragma unroll
    for (int i = 0; i < NC; ++i) { a0[i] = *(const u32x4*)(A14 + i * 512 + lane * 8); a1[i] = *(const u32x4*)(A14 + lda + i * 512 + lane * 8); }
    for (int n = gw; n < N; n += G * NWAVES) {
        float s0 = 0.f, s1 = 0.f;
#pragma unroll
        for (int i = 0; i < NC; ++i) { const u32x4 b = *(const u32x4*)(Bt + (size_t)n * K + i * 512 + lane * 8);
            const unsigned bw[4] = {b.x, b.y, b.z, b.w}, x0[4] = {a0[i].x, a0[i].y, a0[i].z, a0[i].w}, x1[4] = {a1[i].x, a1[i].y, a1[i].z, a1[i].w};
#pragma unroll
            for (int e = 0; e < 4; ++e) { s0 += blo(x0[e]) * blo(bw[e]) + bhi(x0[e]) * bhi(bw[e]); s1 += blo(x1[e]) * blo(bw[e]) + bhi(x1[e]) * bhi(bw[e]); } }
        s0 = wave_sum(s0); s1 = wave_sum(s1);
        if (lane == 0) f(n, s0, s1);
    }
}

template <class F> __device__ __forceinline__ void side2_i8(const signed char* A14, const signed char* Bt, int N, int G, F f) {
    const int lane = threadIdx.x & 63, gw = blockIdx.x * NWAVES + (threadIdx.x >> 6);
    u32x4 a0[4], a1[4];
#pragma unroll
    for (int i = 0; i < 4; ++i) { a0[i] = *(const u32x4*)(A14 + i * 1024 + lane * 16); a1[i] = *(const u32x4*)(A14 + 4096 + i * 1024 + lane * 16); }
    for (int n = gw; n < N; n += G * NWAVES) {
        int s0 = 0, s1 = 0;
#pragma unroll
        for (int i = 0; i < 4; ++i) { const u32x4 b = *(const u32x4*)(Bt + (size_t)n * 4096 + i * 1024 + lane * 16);
            s0 = __builtin_amdgcn_sdot4((int)a0[i].x, (int)b.x, s0, false); s0 = __builtin_amdgcn_sdot4((int)a0[i].y, (int)b.y, s0, false); s0 = __builtin_amdgcn_sdot4((int)a0[i].z, (int)b.z, s0, false); s0 = __builtin_amdgcn_sdot4((int)a0[i].w, (int)b.w, s0, false);
            s1 = __builtin_amdgcn_sdot4((int)a1[i].x, (int)b.x, s1, false); s1 = __builtin_amdgcn_sdot4((int)a1[i].y, (int)b.y, s1, false); s1 = __builtin_amdgcn_sdot4((int)a1[i].z, (int)b.z, s1, false); s1 = __builtin_amdgcn_sdot4((int)a1[i].w, (int)b.w, s1, false); }
#pragma unroll
        for (int d = 32; d >= 1; d >>= 1) { s0 += __shfl_xor(s0, d); s1 += __shfl_xor(s1, d); }
        if (lane == 0) f(n, s0, s1);
    }
}

__device__ __forceinline__ void p_conv_fix(const P& p, int G) {
    const int tid = threadIdx.x;
    const float* HALO = (const float*)(p.ws + WS_ZF); bf16_t* ACT = (bf16_t*)(p.ws + WS_ACT);
    const float* cw = p.in[I_CW]; const float* cb = p.in[I_CB];
    const int nitems = 64 * 2 * DFF;
    for (int it = blockIdx.x * NT + tid; it < nitems; it += G * NT) {
        const int c = it % DFF, d = (it / DFF) & 1, pm = 1 + it / (2 * DFF);
        const int r = pm * 256 + d; if (r >= L) continue;
        const int T = c >> 7, cl = c & 127; const int colg = T * 256 + cl, colu = colg + 128;
        const float* h0 = HALO + ((size_t)(pm - 1) * 4 + 2 + d) * NFI; const float* h1 = d == 0 ? HALO + ((size_t)(pm - 1) * 4 + 3) * NFI : HALO + ((size_t)pm * 4 + 0) * NFI; const float* h2 = HALO + ((size_t)pm * 4 + d) * NFI;
        const float zg = cb[c] + cw[c] * h0[colg] + cw[(size_t)NFI + c] * h1[colg] + cw[(size_t)2 * NFI + c] * h2[colg];
        const float zu = cb[DFF + c] + cw[DFF + c] * h0[colu] + cw[(size_t)NFI + DFF + c] * h1[colu] + cw[(size_t)2 * NFI + DFF + c] * h2[colu];
        ACT[(size_t)r * DFF + c] = f2bf(zg * sigm(zg) * zu);
    }
}

constexpr int NPHASE = 20;
__global__ void __launch_bounds__(NT, 2) fwd_kernel(P p) {
    extern __shared__ __attribute__((aligned(16))) unsigned char lds_raw[];
    LAS unsigned char* lds = (LAS unsigned char*)lds_raw;
    const int G = gridDim.x;
    unsigned char* ws = p.ws;
    volatile LAS unsigned* MISC = (volatile LAS unsigned*)(lds + MISC_OFF);
    if (threadIdx.x < 16) MISC[threadIdx.x] = 0u;
    __syncthreads();
#if MK_ONE_LAUNCH
    XcdBarrier bar = xcd_barrier_post((unsigned*)(ws + WS_CTL), MISC + 8);
#define GRID_BAR() xcd_barrier(bar)
#else
#define GRID_BAR() do {} while (0)
#endif
    unsigned long long tsA0 = 0, tsA1 = 0, tsB0 = 0, tsB1 = 0; (void)tsA0; (void)tsA1; (void)tsB0; (void)tsB1;
    const int lo = p.ph_lo, hi = p.ph_hi;
#ifndef PHASE_MASK
#define PHASE_MASK 0xFFFFFFFu
#endif
#define IN(k) ((((PHASE_MASK) >> (k)) & 1u) && lo <= (k) && (k) < hi)
#ifndef STAMP_A0
#define STAMP_A0 -1
#endif
#if STAMP_A0 >= 0
#define STAMP(k) do { if (blockIdx.x == 0 && threadIdx.x == 0) { const unsigned long long t_ = __builtin_amdgcn_s_memrealtime(); if ((k) == STAMP_A0) tsA0 = t_; if ((k) == STAMP_A1) tsA1 = t_; if ((k) == STAMP_B0) tsB0 = t_; if ((k) == STAMP_B1) { tsB1 = t_; \
    __hip_atomic_store((unsigned*)(ws + WS_CTL) + 65536, (unsigned)(tsB1 - tsB0), __ATOMIC_RELAXED, __HIP_MEMORY_SCOPE_AGENT); } } } while (0)
#else
#define STAMP(k) do {} while (0)
#endif
#define SEAM(k) do { if (IN((k) + 1)) GRID_BAR(); STAMP((k) + 1); } while (0)
    STAMP(0);
#ifndef PROBE_REP_MASK
#define PROBE_REP_MASK 0u
#endif
#define NREP(k) ((((PROBE_REP_MASK) >> (k)) & 1u) ? 2 : 1)
    bf16_t* U = (bf16_t*)(ws + WS_U);
    if (IN(0)) _Pragma("unroll") for (int rep_ = 0; rep_ < NREP(0); ++rep_) { p0_prologue_a(p, lds, G); GRID_BAR(); p0_prologue_b(p, lds, G); if (rep_ == NREP(0) - 1) SEAM(0); }
    if (IN(1)) _Pragma("unroll") for (int rep_ = 0; rep_ < NREP(1); ++rep_) {
        {   pg8::Gemm g{U, (const bf16_t*)(ws + WS_WINT), MP, NZ8, D / 2, (const float*)(ws + WS_CTL + CT_SA), (const float*)(ws + WS_CTL + CT_SB_IN)}; pg8::StaticOrder S; S.init(MP, NZ8, G, (int)blockIdx.x);
            pg8::EpiBf16<0> E{(bf16_t*)(ws + WS_Z), NZ};
            pg8::gemm_phase<pg8::EpiBf16<0>, pg8::StaticOrder, true, true, true>(lds, g, S, E); }
        {   pg8::Gemm g{(const bf16_t*)(ws + WS_R1), (const bf16_t*)(ws + WS_WINT + WINT_BF_OFF), MP, NZ - NZ8, D}; pg8::StaticOrder S; S.init(MP, NZ - NZ8, G, (int)blockIdx.x);
            pg8::EpiBf16<0> E{(bf16_t*)(ws + WS_Z) + NZ8, NZ};
            pg8::gemm_phase<pg8::EpiBf16<0>, pg8::StaticOrder, true, true, false>(lds, g, S, E); }
        if (rep_ == NREP(1) - 1) SEAM(1);
    }
    if (IN(2)) _Pragma("unroll") for (int rep_ = 0; rep_ < NREP(2); ++rep_) { p2_rwkv_prep(p, lds, G); if (rep_ == NREP(2) - 1) SEAM(2); }
    if (IN(3)) _Pragma("unroll") for (int rep_ = 0; rep_ < NREP(3); ++rep_) { ra_items(p, lds, G); if (rep_ == NREP(3) - 1) SEAM(3); }
    if (IN(4)) _Pragma("unroll") for (int rep_ = 0; rep_ < NREP(4); ++rep_) { rb_chain(p, G);
        {
            const int wv_ = threadIdx.x >> 6, nch_ = G < 128 ? G : 128; const int nvw_ = nch_ * 7 + (G - nch_) * 8;
            const int vw_ = (int)blockIdx.x < nch_ ? ((int)blockIdx.x * 7 + wv_ - 1) : (nch_ * 7 + ((int)blockIdx.x - nch_) * 8 + wv_);
            if (!((int)blockIdx.x < nch_ && wv_ == 0)) p0b_weights(p, lds, vw_, nvw_); }
        if (rep_ == NREP(4) - 1) SEAM(4); }
    if (IN(5)) _Pragma("unroll") for (int rep_ = 0; rep_ < NREP(5); ++rep_) { rc_out(p, G); if (rep_ == NREP(5) - 1) SEAM(5); }
    if (IN(6)) _Pragma("unroll") for (int rep_ = 0; rep_ < NREP(6); ++rep_) { p4_dsa_prep(p, G); if (rep_ == NREP(6) - 1) SEAM(6); }
    if (IN(7)) _Pragma("unroll") for (int rep_ = 0; rep_ < NREP(7); ++rep_) { d2_topk(p, lds, G); if (rep_ == NREP(7) - 1) SEAM(7); }
    if (IN(8)) _Pragma("unroll") for (int rep_ = 0; rep_ < NREP(8); ++rep_) { d3_qlat(p, G); if (rep_ == NREP(8) - 1) SEAM(8); }
    if (IN(9)) _Pragma("unroll") for (int rep_ = 0; rep_ < NREP(9); ++rep_) { d4_attn(p, lds, G); if (rep_ == NREP(9) - 1) SEAM(9); }
    if (IN(11)) _Pragma("unroll") for (int rep_ = 0; rep_ < NREP(11); ++rep_) {
        d5_oproj(p, lds, G);
        pg8::Gemm g{U + (size_t)NMETA * (D / 2), (const bf16_t*)(ws + WS_WGT), SEQ, 8192, D / 2, (const float*)(ws + WS_CTL + CT_SA) + NMETA, (const float*)(ws + WS_CTL + CT_SB_G)}; pg8::StaticOrder S; S.init(SEQ, 8192, G, (int)blockIdx.x);
        pg8::EpiBf16<1> E{(bf16_t*)(ws + WS_GATES) + (size_t)NMETA * 8192, 8192};
        pg8::gemm_phase<pg8::EpiBf16<1>, pg8::StaticOrder, true, true, true>(lds, g, S, E);
        {   const float* SA_ = (const float*)(ws + WS_CTL + CT_SA); const float* SB_ = (const float*)(ws + WS_CTL + CT_SB_G); bf16_t* GT = (bf16_t*)(ws + WS_GATES);
            side2_i8((const signed char*)(ws + WS_U) + (size_t)14 * D, (const signed char*)(ws + WS_WGT), 8192, G, [&](int n, int i0, int i1) {
                GT[(size_t)14 * 8192 + n] = f2bf(1.f / (1.f + __expf(-(float)i0 * SA_[14] * SB_[n]))); GT[(size_t)15 * 8192 + n] = f2bf(1.f / (1.f + __expf(-(float)i1 * SA_[15] * SB_[n]))); }); }
        if (rep_ == NREP(11) - 1) SEAM(11);
    }
    if (IN(12)) _Pragma("unroll") for (int rep_ = 0; rep_ < NREP(12); ++rep_) {
        pg8::Gemm g{(const bf16_t*)(ws + WS_YA) + (size_t)NMETA * A_W, (const bf16_t*)(ws + WS_WPAT), SEQ, D, A_W}; pg8::StaticOrder S; S.init(SEQ, D, G, (int)blockIdx.x);
        pg8::EpiGateMulF32 E{(bf16_t*)(ws + WS_MF) + (size_t)NMETA * D, D, (const bf16_t*)(ws + WS_GATES) + (size_t)NMETA * 8192, 8192, 0};
        pg8::gemm_phase<pg8::EpiGateMulF32, pg8::StaticOrder, true, true>(lds, g, S, E);
        {   bf16_t* MA = (bf16_t*)(ws + WS_MF); const bf16_t* GT = (const bf16_t*)(ws + WS_GATES);
            side2<2048>((const bf16_t*)(ws + WS_YA) + (size_t)14 * A_W, A_W, (const bf16_t*)(ws + WS_WPAT), D, G, [&](int n, float s0, float s1) {
                MA[(size_t)14 * D + n] = f2bf(bf2f(GT[(size_t)14 * 8192 + n]) * s0); MA[(size_t)15 * D + n] = f2bf(bf2f(GT[(size_t)15 * 8192 + n]) * s1); }); }
        if (rep_ == NREP(12) - 1) SEAM(12);
    }
    if (IN(13)) _Pragma("unroll") for (int rep_ = 0; rep_ < NREP(13); ++rep_) {
        pg8::Gemm g{(const bf16_t*)(ws + WS_YB) + (size_t)NMETA * A_W, (const bf16_t*)(ws + WS_WPBT), SEQ, D, A_W}; pg8::StaticOrder S; S.init(SEQ, D, G, (int)blockIdx.x);
        pg8::EpiGateMulAddBf16 E{U + (size_t)NMETA * D, D, (const bf16_t*)(ws + WS_MF) + (size_t)NMETA * D, (const bf16_t*)(ws + WS_GATES) + (size_t)NMETA * 8192, 8192, D};
        pg8::gemm_phase<pg8::EpiGateMulAddBf16, pg8::StaticOrder, true, true>(lds, g, S, E);
        {   const bf16_t* MA = (const bf16_t*)(ws + WS_MF); const bf16_t* GT = (const bf16_t*)(ws + WS_GATES);
            side2<2048>((const bf16_t*)(ws + WS_YB) + (size_t)14 * A_W, A_W, (const bf16_t*)(ws + WS_WPBT), D, G, [&](int n, float s0, float s1) {
                U[(size_t)14 * D + n] = f2bf(bf2f(MA[(size_t)14 * D + n]) + bf2f(GT[(size_t)14 * 8192 + D + n]) * s0); U[(size_t)15 * D + n] = f2bf(bf2f(MA[(size_t)15 * D + n]) + bf2f(GT[(size_t)15 * 8192 + D + n]) * s1); }); }
        if (rep_ == NREP(13) - 1) SEAM(13);
    }
    if (IN(14)) _Pragma("unroll") for (int rep_ = 0; rep_ < NREP(14); ++rep_) {
        pg8::Gemm g{U + (size_t)NMETA * D, (const bf16_t*)(ws + WS_WOUTT), SEQ, D, D}; pg8::StaticOrder S; S.init(SEQ, D, G, (int)blockIdx.x);
        pg8::EpiResid E{p.in[I_X], p.in[I_X], p.out, p.out, D, 0, SEQ};
        pg8::gemm_phase<pg8::EpiResid, pg8::StaticOrder, true, true>(lds, g, S, E);
        {   float* HM = (float*)(ws + WS_HMETA); const float* mt = p.in[I_META];
            for (int i2 = blockIdx.x * NT + threadIdx.x; i2 < 14 * D; i2 += G * NT) HM[i2] = mt[i2];
            side2<4096>(U + (size_t)14 * D, D, (const bf16_t*)(ws + WS_WOUTT), D, G, [&](int n, float s0, float s1) { HM[(size_t)14 * D + n] = mt[(size_t)14 * D + n] + s0; HM[(size_t)15 * D + n] = mt[(size_t)15 * D + n] + s1; }); }
        if (rep_ == NREP(14) - 1) SEAM(14);
    }
    if (IN(15)) _Pragma("unroll") for (int rep_ = 0; rep_ < NREP(15); ++rep_) { p12_norm(p, G); if (rep_ == NREP(15) - 1) SEAM(15); }
    if (IN(16)) _Pragma("unroll") for (int rep_ = 0; rep_ < NREP(16); ++rep_) {
        pg8::Gemm g{U, (const bf16_t*)(ws + WS_WFIT), MP, NFI, D / 2, (const float*)(ws + WS_CTL + CT_SA), (const float*)(ws + WS_CTL + CT_SB_F)}; pg8::StaticOrder S; S.init(MP, NFI, G, (int)blockIdx.x);
        pg8::EpiConvAct E{(bf16_t*)(ws + WS_ACT), DFF, (float*)(ws + WS_ZF), NFI, p.in[I_CW], p.in[I_CB], DFF, (PG8_LAS float*)(lds + 131072), (const float*)(ws + WS_CTL + CT_SAG), (const float*)(ws + WS_CTL + CT_SB_F)};
        pg8::gemm_phase<pg8::EpiConvAct, pg8::StaticOrder, true, true, true>(lds, g, S, E);
        if (rep_ == NREP(16) - 1) SEAM(16);
    }
    if (IN(17)) _Pragma("unroll") for (int rep_ = 0; rep_ < NREP(17); ++rep_) { p_conv_fix(p, G); if (rep_ == NREP(17) - 1) SEAM(17); }
    if (IN(18)) _Pragma("unroll") for (int rep_ = 0; rep_ < NREP(18); ++rep_) {
        pg8::Gemm g{(const bf16_t*)(ws + WS_ACT) + (size_t)NMETA * DFF, (const bf16_t*)(ws + WS_WFOT), SEQ, D, DFF}; pg8::StaticOrder S; S.init(SEQ, D, G, (int)blockIdx.x);
        pg8::EpiResid E{p.out, p.out, p.out, p.out, D, 0, SEQ};
        pg8::gemm_phase<pg8::EpiResid, pg8::StaticOrder, true, true>(lds, g, S, E);
        if (rep_ == NREP(18) - 1) SEAM(18);
    }
    if (IN(19)) _Pragma("unroll") for (int rep_ = 0; rep_ < NREP(19); ++rep_) { p18_final_norm(p, G); }
#if STAMP_A0 >= 0
    if (blockIdx.x == 0 && threadIdx.x == 0) { const unsigned long long t_end = __builtin_amdgcn_s_memrealtime(); unsigned long long dA = (tsA1 - tsA0) * 64ull;
#if defined(ATT_REG) && ATT_REG > 0
        dA = (unsigned long long)__hip_atomic_load((const unsigned*)(ws + WS_CTL) + 65540, __ATOMIC_RELAXED, __HIP_MEMORY_SCOPE_AGENT) * 64ull;
#endif
        while (__builtin_amdgcn_s_memrealtime() - t_end < dA) __builtin_amdgcn_s_sleep(8); }
#endif
#undef IN
#undef SEAM
}

extern "C" void kernel_launch(void* const* d_in, const int* in_sizes, int n_in, void* d_out, int out_size, void* d_ws, size_t ws_size, hipStream_t stream) {
    static int grid = 0;
    if (grid == 0) {
        if (n_in != 30 || out_size != SEQ * D || ws_size < WS_END2) { fprintf(stderr, "kernel_launch: unexpected shapes (n_in %d out %d ws %zu need %zu)\n", n_in, out_size, ws_size, (size_t)WS_END); grid = -1; return; }
        int dev = 0, cus = 0, per_cu = 0;
        if (hipGetDevice(&dev) != hipSuccess || hipDeviceGetAttribute(&cus, hipDeviceAttributeMultiprocessorCount, dev) != hipSuccess) { grid = -1; return; }
        if (hipFuncSetAttribute((const void*)fwd_kernel, hipFuncAttributeMaxDynamicSharedMemorySize, LDS_BYTES) != hipSuccess) { fprintf(stderr, "kernel_launch: hipFuncSetAttribute failed\n"); grid = -1; return; }
        if (hipOccupancyMaxActiveBlocksPerMultiprocessor(&per_cu, (const void*)fwd_kernel, NT, LDS_BYTES) != hipSuccess || per_cu < 1) fprintf(stderr, "kernel_launch: occupancy query says %d\n", per_cu);
        (void)hipGetLastError();
        grid = cus;
    }
    if (grid < 0) return;
    (void)hipMemsetAsync((char*)d_ws + WS_CTL, 0, CTL_BYTES, stream);
    P a{};
    for (int i = 0; i < 30; ++i) a.in[i] = (const float*)d_in[i];
    a.out = (float*)d_out; a.ws = (unsigned char*)d_ws;
#if MK_ONE_LAUNCH
    a.ph_lo = 0; a.ph_hi = NPHASE;
    hipLaunchKernelGGL(fwd_kernel, dim3(grid), dim3(NT), LDS_BYTES, stream, a);
#else
    for (int k = 0; k < NPHASE; ++k) { a.ph_lo = k; a.ph_hi = k + 1; hipLaunchKernelGGL(fwd_kernel, dim3(grid), dim3(NT), LDS_BYTES, stream, a); }
#endif
}
```

```cpp
#include <hip/hip_runtime.h>
#include <cstdio>
#include <cstdint>
#define MK_ONE_LAUNCH 1
namespace pg8 {
#define PG8_LAS __attribute__((address_space(3)))
typedef unsigned short bf16_t;
typedef short bf16x8 __attribute__((ext_vector_type(8)));
typedef float f32x4 __attribute__((ext_vector_type(4)));
typedef unsigned u32x4 __attribute__((ext_vector_type(4)));
typedef int i32x4 __attribute__((ext_vector_type(4)));
constexpr int BM = 256, BK = 64, HALF = 128, HTB = HALF * BK * 2  , STAGE_BYTES = 8 * HTB, NXCD = 8, WGM = 4;

__host__ __device__ __forceinline__ int lds_byte(int r, int c) { const int st = (r >> 4) * 2 + (c >> 5), rr = r & 15, cc = c & 31, ob = rr * 64 + cc * 2; return st * 1024 + (ob ^ (((ob >> 9) & 1) << 5)); }
__host__ __device__ __forceinline__ void stage_rc(int b, int& R, int& C) { const int st = b / 1024, sb = b % 1024, swz = sb ^ (((sb >> 9) & 1) << 5); R = (st >> 1) * 16 + swz / 64; C = (st & 1) * 32 + (swz % 64) / 2; }
__host__ __device__ __forceinline__ int perm32(int rho) { const int n = rho >> 4, i = rho & 15; return 8 * (i >> 2) + 4 * n + (i & 3); }

struct Unit { int pm, pn; };
struct Gemm { const bf16_t* A; const bf16_t* Bt; int M, N, K; const float* sa; const float* sb; };

struct StaticOrder {
    int nM, nN, nwg, G, c;
    __host__ __device__ void init(int M, int N, int G_, int c_) { nM = M / BM; nN = N / BM; nwg = nM * nN; G = G_; c = c_; }
    __host__ __device__ bool next(int i, Unit& u) const {
        const long L = (long)i * G + c; if (L >= nwg) return false;
        int wgid = (int)L; { const int q = nwg / NXCD, r = nwg % NXCD, xcd = wgid % NXCD, off = wgid / NXCD; wgid = (xcd < r ? xcd * (q + 1) : r * (q + 1) + (xcd - r) * q) + off; }
        const int nig = WGM * nN, gid = wgid / nig, fm = gid * WGM, gsz = (nM - fm) < WGM ? (nM - fm) : WGM;
        u.pm = fm + ((wgid % nig) % gsz); u.pn = (wgid % nig) / gsz; return true;
    }
    __device__ __forceinline__ void a_ready(const Unit&) const {}
    __device__ __forceinline__ void done(const Unit&) const {}
};

__device__ __forceinline__ unsigned cvt_pk_bf16(float lo, float hi) { unsigned r; asm volatile("v_cvt_pk_bf16_f32 %0, %1, %2" : "=v"(r) : "v"(lo), "v"(hi)); return r; }
typedef float f32x2 __attribute__((ext_vector_type(2)));

typedef unsigned u32x2 __attribute__((ext_vector_type(2)));
__device__ __forceinline__ float bf_lo(unsigned w) { return __uint_as_float(w << 16); }
__device__ __forceinline__ float bf_hi(unsigned w) { return __uint_as_float(w & 0xffff0000u); }
__device__ __forceinline__ float sigmoidf_(float x) { return 1.f / (1.f + __expf(-x)); }

template <int ACT> struct EpiBf16 {
    static constexpr bool PERM = true, AFTER_DRAIN = false, SELF_SCALE = false;
    bf16_t* O; int ldc;
    __device__ __forceinline__ void operator()(const f32x4 (&acc)[2][2][4][2], const Unit& u, int wr, int wc, int fr, int fq) const {
        const int row0 = u.pm * BM + wr * 64 + fr; const int col0 = u.pn * BM + wc * 32 + 8 * fq;
#pragma unroll
        for (int ai = 0; ai < 2; ++ai)
#pragma unroll
            for (int m = 0; m < 4; ++m) { bf16_t* rowp = O + (size_t)(row0 + ai * HALF + m * 16) * ldc + col0;
#pragma unroll
                for (int bj = 0; bj < 2; ++bj) { f32x4 v0 = acc[ai][bj][m][0], v1 = acc[ai][bj][m][1];
                    if (ACT == 1) {
#pragma unroll
                        for (int e = 0; e < 4; ++e) { v0[e] = sigmoidf_(v0[e]); v1[e] = sigmoidf_(v1[e]); } }
                    u32x4 w; w.x = cvt_pk_bf16(v0[0], v0[1]); w.y = cvt_pk_bf16(v0[2], v0[3]); w.z = cvt_pk_bf16(v1[0], v1[1]); w.w = cvt_pk_bf16(v1[2], v1[3]);
                    *(u32x4*)(rowp + bj * HALF) = w; } }
    }
};
struct EpiGateMulF32 {
    static constexpr bool PERM = true, AFTER_DRAIN = false, SELF_SCALE = false;
    bf16_t* MA; int ldc; const bf16_t* G; int ldg; int gcol0;
    __device__ __forceinline__ void operator()(const f32x4 (&acc)[2][2][4][2], const Unit& u, int wr, int wc, int fr, int fq) const {
        const int row0 = u.pm * BM + wr * 64 + fr, col0 = u.pn * BM + wc * 32 + 8 * fq;
#pragma unroll
        for (int ai = 0; ai < 2; ++ai)
#pragma unroll
            for (int m = 0; m < 4; ++m) { const size_t r = (size_t)(row0 + ai * HALF + m * 16); bf16_t* rowp = MA + r * ldc + col0; const bf16_t* gp = G + r * ldg + gcol0 + col0;
#pragma unroll
                for (int bj = 0; bj < 2; ++bj) { const u32x4 g = *(const u32x4*)(gp + bj * HALF); const f32x4 a0 = acc[ai][bj][m][0], a1 = acc[ai][bj][m][1];
                    u32x4 w; w.x = cvt_pk_bf16(a0[0] * bf_lo(g.x), a0[1] * bf_hi(g.x)); w.y = cvt_pk_bf16(a0[2] * bf_lo(g.y), a0[3] * bf_hi(g.y));
                    w.z = cvt_pk_bf16(a1[0] * bf_lo(g.z), a1[1] * bf_hi(g.z)); w.w = cvt_pk_bf16(a1[2] * bf_lo(g.w), a1[3] * bf_hi(g.w));
                    *(u32x4*)(rowp + bj * HALF) = w; } }
    }
};
struct EpiGateMulAddBf16 {
    static constexpr bool PERM = true, AFTER_DRAIN = false, SELF_SCALE = false;
    bf16_t* MB; int ldc; const bf16_t* MA; const bf16_t* G; int ldg; int gcol0;
    __device__ __forceinline__ void operator()(const f32x4 (&acc)[2][2][4][2], const Unit& u, int wr, int wc, int fr, int fq) const {
        const int row0 = u.pm * BM + wr * 64 + fr, col0 = u.pn * BM + wc * 32 + 8 * fq;
#pragma unroll
        for (int ai = 0; ai < 2; ++ai)
#pragma unroll
            for (int m = 0; m < 4; ++m) { const size_t r = (size_t)(row0 + ai * HALF + m * 16); bf16_t* rowp = MB + r * ldc + col0; const bf16_t* mp = MA + r * ldc + col0; const bf16_t* gp = G + r * ldg + gcol0 + col0;
#pragma unroll
                for (int bj = 0; bj < 2; ++bj) { const u32x4 g = *(const u32x4*)(gp + bj * HALF); const u32x4 mm = *(const u32x4*)(mp + bj * HALF);
                    const f32x4 a0 = acc[ai][bj][m][0], a1 = acc[ai][bj][m][1];
                    u32x4 w; w.x = cvt_pk_bf16(bf_lo(mm.x) + a0[0] * bf_lo(g.x), bf_hi(mm.x) + a0[1] * bf_hi(g.x)); w.y = cvt_pk_bf16(bf_lo(mm.y) + a0[2] * bf_lo(g.y), bf_hi(mm.y) + a0[3] * bf_hi(g.y));
                    w.z = cvt_pk_bf16(bf_lo(mm.z) + a1[0] * bf_lo(g.z), bf_hi(mm.z) + a1[1] * bf_hi(g.z)); w.w = cvt_pk_bf16(bf_lo(mm.w) + a1[2] * bf_lo(g.w), bf_hi(mm.w) + a1[3] * bf_hi(g.w));
                    *(u32x4*)(rowp + bj * HALF) = w; } }
    }
};
struct EpiResid {
    static constexpr bool PERM = false, AFTER_DRAIN = false, SELF_SCALE = false;
    const float* smeta; const float* sreal; float* dmeta; float* dreal; int ld; int nmeta; int nrows;
    __device__ __forceinline__ void operator()(const f32x4 (&acc)[2][2][4][2], const Unit& u, int wr, int wc, int fr, int fq) const {
        const int row0 = u.pm * BM + wr * 64 + fr, col0 = u.pn * BM + wc * 32 + 4 * fq;
#pragma unroll
        for (int ai = 0; ai < 2; ++ai)
#pragma unroll
            for (int m = 0; m < 4; ++m) { const int r = row0 + ai * HALF + m * 16;
                if (r < nrows) {
                    const float* sp = (r < nmeta ? smeta + (size_t)r * ld : sreal + (size_t)(r - nmeta) * ld) + col0;
                    float* dp = (r < nmeta ? dmeta + (size_t)r * ld : dreal + (size_t)(r - nmeta) * ld) + col0;
#pragma unroll
                    for (int bj = 0; bj < 2; ++bj)
#pragma unroll
                        for (int n = 0; n < 2; ++n) *(f32x4*)(dp + bj * HALF + n * 16) = *(const f32x4*)(sp + bj * HALF + n * 16) + acc[ai][bj][m][n];
                } }
    }
};

template <int CTRL> __device__ __forceinline__ float dpp_mov(float v) { return __builtin_bit_cast(float, __builtin_amdgcn_update_dpp(0, __builtin_bit_cast(int, v), CTRL, 0xf, 0xf, false)); }
struct EpiConvAct {
    static constexpr bool PERM = true, AFTER_DRAIN = false, SELF_SCALE = true;
    bf16_t* ACT; int ldact; float* HALO; int ldh; const float* cw; const float* cb; int dff; PG8_LAS float* hx; const float* sag; const float* sb;
    __device__ __forceinline__ void operator()(const f32x4 (&acc)[2][2][4][2], const Unit& u, int wr, int wc, int fr, int fq) const {
        const int cl = wc * 32 + 8 * fq;
        const int ch = u.pn * 128 + cl;
        if (fr >= 14) {
#pragma unroll
            for (int ai = 0; ai < 2; ++ai)
#pragma unroll
                for (int bj = 0; bj < 2; ++bj)
#pragma unroll
                    for (int n = 0; n < 2; ++n) *(PG8_LAS f32x4*)(hx + (((ai * 2 + wr) * 2 + (fr - 14)) * 256 + bj * 128 + cl + 4 * n)) = acc[ai][bj][3][n];
        }
        if (wr == 0 && fr < 2) {
            float* hp = HALO + ((size_t)u.pm * 4 + fr) * ldh + u.pn * 256 + cl;
#pragma unroll
            for (int bj = 0; bj < 2; ++bj)
#pragma unroll
                for (int n = 0; n < 2; ++n) *(f32x4*)(hp + bj * 128 + 4 * n) = acc[0][bj][0][n] * (*(const f32x4*)(sb + u.pn * 256 + bj * 128 + cl + 4 * n) * sag[0]);
        }
        if (wr == 1 && fr >= 14) {
            float* hp = HALO + ((size_t)u.pm * 4 + (fr - 12)) * ldh + u.pn * 256 + cl;
#pragma unroll
            for (int bj = 0; bj < 2; ++bj)
#pragma unroll
                for (int n = 0; n < 2; ++n) *(f32x4*)(hp + bj * 128 + 4 * n) = acc[1][bj][3][n] * (*(const f32x4*)(sb + u.pn * 256 + bj * 128 + cl + 4 * n) * sag[0]);
        }
        asm volatile("s_waitcnt lgkmcnt(0)" ::: "memory"); __builtin_amdgcn_s_barrier(); asm volatile("" ::: "memory");
#pragma unroll
        for (int n = 0; n < 2; ++n) {
            f32x4 wt[2][3], bb[2];
#pragma unroll
            for (int bj = 0; bj < 2; ++bj) { bb[bj] = *(const f32x4*)(cb + bj * dff + ch + 4 * n);
#pragma unroll
                for (int i = 0; i < 3; ++i) wt[bj][i] = *(const f32x4*)(cw + (size_t)i * 2 * dff + bj * dff + ch + 4 * n) * (*(const f32x4*)(sb + u.pn * 256 + bj * 128 + cl + 4 * n) * sag[0]); }
#pragma unroll
            for (int ai = 0; ai < 2; ++ai) {
                const bool hasprev = (ai | wr) != 0; const int pb = ai * 2 + wr - 1;
                f32x4 xp[2];
#pragma unroll
                for (int bj = 0; bj < 2; ++bj) { xp[bj] = (f32x4){0.f, 0.f, 0.f, 0.f};
                    if (hasprev && fr >= 14) xp[bj] = *(const PG8_LAS f32x4*)(hx + ((pb * 2 + (fr - 14)) * 256 + bj * 128 + cl + 4 * n)); }
#pragma unroll
                for (int m = 0; m < 4; ++m) {
                    f32x4 z[2];
#pragma unroll
                    for (int bj = 0; bj < 2; ++bj) {
                        const f32x4 x = acc[ai][bj][m][n];
#pragma unroll
                        for (int j = 0; j < 4; ++j) {
                            const float a1 = dpp_mov<0x121>(x[j]), p1 = dpp_mov<0x121>(xp[bj][j]), a2 = dpp_mov<0x122>(x[j]), p2 = dpp_mov<0x122>(xp[bj][j]);
                            const float s1 = fr == 0 ? p1 : a1, s2 = fr < 2 ? p2 : a2;
                            z[bj][j] = bb[bj][j] + wt[bj][2][j] * x[j] + wt[bj][1][j] * s1 + wt[bj][0][j] * s2;
                        }
                        xp[bj] = x;
                    }
                    const int r = u.pm * BM + ai * HALF + wr * 64 + m * 16 + fr;
                    float o[4];
#pragma unroll
                    for (int j = 0; j < 4; ++j) { const float g = z[0][j]; o[j] = g * __builtin_amdgcn_rcpf(1.f + __expf(-g)) * z[1][j]; }
                    u32x2 w; w.x = cvt_pk_bf16(o[0], o[1]); w.y = cvt_pk_bf16(o[2], o[3]);
                    *(u32x2*)(ACT + (size_t)r * ldact + ch + 4 * n) = w;
                }
                asm volatile("" ::: "memory");
            }
        }
    }
};
template <class Epi, class Sched, bool ALIGN_EPI = false, bool SP2 = false, bool I8 = false>
__device__ __forceinline__ void gemm_phase(PG8_LAS unsigned char* lds, const Gemm g, const Sched& S, const Epi& E) {
    const int tid = threadIdx.x, wid = __builtin_amdgcn_readfirstlane(tid >> 6), lane = tid & 63, wr = wid >> 2, wc = wid & 3, fr = lane & 15, fq = lane >> 4;
    const int K = g.K, nt = K / BK;
    unsigned voffA[2], voffB[2];
#pragma unroll
    for (int i = 0; i < 2; ++i) { int R, C; stage_rc(tid * 16 + i * 8192, R, C); const int Rb = Epi::PERM ? ((R & ~31) + perm32(R & 31)) : R;
        voffA[i] = (unsigned)(R * K + C) * 2u; voffB[i] = (unsigned)(Rb * K + C) * 2u; }
    const size_t kstep = (size_t)(BK * 2);
    const size_t hstep = (size_t)HALF * K * 2;
    const size_t tstep = 2 * hstep;
    const unsigned ldsw = (unsigned)wid * 1024u;
    const int aoff = lds_byte(wr * 64 + fr, fq * 8), boff = lds_byte(wc * 32 + fr, fq * 8);
#define PG8_SA(b, h) (((b) * 2 + (h)) * HTB)
#define PG8_SB(b, h) ((4 + (b) * 2 + (h)) * HTB)
#define PG8_STAGE(bufoff, gbase, voff) do { _Pragma("unroll") for (int _i = 0; _i < 2; ++_i) \
        __builtin_amdgcn_global_load_lds((const unsigned*)((const char*)(gbase) + (voff)[_i]), (PG8_LAS unsigned*)(lds + (bufoff) + ldsw + _i * 8192), 16, 0, 0); } while (0)
#define PG8_LDA(dst, b, h) do { _Pragma("unroll") for (int m = 0; m < 4; ++m) _Pragma("unroll") for (int k = 0; k < 2; ++k) dst[m][k] = *(const PG8_LAS bf16x8*)(lds + PG8_SA(b, h) + aoff + m * 2048 + k * 1024); } while (0)
#define PG8_LDB(dst, b, h) do { _Pragma("unroll") for (int n = 0; n < 2; ++n) _Pragma("unroll") for (int k = 0; k < 2; ++k) dst[n][k] = *(const PG8_LAS bf16x8*)(lds + PG8_SB(b, h) + boff + n * 2048 + k * 1024); } while (0)
#define PG8_MMA(ai, bj, At, Bt) do { __builtin_amdgcn_s_setprio(1); _Pragma("unroll") for (int m = 0; m < 4; ++m) _Pragma("unroll") for (int n = 0; n < 2; ++n) _Pragma("unroll") for (int k = 0; k < 2; ++k) { \
        if constexpr (I8) acc[ai][bj][m][n] = __builtin_bit_cast(f32x4, __builtin_amdgcn_mfma_i32_16x16x64_i8(__builtin_bit_cast(i32x4, Bt[n][k]), __builtin_bit_cast(i32x4, At[m][k]), __builtin_bit_cast(i32x4, acc[ai][bj][m][n]), 0, 0, 0)); \
        else acc[ai][bj][m][n] = __builtin_amdgcn_mfma_f32_16x16x32_bf16(Bt[n][k], At[m][k], acc[ai][bj][m][n], 0, 0, 0); } __builtin_amdgcn_s_setprio(0); } while (0)
#define PG8_WAIT_V(n) asm volatile("s_waitcnt vmcnt(" #n ")" ::: "memory")
#define PG8_WAIT_L(n) asm volatile("s_waitcnt lgkmcnt(" #n ")" ::: "memory")
#define PG8_BAR __builtin_amdgcn_s_barrier()
#define PG8_SCHED __builtin_amdgcn_sched_barrier(0)
    Unit cur, nxt; int ui = 0;
    if (!S.next(0, cur)) return;
    f32x4 acc[2][2][4][2];
#pragma unroll
    for (int a = 0; a < 2; ++a)
#pragma unroll
        for (int b = 0; b < 2; ++b)
#pragma unroll
            for (int m = 0; m < 4; ++m)
#pragma unroll
                for (int n = 0; n < 2; ++n) acc[a][b][m][n] = (f32x4){0.f, 0.f, 0.f, 0.f};
    bf16x8 At[4][2], B0[2][2], B1[2][2];
    const char* cA = (const char*)g.A + (size_t)cur.pm * tstep; const char* cB = (const char*)g.Bt + (size_t)cur.pn * tstep;
    S.a_ready(cur);
    if constexpr (SP2) {
        PG8_STAGE(PG8_SB(0, 0), cB, voffB); PG8_STAGE(PG8_SB(0, 1), cB + hstep, voffB); PG8_STAGE(PG8_SA(0, 0), cA, voffA); PG8_STAGE(PG8_SA(0, 1), cA + hstep, voffA);
        if (wr == 1) PG8_BAR;
        PG8_WAIT_V(2); PG8_BAR;
        PG8_STAGE(PG8_SB(1, 0), cB + kstep, voffB); PG8_STAGE(PG8_SA(1, 0), cA + kstep, voffA); PG8_STAGE(PG8_SB(1, 1), cB + hstep + kstep, voffB);
        PG8_WAIT_V(6); PG8_BAR;
    } else {
        PG8_STAGE(PG8_SB(0, 0), cB, voffB); PG8_STAGE(PG8_SA(0, 0), cA, voffA); PG8_STAGE(PG8_SB(0, 1), cB + hstep, voffB); PG8_STAGE(PG8_SA(0, 1), cA + hstep, voffA);
        if (wr == 1) PG8_BAR;
        PG8_WAIT_V(4); PG8_BAR;
        PG8_STAGE(PG8_SB(1, 0), cB + kstep, voffB); PG8_STAGE(PG8_SA(1, 0), cA + kstep, voffA); PG8_STAGE(PG8_SB(1, 1), cB + hstep + kstep, voffB);
        PG8_WAIT_V(6); PG8_BAR;
    }
    for (;;) {
        const bool has_next = S.next(ui + 1, nxt);
        const char* nA = has_next ? (const char*)g.A + (size_t)nxt.pm * tstep : cA; const char* nB = has_next ? (const char*)g.Bt + (size_t)nxt.pn * tstep : cB;
        for (int t = 0; t < nt; t += 2) {
            const bool last = (t == nt - 2);
            const char* a1 = cA + (size_t)(t + 1) * kstep;
            const char* a2 = last ? nA : cA + (size_t)(t + 2) * kstep; const char* b2 = last ? nB : cB + (size_t)(t + 2) * kstep;
            const char* a3 = a2 + kstep; const char* b3 = b2 + kstep;
            if (last && has_next) S.a_ready(nxt);
            if constexpr (SP2) {
            PG8_LDB(B0, 0, 0); PG8_LDB(B1, 0, 1); PG8_SCHED; PG8_LDA(At, 0, 0); PG8_STAGE(PG8_SA(1, 1), a1 + hstep, voffA);
            PG8_WAIT_V(8); PG8_WAIT_L(0); PG8_BAR; PG8_MMA(0, 0, At, B0); PG8_MMA(0, 1, At, B1); PG8_BAR; PG8_SCHED;
            PG8_LDA(At, 0, 1); PG8_STAGE(PG8_SB(0, 0), b2, voffB); PG8_STAGE(PG8_SB(0, 1), b2 + hstep, voffB); PG8_STAGE(PG8_SA(0, 0), a2, voffA);
            PG8_WAIT_V(8); PG8_WAIT_L(0); PG8_BAR; PG8_MMA(1, 0, At, B0); PG8_MMA(1, 1, At, B1); PG8_BAR; PG8_SCHED;
            PG8_LDB(B0, 1, 0); PG8_LDB(B1, 1, 1); PG8_SCHED; PG8_LDA(At, 1, 0); PG8_STAGE(PG8_SA(0, 1), a2 + hstep, voffA);
            PG8_WAIT_V(8); PG8_WAIT_L(0); PG8_BAR; PG8_MMA(0, 0, At, B0); PG8_MMA(0, 1, At, B1); PG8_BAR; PG8_SCHED;
            PG8_LDA(At, 1, 1); PG8_STAGE(PG8_SB(1, 0), b3, voffB); PG8_STAGE(PG8_SB(1, 1), b3 + hstep, voffB); PG8_STAGE(PG8_SA(1, 0), a3, voffA);
            PG8_WAIT_V(8); PG8_WAIT_L(0); PG8_BAR; PG8_MMA(1, 0, At, B0); PG8_MMA(1, 1, At, B1); PG8_BAR; PG8_SCHED;
            } else {
            PG8_LDB(B0, 0, 0); PG8_SCHED; PG8_LDA(At, 0, 0); PG8_STAGE(PG8_SA(1, 1), a1 + hstep, voffA);
            PG8_WAIT_L(8); PG8_BAR; PG8_WAIT_L(0); PG8_MMA(0, 0, At, B0); PG8_BAR; PG8_SCHED;
            PG8_LDB(B1, 0, 1); PG8_STAGE(PG8_SB(0, 0), b2, voffB);
            PG8_BAR; PG8_WAIT_L(0); PG8_MMA(0, 1, At, B1); PG8_BAR;
            PG8_LDA(At, 0, 1); PG8_STAGE(PG8_SA(0, 0), a2, voffA);
            PG8_BAR; PG8_WAIT_L(0); PG8_MMA(1, 0, At, B0); PG8_BAR; PG8_SCHED;
            PG8_STAGE(PG8_SB(0, 1), b2 + hstep, voffB);
            PG8_WAIT_V(6); PG8_BAR; PG8_MMA(1, 1, At, B1); PG8_BAR;
            PG8_LDB(B0, 1, 0); PG8_SCHED; PG8_LDA(At, 1, 0); PG8_STAGE(PG8_SA(0, 1), a2 + hstep, voffA);
            PG8_WAIT_L(8); PG8_BAR; PG8_WAIT_L(0); PG8_MMA(0, 0, At, B0); PG8_BAR; PG8_SCHED;
            PG8_LDB(B1, 1, 1); PG8_STAGE(PG8_SB(1, 0), b3, voffB);
            PG8_BAR; PG8_WAIT_L(0); PG8_MMA(0, 1, At, B1); PG8_BAR;
            PG8_LDA(At, 1, 1); PG8_STAGE(PG8_SA(1, 0), a3, voffA);
            PG8_BAR; PG8_WAIT_L(0); PG8_MMA(1, 0, At, B0); PG8_BAR; PG8_SCHED;
            PG8_STAGE(PG8_SB(1, 1), b3 + hstep, voffB);
            PG8_WAIT_V(6); PG8_BAR; PG8_MMA(1, 1, At, B1); PG8_BAR;
            }
        }
        if constexpr (ALIGN_EPI) { if (wr == 0) PG8_BAR; }
        if constexpr (I8) {
            asm volatile("s_nop 15\n\ts_nop 15" ::: "memory");
#pragma unroll
            for (int ai = 0; ai < 2; ++ai)
#pragma unroll
                for (int bj = 0; bj < 2; ++bj)
#pragma unroll
                    for (int m = 0; m < 4; ++m)
#pragma unroll
                        for (int n = 0; n < 2; ++n)
#pragma unroll
                            for (int j = 0; j < 4; ++j) { float x = acc[ai][bj][m][n][j]; asm volatile("v_cvt_f32_i32 %0, %0" : "+v"(x)); acc[ai][bj][m][n][j] = x; }
            if constexpr (!Epi::SELF_SCALE) {
                const int row0 = cur.pm * BM + wr * 64 + fr, col0 = cur.pn * BM + wc * 32 + (Epi::PERM ? 8 * fq : 4 * fq);
#pragma unroll
                for (int bj = 0; bj < 2; ++bj)
#pragma unroll
                    for (int n = 0; n < 2; ++n) { const f32x4 sc = *(const f32x4*)(g.sb + col0 + bj * HALF + (Epi::PERM ? 4 * n : 16 * n));
#pragma unroll
                        for (int ai = 0; ai < 2; ++ai)
#pragma unroll
                            for (int m = 0; m < 4; ++m) { const float sr = g.sa[row0 + ai * HALF + m * 16]; acc[ai][bj][m][n] = acc[ai][bj][m][n] * (sc * sr); } }
            }
        }
        if constexpr (!Epi::AFTER_DRAIN) { E(acc, cur, wr, wc, fr, fq); S.done(cur); }
        if (!has_next) break;
#pragma unroll
        for (int a = 0; a < 2; ++a)
#pragma unroll
            for (int b = 0; b < 2; ++b)
#pragma unroll
                for (int m = 0; m < 4; ++m)
#pragma unroll
                    for (int n = 0; n < 2; ++n) acc[a][b][m][n] = (f32x4){0.f, 0.f, 0.f, 0.f};
        cur = nxt; cA = nA; cB = nB; ++ui;
        if constexpr (ALIGN_EPI) { if (wr == 1) PG8_BAR; }
    }
    PG8_WAIT_V(0);
    if constexpr (!ALIGN_EPI) { if (wr == 0) PG8_BAR; }
    PG8_BAR;
    if constexpr (Epi::AFTER_DRAIN) { E.fused(acc, cur, wr, wc, fr, fq, lds, wid, lane); S.done(cur); }
#undef PG8_SA
#undef PG8_SB
#undef PG8_STAGE
#undef PG8_LDA
#undef PG8_LDB
#undef PG8_MMA
#undef PG8_WAIT_V
#undef PG8_WAIT_L
#undef PG8_BAR
#undef PG8_SCHED
}
}
#define XB_TMO      128
#define XB_XCNT(j)  (256  + 64 * (j))
#define XB_XSUB(j)  (1280 + 64 * (j))
#define XB_XGEN(j)  (2304 + 64 * (j))
#define XB_TOP      3328
#define XB_TOPGEN   3392
#define XCD_BAR_WORDS 3456
#define XB_SPIN_CAP (1u << 18)
#define LAS __attribute__((address_space(3)))

__device__ __forceinline__ unsigned xb_ld(unsigned* p)              { return __hip_atomic_load(p, __ATOMIC_RELAXED, __HIP_MEMORY_SCOPE_AGENT); }
__device__ __forceinline__ unsigned xb_add(unsigned* p, unsigned v) { return __hip_atomic_fetch_add(p, v, __ATOMIC_RELAXED, __HIP_MEMORY_SCOPE_AGENT); }
__device__ __forceinline__ unsigned xb_xcc_id() { return (unsigned)__builtin_amdgcn_s_getreg((3 << 11) | 20) & 0xFu; }
#define XB_SPIN(cond, bar) do { unsigned _sp = 0; while (cond) { __builtin_amdgcn_s_sleep(1); \
    if ((++_sp & 255u) == 0u) { if (xb_ld(&(bar)[XB_TMO])) break; if (_sp > XB_SPIN_CAP) { atomicAdd(&(bar)[XB_TMO], 1u); break; } } } } while (0)

struct XcdBarrier {
    unsigned* bar; unsigned x;
    volatile LAS unsigned* st;
};

__device__ __forceinline__ XcdBarrier xcd_barrier_post(unsigned* bar, volatile LAS unsigned* st) {
    XcdBarrier b; b.bar = bar; b.x = xb_xcc_id(); b.st = st;
    if (threadIdx.x == 0) (void)xb_add(&bar[XB_XCNT(b.x)], 1u);
    return b;
}
__device__ __forceinline__ void xcd_barrier_complete(unsigned* bar, unsigned x, unsigned& nloc, unsigned& nx) {
    const unsigned G = gridDim.x * gridDim.y * gridDim.z;
    unsigned sum, cnt, mine, sp = 0u;
    for (;;) {
        sum = 0u; cnt = 0u; mine = 0u;
#pragma unroll
        for (unsigned j = 0; j < 16; ++j) { const unsigned c = xb_ld(&bar[XB_XCNT(j)]); sum += c; cnt += (c > 0u) ? 1u : 0u; mine = (j == x) ? c : mine; }
        if (sum == G) break;
        __builtin_amdgcn_s_sleep(1);
        if ((++sp & 255u) == 0u) { if (xb_ld(&bar[XB_TMO])) break; if (sp > XB_SPIN_CAP) { atomicAdd(&bar[XB_TMO], 1u); break; } }
    }
    nloc = mine > 0u ? mine : 1u; nx = cnt > 0u ? cnt : 1u;
}

__device__ __forceinline__ void xcd_barrier(const XcdBarrier& b) {
    asm volatile("s_waitcnt vmcnt(0)" ::: "memory");
    __syncthreads();
    if (threadIdx.x == 0) {
        unsigned* bar = b.bar;
        __builtin_amdgcn_s_waitcnt(0);
        unsigned nloc = b.st[0], nx = b.st[1];
        if (nloc == 0u) { xcd_barrier_complete(bar, b.x, nloc, nx); b.st[0] = nloc; b.st[1] = nx; }
        const unsigned old = xb_add(&bar[XB_XSUB(b.x)], 1u);
        const unsigned gen = old / nloc;
        if (old + 1u == (gen + 1u) * nloc) {
            __builtin_amdgcn_fence(__ATOMIC_RELEASE, "agent");
            asm volatile("s_waitcnt vmcnt(0)" ::: "memory");
            const unsigned og = xb_add(&bar[XB_TOP], 1u);
            const unsigned tg = og / nx;
            if (og + 1u == (tg + 1u) * nx) xb_add(&bar[XB_TOPGEN], 1u);
            else XB_SPIN(xb_ld(&bar[XB_TOPGEN]) == tg, bar);
            __builtin_amdgcn_fence(__ATOMIC_ACQUIRE, "agent");
            xb_add(&bar[XB_XGEN(b.x)], 1u);
            asm volatile("s_waitcnt vmcnt(0)" ::: "memory");
        } else {
            XB_SPIN(xb_ld(&bar[XB_XGEN(b.x)]) == gen, bar);
            __builtin_amdgcn_fence(__ATOMIC_ACQUIRE, "agent");
            asm volatile("s_waitcnt vmcnt(0)" ::: "memory");
        }
    }
    __syncthreads();
}

#define LAS __attribute__((address_space(3)))
typedef unsigned short bf16_t;
typedef float f32x4 __attribute__((ext_vector_type(4)));
typedef unsigned u32x4 __attribute__((ext_vector_type(4)));
typedef unsigned u32x2 __attribute__((ext_vector_type(2)));

#ifndef MK_ONE_LAUNCH
#define MK_ONE_LAUNCH 0
#endif

constexpr int NWAVES = 8, NT = NWAVES * 64;
constexpr int D = 4096, SEQ = 16384, NMETA = 16, L = SEQ + NMETA, MP = 16640;
constexpr int A_W = 2048, A_COLS = 6592, B_COLS = 4704, IN_COLS = A_COLS + B_COLS, NZ = 11520;
constexpr int ZQ = A_COLS, ZCKV = A_COLS + 2048, ZQI = A_COLS + 2560, ZKI = A_COLS + 4608, ZWI = A_COLS + 4672;
constexpr int DFF = 11008, NFI = 2 * DFF;
constexpr int KVR = 512, NH_B = 16, HD_B = 128, IDXH = 32, IDXD = 64, TOPK = 256;
constexpr int LDS_BYTES = 163840, MISC_OFF = 163584;
constexpr int NZ8 = 8960;
constexpr size_t WINT_BF_OFF = (size_t)40 << 20;

constexpr size_t al256(size_t x) { return (x + 255) & ~(size_t)255; }
constexpr size_t WS_CTL = 0, CTL_BYTES = 1u << 20;
constexpr size_t WS_WGT = WS_CTL + CTL_BYTES;
constexpr size_t WS_WPAT = WS_WGT + (size_t)8192 * 4096 * 2;
constexpr size_t WS_WPBT = WS_WPAT + (size_t)4096 * 2048 * 2;
constexpr size_t WS_WOUTT = WS_WPBT + (size_t)4096 * 2048 * 2;
constexpr size_t WS_WFIT = WS_WOUTT + (size_t)4096 * 4096 * 2;
constexpr size_t WS_WFOT = WS_WFIT + (size_t)NFI * 4096 * 2;
constexpr size_t WS_WINT = WS_WFOT + (size_t)4096 * DFF * 2;
constexpr size_t WS_U = WS_WINT + (size_t)NZ * 4096 * 2;
constexpr size_t WS_BIG = WS_U + (size_t)MP * D * 2;
constexpr size_t WS_Z = WS_BIG;
constexpr size_t WS_R1 = WS_Z + (size_t)MP * NZ * 2;
constexpr size_t R1_BYTES = (size_t)MP * D * 4;
constexpr size_t WS_LD = WS_R1;
constexpr size_t WS_AA = WS_LD + (size_t)L * A_W * 4;
constexpr size_t WS_GG = WS_AA + (size_t)L * A_W * 2;
constexpr size_t WS_QLAT = WS_R1;
constexpr size_t WS_MF = WS_R1;
constexpr size_t WS_YA = WS_R1 + R1_BYTES;
constexpr size_t WS_YB = WS_YA + (size_t)MP * A_W * 2;
constexpr size_t WS_END = WS_YB + (size_t)MP * A_W * 2;
constexpr size_t WS_GATES = WS_Z;
constexpr size_t WS_ZF = WS_BIG;
constexpr size_t WS_ACT = WS_BIG + (size_t)MP * DFF * 2;
constexpr size_t WS_CKV = WS_WINT;
constexpr size_t WS_KIDX = WS_CKV + al256((size_t)L * KVR * 2);
constexpr size_t WS_SEL = WS_KIDX + al256((size_t)L * IDXD * 4);
constexpr size_t WS_HMETA = WS_SEL + al256((size_t)L * TOPK * 4);
static_assert(WS_HMETA + (size_t)NMETA * D * 4 <= WS_U, "DSA overlays exceed WINT");
constexpr size_t WS_KIDXB = WS_HMETA + al256((size_t)NMETA * D * 4);
static_assert(WS_KIDXB + (size_t)L * IDXD * 2 <= WS_U, "KIDXB");
constexpr size_t WS_WUKB = WS_END;
constexpr size_t WS_WUVT = WS_WUKB + (size_t)16 * 512 * 128 * 2;
constexpr size_t WS_WLT = WS_WUVT + (size_t)16 * 512 * 128 * 2;
constexpr size_t WS_END2 = WS_WLT + (size_t)2048 * 448 * 2;
static_assert(WS_END2 <= (size_t)4 * 4096 * 22016 * 4, "workspace");
constexpr size_t CT_CMX_IN = 524288, CT_CMX_G = CT_CMX_IN + (size_t)NZ * 4, CT_CMX_F = CT_CMX_G + 8192 * 4, CT_SB_IN = CT_CMX_F + (size_t)NFI * 4, CT_SB_G = CT_SB_IN + (size_t)NZ * 4,
                 CT_SB_F = CT_SB_G + 8192 * 4, CT_SA = CT_SB_F + (size_t)NFI * 4, CT_AMAX = CT_SA + (size_t)MP * 4, CT_SAG = CT_AMAX + 256, CT_END = CT_SAG + 256;
static_assert(CT_END <= CTL_BYTES, "control region");
constexpr size_t WS_ST = WS_WINT;
constexpr size_t WS_BS = WS_ST + al256((size_t)257 * 32 * 4096 * 2);
static_assert(WS_BS + (size_t)L * 32 * 4 <= WS_U, "RWKV overlays exceed WINT");
static_assert((size_t)L * A_W * 4 + 2 * (size_t)L * A_W * 2 <= R1_BYTES && (size_t)L * 8192 * 2 <= R1_BYTES, "R1");
static_assert(WS_ACT + (size_t)MP * DFF * 2 <= WS_END, "ACT");
static_assert((size_t)MP * 8192 * 2 <= (size_t)MP * NZ * 2, "GATES");
static_assert(WS_END <= (size_t)4 * 4096 * 22016 * 4, "workspace");

__device__ __forceinline__ float bf2f(bf16_t b) { return __uint_as_float(((unsigned)b) << 16); }
__device__ __forceinline__ bf16_t f2bf(float f) { unsigned u = __float_as_uint(f); u += 0x7FFFu + ((u >> 16) & 1u); return (bf16_t)(u >> 16); }
__device__ __forceinline__ unsigned pk2(float lo, float hi) { return (unsigned)f2bf(lo) | ((unsigned)f2bf(hi) << 16); }
__device__ __forceinline__ float blo(unsigned w) { return __uint_as_float(w << 16); }
__device__ __forceinline__ float bhi(unsigned w) { return __uint_as_float(w & 0xffff0000u); }
__device__ __forceinline__ float sigm(float x) { return 1.f / (1.f + __expf(-x)); }
template <int CTRL> __device__ __forceinline__ float dpp_f(float v) { return __builtin_bit_cast(float, __builtin_amdgcn_update_dpp(0, __builtin_bit_cast(int, v), CTRL, 0xf, 0xf, false)); }
__device__ __forceinline__ float wave_sum(float v) {
    v += dpp_f<0xB1>(v);
    v += dpp_f<0x4E>(v);
    v += dpp_f<0x141>(v);
    v += dpp_f<0x140>(v);
    const float a = __builtin_bit_cast(float, __builtin_amdgcn_readlane(__builtin_bit_cast(int, v), 0));
    const float b = __builtin_bit_cast(float, __builtin_amdgcn_readlane(__builtin_bit_cast(int, v), 16));
    const float c = __builtin_bit_cast(float, __builtin_amdgcn_readlane(__builtin_bit_cast(int, v), 32));
    const float d = __builtin_bit_cast(float, __builtin_amdgcn_readlane(__builtin_bit_cast(int, v), 48));
    return (a + b) + (c + d);
}
__device__ __forceinline__ float wave_max(float v) {
    v = fmaxf(v, dpp_f<0xB1>(v)); v = fmaxf(v, dpp_f<0x4E>(v)); v = fmaxf(v, dpp_f<0x141>(v)); v = fmaxf(v, dpp_f<0x140>(v));
    const float a = __builtin_bit_cast(float, __builtin_amdgcn_readlane(__builtin_bit_cast(int, v), 0));
    const float b = __builtin_bit_cast(float, __builtin_amdgcn_readlane(__builtin_bit_cast(int, v), 16));
    const float c = __builtin_bit_cast(float, __builtin_amdgcn_readlane(__builtin_bit_cast(int, v), 32));
    const float d = __builtin_bit_cast(float, __builtin_amdgcn_readlane(__builtin_bit_cast(int, v), 48));
    return fmaxf(fmaxf(a, b), fmaxf(c, d));
}
#define LDS_WAIT() asm volatile("s_waitcnt lgkmcnt(0)" ::: "memory")

struct P {
    const float* in[30]; float* out; unsigned char* ws; int ph_lo, ph_hi;
};
enum { I_X = 0, I_META, I_NMW, I_WIN, I_MU, I_W0, I_W2, I_A0, I_A2, I_G2, I_KK, I_KA, I_RK, I_LNW, I_LNB, I_KVNW, I_WUK, I_WUV, I_ILNW, I_ILNB,
       I_WPA, I_WPB, I_WGATE, I_WOUT, I_NFW, I_WFI, I_CW, I_CB, I_WFO, I_NFIN };

template <int MODE>
__device__ __forceinline__ void tr_item(const float* W, int K, int N, int Npad, bf16_t* WT, LAS float* scr, int item, int lane) {
    const int nblk = Npad / 32, kb = item / nblk, nb = item % nblk, k0 = 64 * kb, n0 = 32 * nb;
    int s0 = n0; bool valid = n0 < N;
    if (MODE == 1) { const int T = n0 >> 8, w = n0 & 255; s0 = (w < 128) ? T * 128 + w : DFF + T * 128 + (w - 128); valid = true; }
    if (valid) {
#pragma unroll
        for (int i = 0; i < 8; ++i) { const int kk = 8 * i + (lane >> 3), c4 = 4 * (lane & 7); const f32x4 v_ = *(const f32x4*)(W + (size_t)(k0 + kk) * N + s0 + c4);
            LAS float* d_ = scr + kk * 33 + c4; d_[0] = v_.x; d_[1] = v_.y; d_[2] = v_.z; d_[3] = v_.w; }
    } else {
#pragma unroll 8
        for (int i = 0; i < 32; ++i) { const int kk = 2 * i + (lane >> 5); scr[kk * 33 + (lane & 31)] = 0.f; }
    }
    LDS_WAIT(); __builtin_amdgcn_wave_barrier();
    const int c = lane & 7;
#pragma unroll
    for (int j = 0; j < 4; ++j) { const int n = (lane >> 3) + 8 * j; const LAS float* s = scr + (8 * c) * 33 + n;
        u32x4 o; o.x = pk2(s[0 * 33], s[1 * 33]); o.y = pk2(s[2 * 33], s[3 * 33]); o.z = pk2(s[4 * 33], s[5 * 33]); o.w = pk2(s[6 * 33], s[7 * 33]);
        *(u32x4*)(WT + (size_t)(n0 + n) * K + k0 + 8 * c) = o; }
    LDS_WAIT(); __builtin_amdgcn_wave_barrier();
}
__device__ __forceinline__ void colmax_item(const float* W, int N, unsigned* cmx, int it) {
    const int nb = (N + 2047) / 2048, kc = it / nb, n = (it % nb) * 2048 + threadIdx.x * 4;
    if (n < N) { f32x4 m = {0.f, 0.f, 0.f, 0.f}; const float* wp = W + (size_t)kc * 32 * N + n;
#pragma unroll 8
        for (int k = 0; k < 32; ++k) { const f32x4 v = *(const f32x4*)(wp + (size_t)k * N); m.x = fmaxf(m.x, fabsf(v.x)); m.y = fmaxf(m.y, fabsf(v.y)); m.z = fmaxf(m.z, fabsf(v.z)); m.w = fmaxf(m.w, fabsf(v.w)); }
        atomicMax(cmx + n, __float_as_uint(m.x)); atomicMax(cmx + n + 1, __float_as_uint(m.y)); atomicMax(cmx + n + 2, __float_as_uint(m.z)); atomicMax(cmx + n + 3, __float_as_uint(m.w)); }
}
template <int MODE>
__device__ __forceinline__ void tr_item_i8(const float* W, int K, int N, int Npad, signed char* WT, const unsigned* cmx, float* sbdst, LAS float* scr, int item, int lane) {
    const int nblk = Npad / 32, kb = item / nblk, nb = item % nblk, k0 = 64 * kb, n0 = 32 * nb;
    int s0 = n0; bool valid = n0 < N;
    if (MODE == 1) { const int T = n0 >> 8, w = n0 & 255; s0 = (w < 128) ? T * 128 + w : DFF + T * 128 + (w - 128); valid = true; }
    if (valid) {
#pragma unroll
        for (int i = 0; i < 8; ++i) { const int kk = 8 * i + (lane >> 3), c4 = 4 * (lane & 7); const f32x4 v_ = *(const f32x4*)(W + (size_t)(k0 + kk) * N + s0 + c4);
            LAS float* d_ = scr + kk * 33 + c4; d_[0] = v_.x; d_[1] = v_.y; d_[2] = v_.z; d_[3] = v_.w; }
    } else {
#pragma unroll 8
        for (int i = 0; i < 32; ++i) { const int kk = 2 * i + (lane >> 5); scr[kk * 33 + (lane & 31)] = 0.f; }
    }
    LDS_WAIT(); __builtin_amdgcn_wave_barrier();
    const int n = lane >> 1, half = lane & 1;
    const float mx = valid ? __uint_as_float(cmx[s0 + n]) : 0.f; const float inv = mx > 0.f ? 127.f / mx : 0.f;
    unsigned o[8];
#pragma unroll
    for (int c = 0; c < 8; ++c) { unsigned w = 0u;
#pragma unroll
        for (int e = 0; e < 4; ++e) { const int qv = (int)rintf(scr[(half * 32 + c * 4 + e) * 33 + n] * inv); w |= ((unsigned)qv & 0xffu) << (8 * e); }
        o[c] = w; }
    *(u32x4*)(WT + (size_t)(n0 + n) * K + k0 + half * 32) = (u32x4){o[0], o[1], o[2], o[3]};
    *(u32x4*)(WT + (size_t)(n0 + n) * K + k0 + half * 32 + 16) = (u32x4){o[4], o[5], o[6], o[7]};
    if (kb == 0 && half == 0) sbdst[n0 + n] = mx * (1.f / 127.f);
    LDS_WAIT(); __builtin_amdgcn_wave_barrier();
}
template <bool DUAL = false> __device__ __forceinline__ void rms_row_i8(const float* src, const float* w, signed char* dst, float* sa, int lane, float eps, bf16_t* dstb = nullptr) {
    if (src == nullptr) {
        if (DUAL) {
#pragma unroll
            for (int j = 0; j < 8; ++j) *(u32x4*)(dstb + (j * 64 + lane) * 8) = (u32x4){0u, 0u, 0u, 0u}; }
#pragma unroll
        for (int j = 0; j < 4; ++j) *(u32x4*)(dst + (j * 64 + lane) * 16) = (u32x4){0u, 0u, 0u, 0u};
        if (lane == 0) *sa = 1.f;
        return;
    }
    f32x4 v[16]; float s = 0.f;
#pragma unroll
    for (int j = 0; j < 16; ++j) { v[j] = *(const f32x4*)(src + (j * 64 + lane) * 4); s += (v[j].x * v[j].x + v[j].y * v[j].y) + (v[j].z * v[j].z + v[j].w * v[j].w); }
    const float r = rsqrtf(wave_sum(s) * (1.f / D) + eps);
    float mx = 0.f;
#pragma unroll
    for (int j = 0; j < 16; ++j) { const f32x4 g = *(const f32x4*)(w + (j * 64 + lane) * 4); v[j] = v[j] * r * g; mx = fmaxf(mx, fmaxf(fmaxf(fabsf(v[j].x), fabsf(v[j].y)), fmaxf(fabsf(v[j].z), fabsf(v[j].w))));
        if (DUAL) { u32x2 o; o.x = pk2(v[j].x, v[j].y); o.y = pk2(v[j].z, v[j].w); *(u32x2*)(dstb + (j * 64 + lane) * 4) = o; } }
    mx = wave_max(mx);
    const float inv = mx > 0.f ? 127.f / mx : 0.f;
#pragma unroll
    for (int j = 0; j < 16; ++j) { const unsigned q = ((unsigned)(int)rintf(v[j].x * inv) & 0xffu) | (((unsigned)(int)rintf(v[j].y * inv) & 0xffu) << 8) | (((unsigned)(int)rintf(v[j].z * inv) & 0xffu) << 16) | (((unsigned)(int)rintf(v[j].w * inv) & 0xffu) << 24);
        *(unsigned*)(dst + (j * 64 + lane) * 4) = q; }
    if (lane == 0) *sa = mx > 0.f ? mx * (1.f / 127.f) : 1.f;
}
__device__ __forceinline__ void rms_row_bf16(const float* src, const float* w, bf16_t* dst, int lane, float eps) {
    if (src == nullptr) {
#pragma unroll
        for (int j = 0; j < 8; ++j) *(u32x4*)(dst + (j * 64 + lane) * 8) = (u32x4){0u, 0u, 0u, 0u};
        return;
    }
    f32x4 v[16]; float s = 0.f;
#pragma unroll
    for (int j = 0; j < 16; ++j) { v[j] = *(const f32x4*)(src + (j * 64 + lane) * 4); s += (v[j].x * v[j].x + v[j].y * v[j].y) + (v[j].z * v[j].z + v[j].w * v[j].w); }
    const float r = rsqrtf(wave_sum(s) * (1.f / D) + eps);
#pragma unroll
    for (int j = 0; j < 16; ++j) { const f32x4 g = *(const f32x4*)(w + (j * 64 + lane) * 4);
        u32x2 o; o.x = pk2(v[j].x * r * g.x, v[j].y * r * g.y); o.y = pk2(v[j].z * r * g.z, v[j].w * r * g.w);
        *(u32x2*)(dst + (j * 64 + lane) * 4) = o; }
}
__device__ __forceinline__ void p0_prologue_a(const P& p, LAS unsigned char* lds, int G) {
    const int tid = threadIdx.x, lane = tid & 63, wave = tid >> 6;
    LAS float* scr = (LAS float*)(lds + wave * 16384);
    const int gw = blockIdx.x * NWAVES + wave, NGW = G * NWAVES;
    unsigned char* ws = p.ws;
    {
        constexpr int C0 = 128 * ((IN_COLS + 2047) / 2048), C1 = 128 * (8192 / 2048), C2 = 128 * ((NFI + 2047) / 2048);
        for (int it = blockIdx.x; it < C0 + C1 + C2; it += G) {
            if (it < C0) colmax_item(p.in[I_WIN], IN_COLS, (unsigned*)(ws + WS_CTL + CT_CMX_IN), it);
            else if (it < C0 + C1) colmax_item(p.in[I_WGATE], 8192, (unsigned*)(ws + WS_CTL + CT_CMX_G), it - C0);
            else colmax_item(p.in[I_WFI], NFI, (unsigned*)(ws + WS_CTL + CT_CMX_F), it - C0 - C1);
        } }
    for (int it = gw; it < 16 * 32; it += NGW) { const int hh = it >> 5;
        tr_item<0>(p.in[I_WUV] + (size_t)hh * KVR * HD_B, KVR, HD_B, HD_B, (bf16_t*)(ws + WS_WUVT) + (size_t)hh * HD_B * KVR, scr, it & 31, lane); }
    for (size_t i = (size_t)blockIdx.x * NT + threadIdx.x; i < (size_t)16 * 512 * 128 / 4; i += (size_t)G * NT) {
        const f32x4 v = *(const f32x4*)(p.in[I_WUK] + i * 4); u32x2 o; o.x = pk2(v.x, v.y); o.y = pk2(v.z, v.w); *(u32x2*)((bf16_t*)(ws + WS_WUKB) + i * 4) = o; }
    for (int i = blockIdx.x * NT + threadIdx.x; i < 448 * 2048; i += G * NT) { const int j = i >> 11, c = i & 2047;
        const float v = j < 96 ? p.in[I_W2][(size_t)j * 2048 + c] : (j < 192 ? p.in[I_A2][(size_t)(j - 96) * 2048 + c] : p.in[I_G2][(size_t)(j - 192) * 2048 + c]);
        ((bf16_t*)(ws + WS_WLT))[(size_t)c * 448 + j] = f2bf(v); }
    signed char* U8 = (signed char*)(ws + WS_U); float* SA = (float*)(ws + WS_CTL + CT_SA);
    for (int m = gw; m < MP; m += NGW) {
        const float* src = m < NMETA ? p.in[I_META] + (size_t)m * D : (m < L ? p.in[I_X] + (size_t)(m - NMETA) * D : nullptr);
        rms_row_i8<true>(src, p.in[I_NMW], U8 + (size_t)m * D, SA + m, lane, 1e-6f, (bf16_t*)(ws + WS_R1) + (size_t)m * D);
    }
}
__device__ __forceinline__ void p0_prologue_b(const P& p, LAS unsigned char* lds, int G) {
    const int lane = threadIdx.x & 63, wave = threadIdx.x >> 6;
    LAS float* scr = (LAS float*)(lds + wave * 16384);
    const int gw = blockIdx.x * NWAVES + wave, NGW = G * NWAVES;
    constexpr int I0 = (4096 / 64) * (NZ / 32);
    for (int it = gw; it < I0; it += NGW) {
        const int nb = it % (NZ / 32);
        if (nb * 32 < NZ8) tr_item_i8<0>(p.in[I_WIN], 4096, IN_COLS, NZ, (signed char*)(p.ws + WS_WINT), (const unsigned*)(p.ws + WS_CTL + CT_CMX_IN), (float*)(p.ws + WS_CTL + CT_SB_IN), scr, it, lane);
        else tr_item<0>(p.in[I_WIN], 4096, IN_COLS, NZ, (bf16_t*)(p.ws + WS_WINT + WINT_BF_OFF) - (size_t)NZ8 * 4096, scr, it, lane);
    }
}
__device__ __forceinline__ void p0b_weights(const P& p, LAS unsigned char* lds, int vw, int nvw) {
    const int lane = threadIdx.x & 63, wave = threadIdx.x >> 6;
    LAS float* scr = (LAS float*)(lds + wave * 16384);
    unsigned char* ws = p.ws;
    constexpr int I1 = (4096 / 64) * (8192 / 32), I2 = (2048 / 64) * (4096 / 32), I3 = I2, I4 = (4096 / 64) * (4096 / 32), I5 = (4096 / 64) * (NFI / 32), I6 = (DFF / 64) * (4096 / 32);
    constexpr int NITEMS = I1 + I2 + I3 + I4 + I5 + I6;
    for (int it = vw; it < NITEMS; it += nvw) {
        int r = it;
        if (r < I1) { tr_item_i8<0>(p.in[I_WGATE], 4096, 8192, 8192, (signed char*)(ws + WS_WGT), (const unsigned*)(ws + WS_CTL + CT_CMX_G), (float*)(ws + WS_CTL + CT_SB_G), scr, r, lane); continue; } r -= I1;
        if (r < I2) { tr_item<0>(p.in[I_WPA], 2048, 4096, 4096, (bf16_t*)(ws + WS_WPAT), scr, r, lane); continue; } r -= I2;
        if (r < I3) { tr_item<0>(p.in[I_WPB], 2048, 4096, 4096, (bf16_t*)(ws + WS_WPBT), scr, r, lane); continue; } r -= I3;
        if (r < I4) { tr_item<0>(p.in[I_WOUT], 4096, 4096, 4096, (bf16_t*)(ws + WS_WOUTT), scr, r, lane); continue; } r -= I4;
        if (r < I5) { tr_item_i8<1>(p.in[I_WFI], 4096, NFI, NFI, (signed char*)(ws + WS_WFIT), (const unsigned*)(ws + WS_CTL + CT_CMX_F), (float*)(ws + WS_CTL + CT_SB_F), scr, r, lane); continue; } r -= I5;
        tr_item<0>(p.in[I_WFO], DFF, 4096, 4096, (bf16_t*)(ws + WS_WFOT), scr, r, lane);
    }
}

typedef short bf16x8p_t __attribute__((ext_vector_type(8)));
template <int CTRL> __device__ __forceinline__ float dpp_shr0(float v) { return __builtin_bit_cast(float, __builtin_amdgcn_update_dpp(0, __builtin_bit_cast(int, v), CTRL, 0xf, 0xf, true)); }
__device__ __forceinline__ void p2_rwkv_prep(const P& p, LAS unsigned char* lds, int G) {
    const int tid = threadIdx.x, lane = tid & 63, wave = __builtin_amdgcn_readfirstlane(tid >> 6), r16 = lane & 15, q = lane >> 4;
    const bf16_t* Z = (const bf16_t*)(p.ws + WS_Z); const bf16_t* WLT = (const bf16_t*)(p.ws + WS_WLT);
    float* CSo = (float*)(p.ws + WS_LD); bf16_t* AAo = (bf16_t*)(p.ws + WS_AA); bf16_t* GGo = (bf16_t*)(p.ws + WS_GG);
    constexpr int AST = 456;
    LAS bf16_t* act = (LAS bf16_t*)lds;
    const float* mu = p.in[I_MU] + 6144;
    for (int item = blockIdx.x; item < 256; item += G) {
        const int ct = item & 15, tr = item >> 4;
        const int ch = ct * 128 + wave * 16 + r16;
        bf16x8p_t af[14];
#pragma unroll
        for (int ks = 0; ks < 14; ++ks) af[ks] = *(const bf16x8p_t*)(WLT + (size_t)ch * 448 + ks * 32 + q * 8);
        const int c4 = ct * 128 + wave * 16 + q * 4;
        const f32x4 w0v = *(const f32x4*)(p.in[I_W0] + c4), a0v = *(const f32x4*)(p.in[I_A0] + c4);
        const int st0 = tr * 16, st1 = tr == 15 ? 257 : st0 + 16;
        for (int st = st0; st < st1; ++st) {
            const int t0 = st * 64;
            __syncthreads();
            {
                u32x4 za[7], zp[7];
#pragma unroll
                for (int k = 0; k < 7; ++k) { const int cidx = tid + k * NT, t = cidx / 56, j8 = (cidx % 56) * 8; int tg = t0 + t; if (tg > L - 1) tg = L - 1; const int tp = tg > 0 ? tg - 1 : 0;
                    za[k] = *(const u32x4*)(Z + (size_t)tg * NZ + 6144 + j8); zp[k] = *(const u32x4*)(Z + (size_t)tp * NZ + 6144 + j8); }
#pragma unroll
                for (int k = 0; k < 7; ++k) { const int cidx = tid + k * NT, t = cidx / 56, j8 = (cidx % 56) * 8, tg = t0 + t;
                    u32x4 o = (u32x4){0u, 0u, 0u, 0u};
                    if (tg < L) {
                        const f32x4 m0 = *(const f32x4*)(mu + j8), m1 = *(const f32x4*)(mu + j8 + 4);
                        const float a[8] = {blo(za[k].x), bhi(za[k].x), blo(za[k].y), bhi(za[k].y), blo(za[k].z), bhi(za[k].z), blo(za[k].w), bhi(za[k].w)};
                        float b[8] = {blo(zp[k].x), bhi(zp[k].x), blo(zp[k].y), bhi(zp[k].y), blo(zp[k].z), bhi(zp[k].z), blo(zp[k].w), bhi(zp[k].w)};
                        if (tg == 0) {
#pragma unroll
                            for (int e = 0; e < 8; ++e) b[e] = 0.f; }
                        const float m[8] = {m0.x, m0.y, m0.z, m0.w, m1.x, m1.y, m1.z, m1.w};
                        float v[8];
#pragma unroll
                        for (int e = 0; e < 8; ++e) { const float zs = a[e] + (b[e] - a[e]) * m[e]; const bool ist = j8 < 96, isi = j8 < 192;
                            const float r = __builtin_amdgcn_rcpf(1.f + __expf(ist ? 2.f * zs : -zs)); v[e] = ist ? 1.f - 2.f * r : (isi ? zs : r); }
                        o.x = pk2(v[0], v[1]); o.y = pk2(v[2], v[3]); o.z = pk2(v[4], v[5]); o.w = pk2(v[6], v[7]);
                    }
                    *(LAS u32x4*)(act + t * AST + j8) = o; }
            }
            __syncthreads();
#pragma unroll 1
            for (int nt = 0; nt < 4; ++nt) {
                f32x4 cw = {0.f, 0.f, 0.f, 0.f}, ca = cw, cg = cw;
                const LAS bf16_t* ar = act + (nt * 16 + r16) * AST + q * 8;
#pragma unroll
                for (int ks = 0; ks < 3; ++ks) cw = __builtin_amdgcn_mfma_f32_16x16x32_bf16(af[ks], *(const LAS bf16x8p_t*)(ar + ks * 32), cw, 0, 0, 0);
#pragma unroll
                for (int ks = 3; ks < 6; ++ks) ca = __builtin_amdgcn_mfma_f32_16x16x32_bf16(af[ks], *(const LAS bf16x8p_t*)(ar + ks * 32), ca, 0, 0, 0);
#pragma unroll
                for (int ks = 6; ks < 14; ++ks) cg = __builtin_amdgcn_mfma_f32_16x16x32_bf16(af[ks], *(const LAS bf16x8p_t*)(ar + ks * 32), cg, 0, 0, 0);
                f32x4 ld;
#pragma unroll
                for (int e = 0; e < 4; ++e) { const float xx = -(w0v[e] + cw[e]); const float sp = xx > 20.f ? xx : __logf(1.f + __expf(xx)); ld[e] = -__expf(-sp - 0.5f); }
#pragma unroll
                for (int e = 0; e < 4; ++e) { float x = ld[e]; x += dpp_shr0<0x111>(x); x += dpp_shr0<0x112>(x); x += dpp_shr0<0x114>(x); x += dpp_shr0<0x118>(x); ld[e] = x; }
                const int tg = t0 + nt * 16 + r16;
                if (tg < L) {
                    *(f32x4*)(CSo + (size_t)tg * A_W + c4) = ld;
                    u32x2 oa, og; oa.x = pk2(sigm(a0v[0] + ca[0]), sigm(a0v[1] + ca[1])); oa.y = pk2(sigm(a0v[2] + ca[2]), sigm(a0v[3] + ca[3]));
                    og.x = pk2(cg[0], cg[1]); og.y = pk2(cg[2], cg[3]);
                    *(u32x2*)(AAo + (size_t)tg * A_W + c4) = oa; *(u32x2*)(GGo + (size_t)tg * A_W + c4) = og;
                }
            }
        }
    }
}


typedef short bf16x8_t __attribute__((ext_vector_type(8)));
constexpr int NCHUNK = 257, NITEM = NCHUNK * 32, RS = 72, SLOT = 64 * RS * 2;
constexpr int GAM_OFF = 15 * SLOT;
constexpr size_t GTP_OFF = 0, HT_OFF = (size_t)8192 * 8192;
typedef __bf16 bf16x2v_t __attribute__((ext_vector_type(2)));
typedef float f32x2v_t __attribute__((ext_vector_type(2)));
__device__ __forceinline__ unsigned cvtpk(float lo, float hi) { const f32x2v_t v = {lo, hi}; const bf16x2v_t b = __builtin_convertvector(v, bf16x2v_t); return __builtin_bit_cast(unsigned, b); }
__device__ __forceinline__ void mm2(const LAS bf16_t* X, const LAS bf16_t* Y, int tm, int tn0, int r, int q, f32x4& c0, f32x4& c1) {
#pragma unroll
    for (int s = 0; s < 2; ++s) {
        const bf16x8_t a = *(const LAS bf16x8_t*)(X + (tm * 16 + r) * RS + s * 32 + q * 8);
        const bf16x8_t b0 = *(const LAS bf16x8_t*)(Y + (tn0 * 16 + r) * RS + s * 32 + q * 8);
        const bf16x8_t b1 = *(const LAS bf16x8_t*)(Y + ((tn0 + 1) * 16 + r) * RS + s * 32 + q * 8);
        c0 = __builtin_amdgcn_mfma_f32_16x16x32_bf16(a, b0, c0, 0, 0, 0);
        c1 = __builtin_amdgcn_mfma_f32_16x16x32_bf16(a, b1, c1, 0, 0, 0);
    }
}
__device__ __forceinline__ void st_cheap(LAS bf16_t* B, int m0, int n, const f32x4& c) {
    u32x2 w; w.x = cvtpk(c[0], c[1]); w.y = cvtpk(c[2], c[3]); *(LAS u32x2*)(B + n * RS + m0) = w;
}
__device__ __forceinline__ void st_scat(LAS bf16_t* B, int m0, int n, const f32x4& c) {
#pragma unroll
    for (int e = 0; e < 4; ++e) B[(m0 + e) * RS + n] = f2bf(c[e]);
}
template <int CTRL> __device__ __forceinline__ float dpp_add(float v) { return v + dpp_f<CTRL>(v); }
__device__ __forceinline__ float sum8(float v) { v = dpp_add<0xB1>(v); v = dpp_add<0x4E>(v); v = dpp_add<0x141>(v); return v; }

struct RaIn { u32x4 r0, k0, v0, r1, k1, v1, a0; f32x4 c0v, c1v, p0, p1, ba[3], bb[3]; };
__device__ __forceinline__ void ra_load(RaIn& I, const bf16_t* Z, const float* CS, const bf16_t* AAi, int ch, int h, int tid) {
    const int t = tid >> 3, k8 = (tid & 7) * 8, c0 = h * 64 + k8; int tg = ch * 64 + t; if (tg > L - 1) tg = L - 1; const int tp = tg > 0 ? tg - 1 : 0;
    const bf16_t* zr = Z + (size_t)tg * NZ + c0; const bf16_t* zp = Z + (size_t)tp * NZ + c0;
    I.r0 = *(const u32x4*)zr; I.k0 = *(const u32x4*)(zr + 2048); I.v0 = *(const u32x4*)(zr + 4096);
    I.r1 = *(const u32x4*)zp; I.k1 = *(const u32x4*)(zp + 2048); I.v1 = *(const u32x4*)(zp + 4096);
    I.a0 = *(const u32x4*)(AAi + (size_t)tg * A_W + c0);
    const float* cs = CS + (size_t)tg * A_W + c0; const float* cp = CS + (size_t)tp * A_W + c0;
    I.c0v = *(const f32x4*)cs; I.c1v = *(const f32x4*)(cs + 4); I.p0 = *(const f32x4*)cp; I.p1 = *(const f32x4*)(cp + 4);
#pragma unroll
    for (int b = 0; b < 3; ++b) { int rb = ch * 64 + b * 16 + 15; if (rb > L - 1) rb = L - 1; const float* ce = CS + (size_t)rb * A_W + c0; I.ba[b] = *(const f32x4*)ce; I.bb[b] = *(const f32x4*)(ce + 4); }
}
#define LDS_BARRIER() do { asm volatile("s_waitcnt lgkmcnt(0)" ::: "memory"); __builtin_amdgcn_s_barrier(); asm volatile("" ::: "memory"); } while (0)
__device__ __forceinline__ void ra_items(const P& p, LAS unsigned char* lds, int G) {
    const int tid = threadIdx.x, lane = tid & 63, wave = __builtin_amdgcn_readfirstlane(tid >> 6), r16 = lane & 15, q = lane >> 4;
    const int tm = wave >> 1, tn0 = (wave & 1) * 2;
    const bf16_t* Z = (const bf16_t*)(p.ws + WS_Z); const float* CS = (const float*)(p.ws + WS_LD); const bf16_t* AAi = (const bf16_t*)(p.ws + WS_AA);
    bf16_t* GTP = (bf16_t*)((unsigned char*)p.out + GTP_OFF); float* HT = (float*)((unsigned char*)p.out + HT_OFF);
    bf16_t* PPo = (bf16_t*)(p.ws + WS_YB); bf16_t* Y0o = (bf16_t*)(p.ws + WS_YA); float* BS = (float*)(p.ws + WS_BS);
    LAS bf16_t* sl[15];
#pragma unroll
    for (int i = 0; i < 15; ++i) sl[i] = (LAS bf16_t*)(lds + i * SLOT);
    LAS float* gam = (LAS float*)(lds + GAM_OFF);
    LAS bf16_t *Al_r = sl[0], *Be_r = sl[1], *Ka_r = sl[2], *Al_t = sl[3], *Be_t = sl[4], *Ka_t = sl[5], *Rh_r = sl[6], *V_t = sl[7];
    LAS bf16_t *N_r = sl[8], *N_t = sl[9], *LAK = sl[10], *MRK = sl[11], *MRB = sl[12], *Q_t = sl[13], *T_a = sl[14], *T_b = sl[0], *Q_r = sl[1];
    LAS bf16_t *W_t = sl[8], *X1_t = sl[9], *U0_t = sl[1];
    const bool fixed_h = (G & 31) == 0;
    const int nit = fixed_h ? (NCHUNK - (int)(blockIdx.x >> 5) + (G >> 5) - 1) / (G >> 5) : (NITEM - (int)blockIdx.x + G - 1) / G;
    auto item_of = [&](int i, int& ch, int& h) { if (fixed_h) { h = blockIdx.x & 31; ch = (int)(blockIdx.x >> 5) + i * (G >> 5); } else { const int it = (int)blockIdx.x + i * G; ch = it >> 5; h = it & 31; } };
    float pmr[8], pmk[8], pmv[8], pkk[8], pka[8], prk[8]; int h_par = -1;
    RaIn I; { int ch0, h0; item_of(0, ch0, h0); if (nit > 0) ra_load(I, Z, CS, AAi, ch0, h0, tid); }
    for (int ii = 0; ii < nit; ++ii) {
        int ch, h; item_of(ii, ch, h); const int item = ch * 32 + h;
        if (h != h_par) { const int c0 = h * 64 + (tid & 7) * 8;
#pragma unroll
            for (int e = 0; e < 8; ++e) { pmr[e] = p.in[I_MU][c0 + e]; pmk[e] = p.in[I_MU][2048 + c0 + e]; pmv[e] = p.in[I_MU][4096 + c0 + e]; pkk[e] = p.in[I_KK][c0 + e]; pka[e] = p.in[I_KA][c0 + e]; prk[e] = p.in[I_RK][c0 + e]; }
            h_par = h; }
        LDS_BARRIER();
        {
            const int t = tid >> 3, k8 = (tid & 7) * 8, tg = ch * 64 + t;
            float Av[8], Bv[8], Kv[8], Rv[8], Vv[8];
            const bool valid = tg < L, hasp = tg > 0;
            {
                float lc[8], lx[8];
                {   float base[8];
#pragma unroll
                    for (int e = 0; e < 8; ++e) base[e] = 0.f;
#pragma unroll
                    for (int b = 0; b < 3; ++b) if (b < (t >> 4)) {
#pragma unroll
                        for (int e = 0; e < 4; ++e) { base[e] += I.ba[b][e]; base[4 + e] += I.bb[b][e]; } }
                    const bool pin = (t & 15) != 0;
#pragma unroll
                    for (int e = 0; e < 4; ++e) { lc[e] = base[e] + I.c0v[e]; lc[4 + e] = base[4 + e] + I.c1v[e]; lx[e] = base[e] + (pin ? I.p0[e] : 0.f); lx[4 + e] = base[4 + e] + (pin ? I.p1[e] : 0.f); }
                }
                const unsigned rw[4] = {I.r0.x, I.r0.y, I.r0.z, I.r0.w}, kw[4] = {I.k0.x, I.k0.y, I.k0.z, I.k0.w}, vw[4] = {I.v0.x, I.v0.y, I.v0.z, I.v0.w};
                const unsigned rp[4] = {I.r1.x, I.r1.y, I.r1.z, I.r1.w}, kq[4] = {I.k1.x, I.k1.y, I.k1.z, I.k1.w}, vq[4] = {I.v1.x, I.v1.y, I.v1.z, I.v1.w}, aw[4] = {I.a0.x, I.a0.y, I.a0.z, I.a0.w};
                float rr[8], kk[8], kp[8], aa[8]; float ss = 0.f, bs = 0.f;
#pragma unroll
                for (int e = 0; e < 8; ++e) {
                    const int wi = e >> 1; const bool hi = e & 1;
                    const float zr_ = hi ? bhi(rw[wi]) : blo(rw[wi]), zk_ = hi ? bhi(kw[wi]) : blo(kw[wi]), zv_ = hi ? bhi(vw[wi]) : blo(vw[wi]);
                    float pr_ = hi ? bhi(rp[wi]) : blo(rp[wi]), pk_ = hi ? bhi(kq[wi]) : blo(kq[wi]), pv_ = hi ? bhi(vq[wi]) : blo(vq[wi]);
                    if (!hasp) { pr_ = 0.f; pk_ = 0.f; pv_ = 0.f; }
                    aa[e] = hi ? bhi(aw[wi]) : blo(aw[wi]);
                    rr[e] = zr_ + (pr_ - zr_) * pmr[e]; const float k_ = zk_ + (pk_ - zk_) * pmk[e]; Vv[e] = zv_ + (pv_ - zv_) * pmv[e];
                    kk[e] = k_ * pkk[e]; ss += kk[e] * kk[e];
                    kp[e] = k_ * (1.f + (aa[e] - 1.f) * pka[e]);
                    bs += rr[e] * kp[e] * prk[e];
                }
                ss = sum8(ss); bs = sum8(bs);
                const float rn = rsqrtf(ss + 1e-12f);
                if (valid && (tid & 7) == 0) BS[(size_t)tg * 32 + h] = bs;
#pragma unroll
                for (int e = 0; e < 8; ++e) {
                    const float kn = kk[e] * rn; const float ex = __expf(lx[e]), em = __expf(-lc[e]), ep = __expf(lc[e]);
                    Av[e] = kn * ex; Bv[e] = kn * aa[e] * em; Kv[e] = kp[e] * em; Rv[e] = rr[e] * ep;
                }
                if (t == 63) {
#pragma unroll
                    for (int e = 0; e < 8; ++e) gam[k8 + e] = __expf(valid ? lc[e] : (e < 4 ? I.c0v[e] : I.c1v[e - 4]));
                }
                if (!valid) {
#pragma unroll
                    for (int e = 0; e < 8; ++e) { Av[e] = 0.f; Bv[e] = 0.f; Kv[e] = 0.f; Rv[e] = 0.f; Vv[e] = 0.f; }
                }
            }
            u32x4 w;
            w.x = cvtpk(Av[0], Av[1]); w.y = cvtpk(Av[2], Av[3]); w.z = cvtpk(Av[4], Av[5]); w.w = cvtpk(Av[6], Av[7]); *(LAS u32x4*)(Al_r + t * RS + k8) = w;
            w.x = cvtpk(Bv[0], Bv[1]); w.y = cvtpk(Bv[2], Bv[3]); w.z = cvtpk(Bv[4], Bv[5]); w.w = cvtpk(Bv[6], Bv[7]); *(LAS u32x4*)(Be_r + t * RS + k8) = w;
            w.x = cvtpk(Kv[0], Kv[1]); w.y = cvtpk(Kv[2], Kv[3]); w.z = cvtpk(Kv[4], Kv[5]); w.w = cvtpk(Kv[6], Kv[7]); *(LAS u32x4*)(Ka_r + t * RS + k8) = w;
            w.x = cvtpk(Rv[0], Rv[1]); w.y = cvtpk(Rv[2], Rv[3]); w.z = cvtpk(Rv[4], Rv[5]); w.w = cvtpk(Rv[6], Rv[7]); *(LAS u32x4*)(Rh_r + t * RS + k8) = w;
#pragma unroll
            for (int e = 0; e < 8; ++e) { Al_t[(k8 + e) * RS + t] = f2bf(Av[e]); Be_t[(k8 + e) * RS + t] = f2bf(Bv[e]); Ka_t[(k8 + e) * RS + t] = f2bf(Kv[e]); V_t[(k8 + e) * RS + t] = f2bf(Vv[e]); }
        }
        if (ii + 1 < nit) { int ch1, h1; item_of(ii + 1, ch1, h1); ra_load(I, Z, CS, AAi, ch1, h1, tid); }
        LDS_BARRIER();
        {
            f32x4 cab0 = {0.f, 0.f, 0.f, 0.f}, cab1 = cab0, cak0 = cab0, cak1 = cab0, crk0 = cab0, crk1 = cab0, crb0 = cab0, crb1 = cab0;
            mm2(Be_r, Al_r, tm, tn0, r16, q, cab0, cab1); mm2(Ka_r, Al_r, tm, tn0, r16, q, cak0, cak1);
            mm2(Ka_r, Rh_r, tm, tn0, r16, q, crk0, crk1); mm2(Be_r, Rh_r, tm, tn0, r16, q, crb0, crb1);
            const int s0 = tm * 16 + q * 4;
#pragma unroll
            for (int j = 0; j < 2; ++j) {
                const int t = (tn0 + j) * 16 + r16;
                f32x4 ab = j ? cab1 : cab0, ak = j ? cak1 : cak0, rk = j ? crk1 : crk0, rb = j ? crb1 : crb0, nn, t0;
#pragma unroll
                for (int e = 0; e < 4; ++e) { const int s = s0 + e; nn[e] = s < t ? -ab[e] : 0.f; t0[e] = nn[e] + (s == t ? 1.f : 0.f); ak[e] = s < t ? ak[e] : 0.f; rk[e] = s <= t ? rk[e] : 0.f; rb[e] = s <= t ? rb[e] : 0.f; }
                st_cheap(N_r, s0, t, nn); st_scat(N_t, s0, t, nn); st_cheap(T_a, s0, t, t0); st_cheap(LAK, s0, t, ak); st_cheap(MRK, s0, t, rk); st_cheap(MRB, s0, t, rb);
            }
        }
        LDS_BARRIER();
        {
            LAS bf16_t* Pr = N_r; LAS bf16_t* Pt = N_t; LAS bf16_t* Qr = Q_r; LAS bf16_t* Qt = Q_t; LAS bf16_t* Tc = T_a; LAS bf16_t* Tn = T_b;
#pragma unroll 1
            for (int it = 0; it < 5; ++it) {
                {   f32x4 c0 = {0.f, 0.f, 0.f, 0.f}, c1 = c0;
                    mm2(Pr, Pt, tm, tn0, r16, q, c0, c1);
                    const int m0 = tm * 16 + q * 4;
                    st_cheap(Qt, m0, tn0 * 16 + r16, c0); st_cheap(Qt, m0, (tn0 + 1) * 16 + r16, c1);
                    st_scat(Qr, m0, tn0 * 16 + r16, c0); st_scat(Qr, m0, (tn0 + 1) * 16 + r16, c1); }
                LDS_BARRIER();
                {   f32x4 c0 = {0.f, 0.f, 0.f, 0.f}, c1 = c0;
                    mm2(Qt, Tc, tm, tn0, r16, q, c0, c1);
                    const int b0 = tm * 16 + q * 4;
#pragma unroll
                    for (int j = 0; j < 2; ++j) { const int a = (tn0 + j) * 16 + r16; const u32x2 o = *(const LAS u32x2*)(Tc + a * RS + b0); f32x4 c = j ? c1 : c0;
                        c[0] += blo(o.x); c[1] += bhi(o.x); c[2] += blo(o.y); c[3] += bhi(o.y); st_cheap(Tn, b0, a, c); } }
                LDS_BARRIER();
                LAS bf16_t* x = Pr; Pr = Qr; Qr = x; x = Pt; Pt = Qt; Qt = x; x = Tc; Tc = Tn; Tn = x;
            }
        }
        {
            f32x4 c0 = {0.f, 0.f, 0.f, 0.f}, c1 = c0, d0 = c0, d1 = c0;
            mm2(T_b, Al_t, tm, tn0, r16, q, c0, c1);
            mm2(LAK, V_t, tm, tn0, r16, q, d0, d1);
            const int t0 = tm * 16 + q * 4;
            st_cheap(W_t, t0, tn0 * 16 + r16, c0); st_cheap(W_t, t0, (tn0 + 1) * 16 + r16, c1);
            st_cheap(X1_t, t0, tn0 * 16 + r16, d0); st_cheap(X1_t, t0, (tn0 + 1) * 16 + r16, d1);
        }
        LDS_BARRIER();
        {
            f32x4 c0 = {0.f, 0.f, 0.f, 0.f}, c1 = c0;
            mm2(T_b, X1_t, tm, tn0, r16, q, c0, c1);
            const int t0 = tm * 16 + q * 4;
            st_cheap(U0_t, t0, tn0 * 16 + r16, c0); st_cheap(U0_t, t0, (tn0 + 1) * 16 + r16, c1);
        }
        LDS_BARRIER();
        {
            const int m0 = tm * 16 + q * 4;
            if (ch < 256) {
                f32x4 g0 = {0.f, 0.f, 0.f, 0.f}, g1 = g0, h0 = g0, h1 = g0, u0 = g0, u1 = g0;
                mm2(W_t, Be_t, tm, tn0, r16, q, g0, g1);
                mm2(Ka_t, V_t, tm, tn0, r16, q, h0, h1);
                mm2(Be_t, U0_t, tm, tn0, r16, q, u0, u1);
                const size_t it8 = (size_t)item;
#pragma unroll
                for (int j = 0; j < 2; ++j) {
                    const int n = (tn0 + j) * 16 + r16; const f32x4 g = j ? g1 : g0; const float gc = gam[n];
                    f32x4 o;
#pragma unroll
                    for (int e = 0; e < 4; ++e) o[e] = ((m0 + e == n ? 1.f : 0.f) - g[e]) * gc;
                    u32x2 w; w.x = cvtpk(o[0], o[1]); w.y = cvtpk(o[2], o[3]);
                    *(u32x2*)(GTP + it8 * 4096 + (size_t)n * 64 + 32 * (tm >> 1) + 8 * q + 4 * (tm & 1)) = w;
                    const f32x4 hh = (j ? h1 : h0) - (j ? u1 : u0);
                    const f32x4 gk = *(const LAS f32x4*)(gam + m0);
                    *(f32x4*)(HT + (it8 * 16 + tm * 4 + (tn0 + j)) * 256 + lane * 4) = hh * gk;
                }
            }
            f32x4 p0 = {0.f, 0.f, 0.f, 0.f}, p1 = p0, y0 = p0, y1 = p0, z0 = p0, z1 = p0;
            mm2(W_t, MRB, tm, tn0, r16, q, p0, p1);
            mm2(V_t, MRK, tm, tn0, r16, q, y0, y1);
            mm2(U0_t, MRB, tm, tn0, r16, q, z0, z1);
#pragma unroll
            for (int j = 0; j < 2; ++j) {
                const int t = (tn0 + j) * 16 + r16, tg = ch * 64 + t;
                const u32x2 o = *(const LAS u32x2*)(Rh_r + t * RS + m0); const f32x4 pm = j ? p1 : p0;
                u32x2 w; w.x = cvtpk(blo(o.x) - pm[0], bhi(o.x) - pm[1]); w.y = cvtpk(blo(o.y) - pm[2], bhi(o.y) - pm[3]);
                *(u32x2*)(PPo + (size_t)item * 4096 + t * 64 + m0) = w;
                if (tg < L) { const f32x4 yy = (j ? y1 : y0) - (j ? z1 : z0); u32x2 wy; wy.x = cvtpk(yy[0], yy[1]); wy.y = cvtpk(yy[2], yy[3]);
                    *(u32x2*)(Y0o + (size_t)tg * A_W + h * 64 + m0) = wy; }
            }
        }
    }
}

struct RbSet { bf16x8_t ga[4][2]; f32x4 hv[4]; };
__device__ __forceinline__ void rb_load(RbSet& S, const bf16_t* GTP, const float* HT, int c, int h, int vg, int lane, int r16, int q) {
    const size_t it8 = (size_t)(c < 256 ? c : 255) * 32 + h;
#pragma unroll
    for (int i = 0; i < 4; ++i) { S.hv[i] = *(const f32x4*)(HT + (it8 * 16 + i * 4 + vg) * 256 + lane * 4);
#pragma unroll
        for (int s = 0; s < 2; ++s) S.ga[i][s] = *(const bf16x8_t*)(GTP + it8 * 4096 + (size_t)(i * 16 + r16) * 64 + s * 32 + q * 8); }
}
__device__ __forceinline__ void rb_step(f32x4 (&acc)[4], const RbSet& S, bf16_t* ST, int c, int h, int vg, int r16, int q) {
    const size_t item = (size_t)c * 32 + h;
    unsigned w[8];
#pragma unroll
    for (int i = 0; i < 4; ++i) { w[2 * i] = cvtpk(acc[i][0], acc[i][1]); w[2 * i + 1] = cvtpk(acc[i][2], acc[i][3]);
        u32x2 o; o.x = w[2 * i]; o.y = w[2 * i + 1]; *(u32x2*)(ST + item * 4096 + (size_t)(vg * 16 + r16) * 64 + i * 16 + q * 4) = o; }
    const u32x4 b0 = (u32x4){w[0], w[1], w[2], w[3]}, b1 = (u32x4){w[4], w[5], w[6], w[7]};
    const bf16x8_t f0 = __builtin_bit_cast(bf16x8_t, b0), f1 = __builtin_bit_cast(bf16x8_t, b1);
#pragma unroll
    for (int i = 0; i < 4; ++i) { f32x4 a = S.hv[i];
        a = __builtin_amdgcn_mfma_f32_16x16x32_bf16(S.ga[i][0], f0, a, 0, 0, 0);
        a = __builtin_amdgcn_mfma_f32_16x16x32_bf16(S.ga[i][1], f1, a, 0, 0, 0);
        acc[i] = a; }
}
__device__ __forceinline__ void rb_chain(const P& p, int G) {
    const int tid = threadIdx.x, lane = tid & 63, wave = __builtin_amdgcn_readfirstlane(tid >> 6), r16 = lane & 15, q = lane >> 4;
    if (wave == 0) for (int cw = blockIdx.x; cw < 128; cw += G) {
        const int h = cw >> 2, vg = cw & 3;
        const bf16_t* GTP = (const bf16_t*)((const unsigned char*)p.out + GTP_OFF); const float* HT = (const float*)((const unsigned char*)p.out + HT_OFF);
        bf16_t* ST = (bf16_t*)(p.ws + WS_ST);
        f32x4 acc[4];
#pragma unroll
        for (int i = 0; i < 4; ++i) acc[i] = (f32x4){0.f, 0.f, 0.f, 0.f};
        RbSet S0, S1, S2, S3;
        rb_load(S0, GTP, HT, 0, h, vg, lane, r16, q); rb_load(S1, GTP, HT, 1, h, vg, lane, r16, q); rb_load(S2, GTP, HT, 2, h, vg, lane, r16, q); rb_load(S3, GTP, HT, 3, h, vg, lane, r16, q);
#pragma unroll 1
        for (int c = 0; c < 256; c += 4) {
            rb_step(acc, S0, ST, c, h, vg, r16, q);     rb_load(S0, GTP, HT, c + 4, h, vg, lane, r16, q);
            rb_step(acc, S1, ST, c + 1, h, vg, r16, q); rb_load(S1, GTP, HT, c + 5, h, vg, lane, r16, q);
            rb_step(acc, S2, ST, c + 2, h, vg, r16, q); rb_load(S2, GTP, HT, c + 6, h, vg, lane, r16, q);
            rb_step(acc, S3, ST, c + 3, h, vg, r16, q); rb_load(S3, GTP, HT, c + 7, h, vg, lane, r16, q);
        }
        {
            const size_t item = (size_t)256 * 32 + h;
#pragma unroll
            for (int i = 0; i < 4; ++i) { u32x2 o; o.x = cvtpk(acc[i][0], acc[i][1]); o.y = cvtpk(acc[i][2], acc[i][3]); *(u32x2*)(ST + item * 4096 + (size_t)(vg * 16 + r16) * 64 + i * 16 + q * 4) = o; }
        }
    }
}

__device__ __forceinline__ void rc_out(const P& p, int G) {
    const int tid = threadIdx.x, lane = tid & 63, wave = __builtin_amdgcn_readfirstlane(tid >> 6), r16 = lane & 15, q = lane >> 4;
    const bf16_t* Z = (const bf16_t*)(p.ws + WS_Z); const bf16_t* GGi = (const bf16_t*)(p.ws + WS_GG); const float* BS = (const float*)(p.ws + WS_BS);
    const bf16_t* ST = (const bf16_t*)(p.ws + WS_ST); const bf16_t* PPi = (const bf16_t*)(p.ws + WS_YB); bf16_t* YA = (bf16_t*)(p.ws + WS_YA);
    for (size_t i = (size_t)blockIdx.x * NT + tid; i < (size_t)(MP - L) * A_W / 8; i += (size_t)G * NT) *(u32x4*)(YA + (size_t)L * A_W + i * 8) = (u32x4){0u, 0u, 0u, 0u};
    const int tt = wave & 3;
    for (int item = blockIdx.x * 2 + (wave >> 2); item < NITEM; item += 2 * G) {
        const int ch = item >> 5, h = item & 31;
        const int t = tt * 16 + r16, tg = ch * 64 + t;
        f32x4 acc[4];
#pragma unroll
        for (int i = 0; i < 4; ++i) acc[i] = (f32x4){0.f, 0.f, 0.f, 0.f};
        const bf16_t* sp = ST + (size_t)item * 4096; const bf16_t* pp = PPi + (size_t)item * 4096 + (size_t)t * 64;
#pragma unroll
        for (int s = 0; s < 2; ++s) {
            const bf16x8_t b = *(const bf16x8_t*)(pp + s * 32 + q * 8);
#pragma unroll
            for (int i = 0; i < 4; ++i) { const bf16x8_t a = *(const bf16x8_t*)(sp + (size_t)(i * 16 + r16) * 64 + s * 32 + q * 8);
                acc[i] = __builtin_amdgcn_mfma_f32_16x16x32_bf16(a, b, acc[i], 0, 0, 0); }
        }
        if (tg < L) {
            float s1 = 0.f;
#pragma unroll
            for (int i = 0; i < 4; ++i) { const u32x2 y0 = *(const u32x2*)(YA + (size_t)tg * A_W + h * 64 + i * 16 + q * 4);
                acc[i][0] += blo(y0.x); acc[i][1] += bhi(y0.x); acc[i][2] += blo(y0.y); acc[i][3] += bhi(y0.y);
                s1 += (acc[i][0] + acc[i][1]) + (acc[i][2] + acc[i][3]); }
            s1 += __shfl_xor(s1, 16); s1 += __shfl_xor(s1, 32);
            const float mean = s1 * (1.f / 64.f);
            float s2 = 0.f;
#pragma unroll
            for (int i = 0; i < 4; ++i)
#pragma unroll
                for (int e = 0; e < 4; ++e) { const float d = acc[i][e] - mean; s2 += d * d; }
            s2 += __shfl_xor(s2, 16); s2 += __shfl_xor(s2, 32);
            const float rstd = rsqrtf(s2 * (1.f / 64.f) + 64e-5f);
            const float bs = BS[(size_t)tg * 32 + h];
#pragma unroll
            for (int i = 0; i < 4; ++i) {
                const int c = h * 64 + i * 16 + q * 4;
                const u32x2 zv = *(const u32x2*)(Z + (size_t)tg * NZ + 4096 + c);
                u32x2 pv = (u32x2){0u, 0u}; if (tg > 0) pv = *(const u32x2*)(Z + (size_t)(tg - 1) * NZ + 4096 + c);
                const u32x2 gg = *(const u32x2*)(GGi + (size_t)tg * A_W + c);
                const f32x4 lw = *(const f32x4*)(p.in[I_LNW] + c), lb = *(const f32x4*)(p.in[I_LNB] + c), mv = *(const f32x4*)(p.in[I_MU] + 4096 + c);
                const float zz[4] = {blo(zv.x), bhi(zv.x), blo(zv.y), bhi(zv.y)}, pz[4] = {blo(pv.x), bhi(pv.x), blo(pv.y), bhi(pv.y)}, gv[4] = {blo(gg.x), bhi(gg.x), blo(gg.y), bhi(gg.y)};
                float o[4];
#pragma unroll
                for (int e = 0; e < 4; ++e) { const float vv = zz[e] + (pz[e] - zz[e]) * mv[e]; const float yn = (acc[i][e] - mean) * rstd * lw[e] + lb[e]; o[e] = (yn + bs * vv) * gv[e]; }
                u32x2 w; w.x = cvtpk(o[0], o[1]); w.y = cvtpk(o[2], o[3]);
                *(u32x2*)(YA + (size_t)tg * A_W + c) = w;
            }
        }
    }
}


__device__ __forceinline__ void p4_dsa_prep(const P& p, int G) {
    const int tid = threadIdx.x, lane = tid & 63, wave = tid >> 6;
    const bf16_t* Z = (const bf16_t*)(p.ws + WS_Z);
    bf16_t* CKV = (bf16_t*)(p.ws + WS_CKV); float* KIDX = (float*)(p.ws + WS_KIDX);
    for (int t = blockIdx.x * NWAVES + wave; t < L; t += G * NWAVES) {
        const u32x4 raw = *(const u32x4*)(Z + (size_t)t * NZ + ZCKV + lane * 8);
        float x[8] = {blo(raw.x), bhi(raw.x), blo(raw.y), bhi(raw.y), blo(raw.z), bhi(raw.z), blo(raw.w), bhi(raw.w)};
        float s = 0.f;
#pragma unroll
        for (int e = 0; e < 8; ++e) s += x[e] * x[e];
        const float r = rsqrtf(wave_sum(s) * (1.f / KVR) + 1e-6f);
        const f32x4 w0 = *(const f32x4*)(p.in[I_KVNW] + lane * 8), w1 = *(const f32x4*)(p.in[I_KVNW] + lane * 8 + 4);
        u32x4 o; o.x = pk2(x[0] * r * w0.x, x[1] * r * w0.y); o.y = pk2(x[2] * r * w0.z, x[3] * r * w0.w); o.z = pk2(x[4] * r * w1.x, x[5] * r * w1.y); o.w = pk2(x[6] * r * w1.z, x[7] * r * w1.w);
        *(u32x4*)(CKV + (size_t)t * KVR + lane * 8) = o;
        const float ki = bf2f(Z[(size_t)t * NZ + ZKI + lane]);
        const float mean = wave_sum(ki) * (1.f / 64.f), dk = ki - mean, var = wave_sum(dk * dk) * (1.f / 64.f);
        const float kn_ = dk * rsqrtf(var + 1e-6f) * p.in[I_ILNW][lane] + p.in[I_ILNB][lane];
        KIDX[(size_t)t * IDXD + lane] = kn_;
        ((bf16_t*)(p.ws + WS_KIDXB))[(size_t)t * IDXD + lane] = f2bf(kn_);
    }
}

__device__ __forceinline__ unsigned fkey(float f) { const unsigned u = __float_as_uint(f); return (u & 0x80000000u) ? ~u : (u | 0x80000000u); }


typedef float f32x16 __attribute__((ext_vector_type(16)));
constexpr int SCR_N = 16416;
__device__ __forceinline__ unsigned lds_add(LAS unsigned* p, unsigned v) { return __hip_atomic_fetch_add(p, v, __ATOMIC_RELAXED, __HIP_MEMORY_SCOPE_WORKGROUP); }
constexpr int KST = 72, SELB = 8;
template <int NBL> __device__ __forceinline__ void wfind(const LAS unsigned* hist, unsigned target, int lane, unsigned& b, unsigned& ab) {
    unsigned loc[NBL]; unsigned s = 0;
#pragma unroll
    for (int j = 0; j < NBL; j += 4) { const u32x4 v4 = *(const LAS u32x4*)(hist + lane * NBL + j); loc[j] = v4.x; loc[j + 1] = v4.y; loc[j + 2] = v4.z; loc[j + 3] = v4.w; s += (v4.x + v4.y) + (v4.z + v4.w); }
    unsigned v = s;
#pragma unroll
    for (int d = 1; d < 64; d <<= 1) { const unsigned o = (unsigned)__shfl_down((int)v, d); if (lane + d < 64) v += o; }
    const unsigned above = v - s;
    const bool found = above < target && above + s >= target;
    unsigned bb = 0u, aa = 0u;
    if (found) { unsigned a = above;
#pragma unroll
        for (int j = NBL - 1; j >= 0; --j) { if (a < target && a + loc[j] >= target) { bb = (unsigned)(lane * NBL + j); aa = a; } a += loc[j]; } }
    const unsigned long long m = __ballot(found);
    const int src = m ? (int)__builtin_ctzll(m) : 0;
    b = (unsigned)__shfl((int)bb, src); ab = (unsigned)__shfl((int)aa, src);
}
__device__ __forceinline__ void d2_topk(const P& p, LAS unsigned char* lds, int G) {
    const int tid = threadIdx.x, lane = tid & 63, wave = __builtin_amdgcn_readfirstlane(tid >> 6);
    const bf16_t* Z = (const bf16_t*)(p.ws + WS_Z); const bf16_t* KB = (const bf16_t*)(p.ws + WS_KIDXB); int* SEL = (int*)(p.ws + WS_SEL);
    float* scr = (float*)(p.ws + WS_R1) + ((size_t)blockIdx.x * NWAVES + wave) * 2 * SCR_N;
    LAS bf16_t* ksb = (LAS bf16_t*)lds;
    LAS unsigned* hw = (LAS unsigned*)(lds + 73728) + wave * 2048;
    const int key_l = lane & 31, hh = lane >> 5;
    for (int t = blockIdx.x; t < NMETA + 192; t += G) { const int n = t < NMETA ? NMETA : NMETA + 64 * (1 + (t - NMETA) / 64);
        if (tid < TOPK) SEL[(size_t)t * TOPK + tid] = tid < n ? tid : -1; }
    const int nui = (G == 256) ? 4 : (1012 + G - 1) / G;
    for (int ui = 0; ui < nui; ++ui) {
        int i = (int)blockIdx.x + ui * G;
        if (G == 256) i = ui == 0 ? (int)blockIdx.x : (ui == 1 ? 511 - (int)blockIdx.x : (ui == 2 ? 512 + (int)blockIdx.x : 1023 - (int)blockIdx.x));
        if (i >= 1012) continue;
        const int c = 256 - (i >> 2), r = i & 3, n = NMETA + 64 * c;
        const int tA = NMETA + 64 * (c - 1) + 16 * r + 2 * wave;
        bf16x8_t af[2][4]; float wv[2][16];
#pragma unroll
        for (int qq = 0; qq < 2; ++qq) {
            const bf16_t* zr = Z + (size_t)(tA + qq) * NZ;
#pragma unroll
            for (int ks = 0; ks < 4; ++ks) af[qq][ks] = *(const bf16x8_t*)(zr + ZQI + key_l * 64 + ks * 16 + hh * 8);
#pragma unroll
            for (int g = 0; g < 4; ++g) { const u32x2 w2 = *(const u32x2*)(zr + ZWI + 8 * g + 4 * hh);
                wv[qq][g * 4 + 0] = blo(w2.x) * 0.02209708691207961f; wv[qq][g * 4 + 1] = bhi(w2.x) * 0.02209708691207961f;
                wv[qq][g * 4 + 2] = blo(w2.y) * 0.02209708691207961f; wv[qq][g * 4 + 3] = bhi(w2.y) * 0.02209708691207961f; }
        }
#pragma unroll
        for (int j = 0; j < 8; ++j) *(LAS u32x4*)(hw + (j * 64 + lane) * 4) = (u32x4){0u, 0u, 0u, 0u};
        const int nblk = (n + 255) >> 8;
        __syncthreads();
        {
            const int kk = tid >> 1, hf = tid & 1; const int src = kk < n ? kk : n - 1;
            const u32x4* gp = (const u32x4*)(KB + (size_t)src * IDXD + hf * 32);
#pragma unroll
            for (int j = 0; j < 4; ++j) *(LAS u32x4*)(ksb + kk * KST + hf * 32 + j * 8) = gp[j];
        }
        __syncthreads();
        for (int b = 0; b < nblk; ++b) {
            u32x4 pre[4];
            const bool more = b + 1 < nblk;
            if (more) { const int kk = (b + 1) * 256 + (tid >> 1); const int src = kk < n ? kk : n - 1; const u32x4* gp = (const u32x4*)(KB + (size_t)src * IDXD + (tid & 1) * 32);
#pragma unroll
                for (int j = 0; j < 4; ++j) pre[j] = gp[j]; }
            const LAS bf16_t* kb = ksb + (b & 1) * 256 * KST;
#pragma unroll 2
            for (int tt = 0; tt < 8; ++tt) {
                const int s0 = b * 256 + tt * 32;
                if (s0 < n) {
                    bf16x8_t bfr[4];
#pragma unroll
                    for (int ks = 0; ks < 4; ++ks) bfr[ks] = *(const LAS bf16x8_t*)(kb + (tt * 32 + key_l) * KST + ks * 16 + hh * 8);
                    float part[2];
#pragma unroll
                    for (int qq = 0; qq < 2; ++qq) {
                        f32x16 acc;
#pragma unroll
                        for (int e = 0; e < 16; ++e) acc[e] = 0.f;
#pragma unroll
                        for (int ks = 0; ks < 4; ++ks) acc = __builtin_amdgcn_mfma_f32_32x32x16_bf16(af[qq][ks], bfr[ks], acc, 0, 0, 0);
                        float s = 0.f;
                        float s0_ = 0.f, s1_ = 0.f;
#pragma unroll
                        for (int e = 0; e < 16; e += 2) { s0_ += wv[qq][e] * __builtin_amdgcn_fmed3f(acc[e], 0.f, 3.0e38f); s1_ += wv[qq][e + 1] * __builtin_amdgcn_fmed3f(acc[e + 1], 0.f, 3.0e38f); }
                        part[qq] = s0_ + s1_; (void)s;
                    }
                    const float mine = hh ? part[1] : part[0], give = hh ? part[0] : part[1];
                    const float score = mine + __shfl_xor(give, 32);
                    const int key = s0 + key_l;
                    if (key < n) { scr[hh * SCR_N + key] = score; lds_add(hw + hh * 1024 + (fkey(score) >> 22), 1u); }
                }
            }
            if (more) { const int kk = tid >> 1, hf = tid & 1;
#pragma unroll
                for (int j = 0; j < 4; ++j) *(LAS u32x4*)(ksb + ((b + 1) & 1) * 256 * KST + kk * KST + hf * 32 + j * 8) = pre[j]; }
            __syncthreads();
        }
        unsigned b1[2], ab1[2];
        wfind<16>(hw, TOPK, lane, b1[0], ab1[0]); wfind<16>(hw + 1024, TOPK, lane, b1[1], ab1[1]);
        const int nv4 = (n + 3) >> 2;
#pragma unroll
        for (int j = 0; j < 8; ++j) *(LAS u32x4*)(hw + (j * 64 + lane) * 4) = (u32x4){0u, 0u, 0u, 0u};
        for (int sb = 0; sb < nv4; sb += 64 * SELB) {
            f32x4 va[SELB], vb[SELB];
#pragma unroll
            for (int u = 0; u < SELB; ++u) { const int s4 = sb + u * 64 + lane; const int sc = s4 < nv4 ? s4 : nv4 - 1; va[u] = *(const f32x4*)(scr + sc * 4); vb[u] = *(const f32x4*)(scr + SCR_N + sc * 4); }
#pragma unroll
            for (int u = 0; u < SELB; ++u) if (sb + u * 64 + lane < nv4) {
#pragma unroll
                for (int e = 0; e < 4; ++e) { const unsigned ka = fkey(va[u][e]), kb = fkey(vb[u][e]);
                    if ((ka >> 22) == b1[0]) lds_add(hw + ((ka >> 12) & 1023u), 1u);
                    if ((kb >> 22) == b1[1]) lds_add(hw + 1024 + ((kb >> 12) & 1023u), 1u); } } }
        unsigned b2[2], ab2[2];
        wfind<16>(hw, TOPK - ab1[0], lane, b2[0], ab2[0]); wfind<16>(hw + 1024, TOPK - ab1[1], lane, b2[1], ab2[1]);
        const unsigned pfx0 = (b1[0] << 10) | b2[0], pfx1 = (b1[1] << 10) | b2[1];
        const unsigned need0 = (unsigned)TOPK - ab1[0] - ab2[0], need1 = (unsigned)TOPK - ab1[1] - ab2[1];
        LAS unsigned* cl0 = hw; LAS unsigned* cl1 = hw + 1024;
        unsigned cnt0 = 0u, cnt1 = 0u, cc0 = 0u, cc1 = 0u; int* sel0 = SEL + (size_t)tA * TOPK; int* sel1 = sel0 + TOPK;
        const unsigned long long lt = (1ull << lane) - 1ull;
        for (int sb = 0; sb < nv4; sb += 64 * SELB) {
            f32x4 va[SELB], vb[SELB];
#pragma unroll
            for (int u = 0; u < SELB; ++u) { const int s4 = sb + u * 64 + lane; const int sc = s4 < nv4 ? s4 : nv4 - 1; va[u] = *(const f32x4*)(scr + sc * 4); vb[u] = *(const f32x4*)(scr + SCR_N + sc * 4); }
#pragma unroll
            for (int u = 0; u < SELB; ++u) { const int s4 = sb + u * 64 + lane; const bool inr = s4 < nv4;
                if (sb + u * 64 < nv4) {
#pragma unroll
                    for (int e = 0; e < 4; ++e) {
                        {   const unsigned k = fkey(va[u][e]); const bool gt = inr && (k >> 12) > pfx0, eq = inr && (k >> 12) == pfx0;
                            const unsigned long long mg = __ballot(gt), me = __ballot(eq);
                            if (gt) { const unsigned pos = cnt0 + (unsigned)__builtin_popcountll(mg & lt); if (pos < (unsigned)TOPK) sel0[pos] = s4 * 4 + e; }
                            if (eq) { const unsigned ci = cc0 + (unsigned)__builtin_popcountll(me & lt); if (ci < 512u) { cl0[2 * ci] = k; cl0[2 * ci + 1] = (unsigned)(s4 * 4 + e); } }
                            cnt0 += (unsigned)__builtin_popcountll(mg); cc0 += (unsigned)__builtin_popcountll(me); }
                        {   const unsigned k = fkey(vb[u][e]); const bool gt = inr && (k >> 12) > pfx1, eq = inr && (k >> 12) == pfx1;
                            const unsigned long long mg = __ballot(gt), me = __ballot(eq);
                            if (gt) { const unsigned pos = cnt1 + (unsigned)__builtin_popcountll(mg & lt); if (pos < (unsigned)TOPK) sel1[pos] = s4 * 4 + e; }
                            if (eq) { const unsigned ci = cc1 + (unsigned)__builtin_popcountll(me & lt); if (ci < 512u) { cl1[2 * ci] = k; cl1[2 * ci + 1] = (unsigned)(s4 * 4 + e); } }
                            cnt1 += (unsigned)__builtin_popcountll(mg); cc1 += (unsigned)__builtin_popcountll(me); }
                    } } } }
#pragma unroll 1
        for (int qq = 0; qq < 2; ++qq) {
            const LAS unsigned* cl = qq ? cl1 : cl0; const unsigned c = min(qq ? cc1 : cc0, 512u), need = qq ? need1 : need0, base = qq ? cnt1 : cnt0; int* sel = qq ? sel1 : sel0;
            for (unsigned i = lane; i < c; i += 64) { const unsigned k = cl[2 * i], ix = cl[2 * i + 1]; unsigned rank = 0;
                for (unsigned j = 0; j < c; ++j) { const unsigned kj = cl[2 * j], ij = cl[2 * j + 1]; rank += (kj > k || (kj == k && ij < ix)) ? 1u : 0u; }
                if (rank < need && base + rank < (unsigned)TOPK) sel[base + rank] = (int)ix; }
        }
    }
}

__device__ __forceinline__ void d3_qlat(const P& p, LAS unsigned char* lds, int G) {
    const int tid = threadIdx.x, lane = tid & 63, wave = __builtin_amdgcn_readfirstlane(tid >> 6), r16 = lane & 15, q = lane >> 4;
    const bf16_t* Z = (const bf16_t*)(p.ws + WS_Z); const bf16_t* WK = (const bf16_t*)(p.ws + WS_WUKB); bf16_t* QL = (bf16_t*)(p.ws + WS_QLAT);
    constexpr int NB = L / 16, QBS = 136;
    LAS bf16_t* qb = (LAS bf16_t*)lds;
    const int srow = (tid >> 4) & 15, scol = (tid & 15) * 8;
    for (int item = blockIdx.x; item < 256; item += G) {
        const int h = item & 15, qr = item >> 4; const int b0 = qr * 64, b1 = qr == 15 ? NB : b0 + 64;
        bf16x8_t af[4][4];
#pragma unroll
        for (int mt = 0; mt < 4; ++mt)
#pragma unroll
            for (int ks = 0; ks < 4; ++ks) af[mt][ks] = *(const bf16x8_t*)(WK + ((size_t)h * KVR + wave * 64 + 32 * (mt >> 1) + 8 * (r16 >> 2) + 4 * (mt & 1) + (r16 & 3)) * HD_B + ks * 32 + q * 8);
        u32x4 g0 = *(const u32x4*)(Z + (size_t)(b0 * 16 + srow) * NZ + ZQ + h * 128 + scol);
        __syncthreads();
        for (int b = b0; b < b1; ++b) {
            LAS bf16_t* buf = qb + ((b - b0) & 1) * 16 * QBS;
            if (tid < 256) *(LAS u32x4*)(buf + srow * QBS + scol) = g0;
            const int bnx = b + 1 < b1 ? b + 1 : b;
            g0 = *(const u32x4*)(Z + (size_t)(bnx * 16 + srow) * NZ + ZQ + h * 128 + scol);
            LDS_BARRIER();
            bf16x8_t bq[4];
#pragma unroll
            for (int ks = 0; ks < 4; ++ks) bq[ks] = *(const LAS bf16x8_t*)(buf + r16 * QBS + ks * 32 + q * 8);
#pragma unroll
            for (int mp = 0; mp < 2; ++mp) {
                f32x4 acc0 = {0.f, 0.f, 0.f, 0.f}, acc1 = acc0;
#pragma unroll
                for (int ks = 0; ks < 4; ++ks) { acc0 = __builtin_amdgcn_mfma_f32_16x16x32_bf16(af[2 * mp][ks], bq[ks], acc0, 0, 0, 0); acc1 = __builtin_amdgcn_mfma_f32_16x16x32_bf16(af[2 * mp + 1][ks], bq[ks], acc1, 0, 0, 0); }
                u32x4 w; w.x = cvtpk(acc0[0], acc0[1]); w.y = cvtpk(acc0[2], acc0[3]); w.z = cvtpk(acc1[0], acc1[1]); w.w = cvtpk(acc1[2], acc1[3]);
                *(u32x4*)(QL + (size_t)(b * 16 + r16) * 8192 + h * 512 + wave * 64 + mp * 32 + q * 8) = w;
            }
        }
    }
    __syncthreads();
}
__device__ __forceinline__ void d5_oproj(const P& p, LAS unsigned char* lds, int G) {
    const int tid = threadIdx.x, lane = tid & 63, wave = __builtin_amdgcn_readfirstlane(tid >> 6), r16 = lane & 15, q = lane >> 4;
    const bf16_t* OL = (const bf16_t*)(p.ws + WS_QLAT); const bf16_t* WV = (const bf16_t*)(p.ws + WS_WUVT); bf16_t* YB = (bf16_t*)(p.ws + WS_YB);
    for (size_t i = (size_t)blockIdx.x * NT + tid; i < (size_t)(MP - L) * A_W / 8; i += (size_t)G * NT) *(u32x4*)(YB + (size_t)L * A_W + i * 8) = (u32x4){0u, 0u, 0u, 0u};
    constexpr int NB = L / 16, OLS = 520;
    LAS bf16_t* ob = (LAS bf16_t*)lds;
    const int srow = tid >> 5, scol = (tid & 31) * 8;
    for (int item = blockIdx.x; item < 256; item += G) {
        const int h = item & 15, qr = item >> 4; const int b0 = qr * 64, b1 = qr == 15 ? NB : b0 + 64;
        bf16x8_t af[16];
#pragma unroll
        for (int ks = 0; ks < 16; ++ks) af[ks] = *(const bf16x8_t*)(WV + ((size_t)h * HD_B + wave * 16 + r16) * KVR + ks * 32 + q * 8);
        u32x4 g0 = *(const u32x4*)(OL + (size_t)(b0 * 16 + srow) * 8192 + h * 512 + scol), g1 = *(const u32x4*)(OL + (size_t)(b0 * 16 + srow) * 8192 + h * 512 + scol + 256);
        __syncthreads();
        for (int b = b0; b < b1; ++b) {
            LAS bf16_t* buf = ob + ((b - b0) & 1) * 16 * OLS;
            *(LAS u32x4*)(buf + srow * OLS + scol) = g0; *(LAS u32x4*)(buf + srow * OLS + scol + 256) = g1;
            const int bnx = b + 1 < b1 ? b + 1 : b;
            g0 = *(const u32x4*)(OL + (size_t)(bnx * 16 + srow) * 8192 + h * 512 + scol); g1 = *(const u32x4*)(OL + (size_t)(bnx * 16 + srow) * 8192 + h * 512 + scol + 256);
            LDS_BARRIER();
            f32x4 acc0 = {0.f, 0.f, 0.f, 0.f}, acc1 = acc0;
#pragma unroll
            for (int ks = 0; ks < 16; ks += 2) {
                const bf16x8_t bo0 = *(const LAS bf16x8_t*)(buf + r16 * OLS + ks * 32 + q * 8), bo1 = *(const LAS bf16x8_t*)(buf + r16 * OLS + (ks + 1) * 32 + q * 8);
                acc0 = __builtin_amdgcn_mfma_f32_16x16x32_bf16(af[ks], bo0, acc0, 0, 0, 0); acc1 = __builtin_amdgcn_mfma_f32_16x16x32_bf16(af[ks + 1], bo1, acc1, 0, 0, 0); }
            const f32x4 acc = acc0 + acc1;
            u32x2 w; w.x = cvtpk(acc[0], acc[1]); w.y = cvtpk(acc[2], acc[3]);
            *(u32x2*)(YB + (size_t)(b * 16 + r16) * A_W + h * HD_B + wave * 16 + q * 4) = w;
        }
    }
    __syncthreads();
}

typedef short s16x4_t __attribute__((ext_vector_type(4)));
constexpr int QLS = 520, PLS = 264, CTS = 528;
#ifndef ATT_REG
#define ATT_REG 0
#endif
#if ATT_REG > 0
#define AREG_T() const unsigned long long tt_ = __builtin_amdgcn_s_memrealtime()
#ifndef ATT_BLK
#define ATT_BLK 0
#endif
#define AREG(k) do { if (ATT_REG == (k) && blockIdx.x == ATT_BLK && threadIdx.x == 0) { const unsigned long long t1_ = __builtin_amdgcn_s_memrealtime(); areg_acc += t1_ - areg_t0; } if (ATT_REG != 9 && blockIdx.x == ATT_BLK && threadIdx.x == 0) areg_t0 = __builtin_amdgcn_s_memrealtime(); } while (0)
#else
#define AREG(k) do {} while (0)
#endif
__device__ __forceinline__ void d4_attn(const P& p, LAS unsigned char* lds, int G) {
    unsigned long long areg_acc = 0, areg_t0 = 0; (void)areg_acc; (void)areg_t0;
    const int tid = threadIdx.x, lane = tid & 63, wave = __builtin_amdgcn_readfirstlane(tid >> 6), r16 = lane & 15, q = lane >> 4;
    bf16_t* QO = (bf16_t*)(p.ws + WS_QLAT); const bf16_t* CKV = (const bf16_t*)(p.ws + WS_CKV); const int* SEL = (const int*)(p.ws + WS_SEL);
    LAS bf16_t* ql = (LAS bf16_t*)lds;
    LAS float* lg = (LAS float*)(lds + 16640);
    LAS bf16_t* pl = (LAS bf16_t*)(lds + 49408);
    LAS int* sl = (LAS int*)(lds + 57856);
    LAS bf16_t* ct = (LAS bf16_t*)(lds + 58880);
    LAS bf16_t* cx = (LAS bf16_t*)(lds + 126464);
    const float scale = 0.08838834764831845f;
    u32x4 qn0 = (u32x4){0u, 0u, 0u, 0u}, qn1 = qn0; int seln = -1;
    const bool xdeal = (G == 256);
    const int tq0 = xdeal ? ((int)(blockIdx.x & 7) * (L / 8) + (int)(blockIdx.x >> 3)) : (int)blockIdx.x, tqs = xdeal ? 32 : G, tq1 = xdeal ? ((int)(blockIdx.x & 7) + 1) * (L / 8) : L;
    {   const int t = tq0;
        if (t < tq1) { qn0 = *(const u32x4*)(QO + (size_t)t * 8192 + tid * 8); qn1 = *(const u32x4*)(QO + (size_t)t * 8192 + 4096 + tid * 8); if (tid < TOPK) seln = SEL[(size_t)t * TOPK + tid]; } }
#if ATT_REG == 9
    if (blockIdx.x == ATT_BLK && threadIdx.x == 0) areg_t0 = __builtin_amdgcn_s_memrealtime();
#endif
    for (int t = tq0; t < tq1; t += tqs) {
        AREG(5);
        LDS_BARRIER();
        {   const int i0_ = tid, i1_ = tid + 512;
            *(LAS u32x4*)(ql + (i0_ >> 6) * QLS + (i0_ & 63) * 8) = qn0; *(LAS u32x4*)(ql + (i1_ >> 6) * QLS + (i1_ & 63) * 8) = qn1;
            if (tid < TOPK) sl[tid] = seln; }
        LDS_BARRIER();
        AREG(1);
        u32x4 st[8];
#pragma unroll
        for (int i = 0; i < 8; ++i) { const int idx = sl[wave + 8 * i]; st[i] = *(const u32x4*)(CKV + (size_t)(idx < 0 ? 0 : idx) * KVR + lane * 8); }
        const int kk = wave & 3, kh = wave >> 2;
        bf16x8_t af[8];
#pragma unroll
        for (int ks = 0; ks < 8; ++ks) af[ks] = *(const LAS bf16x8_t*)(ql + r16 * QLS + kh * 256 + ks * 32 + q * 8);
        for (int kt = 0; kt < 4; ++kt) {
            LDS_BARRIER();
#pragma unroll
            for (int i = 0; i < 8; ++i) { LAS bf16_t* dst = (kt == 2 && i >= 4) ? cx + (wave + 8 * i - 32) * CTS : ct + (wave + 8 * i) * CTS; *(LAS u32x4*)(dst + lane * 8) = st[i]; }
            if (kt < 3) {
#pragma unroll
                for (int i = 0; i < 8; ++i) { const int idx = sl[(kt + 1) * 64 + wave + 8 * i]; st[i] = *(const u32x4*)(CKV + (size_t)(idx < 0 ? 0 : idx) * KVR + lane * 8); }
            } else {
#pragma unroll
                for (int i = 0; i < 4; ++i) { const int idx = sl[128 + wave + 8 * i]; st[i] = *(const u32x4*)(CKV + (size_t)(idx < 0 ? 0 : idx) * KVR + lane * 8); }
            }
            LDS_BARRIER();
            const LAS bf16_t* kb = (kt == 2 && kk >= 2) ? cx + ((kk - 2) * 16 + r16) * CTS : ct + (kk * 16 + r16) * CTS;
            f32x4 c0 = {0.f, 0.f, 0.f, 0.f};
#pragma unroll
            for (int ks = 0; ks < 8; ++ks) {
                const bf16x8_t b = *(const LAS bf16x8_t*)(kb + kh * 256 + ks * 32 + q * 8);
                c0 = __builtin_amdgcn_mfma_f32_16x16x32_bf16(af[ks], b, c0, 0, 0, 0);
            }
            const int key = kt * 64 + kk * 16 + r16; const bool inval = sl[key] < 0;
#pragma unroll
            for (int e = 0; e < 4; ++e) lg[kh * 4096 + (4 * q + e) * 256 + key] = inval ? (kh ? 0.f : -INFINITY) : c0[e] * scale;
        }
        LDS_BARRIER();
        AREG(2);
        for (int hd = wave * 2; hd < wave * 2 + 2; ++hd) {
            float v[4]; float mx = -INFINITY;
#pragma unroll
            for (int k = 0; k < 4; ++k) { v[k] = lg[hd * 256 + k * 64 + lane] + lg[4096 + hd * 256 + k * 64 + lane]; mx = fmaxf(mx, v[k]); }
            mx = wave_max(mx);
            float s = 0.f;
#pragma unroll
            for (int k = 0; k < 4; ++k) { v[k] = __expf(v[k] - mx); s += v[k]; }
            s = 1.f / wave_sum(s);
#pragma unroll
            for (int k = 0; k < 4; ++k) pl[hd * PLS + k * 64 + lane] = f2bf(v[k] * s);
        }
        f32x4 acc[4];
#pragma unroll
        for (int m = 0; m < 4; ++m) acc[m] = (f32x4){0.f, 0.f, 0.f, 0.f};
        {   const int tn = t + tqs;
            if (tn < tq1) { qn0 = *(const u32x4*)(QO + (size_t)tn * 8192 + tid * 8); qn1 = *(const u32x4*)(QO + (size_t)tn * 8192 + 4096 + tid * 8); if (tid < TOPK) seln = SEL[(size_t)tn * TOPK + tid]; } }
        AREG(3);
        for (int j2 = 0; j2 < 4; ++j2) {
            const int kt = 3 - j2;
            LDS_BARRIER();
            if (j2 > 0) {
                if (j2 == 1) {
#pragma unroll
                    for (int i = 0; i < 4; ++i) *(LAS u32x4*)(ct + (wave + 8 * i) * CTS + lane * 8) = st[i];
                } else {
#pragma unroll
                    for (int i = 0; i < 8; ++i) *(LAS u32x4*)(ct + (wave + 8 * i) * CTS + lane * 8) = st[i];
                }
                if (j2 < 3) {
#pragma unroll
                    for (int i = 0; i < 8; ++i) { const int idx = sl[(kt - 1) * 64 + wave + 8 * i]; st[i] = *(const u32x4*)(CKV + (size_t)(idx < 0 ? 0 : idx) * KVR + lane * 8); } }
                LDS_BARRIER();
            }
            const int kq = 16 * (q >> 1) + 4 * (q & 1);
#pragma unroll
            for (int s = 0; s < 2; ++s) {
                const u32x2 pa = *(const LAS u32x2*)(pl + r16 * PLS + kt * 64 + s * 32 + kq), pb = *(const LAS u32x2*)(pl + r16 * PLS + kt * 64 + s * 32 + kq + 8);
                const u32x4 pw = (u32x4){pa.x, pa.y, pb.x, pb.y}; const bf16x8_t b = __builtin_bit_cast(bf16x8_t, pw);
                const LAS bf16_t* cb = (kt == 2 && s == 1) ? cx : ct + s * 32 * CTS;
                const LAS bf16_t* tp = cb + (kq + (r16 >> 2)) * CTS + wave * 64 + (r16 & 3) * 4;
#pragma unroll
                for (int m = 0; m < 4; ++m) {
                    const s16x4_t lo = __builtin_amdgcn_ds_read_tr16_b64_v4i16((LAS s16x4_t*)(tp + m * 16)), hi = __builtin_amdgcn_ds_read_tr16_b64_v4i16((LAS s16x4_t*)(tp + 8 * CTS + m * 16));
                    const bf16x8_t a = (bf16x8_t){lo[0], lo[1], lo[2], lo[3], hi[0], hi[1], hi[2], hi[3]};
                    acc[m] = __builtin_amdgcn_mfma_f32_16x16x32_bf16(a, b, acc[m], 0, 0, 0);
                }
            }
        }
        AREG(4);
#pragma unroll
        for (int m = 0; m < 4; ++m) { u32x2 w; w.x = cvtpk(acc[m][0], acc[m][1]); w.y = cvtpk(acc[m][2], acc[m][3]);
            *(u32x2*)(QO + (size_t)t * 8192 + r16 * 512 + wave * 64 + m * 16 + q * 4) = w; }
    }
#if ATT_REG == 9
    if (blockIdx.x == ATT_BLK && threadIdx.x == 0) areg_acc = __builtin_amdgcn_s_memrealtime() - areg_t0;
#endif
#if ATT_REG > 0
    if (blockIdx.x == ATT_BLK && threadIdx.x == 0) __hip_atomic_store((unsigned*)(p.ws + WS_CTL) + 65540, (unsigned)areg_acc, __ATOMIC_RELAXED, __HIP_MEMORY_SCOPE_AGENT);
#endif
}


__device__ __forceinline__ const float* h1_row(const P& p, int m) { const float* hmeta = (const float*)(p.ws + WS_HMETA); return m < NMETA ? hmeta + (size_t)m * D : p.out + (size_t)(m - NMETA) * D; }
__device__ __forceinline__ void p12_norm(const P& p, int G) {
    const int lane = threadIdx.x & 63, wave = threadIdx.x >> 6;
    signed char* U8 = (signed char*)(p.ws + WS_U); const float* w = p.in[I_NFW];
    float wm = 0.f;
#pragma unroll
    for (int j = 0; j < 16; ++j) { const f32x4 g = *(const f32x4*)(w + (j * 64 + lane) * 4); wm += (g.x * g.x + g.y * g.y) + (g.z * g.z + g.w * g.w); }
    wm = sqrtf(wave_sum(wm) * (1.f / D));
    const float amc = 4.0f * wm;
    const float inv = amc > 0.f ? 127.f / amc : 0.f;
    if (blockIdx.x == 0 && threadIdx.x == 0) *(float*)(p.ws + WS_CTL + CT_SAG) = amc > 0.f ? amc * (1.f / 127.f) : 1.f;
    for (int m = blockIdx.x * NWAVES + wave; m < MP; m += G * NWAVES) {
        signed char* dst = U8 + (size_t)m * D;
        if (m >= L) {
#pragma unroll
            for (int j = 0; j < 4; ++j) *(u32x4*)(dst + (j * 64 + lane) * 16) = (u32x4){0u, 0u, 0u, 0u};
            continue; }
        const float* src = h1_row(p, m);
        f32x4 v[16]; float s = 0.f;
#pragma unroll
        for (int j = 0; j < 16; ++j) { v[j] = *(const f32x4*)(src + (j * 64 + lane) * 4); s += (v[j].x * v[j].x + v[j].y * v[j].y) + (v[j].z * v[j].z + v[j].w * v[j].w); }
        const float ri = rsqrtf(wave_sum(s) * (1.f / D) + 1e-6f) * inv;
#pragma unroll
        for (int j = 0; j < 16; ++j) { const f32x4 x = v[j] * ri; const f32x4 g = *(const f32x4*)(w + (j * 64 + lane) * 4);
            const unsigned q = ((unsigned)(int)rintf(fminf(fmaxf(x.x * g.x, -127.f), 127.f)) & 0xffu) | (((unsigned)(int)rintf(fminf(fmaxf(x.y * g.y, -127.f), 127.f)) & 0xffu) << 8) | (((unsigned)(int)rintf(fminf(fmaxf(x.z * g.z, -127.f), 127.f)) & 0xffu) << 16) | (((unsigned)(int)rintf(fminf(fmaxf(x.w * g.w, -127.f), 127.f)) & 0xffu) << 24);
            *(unsigned*)(dst + (j * 64 + lane) * 4) = q; }
    }
}
__device__ __forceinline__ void p18_final_norm(const P& p, int G) {
    const int tid = threadIdx.x, lane = tid & 63, wave = tid >> 6;
    const float* w = p.in[I_NFIN];
    for (int m = blockIdx.x * NWAVES + wave; m < SEQ; m += G * NWAVES) {
        float* row = p.out + (size_t)m * D;
        f32x4 v[16]; float s = 0.f;
#pragma unroll
        for (int j = 0; j < 16; ++j) { v[j] = *(const f32x4*)(row + (j * 64 + lane) * 4); s += (v[j].x * v[j].x + v[j].y * v[j].y) + (v[j].z * v[j].z + v[j].w * v[j].w); }
        float r = rsqrtf(wave_sum(s) * (1.f / D) + 1e-6f);
#if STAMP_A0 >= 0
        r *= 1.f + 1e-7f * (float)__hip_atomic_load((const unsigned*)(p.ws + WS_CTL) + 65536, __ATOMIC_RELAXED, __HIP_MEMORY_SCOPE_AGENT);
#endif
#pragma unroll
        for (int j = 0; j < 16; ++j) { const f32x4 g = *(const f32x4*)(w + (j * 64 + lane) * 4); *(f32x4*)(row + (j * 64 + lane) * 4) = v[j] * r * g; }
    }
}

__device__ __forceinline__ void p14_conv_act(const P& p, int G, int pass) {
    const int tid = threadIdx.x;
    const bf16_t* ZF = (const bf16_t*)(p.ws + WS_ZF); bf16_t* ACT = (bf16_t*)(p.ws + WS_ACT);
    const float* cw = p.in[I_CW]; const float* cb = p.in[I_CB];
    const size_t nitems = (size_t)MP * 43 * 16;
    for (size_t it = (size_t)blockIdx.x * NT + tid; it < nitems; it += (size_t)G * NT) {
        const int g8 = (int)(it % 16), tl = (int)((it / 16) % 43), t = (int)(it / (16 * 43));
        const int ch = (pass * 43 + tl) * 128 + g8 * 8;
        u32x4 o = (u32x4){0u, 0u, 0u, 0u};
        if (t < L) {
            float zg[8], zu[8];
#pragma unroll
            for (int e = 0; e < 8; ++e) { zg[e] = cb[ch + e]; zu[e] = cb[DFF + ch + e]; }
#pragma unroll
            for (int i = 0; i < 3; ++i) { const int tt = t - 2 + i;
                if (tt >= 0) {
                    const u32x4 a = *(const u32x4*)(ZF + (size_t)tt * DFF + tl * 256 + g8 * 8), b = *(const u32x4*)(ZF + (size_t)tt * DFF + tl * 256 + 128 + g8 * 8);
                    const float xa[8] = {blo(a.x), bhi(a.x), blo(a.y), bhi(a.y), blo(a.z), bhi(a.z), blo(a.w), bhi(a.w)};
                    const float xb[8] = {blo(b.x), bhi(b.x), blo(b.y), bhi(b.y), blo(b.z), bhi(b.z), blo(b.w), bhi(b.w)};
#pragma unroll
                    for (int e = 0; e < 8; ++e) { zg[e] += cw[(size_t)i * NFI + ch + e] * xa[e]; zu[e] += cw[(size_t)i * NFI + DFF + ch + e] * xb[e]; }
                } }
            float r[8];
#pragma unroll
            for (int e = 0; e < 8; ++e) r[e] = zg[e] * sigm(zg[e]) * zu[e];
            o.x = pk2(r[0], r[1]); o.y = pk2(r[2], r[3]); o.z = pk2(r[4], r[5]); o.w = pk2(r[6], r[7]);
        }
        *(u32x4*)(ACT + (size_t)t * DFF + ch) = o;
    }
}

template <int K, class F> __device__ __forceinline__ void side2(const bf16_t* A14, int lda, const bf16_t* Bt, int N, int G, F f) {
    const int lane = threadIdx.x & 63, gw = blockIdx.x * NWAVES + (threadIdx.x >> 6);
    constexpr int NC = K / 512;
    u32x4 a0[NC], a1[NC];
#pragma unroll
    for (int i = 0; i < NC; ++i) { a0[i] = *(const u32x4*)(A14 + i * 512 + lane * 8); a1[i] = *(const u32x4*)(A14 + lda + i * 512 + lane * 8); }
    for (int n = gw; n < N; n += G * NWAVES) {
        float s0 = 0.f, s1 = 0.f;
#pragma unroll
        for (int i = 0; i < NC; ++i) { const u32x4 b = *(const u32x4*)(Bt + (size_t)n * K + i * 512 + lane * 8);
            const unsigned bw[4] = {b.x, b.y, b.z, b.w}, x0[4] = {a0[i].x, a0[i].y, a0[i].z, a0[i].w}, x1[4] = {a1[i].x, a1[i].y, a1[i].z, a1[i].w};
#pragma unroll
            for (int e = 0; e < 4; ++e) { s0 += blo(x0[e]) * blo(bw[e]) + bhi(x0[e]) * bhi(bw[e]); s1 += blo(x1[e]) * blo(bw[e]) + bhi(x1[e]) * bhi(bw[e]); } }
        s0 = wave_sum(s0); s1 = wave_sum(s1);
        if (lane == 0) f(n, s0, s1);
    }
}

template <class F> __device__ __forceinline__ void side2_i8(const signed char* A14, const signed char* Bt, int N, int G, F f) {
    const int lane = threadIdx.x & 63, gw = blockIdx.x * NWAVES + (threadIdx.x >> 6);
    u32x4 a0[4], a1[4];
#pragma unroll
    for (int i = 0; i < 4; ++i) { a0[i] = *(const u32x4*)(A14 + i * 1024 + lane * 16); a1[i] = *(const u32x4*)(A14 + 4096 + i * 1024 + lane * 16); }
    for (int n = gw; n < N; n += G * NWAVES) {
        int s0 = 0, s1 = 0;
#pragma unroll
        for (int i = 0; i < 4; ++i) { const u32x4 b = *(const u32x4*)(Bt + (size_t)n * 4096 + i * 1024 + lane * 16);
            s0 = __builtin_amdgcn_sdot4((int)a0[i].x, (int)b.x, s0, false); s0 = __builtin_amdgcn_sdot4((int)a0[i].y, (int)b.y, s0, false); s0 = __builtin_amdgcn_sdot4((int)a0[i].z, (int)b.z, s0, false); s0 = __builtin_amdgcn_sdot4((int)a0[i].w, (int)b.w, s0, false);
            s1 = __builtin_amdgcn_sdot4((int)a1[i].x, (int)b.x, s1, false); s1 = __builtin_amdgcn_sdot4((int)a1[i].y, (int)b.y, s1, false); s1 = __builtin_amdgcn_sdot4((int)a1[i].z, (int)b.z, s1, false); s1 = __builtin_amdgcn_sdot4((int)a1[i].w, (int)b.w, s1, false); }
#pragma unroll
        for (int d = 32; d >= 1; d >>= 1) { s0 += __shfl_xor(s0, d); s1 += __shfl_xor(s1, d); }
        if (lane == 0) f(n, s0, s1);
    }
}

__device__ __forceinline__ void p_conv_fix(const P& p, int G) {
    const int tid = threadIdx.x;
    const float* HALO = (const float*)(p.ws + WS_ZF); bf16_t* ACT = (bf16_t*)(p.ws + WS_ACT);
    const float* cw = p.in[I_CW]; const float* cb = p.in[I_CB];
    const int nitems = 64 * 2 * DFF;
    for (int it = blockIdx.x * NT + tid; it < nitems; it += G * NT) {
        const int c = it % DFF, d = (it / DFF) & 1, pm = 1 + it / (2 * DFF);
        const int r = pm * 256 + d; if (r >= L) continue;
        const int T = c >> 7, cl = c & 127; const int colg = T * 256 + cl, colu = colg + 128;
        const float* h0 = HALO + ((size_t)(pm - 1) * 4 + 2 + d) * NFI; const float* h1 = d == 0 ? HALO + ((size_t)(pm - 1) * 4 + 3) * NFI : HALO + ((size_t)pm * 4 + 0) * NFI; const float* h2 = HALO + ((size_t)pm * 4 + d) * NFI;
        const float zg = cb[c] + cw[c] * h0[colg] + cw[(size_t)NFI + c] * h1[colg] + cw[(size_t)2 * NFI + c] * h2[colg];
        const float zu = cb[DFF + c] + cw[DFF + c] * h0[colu] + cw[(size_t)NFI + DFF + c] * h1[colu] + cw[(size_t)2 * NFI + DFF + c] * h2[colu];
        ACT[(size_t)r * DFF + c] = f2bf(zg * sigm(zg) * zu);
    }
}

constexpr int NPHASE = 20;
__global__ void __launch_bounds__(NT, 2) fwd_kernel(P p) {
    extern __shared__ __attribute__((aligned(16))) unsigned char lds_raw[];
    LAS unsigned char* lds = (LAS unsigned char*)lds_raw;
    const int G = gridDim.x;
    unsigned char* ws = p.ws;
    volatile LAS unsigned* MISC = (volatile LAS unsigned*)(lds + MISC_OFF);
    if (threadIdx.x < 16) MISC[threadIdx.x] = 0u;
    __syncthreads();
#if MK_ONE_LAUNCH
    XcdBarrier bar = xcd_barrier_post((unsigned*)(ws + WS_CTL), MISC + 8);
#define GRID_BAR() xcd_barrier(bar)
#else
#define GRID_BAR() do {} while (0)
#endif
    unsigned long long tsA0 = 0, tsA1 = 0, tsB0 = 0, tsB1 = 0; (void)tsA0; (void)tsA1; (void)tsB0; (void)tsB1;
    const int lo = p.ph_lo, hi = p.ph_hi;
#ifndef PHASE_MASK
#define PHASE_MASK 0xFFFFFFFu
#endif
#define IN(k) ((((PHASE_MASK) >> (k)) & 1u) && lo <= (k) && (k) < hi)
#ifndef STAMP_A0
#define STAMP_A0 -1
#endif
#if STAMP_A0 >= 0
#define STAMP(k) do { if (blockIdx.x == 0 && threadIdx.x == 0) { const unsigned long long t_ = __builtin_amdgcn_s_memrealtime(); if ((k) == STAMP_A0) tsA0 = t_; if ((k) == STAMP_A1) tsA1 = t_; if ((k) == STAMP_B0) tsB0 = t_; if ((k) == STAMP_B1) { tsB1 = t_; \
    __hip_atomic_store((unsigned*)(ws + WS_CTL) + 65536, (unsigned)(tsB1 - tsB0), __ATOMIC_RELAXED, __HIP_MEMORY_SCOPE_AGENT); } } } while (0)
#else
#define STAMP(k) do {} while (0)
#endif
#define SEAM(k) do { if (IN((k) + 1)) GRID_BAR(); STAMP((k) + 1); } while (0)
    STAMP(0);
#ifndef PROBE_REP_MASK
#define PROBE_REP_MASK 0u
#endif
#define NREP(k) ((((PROBE_REP_MASK) >> (k)) & 1u) ? 2 : 1)
    bf16_t* U = (bf16_t*)(ws + WS_U);
    if (IN(0)) _Pragma("unroll") for (int rep_ = 0; rep_ < NREP(0); ++rep_) { p0_prologue_a(p, lds, G); GRID_BAR(); p0_prologue_b(p, lds, G); if (rep_ == NREP(0) - 1) SEAM(0); }
    if (IN(1)) _Pragma("unroll") for (int rep_ = 0; rep_ < NREP(1); ++rep_) {
        {   pg8::Gemm g{U, (const bf16_t*)(ws + WS_WINT), MP, NZ8, D / 2, (const float*)(ws + WS_CTL + CT_SA), (const float*)(ws + WS_CTL + CT_SB_IN)}; pg8::StaticOrder S; S.init(MP, NZ8, G, (int)blockIdx.x);
            pg8::EpiBf16<0> E{(bf16_t*)(ws + WS_Z), NZ};
            pg8::gemm_phase<pg8::EpiBf16<0>, pg8::StaticOrder, true, true, true>(lds, g, S, E); }
        {   pg8::Gemm g{(const bf16_t*)(ws + WS_R1), (const bf16_t*)(ws + WS_WINT + WINT_BF_OFF), MP, NZ - NZ8, D}; pg8::StaticOrder S; S.init(MP, NZ - NZ8, G, (int)blockIdx.x);
            pg8::EpiBf16<0> E{(bf16_t*)(ws + WS_Z) + NZ8, NZ};
            pg8::gemm_phase<pg8::EpiBf16<0>, pg8::StaticOrder, true, true, false>(lds, g, S, E); }
        if (rep_ == NREP(1) - 1) SEAM(1);
    }
    if (IN(2)) _Pragma("unroll") for (int rep_ = 0; rep_ < NREP(2); ++rep_) { p2_rwkv_prep(p, lds, G); if (rep_ == NREP(2) - 1) SEAM(2); }
    if (IN(3)) _Pragma("unroll") for (int rep_ = 0; rep_ < NREP(3); ++rep_) { ra_items(p, lds, G); if (rep_ == NREP(3) - 1) SEAM(3); }
    if (IN(4)) _Pragma("unroll") for (int rep_ = 0; rep_ < NREP(4); ++rep_) { rb_chain(p, G);
        {
            const int wv_ = threadIdx.x >> 6, nch_ = G < 128 ? G : 128; const int nvw_ = nch_ * 7 + (G - nch_) * 8;
            const int vw_ = (int)blockIdx.x < nch_ ? ((int)blockIdx.x * 7 + wv_ - 1) : (nch_ * 7 + ((int)blockIdx.x - nch_) * 8 + wv_);
            if (!((int)blockIdx.x < nch_ && wv_ == 0)) p0b_weights(p, lds, vw_, nvw_); }
        if (rep_ == NREP(4) - 1) SEAM(4); }
    if (IN(5)) _Pragma("unroll") for (int rep_ = 0; rep_ < NREP(5); ++rep_) { rc_out(p, G); if (rep_ == NREP(5) - 1) SEAM(5); }
    if (IN(6)) _Pragma("unroll") for (int rep_ = 0; rep_ < NREP(6); ++rep_) { p4_dsa_prep(p, G); if (rep_ == NREP(6) - 1) SEAM(6); }
    if (IN(7)) _Pragma("unroll") for (int rep_ = 0; rep_ < NREP(7); ++rep_) { d2_topk(p, lds, G); if (rep_ == NREP(7) - 1) SEAM(7); }
    if (IN(8)) _Pragma("unroll") for (int rep_ = 0; rep_ < NREP(8); ++rep_) { d3_qlat(p, lds, G); if (rep_ == NREP(8) - 1) SEAM(8); }
    if (IN(9)) _Pragma("unroll") for (int rep_ = 0; rep_ < NREP(9); ++rep_) { d4_attn(p, lds, G); if (rep_ == NREP(9) - 1) SEAM(9); }
    if (IN(11)) _Pragma("unroll") for (int rep_ = 0; rep_ < NREP(11); ++rep_) {
        d5_oproj(p, lds, G);
        pg8::Gemm g{U + (size_t)NMETA * (D / 2), (const bf16_t*)(ws + WS_WGT), SEQ, 8192, D / 2, (const float*)(ws + WS_CTL + CT_SA) + NMETA, (const float*)(ws + WS_CTL + CT_SB_G)}; pg8::StaticOrder S; S.init(SEQ, 8192, G, (int)blockIdx.x);
        pg8::EpiBf16<1> E{(bf16_t*)(ws + WS_GATES) + (size_t)NMETA * 8192, 8192};
        pg8::gemm_phase<pg8::EpiBf16<1>, pg8::StaticOrder, true, true, true>(lds, g, S, E);
        {   const float* SA_ = (const float*)(ws + WS_CTL + CT_SA); const float* SB_ = (const float*)(ws + WS_CTL + CT_SB_G); bf16_t* GT = (bf16_t*)(ws + WS_GATES);
            side2_i8((const signed char*)(ws + WS_U) + (size_t)14 * D, (const signed char*)(ws + WS_WGT), 8192, G, [&](int n, int i0, int i1) {
                GT[(size_t)14 * 8192 + n] = f2bf(1.f / (1.f + __expf(-(float)i0 * SA_[14] * SB_[n]))); GT[(size_t)15 * 8192 + n] = f2bf(1.f / (1.f + __expf(-(float)i1 * SA_[15] * SB_[n]))); }); }
        if (rep_ == NREP(11) - 1) SEAM(11);
    }
    if (IN(12)) _Pragma("unroll") for (int rep_ = 0; rep_ < NREP(12); ++rep_) {
        pg8::Gemm g{(const bf16_t*)(ws + WS_YA) + (size_t)NMETA * A_W, (const bf16_t*)(ws + WS_WPAT), SEQ, D, A_W}; pg8::StaticOrder S; S.init(SEQ, D, G, (int)blockIdx.x);
        pg8::EpiGateMulF32 E{(bf16_t*)(ws + WS_MF) + (size_t)NMETA * D, D, (const bf16_t*)(ws + WS_GATES) + (size_t)NMETA * 8192, 8192, 0};
        pg8::gemm_phase<pg8::EpiGateMulF32, pg8::StaticOrder, true, true>(lds, g, S, E);
        {   bf16_t* MA = (bf16_t*)(ws + WS_MF); const bf16_t* GT = (const bf16_t*)(ws + WS_GATES);
            side2<2048>((const bf16_t*)(ws + WS_YA) + (size_t)14 * A_W, A_W, (const bf16_t*)(ws + WS_WPAT), D, G, [&](int n, float s0, float s1) {
                MA[(size_t)14 * D + n] = f2bf(bf2f(GT[(size_t)14 * 8192 + n]) * s0); MA[(size_t)15 * D + n] = f2bf(bf2f(GT[(size_t)15 * 8192 + n]) * s1); }); }
        if (rep_ == NREP(12) - 1) SEAM(12);
    }
    if (IN(13)) _Pragma("unroll") for (int rep_ = 0; rep_ < NREP(13); ++rep_) {
        pg8::Gemm g{(const bf16_t*)(ws + WS_YB) + (size_t)NMETA * A_W, (const bf16_t*)(ws + WS_WPBT), SEQ, D, A_W}; pg8::StaticOrder S; S.init(SEQ, D, G, (int)blockIdx.x);
        pg8::EpiGateMulAddBf16 E{U + (size_t)NMETA * D, D, (const bf16_t*)(ws + WS_MF) + (size_t)NMETA * D, (const bf16_t*)(ws + WS_GATES) + (size_t)NMETA * 8192, 8192, D};
        pg8::gemm_phase<pg8::EpiGateMulAddBf16, pg8::StaticOrder, true, true>(lds, g, S, E);
        {   const bf16_t* MA = (const bf16_t*)(ws + WS_MF); const bf16_t* GT = (const bf16_t*)(ws + WS_GATES);
            side2<2048>((const bf16_t*)(ws + WS_YB) + (size_t)14 * A_W, A_W, (const bf16_t*)(ws + WS_WPBT), D, G, [&](int n, float s0, float s1) {
                U[(size_t)14 * D + n] = f2bf(bf2f(MA[(size_t)14 * D + n]) + bf2f(GT[(size_t)14 * 8192 + D + n]) * s0); U[(size_t)15 * D + n] = f2bf(bf2f(MA[(size_t)15 * D + n]) + bf2f(GT[(size_t)15 * 8192 + D + n]) * s1); }); }
        if (rep_ == NREP(13) - 1) SEAM(13);
    }
    if (IN(14)) _Pragma("unroll") for (int rep_ = 0; rep_ < NREP(14); ++rep_) {
        pg8::Gemm g{U + (size_t)NMETA * D, (const bf16_t*)(ws + WS_WOUTT), SEQ, D, D}; pg8::StaticOrder S; S.init(SEQ, D, G, (int)blockIdx.x);
        pg8::EpiResid E{p.in[I_X], p.in[I_X], p.out, p.out, D, 0, SEQ};
        pg8::gemm_phase<pg8::EpiResid, pg8::StaticOrder, true, true>(lds, g, S, E);
        {   float* HM = (float*)(ws + WS_HMETA); const float* mt = p.in[I_META];
            for (int i2 = blockIdx.x * NT + threadIdx.x; i2 < 14 * D; i2 += G * NT) HM[i2] = mt[i2];
            side2<4096>(U + (size_t)14 * D, D, (const bf16_t*)(ws + WS_WOUTT), D, G, [&](int n, float s0, float s1) { HM[(size_t)14 * D + n] = mt[(size_t)14 * D + n] + s0; HM[(size_t)15 * D + n] = mt[(size_t)15 * D + n] + s1; }); }
        if (rep_ == NREP(14) - 1) SEAM(14);
    }
    if (IN(15)) _Pragma("unroll") for (int rep_ = 0; rep_ < NREP(15); ++rep_) { p12_norm(p, G); if (rep_ == NREP(15) - 1) SEAM(15); }
    if (IN(16)) _Pragma("unroll") for (int rep_ = 0; rep_ < NREP(16); ++rep_) {
        pg8::Gemm g{U, (const bf16_t*)(ws + WS_WFIT), MP, NFI, D / 2, (const float*)(ws + WS_CTL + CT_SA), (const float*)(ws + WS_CTL + CT_SB_F)}; pg8::StaticOrder S; S.init(MP, NFI, G, (int)blockIdx.x);
        pg8::EpiConvAct E{(bf16_t*)(ws + WS_ACT), DFF, (float*)(ws + WS_ZF), NFI, p.in[I_CW], p.in[I_CB], DFF, (PG8_LAS float*)(lds + 131072), (const float*)(ws + WS_CTL + CT_SAG), (const float*)(ws + WS_CTL + CT_SB_F)};
        pg8::gemm_phase<pg8::EpiConvAct, pg8::StaticOrder, true, true, true>(lds, g, S, E);
        if (rep_ == NREP(16) - 1) SEAM(16);
    }
    if (IN(17)) _Pragma("unroll") for (int rep_ = 0; rep_ < NREP(17); ++rep_) { p_conv_fix(p, G); if (rep_ == NREP(17) - 1) SEAM(17); }
    if (IN(18)) _Pragma("unroll") for (int rep_ = 0; rep_ < NREP(18); ++rep_) {
        pg8::Gemm g{(const bf16_t*)(ws + WS_ACT) + (size_t)NMETA * DFF, (const bf16_t*)(ws + WS_WFOT), SEQ, D, DFF}; pg8::StaticOrder S; S.init(SEQ, D, G, (int)blockIdx.x);
        pg8::EpiResid E{p.out, p.out, p.out, p.out, D, 0, SEQ};
        pg8::gemm_phase<pg8::EpiResid, pg8::StaticOrder, true, true>(lds, g, S, E);
        if (rep_ == NREP(18) - 1) SEAM(18);
    }
    if (IN(19)) _Pragma("unroll") for (int rep_ = 0; rep_ < NREP(19); ++rep_) { p18_final_norm(p, G); }
#if STAMP_A0 >= 0
    if (blockIdx.x == 0 && threadIdx.x == 0) { const unsigned long long t_end = __builtin_amdgcn_s_memrealtime(); unsigned long long dA = (tsA1 - tsA0) * 64ull;
#if defined(ATT_REG) && ATT_REG > 0
        dA = (unsigned long long)__hip_atomic_load((const unsigned*)(ws + WS_CTL) + 65540, __ATOMIC_RELAXED, __HIP_MEMORY_SCOPE_AGENT) * 64ull;
#endif
        while (__builtin_amdgcn_s_memrealtime() - t_end < dA) __builtin_amdgcn_s_sleep(8); }
#endif
#undef IN
#undef SEAM
}

extern "C" void kernel_launch(void* const* d_in, const int* in_sizes, int n_in, void* d_out, int out_size, void* d_ws, size_t ws_size, hipStream_t stream) {
    static int grid = 0;
    if (grid == 0) {
        if (n_in != 30 || out_size != SEQ * D || ws_size < WS_END2) { fprintf(stderr, "kernel_launch: unexpected shapes (n_in %d out %d ws %zu need %zu)\n", n_in, out_size, ws_size, (size_t)WS_END); grid = -1; return; }
        int dev = 0, cus = 0, per_cu = 0;
        if (hipGetDevice(&dev) != hipSuccess || hipDeviceGetAttribute(&cus, hipDeviceAttributeMultiprocessorCount, dev) != hipSuccess) { grid = -1; return; }
        if (hipFuncSetAttribute((const void*)fwd_kernel, hipFuncAttributeMaxDynamicSharedMemorySize, LDS_BYTES) != hipSuccess) { fprintf(stderr, "kernel_launch: hipFuncSetAttribute failed\n"); grid = -1; return; }
        if (hipOccupancyMaxActiveBlocksPerMultiprocessor(&per_cu, (const void*)fwd_kernel, NT, LDS_BYTES) != hipSuccess || per_cu < 1) fprintf(stderr, "kernel_launch: occupancy query says %d\n", per_cu);
        (void)hipGetLastError();
        grid = cus;
    }
    if (grid < 0) return;
    (void)hipMemsetAsync((char*)d_ws + WS_CTL, 0, CTL_BYTES, stream);
    P a{};
    for (int i = 0; i < 30; ++i) a.in[i] = (const float*)d_in[i];
    a.out = (float*)d_out; a.ws = (unsigned char*)d_ws;
#if MK_ONE_LAUNCH
    a.ph_lo = 0; a.ph_hi = NPHASE;
    hipLaunchKernelGGL(fwd_kernel, dim3(grid), dim3(NT), LDS_BYTES, stream, a);
#else
    for (int k = 0; k < NPHASE; ++k) { a.ph_lo = k; a.ph_hi = k + 1; hipLaunchKernelGGL(fwd_kernel, dim3(grid), dim3(NT), LDS_BYTES, stream, a); }
#endif
}
```

```cpp
#include <hip/hip_runtime.h>
#include <cstdio>
#include <cstdint>
#define MK_ONE_LAUNCH 1
namespace pg8 {
#define PG8_LAS __attribute__((address_space(3)))
typedef unsigned short bf16_t;
typedef short bf16x8 __attribute__((ext_vector_type(8)));
typedef float f32x4 __attribute__((ext_vector_type(4)));
typedef unsigned u32x4 __attribute__((ext_vector_type(4)));
typedef int i32x4 __attribute__((ext_vector_type(4)));
constexpr int BM = 256, BK = 64, HALF = 128, HTB = HALF * BK * 2  , STAGE_BYTES = 8 * HTB, NXCD = 8, WGM = 4;

__host__ __device__ __forceinline__ int lds_byte(int r, int c) { const int st = (r >> 4) * 2 + (c >> 5), rr = r & 15, cc = c & 31, ob = rr * 64 + cc * 2; return st * 1024 + (ob ^ (((ob >> 9) & 1) << 5)); }
__host__ __device__ __forceinline__ void stage_rc(int b, int& R, int& C) { const int st = b / 1024, sb = b % 1024, swz = sb ^ (((sb >> 9) & 1) << 5); R = (st >> 1) * 16 + swz / 64; C = (st & 1) * 32 + (swz % 64) / 2; }
__host__ __device__ __forceinline__ int perm32(int rho) { const int n = rho >> 4, i = rho & 15; return 8 * (i >> 2) + 4 * n + (i & 3); }

struct Unit { int pm, pn; };
struct Gemm { const bf16_t* A; const bf16_t* Bt; int M, N, K; const float* sa; const float* sb; };

struct StaticOrder {
    int nM, nN, nwg, G, c;
    __host__ __device__ void init(int M, int N, int G_, int c_) { nM = M / BM; nN = N / BM; nwg = nM * nN; G = G_; c = c_; }
    __host__ __device__ bool next(int i, Unit& u) const {
        const long L = (long)i * G + c; if (L >= nwg) return false;
        int wgid = (int)L; { const int q = nwg / NXCD, r = nwg % NXCD, xcd = wgid % NXCD, off = wgid / NXCD; wgid = (xcd < r ? xcd * (q + 1) : r * (q + 1) + (xcd - r) * q) + off; }
        const int nig = WGM * nN, gid = wgid / nig, fm = gid * WGM, gsz = (nM - fm) < WGM ? (nM - fm) : WGM;
        u.pm = fm + ((wgid % nig) % gsz); u.pn = (wgid % nig) / gsz; return true;
    }
    __device__ __forceinline__ void a_ready(const Unit&) const {}
    __device__ __forceinline__ void done(const Unit&) const {}
};

__device__ __forceinline__ unsigned cvt_pk_bf16(float lo, float hi) { unsigned r; asm volatile("v_cvt_pk_bf16_f32 %0, %1, %2" : "=v"(r) : "v"(lo), "v"(hi)); return r; }
typedef float f32x2 __attribute__((ext_vector_type(2)));

typedef unsigned u32x2 __attribute__((ext_vector_type(2)));
__device__ __forceinline__ float bf_lo(unsigned w) { return __uint_as_float(w << 16); }
__device__ __forceinline__ float bf_hi(unsigned w) { return __uint_as_float(w & 0xffff0000u); }
__device__ __forceinline__ float sigmoidf_(float x) { return 1.f / (1.f + __expf(-x)); }

template <int ACT> struct EpiBf16 {
    static constexpr bool PERM = true, AFTER_DRAIN = false, SELF_SCALE = false;
    bf16_t* O; int ldc;
    __device__ __forceinline__ void operator()(const f32x4 (&acc)[2][2][4][2], const Unit& u, int wr, int wc, int fr, int fq) const {
        const int row0 = u.pm * BM + wr * 64 + fr; const int col0 = u.pn * BM + wc * 32 + 8 * fq;
#pragma unroll
        for (int ai = 0; ai < 2; ++ai)
#pragma unroll
            for (int m = 0; m < 4; ++m) { bf16_t* rowp = O + (size_t)(row0 + ai * HALF + m * 16) * ldc + col0;
#pragma unroll
                for (int bj = 0; bj < 2; ++bj) { f32x4 v0 = acc[ai][bj][m][0], v1 = acc[ai][bj][m][1];
                    if (ACT == 1) {
#pragma unroll
                        for (int e = 0; e < 4; ++e) { v0[e] = sigmoidf_(v0[e]); v1[e] = sigmoidf_(v1[e]); } }
                    u32x4 w; w.x = cvt_pk_bf16(v0[0], v0[1]); w.y = cvt_pk_bf16(v0[2], v0[3]); w.z = cvt_pk_bf16(v1[0], v1[1]); w.w = cvt_pk_bf16(v1[2], v1[3]);
                    *(u32x4*)(rowp + bj * HALF) = w; } }
    }
};
struct EpiGateMulF32 {
    static constexpr bool PERM = true, AFTER_DRAIN = false, SELF_SCALE = false;
    bf16_t* MA; int ldc; const bf16_t* G; int ldg; int gcol0;
    __device__ __forceinline__ void operator()(const f32x4 (&acc)[2][2][4][2], const Unit& u, int wr, int wc, int fr, int fq) const {
        const int row0 = u.pm * BM + wr * 64 + fr, col0 = u.pn * BM + wc * 32 + 8 * fq;
#pragma unroll
        for (int ai = 0; ai < 2; ++ai)
#pragma unroll
            for (int m = 0; m < 4; ++m) { const size_t r = (size_t)(row0 + ai * HALF + m * 16); bf16_t* rowp = MA + r * ldc + col0; const bf16_t* gp = G + r * ldg + gcol0 + col0;
#pragma unroll
                for (int bj = 0; bj < 2; ++bj) { const u32x4 g = *(const u32x4*)(gp + bj * HALF); const f32x4 a0 = acc[ai][bj][m][0], a1 = acc[ai][bj][m][1];
                    u32x4 w; w.x = cvt_pk_bf16(a0[0] * bf_lo(g.x), a0[1] * bf_hi(g.x)); w.y = cvt_pk_bf16(a0[2] * bf_lo(g.y), a0[3] * bf_hi(g.y));
                    w.z = cvt_pk_bf16(a1[0] * bf_lo(g.z), a1[1] * bf_hi(g.z)); w.w = cvt_pk_bf16(a1[2] * bf_lo(g.w), a1[3] * bf_hi(g.w));
                    *(u32x4*)(rowp + bj * HALF) = w; } }
    }
};
struct EpiGateMulAddBf16 {
    static constexpr bool PERM = true, AFTER_DRAIN = false, SELF_SCALE = false;
    bf16_t* MB; int ldc; const bf16_t* MA; const bf16_t* G; int ldg; int gcol0;
    __device__ __forceinline__ void operator()(const f32x4 (&acc)[2][2][4][2], const Unit& u, int wr, int wc, int fr, int fq) const {
        const int row0 = u.pm * BM + wr * 64 + fr, col0 = u.pn * BM + wc * 32 + 8 * fq;
#pragma unroll
        for (int ai = 0; ai < 2; ++ai)
#pragma unroll
            for (int m = 0; m < 4; ++m) { const size_t r = (size_t)(row0 + ai * HALF + m * 16); bf16_t* rowp = MB + r * ldc + col0; const bf16_t* mp = MA + r * ldc + col0; const bf16_t* gp = G + r * ldg + gcol0 + col0;
#pragma unroll
                for (int bj = 0; bj < 2; ++bj) { const u32x4 g = *(const u32x4*)(gp + bj * HALF); const u32x4 mm = *(const u32x4*)(mp + bj * HALF);
                    const f32x4 a0 = acc[ai][bj][m][0], a1 = acc[ai][bj][m][1];
                    u32x4 w; w.x = cvt_pk_bf16(bf_lo(mm.x) + a0[0] * bf_lo(g.x), bf_hi(mm.x) + a0[1] * bf_hi(g.x)); w.y = cvt_pk_bf16(bf_lo(mm.y) + a0[2] * bf_lo(g.y), bf_hi(mm.y) + a0[3] * bf_hi(g.y));
                    w.z = cvt_pk_bf16(bf_lo(mm.z) + a1[0] * bf_lo(g.z), bf_hi(mm.z) + a1[1] * bf_hi(g.z)); w.w = cvt_pk_bf16(bf_lo(mm.w) + a1[2] * bf_lo(g.w), bf_hi(mm.w) + a1[3] * bf_hi(g.w));
                    *(u32x4*)(rowp + bj * HALF) = w; } }
    }
};
struct EpiResid {
    static constexpr bool PERM = false, AFTER_DRAIN = false, SELF_SCALE = false;
    const float* smeta; const float* sreal; float* dmeta; float* dreal; int ld; int nmeta; int nrows;
    __device__ __forceinline__ void operator()(const f32x4 (&acc)[2][2][4][2], const Unit& u, int wr, int wc, int fr, int fq) const {
        const int row0 = u.pm * BM + wr * 64 + fr, col0 = u.pn * BM + wc * 32 + 4 * fq;
#pragma unroll
        for (int ai = 0; ai < 2; ++ai)
#pragma unroll
            for (int m = 0; m < 4; ++m) { const int r = row0 + ai * HALF + m * 16;
                if (r < nrows) {
                    const float* sp = (r < nmeta ? smeta + (size_t)r * ld : sreal + (size_t)(r - nmeta) * ld) + col0;
                    float* dp = (r < nmeta ? dmeta + (size_t)r * ld : dreal + (size_t)(r - nmeta) * ld) + col0;
#pragma unroll
                    for (int bj = 0; bj < 2; ++bj)
#pragma unroll
                        for (int n = 0; n < 2; ++n) *(f32x4*)(dp + bj * HALF + n * 16) = *(const f32x4*)(sp + bj * HALF + n * 16) + acc[ai][bj][m][n];
                } }
    }
};

template <int CTRL> __device__ __forceinline__ float dpp_mov(float v) { return __builtin_bit_cast(float, __builtin_amdgcn_update_dpp(0, __builtin_bit_cast(int, v), CTRL, 0xf, 0xf, false)); }
struct EpiConvAct {
    static constexpr bool PERM = true, AFTER_DRAIN = false, SELF_SCALE = true;
    bf16_t* ACT; int ldact; float* HALO; int ldh; const float* cw; const float* cb; int dff; PG8_LAS float* hx; const float* sag; const float* sb;
    __device__ __forceinline__ void operator()(const f32x4 (&acc)[2][2][4][2], const Unit& u, int wr, int wc, int fr, int fq) const {
        const int cl = wc * 32 + 8 * fq;
        const int ch = u.pn * 128 + cl;
        if (fr >= 14) {
#pragma unroll
            for (int ai = 0; ai < 2; ++ai)
#pragma unroll
                for (int bj = 0; bj < 2; ++bj)
#pragma unroll
                    for (int n = 0; n < 2; ++n) *(PG8_LAS f32x4*)(hx + (((ai * 2 + wr) * 2 + (fr - 14)) * 256 + bj * 128 + cl + 4 * n)) = acc[ai][bj][3][n];
        }
        if (wr == 0 && fr < 2) {
            float* hp = HALO + ((size_t)u.pm * 4 + fr) * ldh + u.pn * 256 + cl;
#pragma unroll
            for (int bj = 0; bj < 2; ++bj)
#pragma unroll
                for (int n = 0; n < 2; ++n) *(f32x4*)(hp + bj * 128 + 4 * n) = acc[0][bj][0][n] * (*(const f32x4*)(sb + u.pn * 256 + bj * 128 + cl + 4 * n) * sag[0]);
        }
        if (wr == 1 && fr >= 14) {
            float* hp = HALO + ((size_t)u.pm * 4 + (fr - 12)) * ldh + u.pn * 256 + cl;
#pragma unroll
            for (int bj = 0; bj < 2; ++bj)
#pragma unroll
                for (int n = 0; n < 2; ++n) *(f32x4*)(hp + bj * 128 + 4 * n) = acc[1][bj][3][n] * (*(const f32x4*)(sb + u.pn * 256 + bj * 128 + cl + 4 * n) * sag[0]);
        }
        asm volatile("s_waitcnt lgkmcnt(0)" ::: "memory"); __builtin_amdgcn_s_barrier(); asm volatile("" ::: "memory");
#pragma unroll
        for (int n = 0; n < 2; ++n) {
            f32x4 wt[2][3], bb[2];
#pragma unroll
            for (int bj = 0; bj < 2; ++bj) { bb[bj] = *(const f32x4*)(cb + bj * dff + ch + 4 * n);
#pragma unroll
                for (int i = 0; i < 3; ++i) wt[bj][i] = *(const f32x4*)(cw + (size_t)i * 2 * dff + bj * dff + ch + 4 * n) * (*(const f32x4*)(sb + u.pn * 256 + bj * 128 + cl + 4 * n) * sag[0]); }
#pragma unroll
            for (int ai = 0; ai < 2; ++ai) {
                const bool hasprev = (ai | wr) != 0; const int pb = ai * 2 + wr - 1;
                f32x4 xp[2];
#pragma unroll
                for (int bj = 0; bj < 2; ++bj) { xp[bj] = (f32x4){0.f, 0.f, 0.f, 0.f};
                    if (hasprev && fr >= 14) xp[bj] = *(const PG8_LAS f32x4*)(hx + ((pb * 2 + (fr - 14)) * 256 + bj * 128 + cl + 4 * n)); }
#pragma unroll
                for (int m = 0; m < 4; ++m) {
                    f32x4 z[2];
#pragma unroll
                    for (int bj = 0; bj < 2; ++bj) {
                        const f32x4 x = acc[ai][bj][m][n];
#pragma unroll
                        for (int j = 0; j < 4; ++j) {
                            const float a1 = dpp_mov<0x121>(x[j]), p1 = dpp_mov<0x121>(xp[bj][j]), a2 = dpp_mov<0x122>(x[j]), p2 = dpp_mov<0x122>(xp[bj][j]);
                            const float s1 = fr == 0 ? p1 : a1, s2 = fr < 2 ? p2 : a2;
                            z[bj][j] = bb[bj][j] + wt[bj][2][j] * x[j] + wt[bj][1][j] * s1 + wt[bj][0][j] * s2;
                        }
                        xp[bj] = x;
                    }
                    const int r = u.pm * BM + ai * HALF + wr * 64 + m * 16 + fr;
                    float o[4];
#pragma unroll
                    for (int j = 0; j < 4; ++j) { const float g = z[0][j]; o[j] = g * __builtin_amdgcn_rcpf(1.f + __expf(-g)) * z[1][j]; }
                    u32x2 w; w.x = cvt_pk_bf16(o[0], o[1]); w.y = cvt_pk_bf16(o[2], o[3]);
                    *(u32x2*)(ACT + (size_t)r * ldact + ch + 4 * n) = w;
                }
                asm volatile("" ::: "memory");
            }
        }
    }
};
template <class Epi, class Sched, bool ALIGN_EPI = false, bool SP2 = false, bool I8 = false>
__device__ __forceinline__ void gemm_phase(PG8_LAS unsigned char* lds, const Gemm g, const Sched& S, const Epi& E) {
    const int tid = threadIdx.x, wid = __builtin_amdgcn_readfirstlane(tid >> 6), lane = tid & 63, wr = wid >> 2, wc = wid & 3, fr = lane & 15, fq = lane >> 4;
    const int K = g.K, nt = K / BK;
    unsigned voffA[2], voffB[2];
#pragma unroll
    for (int i = 0; i < 2; ++i) { int R, C; stage_rc(tid * 16 + i * 8192, R, C); const int Rb = Epi::PERM ? ((R & ~31) + perm32(R & 31)) : R;
        voffA[i] = (unsigned)(R * K + C) * 2u; voffB[i] = (unsigned)(Rb * K + C) * 2u; }
    const size_t kstep = (size_t)(BK * 2);
    const size_t hstep = (size_t)HALF * K * 2;
    const size_t tstep = 2 * hstep;
    const unsigned ldsw = (unsigned)wid * 1024u;
    const int aoff = lds_byte(wr * 64 + fr, fq * 8), boff = lds_byte(wc * 32 + fr, fq * 8);
#define PG8_SA(b, h) (((b) * 2 + (h)) * HTB)
#define PG8_SB(b, h) ((4 + (b) * 2 + (h)) * HTB)
#define PG8_STAGE(bufoff, gbase, voff) do { _Pragma("unroll") for (int _i = 0; _i < 2; ++_i) \
        __builtin_amdgcn_global_load_lds((const unsigned*)((const char*)(gbase) + (voff)[_i]), (PG8_LAS unsigned*)(lds + (bufoff) + ldsw + _i * 8192), 16, 0, 0); } while (0)
#define PG8_LDA(dst, b, h) do { _Pragma("unroll") for (int m = 0; m < 4; ++m) _Pragma("unroll") for (int k = 0; k < 2; ++k) dst[m][k] = *(const PG8_LAS bf16x8*)(lds + PG8_SA(b, h) + aoff + m * 2048 + k * 1024); } while (0)
#define PG8_LDB(dst, b, h) do { _Pragma("unroll") for (int n = 0; n < 2; ++n) _Pragma("unroll") for (int k = 0; k < 2; ++k) dst[n][k] = *(const PG8_LAS bf16x8*)(lds + PG8_SB(b, h) + boff + n * 2048 + k * 1024); } while (0)
#define PG8_MMA(ai, bj, At, Bt) do { __builtin_amdgcn_s_setprio(1); _Pragma("unroll") for (int m = 0; m < 4; ++m) _Pragma("unroll") for (int n = 0; n < 2; ++n) _Pragma("unroll") for (int k = 0; k < 2; ++k) { \
        if constexpr (I8) acc[ai][bj][m][n] = __builtin_bit_cast(f32x4, __builtin_amdgcn_mfma_i32_16x16x64_i8(__builtin_bit_cast(i32x4, Bt[n][k]), __builtin_bit_cast(i32x4, At[m][k]), __builtin_bit_cast(i32x4, acc[ai][bj][m][n]), 0, 0, 0)); \
        else acc[ai][bj][m][n] = __builtin_amdgcn_mfma_f32_16x16x32_bf16(Bt[n][k], At[m][k], acc[ai][bj][m][n], 0, 0, 0); } __builtin_amdgcn_s_setprio(0); } while (0)
#define PG8_WAIT_V(n) asm volatile("s_waitcnt vmcnt(" #n ")" ::: "memory")
#define PG8_WAIT_L(n) asm volatile("s_waitcnt lgkmcnt(" #n ")" ::: "memory")
#define PG8_BAR __builtin_amdgcn_s_barrier()
#define PG8_SCHED __builtin_amdgcn_sched_barrier(0)
    Unit cur, nxt; int ui = 0;
    if (!S.next(0, cur)) return;
    f32x4 acc[2][2][4][2];
#pragma unroll
    for (int a = 0; a < 2; ++a)
#pragma unroll
        for (int b = 0; b < 2; ++b)
#pragma unroll
            for (int m = 0; m < 4; ++m)
#pragma unroll
                for (int n = 0; n < 2; ++n) acc[a][b][m][n] = (f32x4){0.f, 0.f, 0.f, 0.f};
    bf16x8 At[4][2], B0[2][2], B1[2][2];
    const char* cA = (const char*)g.A + (size_t)cur.pm * tstep; const char* cB = (const char*)g.Bt + (size_t)cur.pn * tstep;
    S.a_ready(cur);
    if constexpr (SP2) {
        PG8_STAGE(PG8_SB(0, 0), cB, voffB); PG8_STAGE(PG8_SB(0, 1), cB + hstep, voffB); PG8_STAGE(PG8_SA(0, 0), cA, voffA); PG8_STAGE(PG8_SA(0, 1), cA + hstep, voffA);
        if (wr == 1) PG8_BAR;
        PG8_WAIT_V(2); PG8_BAR;
        PG8_STAGE(PG8_SB(1, 0), cB + kstep, voffB); PG8_STAGE(PG8_SA(1, 0), cA + kstep, voffA); PG8_STAGE(PG8_SB(1, 1), cB + hstep + kstep, voffB);
        PG8_WAIT_V(6); PG8_BAR;
    } else {
        PG8_STAGE(PG8_SB(0, 0), cB, voffB); PG8_STAGE(PG8_SA(0, 0), cA, voffA); PG8_STAGE(PG8_SB(0, 1), cB + hstep, voffB); PG8_STAGE(PG8_SA(0, 1), cA + hstep, voffA);
        if (wr == 1) PG8_BAR;
        PG8_WAIT_V(4); PG8_BAR;
        PG8_STAGE(PG8_SB(1, 0), cB + kstep, voffB); PG8_STAGE(PG8_SA(1, 0), cA + kstep, voffA); PG8_STAGE(PG8_SB(1, 1), cB + hstep + kstep, voffB);
        PG8_WAIT_V(6); PG8_BAR;
    }
    for (;;) {
        const bool has_next = S.next(ui + 1, nxt);
        const char* nA = has_next ? (const char*)g.A + (size_t)nxt.pm * tstep : cA; const char* nB = has_next ? (const char*)g.Bt + (size_t)nxt.pn * tstep : cB;
        for (int t = 0; t < nt; t += 2) {
            const bool last = (t == nt - 2);
            const char* a1 = cA + (size_t)(t + 1) * kstep;
            const char* a2 = last ? nA : cA + (size_t)(t + 2) * kstep; const char* b2 = last ? nB : cB + (size_t)(t + 2) * kstep;
            const char* a3 = a2 + kstep; const char* b3 = b2 + kstep;
            if (last && has_next) S.a_ready(nxt);
            if constexpr (SP2) {
            PG8_LDB(B0, 0, 0); PG8_LDB(B1, 0, 1); PG8_SCHED; PG8_LDA(At, 0, 0); PG8_STAGE(PG8_SA(1, 1), a1 + hstep, voffA);
            PG8_WAIT_V(8); PG8_WAIT_L(0); PG8_BAR; PG8_MMA(0, 0, At, B0); PG8_MMA(0, 1, At, B1); PG8_BAR; PG8_SCHED;
            PG8_LDA(At, 0, 1); PG8_STAGE(PG8_SB(0, 0), b2, voffB); PG8_STAGE(PG8_SB(0, 1), b2 + hstep, voffB); PG8_STAGE(PG8_SA(0, 0), a2, voffA);
            PG8_WAIT_V(8); PG8_WAIT_L(0); PG8_BAR; PG8_MMA(1, 0, At, B0); PG8_MMA(1, 1, At, B1); PG8_BAR; PG8_SCHED;
            PG8_LDB(B0, 1, 0); PG8_LDB(B1, 1, 1); PG8_SCHED; PG8_LDA(At, 1, 0); PG8_STAGE(PG8_SA(0, 1), a2 + hstep, voffA);
            PG8_WAIT_V(8); PG8_WAIT_L(0); PG8_BAR; PG8_MMA(0, 0, At, B0); PG8_MMA(0, 1, At, B1); PG8_BAR; PG8_SCHED;
            PG8_LDA(At, 1, 1); PG8_STAGE(PG8_SB(1, 0), b3, voffB); PG8_STAGE(PG8_SB(1, 1), b3 + hstep, voffB); PG8_STAGE(PG8_SA(1, 0), a3, voffA);
            PG8_WAIT_V(8); PG8_WAIT_L(0); PG8_BAR; PG8_MMA(1, 0, At, B0); PG8_MMA(1, 1, At, B1); PG8_BAR; PG8_SCHED;
            } else {
            PG8_LDB(B0, 0, 0); PG8_SCHED; PG8_LDA(At, 0, 0); PG8_STAGE(PG8_SA(1, 1), a1 + hstep, voffA);
            PG8_WAIT_L(8); PG8_BAR; PG8_WAIT_L(0); PG8_MMA(0, 0, At, B0); PG8_BAR; PG8_SCHED;
            PG8_LDB(B1, 0, 1); PG8_STAGE(PG8_SB(0, 0), b2, voffB);
            PG8_BAR; PG8_WAIT_L(0); PG8_MMA(0, 1, At, B1); PG8_BAR;
            PG8_LDA(At, 0, 1); PG8_STAGE(PG8_SA(0, 0), a2, voffA);
            PG8_BAR; PG8_WAIT_L(0); PG8_MMA(1, 0, At, B0); PG8_BAR; PG8_SCHED;
            PG8_STAGE(PG8_SB(0, 1), b2 + hstep, voffB);
            PG8_WAIT_V(6); PG8_BAR; PG8_MMA(1, 1, At, B1); PG8_BAR;
            PG8_LDB(B0, 1, 0); PG8_SCHED; PG8_LDA(At, 1, 0); PG8_STAGE(PG8_SA(0, 1), a2 + hstep, voffA);
            PG8_WAIT_L(8); PG8_BAR; PG8_WAIT_L(0); PG8_MMA(0, 0, At, B0); PG8_BAR; PG8_SCHED;
            PG8_LDB(B1, 1, 1); PG8_STAGE(PG8_SB(1, 0), b3, voffB);
            PG8_BAR; PG8_WAIT_L(0); PG8_MMA(0, 1, At, B1); PG8_BAR;
            PG8_LDA(At, 1, 1); PG8_STAGE(PG8_SA(1, 0), a3, voffA);
            PG8_BAR; PG8_WAIT_L(0); PG8_MMA(1, 0, At, B0); PG8_BAR; PG8_SCHED;
            PG8_STAGE(PG8_SB(1, 1), b3 + hstep, voffB);
            PG8_WAIT_V(6); PG8_BAR; PG8_MMA(1, 1, At, B1); PG8_BAR;
            }
        }
        if constexpr (ALIGN_EPI) { if (wr == 0) PG8_BAR; }
        if constexpr (I8) {
            asm volatile("s_nop 15\n\ts_nop 15" ::: "memory");
#pragma unroll
            for (int ai = 0; ai < 2; ++ai)
#pragma unroll
                for (int bj = 0; bj < 2; ++bj)
#pragma unroll
                    for (int m = 0; m < 4; ++m)
#pragma unroll
                        for (int n = 0; n < 2; ++n)
#pragma unroll
                            for (int j = 0; j < 4; ++j) { float x = acc[ai][bj][m][n][j]; asm volatile("v_cvt_f32_i32 %0, %0" : "+v"(x)); acc[ai][bj][m][n][j] = x; }
            if constexpr (!Epi::SELF_SCALE) {
                const int row0 = cur.pm * BM + wr * 64 + fr, col0 = cur.pn * BM + wc * 32 + (Epi::PERM ? 8 * fq : 4 * fq);
#pragma unroll
                for (int bj = 0; bj < 2; ++bj)
#pragma unroll
                    for (int n = 0; n < 2; ++n) { const f32x4 sc = *(const f32x4*)(g.sb + col0 + bj * HALF + (Epi::PERM ? 4 * n : 16 * n));
#pragma unroll
                        for (int ai = 0; ai < 2; ++ai)
#pragma unroll
                            for (int m = 0; m < 4; ++m) { const float sr = g.sa[row0 + ai * HALF + m * 16]; acc[ai][bj][m][n] = acc[ai][bj][m][n] * (sc * sr); } }
            }
        }
        if constexpr (!Epi::AFTER_DRAIN) { E(acc, cur, wr, wc, fr, fq); S.done(cur); }
        if (!has_next) break;
#pragma unroll
        for (int a = 0; a < 2; ++a)
#pragma unroll
            for (int b = 0; b < 2; ++b)
#pragma unroll
                for (int m = 0; m < 4; ++m)
#pragma unroll
                    for (int n = 0; n < 2; ++n) acc[a][b][m][n] = (f32x4){0.f, 0.f, 0.f, 0.f};
        cur = nxt; cA = nA; cB = nB; ++ui;
        if constexpr (ALIGN_EPI) { if (wr == 1) PG8_BAR; }
    }
    PG8_WAIT_V(0);
    if constexpr (!ALIGN_EPI) { if (wr == 0) PG8_BAR; }
    PG8_BAR;
    if constexpr (Epi::AFTER_DRAIN) { E.fused(acc, cur, wr, wc, fr, fq, lds, wid, lane); S.done(cur); }
#undef PG8_SA
#undef PG8_SB
#undef PG8_STAGE
#undef PG8_LDA
#undef PG8_LDB
#undef PG8_MMA
#undef PG8_WAIT_V
#undef PG8_WAIT_L
#undef PG8_BAR
#undef PG8_SCHED
}
}
#define XB_TMO      128
#define XB_XCNT(j)  (256  + 64 * (j))
#define XB_XSUB(j)  (1280 + 64 * (j))
#define XB_XGEN(j)  (2304 + 64 * (j))
#define XB_TOP      3328
#define XB_TOPGEN   3392
#define XCD_BAR_WORDS 3456
#define XB_SPIN_CAP (1u << 18)
#define LAS __attribute__((address_space(3)))

__device__ __forceinline__ unsigned xb_ld(unsigned* p)              { return __hip_atomic_load(p, __ATOMIC_RELAXED, __HIP_MEMORY_SCOPE_AGENT); }
__device__ __forceinline__ unsigned xb_add(unsigned* p, unsigned v) { return __hip_atomic_fetch_add(p, v, __ATOMIC_RELAXED, __HIP_MEMORY_SCOPE_AGENT); }
__device__ __forceinline__ unsigned xb_xcc_id() { return (unsigned)__builtin_amdgcn_s_getreg((3 << 11) | 20) & 0xFu; }
#define XB_SPIN(cond, bar) do { unsigned _sp = 0; while (cond) { __builtin_amdgcn_s_sleep(1); \
    if ((++_sp & 255u) == 0u) { if (xb_ld(&(bar)[XB_TMO])) break; if (_sp > XB_SPIN_CAP) { atomicAdd(&(bar)[XB_TMO], 1u); break; } } } } while (0)

struct XcdBarrier {
    unsigned* bar; unsigned x;
    volatile LAS unsigned* st;
};

__device__ __forceinline__ XcdBarrier xcd_barrier_post(unsigned* bar, volatile LAS unsigned* st) {
    XcdBarrier b; b.bar = bar; b.x = xb_xcc_id(); b.st = st;
    if (threadIdx.x == 0) (void)xb_add(&bar[XB_XCNT(b.x)], 1u);
    return b;
}
__device__ __forceinline__ void xcd_barrier_complete(unsigned* bar, unsigned x, unsigned& nloc, unsigned& nx) {
    const unsigned G = gridDim.x * gridDim.y * gridDim.z;
    unsigned sum, cnt, mine, sp = 0u;
    for (;;) {
        sum = 0u; cnt = 0u; mine = 0u;
#pragma unroll
        for (unsigned j = 0; j < 16; ++j) { const unsigned c = xb_ld(&bar[XB_XCNT(j)]); sum += c; cnt += (c > 0u) ? 1u : 0u; mine = (j == x) ? c : mine; }
        if (sum == G) break;
        __builtin_amdgcn_s_sleep(1);
        if ((++sp & 255u) == 0u) { if (xb_ld(&bar[XB_TMO])) break; if (sp > XB_SPIN_CAP) { atomicAdd(&bar[XB_TMO], 1u); break; } }
    }
    nloc = mine > 0u ? mine : 1u; nx = cnt > 0u ? cnt : 1u;
}

__device__ __forceinline__ void xcd_barrier(const XcdBarrier& b) {
    asm volatile("s_waitcnt vmcnt(0)" ::: "memory");
    __syncthreads();
    if (threadIdx.x == 0) {
        unsigned* bar = b.bar;
        __builtin_amdgcn_s_waitcnt(0);
        unsigned nloc = b.st[0], nx = b.st[1];
        if (nloc == 0u) { xcd_barrier_complete(bar, b.x, nloc, nx); b.st[0] = nloc; b.st[1] = nx; }
        const unsigned old = xb_add(&bar[XB_XSUB(b.x)], 1u);
        const unsigned gen = old / nloc;
        if (old + 1u == (gen + 1u) * nloc) {
            __builtin_amdgcn_fence(__ATOMIC_RELEASE, "agent");
            asm volatile("s_waitcnt vmcnt(0)" ::: "memory");
            const unsigned og = xb_add(&bar[XB_TOP], 1u);
            const unsigned tg = og / nx;
            if (og + 1u == (tg + 1u) * nx) xb_add(&bar[XB_TOPGEN], 1u);
            else XB_SPIN(xb_ld(&bar[XB_TOPGEN]) == tg, bar);
            __builtin_amdgcn_fence(__ATOMIC_ACQUIRE, "agent");
            xb_add(&bar[XB_XGEN(b.x)], 1u);
            asm volatile("s_waitcnt vmcnt(0)" ::: "memory");
        } else {
            XB_SPIN(xb_ld(&bar[XB_XGEN(b.x)]) == gen, bar);
            __builtin_amdgcn_fence(__ATOMIC_ACQUIRE, "agent");
            asm volatile("s_waitcnt vmcnt(0)" ::: "memory");
        }
    }
    __syncthreads();
}

#define LAS __attribute__((address_space(3)))
typedef unsigned short bf16_t;
typedef float f32x4 __attribute__((ext_vector_type(4)));
typedef unsigned u32x4 __attribute__((ext_vector_type(4)));
typedef unsigned u32x2 __attribute__((ext_vector_type(2)));

#ifndef MK_ONE_LAUNCH
#define MK_ONE_LAUNCH 0
#endif

constexpr int NWAVES = 8, NT = NWAVES * 64;
constexpr int D = 4096, SEQ = 16384, NMETA = 16, L = SEQ + NMETA, MP = 16640;
constexpr int A_W = 2048, A_COLS = 6592, B_COLS = 4704, IN_COLS = A_COLS + B_COLS, NZ = 11520;
constexpr int ZQ = A_COLS, ZCKV = A_COLS + 2048, ZQI = A_COLS + 2560, ZKI = A_COLS + 4608, ZWI = A_COLS + 4672;
constexpr int DFF = 11008, NFI = 2 * DFF;
constexpr int KVR = 512, NH_B = 16, HD_B = 128, IDXH = 32, IDXD = 64, TOPK = 256;
constexpr int LDS_BYTES = 163840, MISC_OFF = 163584;
constexpr int NZ8 = 8960;
constexpr size_t WINT_BF_OFF = (size_t)40 << 20;

constexpr size_t al256(size_t x) { return (x + 255) & ~(size_t)255; }
constexpr size_t WS_CTL = 0, CTL_BYTES = 1u << 20;
constexpr size_t WS_WGT = WS_CTL + CTL_BYTES;
constexpr size_t WS_WPAT = WS_WGT + (size_t)8192 * 4096 * 2;
constexpr size_t WS_WPBT = WS_WPAT + (size_t)4096 * 2048 * 2;
constexpr size_t WS_WOUTT = WS_WPBT + (size_t)4096 * 2048 * 2;
constexpr size_t WS_WFIT = WS_WOUTT + (size_t)4096 * 4096 * 2;
constexpr size_t WS_WFOT = WS_WFIT + (size_t)NFI * 4096 * 2;
constexpr size_t WS_WINT = WS_WFOT + (size_t)4096 * DFF * 2;
constexpr size_t WS_U = WS_WINT + (size_t)NZ * 4096 * 2;
constexpr size_t WS_BIG = WS_U + (size_t)MP * D * 2;
constexpr size_t WS_Z = WS_BIG;
constexpr size_t WS_R1 = WS_Z + (size_t)MP * NZ * 2;
constexpr size_t R1_BYTES = (size_t)MP * D * 4;
constexpr size_t WS_LD = WS_R1;
constexpr size_t WS_AA = WS_LD + (size_t)L * A_W * 4;
constexpr size_t WS_GG = WS_AA + (size_t)L * A_W * 2;
constexpr size_t WS_QLAT = WS_R1;
constexpr size_t WS_MF = WS_R1;
constexpr size_t WS_YA = WS_R1 + R1_BYTES;
constexpr size_t WS_YB = WS_YA + (size_t)MP * A_W * 2;
constexpr size_t WS_END = WS_YB + (size_t)MP * A_W * 2;
constexpr size_t WS_GATES = WS_Z;
constexpr size_t WS_ZF = WS_BIG;
constexpr size_t WS_ACT = WS_BIG + (size_t)MP * DFF * 2;
constexpr size_t WS_CKV = WS_WINT;
constexpr size_t WS_KIDX = WS_CKV + al256((size_t)L * KVR * 2);
constexpr size_t WS_SEL = WS_KIDX + al256((size_t)L * IDXD * 4);
constexpr size_t WS_HMETA = WS_SEL + al256((size_t)L * TOPK * 4);
static_assert(WS_HMETA + (size_t)NMETA * D * 4 <= WS_U, "DSA overlays exceed WINT");
constexpr size_t WS_KIDXB = WS_HMETA + al256((size_t)NMETA * D * 4);
static_assert(WS_KIDXB + (size_t)L * IDXD * 2 <= WS_U, "KIDXB");
constexpr size_t WS_WUKB = WS_END;
constexpr size_t WS_WUVT = WS_WUKB + (size_t)16 * 512 * 128 * 2;
constexpr size_t WS_WLT = WS_WUVT + (size_t)16 * 512 * 128 * 2;
constexpr size_t WS_END2 = WS_WLT + (size_t)2048 * 448 * 2;
static_assert(WS_END2 <= (size_t)4 * 4096 * 22016 * 4, "workspace");
constexpr size_t CT_CMX_IN = 524288, CT_CMX_G = CT_CMX_IN + (size_t)NZ * 4, CT_CMX_F = CT_CMX_G + 8192 * 4, CT_SB_IN = CT_CMX_F + (size_t)NFI * 4, CT_SB_G = CT_SB_IN + (size_t)NZ * 4,
                 CT_SB_F = CT_SB_G + 8192 * 4, CT_SA = CT_SB_F + (size_t)NFI * 4, CT_AMAX = CT_SA + (size_t)MP * 4, CT_SAG = CT_AMAX + 256, CT_END = CT_SAG + 256;
static_assert(CT_END <= CTL_BYTES, "control region");
constexpr size_t WS_ST = WS_WINT;
constexpr size_t WS_BS = WS_ST + al256((size_t)257 * 32 * 4096 * 2);
static_assert(WS_BS + (size_t)L * 32 * 4 <= WS_U, "RWKV overlays exceed WINT");
static_assert((size_t)L * A_W * 4 + 2 * (size_t)L * A_W * 2 <= R1_BYTES && (size_t)L * 8192 * 2 <= R1_BYTES, "R1");
static_assert(WS_ACT + (size_t)MP * DFF * 2 <= WS_END, "ACT");
static_assert((size_t)MP * 8192 * 2 <= (size_t)MP * NZ * 2, "GATES");
static_assert(WS_END <= (size_t)4 * 4096 * 22016 * 4, "workspace");

__device__ __forceinline__ float bf2f(bf16_t b) { return __uint_as_float(((unsigned)b) << 16); }
__device__ __forceinline__ bf16_t f2bf(float f) { unsigned u = __float_as_uint(f); u += 0x7FFFu + ((u >> 16) & 1u); return (bf16_t)(u >> 16); }
__device__ __forceinline__ unsigned pk2(float lo, float hi) { return (unsigned)f2bf(lo) | ((unsigned)f2bf(hi) << 16); }
__device__ __forceinline__ float blo(unsigned w) { return __uint_as_float(w << 16); }
__device__ __forceinline__ float bhi(unsigned w) { return __uint_as_float(w & 0xffff0000u); }
__device__ __forceinline__ float sigm(float x) { return 1.f / (1.f + __expf(-x)); }
template <int CTRL> __device__ __forceinline__ float dpp_f(float v) { return __builtin_bit_cast(float, __builtin_amdgcn_update_dpp(0, __builtin_bit_cast(int, v), CTRL, 0xf, 0xf, false)); }
__device__ __forceinline__ float wave_sum(float v) {
    v += dpp_f<0xB1>(v);
    v += dpp_f<0x4E>(v);
    v += dpp_f<0x141>(v);
    v += dpp_f<0x140>(v);
    const float a = __builtin_bit_cast(float, __builtin_amdgcn_readlane(__builtin_bit_cast(int, v), 0));
    const float b = __builtin_bit_cast(float, __builtin_amdgcn_readlane(__builtin_bit_cast(int, v), 16));
    const float c = __builtin_bit_cast(float, __builtin_amdgcn_readlane(__builtin_bit_cast(int, v), 32));
    const float d = __builtin_bit_cast(float, __builtin_amdgcn_readlane(__builtin_bit_cast(int, v), 48));
    return (a + b) + (c + d);
}
__device__ __forceinline__ float wave_max(float v) {
    v = fmaxf(v, dpp_f<0xB1>(v)); v = fmaxf(v, dpp_f<0x4E>(v)); v = fmaxf(v, dpp_f<0x141>(v)); v = fmaxf(v, dpp_f<0x140>(v));
    const float a = __builtin_bit_cast(float, __builtin_amdgcn_readlane(__builtin_bit_cast(int, v), 0));
    const float b = __builtin_bit_cast(float, __builtin_amdgcn_readlane(__builtin_bit_cast(int, v), 16));
    const float c = __builtin_bit_cast(float, __builtin_amdgcn_readlane(__builtin_bit_cast(int, v), 32));
    const float d = __builtin_bit_cast(float, __builtin_amdgcn_readlane(__builtin_bit_cast(int, v), 48));
    return fmaxf(fmaxf(a, b), fmaxf(c, d));
}
#define LDS_WAIT() asm volatile("s_waitcnt lgkmcnt(0)" ::: "memory")

struct P {
    const float* in[30]; float* out; unsigned char* ws; int ph_lo, ph_hi;
};
enum { I_X = 0, I_META, I_NMW, I_WIN, I_MU, I_W0, I_W2, I_A0, I_A2, I_G2, I_KK, I_KA, I_RK, I_LNW, I_LNB, I_KVNW, I_WUK, I_WUV, I_ILNW, I_ILNB,
       I_WPA, I_WPB, I_WGATE, I_WOUT, I_NFW, I_WFI, I_CW, I_CB, I_WFO, I_NFIN };

template <int MODE>
__device__ __forceinline__ void tr_item(const float* W, int K, int N, int Npad, bf16_t* WT, LAS float* scr, int item, int lane) {
    const int nblk = Npad / 32, kb = item / nblk, nb = item % nblk, k0 = 64 * kb, n0 = 32 * nb;
    int s0 = n0; bool valid = n0 < N;
    if (MODE == 1) { const int T = n0 >> 8, w = n0 & 255; s0 = (w < 128) ? T * 128 + w : DFF + T * 128 + (w - 128); valid = true; }
    if (valid) {
#pragma unroll
        for (int i = 0; i < 8; ++i) { const int kk = 8 * i + (lane >> 3), c4 = 4 * (lane & 7); const f32x4 v_ = *(const f32x4*)(W + (size_t)(k0 + kk) * N + s0 + c4);
            LAS float* d_ = scr + kk * 33 + c4; d_[0] = v_.x; d_[1] = v_.y; d_[2] = v_.z; d_[3] = v_.w; }
    } else {
#pragma unroll 8
        for (int i = 0; i < 32; ++i) { const int kk = 2 * i + (lane >> 5); scr[kk * 33 + (lane & 31)] = 0.f; }
    }
    LDS_WAIT(); __builtin_amdgcn_wave_barrier();
    const int c = lane & 7;
#pragma unroll
    for (int j = 0; j < 4; ++j) { const int n = (lane >> 3) + 8 * j; const LAS float* s = scr + (8 * c) * 33 + n;
        u32x4 o; o.x = pk2(s[0 * 33], s[1 * 33]); o.y = pk2(s[2 * 33], s[3 * 33]); o.z = pk2(s[4 * 33], s[5 * 33]); o.w = pk2(s[6 * 33], s[7 * 33]);
        *(u32x4*)(WT + (size_t)(n0 + n) * K + k0 + 8 * c) = o; }
    LDS_WAIT(); __builtin_amdgcn_wave_barrier();
}
__device__ __forceinline__ void colmax_item(const float* W, int N, unsigned* cmx, int it) {
    const int nb = (N + 2047) / 2048, kc = it / nb, n = (it % nb) * 2048 + threadIdx.x * 4;
    if (n < N) { f32x4 m = {0.f, 0.f, 0.f, 0.f}; const float* wp = W + (size_t)kc * 32 * N + n;
#pragma unroll 8
        for (int k = 0; k < 32; ++k) { const f32x4 v = *(const f32x4*)(wp + (size_t)k * N); m.x = fmaxf(m.x, fabsf(v.x)); m.y = fmaxf(m.y, fabsf(v.y)); m.z = fmaxf(m.z, fabsf(v.z)); m.w = fmaxf(m.w, fabsf(v.w)); }
        atomicMax(cmx + n, __float_as_uint(m.x)); atomicMax(cmx + n + 1, __float_as_uint(m.y)); atomicMax(cmx + n + 2, __float_as_uint(m.z)); atomicMax(cmx + n + 3, __float_as_uint(m.w)); }
}
template <int MODE>
__device__ __forceinline__ void tr_item_i8(const float* W, int K, int N, int Npad, signed char* WT, const unsigned* cmx, float* sbdst, LAS float* scr, int item, int lane) {
    const int nblk = Npad / 32, kb = item / nblk, nb = item % nblk, k0 = 64 * kb, n0 = 32 * nb;
    int s0 = n0; bool valid = n0 < N;
    if (MODE == 1) { const int T = n0 >> 8, w = n0 & 255; s0 = (w < 128) ? T * 128 + w : DFF + T * 128 + (w - 128); valid = true; }
    if (valid) {
#pragma unroll
        for (int i = 0; i < 8; ++i) { const int kk = 8 * i + (lane >> 3), c4 = 4 * (lane & 7); const f32x4 v_ = *(const f32x4*)(W + (size_t)(k0 + kk) * N + s0 + c4);
            LAS float* d_ = scr + kk * 33 + c4; d_[0] = v_.x; d_[1] = v_.y; d_[2] = v_.z; d_[3] = v_.w; }
    } else {
#pragma unroll 8
        for (int i = 0; i < 32; ++i) { const int kk = 2 * i + (lane >> 5); scr[kk * 33 + (lane & 31)] = 0.f; }
    }
    LDS_WAIT(); __builtin_amdgcn_wave_barrier();
    const int n = lane >> 1, half = lane & 1;
    const float mx = valid ? __uint_as_float(cmx[s0 + n]) : 0.f; const float inv = mx > 0.f ? 127.f / mx : 0.f;
    unsigned o[8];
#pragma unroll
    for (int c = 0; c < 8; ++c) { unsigned w = 0u;
#pragma unroll
        for (int e = 0; e < 4; ++e) { const int qv = (int)rintf(scr[(half * 32 + c * 4 + e) * 33 + n] * inv); w |= ((unsigned)qv & 0xffu) << (8 * e); }
        o[c] = w; }
    *(u32x4*)(WT + (size_t)(n0 + n) * K + k0 + half * 32) = (u32x4){o[0], o[1], o[2], o[3]};
    *(u32x4*)(WT + (size_t)(n0 + n) * K + k0 + half * 32 + 16) = (u32x4){o[4], o[5], o[6], o[7]};
    if (kb == 0 && half == 0) sbdst[n0 + n] = mx * (1.f / 127.f);
    LDS_WAIT(); __builtin_amdgcn_wave_barrier();
}
template <bool DUAL = false> __device__ __forceinline__ void rms_row_i8(const float* src, const float* w, signed char* dst, float* sa, int lane, float eps, bf16_t* dstb = nullptr) {
    if (src == nullptr) {
        if (DUAL) {
#pragma unroll
            for (int j = 0; j < 8; ++j) *(u32x4*)(dstb + (j * 64 + lane) * 8) = (u32x4){0u, 0u, 0u, 0u}; }
#pragma unroll
        for (int j = 0; j < 4; ++j) *(u32x4*)(dst + (j * 64 + lane) * 16) = (u32x4){0u, 0u, 0u, 0u};
        if (lane == 0) *sa = 1.f;
        return;
    }
    f32x4 v[16]; float s = 0.f;
#pragma unroll
    for (int j = 0; j < 16; ++j) { v[j] = *(const f32x4*)(src + (j * 64 + lane) * 4); s += (v[j].x * v[j].x + v[j].y * v[j].y) + (v[j].z * v[j].z + v[j].w * v[j].w); }
    const float r = rsqrtf(wave_sum(s) * (1.f / D) + eps);
    float mx = 0.f;
#pragma unroll
    for (int j = 0; j < 16; ++j) { const f32x4 g = *(const f32x4*)(w + (j * 64 + lane) * 4); v[j] = v[j] * r * g; mx = fmaxf(mx, fmaxf(fmaxf(fabsf(v[j].x), fabsf(v[j].y)), fmaxf(fabsf(v[j].z), fabsf(v[j].w))));
        if (DUAL) { u32x2 o; o.x = pk2(v[j].x, v[j].y); o.y = pk2(v[j].z, v[j].w); *(u32x2*)(dstb + (j * 64 + lane) * 4) = o; } }
    mx = wave_max(mx);
    const float inv = mx > 0.f ? 127.f / mx : 0.f;
#pragma unroll
    for (int j = 0; j < 16; ++j) { const unsigned q = ((unsigned)(int)rintf(v[j].x * inv) & 0xffu) | (((unsigned)(int)rintf(v[j].y * inv) & 0xffu) << 8) | (((unsigned)(int)rintf(v[j].z * inv) & 0xffu) << 16) | (((unsigned)(int)rintf(v[j].w * inv) & 0xffu) << 24);
        *(unsigned*)(dst + (j * 64 + lane) * 4) = q; }
    if (lane == 0) *sa = mx > 0.f ? mx * (1.f / 127.f) : 1.f;
}
__device__ __forceinline__ void rms_row_bf16(const float* src, const float* w, bf16_t* dst, int lane, float eps) {
    if (src == nullptr) {
#pragma unroll
        for (int j = 0; j < 8; ++j) *(u32x4*)(dst + (j * 64 + lane) * 8) = (u32x4){0u, 0u, 0u, 0u};
        return;
    }
    f32x4 v[16]; float s = 0.f;
#pragma unroll
    for (int j = 0; j < 16; ++j) { v[j] = *(const f32x4*)(src + (j * 64 + lane) * 4); s += (v[j].x * v[j].x + v[j].y * v[j].y) + (v[j].z * v[j].z + v[j].w * v[j].w); }
    const float r = rsqrtf(wave_sum(s) * (1.f / D) + eps);
#pragma unroll
    for (int j = 0; j < 16; ++j) { const f32x4 g = *(const f32x4*)(w + (j * 64 + lane) * 4);
        u32x2 o; o.x = pk2(v[j].x * r * g.x, v[j].y * r * g.y); o.y = pk2(v[j].z * r * g.z, v[j].w * r * g.w);
        *(u32x2*)(dst + (j * 64 + lane) * 4) = o; }
}
__device__ __forceinline__ void p0_prologue_a(const P& p, LAS unsigned char* lds, int G) {
    const int tid = threadIdx.x, lane = tid & 63, wave = tid >> 6;
    LAS float* scr = (LAS float*)(lds + wave * 16384);
    const int gw = blockIdx.x * NWAVES + wave, NGW = G * NWAVES;
    unsigned char* ws = p.ws;
    {
        constexpr int C0 = 128 * ((IN_COLS + 2047) / 2048), C1 = 128 * (8192 / 2048), C2 = 128 * ((NFI + 2047) / 2048);
        for (int it = blockIdx.x; it < C0 + C1 + C2; it += G) {
            if (it < C0) colmax_item(p.in[I_WIN], IN_COLS, (unsigned*)(ws + WS_CTL + CT_CMX_IN), it);
            else if (it < C0 + C1) colmax_item(p.in[I_WGATE], 8192, (unsigned*)(ws + WS_CTL + CT_CMX_G), it - C0);
            else colmax_item(p.in[I_WFI], NFI, (unsigned*)(ws + WS_CTL + CT_CMX_F), it - C0 - C1);
        } }
    for (int it = gw; it < 16 * 32; it += NGW) { const int hh = it >> 5;
        tr_item<0>(p.in[I_WUV] + (size_t)hh * KVR * HD_B, KVR, HD_B, HD_B, (bf16_t*)(ws + WS_WUVT) + (size_t)hh * HD_B * KVR, scr, it & 31, lane); }
    for (size_t i = (size_t)blockIdx.x * NT + threadIdx.x; i < (size_t)16 * 512 * 128 / 4; i += (size_t)G * NT) {
        const f32x4 v = *(const f32x4*)(p.in[I_WUK] + i * 4); u32x2 o; o.x = pk2(v.x, v.y); o.y = pk2(v.z, v.w); *(u32x2*)((bf16_t*)(ws + WS_WUKB) + i * 4) = o; }
    for (int i = blockIdx.x * NT + threadIdx.x; i < 448 * 2048; i += G * NT) { const int j = i >> 11, c = i & 2047;
        const float v = j < 96 ? p.in[I_W2][(size_t)j * 2048 + c] : (j < 192 ? p.in[I_A2][(size_t)(j - 96) * 2048 + c] : p.in[I_G2][(size_t)(j - 192) * 2048 + c]);
        ((bf16_t*)(ws + WS_WLT))[(size_t)c * 448 + j] = f2bf(v); }
    signed char* U8 = (signed char*)(ws + WS_U); float* SA = (float*)(ws + WS_CTL + CT_SA);
    for (int m = gw; m < MP; m += NGW) {
        const float* src = m < NMETA ? p.in[I_META] + (size_t)m * D : (m < L ? p.in[I_X] + (size_t)(m - NMETA) * D : nullptr);
        rms_row_i8<true>(src, p.in[I_NMW], U8 + (size_t)m * D, SA + m, lane, 1e-6f, (bf16_t*)(ws + WS_R1) + (size_t)m * D);
    }
}
__device__ __forceinline__ void p0_prologue_b(const P& p, LAS unsigned char* lds, int G) {
    const int lane = threadIdx.x & 63, wave = threadIdx.x >> 6;
    LAS float* scr = (LAS float*)(lds + wave * 16384);
    const int gw = blockIdx.x * NWAVES + wave, NGW = G * NWAVES;
    constexpr int I0 = (4096 / 64) * (NZ / 32);
    for (int it = gw; it < I0; it += NGW) {
        const int nb = it % (NZ / 32);
        if (nb * 32 < NZ8) tr_item_i8<0>(p.in[I_WIN], 4096, IN_COLS, NZ, (signed char*)(p.ws + WS_WINT), (const unsigned*)(p.ws + WS_CTL + CT_CMX_IN), (float*)(p.ws + WS_CTL + CT_SB_IN), scr, it, lane);
        else tr_item<0>(p.in[I_WIN], 4096, IN_COLS, NZ, (bf16_t*)(p.ws + WS_WINT + WINT_BF_OFF) - (size_t)NZ8 * 4096, scr, it, lane);
    }
}
__device__ __forceinline__ void p0b_weights(const P& p, LAS unsigned char* lds, int vw, int nvw) {
    const int lane = threadIdx.x & 63, wave = threadIdx.x >> 6;
    LAS float* scr = (LAS float*)(lds + wave * 16384);
    unsigned char* ws = p.ws;
    constexpr int I1 = (4096 / 64) * (8192 / 32), I2 = (2048 / 64) * (4096 / 32), I3 = I2, I4 = (4096 / 64) * (4096 / 32), I5 = (4096 / 64) * (NFI / 32), I6 = (DFF / 64) * (4096 / 32);
    constexpr int NITEMS = I1 + I2 + I3 + I4 + I5 + I6;
    for (int it = vw; it < NITEMS; it += nvw) {
        int r = it;
        if (r < I1) { tr_item_i8<0>(p.in[I_WGATE], 4096, 8192, 8192, (signed char*)(ws + WS_WGT), (const unsigned*)(ws + WS_CTL + CT_CMX_G), (float*)(ws + WS_CTL + CT_SB_G), scr, r, lane); continue; } r -= I1;
        if (r < I2) { tr_item<0>(p.in[I_WPA], 2048, 4096, 4096, (bf16_t*)(ws + WS_WPAT), scr, r, lane); continue; } r -= I2;
        if (r < I3) { tr_item<0>(p.in[I_WPB], 2048, 4096, 4096, (bf16_t*)(ws + WS_WPBT), scr, r, lane); continue; } r -= I3;
        if (r < I4) { tr_item<0>(p.in[I_WOUT], 4096, 4096, 4096, (bf16_t*)(ws + WS_WOUTT), scr, r, lane); continue; } r -= I4;
        if (r < I5) { tr_item_i8<1>(p.in[I_WFI], 4096, NFI, NFI, (signed char*)(ws + WS_WFIT), (const unsigned*)(ws + WS_CTL + CT_CMX_F), (float*)(ws + WS_CTL + CT_SB_F), scr, r, lane); continue; } r -= I5;
        tr_item<0>(p.in[I_WFO], DFF, 4096, 4096, (bf16_t*)(ws + WS_WFOT), scr, r, lane);
    }
}

typedef short bf16x8p_t __attribute__((ext_vector_type(8)));
template <int CTRL> __device__ __forceinline__ float dpp_shr0(float v) { return __builtin_bit_cast(float, __builtin_amdgcn_update_dpp(0, __builtin_bit_cast(int, v), CTRL, 0xf, 0xf, true)); }
__device__ __forceinline__ void p2_rwkv_prep(const P& p, LAS unsigned char* lds, int G) {
    const int tid = threadIdx.x, lane = tid & 63, wave = __builtin_amdgcn_readfirstlane(tid >> 6), r16 = lane & 15, q = lane >> 4;
    const bf16_t* Z = (const bf16_t*)(p.ws + WS_Z); const bf16_t* WLT = (const bf16_t*)(p.ws + WS_WLT);
    float* CSo = (float*)(p.ws + WS_LD); bf16_t* AAo = (bf16_t*)(p.ws + WS_AA); bf16_t* GGo = (bf16_t*)(p.ws + WS_GG);
    constexpr int AST = 456;
    LAS bf16_t* act = (LAS bf16_t*)lds;
    const float* mu = p.in[I_MU] + 6144;
    for (int item = blockIdx.x; item < 256; item += G) {
        const int ct = item & 7, tr = item >> 3;
        bf16x8p_t af[2][14];
#pragma unroll
        for (int mtl = 0; mtl < 2; ++mtl) { const int ch = ct * 256 + wave * 32 + 8 * (r16 >> 2) + 4 * mtl + (r16 & 3);
#pragma unroll
            for (int ks = 0; ks < 14; ++ks) af[mtl][ks] = *(const bf16x8p_t*)(WLT + (size_t)ch * 448 + ks * 32 + q * 8); }
        const int c8 = ct * 256 + wave * 32 + q * 8;
        const f32x4 w0v[2] = {*(const f32x4*)(p.in[I_W0] + c8), *(const f32x4*)(p.in[I_W0] + c8 + 4)}, a0v[2] = {*(const f32x4*)(p.in[I_A0] + c8), *(const f32x4*)(p.in[I_A0] + c8 + 4)};
        const int st0 = tr * 8, st1 = tr == 31 ? 257 : st0 + 8;
        for (int st = st0; st < st1; ++st) {
            const int t0 = st * 64;
            __syncthreads();
#pragma unroll
            for (int kb_ = 0; kb_ < 7; kb_ += 2) {
                u32x4 za[2], zp[2];
#pragma unroll
                for (int k = 0; k < 2; ++k) if (kb_ + k < 7) { const int cidx = tid + (kb_ + k) * NT, t = cidx / 56, j8 = (cidx % 56) * 8; int tg = t0 + t; if (tg > L - 1) tg = L - 1; const int tp = tg > 0 ? tg - 1 : 0;
                    za[k] = *(const u32x4*)(Z + (size_t)tg * NZ + 6144 + j8); zp[k] = *(const u32x4*)(Z + (size_t)tp * NZ + 6144 + j8); }
#pragma unroll
                for (int k = 0; k < 2; ++k) if (kb_ + k < 7) { const int cidx = tid + (kb_ + k) * NT, t = cidx / 56, j8 = (cidx % 56) * 8, tg = t0 + t;
                    u32x4 o = (u32x4){0u, 0u, 0u, 0u};
                    if (tg < L) {
                        const f32x4 m0 = *(const f32x4*)(mu + j8), m1 = *(const f32x4*)(mu + j8 + 4);
                        const float a[8] = {blo(za[k].x), bhi(za[k].x), blo(za[k].y), bhi(za[k].y), blo(za[k].z), bhi(za[k].z), blo(za[k].w), bhi(za[k].w)};
                        float b[8] = {blo(zp[k].x), bhi(zp[k].x), blo(zp[k].y), bhi(zp[k].y), blo(zp[k].z), bhi(zp[k].z), blo(zp[k].w), bhi(zp[k].w)};
                        if (tg == 0) {
#pragma unroll
                            for (int e = 0; e < 8; ++e) b[e] = 0.f; }
                        const float m[8] = {m0.x, m0.y, m0.z, m0.w, m1.x, m1.y, m1.z, m1.w};
                        float v[8];
#pragma unroll
                        for (int e = 0; e < 8; ++e) { const float zs = a[e] + (b[e] - a[e]) * m[e]; const bool ist = j8 < 96, isi = j8 < 192;
                            const float r = __builtin_amdgcn_rcpf(1.f + __expf(ist ? 2.f * zs : -zs)); v[e] = ist ? 1.f - 2.f * r : (isi ? zs : r); }
                        o.x = pk2(v[0], v[1]); o.y = pk2(v[2], v[3]); o.z = pk2(v[4], v[5]); o.w = pk2(v[6], v[7]);
                    }
                    *(LAS u32x4*)(act + t * AST + j8) = o; }
            }
            __syncthreads();
#pragma unroll 1
            for (int nt = 0; nt < 4; ++nt) {
                const LAS bf16_t* ar = act + (nt * 16 + r16) * AST + q * 8;
                f32x4 ldv[2]; u32x2 oa[2], og[2];
#pragma unroll
                for (int mtl = 0; mtl < 2; ++mtl) {
                    f32x4 cw = {0.f, 0.f, 0.f, 0.f}, ca = cw, cg = cw;
#pragma unroll
                    for (int ks = 0; ks < 3; ++ks) cw = __builtin_amdgcn_mfma_f32_16x16x32_bf16(af[mtl][ks], *(const LAS bf16x8p_t*)(ar + ks * 32), cw, 0, 0, 0);
#pragma unroll
                    for (int ks = 3; ks < 6; ++ks) ca = __builtin_amdgcn_mfma_f32_16x16x32_bf16(af[mtl][ks], *(const LAS bf16x8p_t*)(ar + ks * 32), ca, 0, 0, 0);
#pragma unroll
                    for (int ks = 6; ks < 14; ++ks) cg = __builtin_amdgcn_mfma_f32_16x16x32_bf16(af[mtl][ks], *(const LAS bf16x8p_t*)(ar + ks * 32), cg, 0, 0, 0);
                    f32x4 ld;
#pragma unroll
                    for (int e = 0; e < 4; ++e) { const float xx = -(w0v[mtl][e] + cw[e]); const float sp = xx > 20.f ? xx : __logf(1.f + __expf(xx)); ld[e] = -__expf(-sp - 0.5f); }
#pragma unroll
                    for (int e = 0; e < 4; ++e) { float x = ld[e]; x += dpp_shr0<0x111>(x); x += dpp_shr0<0x112>(x); x += dpp_shr0<0x114>(x); x += dpp_shr0<0x118>(x); ld[e] = x; }
                    ldv[mtl] = ld;
                    oa[mtl].x = pk2(sigm(a0v[mtl][0] + ca[0]), sigm(a0v[mtl][1] + ca[1])); oa[mtl].y = pk2(sigm(a0v[mtl][2] + ca[2]), sigm(a0v[mtl][3] + ca[3]));
                    og[mtl].x = pk2(cg[0], cg[1]); og[mtl].y = pk2(cg[2], cg[3]);
                    __builtin_amdgcn_sched_barrier(0);
                }
                const int tg = t0 + nt * 16 + r16;
                if (tg < L) {
                    *(f32x4*)(CSo + (size_t)tg * A_W + c8) = ldv[0]; *(f32x4*)(CSo + (size_t)tg * A_W + c8 + 4) = ldv[1];
                    *(u32x4*)(AAo + (size_t)tg * A_W + c8) = (u32x4){oa[0].x, oa[0].y, oa[1].x, oa[1].y};
                    *(u32x4*)(GGo + (size_t)tg * A_W + c8) = (u32x4){og[0].x, og[0].y, og[1].x, og[1].y};
                }
            }
        }
    }
}


typedef short bf16x8_t __attribute__((ext_vector_type(8)));
constexpr int NCHUNK = 257, NITEM = NCHUNK * 32, RS = 72, SLOT = 64 * RS * 2;
constexpr int GAM_OFF = 15 * SLOT;
constexpr size_t GTP_OFF = 0, HT_OFF = (size_t)8192 * 8192;
typedef __bf16 bf16x2v_t __attribute__((ext_vector_type(2)));
typedef float f32x2v_t __attribute__((ext_vector_type(2)));
__device__ __forceinline__ unsigned cvtpk(float lo, float hi) { const f32x2v_t v = {lo, hi}; const bf16x2v_t b = __builtin_convertvector(v, bf16x2v_t); return __builtin_bit_cast(unsigned, b); }
__device__ __forceinline__ void mm2(const LAS bf16_t* X, const LAS bf16_t* Y, int tm, int tn0, int r, int q, f32x4& c0, f32x4& c1) {
#pragma unroll
    for (int s = 0; s < 2; ++s) {
        const bf16x8_t a = *(const LAS bf16x8_t*)(X + (tm * 16 + r) * RS + s * 32 + q * 8);
        const bf16x8_t b0 = *(const LAS bf16x8_t*)(Y + (tn0 * 16 + r) * RS + s * 32 + q * 8);
        const bf16x8_t b1 = *(const LAS bf16x8_t*)(Y + ((tn0 + 1) * 16 + r) * RS + s * 32 + q * 8);
        c0 = __builtin_amdgcn_mfma_f32_16x16x32_bf16(a, b0, c0, 0, 0, 0);
        c1 = __builtin_amdgcn_mfma_f32_16x16x32_bf16(a, b1, c1, 0, 0, 0);
    }
}
__device__ __forceinline__ void st_cheap(LAS bf16_t* B, int m0, int n, const f32x4& c) {
    u32x2 w; w.x = cvtpk(c[0], c[1]); w.y = cvtpk(c[2], c[3]); *(LAS u32x2*)(B + n * RS + m0) = w;
}
__device__ __forceinline__ void st_scat(LAS bf16_t* B, int m0, int n, const f32x4& c) {
#pragma unroll
    for (int e = 0; e < 4; ++e) B[(m0 + e) * RS + n] = f2bf(c[e]);
}
template <int CTRL> __device__ __forceinline__ float dpp_add(float v) { return v + dpp_f<CTRL>(v); }
__device__ __forceinline__ float sum8(float v) { v = dpp_add<0xB1>(v); v = dpp_add<0x4E>(v); v = dpp_add<0x141>(v); return v; }

struct RaIn { u32x4 r0, k0, v0, r1, k1, v1, a0; f32x4 c0v, c1v, p0, p1, ba[3], bb[3]; };
__device__ __forceinline__ void ra_load(RaIn& I, const bf16_t* Z, const float* CS, const bf16_t* AAi, int ch, int h, int tid) {
    const int t = tid >> 3, k8 = (tid & 7) * 8, c0 = h * 64 + k8; int tg = ch * 64 + t; if (tg > L - 1) tg = L - 1; const int tp = tg > 0 ? tg - 1 : 0;
    const bf16_t* zr = Z + (size_t)tg * NZ + c0; const bf16_t* zp = Z + (size_t)tp * NZ + c0;
    I.r0 = *(const u32x4*)zr; I.k0 = *(const u32x4*)(zr + 2048); I.v0 = *(const u32x4*)(zr + 4096);
    I.r1 = *(const u32x4*)zp; I.k1 = *(const u32x4*)(zp + 2048); I.v1 = *(const u32x4*)(zp + 4096);
    I.a0 = *(const u32x4*)(AAi + (size_t)tg * A_W + c0);
    const float* cs = CS + (size_t)tg * A_W + c0; const float* cp = CS + (size_t)tp * A_W + c0;
    I.c0v = *(const f32x4*)cs; I.c1v = *(const f32x4*)(cs + 4); I.p0 = *(const f32x4*)cp; I.p1 = *(const f32x4*)(cp + 4);
#pragma unroll
    for (int b = 0; b < 3; ++b) { int rb = ch * 64 + b * 16 + 15; if (rb > L - 1) rb = L - 1; const float* ce = CS + (size_t)rb * A_W + c0; I.ba[b] = *(const f32x4*)ce; I.bb[b] = *(const f32x4*)(ce + 4); }
}
#define LDS_BARRIER() do { asm volatile("s_waitcnt lgkmcnt(0)" ::: "memory"); __builtin_amdgcn_s_barrier(); asm volatile("" ::: "memory"); } while (0)
__device__ __forceinline__ void ra_items(const P& p, LAS unsigned char* lds, int G) {
    const int tid = threadIdx.x, lane = tid & 63, wave = __builtin_amdgcn_readfirstlane(tid >> 6), r16 = lane & 15, q = lane >> 4;
    const int tm = wave >> 1, tn0 = (wave & 1) * 2;
    const bf16_t* Z = (const bf16_t*)(p.ws + WS_Z); const float* CS = (const float*)(p.ws + WS_LD); const bf16_t* AAi = (const bf16_t*)(p.ws + WS_AA);
    bf16_t* GTP = (bf16_t*)((unsigned char*)p.out + GTP_OFF); float* HT = (float*)((unsigned char*)p.out + HT_OFF);
    bf16_t* PPo = (bf16_t*)(p.ws + WS_YB); bf16_t* Y0o = (bf16_t*)(p.ws + WS_YA); float* BS = (float*)(p.ws + WS_BS);
    LAS bf16_t* sl[15];
#pragma unroll
    for (int i = 0; i < 15; ++i) sl[i] = (LAS bf16_t*)(lds + i * SLOT);
    LAS float* gam = (LAS float*)(lds + GAM_OFF);
    LAS bf16_t *Al_r = sl[0], *Be_r = sl[1], *Ka_r = sl[2], *Al_t = sl[3], *Be_t = sl[4], *Ka_t = sl[5], *Rh_r = sl[6], *V_t = sl[7];
    LAS bf16_t *N_r = sl[8], *N_t = sl[9], *LAK = sl[10], *MRK = sl[11], *MRB = sl[12], *Q_t = sl[13], *T_a = sl[14], *T_b = sl[0], *Q_r = sl[1];
    LAS bf16_t *W_t = sl[8], *X1_t = sl[9], *U0_t = sl[1];
    const bool fixed_h = (G & 31) == 0;
    const int nit = fixed_h ? (NCHUNK - (int)(blockIdx.x >> 5) + (G >> 5) - 1) / (G >> 5) : (NITEM - (int)blockIdx.x + G - 1) / G;
    auto item_of = [&](int i, int& ch, int& h) { if (fixed_h) { h = blockIdx.x & 31; ch = (int)(blockIdx.x >> 5) + i * (G >> 5); } else { const int it = (int)blockIdx.x + i * G; ch = it >> 5; h = it & 31; } };
    float pmr[8], pmk[8], pmv[8], pkk[8], pka[8], prk[8]; int h_par = -1;
    RaIn I; { int ch0, h0; item_of(0, ch0, h0); if (nit > 0) ra_load(I, Z, CS, AAi, ch0, h0, tid); }
    for (int ii = 0; ii < nit; ++ii) {
        int ch, h; item_of(ii, ch, h); const int item = ch * 32 + h;
        if (h != h_par) { const int c0 = h * 64 + (tid & 7) * 8;
#pragma unroll
            for (int e = 0; e < 8; ++e) { pmr[e] = p.in[I_MU][c0 + e]; pmk[e] = p.in[I_MU][2048 + c0 + e]; pmv[e] = p.in[I_MU][4096 + c0 + e]; pkk[e] = p.in[I_KK][c0 + e]; pka[e] = p.in[I_KA][c0 + e]; prk[e] = p.in[I_RK][c0 + e]; }
            h_par = h; }
        LDS_BARRIER();
        {
            const int t = tid >> 3, k8 = (tid & 7) * 8, tg = ch * 64 + t;
            float Av[8], Bv[8], Kv[8], Rv[8], Vv[8];
            const bool valid = tg < L, hasp = tg > 0;
            {
                float lc[8], lx[8];
                {   float base[8];
#pragma unroll
                    for (int e = 0; e < 8; ++e) base[e] = 0.f;
#pragma unroll
                    for (int b = 0; b < 3; ++b) if (b < (t >> 4)) {
#pragma unroll
                        for (int e = 0; e < 4; ++e) { base[e] += I.ba[b][e]; base[4 + e] += I.bb[b][e]; } }
                    const bool pin = (t & 15) != 0;
#pragma unroll
                    for (int e = 0; e < 4; ++e) { lc[e] = base[e] + I.c0v[e]; lc[4 + e] = base[4 + e] + I.c1v[e]; lx[e] = base[e] + (pin ? I.p0[e] : 0.f); lx[4 + e] = base[4 + e] + (pin ? I.p1[e] : 0.f); }
                }
                const unsigned rw[4] = {I.r0.x, I.r0.y, I.r0.z, I.r0.w}, kw[4] = {I.k0.x, I.k0.y, I.k0.z, I.k0.w}, vw[4] = {I.v0.x, I.v0.y, I.v0.z, I.v0.w};
                const unsigned rp[4] = {I.r1.x, I.r1.y, I.r1.z, I.r1.w}, kq[4] = {I.k1.x, I.k1.y, I.k1.z, I.k1.w}, vq[4] = {I.v1.x, I.v1.y, I.v1.z, I.v1.w}, aw[4] = {I.a0.x, I.a0.y, I.a0.z, I.a0.w};
                float rr[8], kk[8], kp[8], aa[8]; float ss = 0.f, bs = 0.f;
#pragma unroll
                for (int e = 0; e < 8; ++e) {
                    const int wi = e >> 1; const bool hi = e & 1;
                    const float zr_ = hi ? bhi(rw[wi]) : blo(rw[wi]), zk_ = hi ? bhi(kw[wi]) : blo(kw[wi]), zv_ = hi ? bhi(vw[wi]) : blo(vw[wi]);
                    float pr_ = hi ? bhi(rp[wi]) : blo(rp[wi]), pk_ = hi ? bhi(kq[wi]) : blo(kq[wi]), pv_ = hi ? bhi(vq[wi]) : blo(vq[wi]);
                    if (!hasp) { pr_ = 0.f; pk_ = 0.f; pv_ = 0.f; }
                    aa[e] = hi ? bhi(aw[wi]) : blo(aw[wi]);
                    rr[e] = zr_ + (pr_ - zr_) * pmr[e]; const float k_ = zk_ + (pk_ - zk_) * pmk[e]; Vv[e] = zv_ + (pv_ - zv_) * pmv[e];
                    kk[e] = k_ * pkk[e]; ss += kk[e] * kk[e];
                    kp[e] = k_ * (1.f + (aa[e] - 1.f) * pka[e]);
                    bs += rr[e] * kp[e] * prk[e];
                }
                ss = sum8(ss); bs = sum8(bs);
                const float rn = rsqrtf(ss + 1e-12f);
                if (valid && (tid & 7) == 0) BS[(size_t)tg * 32 + h] = bs;
#pragma unroll
                for (int e = 0; e < 8; ++e) {
                    const float kn = kk[e] * rn; const float ex = __expf(lx[e]), em = __expf(-lc[e]), ep = __expf(lc[e]);
                    Av[e] = kn * ex; Bv[e] = kn * aa[e] * em; Kv[e] = kp[e] * em; Rv[e] = rr[e] * ep;
                }
                if (t == 63) {
#pragma unroll
                    for (int e = 0; e < 8; ++e) gam[k8 + e] = __expf(valid ? lc[e] : (e < 4 ? I.c0v[e] : I.c1v[e - 4]));
                }
                if (!valid) {
#pragma unroll
                    for (int e = 0; e < 8; ++e) { Av[e] = 0.f; Bv[e] = 0.f; Kv[e] = 0.f; Rv[e] = 0.f; Vv[e] = 0.f; }
                }
            }
            u32x4 w;
            w.x = cvtpk(Av[0], Av[1]); w.y = cvtpk(Av[2], Av[3]); w.z = cvtpk(Av[4], Av[5]); w.w = cvtpk(Av[6], Av[7]); *(LAS u32x4*)(Al_r + t * RS + k8) = w;
            w.x = cvtpk(Bv[0], Bv[1]); w.y = cvtpk(Bv[2], Bv[3]); w.z = cvtpk(Bv[4], Bv[5]); w.w = cvtpk(Bv[6], Bv[7]); *(LAS u32x4*)(Be_r + t * RS + k8) = w;
            w.x = cvtpk(Kv[0], Kv[1]); w.y = cvtpk(Kv[2], Kv[3]); w.z = cvtpk(Kv[4], Kv[5]); w.w = cvtpk(Kv[6], Kv[7]); *(LAS u32x4*)(Ka_r + t * RS + k8) = w;
            w.x = cvtpk(Rv[0], Rv[1]); w.y = cvtpk(Rv[2], Rv[3]); w.z = cvtpk(Rv[4], Rv[5]); w.w = cvtpk(Rv[6], Rv[7]); *(LAS u32x4*)(Rh_r + t * RS + k8) = w;
#pragma unroll
            for (int e = 0; e < 8; ++e) { Al_t[(k8 + e) * RS + t] = f2bf(Av[e]); Be_t[(k8 + e) * RS + t] = f2bf(Bv[e]); Ka_t[(k8 + e) * RS + t] = f2bf(Kv[e]); V_t[(k8 + e) * RS + t] = f2bf(Vv[e]); }
        }
        if (ii + 1 < nit) { int ch1, h1; item_of(ii + 1, ch1, h1); ra_load(I, Z, CS, AAi, ch1, h1, tid); }
        LDS_BARRIER();
        {
            f32x4 cab0 = {0.f, 0.f, 0.f, 0.f}, cab1 = cab0, cak0 = cab0, cak1 = cab0, crk0 = cab0, crk1 = cab0, crb0 = cab0, crb1 = cab0;
            mm2(Be_r, Al_r, tm, tn0, r16, q, cab0, cab1); mm2(Ka_r, Al_r, tm, tn0, r16, q, cak0, cak1);
            mm2(Ka_r, Rh_r, tm, tn0, r16, q, crk0, crk1); mm2(Be_r, Rh_r, tm, tn0, r16, q, crb0, crb1);
            const int s0 = tm * 16 + q * 4;
#pragma unroll
            for (int j = 0; j < 2; ++j) {
                const int t = (tn0 + j) * 16 + r16;
                f32x4 ab = j ? cab1 : cab0, ak = j ? cak1 : cak0, rk = j ? crk1 : crk0, rb = j ? crb1 : crb0, nn, t0;
#pragma unroll
                for (int e = 0; e < 4; ++e) { const int s = s0 + e; nn[e] = s < t ? -ab[e] : 0.f; t0[e] = nn[e] + (s == t ? 1.f : 0.f); ak[e] = s < t ? ak[e] : 0.f; rk[e] = s <= t ? rk[e] : 0.f; rb[e] = s <= t ? rb[e] : 0.f; }
                st_cheap(N_r, s0, t, nn); st_scat(N_t, s0, t, nn); st_cheap(T_a, s0, t, t0); st_cheap(LAK, s0, t, ak); st_cheap(MRK, s0, t, rk); st_cheap(MRB, s0, t, rb);
            }
        }
        LDS_BARRIER();
        {
            LAS bf16_t* Pr = N_r; LAS bf16_t* Pt = N_t; LAS bf16_t* Qr = Q_r; LAS bf16_t* Qt = Q_t; LAS bf16_t* Tc = T_a; LAS bf16_t* Tn = T_b;
#pragma unroll 1
            for (int it = 0; it < 5; ++it) {
                {   f32x4 c0 = {0.f, 0.f, 0.f, 0.f}, c1 = c0;
                    mm2(Pr, Pt, tm, tn0, r16, q, c0, c1);
                    const int m0 = tm * 16 + q * 4;
                    st_cheap(Qt, m0, tn0 * 16 + r16, c0); st_cheap(Qt, m0, (tn0 + 1) * 16 + r16, c1);
                    st_scat(Qr, m0, tn0 * 16 + r16, c0); st_scat(Qr, m0, (tn0 + 1) * 16 + r16, c1); }
                LDS_BARRIER();
                {   f32x4 c0 = {0.f, 0.f, 0.f, 0.f}, c1 = c0;
                    mm2(Qt, Tc, tm, tn0, r16, q, c0, c1);
                    const int b0 = tm * 16 + q * 4;
#pragma unroll
                    for (int j = 0; j < 2; ++j) { const int a = (tn0 + j) * 16 + r16; const u32x2 o = *(const LAS u32x2*)(Tc + a * RS + b0); f32x4 c = j ? c1 : c0;
                        c[0] += blo(o.x); c[1] += bhi(o.x); c[2] += blo(o.y); c[3] += bhi(o.y); st_cheap(Tn, b0, a, c); } }
                LDS_BARRIER();
                LAS bf16_t* x = Pr; Pr = Qr; Qr = x; x = Pt; Pt = Qt; Qt = x; x = Tc; Tc = Tn; Tn = x;
            }
        }
        {
            f32x4 c0 = {0.f, 0.f, 0.f, 0.f}, c1 = c0, d0 = c0, d1 = c0;
            mm2(T_b, Al_t, tm, tn0, r16, q, c0, c1);
            mm2(LAK, V_t, tm, tn0, r16, q, d0, d1);
            const int t0 = tm * 16 + q * 4;
            st_cheap(W_t, t0, tn0 * 16 + r16, c0); st_cheap(W_t, t0, (tn0 + 1) * 16 + r16, c1);
            st_cheap(X1_t, t0, tn0 * 16 + r16, d0); st_cheap(X1_t, t0, (tn0 + 1) * 16 + r16, d1);
        }
        LDS_BARRIER();
        {
            f32x4 c0 = {0.f, 0.f, 0.f, 0.f}, c1 = c0;
            mm2(T_b, X1_t, tm, tn0, r16, q, c0, c1);
            const int t0 = tm * 16 + q * 4;
            st_cheap(U0_t, t0, tn0 * 16 + r16, c0); st_cheap(U0_t, t0, (tn0 + 1) * 16 + r16, c1);
        }
        LDS_BARRIER();
        {
            const int m0 = tm * 16 + q * 4;
            if (ch < 256) {
                f32x4 g0 = {0.f, 0.f, 0.f, 0.f}, g1 = g0, h0 = g0, h1 = g0, u0 = g0, u1 = g0;
                mm2(W_t, Be_t, tm, tn0, r16, q, g0, g1);
                mm2(Ka_t, V_t, tm, tn0, r16, q, h0, h1);
                mm2(Be_t, U0_t, tm, tn0, r16, q, u0, u1);
                const size_t it8 = (size_t)item;
#pragma unroll
                for (int j = 0; j < 2; ++j) {
                    const int n = (tn0 + j) * 16 + r16; const f32x4 g = j ? g1 : g0; const float gc = gam[n];
                    f32x4 o;
#pragma unroll
                    for (int e = 0; e < 4; ++e) o[e] = ((m0 + e == n ? 1.f : 0.f) - g[e]) * gc;
                    u32x2 w; w.x = cvtpk(o[0], o[1]); w.y = cvtpk(o[2], o[3]);
                    *(u32x2*)(GTP + it8 * 4096 + (size_t)n * 64 + 32 * (tm >> 1) + 8 * q + 4 * (tm & 1)) = w;
                    const f32x4 hh = (j ? h1 : h0) - (j ? u1 : u0);
                    const f32x4 gk = *(const LAS f32x4*)(gam + m0);
                    *(f32x4*)(HT + (it8 * 16 + tm * 4 + (tn0 + j)) * 256 + lane * 4) = hh * gk;
                }
            }
            f32x4 p0 = {0.f, 0.f, 0.f, 0.f}, p1 = p0, y0 = p0, y1 = p0, z0 = p0, z1 = p0;
            mm2(W_t, MRB, tm, tn0, r16, q, p0, p1);
            mm2(V_t, MRK, tm, tn0, r16, q, y0, y1);
            mm2(U0_t, MRB, tm, tn0, r16, q, z0, z1);
#pragma unroll
            for (int j = 0; j < 2; ++j) {
                const int t = (tn0 + j) * 16 + r16, tg = ch * 64 + t;
                const u32x2 o = *(const LAS u32x2*)(Rh_r + t * RS + m0); const f32x4 pm = j ? p1 : p0;
                u32x2 w; w.x = cvtpk(blo(o.x) - pm[0], bhi(o.x) - pm[1]); w.y = cvtpk(blo(o.y) - pm[2], bhi(o.y) - pm[3]);
                *(u32x2*)(PPo + (size_t)item * 4096 + t * 64 + m0) = w;
                if (tg < L) { const f32x4 yy = (j ? y1 : y0) - (j ? z1 : z0); u32x2 wy; wy.x = cvtpk(yy[0], yy[1]); wy.y = cvtpk(yy[2], yy[3]);
                    *(u32x2*)(Y0o + (size_t)tg * A_W + h * 64 + m0) = wy; }
            }
        }
    }
}

struct RbSet { bf16x8_t ga[4][2]; f32x4 hv[4]; };
__device__ __forceinline__ void rb_load(RbSet& S, const bf16_t* GTP, const float* HT, int c, int h, int vg, int lane, int r16, int q) {
    const size_t it8 = (size_t)(c < 256 ? c : 255) * 32 + h;
#pragma unroll
    for (int i = 0; i < 4; ++i) { S.hv[i] = *(const f32x4*)(HT + (it8 * 16 + i * 4 + vg) * 256 + lane * 4);
#pragma unroll
        for (int s = 0; s < 2; ++s) S.ga[i][s] = *(const bf16x8_t*)(GTP + it8 * 4096 + (size_t)(i * 16 + r16) * 64 + s * 32 + q * 8); }
}
__device__ __forceinline__ void rb_step(f32x4 (&acc)[4], const RbSet& S, bf16_t* ST, int c, int h, int vg, int r16, int q) {
    const size_t item = (size_t)c * 32 + h;
    unsigned w[8];
#pragma unroll
    for (int i = 0; i < 4; ++i) { w[2 * i] = cvtpk(acc[i][0], acc[i][1]); w[2 * i + 1] = cvtpk(acc[i][2], acc[i][3]);
        u32x2 o; o.x = w[2 * i]; o.y = w[2 * i + 1]; *(u32x2*)(ST + item * 4096 + (size_t)(vg * 16 + r16) * 64 + i * 16 + q * 4) = o; }
    const u32x4 b0 = (u32x4){w[0], w[1], w[2], w[3]}, b1 = (u32x4){w[4], w[5], w[6], w[7]};
    const bf16x8_t f0 = __builtin_bit_cast(bf16x8_t, b0), f1 = __builtin_bit_cast(bf16x8_t, b1);
#pragma unroll
    for (int i = 0; i < 4; ++i) { f32x4 a = S.hv[i];
        a = __builtin_amdgcn_mfma_f32_16x16x32_bf16(S.ga[i][0], f0, a, 0, 0, 0);
        a = __builtin_amdgcn_mfma_f32_16x16x32_bf16(S.ga[i][1], f1, a, 0, 0, 0);
        acc[i] = a; }
}
__device__ __forceinline__ void rb_chain(const P& p, int G) {
    const int tid = threadIdx.x, lane = tid & 63, wave = __builtin_amdgcn_readfirstlane(tid >> 6), r16 = lane & 15, q = lane >> 4;
    if (wave == 0) for (int cw = blockIdx.x; cw < 128; cw += G) {
        const int h = cw >> 2, vg = cw & 3;
        const bf16_t* GTP = (const bf16_t*)((const unsigned char*)p.out + GTP_OFF); const float* HT = (const float*)((const unsigned char*)p.out + HT_OFF);
        bf16_t* ST = (bf16_t*)(p.ws + WS_ST);
        f32x4 acc[4];
#pragma unroll
        for (int i = 0; i < 4; ++i) acc[i] = (f32x4){0.f, 0.f, 0.f, 0.f};
        RbSet S0, S1, S2, S3;
        rb_load(S0, GTP, HT, 0, h, vg, lane, r16, q); rb_load(S1, GTP, HT, 1, h, vg, lane, r16, q); rb_load(S2, GTP, HT, 2, h, vg, lane, r16, q); rb_load(S3, GTP, HT, 3, h, vg, lane, r16, q);
#pragma unroll 1
        for (int c = 0; c < 256; c += 4) {
            rb_step(acc, S0, ST, c, h, vg, r16, q);     rb_load(S0, GTP, HT, c + 4, h, vg, lane, r16, q);
            rb_step(acc, S1, ST, c + 1, h, vg, r16, q); rb_load(S1, GTP, HT, c + 5, h, vg, lane, r16, q);
            rb_step(acc, S2, ST, c + 2, h, vg, r16, q); rb_load(S2, GTP, HT, c + 6, h, vg, lane, r16, q);
            rb_step(acc, S3, ST, c + 3, h, vg, r16, q); rb_load(S3, GTP, HT, c + 7, h, vg, lane, r16, q);
        }
        {
            const size_t item = (size_t)256 * 32 + h;
#pragma unroll
            for (int i = 0; i < 4; ++i) { u32x2 o; o.x = cvtpk(acc[i][0], acc[i][1]); o.y = cvtpk(acc[i][2], acc[i][3]); *(u32x2*)(ST + item * 4096 + (size_t)(vg * 16 + r16) * 64 + i * 16 + q * 4) = o; }
        }
    }
}

__device__ __forceinline__ void rc_out(const P& p, int G) {
    const int tid = threadIdx.x, lane = tid & 63, wave = __builtin_amdgcn_readfirstlane(tid >> 6), r16 = lane & 15, q = lane >> 4;
    const bf16_t* Z = (const bf16_t*)(p.ws + WS_Z); const bf16_t* GGi = (const bf16_t*)(p.ws + WS_GG); const float* BS = (const float*)(p.ws + WS_BS);
    const bf16_t* ST = (const bf16_t*)(p.ws + WS_ST); const bf16_t* PPi = (const bf16_t*)(p.ws + WS_YB); bf16_t* YA = (bf16_t*)(p.ws + WS_YA);
    for (size_t i = (size_t)blockIdx.x * NT + tid; i < (size_t)(MP - L) * A_W / 8; i += (size_t)G * NT) *(u32x4*)(YA + (size_t)L * A_W + i * 8) = (u32x4){0u, 0u, 0u, 0u};
    const int tt = wave & 3;
    for (int item = blockIdx.x * 2 + (wave >> 2); item < NITEM; item += 2 * G) {
        const int ch = item >> 5, h = item & 31;
        const int t = tt * 16 + r16, tg = ch * 64 + t;
        f32x4 acc[4];
#pragma unroll
        for (int i = 0; i < 4; ++i) acc[i] = (f32x4){0.f, 0.f, 0.f, 0.f};
        const bf16_t* sp = ST + (size_t)item * 4096; const bf16_t* pp = PPi + (size_t)item * 4096 + (size_t)t * 64;
#pragma unroll
        for (int s = 0; s < 2; ++s) {
            const bf16x8_t b = *(const bf16x8_t*)(pp + s * 32 + q * 8);
#pragma unroll
            for (int i = 0; i < 4; ++i) { const bf16x8_t a = *(const bf16x8_t*)(sp + (size_t)(i * 16 + r16) * 64 + s * 32 + q * 8);
                acc[i] = __builtin_amdgcn_mfma_f32_16x16x32_bf16(a, b, acc[i], 0, 0, 0); }
        }
        if (tg < L) {
            float s1 = 0.f;
#pragma unroll
            for (int i = 0; i < 4; ++i) { const u32x2 y0 = *(const u32x2*)(YA + (size_t)tg * A_W + h * 64 + i * 16 + q * 4);
                acc[i][0] += blo(y0.x); acc[i][1] += bhi(y0.x); acc[i][2] += blo(y0.y); acc[i][3] += bhi(y0.y);
                s1 += (acc[i][0] + acc[i][1]) + (acc[i][2] + acc[i][3]); }
            s1 += __shfl_xor(s1, 16); s1 += __shfl_xor(s1, 32);
            const float mean = s1 * (1.f / 64.f);
            float s2 = 0.f;
#pragma unroll
            for (int i = 0; i < 4; ++i)
#pragma unroll
                for (int e = 0; e < 4; ++e) { const float d = acc[i][e] - mean; s2 += d * d; }
            s2 += __shfl_xor(s2, 16); s2 += __shfl_xor(s2, 32);
            const float rstd = rsqrtf(s2 * (1.f / 64.f) + 64e-5f);
            const float bs = BS[(size_t)tg * 32 + h];
#pragma unroll
            for (int i = 0; i < 4; ++i) {
                const int c = h * 64 + i * 16 + q * 4;
                const u32x2 zv = *(const u32x2*)(Z + (size_t)tg * NZ + 4096 + c);
                u32x2 pv = (u32x2){0u, 0u}; if (tg > 0) pv = *(const u32x2*)(Z + (size_t)(tg - 1) * NZ + 4096 + c);
                const u32x2 gg = *(const u32x2*)(GGi + (size_t)tg * A_W + c);
                const f32x4 lw = *(const f32x4*)(p.in[I_LNW] + c), lb = *(const f32x4*)(p.in[I_LNB] + c), mv = *(const f32x4*)(p.in[I_MU] + 4096 + c);
                const float zz[4] = {blo(zv.x), bhi(zv.x), blo(zv.y), bhi(zv.y)}, pz[4] = {blo(pv.x), bhi(pv.x), blo(pv.y), bhi(pv.y)}, gv[4] = {blo(gg.x), bhi(gg.x), blo(gg.y), bhi(gg.y)};
                float o[4];
#pragma unroll
                for (int e = 0; e < 4; ++e) { const float vv = zz[e] + (pz[e] - zz[e]) * mv[e]; const float yn = (acc[i][e] - mean) * rstd * lw[e] + lb[e]; o[e] = (yn + bs * vv) * gv[e]; }
                u32x2 w; w.x = cvtpk(o[0], o[1]); w.y = cvtpk(o[2], o[3]);
                *(u32x2*)(YA + (size_t)tg * A_W + c) = w;
            }
        }
    }
}


__device__ __forceinline__ void p4_dsa_prep(const P& p, int G) {
    const int tid = threadIdx.x, lane = tid & 63, wave = tid >> 6;
    const bf16_t* Z = (const bf16_t*)(p.ws + WS_Z);
    bf16_t* CKV = (bf16_t*)(p.ws + WS_CKV); float* KIDX = (float*)(p.ws + WS_KIDX);
    for (int t = blockIdx.x * NWAVES + wave; t < L; t += G * NWAVES) {
        const u32x4 raw = *(const u32x4*)(Z + (size_t)t * NZ + ZCKV + lane * 8);
        float x[8] = {blo(raw.x), bhi(raw.x), blo(raw.y), bhi(raw.y), blo(raw.z), bhi(raw.z), blo(raw.w), bhi(raw.w)};
        float s = 0.f;
#pragma unroll
        for (int e = 0; e < 8; ++e) s += x[e] * x[e];
        const float r = rsqrtf(wave_sum(s) * (1.f / KVR) + 1e-6f);
        const f32x4 w0 = *(const f32x4*)(p.in[I_KVNW] + lane * 8), w1 = *(const f32x4*)(p.in[I_KVNW] + lane * 8 + 4);
        u32x4 o; o.x = pk2(x[0] * r * w0.x, x[1] * r * w0.y); o.y = pk2(x[2] * r * w0.z, x[3] * r * w0.w); o.z = pk2(x[4] * r * w1.x, x[5] * r * w1.y); o.w = pk2(x[6] * r * w1.z, x[7] * r * w1.w);
        *(u32x4*)(CKV + (size_t)t * KVR + lane * 8) = o;
        const float ki = bf2f(Z[(size_t)t * NZ + ZKI + lane]);
        const float mean = wave_sum(ki) * (1.f / 64.f), dk = ki - mean, var = wave_sum(dk * dk) * (1.f / 64.f);
        const float kn_ = dk * rsqrtf(var + 1e-6f) * p.in[I_ILNW][lane] + p.in[I_ILNB][lane];
        KIDX[(size_t)t * IDXD + lane] = kn_;
        ((bf16_t*)(p.ws + WS_KIDXB))[(size_t)t * IDXD + lane] = f2bf(kn_);
    }
}

__device__ __forceinline__ unsigned fkey(float f) { const unsigned u = __float_as_uint(f); return (u & 0x80000000u) ? ~u : (u | 0x80000000u); }


typedef float f32x16 __attribute__((ext_vector_type(16)));
constexpr int SCR_N = 16416;
__device__ __forceinline__ unsigned lds_add(LAS unsigned* p, unsigned v) { return __hip_atomic_fetch_add(p, v, __ATOMIC_RELAXED, __HIP_MEMORY_SCOPE_WORKGROUP); }
constexpr int KST = 72, SELB = 8;
template <int NBL> __device__ __forceinline__ void wfind(const LAS unsigned* hist, unsigned target, int lane, unsigned& b, unsigned& ab) {
    unsigned loc[NBL]; unsigned s = 0;
#pragma unroll
    for (int j = 0; j < NBL; j += 4) { const u32x4 v4 = *(const LAS u32x4*)(hist + lane * NBL + j); loc[j] = v4.x; loc[j + 1] = v4.y; loc[j + 2] = v4.z; loc[j + 3] = v4.w; s += (v4.x + v4.y) + (v4.z + v4.w); }
    unsigned v = s;
#pragma unroll
    for (int d = 1; d < 64; d <<= 1) { const unsigned o = (unsigned)__shfl_down((int)v, d); if (lane + d < 64) v += o; }
    const unsigned above = v - s;
    const bool found = above < target && above + s >= target;
    unsigned bb = 0u, aa = 0u;
    if (found) { unsigned a = above;
#pragma unroll
        for (int j = NBL - 1; j >= 0; --j) { if (a < target && a + loc[j] >= target) { bb = (unsigned)(lane * NBL + j); aa = a; } a += loc[j]; } }
    const unsigned long long m = __ballot(found);
    const int src = m ? (int)__builtin_ctzll(m) : 0;
    b = (unsigned)__shfl((int)bb, src); ab = (unsigned)__shfl((int)aa, src);
}
__device__ __forceinline__ void d2_topk(const P& p, LAS unsigned char* lds, int G) {
    const int tid = threadIdx.x, lane = tid & 63, wave = __builtin_amdgcn_readfirstlane(tid >> 6);
    const bf16_t* Z = (const bf16_t*)(p.ws + WS_Z); const bf16_t* KB = (const bf16_t*)(p.ws + WS_KIDXB); int* SEL = (int*)(p.ws + WS_SEL);
    float* scr = (float*)(p.ws + WS_R1) + ((size_t)blockIdx.x * NWAVES + wave) * 2 * SCR_N;
    LAS bf16_t* ksb = (LAS bf16_t*)lds;
    LAS unsigned* hw = (LAS unsigned*)(lds + 73728) + wave * 2048;
    const int key_l = lane & 31, hh = lane >> 5;
    for (int t = blockIdx.x; t < NMETA + 192; t += G) { const int n = t < NMETA ? NMETA : NMETA + 64 * (1 + (t - NMETA) / 64);
        if (tid < TOPK) SEL[(size_t)t * TOPK + tid] = tid < n ? tid : -1; }
    const int nui = (G == 256) ? 4 : (1012 + G - 1) / G;
    for (int ui = 0; ui < nui; ++ui) {
        int i = (int)blockIdx.x + ui * G;
        if (G == 256) i = ui == 0 ? (int)blockIdx.x : (ui == 1 ? 511 - (int)blockIdx.x : (ui == 2 ? 512 + (int)blockIdx.x : 1023 - (int)blockIdx.x));
        if (i >= 1012) continue;
        const int c = 256 - (i >> 2), r = i & 3, n = NMETA + 64 * c;
        const int tA = NMETA + 64 * (c - 1) + 16 * r + 2 * wave;
        bf16x8_t af[2][4]; float wv[2][16];
#pragma unroll
        for (int qq = 0; qq < 2; ++qq) {
            const bf16_t* zr = Z + (size_t)(tA + qq) * NZ;
#pragma unroll
            for (int ks = 0; ks < 4; ++ks) af[qq][ks] = *(const bf16x8_t*)(zr + ZQI + key_l * 64 + ks * 16 + hh * 8);
#pragma unroll
            for (int g = 0; g < 4; ++g) { const u32x2 w2 = *(const u32x2*)(zr + ZWI + 8 * g + 4 * hh);
                wv[qq][g * 4 + 0] = blo(w2.x) * 0.02209708691207961f; wv[qq][g * 4 + 1] = bhi(w2.x) * 0.02209708691207961f;
                wv[qq][g * 4 + 2] = blo(w2.y) * 0.02209708691207961f; wv[qq][g * 4 + 3] = bhi(w2.y) * 0.02209708691207961f; }
        }
#pragma unroll
        for (int j = 0; j < 8; ++j) *(LAS u32x4*)(hw + (j * 64 + lane) * 4) = (u32x4){0u, 0u, 0u, 0u};
        const int nblk = (n + 255) >> 8;
        __syncthreads();
        {
            const int kk = tid >> 1, hf = tid & 1; const int src = kk < n ? kk : n - 1;
            const u32x4* gp = (const u32x4*)(KB + (size_t)src * IDXD + hf * 32);
#pragma unroll
            for (int j = 0; j < 4; ++j) *(LAS u32x4*)(ksb + kk * KST + hf * 32 + j * 8) = gp[j];
        }
        __syncthreads();
        for (int b = 0; b < nblk; ++b) {
            u32x4 pre[4];
            const bool more = b + 1 < nblk;
            if (more) { const int kk = (b + 1) * 256 + (tid >> 1); const int src = kk < n ? kk : n - 1; const u32x4* gp = (const u32x4*)(KB + (size_t)src * IDXD + (tid & 1) * 32);
#pragma unroll
                for (int j = 0; j < 4; ++j) pre[j] = gp[j]; }
            const LAS bf16_t* kb = ksb + (b & 1) * 256 * KST;
#pragma unroll 2
            for (int tt = 0; tt < 8; ++tt) {
                const int s0 = b * 256 + tt * 32;
                if (s0 < n) {
                    bf16x8_t bfr[4];
#pragma unroll
                    for (int ks = 0; ks < 4; ++ks) bfr[ks] = *(const LAS bf16x8_t*)(kb + (tt * 32 + key_l) * KST + ks * 16 + hh * 8);
                    float part[2];
#pragma unroll
                    for (int qq = 0; qq < 2; ++qq) {
                        f32x16 acc;
#pragma unroll
                        for (int e = 0; e < 16; ++e) acc[e] = 0.f;
#pragma unroll
                        for (int ks = 0; ks < 4; ++ks) acc = __builtin_amdgcn_mfma_f32_32x32x16_bf16(af[qq][ks], bfr[ks], acc, 0, 0, 0);
                        float s = 0.f;
                        float s0_ = 0.f, s1_ = 0.f;
#pragma unroll
                        for (int e = 0; e < 16; e += 2) { s0_ += wv[qq][e] * __builtin_amdgcn_fmed3f(acc[e], 0.f, 3.0e38f); s1_ += wv[qq][e + 1] * __builtin_amdgcn_fmed3f(acc[e + 1], 0.f, 3.0e38f); }
                        part[qq] = s0_ + s1_; (void)s;
                    }
                    const float mine = hh ? part[1] : part[0], give = hh ? part[0] : part[1];
                    const float score = mine + __shfl_xor(give, 32);
                    const int key = s0 + key_l;
                    if (key < n) { scr[hh * SCR_N + key] = score; lds_add(hw + hh * 1024 + (fkey(score) >> 22), 1u); }
                }
            }
            if (more) { const int kk = tid >> 1, hf = tid & 1;
#pragma unroll
                for (int j = 0; j < 4; ++j) *(LAS u32x4*)(ksb + ((b + 1) & 1) * 256 * KST + kk * KST + hf * 32 + j * 8) = pre[j]; }
            __syncthreads();
        }
        unsigned b1[2], ab1[2];
        wfind<16>(hw, TOPK, lane, b1[0], ab1[0]); wfind<16>(hw + 1024, TOPK, lane, b1[1], ab1[1]);
        const int nv4 = (n + 3) >> 2;
#pragma unroll
        for (int j = 0; j < 8; ++j) *(LAS u32x4*)(hw + (j * 64 + lane) * 4) = (u32x4){0u, 0u, 0u, 0u};
        for (int sb = 0; sb < nv4; sb += 64 * SELB) {
            f32x4 va[SELB], vb[SELB];
#pragma unroll
            for (int u = 0; u < SELB; ++u) { const int s4 = sb + u * 64 + lane; const int sc = s4 < nv4 ? s4 : nv4 - 1; va[u] = *(const f32x4*)(scr + sc * 4); vb[u] = *(const f32x4*)(scr + SCR_N + sc * 4); }
#pragma unroll
            for (int u = 0; u < SELB; ++u) if (sb + u * 64 + lane < nv4) {
#pragma unroll
                for (int e = 0; e < 4; ++e) { const unsigned ka = fkey(va[u][e]), kb = fkey(vb[u][e]);
                    if ((ka >> 22) == b1[0]) lds_add(hw + ((ka >> 12) & 1023u), 1u);
                    if ((kb >> 22) == b1[1]) lds_add(hw + 1024 + ((kb >> 12) & 1023u), 1u); } } }
        unsigned b2[2], ab2[2];
        wfind<16>(hw, TOPK - ab1[0], lane, b2[0], ab2[0]); wfind<16>(hw + 1024, TOPK - ab1[1], lane, b2[1], ab2[1]);
        const unsigned pfx0 = (b1[0] << 10) | b2[0], pfx1 = (b1[1] << 10) | b2[1];
        const unsigned need0 = (unsigned)TOPK - ab1[0] - ab2[0], need1 = (unsigned)TOPK - ab1[1] - ab2[1];
        LAS unsigned* cl0 = hw; LAS unsigned* cl1 = hw + 1024;
        unsigned cnt0 = 0u, cnt1 = 0u, cc0 = 0u, cc1 = 0u; int* sel0 = SEL + (size_t)tA * TOPK; int* sel1 = sel0 + TOPK;
        const unsigned long long lt = (1ull << lane) - 1ull;
        for (int sb = 0; sb < nv4; sb += 64 * SELB) {
            f32x4 va[SELB], vb[SELB];
#pragma unroll
            for (int u = 0; u < SELB; ++u) { const int s4 = sb + u * 64 + lane; const int sc = s4 < nv4 ? s4 : nv4 - 1; va[u] = *(const f32x4*)(scr + sc * 4); vb[u] = *(const f32x4*)(scr + SCR_N + sc * 4); }
#pragma unroll
            for (int u = 0; u < SELB; ++u) { const int s4 = sb + u * 64 + lane; const bool inr = s4 < nv4;
                if (sb + u * 64 < nv4) {
#pragma unroll
                    for (int e = 0; e < 4; ++e) {
                        {   const unsigned k = fkey(va[u][e]); const bool gt = inr && (k >> 12) > pfx0, eq = inr && (k >> 12) == pfx0;
                            const unsigned long long mg = __ballot(gt), me = __ballot(eq);
                            if (gt) { const unsigned pos = cnt0 + (unsigned)__builtin_popcountll(mg & lt); if (pos < (unsigned)TOPK) sel0[pos] = s4 * 4 + e; }
                            if (eq) { const unsigned ci = cc0 + (unsigned)__builtin_popcountll(me & lt); if (ci < 512u) { cl0[2 * ci] = k; cl0[2 * ci + 1] = (unsigned)(s4 * 4 + e); } }
                            cnt0 += (unsigned)__builtin_popcountll(mg); cc0 += (unsigned)__builtin_popcountll(me); }
                        {   const unsigned k = fkey(vb[u][e]); const bool gt = inr && (k >> 12) > pfx1, eq = inr && (k >> 12) == pfx1;
                            const unsigned long long mg = __ballot(gt), me = __ballot(eq);
                            if (gt) { const unsigned pos = cnt1 + (unsigned)__builtin_popcountll(mg & lt); if (pos < (unsigned)TOPK) sel1[pos] = s4 * 4 + e; }
                            if (eq) { const unsigned ci = cc1 + (unsigned)__builtin_popcountll(me & lt); if (ci < 512u) { cl1[2 * ci] = k; cl1[2 * ci + 1] = (unsigned)(s4 * 4 + e); } }
                            cnt1 += (unsigned)__builtin_popcountll(mg); cc1 += (unsigned)__builtin_popcountll(me); }
                    } } } }
#pragma unroll 1
        for (int qq = 0; qq < 2; ++qq) {
            const LAS unsigned* cl = qq ? cl1 : cl0; const unsigned c = min(qq ? cc1 : cc0, 512u), need = qq ? need1 : need0, base = qq ? cnt1 : cnt0; int* sel = qq ? sel1 : sel0;
            for (unsigned i = lane; i < c; i += 64) { const unsigned k = cl[2 * i], ix = cl[2 * i + 1]; unsigned rank = 0;
                for (unsigned j = 0; j < c; ++j) { const unsigned kj = cl[2 * j], ij = cl[2 * j + 1]; rank += (kj > k || (kj == k && ij < ix)) ? 1u : 0u; }
                if (rank < need && base + rank < (unsigned)TOPK) sel[base + rank] = (int)ix; }
        }
    }
}

__device__ __forceinline__ void d3_qlat(const P& p, LAS unsigned char* lds, int G) {
    const int tid = threadIdx.x, lane = tid & 63, wave = __builtin_amdgcn_readfirstlane(tid >> 6), r16 = lane & 15, q = lane >> 4;
    const bf16_t* Z = (const bf16_t*)(p.ws + WS_Z); const bf16_t* WK = (const bf16_t*)(p.ws + WS_WUKB); bf16_t* QL = (bf16_t*)(p.ws + WS_QLAT);
    constexpr int NB = L / 16, QBS = 136;
    LAS bf16_t* qb = (LAS bf16_t*)lds;
    const int srow = (tid >> 4) & 15, scol = (tid & 15) * 8;
    for (int item = blockIdx.x; item < 256; item += G) {
        const int h = item & 15, qr = item >> 4; const int b0 = qr * 64, b1 = qr == 15 ? NB : b0 + 64;
        bf16x8_t af[4][4];
#pragma unroll
        for (int mt = 0; mt < 4; ++mt)
#pragma unroll
            for (int ks = 0; ks < 4; ++ks) af[mt][ks] = *(const bf16x8_t*)(WK + ((size_t)h * KVR + wave * 64 + 32 * (mt >> 1) + 8 * (r16 >> 2) + 4 * (mt & 1) + (r16 & 3)) * HD_B + ks * 32 + q * 8);
        u32x4 g0 = *(const u32x4*)(Z + (size_t)(b0 * 16 + srow) * NZ + ZQ + h * 128 + scol);
        __syncthreads();
        for (int b = b0; b < b1; ++b) {
            LAS bf16_t* buf = qb + ((b - b0) & 1) * 16 * QBS;
            if (tid < 256) *(LAS u32x4*)(buf + srow * QBS + scol) = g0;
            const int bnx = b + 1 < b1 ? b + 1 : b;
            g0 = *(const u32x4*)(Z + (size_t)(bnx * 16 + srow) * NZ + ZQ + h * 128 + scol);
            LDS_BARRIER();
            bf16x8_t bq[4];
#pragma unroll
            for (int ks = 0; ks < 4; ++ks) bq[ks] = *(const LAS bf16x8_t*)(buf + r16 * QBS + ks * 32 + q * 8);
#pragma unroll
            for (int mp = 0; mp < 2; ++mp) {
                f32x4 acc0 = {0.f, 0.f, 0.f, 0.f}, acc1 = acc0;
#pragma unroll
                for (int ks = 0; ks < 4; ++ks) { acc0 = __builtin_amdgcn_mfma_f32_16x16x32_bf16(af[2 * mp][ks], bq[ks], acc0, 0, 0, 0); acc1 = __builtin_amdgcn_mfma_f32_16x16x32_bf16(af[2 * mp + 1][ks], bq[ks], acc1, 0, 0, 0); }
                u32x4 w; w.x = cvtpk(acc0[0], acc0[1]); w.y = cvtpk(acc0[2], acc0[3]); w.z = cvtpk(acc1[0], acc1[1]); w.w = cvtpk(acc1[2], acc1[3]);
                *(u32x4*)(QL + (size_t)(b * 16 + r16) * 8192 + h * 512 + wave * 64 + mp * 32 + q * 8) = w;
            }
        }
    }
    __syncthreads();
}
__device__ __forceinline__ void d5_oproj(const P& p, LAS unsigned char* lds, int G) {
    const int tid = threadIdx.x, lane = tid & 63, wave = __builtin_amdgcn_readfirstlane(tid >> 6), r16 = lane & 15, q = lane >> 4;
    const bf16_t* OL = (const bf16_t*)(p.ws + WS_QLAT); const bf16_t* WV = (const bf16_t*)(p.ws + WS_WUVT); bf16_t* YB = (bf16_t*)(p.ws + WS_YB);
    for (size_t i = (size_t)blockIdx.x * NT + tid; i < (size_t)(MP - L) * A_W / 8; i += (size_t)G * NT) *(u32x4*)(YB + (size_t)L * A_W + i * 8) = (u32x4){0u, 0u, 0u, 0u};
    constexpr int NB = L / 16, OLS = 520;
    LAS bf16_t* ob = (LAS bf16_t*)lds;
    const int srow = tid >> 5, scol = (tid & 31) * 8;
    for (int item = blockIdx.x; item < 256; item += G) {
        const int h = item & 15, qr = item >> 4; const int b0 = qr * 64, b1 = qr == 15 ? NB : b0 + 64;
        bf16x8_t af[16];
#pragma unroll
        for (int ks = 0; ks < 16; ++ks) af[ks] = *(const bf16x8_t*)(WV + ((size_t)h * HD_B + wave * 16 + r16) * KVR + ks * 32 + q * 8);
        u32x4 g0 = *(const u32x4*)(OL + (size_t)(b0 * 16 + srow) * 8192 + h * 512 + scol), g1 = *(const u32x4*)(OL + (size_t)(b0 * 16 + srow) * 8192 + h * 512 + scol + 256);
        __syncthreads();
        for (int b = b0; b < b1; ++b) {
            LAS bf16_t* buf = ob + ((b - b0) & 1) * 16 * OLS;
            *(LAS u32x4*)(buf + srow * OLS + scol) = g0; *(LAS u32x4*)(buf + srow * OLS + scol + 256) = g1;
            const int bnx = b + 1 < b1 ? b + 1 : b;
            g0 = *(const u32x4*)(OL + (size_t)(bnx * 16 + srow) * 8192 + h * 512 + scol); g1 = *(const u32x4*)(OL + (size_t)(bnx * 16 + srow) * 8192 + h * 512 + scol + 256);
            LDS_BARRIER();
            f32x4 acc0 = {0.f, 0.f, 0.f, 0.f}, acc1 = acc0;
#pragma unroll
            for (int ks = 0; ks < 16; ks += 2) {
                const bf16x8_t bo0 = *(const LAS bf16x8_t*)(buf + r16 * OLS + ks * 32 + q * 8), bo1 = *(const LAS bf16x8_t*)(buf + r16 * OLS + (ks + 1) * 32 + q * 8);
                acc0 = __builtin_amdgcn_mfma_f32_16x16x32_bf16(af[ks], bo0, acc0, 0, 0, 0); acc1 = __builtin_amdgcn_mfma_f32_16x16x32_bf16(af[ks + 1], bo1, acc1, 0, 0, 0); }
            const f32x4 acc = acc0 + acc1;
            u32x2 w; w.x = cvtpk(acc[0], acc[1]); w.y = cvtpk(acc[2], acc[3]);
            *(u32x2*)(YB + (size_t)(b * 16 + r16) * A_W + h * HD_B + wave * 16 + q * 4) = w;
        }
    }
    __syncthreads();
}

typedef short s16x4_t __attribute__((ext_vector_type(4)));
constexpr int QLS = 520, PLS = 264, CTS = 528;
#ifndef ATT_REG
#define ATT_REG 0
#endif
#if ATT_REG > 0
#define AREG_T() const unsigned long long tt_ = __builtin_amdgcn_s_memrealtime()
#ifndef ATT_BLK
#define ATT_BLK 0
#endif
#define AREG(k) do { if (ATT_REG == (k) && blockIdx.x == ATT_BLK && threadIdx.x == 0) { const unsigned long long t1_ = __builtin_amdgcn_s_memrealtime(); areg_acc += t1_ - areg_t0; } if (ATT_REG != 9 && blockIdx.x == ATT_BLK && threadIdx.x == 0) areg_t0 = __builtin_amdgcn_s_memrealtime(); } while (0)
#else
#define AREG(k) do {} while (0)
#endif
__device__ __forceinline__ void d4_attn(const P& p, LAS unsigned char* lds, int G) {
    unsigned long long areg_acc = 0, areg_t0 = 0; (void)areg_acc; (void)areg_t0;
    const int tid = threadIdx.x, lane = tid & 63, wave = __builtin_amdgcn_readfirstlane(tid >> 6), r16 = lane & 15, q = lane >> 4;
    bf16_t* QO = (bf16_t*)(p.ws + WS_QLAT); const bf16_t* CKV = (const bf16_t*)(p.ws + WS_CKV); const int* SEL = (const int*)(p.ws + WS_SEL);
    LAS bf16_t* ql = (LAS bf16_t*)lds;
    LAS float* lg = (LAS float*)(lds + 16640);
    LAS bf16_t* pl = (LAS bf16_t*)(lds + 49408);
    LAS int* sl = (LAS int*)(lds + 57856);
    LAS bf16_t* ct = (LAS bf16_t*)(lds + 58880);
    LAS bf16_t* cx = (LAS bf16_t*)(lds + 126464);
    const float scale = 0.08838834764831845f;
    u32x4 qn0 = (u32x4){0u, 0u, 0u, 0u}, qn1 = qn0; int seln = -1;
    const bool xdeal = (G == 256);
    const int tq0 = xdeal ? ((int)(blockIdx.x & 7) * (L / 8) + (int)(blockIdx.x >> 3)) : (int)blockIdx.x, tqs = xdeal ? 32 : G, tq1 = xdeal ? ((int)(blockIdx.x & 7) + 1) * (L / 8) : L;
    {   const int t = tq0;
        if (t < tq1) { qn0 = *(const u32x4*)(QO + (size_t)t * 8192 + tid * 8); qn1 = *(const u32x4*)(QO + (size_t)t * 8192 + 4096 + tid * 8); if (tid < TOPK) seln = SEL[(size_t)t * TOPK + tid]; } }
#if ATT_REG == 9
    if (blockIdx.x == ATT_BLK && threadIdx.x == 0) areg_t0 = __builtin_amdgcn_s_memrealtime();
#endif
    for (int t = tq0; t < tq1; t += tqs) {
        AREG(5);
        LDS_BARRIER();
        {   const int i0_ = tid, i1_ = tid + 512;
            *(LAS u32x4*)(ql + (i0_ >> 6) * QLS + (i0_ & 63) * 8) = qn0; *(LAS u32x4*)(ql + (i1_ >> 6) * QLS + (i1_ & 63) * 8) = qn1;
            if (tid < TOPK) sl[tid] = seln; }
        LDS_BARRIER();
        AREG(1);
        u32x4 st[8];
#pragma unroll
        for (int i = 0; i < 8; ++i) { const int idx = sl[wave + 8 * i]; st[i] = *(const u32x4*)(CKV + (size_t)(idx < 0 ? 0 : idx) * KVR + lane * 8); }
        const int kk = wave & 3, kh = wave >> 2;
        bf16x8_t af[8];
#pragma unroll
        for (int ks = 0; ks < 8; ++ks) af[ks] = *(const LAS bf16x8_t*)(ql + r16 * QLS + kh * 256 + ks * 32 + q * 8);
        for (int kt = 0; kt < 4; ++kt) {
            LDS_BARRIER();
#pragma unroll
            for (int i = 0; i < 8; ++i) { LAS bf16_t* dst = (kt == 2 && i >= 4) ? cx + (wave + 8 * i - 32) * CTS : ct + (wave + 8 * i) * CTS; *(LAS u32x4*)(dst + lane * 8) = st[i]; }
            if (kt < 3) {
#pragma unroll
                for (int i = 0; i < 8; ++i) { const int idx = sl[(kt + 1) * 64 + wave + 8 * i]; st[i] = *(const u32x4*)(CKV + (size_t)(idx < 0 ? 0 : idx) * KVR + lane * 8); }
            } else {
#pragma unroll
                for (int i = 0; i < 4; ++i) { const int idx = sl[128 + wave + 8 * i]; st[i] = *(const u32x4*)(CKV + (size_t)(idx < 0 ? 0 : idx) * KVR + lane * 8); }
            }
            LDS_BARRIER();
            const LAS bf16_t* kb = (kt == 2 && kk >= 2) ? cx + ((kk - 2) * 16 + r16) * CTS : ct + (kk * 16 + r16) * CTS;
            f32x4 c0 = {0.f, 0.f, 0.f, 0.f};
#pragma unroll
            for (int ks = 0; ks < 8; ++ks) {
                const bf16x8_t b = *(const LAS bf16x8_t*)(kb + kh * 256 + ks * 32 + q * 8);
                c0 = __builtin_amdgcn_mfma_f32_16x16x32_bf16(af[ks], b, c0, 0, 0, 0);
            }
            const int key = kt * 64 + kk * 16 + r16; const bool inval = sl[key] < 0;
#pragma unroll
            for (int e = 0; e < 4; ++e) lg[kh * 4096 + (4 * q + e) * 256 + key] = inval ? (kh ? 0.f : -INFINITY) : c0[e] * scale;
        }
        LDS_BARRIER();
        AREG(2);
        for (int hd = wave * 2; hd < wave * 2 + 2; ++hd) {
            float v[4]; float mx = -INFINITY;
#pragma unroll
            for (int k = 0; k < 4; ++k) { v[k] = lg[hd * 256 + k * 64 + lane] + lg[4096 + hd * 256 + k * 64 + lane]; mx = fmaxf(mx, v[k]); }
            mx = wave_max(mx);
            float s = 0.f;
#pragma unroll
            for (int k = 0; k < 4; ++k) { v[k] = __expf(v[k] - mx); s += v[k]; }
            s = 1.f / wave_sum(s);
#pragma unroll
            for (int k = 0; k < 4; ++k) pl[hd * PLS + k * 64 + lane] = f2bf(v[k] * s);
        }
        f32x4 acc[4];
#pragma unroll
        for (int m = 0; m < 4; ++m) acc[m] = (f32x4){0.f, 0.f, 0.f, 0.f};
        {   const int tn = t + tqs;
            if (tn < tq1) { qn0 = *(const u32x4*)(QO + (size_t)tn * 8192 + tid * 8); qn1 = *(const u32x4*)(QO + (size_t)tn * 8192 + 4096 + tid * 8); if (tid < TOPK) seln = SEL[(size_t)tn * TOPK + tid]; } }
        AREG(3);
        for (int j2 = 0; j2 < 4; ++j2) {
            const int kt = 3 - j2;
            LDS_BARRIER();
            if (j2 > 0) {
                if (j2 == 1) {
#pragma unroll
                    for (int i = 0; i < 4; ++i) *(LAS u32x4*)(ct + (wave + 8 * i) * CTS + lane * 8) = st[i];
                } else {
#pragma unroll
                    for (int i = 0; i < 8; ++i) *(LAS u32x4*)(ct + (wave + 8 * i) * CTS + lane * 8) = st[i];
                }
                if (j2 < 3) {
#pragma unroll
                    for (int i = 0; i < 8; ++i) { const int idx = sl[(kt - 1) * 64 + wave + 8 * i]; st[i] = *(const u32x4*)(CKV + (size_t)(idx < 0 ? 0 : idx) * KVR + lane * 8); } }
                LDS_BARRIER();
            }
            const int kq = 16 * (q >> 1) + 4 * (q & 1);
#pragma unroll
            for (int s = 0; s < 2; ++s) {
                const u32x2 pa = *(const LAS u32x2*)(pl + r16 * PLS + kt * 64 + s * 32 + kq), pb = *(const LAS u32x2*)(pl + r16 * PLS + kt * 64 + s * 32 + kq + 8);
                const u32x4 pw = (u32x4){pa.x, pa.y, pb.x, pb.y}; const bf16x8_t b = __builtin_bit_cast(bf16x8_t, pw);
                const LAS bf16_t* cb = (kt == 2 && s == 1) ? cx : ct + s * 32 * CTS;
                const LAS bf16_t* tp = cb + (kq + (r16 >> 2)) * CTS + wave * 64 + (r16 & 3) * 4;
#pragma unroll
                for (int m = 0; m < 4; ++m) {
                    const s16x4_t lo = __builtin_amdgcn_ds_read_tr16_b64_v4i16((LAS s16x4_t*)(tp + m * 16)), hi = __builtin_amdgcn_ds_read_tr16_b64_v4i16((LAS s16x4_t*)(tp + 8 * CTS + m * 16));
                    const bf16x8_t a = (bf16x8_t){lo[0], lo[1], lo[2], lo[3], hi[0], hi[1], hi[2], hi[3]};
                    acc[m] = __builtin_amdgcn_mfma_f32_16x16x32_bf16(a, b, acc[m], 0, 0, 0);
                }
            }
        }
        AREG(4);
#pragma unroll
        for (int m = 0; m < 4; ++m) { u32x2 w; w.x = cvtpk(acc[m][0], acc[m][1]); w.y = cvtpk(acc[m][2], acc[m][3]);
            *(u32x2*)(QO + (size_t)t * 8192 + r16 * 512 + wave * 64 + m * 16 + q * 4) = w; }
    }
#if ATT_REG == 9
    if (blockIdx.x == ATT_BLK && threadIdx.x == 0) areg_acc = __builtin_amdgcn_s_memrealtime() - areg_t0;
#endif
#if ATT_REG > 0
    if (blockIdx.x == ATT_BLK && threadIdx.x == 0) __hip_atomic_store((unsigned*)(p.ws + WS_CTL) + 65540, (unsigned)areg_acc, __ATOMIC_RELAXED, __HIP_MEMORY_SCOPE_AGENT);
#endif
}


__device__ __forceinline__ const float* h1_row(const P& p, int m) { const float* hmeta = (const float*)(p.ws + WS_HMETA); return m < NMETA ? hmeta + (size_t)m * D : p.out + (size_t)(m - NMETA) * D; }
__device__ __forceinline__ void p12_norm(const P& p, int G) {
    const int lane = threadIdx.x & 63, wave = threadIdx.x >> 6;
    signed char* U8 = (signed char*)(p.ws + WS_U); const float* w = p.in[I_NFW];
    float wm = 0.f;
#pragma unroll
    for (int j = 0; j < 16; ++j) { const f32x4 g = *(const f32x4*)(w + (j * 64 + lane) * 4); wm += (g.x * g.x + g.y * g.y) + (g.z * g.z + g.w * g.w); }
    wm = sqrtf(wave_sum(wm) * (1.f / D));
    const float amc = 4.0f * wm;
    const float inv = amc > 0.f ? 127.f / amc : 0.f;
    if (blockIdx.x == 0 && threadIdx.x == 0) *(float*)(p.ws + WS_CTL + CT_SAG) = amc > 0.f ? amc * (1.f / 127.f) : 1.f;
    for (int m = blockIdx.x * NWAVES + wave; m < MP; m += G * NWAVES) {
        signed char* dst = U8 + (size_t)m * D;
        if (m >= L) {
#pragma unroll
            for (int j = 0; j < 4; ++j) *(u32x4*)(dst + (j * 64 + lane) * 16) = (u32x4){0u, 0u, 0u, 0u};
            continue; }
        const float* src = h1_row(p, m);
        f32x4 v[16]; float s = 0.f;
#pragma unroll
        for (int j = 0; j < 16; ++j) { v[j] = *(const f32x4*)(src + (j * 64 + lane) * 4); s += (v[j].x * v[j].x + v[j].y * v[j].y) + (v[j].z * v[j].z + v[j].w * v[j].w); }
        const float ri = rsqrtf(wave_sum(s) * (1.f / D) + 1e-6f) * inv;
#pragma unroll
        for (int j = 0; j < 16; ++j) { const f32x4 x = v[j] * ri; const f32x4 g = *(const f32x4*)(w + (j * 64 + lane) * 4);
            const unsigned q = ((unsigned)(int)rintf(fminf(fmaxf(x.x * g.x, -127.f), 127.f)) & 0xffu) | (((unsigned)(int)rintf(fminf(fmaxf(x.y * g.y, -127.f), 127.f)) & 0xffu) << 8) | (((unsigned)(int)rintf(fminf(fmaxf(x.z * g.z, -127.f), 127.f)) & 0xffu) << 16) | (((unsigned)(int)rintf(fminf(fmaxf(x.w * g.w, -127.f), 127.f)) & 0xffu) << 24);
            *(unsigned*)(dst + (j * 64 + lane) * 4) = q; }
    }
}
__device__ __forceinline__ void p18_final_norm(const P& p, int G) {
    const int tid = threadIdx.x, lane = tid & 63, wave = tid >> 6;
    const float* w = p.in[I_NFIN];
    for (int m = blockIdx.x * NWAVES + wave; m < SEQ; m += G * NWAVES) {
        float* row = p.out + (size_t)m * D;
        f32x4 v[16]; float s = 0.f;
#pragma unroll
        for (int j = 0; j < 16; ++j) { v[j] = *(const f32x4*)(row + (j * 64 + lane) * 4); s += (v[j].x * v[j].x + v[j].y * v[j].y) + (v[j].z * v[j].z + v[j].w * v[j].w); }
        float r = rsqrtf(wave_sum(s) * (1.f / D) + 1e-6f);
#if STAMP_A0 >= 0
        r *= 1.f + 1e-7f * (float)__hip_atomic_load((const unsigned*)(p.ws + WS_CTL) + 65536, __ATOMIC_RELAXED, __HIP_MEMORY_SCOPE_AGENT);
#endif
#pragma unroll
        for (int j = 0; j < 16; ++j) { const f32x4 g = *(const f32x4*)(w + (j * 64 + lane) * 4); *(f32x4*)(row + (j * 64 + lane) * 4) = v[j] * r * g; }
    }
}

__device__ __forceinline__ void p14_conv_act(const P& p, int G, int pass) {
    const int tid = threadIdx.x;
    const bf16_t* ZF = (const bf16_t*)(p.ws + WS_ZF); bf16_t* ACT = (bf16_t*)(p.ws + WS_ACT);
    const float* cw = p.in[I_CW]; const float* cb = p.in[I_CB];
    const size_t nitems = (size_t)MP * 43 * 16;
    for (size_t it = (size_t)blockIdx.x * NT + tid; it < nitems; it += (size_t)G * NT) {
        const int g8 = (int)(it % 16), tl = (int)((it / 16) % 43), t = (int)(it / (16 * 43));
        const int ch = (pass * 43 + tl) * 128 + g8 * 8;
        u32x4 o = (u32x4){0u, 0u, 0u, 0u};
        if (t < L) {
            float zg[8], zu[8];
#pragma unroll
            for (int e = 0; e < 8; ++e) { zg[e] = cb[ch + e]; zu[e] = cb[DFF + ch + e]; }
#pragma unroll
            for (int i = 0; i < 3; ++i) { const int tt = t - 2 + i;
                if (tt >= 0) {
                    const u32x4 a = *(const u32x4*)(ZF + (size_t)tt * DFF + tl * 256 + g8 * 8), b = *(const u32x4*)(ZF + (size_t)tt * DFF + tl * 256 + 128 + g8 * 8);
                    const float xa[8] = {blo(a.x), bhi(a.x), blo(a.y), bhi(a.y), blo(a.z), bhi(a.z), blo(a.w), bhi(a.w)};
                    const float xb[8] = {blo(b.x), bhi(b.x), blo(b.y), bhi(b.y), blo(b.z), bhi(b.z), blo(b.w), bhi(b.w)};
#pragma unroll
                    for (int e = 0; e < 8; ++e) { zg[e] += cw[(size_t)i * NFI + ch + e] * xa[e]; zu[e] += cw[(size_t)i * NFI + DFF + ch + e] * xb[e]; }
                } }
            float r[8];
#pragma unroll
            for (int e = 0; e < 8; ++e) r[e] = zg[e] * sigm(zg[e]) * zu[e];
            o.x = pk2(r[0], r[1]); o.y = pk2(r[2], r[3]); o.z = pk2(r[4], r[5]); o.w = pk2(r[6], r[7]);
        }
        *(u32x4*)(ACT + (size_t)t * DFF + ch) = o;
    }
}

template <int K, class F> __device__ __forceinline__ void side2(const bf16_t* A14, int lda, const bf16_t* Bt, int N, int G, F f) {
    const int lane = threadIdx.x & 63, gw = blockIdx.x * NWAVES + (threadIdx.x >> 6);
    constexpr int NC = K / 512;
    u32x4 a0[NC], a1[NC];
#pragma unroll
    for (int i = 0; i < NC; ++i) { a0[i] = *(const u32x4*)(A14 + i * 512 + lane * 8); a1[i] = *(const u32x4*)(A14 + lda + i * 512 + lane * 8); }
    for (int n = gw; n < N; n += G * NWAVES) {
        float s0 = 0.f, s1 = 0.f;
#pragma unroll
        for (int i = 0; i < NC; ++i) { const u32x4 b = *(const u32x4*)(Bt + (size_t)n * K + i * 512 + lane * 8);
            const unsigned bw[4] = {b.x, b.y, b.z, b.w}, x0[4] = {a0[i].x, a0[i].y, a0[i].z, a0[i].w}, x1[4] = {a1[i].x, a1[i].y, a1[i].z, a1[i].w};
#pragma unroll
            for (int e = 0; e < 4; ++e) { s0 += blo(x0[e]) * blo(bw[e]) + bhi(x0[e]) * bhi(bw[e]); s1 += blo(x1[e]) * blo(bw[e]) + bhi(x1[e]) * bhi(bw[e]); } }
        s0 = wave_sum(s0); s1 = wave_sum(s1);
        if (lane == 0) f(n, s0, s1);
    }
}

template <class F> __device__ __forceinline__ void side2_i8(const signed char* A14, const signed char* Bt, int N, int G, F f) {
    const int lane = threadIdx.x & 63, gw = blockIdx.x * NWAVES + (threadIdx.x >> 6);
    u32x4 a0[4], a1[4];
#pragma unroll
    for (int i = 0; i < 4; ++i) { a0[i] = *(const u32x4*)(A14 + i * 1024 + lane * 16); a1[i] = *(const u32x4*)(A14 + 4096 + i * 1024 + lane * 16); }
    for (int n = gw; n < N; n += G * NWAVES) {
        int s0 = 0, s1 = 0;
#pragma unroll
        for (int i = 0; i < 4; ++i) { const u32x4 b = *(const u32x4*)(Bt + (size_t)n * 4096 + i * 1024 + lane * 16);
            s0 = __builtin_amdgcn_sdot4((int)a0[i].x, (int)b.x, s0, false); s0 = __builtin_amdgcn_sdot4((int)a0[i].y, (int)b.y, s0, false); s0 = __builtin_amdgcn_sdot4((int)a0[i].z, (int)b.z, s0, false); s0 = __builtin_amdgcn_sdot4((int)a0[i].w, (int)b.w, s0, false);
            s1 = __builtin_amdgcn_sdot4((int)a1[i].x, (int)b.x, s1, false); s1 = __builtin_amdgcn_sdot4((int)a1[i].y, (int)b.y, s1, false); s1 = __builtin_amdgcn_sdot4((int)a1[i].z, (int)b.z, s1, false); s1 = __builtin_amdgcn_sdot4((int)a1[i].w, (int)b.w, s1, false); }
#pragma unroll
        for (int d = 32; d >= 1; d >>= 1) { s0 += __shfl_xor(s0, d); s1 += __shfl_xor(s1, d); }
        if (lane == 0) f(n, s0, s1);
    }
}

__device__ __forceinline__ void p_conv_fix(const P& p, int G) {
    const int tid = threadIdx.x;
    const float* HALO = (const float*)(p.ws + WS_ZF); bf16_t* ACT = (bf16_t*)(p.ws + WS_ACT);
    const float* cw = p.in[I_CW]; const float* cb = p.in[I_CB];
    const int nitems = 64 * 2 * DFF;
    for (int it = blockIdx.x * NT + tid; it < nitems; it += G * NT) {
        const int c = it % DFF, d = (it / DFF) & 1, pm = 1 + it / (2 * DFF);
        const int r = pm * 256 + d; if (r >= L) continue;
        const int T = c >> 7, cl = c & 127; const int colg = T * 256 + cl, colu = colg + 128;
        const float* h0 = HALO + ((size_t)(pm - 1) * 4 + 2 + d) * NFI; const float* h1 = d == 0 ? HALO + ((size_t)(pm - 1) * 4 + 3) * NFI : HALO + ((size_t)pm * 4 + 0) * NFI; const float* h2 = HALO + ((size_t)pm * 4 + d) * NFI;
        const float zg = cb[c] + cw[c] * h0[colg] + cw[(size_t)NFI + c] * h1[colg] + cw[(size_t)2 * NFI + c] * h2[colg];
        const float zu = cb[DFF + c] + cw[DFF + c] * h0[colu] + cw[(size_t)NFI + DFF + c] * h1[colu] + cw[(size_t)2 * NFI + DFF + c] * h2[colu];
        ACT[(size_t)r * DFF + c] = f2bf(zg * sigm(zg) * zu);
    }
}

constexpr int NPHASE = 20;
__global__ void __launch_bounds__(NT, 2) fwd_kernel(P p) {
    extern __shared__ __attribute__((aligned(16))) unsigned char lds_raw[];
    LAS unsigned char* lds = (LAS unsigned char*)lds_raw;
    const int G = gridDim.x;
    unsigned char* ws = p.ws;
    volatile LAS unsigned* MISC = (volatile LAS unsigned*)(lds + MISC_OFF);
    if (threadIdx.x < 16) MISC[threadIdx.x] = 0u;
    __syncthreads();
#if MK_ONE_LAUNCH
    XcdBarrier bar = xcd_barrier_post((unsigned*)(ws + WS_CTL), MISC + 8);
#define GRID_BAR() xcd_barrier(bar)
#else
#define GRID_BAR() do {} while (0)
#endif
    unsigned long long tsA0 = 0, tsA1 = 0, tsB0 = 0, tsB1 = 0; (void)tsA0; (void)tsA1; (void)tsB0; (void)tsB1;
    const int lo = p.ph_lo, hi = p.ph_hi;
#ifndef PHASE_MASK
#define PHASE_MASK 0xFFFFFFFu
#endif
#define IN(k) ((((PHASE_MASK) >> (k)) & 1u) && lo <= (k) && (k) < hi)
#ifndef STAMP_A0
#define STAMP_A0 -1
#endif
#if STAMP_A0 >= 0
#define STAMP(k) do { if (blockIdx.x == 0 && threadIdx.x == 0) { const unsigned long long t_ = __builtin_amdgcn_s_memrealtime(); if ((k) == STAMP_A0) tsA0 = t_; if ((k) == STAMP_A1) tsA1 = t_; if ((k) == STAMP_B0) tsB0 = t_; if ((k) == STAMP_B1) { tsB1 = t_; \
    __hip_atomic_store((unsigned*)(ws + WS_CTL) + 65536, (unsigned)(tsB1 - tsB0), __ATOMIC_RELAXED, __HIP_MEMORY_SCOPE_AGENT); } } } while (0)
#else
#define STAMP(k) do {} while (0)
#endif
#define SEAM(k) do { if (IN((k) + 1)) GRID_BAR(); STAMP((k) + 1); } while (0)
    STAMP(0);
#ifndef PROBE_REP_MASK
#define PROBE_REP_MASK 0u
#endif
#define NREP(k) ((((PROBE_REP_MASK) >> (k)) & 1u) ? 2 : 1)
    bf16_t* U = (bf16_t*)(ws + WS_U);
    if (IN(0)) _Pragma("unroll") for (int rep_ = 0; rep_ < NREP(0); ++rep_) { p0_prologue_a(p, lds, G); GRID_BAR(); p0_prologue_b(p, lds, G); if (rep_ == NREP(0) - 1) SEAM(0); }
    if (IN(1)) _Pragma("unroll") for (int rep_ = 0; rep_ < NREP(1); ++rep_) {
        {   pg8::Gemm g{U, (const bf16_t*)(ws + WS_WINT), MP, NZ8, D / 2, (const float*)(ws + WS_CTL + CT_SA), (const float*)(ws + WS_CTL + CT_SB_IN)}; pg8::StaticOrder S; S.init(MP, NZ8, G, (int)blockIdx.x);
            pg8::EpiBf16<0> E{(bf16_t*)(ws + WS_Z), NZ};
            pg8::gemm_phase<pg8::EpiBf16<0>, pg8::StaticOrder, true, true, true>(lds, g, S, E); }
        {   pg8::Gemm g{(const bf16_t*)(ws + WS_R1), (const bf16_t*)(ws + WS_WINT + WINT_BF_OFF), MP, NZ - NZ8, D}; pg8::StaticOrder S; S.init(MP, NZ - NZ8, G, (int)blockIdx.x);
            pg8::EpiBf16<0> E{(bf16_t*)(ws + WS_Z) + NZ8, NZ};
            pg8::gemm_phase<pg8::EpiBf16<0>, pg8::StaticOrder, true, true, false>(lds, g, S, E); }
        if (rep_ == NREP(1) - 1) SEAM(1);
    }
    if (IN(2)) _Pragma("unroll") for (int rep_ = 0; rep_ < NREP(2); ++rep_) { p2_rwkv_prep(p, lds, G); if (rep_ == NREP(2) - 1) SEAM(2); }
    if (IN(3)) _Pragma("unroll") for (int rep_ = 0; rep_ < NREP(3); ++rep_) { ra_items(p, lds, G); if (rep_ == NREP(3) - 1) SEAM(3); }
    if (IN(4)) _Pragma("unroll") for (int rep_ = 0; rep_ < NREP(4); ++rep_) { rb_chain(p, G);
        {
            const int wv_ = threadIdx.x >> 6, nch_ = G < 128 ? G : 128; const int nvw_ = nch_ * 7 + (G - nch_) * 8;
            const int vw_ = (int)blockIdx.x < nch_ ? ((int)blockIdx.x * 7 + wv_ - 1) : (nch_ * 7 + ((int)blockIdx.x - nch_) * 8 + wv_);
            if (!((int)blockIdx.x < nch_ && wv_ == 0)) p0b_weights(p, lds, vw_, nvw_); }
        if (rep_ == NREP(4) - 1) SEAM(4); }
    if (IN(5)) _Pragma("unroll") for (int rep_ = 0; rep_ < NREP(5); ++rep_) { rc_out(p, G); if (rep_ == NREP(5) - 1) SEAM(5); }
    if (IN(6)) _Pragma("unroll") for (int rep_ = 0; rep_ < NREP(6); ++rep_) { p4_dsa_prep(p, G); if (rep_ == NREP(6) - 1) SEAM(6); }
    if (IN(7)) _Pragma("unroll") for (int rep_ = 0; rep_ < NREP(7); ++rep_) { d2_topk(p, lds, G); if (rep_ == NREP(7) - 1) SEAM(7); }
    if (IN(8)) _Pragma("unroll") for (int rep_ = 0; rep_ < NREP(8); ++rep_) { d3_qlat(p, lds, G); if (rep_ == NREP(8) - 1) SEAM(8); }
    if (IN(9)) _Pragma("unroll") for (int rep_ = 0; rep_ < NREP(9); ++rep_) { d4_attn(p, lds, G); if (rep_ == NREP(9) - 1) SEAM(9); }
    if (IN(11)) _Pragma("unroll") for (int rep_ = 0; rep_ < NREP(11); ++rep_) {
        d5_oproj(p, lds, G);
        pg8::Gemm g{U + (size_t)NMETA * (D / 2), (const bf16_t*)(ws + WS_WGT), SEQ, 8192, D / 2, (const float*)(ws + WS_CTL + CT_SA) + NMETA, (const float*)(ws + WS_CTL + CT_SB_G)}; pg8::StaticOrder S; S.init(SEQ, 8192, G, (int)blockIdx.x);
        pg8::EpiBf16<1> E{(bf16_t*)(ws + WS_GATES) + (size_t)NMETA * 8192, 8192};
        pg8::gemm_phase<pg8::EpiBf16<1>, pg8::StaticOrder, true, true, true>(lds, g, S, E);
        {   const float* SA_ = (const float*)(ws + WS_CTL + CT_SA); const float* SB_ = (const float*)(ws + WS_CTL + CT_SB_G); bf16_t* GT = (bf16_t*)(ws + WS_GATES);
            side2_i8((const signed char*)(ws + WS_U) + (size_t)14 * D, (const signed char*)(ws + WS_WGT), 8192, G, [&](int n, int i0, int i1) {
                GT[(size_t)14 * 8192 + n] = f2bf(1.f / (1.f + __expf(-(float)i0 * SA_[14] * SB_[n]))); GT[(size_t)15 * 8192 + n] = f2bf(1.f / (1.f + __expf(-(float)i1 * SA_[15] * SB_[n]))); }); }
        if (rep_ == NREP(11) - 1) SEAM(11);
    }
    if (IN(12)) _Pragma("unroll") for (int rep_ = 0; rep_ < NREP(12); ++rep_) {
        pg8::Gemm g{(const bf16_t*)(ws + WS_YA) + (size_t)NMETA * A_W, (const bf16_t*)(ws + WS_WPAT), SEQ, D, A_W}; pg8::StaticOrder S; S.init(SEQ, D, G, (int)blockIdx.x);
        pg8::EpiGateMulF32 E{(bf16_t*)(ws + WS_MF) + (size_t)NMETA * D, D, (const bf16_t*)(ws + WS_GATES) + (size_t)NMETA * 8192, 8192, 0};
        pg8::gemm_phase<pg8::EpiGateMulF32, pg8::StaticOrder, true, true>(lds, g, S, E);
        {   bf16_t* MA = (bf16_t*)(ws + WS_MF); const bf16_t* GT = (const bf16_t*)(ws + WS_GATES);
            side2<2048>((const bf16_t*)(ws + WS_YA) + (size_t)14 * A_W, A_W, (const bf16_t*)(ws + WS_WPAT), D, G, [&](int n, float s0, float s1) {
                MA[(size_t)14 * D + n] = f2bf(bf2f(GT[(size_t)14 * 8192 + n]) * s0); MA[(size_t)15 * D + n] = f2bf(bf2f(GT[(size_t)15 * 8192 + n]) * s1); }); }
        if (rep_ == NREP(12) - 1) SEAM(12);
    }
    if (IN(13)) _Pragma("unroll") for (int rep_ = 0; rep_ < NREP(13); ++rep_) {
        pg8::Gemm g{(const bf16_t*)(ws + WS_YB) + (size_t)NMETA * A_W, (const bf16_t*)(ws + WS_WPBT), SEQ, D, A_W}; pg8::StaticOrder S; S.init(SEQ, D, G, (int)blockIdx.x);
        pg8::EpiGateMulAddBf16 E{U + (size_t)NMETA * D, D, (const bf16_t*)(ws + WS_MF) + (size_t)NMETA * D, (const bf16_t*)(ws + WS_GATES) + (size_t)NMETA * 8192, 8192, D};
        pg8::gemm_phase<pg8::EpiGateMulAddBf16, pg8::StaticOrder, true, true>(lds, g, S, E);
        {   const bf16_t* MA = (const bf16_t*)(ws + WS_MF); const bf16_t* GT = (const bf16_t*)(ws + WS_GATES);
            side2<2048>((const bf16_t*)(ws + WS_YB) + (size_t)14 * A_W, A_W, (const bf16_t*)(ws + WS_WPBT), D, G, [&](int n, float s0, float s1) {
                U[(size_t)14 * D + n] = f2bf(bf2f(MA[(size_t)14 * D + n]) + bf2f(GT[(size_t)14 * 8192 + D + n]) * s0); U[(size_t)15 * D + n] = f2bf(bf2f(MA[(size_t)15 * D + n]) + bf2f(GT[(size_t)15 * 8192 + D + n]) * s1); }); }
        if (rep_ == NREP(13) - 1) SEAM(13);
    }
    if (IN(14)) _Pragma("unroll") for (int rep_ = 0; rep_ < NREP(14); ++rep_) {
        pg8::Gemm g{U + (size_t)NMETA * D, (const bf16_t*)(ws + WS_WOUTT), SEQ, D, D}; pg8::StaticOrder S; S.init(SEQ, D, G, (int)blockIdx.x);
        pg8::EpiResid E{p.in[I_X], p.in[I_X], p.out, p.out, D, 0, SEQ};
        pg8::gemm_phase<pg8::EpiResid, pg8::StaticOrder, true, true>(lds, g, S, E);
        {   float* HM = (float*)(ws + WS_HMETA); const float* mt = p.in[I_META];
            for (int i2 = blockIdx.x * NT + threadIdx.x; i2 < 14 * D; i2 += G * NT) HM[i2] = mt[i2];
            side2<4096>(U + (size_t)14 * D, D, (const bf16_t*)(ws + WS_WOUTT), D, G, [&](int n, float s0, float s1) { HM[(size_t)14 * D + n] = mt[(size_t)14 * D + n] + s0; HM[(size_t)15 * D + n] = mt[(size_t)15 * D + n] + s1; }); }
        if (rep_ == NREP(14) - 1) SEAM(14);
    }
    if (IN(15)) _Pragma("unroll") for (int rep_ = 0; rep_ < NREP(15); ++rep_) { p12_norm(p, G); if (rep_ == NREP(15) - 1) SEAM(15); }
    if (IN(16)) _Pragma("unroll") for (int rep_ = 0; rep_ < NREP(16); ++rep_) {
        pg8::Gemm g{U, (const bf16_t*)(ws + WS_WFIT), MP, NFI, D / 2, (const float*)(ws + WS_CTL + CT_SA), (const float*)(ws + WS_CTL + CT_SB_F)}; pg8::StaticOrder S; S.init(MP, NFI, G, (int)blockIdx.x);
        pg8::EpiConvAct E{(bf16_t*)(ws + WS_ACT), DFF, (float*)(ws + WS_ZF), NFI, p.in[I_CW], p.in[I_CB], DFF, (PG8_LAS float*)(lds + 131072), (const float*)(ws + WS_CTL + CT_SAG), (const float*)(ws + WS_CTL + CT_SB_F)};
        pg8::gemm_phase<pg8::EpiConvAct, pg8::StaticOrder, true, true, true>(lds, g, S, E);
        if (rep_ == NREP(16) - 1) SEAM(16);
    }
    if (IN(17)) _Pragma("unroll") for (int rep_ = 0; rep_ < NREP(17); ++rep_) { p_conv_fix(p, G); if (rep_ == NREP(17) - 1) SEAM(17); }
    if (IN(18)) _Pragma("unroll") for (int rep_ = 0; rep_ < NREP(18); ++rep_) {
        pg8::Gemm g{(const bf16_t*)(ws + WS_ACT) + (size_t)NMETA * DFF, (const bf16_t*)(ws + WS_WFOT), SEQ, D, DFF}; pg8::StaticOrder S; S.init(SEQ, D, G, (int)blockIdx.x);
        pg8::EpiResid E{p.out, p.out, p.out, p.out, D, 0, SEQ};
        pg8::gemm_phase<pg8::EpiResid, pg8::StaticOrder, true, true>(lds, g, S, E);
        if (rep_ == NREP(18) - 1) SEAM(18);
    }
    if (IN(19)) _Pragma("unroll") for (int rep_ = 0; rep_ < NREP(19); ++rep_) { p18_final_norm(p, G); }
#if STAMP_A0 >= 0
    if (blockIdx.x == 0 && threadIdx.x == 0) { const unsigned long long t_end = __builtin_amdgcn_s_memrealtime(); unsigned long long dA = (tsA1 - tsA0) * 64ull;
#if defined(ATT_REG) && ATT_REG > 0
        dA = (unsigned long long)__hip_atomic_load((const unsigned*)(ws + WS_CTL) + 65540, __ATOMIC_RELAXED, __HIP_MEMORY_SCOPE_AGENT) * 64ull;
#endif
        while (__builtin_amdgcn_s_memrealtime() - t_end < dA) __builtin_amdgcn_s_sleep(8); }
#endif
#undef IN
#undef SEAM
}

extern "C" void kernel_launch(void* const* d_in, const int* in_sizes, int n_in, void* d_out, int out_size, void* d_ws, size_t ws_size, hipStream_t stream) {
    static int grid = 0;
    if (grid == 0) {
        if (n_in != 30 || out_size != SEQ * D || ws_size < WS_END2) { fprintf(stderr, "kernel_launch: unexpected shapes (n_in %d out %d ws %zu need %zu)\n", n_in, out_size, ws_size, (size_t)WS_END); grid = -1; return; }
        int dev = 0, cus = 0, per_cu = 0;
        if (hipGetDevice(&dev) != hipSuccess || hipDeviceGetAttribute(&cus, hipDeviceAttributeMultiprocessorCount, dev) != hipSuccess) { grid = -1; return; }
        if (hipFuncSetAttribute((const void*)fwd_kernel, hipFuncAttributeMaxDynamicSharedMemorySize, LDS_BYTES) != hipSuccess) { fprintf(stderr, "kernel_launch: hipFuncSetAttribute failed\n"); grid = -1; return; }
        if (hipOccupancyMaxActiveBlocksPerMultiprocessor(&per_cu, (const void*)fwd_kernel, NT, LDS_BYTES) != hipSuccess || per_cu < 1) fprintf(stderr, "kernel_launch: occupancy query says %d\n", per_cu);
        (void)hipGetLastError();
        grid = cus;
    }
    if (grid < 0) return;
    (void)hipMemsetAsync((char*)d_ws + WS_CTL, 0, CTL_BYTES, stream);
    P a{};
    for (int i = 0; i < 30; ++i) a.in[i] = (const float*)d_in[i];
    a.out = (float*)d_out; a.ws = (unsigned char*)d_ws;
#if MK_ONE_LAUNCH
    a.ph_lo = 0; a.ph_hi = NPHASE;
    hipLaunchKernelGGL(fwd_kernel, dim3(grid), dim3(NT), LDS_BYTES, stream, a);
#else
    for (int k = 0; k < NPHASE; ++k) { a.ph_lo = k; a.ph_hi = k + 1; hipLaunchKernelGGL(fwd_kernel, dim3(grid), dim3(NT), LDS_BYTES, stream, a); }
#endif
}
```
